# Optimizing an MI355X kernel written in HIP

```python
import math
import jax, jax.numpy as jnp
from jax import lax
import numpy as np

D_MODEL = 1024
BATCH = 8
SEQ = 2048
DEPTH = 1

MEM_LEN = 256
RMS_EPS = 1e-6
NEG = -1e30

ATTN_HEADS = 8
ATTN_HEAD_DIM = 64
ATTN_WIDTH = ATTN_HEADS * ATTN_HEAD_DIM
MOBA_BLOCK = 256
MOBA_TOPK = 3
MOBA_Q_CHUNK = 64

REL_BUCKETS = 32
REL_MAX_DIST = 1024

CONV_WIDTH = 512
CONV_K = 3

XATTN_HEADS = 4
XATTN_HEAD_DIM = 128
XATTN_WIDTH = XATTN_HEADS * XATTN_HEAD_DIM

N_BRANCH = 3
PROJ_SPLITS = [ATTN_WIDTH, ATTN_WIDTH, ATTN_WIDTH, CONV_WIDTH, CONV_WIDTH, CONV_WIDTH, XATTN_WIDTH, N_BRANCH * D_MODEL]
PROJ_WIDTH = sum(PROJ_SPLITS)
PROJ_OFFSETS = [int(o) for o in np.cumsum(PROJ_SPLITS)[:-1]]

PEER_HEADS = 8
PEER_NKEYS = 128
PEER_EXPERTS = PEER_NKEYS * PEER_NKEYS
PEER_DHALF = 128
PEER_TOPK = 16
PEER_TOKEN_CHUNK = 128

kernel_name = "hybrid_moba_conv_xattn_peer"


def rms_norm(x, g):
    xf = x.astype(jnp.float32)
    y = xf * lax.rsqrt(jnp.mean(xf * xf, axis=-1, keepdims=True) + RMS_EPS)
    return (y * g.astype(jnp.float32)).astype(x.dtype)


def rel_bucket(dist):
    max_exact = REL_BUCKETS // 2
    d = jnp.maximum(dist, 0)
    df = jnp.maximum(d, 1).astype(jnp.float32)
    large = max_exact + (jnp.log(df / max_exact) / math.log(REL_MAX_DIST / max_exact)
                         * (REL_BUCKETS - max_exact)).astype(jnp.int32)
    large = jnp.minimum(large, REL_BUCKETS - 1)
    return jnp.where(d < max_exact, d, large)


def split_heads(t, n_heads):
    b, s, w = t.shape
    return t.reshape(b, s, n_heads, w // n_heads).transpose(0, 2, 1, 3)


def merge_heads(t):
    b, h, s, dh = t.shape
    return t.transpose(0, 2, 1, 3).reshape(b, s, h * dh)


def moba_attention(q, k, v, rel_bias):
    B, H, S, dh = q.shape
    L = MOBA_BLOCK
    nb = -(-S // L)
    pad = nb * L - S
    kp = jnp.pad(k, ((0, 0), (0, 0), (0, pad), (0, 0)))
    vp = jnp.pad(v, ((0, 0), (0, 0), (0, pad), (0, 0)))
    kb = kp.reshape(B, H, nb, L, dh)
    vb = vp.reshape(B, H, nb, L, dh)
    k_mean = jnp.mean(kb.astype(jnp.float32), axis=3)
    q_blk = jnp.arange(S) // L
    gate = jnp.einsum('bhsd,bhnd->bhsn', q.astype(jnp.float32), k_mean)
    past = jnp.arange(nb)[None, :] < q_blk[:, None]
    gate = jnp.where(past, gate, NEG)
    n_sel = min(MOBA_TOPK, nb)
    _, sel = lax.top_k(gate, n_sel)
    sel_valid = sel < q_blk[:, None]
    scale = dh ** -0.5
    rel_t = rel_bias.T
    b_ix = jnp.arange(B)[:, None, None, None]
    h_ix = jnp.arange(H)[None, :, None, None]
    Qc = MOBA_Q_CHUNK
    n_chunks = S // Qc

    def chunk(c):
        start = c * Qc
        qc = lax.dynamic_slice_in_dim(q, start, Qc, axis=2)
        sc = lax.dynamic_slice_in_dim(sel, start, Qc, axis=2)
        vc = lax.dynamic_slice_in_dim(sel_valid, start, Qc, axis=2)
        qpos = start + jnp.arange(Qc)
        blk = start // L
        kg = kb[b_ix, h_ix, sc]
        vg = vb[b_ix, h_ix, sc]
        kpos_g = sc[..., None] * L + jnp.arange(L)
        bias_g = rel_t[h_ix[..., None], rel_bucket(qpos[:, None, None] - kpos_g)]
        lg = jnp.einsum('bhqd,bhqnld->bhqnl', qc, kg).astype(jnp.float32) * scale + bias_g
        lg = jnp.where(vc[..., None], lg, NEG)
        ko = lax.dynamic_slice_in_dim(kp, blk * L, L, axis=2)
        vo = lax.dynamic_slice_in_dim(vp, blk * L, L, axis=2)
        dist_o = qpos[:, None] - (blk * L + jnp.arange(L))[None, :]
        bias_o = rel_t[:, rel_bucket(dist_o)]
        lo = jnp.einsum('bhqd,bhld->bhql', qc, ko).astype(jnp.float32) * scale + bias_o
        lo = jnp.where(dist_o >= 0, lo, NEG)
        logits = jnp.concatenate([lg.reshape(B, H, Qc, n_sel * L), lo], axis=-1)
        p = jax.nn.softmax(logits, axis=-1)
        pg = p[..., :n_sel * L].reshape(B, H, Qc, n_sel, L).astype(v.dtype)
        po = p[..., n_sel * L:].astype(v.dtype)
        return (jnp.einsum('bhqnl,bhqnld->bhqd', pg, vg)
                + jnp.einsum('bhql,bhld->bhqd', po, vo))

    outs = lax.map(chunk, jnp.arange(n_chunks))
    return outs.transpose(1, 2, 0, 3, 4).reshape(B, H, S, dh)


def short_conv(u, w):
    C = u.shape[-1]
    return lax.conv_general_dilated(
        u, w[:, None, :], window_strides=(1,), padding=((CONV_K - 1, 0),),
        dimension_numbers=('NWC', 'WIO', 'NWC'), feature_group_count=C)


def cross_attention(q, k, v):
    scale = q.shape[-1] ** -0.5
    logits = jnp.einsum('bhsd,bhmd->bhsm', q, k).astype(jnp.float32) * scale
    p = jax.nn.softmax(logits, axis=-1)
    return jnp.einsum('bhsm,bhmd->bhsd', p.astype(v.dtype), v)


def peer(x, w_query, sub_keys, expert_u, expert_v):
    B, S, D = x.shape
    T = B * S
    xt = x.reshape(T, D)
    CH = PEER_TOKEN_CHUNK
    K = PEER_TOPK

    def chunk(c):
        xc = lax.dynamic_slice_in_dim(xt, c * CH, CH, axis=0)
        qry = (xc @ w_query).reshape(CH, PEER_HEADS, 2, PEER_DHALF)
        s = jnp.einsum('thpd,hpnd->thpn', qry, sub_keys).astype(jnp.float32)
        s_top, i_top = lax.top_k(s, K)
        cand = s_top[:, :, 0, :, None] + s_top[:, :, 1, None, :]
        cand_idx = i_top[:, :, 0, :, None] * PEER_NKEYS + i_top[:, :, 1, None, :]
        best_s, best_pos = lax.top_k(cand.reshape(CH, PEER_HEADS, K * K), K)
        e_idx = jnp.take_along_axis(cand_idx.reshape(CH, PEER_HEADS, K * K), best_pos, axis=-1)
        g = jax.nn.softmax(best_s, axis=-1)
        u = expert_u[e_idx]
        vv = expert_v[e_idx]
        act = jax.nn.gelu(jnp.einsum('td,thkd->thk', xc, u).astype(jnp.float32), approximate=False)
        return jnp.einsum('thk,thkd->td', (g * act).astype(x.dtype), vv)

    out = lax.map(chunk, jnp.arange(T // CH))
    return out.reshape(B, S, D)


def setup_inputs(seed: int = 0) -> dict:
    key = jax.random.key(seed)
    ks = jax.random.split(key, 24)
    f32 = jnp.float32
    D = D_MODEL

    def nrm(k, shape, scale):
        return jax.random.normal(k, shape, f32) * scale

    def gain(k, shape):
        return 1.0 + 0.1 * jax.random.normal(k, shape, f32)

    return {
        "x": nrm(ks[0], (BATCH, SEQ, D), 1.0),
        "mem": nrm(ks[1], (BATCH, MEM_LEN, D), 1.0),
        "g_mix": gain(ks[2], (DEPTH, D)),
        "w_in": nrm(ks[3], (DEPTH, D, PROJ_WIDTH), D ** -0.5),
        "q_gain_a": gain(ks[4], (DEPTH, ATTN_HEAD_DIM)),
        "k_gain_a": gain(ks[5], (DEPTH, ATTN_HEAD_DIM)),
        "rel_bias": nrm(ks[6], (REL_BUCKETS, ATTN_HEADS), 0.3),
        "conv_w": nrm(ks[7], (DEPTH, CONV_K, CONV_WIDTH), CONV_K ** -0.5),
        "g_mem": gain(ks[8], (DEPTH, D)),
        "w_mem_kv": nrm(ks[9], (DEPTH, D, 2 * XATTN_WIDTH), D ** -0.5),
        "q_gain_x": gain(ks[10], (DEPTH, XATTN_HEAD_DIM)),
        "k_gain_x": gain(ks[11], (DEPTH, XATTN_HEAD_DIM)),
        "w_br_attn": nrm(ks[12], (DEPTH, ATTN_WIDTH, D), ATTN_WIDTH ** -0.5),
        "w_br_conv": nrm(ks[13], (DEPTH, CONV_WIDTH, D), CONV_WIDTH ** -0.5),
        "w_br_x": nrm(ks[14], (DEPTH, XATTN_WIDTH, D), XATTN_WIDTH ** -0.5),
        "w_out": nrm(ks[15], (DEPTH, D, D), D ** -0.5),
        "g_ffn": gain(ks[16], (DEPTH, D)),
        "peer_w_query": nrm(ks[17], (DEPTH, D, PEER_HEADS * 2 * PEER_DHALF), D ** -0.5),
        "peer_sub_keys": nrm(ks[18], (DEPTH, PEER_HEADS, 2, PEER_NKEYS, PEER_DHALF), PEER_DHALF ** -0.5),
        "peer_u": nrm(ks[19], (DEPTH, PEER_EXPERTS, D), D ** -0.5),
        "peer_v": nrm(ks[20], (DEPTH, PEER_EXPERTS, D), 0.5),
    }


def reference(x, mem, g_mix, w_in, q_gain_a, k_gain_a, rel_bias, conv_w, g_mem, w_mem_kv,
              q_gain_x, k_gain_x, w_br_attn, w_br_conv, w_br_x, w_out, g_ffn,
              peer_w_query, peer_sub_keys, peer_u, peer_v):
    B, S, D = x.shape
    h = x
    for l in range(DEPTH):
        hn = rms_norm(h, g_mix[l])
        proj = hn @ w_in[l]
        q_a, k_a, v_a, u_c, b_c, c_c, q_x, gates = jnp.split(proj, PROJ_OFFSETS, axis=-1)

        qa = rms_norm(split_heads(q_a, ATTN_HEADS), q_gain_a[l])
        ka = rms_norm(split_heads(k_a, ATTN_HEADS), k_gain_a[l])
        va = split_heads(v_a, ATTN_HEADS)
        y_a = merge_heads(moba_attention(qa, ka, va, rel_bias)) @ w_br_attn[l]

        y_c = (b_c * short_conv(c_c * u_c, conv_w[l])) @ w_br_conv[l]

        kv_m = rms_norm(mem, g_mem[l]) @ w_mem_kv[l]
        k_m, v_m = jnp.split(kv_m, 2, axis=-1)
        qx = rms_norm(split_heads(q_x, XATTN_HEADS), q_gain_x[l])
        kx = rms_norm(split_heads(k_m, XATTN_HEADS), k_gain_x[l])
        vx = split_heads(v_m, XATTN_HEADS)
        y_x = merge_heads(cross_attention(qx, kx, vx)) @ w_br_x[l]

        g = jax.nn.sigmoid(gates.reshape(B, S, N_BRANCH, D))
        merged = g[:, :, 0] * y_a + g[:, :, 1] * y_c + g[:, :, 2] * y_x
        h = h + merged @ w_out[l]

        h = h + peer(rms_norm(h, g_ffn[l]), peer_w_query[l], peer_sub_keys[l], peer_u[l], peer_v[l])
    return h
```

```cpp
#include <hip/hip_runtime.h>
#include <hip/hip_bf16.h>
#include <cstdio>
#include <cstdint>
#include <cmath>
namespace pg8 {
#define PG8_LAS __attribute__((address_space(3)))
typedef unsigned short bf16_t;
typedef short bf16x8 __attribute__((ext_vector_type(8)));
typedef float f32x4 __attribute__((ext_vector_type(4)));
typedef unsigned u32x4 __attribute__((ext_vector_type(4)));
constexpr int BM = 256, BK = 64, HALF = 128, HTB = HALF * BK * 2  , STAGE_BYTES = 8 * HTB, NXCD = 8, WGM = 8;

__host__ __device__ __forceinline__ int lds_byte(int r, int c) { const int st = (r >> 4) * 2 + (c >> 5), rr = r & 15, cc = c & 31, ob = rr * 64 + cc * 2; return st * 1024 + (ob ^ (((ob >> 9) & 1) << 5)); }
__host__ __device__ __forceinline__ void stage_rc(int b, int& R, int& C) { const int st = b / 1024, sb = b % 1024, swz = sb ^ (((sb >> 9) & 1) << 5); R = (st >> 1) * 16 + swz / 64; C = (st & 1) * 32 + (swz % 64) / 2; }
__host__ __device__ __forceinline__ int perm32(int rho) { const int n = rho >> 4, i = rho & 15; return 8 * (i >> 2) + 4 * n + (i & 3); }

struct Unit { int pm, pn; };
struct Gemm { const bf16_t* A; const bf16_t* Bt; int M, N, K; };

struct StaticOrder {
    int nM, nN, nwg, G, c;
    __host__ __device__ void init(int M, int N, int G_, int c_) { nM = M / BM; nN = N / BM; nwg = nM * nN; G = G_; c = c_; }
    __host__ __device__ bool next(int i, Unit& u) const {
        const long L = (long)i * G + c; if (L >= nwg) return false;
        int wgid = (int)L; { const int q = nwg / NXCD, r = nwg % NXCD, xcd = wgid % NXCD, off = wgid / NXCD; wgid = (xcd < r ? xcd * (q + 1) : r * (q + 1) + (xcd - r) * q) + off; }
        const int nig = WGM * nN, gid = wgid / nig, fm = gid * WGM, gsz = (nM - fm) < WGM ? (nM - fm) : WGM;
        u.pm = fm + ((wgid % nig) % gsz); u.pn = (wgid % nig) / gsz; return true;
    }
    __device__ __forceinline__ void a_ready(const Unit&) const {}
    __device__ __forceinline__ void done(const Unit&) const {}
};

__device__ __forceinline__ unsigned cvt_pk_bf16(float lo, float hi) { unsigned r; asm volatile("v_cvt_pk_bf16_f32 %0, %1, %2" : "=v"(r) : "v"(lo), "v"(hi)); return r; }
typedef float f32x2 __attribute__((ext_vector_type(2)));
__device__ __forceinline__ f32x2 gelu_pk(f32x2 v) {
    const f32x2 av = __builtin_elementwise_abs(v), d = av * 0.2316418882f + 1.0f;
    f32x2 t; t.x = __builtin_amdgcn_rcpf(d.x); t.y = __builtin_amdgcn_rcpf(d.y);
    f32x2 q = t * 0.5307027145f + (-0.7265760135f); q = q * t + 0.7107068705f; q = q * t + (-0.142248368f); q = q * t + 0.127414796f; q = q * t;
    const f32x2 s = (v * v) * (-0.72134752044f);
    f32x2 e; e.x = __builtin_amdgcn_exp2f(s.x); e.y = __builtin_amdgcn_exp2f(s.y);
    const f32x2 m = v * (q * e), r = v - m;
    f32x2 o; o.x = v.x < 0.f ? m.x : r.x; o.y = v.y < 0.f ? m.y : r.y; return o;
}

template <int ACT  > struct EpiBf16 {
    static constexpr bool PERM = true, AFTER_DRAIN = false; static_assert(ACT == 0 || ACT == 1, "EpiBf16: ACT is 0 (none) or 1 (gelu_pk)");
    bf16_t* O; int ldc; const float* bias; int split_cols; size_t split_stride; float scale0;
    __device__ __forceinline__ void operator()(const f32x4 (&acc)[2][2][4][2], const Unit& u, int wr, int wc, int fr, int fq) const {
        const int row0 = u.pm * BM + wr * 64 + fr; int colt = u.pn * BM; bf16_t* base = O;
        float sc = 1.f; if (split_cols) { const int t = colt / split_cols; base += (size_t)t * split_stride; colt -= t * split_cols; if (t == 0) sc = scale0; }
        const int col0 = colt + wc * 32 + 8 * fq, bcol0 = u.pn * BM + wc * 32 + 8 * fq;
        f32x4 bv[2][2];
#pragma unroll
        for (int bj = 0; bj < 2; ++bj)
#pragma unroll
            for (int n = 0; n < 2; ++n) bv[bj][n] = bias ? *(const f32x4*)(bias + bcol0 + bj * HALF + 4 * n) : (f32x4){0.f, 0.f, 0.f, 0.f};
#pragma unroll
        for (int ai = 0; ai < 2; ++ai)
#pragma unroll
            for (int m = 0; m < 4; ++m) { bf16_t* rowp = base + (size_t)(row0 + ai * HALF + m * 16) * ldc + col0;
#pragma unroll
                for (int bj = 0; bj < 2; ++bj) { f32x4 v0 = acc[ai][bj][m][0] + bv[bj][0], v1 = acc[ai][bj][m][1] + bv[bj][1];
                    if (ACT == 1) { f32x2 a = gelu_pk((f32x2){v0[0], v0[1]}), b = gelu_pk((f32x2){v0[2], v0[3]}), c = gelu_pk((f32x2){v1[0], v1[1]}), d = gelu_pk((f32x2){v1[2], v1[3]});
                        v0 = (f32x4){a.x, a.y, b.x, b.y}; v1 = (f32x4){c.x, c.y, d.x, d.y}; }
                    v0 = v0 * sc; v1 = v1 * sc; u32x4 w; w.x = cvt_pk_bf16(v0[0], v0[1]); w.y = cvt_pk_bf16(v0[2], v0[3]); w.z = cvt_pk_bf16(v1[0], v1[1]); w.w = cvt_pk_bf16(v1[2], v1[3]);
                    *(u32x4*)(rowp + bj * HALF) = w; } }
    }
};


struct GOrder {
    int nM, nN, nwg, G, c;
    __host__ __device__ void init(int M, int N, int G_, int c_) { nM = M / BM; nN = N / BM; nwg = nM * nN; G = G_; c = c_; }
    __host__ __device__ bool next(int i, Unit& u) const {
        if (c < 0) return false;
        const long L = (long)i * G + c; if (L >= nwg) return false;
        int wgid = (int)L; { const int q = nwg / NXCD, r = nwg % NXCD, xcd = wgid % NXCD, off = wgid / NXCD; wgid = (xcd < r ? xcd * (q + 1) : r * (q + 1) + (xcd - r) * q) + off; }
        const int nig = WGM * nN, gid = wgid / nig, fm = gid * WGM, gsz = (nM - fm) < WGM ? (nM - fm) : WGM;
        u.pm = fm + ((wgid % nig) % gsz); u.pn = (wgid % nig) / gsz; return true;
    }
    __device__ __forceinline__ void a_ready(const Unit&) const {}
    __device__ __forceinline__ void done(const Unit&) const {}
};
struct BranchOrder {
    GOrder g;
    __device__ void init(int G, int c) { g.init(16384, 1024, G, c); }
    __device__ bool next(int i, Unit& u) const { Unit t; if (!g.next(i / 3, t)) return false; const int br = i % 3; u.pm = 64 * br + t.pm; u.pn = 4 * br + t.pn; return true; }
    __device__ __forceinline__ void a_ready(const Unit&) const {}
    __device__ __forceinline__ void done(const Unit&) const {}
};
__device__ __forceinline__ float bf_lo(unsigned w) { return __builtin_bit_cast(float, w << 16); }
__device__ __forceinline__ float bf_hi(unsigned w) { return __builtin_bit_cast(float, w & 0xffff0000u); }
__device__ __forceinline__ float sigmoid_f(float x) { return __builtin_amdgcn_rcpf(1.0f + __builtin_amdgcn_exp2f(-1.4426950408889634f * x)); }
struct EpiProj {
    static constexpr bool PERM = true, AFTER_DRAIN = false;
    bf16_t* PA; bf16_t* PG;
    __device__ __forceinline__ void operator()(const f32x4 (&acc)[2][2][4][2], const Unit& u, int wr, int wc, int fr, int fq) const {
        const bool gate = u.pn >= 14;
        bf16_t* base = gate ? PG : PA; const int ldc = gate ? 3072 : 3584; const int colt = gate ? (u.pn - 14) * BM : u.pn * BM;
        const int row0 = u.pm * BM + wr * 64 + fr, col0 = colt + wc * 32 + 8 * fq;
#pragma unroll
        for (int ai = 0; ai < 2; ++ai)
#pragma unroll
            for (int m = 0; m < 4; ++m) { bf16_t* rowp = base + (size_t)(row0 + ai * HALF + m * 16) * ldc + col0;
#pragma unroll
                for (int bj = 0; bj < 2; ++bj) { f32x4 v0 = acc[ai][bj][m][0], v1 = acc[ai][bj][m][1];
                    if (gate) {
#pragma unroll
                        for (int e = 0; e < 4; ++e) { v0[e] = sigmoid_f(v0[e]); v1[e] = sigmoid_f(v1[e]); } }
                    u32x4 w; w.x = cvt_pk_bf16(v0[0], v0[1]); w.y = cvt_pk_bf16(v0[2], v0[3]); w.z = cvt_pk_bf16(v1[0], v1[1]); w.w = cvt_pk_bf16(v1[2], v1[3]);
                    *(u32x4*)(rowp + bj * HALF) = w; } }
    }
};
struct EpiBranch {
    static constexpr bool PERM = true, AFTER_DRAIN = false;
    const bf16_t* PG; bf16_t* MG;
    __device__ __forceinline__ void operator()(const f32x4 (&acc)[2][2][4][2], const Unit& u, int wr, int wc, int fr, int fq) const {
        const int br = u.pm >> 6, tm = u.pm & 63, tn = u.pn & 3;
        const int row0 = tm * BM + wr * 64 + fr, col0 = tn * BM + wc * 32 + 8 * fq;
#pragma unroll
        for (int ai = 0; ai < 2; ++ai)
#pragma unroll
            for (int m = 0; m < 4; ++m) { const size_t row = (size_t)(row0 + ai * HALF + m * 16);
#pragma unroll
                for (int bj = 0; bj < 2; ++bj) { const int col = col0 + bj * HALF;
                    const u32x4 g = *(const u32x4*)(PG + row * 3072 + br * 1024 + col);
                    f32x4 v0 = acc[ai][bj][m][0], v1 = acc[ai][bj][m][1];
                    v0[0] *= bf_lo(g.x); v0[1] *= bf_hi(g.x); v0[2] *= bf_lo(g.y); v0[3] *= bf_hi(g.y);
                    v1[0] *= bf_lo(g.z); v1[1] *= bf_hi(g.z); v1[2] *= bf_lo(g.w); v1[3] *= bf_hi(g.w);
                    bf16_t* mp = MG + row * 1024 + col;
                    if (br > 0) { const u32x4 p = *(const u32x4*)mp;
                        v0[0] += bf_lo(p.x); v0[1] += bf_hi(p.x); v0[2] += bf_lo(p.y); v0[3] += bf_hi(p.y);
                        v1[0] += bf_lo(p.z); v1[1] += bf_hi(p.z); v1[2] += bf_lo(p.w); v1[3] += bf_hi(p.w); }
                    u32x4 w; w.x = cvt_pk_bf16(v0[0], v0[1]); w.y = cvt_pk_bf16(v0[2], v0[3]); w.z = cvt_pk_bf16(v1[0], v1[1]); w.w = cvt_pk_bf16(v1[2], v1[3]);
                    *(u32x4*)mp = w; } }
    }
};
struct EpiWout {
    static constexpr bool PERM = false, AFTER_DRAIN = false;
    const float* X; float* H; bf16_t* HB; float* SL;
    __device__ __forceinline__ void operator()(const f32x4 (&acc)[2][2][4][2], const Unit& u, int wr, int wc, int fr, int fq) const {
        const int row0 = u.pm * BM + wr * 64 + fr, col0 = u.pn * BM + wc * 32 + 4 * fq;
#pragma unroll
        for (int ai = 0; ai < 2; ++ai)
#pragma unroll
            for (int m = 0; m < 4; ++m) { const size_t row = (size_t)(row0 + ai * HALF + m * 16); float ss = 0.f;
#pragma unroll
                for (int bj = 0; bj < 2; ++bj)
#pragma unroll
                    for (int n = 0; n < 2; ++n) { const size_t off = row * 1024 + col0 + bj * HALF + n * 16;
                        const f32x4 xv = *(const f32x4*)(X + off); const f32x4 hv = xv + acc[ai][bj][m][n];
                        *(f32x4*)(H + off) = hv; ss += (hv[0] * hv[0] + hv[1] * hv[1]) + (hv[2] * hv[2] + hv[3] * hv[3]);
                        typedef unsigned u32x2v __attribute__((ext_vector_type(2))); u32x2v w; w.x = cvt_pk_bf16(hv[0], hv[1]); w.y = cvt_pk_bf16(hv[2], hv[3]);
                        *(u32x2v*)(HB + off) = w; }
                ss += __shfl_xor(ss, 16); ss += __shfl_xor(ss, 32);
                if (fq == 0) SL[row * 16 + u.pn * 4 + wc] = ss; }
    }
};
template <class Epi, class Sched, bool ALIGN_EPI = false, bool SP2 = false>
__device__ __forceinline__ void gemm_phase(PG8_LAS unsigned char* lds, const Gemm g, const Sched& S, const Epi& E) {
    const int tid = threadIdx.x, wid = __builtin_amdgcn_readfirstlane(tid >> 6), lane = tid & 63, wr = wid >> 2, wc = wid & 3, fr = lane & 15, fq = lane >> 4;
    const int K = g.K, nt = K / BK;
    unsigned voffA[2], voffB[2];
#pragma unroll
    for (int i = 0; i < 2; ++i) { int R, C; stage_rc(tid * 16 + i * 8192, R, C); const int Rb = Epi::PERM ? ((R & ~31) + perm32(R & 31)) : R;
        voffA[i] = (unsigned)(R * K + C) * 2u; voffB[i] = (unsigned)(Rb * K + C) * 2u; }
    const size_t kstep = (size_t)(BK * 2);
    const size_t hstep = (size_t)HALF * K * 2;
    const size_t tstep = 2 * hstep;
    const unsigned ldsw = (unsigned)wid * 1024u;
    const int aoff = lds_byte(wr * 64 + fr, fq * 8), boff = lds_byte(wc * 32 + fr, fq * 8);
#define PG8_SA(b, h) (((b) * 2 + (h)) * HTB)
#define PG8_SB(b, h) ((4 + (b) * 2 + (h)) * HTB)
#define PG8_STAGE(bufoff, gbase, voff) do { _Pragma("unroll") for (int _i = 0; _i < 2; ++_i) \
        __builtin_amdgcn_global_load_lds((const unsigned*)((const char*)(gbase) + (voff)[_i]), (PG8_LAS unsigned*)(lds + (bufoff) + ldsw + _i * 8192), 16, 0, 0); } while (0)
#define PG8_LDA(dst, b, h) do { _Pragma("unroll") for (int m = 0; m < 4; ++m) _Pragma("unroll") for (int k = 0; k < 2; ++k) dst[m][k] = *(const PG8_LAS bf16x8*)(lds + PG8_SA(b, h) + aoff + m * 2048 + k * 1024); } while (0)
#define PG8_LDB(dst, b, h) do { _Pragma("unroll") for (int n = 0; n < 2; ++n) _Pragma("unroll") for (int k = 0; k < 2; ++k) dst[n][k] = *(const PG8_LAS bf16x8*)(lds + PG8_SB(b, h) + boff + n * 2048 + k * 1024); } while (0)
#define PG8_MMA(ai, bj, At, Bt) do { __builtin_amdgcn_s_setprio(1); _Pragma("unroll") for (int m = 0; m < 4; ++m) _Pragma("unroll") for (int n = 0; n < 2; ++n) _Pragma("unroll") for (int k = 0; k < 2; ++k) \
        acc[ai][bj][m][n] = __builtin_amdgcn_mfma_f32_16x16x32_bf16(Bt[n][k], At[m][k], acc[ai][bj][m][n], 0, 0, 0); __builtin_amdgcn_s_setprio(0); } while (0)
#define PG8_WAIT_V(n) asm volatile("s_waitcnt vmcnt(" #n ")" ::: "memory")
#define PG8_WAIT_L(n) asm volatile("s_waitcnt lgkmcnt(" #n ")" ::: "memory")
#define PG8_BAR __builtin_amdgcn_s_barrier()
#define PG8_SCHED __builtin_amdgcn_sched_barrier(0)
    Unit cur, nxt; int ui = 0;
    if (!S.next(0, cur)) return;
    f32x4 acc[2][2][4][2];
#pragma unroll
    for (int a = 0; a < 2; ++a)
#pragma unroll
        for (int b = 0; b < 2; ++b)
#pragma unroll
            for (int m = 0; m < 4; ++m)
#pragma unroll
                for (int n = 0; n < 2; ++n) acc[a][b][m][n] = (f32x4){0.f, 0.f, 0.f, 0.f};
    bf16x8 At[4][2], B0[2][2], B1[2][2];
    const char* cA = (const char*)g.A + (size_t)cur.pm * tstep; const char* cB = (const char*)g.Bt + (size_t)cur.pn * tstep;
    S.a_ready(cur);
    if constexpr (SP2) {
        PG8_STAGE(PG8_SB(0, 0), cB, voffB); PG8_STAGE(PG8_SB(0, 1), cB + hstep, voffB); PG8_STAGE(PG8_SA(0, 0), cA, voffA); PG8_STAGE(PG8_SA(0, 1), cA + hstep, voffA);
        if (wr == 1) PG8_BAR;
        PG8_WAIT_V(2); PG8_BAR;
        PG8_STAGE(PG8_SB(1, 0), cB + kstep, voffB); PG8_STAGE(PG8_SA(1, 0), cA + kstep, voffA); PG8_STAGE(PG8_SB(1, 1), cB + hstep + kstep, voffB);
        PG8_WAIT_V(6); PG8_BAR;
    } else {
        PG8_STAGE(PG8_SB(0, 0), cB, voffB); PG8_STAGE(PG8_SA(0, 0), cA, voffA); PG8_STAGE(PG8_SB(0, 1), cB + hstep, voffB); PG8_STAGE(PG8_SA(0, 1), cA + hstep, voffA);
        if (wr == 1) PG8_BAR;
        PG8_WAIT_V(4); PG8_BAR;
        PG8_STAGE(PG8_SB(1, 0), cB + kstep, voffB); PG8_STAGE(PG8_SA(1, 0), cA + kstep, voffA); PG8_STAGE(PG8_SB(1, 1), cB + hstep + kstep, voffB);
        PG8_WAIT_V(6); PG8_BAR;
    }
    for (;;) {
        const bool has_next = S.next(ui + 1, nxt);
        const char* nA = has_next ? (const char*)g.A + (size_t)nxt.pm * tstep : cA; const char* nB = has_next ? (const char*)g.Bt + (size_t)nxt.pn * tstep : cB;
        for (int t = 0; t < nt; t += 2) {
            const bool last = (t == nt - 2);
            const char* a1 = cA + (size_t)(t + 1) * kstep;
            const char* a2 = last ? nA : cA + (size_t)(t + 2) * kstep; const char* b2 = last ? nB : cB + (size_t)(t + 2) * kstep;
            const char* a3 = a2 + kstep; const char* b3 = b2 + kstep;
            if (last && has_next) S.a_ready(nxt);
            if constexpr (SP2) {
            PG8_LDB(B0, 0, 0); PG8_LDB(B1, 0, 1); PG8_SCHED; PG8_LDA(At, 0, 0); PG8_STAGE(PG8_SA(1, 1), a1 + hstep, voffA);
            PG8_WAIT_V(8); PG8_WAIT_L(0); PG8_BAR; PG8_MMA(0, 0, At, B0); PG8_MMA(0, 1, At, B1); PG8_BAR; PG8_SCHED;
            PG8_LDA(At, 0, 1); PG8_STAGE(PG8_SB(0, 0), b2, voffB); PG8_STAGE(PG8_SB(0, 1), b2 + hstep, voffB); PG8_STAGE(PG8_SA(0, 0), a2, voffA);
            PG8_WAIT_V(8); PG8_WAIT_L(0); PG8_BAR; PG8_MMA(1, 0, At, B0); PG8_MMA(1, 1, At, B1); PG8_BAR; PG8_SCHED;
            PG8_LDB(B0, 1, 0); PG8_LDB(B1, 1, 1); PG8_SCHED; PG8_LDA(At, 1, 0); PG8_STAGE(PG8_SA(0, 1), a2 + hstep, voffA);
            PG8_WAIT_V(8); PG8_WAIT_L(0); PG8_BAR; PG8_MMA(0, 0, At, B0); PG8_MMA(0, 1, At, B1); PG8_BAR; PG8_SCHED;
            PG8_LDA(At, 1, 1); PG8_STAGE(PG8_SB(1, 0), b3, voffB); PG8_STAGE(PG8_SB(1, 1), b3 + hstep, voffB); PG8_STAGE(PG8_SA(1, 0), a3, voffA);
            PG8_WAIT_V(8); PG8_WAIT_L(0); PG8_BAR; PG8_MMA(1, 0, At, B0); PG8_MMA(1, 1, At, B1); PG8_BAR; PG8_SCHED;
            } else {
            PG8_LDB(B0, 0, 0); PG8_SCHED; PG8_LDA(At, 0, 0); PG8_STAGE(PG8_SA(1, 1), a1 + hstep, voffA);
            PG8_WAIT_L(8); PG8_BAR; PG8_WAIT_L(0); PG8_MMA(0, 0, At, B0); PG8_BAR; PG8_SCHED;
            PG8_LDB(B1, 0, 1); PG8_STAGE(PG8_SB(0, 0), b2, voffB);
            PG8_BAR; PG8_WAIT_L(0); PG8_MMA(0, 1, At, B1); PG8_BAR;
            PG8_LDA(At, 0, 1); PG8_STAGE(PG8_SA(0, 0), a2, voffA);
            PG8_BAR; PG8_WAIT_L(0); PG8_MMA(1, 0, At, B0); PG8_BAR; PG8_SCHED;
            PG8_STAGE(PG8_SB(0, 1), b2 + hstep, voffB);
            PG8_WAIT_V(6); PG8_BAR; PG8_MMA(1, 1, At, B1); PG8_BAR;
            PG8_LDB(B0, 1, 0); PG8_SCHED; PG8_LDA(At, 1, 0); PG8_STAGE(PG8_SA(0, 1), a2 + hstep, voffA);
            PG8_WAIT_L(8); PG8_BAR; PG8_WAIT_L(0); PG8_MMA(0, 0, At, B0); PG8_BAR; PG8_SCHED;
            PG8_LDB(B1, 1, 1); PG8_STAGE(PG8_SB(1, 0), b3, voffB);
            PG8_BAR; PG8_WAIT_L(0); PG8_MMA(0, 1, At, B1); PG8_BAR;
            PG8_LDA(At, 1, 1); PG8_STAGE(PG8_SA(1, 0), a3, voffA);
            PG8_BAR; PG8_WAIT_L(0); PG8_MMA(1, 0, At, B0); PG8_BAR; PG8_SCHED;
            PG8_STAGE(PG8_SB(1, 1), b3 + hstep, voffB);
            PG8_WAIT_V(6); PG8_BAR; PG8_MMA(1, 1, At, B1); PG8_BAR;
            }
        }
        if constexpr (ALIGN_EPI) { if (wr == 0) PG8_BAR; }
        if constexpr (!Epi::AFTER_DRAIN) { E(acc, cur, wr, wc, fr, fq); S.done(cur); }
        if (!has_next) break;
#pragma unroll
        for (int a = 0; a < 2; ++a)
#pragma unroll
            for (int b = 0; b < 2; ++b)
#pragma unroll
                for (int m = 0; m < 4; ++m)
#pragma unroll
                    for (int n = 0; n < 2; ++n) acc[a][b][m][n] = (f32x4){0.f, 0.f, 0.f, 0.f};
        cur = nxt; cA = nA; cB = nB; ++ui;
        if constexpr (ALIGN_EPI) { if (wr == 1) PG8_BAR; }
    }
    PG8_WAIT_V(0);
    if constexpr (!ALIGN_EPI) { if (wr == 0) PG8_BAR; }
    PG8_BAR;
    if constexpr (Epi::AFTER_DRAIN) { E.fused(acc, cur, wr, wc, fr, fq, lds, wid, lane); S.done(cur); }
#undef PG8_SA
#undef PG8_SB
#undef PG8_STAGE
#undef PG8_LDA
#undef PG8_LDB
#undef PG8_MMA
#undef PG8_WAIT_V
#undef PG8_WAIT_L
#undef PG8_BAR
#undef PG8_SCHED
}
}

constexpr int NWAVES = 8;
constexpr int T = 16384, DM = 1024, SEQ = 2048, NBATCH = 8, MEMLEN = 256;
constexpr int PW = 6656, PAW = 3584, PGW = 3072;
constexpr int COL_QA = 0, COL_KA = 512, COL_VA = 1024, COL_UC = 1536, COL_BC = 2048, COL_CC = 2560, COL_QX = 3072;
constexpr float RMS_EPS = 1e-6f, LOG2E = 1.4426950408889634f;
constexpr float C2A = 0.125f * LOG2E;
constexpr float C2X = 0.08838834764831845f * LOG2E;
constexpr int NEXP = 16384;

constexpr size_t MiB = 1u << 20;
constexpr size_t WS_CTL = 0, CTL_ZERO_BYTES = 1 * MiB;
constexpr size_t WS_WIN = 1 * MiB;
constexpr size_t WS_WKV = 14 * MiB;
constexpr size_t WS_WBR = 16 * MiB;
constexpr size_t WS_WOUT = 19 * MiB;
constexpr size_t WS_WQ = 21 * MiB;
constexpr size_t WS_SK = 25 * MiB;
constexpr size_t WS_TAB = 25 * MiB + 512 * 1024;
constexpr size_t WS_KMEAN = WS_TAB + 64 * 1024;
constexpr size_t WS_MEMN = 26 * MiB;
constexpr size_t WS_KVM = 30 * MiB;
constexpr size_t WS_SLOTS = 34 * MiB;
constexpr size_t WS_SEL = 35 * MiB;
constexpr size_t WS_PA = 44 * MiB;
constexpr size_t WS_PG = 156 * MiB;
constexpr size_t WS_END = 252 * MiB;
constexpr size_t PA_MERGED = WS_PA, PA_HB = WS_PA + 32 * MiB, PA_UT = WS_PA + 64 * MiB, PA_VT = WS_PA;
constexpr size_t PG_QRY = WS_PG;
constexpr int CW_BAR = 4096;

constexpr int RING_OFF = 0, RING_BYTES = 131072;
constexpr int LDSCTL_OFF = RING_BYTES, MISC_OFF = LDSCTL_OFF + 320;
constexpr int LDS_BYTES = 147456;

#define GAS __attribute__((address_space(1)))
#define LAS __attribute__((address_space(3)))
typedef unsigned short bf16;
typedef unsigned v4u __attribute__((ext_vector_type(4)));
typedef unsigned v2u __attribute__((ext_vector_type(2)));
typedef float f32x4 __attribute__((ext_vector_type(4)));
typedef float f32x16 __attribute__((ext_vector_type(16)));
typedef short bf16x8 __attribute__((ext_vector_type(8)));
typedef short s16x4 __attribute__((ext_vector_type(4)));
typedef GAS unsigned gu32;
#define RLX_AGENT __ATOMIC_RELAXED, __HIP_MEMORY_SCOPE_AGENT
#define LDS_WAIT() asm volatile("s_waitcnt lgkmcnt(0)" ::: "memory")
#define VM_WAIT() asm volatile("s_waitcnt vmcnt(0)" ::: "memory")
__device__ __forceinline__ unsigned f2bf(float f) { unsigned u = __builtin_bit_cast(unsigned, f); return (u + 0x7fffu + ((u >> 16) & 1u)) >> 16; }
__device__ __forceinline__ unsigned pk2(float lo, float hi) { return f2bf(lo) | (f2bf(hi) << 16); }
__device__ __forceinline__ float bflo(unsigned w) { return __builtin_bit_cast(float, w << 16); }
__device__ __forceinline__ float bfhi(unsigned w) { return __builtin_bit_cast(float, w & 0xffff0000u); }
__device__ __forceinline__ float wave_sum(float v) {
#pragma unroll
    for (int o = 1; o < 64; o <<= 1) v += __shfl_xor(v, o);
    return v;
}
#define XB_TMO      128
#define XB_XCNT(j)  (256  + 64 * (j))
#define XB_XSUB(j)  (1280 + 64 * (j))
#define XB_XGEN(j)  (2304 + 64 * (j))
#define XB_TOP      3328
#define XB_TOPGEN   3392
#define XCD_BAR_WORDS 3456
#define XB_SPIN_CAP (1u << 18)

__device__ __forceinline__ unsigned xb_ld(unsigned* p)              { return __hip_atomic_load(p, __ATOMIC_RELAXED, __HIP_MEMORY_SCOPE_AGENT); }
__device__ __forceinline__ unsigned xb_add(unsigned* p, unsigned v) { return __hip_atomic_fetch_add(p, v, __ATOMIC_RELAXED, __HIP_MEMORY_SCOPE_AGENT); }
__device__ __forceinline__ unsigned xb_xcc_id() { return (unsigned)__builtin_amdgcn_s_getreg((3 << 11) | 20) & 0xFu; }
#define XB_SPIN(cond, bar) do { unsigned _sp = 0; while (cond) { __builtin_amdgcn_s_sleep(1); \
    if ((++_sp & 255u) == 0u) { if (xb_ld(&(bar)[XB_TMO])) break; if (_sp > XB_SPIN_CAP) { atomicAdd(&(bar)[XB_TMO], 1u); break; } } } } while (0)

struct XcdBarrier {
    unsigned* bar; unsigned x;
    volatile LAS unsigned* st;
};

__device__ __forceinline__ XcdBarrier xcd_barrier_post(unsigned* bar, volatile LAS unsigned* st) {
    XcdBarrier b; b.bar = bar; b.x = xb_xcc_id(); b.st = st;
    if (threadIdx.x == 0) (void)xb_add(&bar[XB_XCNT(b.x)], 1u);
    return b;
}
__device__ __forceinline__ void xcd_barrier_complete(unsigned* bar, unsigned x, unsigned& nloc, unsigned& nx) {
    const unsigned G = gridDim.x * gridDim.y * gridDim.z;
    unsigned sum, cnt, mine, sp = 0u;
    for (;;) {
        sum = 0u; cnt = 0u; mine = 0u;
#pragma unroll
        for (unsigned j = 0; j < 16; ++j) { const unsigned c = xb_ld(&bar[XB_XCNT(j)]); sum += c; cnt += (c > 0u) ? 1u : 0u; mine = (j == x) ? c : mine; }
        if (sum == G) break;
        __builtin_amdgcn_s_sleep(1);
        if ((++sp & 255u) == 0u) { if (xb_ld(&bar[XB_TMO])) break; if (sp > XB_SPIN_CAP) { atomicAdd(&bar[XB_TMO], 1u); break; } }
    }
    nloc = mine > 0u ? mine : 1u; nx = cnt > 0u ? cnt : 1u;
}

__device__ __forceinline__ void xcd_barrier(const XcdBarrier& b) {
    asm volatile("s_waitcnt vmcnt(0)" ::: "memory");
    __syncthreads();
    if (threadIdx.x == 0) {
        unsigned* bar = b.bar;
        __builtin_amdgcn_s_waitcnt(0);
        unsigned nloc = b.st[0], nx = b.st[1];
        if (nloc == 0u) { xcd_barrier_complete(bar, b.x, nloc, nx); b.st[0] = nloc; b.st[1] = nx; }
        const unsigned old = xb_add(&bar[XB_XSUB(b.x)], 1u);
        const unsigned gen = old / nloc;
        if (old + 1u == (gen + 1u) * nloc) {
            __builtin_amdgcn_fence(__ATOMIC_RELEASE, "agent");
            asm volatile("s_waitcnt vmcnt(0)" ::: "memory");
            const unsigned og = xb_add(&bar[XB_TOP], 1u);
            const unsigned tg = og / nx;
            if (og + 1u == (tg + 1u) * nx) xb_add(&bar[XB_TOPGEN], 1u);
            else XB_SPIN(xb_ld(&bar[XB_TOPGEN]) == tg, bar);
            __builtin_amdgcn_fence(__ATOMIC_ACQUIRE, "agent");
            xb_add(&bar[XB_XGEN(b.x)], 1u);
            asm volatile("s_waitcnt vmcnt(0)" ::: "memory");
        } else {
            XB_SPIN(xb_ld(&bar[XB_XGEN(b.x)]) == gen, bar);
            __builtin_amdgcn_fence(__ATOMIC_ACQUIRE, "agent");
            asm volatile("s_waitcnt vmcnt(0)" ::: "memory");
        }
    }
    __syncthreads();
}

__device__ __forceinline__ void p0_transpose_item(const float* W, int K, int N, bf16* WT, int row_off, const float* ksc, LAS float* scr, int item, int lane) {
    const int nblk = N / 32, kb = item / nblk, nb = item % nblk, k0 = 64 * kb, n0 = 32 * nb;
#pragma unroll 8
    for (int i = 0; i < 32; ++i) { const int kk = 2 * i + (lane >> 5); float v = W[(size_t)(k0 + kk) * N + n0 + (lane & 31)]; if (ksc) v *= ksc[k0 + kk]; scr[kk * 33 + (lane & 31)] = v; }
    LDS_WAIT(); asm volatile("" ::: "memory");
    const int c = lane & 7;
#pragma unroll
    for (int j = 0; j < 4; ++j) { const int n = (lane >> 3) + 8 * j; const LAS float* s = scr + (8 * c) * 33 + n;
        v4u o; o.x = pk2(s[0 * 33], s[1 * 33]); o.y = pk2(s[2 * 33], s[3 * 33]); o.z = pk2(s[4 * 33], s[5 * 33]); o.w = pk2(s[6 * 33], s[7 * 33]);
        *(GAS v4u*)(WT + (size_t)(row_off + n0 + n) * K + k0 + 8 * c) = o; }
    LDS_WAIT(); asm volatile("" ::: "memory");
}
__device__ __forceinline__ void rms_row_to_bf16(const float* xrow, const float* g, bf16* orow, int lane) {
    const GAS f32x4* xr = (const GAS f32x4*)xrow + lane; const GAS f32x4* gr = (const GAS f32x4*)g + lane;
    f32x4 v[4]; float s = 0.f;
#pragma unroll
    for (int j = 0; j < 4; ++j) { v[j] = xr[64 * j]; s += (v[j].x * v[j].x + v[j].y * v[j].y) + (v[j].z * v[j].z + v[j].w * v[j].w); }
    const float r = 1.f / sqrtf(wave_sum(s) * (1.f / 1024.f) + RMS_EPS);
    GAS unsigned long long* o8 = (GAS unsigned long long*)orow + lane;
#pragma unroll
    for (int j = 0; j < 4; ++j) { const f32x4 gv = gr[64 * j];
        o8[64 * j] = (unsigned long long)pk2(v[j].x * r * gv.x, v[j].y * r * gv.y) | ((unsigned long long)pk2(v[j].z * r * gv.z, v[j].w * r * gv.w) << 32); }
}
__device__ __forceinline__ void cvt_row_to_bf16(const float* xrow, bf16* orow, int lane) {
    const GAS f32x4* xr = (const GAS f32x4*)xrow + lane; GAS unsigned long long* o8 = (GAS unsigned long long*)orow + lane;
    f32x4 v[4];
#pragma unroll
    for (int j = 0; j < 4; ++j) v[j] = xr[64 * j];
#pragma unroll
    for (int j = 0; j < 4; ++j) o8[64 * j] = (unsigned long long)pk2(v[j].x, v[j].y) | ((unsigned long long)pk2(v[j].z, v[j].w) << 32);
}
__device__ __forceinline__ int rel_bucket_dev(int d) {
    if (d < 16) return d;
    int b = 16;
    b += (d >= 21); b += (d >= 27); b += (d >= 35); b += (d >= 46); b += (d >= 59); b += (d >= 77); b += (d >= 99); b += (d >= 128);
    b += (d >= 166); b += (d >= 216); b += (d >= 280); b += (d >= 363); b += (d >= 470); b += (d >= 609); b += (d >= 790);
    return b;
}
struct P0Args { const float *x, *mem, *g_mix, *w_in, *rel_bias, *g_mem, *w_mem_kv, *w_br_attn, *w_br_conv, *w_br_x, *w_out, *g_ffn, *w_query, *sub_keys;
                bf16 *WinT, *WkvT, *WbrT, *WoutT, *WqT, *SK, *HN, *MEMN; float* TAB; };
__device__ __forceinline__ void p0_prologue(const P0Args& a, LAS unsigned char* lds, int gw, int NGW, int wave, int lane) {
    LAS float* scr = (LAS float*)(lds + RING_OFF + wave * 16384);
    constexpr int I_IN = (DM / 64) * (PW / 32), I_KV = (DM / 64) * (1024 / 32), I_BR = (512 / 64) * (1024 / 32), I_OUT = (DM / 64) * (1024 / 32), I_Q = (DM / 64) * (2048 / 32);
    constexpr int NITEMS = I_IN + I_KV + 3 * I_BR + I_OUT + I_Q;
    for (int it = gw; it < NITEMS; it += NGW) {
        int r = it;
        if (r < I_IN) { p0_transpose_item(a.w_in, DM, PW, a.WinT, 0, nullptr, scr, r, lane); continue; } r -= I_IN;
        if (r < I_KV) { p0_transpose_item(a.w_mem_kv, DM, 1024, a.WkvT, 0, nullptr, scr, r, lane); continue; } r -= I_KV;
        if (r < I_BR) { p0_transpose_item(a.w_br_attn, 512, 1024, a.WbrT, 0, nullptr, scr, r, lane); continue; } r -= I_BR;
        if (r < I_BR) { p0_transpose_item(a.w_br_conv, 512, 1024, a.WbrT, 1024, nullptr, scr, r, lane); continue; } r -= I_BR;
        if (r < I_BR) { p0_transpose_item(a.w_br_x, 512, 1024, a.WbrT, 2048, nullptr, scr, r, lane); continue; } r -= I_BR;
        if (r < I_OUT) { p0_transpose_item(a.w_out, DM, 1024, a.WoutT, 0, nullptr, scr, r, lane); continue; } r -= I_OUT;
        p0_transpose_item(a.w_query, DM, 2048, a.WqT, 0, a.g_ffn, scr, r, lane);
    }
    for (int m = gw; m < T; m += NGW) rms_row_to_bf16(a.x + (size_t)m * DM, a.g_mix, a.HN + (size_t)m * DM, lane);
    for (int m = gw; m < NBATCH * MEMLEN; m += NGW) rms_row_to_bf16(a.mem + (size_t)m * DM, a.g_mem, a.MEMN + (size_t)m * DM, lane);
    for (int m = gw; m < 256; m += NGW) cvt_row_to_bf16(a.sub_keys + (size_t)m * 1024, a.SK + (size_t)m * 1024, lane);
    for (int m = gw; m < 256; m += NGW) {
        const int idx = m * 64 + lane, h = idx >> 11, d = idx & 2047;
        a.TAB[idx] = a.rel_bias[rel_bucket_dev(d) * 8 + h] * LOG2E;
    }
}

template <int DH> __device__ __forceinline__ void fix_item(bf16* buf, size_t pitch, int row0, int col0, const float* gain, float gscale, float* kmean, int lane) {
    constexpr int LPR = DH / 8, RPI = 64 / LPR;
    const int sub = lane / LPR, ch = lane % LPR;
    float g[8], cs[8];
#pragma unroll
    for (int j = 0; j < 8; ++j) { g[j] = gain[ch * 8 + j] * gscale; cs[j] = 0.f; }
    for (int it = 0; it < 256 / RPI; ++it) {
        GAS v4u* p = (GAS v4u*)(buf + (size_t)(row0 + it * RPI + sub) * pitch + col0 + ch * 8);
        const v4u w = *p;
        float x[8] = {bflo(w.x), bfhi(w.x), bflo(w.y), bfhi(w.y), bflo(w.z), bfhi(w.z), bflo(w.w), bfhi(w.w)};
        float ss = 0.f;
#pragma unroll
        for (int j = 0; j < 8; ++j) ss += x[j] * x[j];
#pragma unroll
        for (int o = 1; o < LPR; o <<= 1) ss += __shfl_xor(ss, o);
        const float r = 1.f / sqrtf(ss * (1.f / DH) + RMS_EPS);
#pragma unroll
        for (int j = 0; j < 8; ++j) { x[j] = x[j] * r * g[j]; cs[j] += x[j]; }
        v4u o; o.x = pk2(x[0], x[1]); o.y = pk2(x[2], x[3]); o.z = pk2(x[4], x[5]); o.w = pk2(x[6], x[7]);
        *p = o;
    }
    if (kmean) {
#pragma unroll
        for (int j = 0; j < 8; ++j) {
#pragma unroll
            for (int o = LPR; o < 64; o <<= 1) cs[j] += __shfl_xor(cs[j], o);
        }
        if (sub == 0) {
#pragma unroll
            for (int j = 0; j < 8; ++j) kmean[ch * 8 + j] = cs[j] * (1.f / 256.f);
        }
    }
}
__device__ __forceinline__ void p2_fixup(bf16* PA, bf16* KVM, float* KMEAN, const float* q_gain_a, const float* k_gain_a, const float* q_gain_x, const float* k_gain_x, int gw, int NGW, int lane) {
    constexpr int N_A = 512, N_X = 256, N_KX = 32, NIT = 2 * N_A + N_X + N_KX;
    for (int it = gw; it < NIT; it += NGW) {
        int r = it;
        if (r < N_A) { const int b = r >> 6, h = (r >> 3) & 7, n = r & 7;
            fix_item<64>(PA, PAW, b * SEQ + n * 256, COL_KA + h * 64, k_gain_a, 1.0f, KMEAN + (size_t)((b * 8 + h) * 8 + n) * 64, lane); continue; } r -= N_A;
        if (r < N_A) { const int b = r >> 6, h = (r >> 3) & 7, n = r & 7;
            fix_item<64>(PA, PAW, b * SEQ + n * 256, COL_QA + h * 64, q_gain_a, C2A, nullptr, lane); continue; } r -= N_A;
        if (r < N_X) { const int b = r >> 5, h = (r >> 3) & 3, n = r & 7;
            fix_item<128>(PA, PAW, b * SEQ + n * 256, COL_QX + h * 128, q_gain_x, C2X, nullptr, lane); continue; } r -= N_X;
        { const int b = r >> 2, h = r & 3;
            fix_item<128>(KVM, 1024, b * MEMLEN, h * 128, k_gain_x, 1.0f, nullptr, lane); }
    }
}

namespace att {
constexpr int L_K = 0, L_V = 16384, L_TAB = 32768, TAB_PAD = 256, L_KM = L_TAB + (TAB_PAD + 2048) * 4  , L_SEL = L_KM + 2048  , L_WSF = L_SEL + 1024  ,
              L_OST = L_WSF + NWAVES * 256  , L_END = L_OST + NWAVES * 8192  ;
static_assert(L_END <= RING_BYTES, "attention LDS map");
__device__ __forceinline__ int crow(int r, int hi) { return (r & 3) + 8 * (r >> 2) + 4 * hi; }
__device__ __forceinline__ void glds16(const void* gsrc, unsigned lds_dst) { unsigned keep;
    asm volatile("s_mov_b32 %0, m0\n\ts_mov_b32 m0, %2\n\ts_nop 0\n\tglobal_load_lds_dwordx4 %1, off\n\ts_mov_b32 m0, %0" : "=&s"(keep) : "v"(gsrc), "s"(lds_dst) : "memory"); }
__device__ __forceinline__ unsigned cvtpk(float lo, float hi) { typedef float f2 __attribute__((ext_vector_type(2))); typedef __bf16 b2 __attribute__((ext_vector_type(2))); f2 v = {lo, hi}; b2 b = __builtin_convertvector(v, b2); return __builtin_bit_cast(unsigned, b); }
__device__ __forceinline__ float rowmax(const f32x16& p0, const f32x16& p1) {
    float a = fmaxf(p0[0], p1[0]);
#pragma unroll
    for (int r = 1; r < 16; ++r) a = fmaxf(a, fmaxf(p0[r], p1[r]));
    auto rr = __builtin_amdgcn_permlane32_swap(__float_as_uint(a), __float_as_uint(a), false, false);
    return fmaxf(__uint_as_float(rr[0]), __uint_as_float(rr[1]));
}
template <int ND0> __device__ __forceinline__ void qkt(f32x16& p0, f32x16& p1, const LAS unsigned char* Kslot, const bf16x8* qr, int r32, int hi) {
    const LAS unsigned char* kb = Kslot + hi * 1024 + r32 * 16;
    p0 = f32x16{}; p1 = f32x16{};
#pragma unroll
    for (int d0 = 0; d0 < ND0; ++d0) {
        const bf16x8 b0 = *(const LAS bf16x8*)(kb + d0 * 2048);
        const bf16x8 b1 = *(const LAS bf16x8*)(kb + d0 * 2048 + 512);
        p0 = __builtin_amdgcn_mfma_f32_32x32x16_bf16(b0, qr[d0], p0, 0, 0, 0);
        p1 = __builtin_amdgcn_mfma_f32_32x32x16_bf16(b1, qr[d0], p1, 0, 0, 0);
    }
}
template <int NDB> __device__ __forceinline__ void pv(f32x16* o, int vb, bf16x8 pa0, bf16x8 pa1, bf16x8 pa2, bf16x8 pa3) {
#pragma unroll
    for (int d0 = 0; d0 < NDB; ++d0) { s16x4 lo[4], hi[4];
#pragma unroll
        for (int ks = 0; ks < 4; ++ks) {
            asm volatile("ds_read_b64_tr_b16 %0,%1 offset:%c2" : "=&v"(lo[ks]) : "v"(vb), "i"(d0 * 4096 + ks * 1024) : "memory");
            asm volatile("ds_read_b64_tr_b16 %0,%1 offset:%c2" : "=&v"(hi[ks]) : "v"(vb), "i"(d0 * 4096 + ks * 1024 + 512) : "memory"); }
        asm volatile("s_waitcnt lgkmcnt(0)" ::: "memory"); __builtin_amdgcn_sched_barrier(0);
#define ATT_PK(k) (bf16x8){lo[k][0], lo[k][1], lo[k][2], lo[k][3], hi[k][0], hi[k][1], hi[k][2], hi[k][3]}
        o[d0] = __builtin_amdgcn_mfma_f32_32x32x16_bf16(pa0, ATT_PK(0), o[d0], 0, 0, 0);
        o[d0] = __builtin_amdgcn_mfma_f32_32x32x16_bf16(pa1, ATT_PK(1), o[d0], 0, 0, 0);
        o[d0] = __builtin_amdgcn_mfma_f32_32x32x16_bf16(pa2, ATT_PK(2), o[d0], 0, 0, 0);
        o[d0] = __builtin_amdgcn_mfma_f32_32x32x16_bf16(pa3, ATT_PK(3), o[d0], 0, 0, 0);
#undef ATT_PK
    }
}
#define ATT_BAR() asm volatile("s_waitcnt lgkmcnt(0)\n\ts_barrier" ::: "memory")
#define ATT_WAIT_BAR() asm volatile("s_waitcnt vmcnt(0) lgkmcnt(0)\n\ts_barrier" ::: "memory")

template <int DH, bool MOBA> __device__ __forceinline__ void attn_unit(const bf16* Qp, size_t qpitch, const bf16* Kp, const bf16* Vp, size_t kpitch, bf16* Op, int qb, const float* kmean_bh, const float* tab_h,
                                                                   LAS unsigned char* lds, int tid, int wid, int lane) {
    constexpr int ND0 = DH / 16, NDB = DH / 32, NPIECE = DH / 64;
    const int r32 = lane & 31, hi = lane >> 5;
    const unsigned lds0 = (unsigned)(uintptr_t)lds;
    LAS float* wsf = (LAS float*)(lds + L_WSF) + wid * 64;
    ATT_BAR();
    int my_sel = 0;
    if (MOBA) {
        LAS float* tl = (LAS float*)(lds + L_TAB);
        for (int i = tid; i < TAB_PAD + 2048; i += NWAVES * 64) tl[i] = (i < TAB_PAD) ? 0.f : tab_h[i - TAB_PAD];
        LAS float* km = (LAS float*)(lds + L_KM);
        for (int i = tid; i < 512; i += NWAVES * 64) km[i] = kmean_bh[i];
        ATT_BAR();
        if (tid < 256) {
            int sel = 0;
            if (qb <= 3) sel = (1 << qb) - 1;
            else {
                const GAS v4u* qrow = (const GAS v4u*)(Qp + (size_t)tid * qpitch);
                v4u qw[8];
#pragma unroll
                for (int c = 0; c < 8; ++c) qw[c] = qrow[c];
                float b1 = -INFINITY, b2 = -INFINITY, b3 = -INFINITY; int i1 = 0, i2 = 0, i3 = 0;
#pragma unroll 1
                for (int n = 0; n < qb; ++n) { float s = 0.f; const LAS f32x4* kr = (const LAS f32x4*)(km + n * 64);
#pragma unroll
                    for (int c = 0; c < 8; ++c) { const f32x4 ka = kr[2 * c], kb2 = kr[2 * c + 1]; const v4u w = qw[c];
                        s += bflo(w.x) * ka.x; s += bfhi(w.x) * ka.y; s += bflo(w.y) * ka.z; s += bfhi(w.y) * ka.w;
                        s += bflo(w.z) * kb2.x; s += bfhi(w.z) * kb2.y; s += bflo(w.w) * kb2.z; s += bfhi(w.w) * kb2.w; }
                    if (s > b1) { b3 = b2; i3 = i2; b2 = b1; i2 = i1; b1 = s; i1 = n; }
                    else if (s > b2) { b3 = b2; i3 = i2; b2 = s; i2 = n; }
                    else if (s > b3) { b3 = s; i3 = n; } }
                sel = (1 << i1) | (1 << i2) | (1 << i3);
            }
            ((LAS int*)(lds + L_SEL))[tid] = sel;
        }
        ATT_BAR();
        my_sel = ((LAS int*)(lds + L_SEL))[wid * 32 + r32];
    }
    bf16x8 qr[ND0];
    { const bf16* Qw = Qp + (size_t)(wid * 32 + r32) * qpitch + hi * 8;
#pragma unroll
      for (int d0 = 0; d0 < ND0; ++d0) qr[d0] = *(const GAS bf16x8*)(Qw + d0 * 16); }
    float m_run = -INFINITY, l_run = 0.f;
    f32x16 o[NDB];
#pragma unroll
    for (int d = 0; d < NDB; ++d) o[d] = f32x16{};
    const int vb0 = (int)(lds0 + L_V) + ((lane >> 4) & 1) * 32 + (lane & 3) * 8 + (4 * hi + ((lane & 15) >> 2)) * 64;
    const int qrel = wid * 32 + r32;
    const int ntiles = MOBA ? 4 + 4 * qb : 4;
    for (int tt = 0; tt < ntiles; ++tt) {
        int kb, j; bool own;
        if (MOBA) { if (tt < 4) { kb = qb; j = tt; own = true; } else { kb = (tt - 4) >> 2; j = (tt - 4) & 3; own = false; } }
        else { kb = 0; j = tt; own = false; }
        const int key0 = kb * 256 + j * 64;
        ATT_BAR();
#pragma unroll
        for (int pc = 0; pc < NPIECE; ++pc) { const int p = wid + 8 * pc;
            glds16(Kp + (size_t)(key0 + lane) * kpitch + p * 8, (unsigned)__builtin_amdgcn_readfirstlane(lds0 + L_K + p * 1024));
            glds16(Vp + (size_t)(key0 + 16 * (p & 3) + (lane >> 2)) * kpitch + (p >> 2) * 32 + (lane & 3) * 8, (unsigned)__builtin_amdgcn_readfirstlane(lds0 + L_V + p * 1024)); }
        ATT_WAIT_BAR();
        if (MOBA && own && 64 * j > wid * 32 + 31) continue;
        f32x16 p0, p1;
        qkt<ND0>(p0, p1, lds + L_K, qr, r32, hi);
        if (MOBA) {
            const int dbase = (qb - kb) * 256 + qrel - 64 * j - 4 * hi;
            const LAS float* tp = (const LAS float*)(lds + L_TAB) + TAB_PAD + dbase - 63;
            const bool lane_ok = own ? true : (((my_sel >> kb) & 1) != 0);
#pragma unroll
            for (int r = 0; r < 16; ++r) { const int c = (r & 3) + 8 * (r >> 2);
                const bool v0 = own ? (dbase - c >= 0) : lane_ok, v1 = own ? (dbase - c - 32 >= 0) : lane_ok;
                p0[r] = v0 ? p0[r] + tp[63 - c] : -INFINITY; p1[r] = v1 ? p1[r] + tp[31 - c] : -INFINITY; }
        }
        const float rm = rowmax(p0, p1);
        const float m_new = fmaxf(m_run, rm);
        const float alpha = __builtin_amdgcn_exp2f(m_run - m_new);
        float ps = 0.f;
#pragma unroll
        for (int r = 0; r < 16; ++r) { p0[r] = __builtin_amdgcn_exp2f(p0[r] - m_new); p1[r] = __builtin_amdgcn_exp2f(p1[r] - m_new); ps += p0[r] + p1[r]; }
        l_run = l_run * alpha + ps;
        if (!__all(m_new == m_run)) {
            if (hi == 0) wsf[r32] = alpha;
            LDS_WAIT();
#pragma unroll
            for (int r = 0; r < 16; ++r) { const float f = wsf[crow(r, hi)];
#pragma unroll
                for (int d = 0; d < NDB; ++d) o[d][r] *= f; }
        }
        m_run = m_new;
        v4u pw0, pw1, pw2, pw3;
        pw0 = (v4u){cvtpk(p0[0], p0[1]), cvtpk(p0[2], p0[3]), cvtpk(p0[4], p0[5]), cvtpk(p0[6], p0[7])};
        pw1 = (v4u){cvtpk(p0[8], p0[9]), cvtpk(p0[10], p0[11]), cvtpk(p0[12], p0[13]), cvtpk(p0[14], p0[15])};
        pw2 = (v4u){cvtpk(p1[0], p1[1]), cvtpk(p1[2], p1[3]), cvtpk(p1[4], p1[5]), cvtpk(p1[6], p1[7])};
        pw3 = (v4u){cvtpk(p1[8], p1[9]), cvtpk(p1[10], p1[11]), cvtpk(p1[12], p1[13]), cvtpk(p1[14], p1[15])};
        pv<NDB>(o, vb0, __builtin_bit_cast(bf16x8, pw0), __builtin_bit_cast(bf16x8, pw1), __builtin_bit_cast(bf16x8, pw2), __builtin_bit_cast(bf16x8, pw3));
    }
    { auto rr = __builtin_amdgcn_permlane32_swap(__float_as_uint(l_run), __float_as_uint(l_run), false, false); l_run = __uint_as_float(rr[0]) + __uint_as_float(rr[1]); }
    if (hi == 0) wsf[32 + r32] = l_run;
    LDS_WAIT();
    LAS bf16* stg = (LAS bf16*)(lds + L_OST + wid * 8192);
#pragma unroll
    for (int r = 0; r < 16; ++r) { const int orow = crow(r, hi); const float rl = __builtin_amdgcn_rcpf(wsf[32 + orow]);
#pragma unroll
        for (int d = 0; d < NDB; ++d) stg[orow * DH + d * 32 + r32] = (bf16)f2bf(o[d][r] * rl); }
    LDS_WAIT();
    constexpr int CPR = DH / 8;
    int lane2 = lane; asm volatile("" : "+v"(lane2));
#pragma unroll
    for (int i = 0; i < (32 * CPR) / 64; ++i) { const int idx = i * 64 + lane2, row = idx / CPR, ch = idx % CPR;
        const v4u v = *(const LAS v4u*)(stg + row * DH + ch * 8);
        *(GAS v4u*)(Op + (size_t)(wid * 32 + row) * 512 + ch * 8) = v; }
}
#undef ATT_BAR
#undef ATT_WAIT_BAR
}

__device__ __forceinline__ void conv_item(const bf16* PA, const float* conv_w, bf16* CO, int item, int tid) {
    const int ch = (tid & 63) * 8, r0 = item * 64 + (tid >> 6) * 8;
    float w0[8], w1[8], w2[8];
#pragma unroll
    for (int j = 0; j < 8; ++j) { w0[j] = conv_w[ch + j]; w1[j] = conv_w[512 + ch + j]; w2[j] = conv_w[1024 + ch + j]; }
    float pm2[8], pm1[8];
#pragma unroll
    for (int j = 0; j < 8; ++j) { pm2[j] = 0.f; pm1[j] = 0.f; }
    auto load8 = [&](int row, int col, float* o) { const v4u w = *(const GAS v4u*)(PA + (size_t)row * PAW + col + ch);
        o[0] = bflo(w.x); o[1] = bfhi(w.x); o[2] = bflo(w.y); o[3] = bfhi(w.y); o[4] = bflo(w.z); o[5] = bfhi(w.z); o[6] = bflo(w.w); o[7] = bfhi(w.w); };
    const int s0 = r0 & (SEQ - 1);
    if (s0 >= 2) { float a[8], b[8]; load8(r0 - 2, COL_CC, a); load8(r0 - 2, COL_UC, b);
#pragma unroll
        for (int j = 0; j < 8; ++j) pm2[j] = a[j] * b[j]; }
    if (s0 >= 1) { float a[8], b[8]; load8(r0 - 1, COL_CC, a); load8(r0 - 1, COL_UC, b);
#pragma unroll
        for (int j = 0; j < 8; ++j) pm1[j] = a[j] * b[j]; }
#pragma unroll
    for (int i = 0; i < 8; ++i) { const int row = r0 + i; float c[8], u[8], bb[8], y[8];
        load8(row, COL_CC, c); load8(row, COL_UC, u); load8(row, COL_BC, bb);
#pragma unroll
        for (int j = 0; j < 8; ++j) { const float cur = c[j] * u[j]; y[j] = bb[j] * (w0[j] * pm2[j] + w1[j] * pm1[j] + w2[j] * cur); pm2[j] = pm1[j]; pm1[j] = cur; }
        v4u o; o.x = pk2(y[0], y[1]); o.y = pk2(y[2], y[3]); o.z = pk2(y[4], y[5]); o.w = pk2(y[6], y[7]);
        *(GAS v4u*)(CO + (size_t)row * 512 + ch) = o; }
}

namespace pk {
template <int N> __device__ __forceinline__ void bsort_desc(unsigned (&a)[N]) {
#pragma unroll
    for (int k = 2; k <= N; k <<= 1) {
#pragma unroll
        for (int j = k >> 1; j > 0; j >>= 1) {
#pragma unroll
            for (int i = 0; i < N; ++i) { const int l = i ^ j;
                if (l > i) { const unsigned x = a[i], y = a[l]; const unsigned mx = x > y ? x : y, mn = x > y ? y : x;
                    if ((i & k) == 0) { a[i] = mx; a[l] = mn; } else { a[i] = mn; a[l] = mx; } } } } }
}
template <int N> __device__ __forceinline__ void bmerge_desc(unsigned (&a)[N]) {
#pragma unroll
    for (int j = N >> 1; j > 0; j >>= 1) {
#pragma unroll
        for (int i = 0; i < N; ++i) { const int l = i ^ j; if (l > i) { const unsigned x = a[i], y = a[l]; a[i] = x > y ? x : y; a[l] = x > y ? y : x; } } }
}
__device__ __forceinline__ void top16_merge(unsigned (&x)[16], const unsigned (&y)[16]) {
#pragma unroll
    for (int i = 0; i < 16; ++i) x[i] = x[i] > y[15 - i] ? x[i] : y[15 - i];
    bmerge_desc<16>(x);
}
__device__ __forceinline__ unsigned f2ord(float f) { const unsigned u = __float_as_uint(f); return u ^ ((unsigned)((int)u >> 31) | 0x80000000u); }
__device__ __forceinline__ float ord2f(unsigned o) { return __uint_as_float(o ^ ((o & 0x80000000u) ? 0x80000000u : 0xFFFFFFFFu)); }

constexpr int L_TBL = 0;
__device__ __forceinline__ void topk_unit(const bf16* QRY, const bf16* SK, const float* SLOTS, unsigned* SEL, LAS unsigned char* lds, int v, int tid, int wid, int lane) {
    const int hp = v & 3, t0 = ((v >> 2) * 8 + wid) * 32, r32 = lane & 31, hi = lane >> 5;
    for (int tb = 0; tb < 4; ++tb) { const bf16* src = SK + (size_t)(((2 * hp + (tb >> 1)) * 2 + (tb & 1)) * 128) * 128;
        for (int idx = tid; idx < 2048; idx += NWAVES * 64) { const int key = idx >> 4, c16 = idx & 15;
            const v4u w = *(const GAS v4u*)(src + key * 128 + c16 * 8);
            *(LAS v4u*)(lds + L_TBL + tb * 32768 + (c16 * 4 + (key >> 5)) * 512 + (key & 31) * 16) = w; } }
    asm volatile("s_waitcnt vmcnt(0) lgkmcnt(0)\n\ts_barrier" ::: "memory");
    const int tok = t0 + r32;
    float rn; { const GAS f32x4* sl = (const GAS f32x4*)(SLOTS + (size_t)tok * 16); const f32x4 a = sl[0], b = sl[1], c = sl[2], d = sl[3];
        const float ss = ((a.x + a.y) + (a.z + a.w)) + ((b.x + b.y) + (b.z + b.w)) + ((c.x + c.y) + (c.z + c.w)) + ((d.x + d.y) + (d.z + d.w));
        rn = 1.f / sqrtf(ss * (1.f / 1024.f) + RMS_EPS); }
    unsigned L[4][16];
#pragma unroll
    for (int tb = 0; tb < 4; ++tb) {
        const int hh = tb >> 1, p = tb & 1;
        const bf16* qp = QRY + (size_t)tok * 2048 + ((2 * hp + hh) * 2 + p) * 128 + hi * 8;
        bf16x8 qf[8];
#pragma unroll
        for (int kk = 0; kk < 8; ++kk) qf[kk] = *(const GAS bf16x8*)(qp + kk * 16);
        f32x16 acc[4];
#pragma unroll
        for (int blk = 0; blk < 4; ++blk) acc[blk] = f32x16{};
        const LAS unsigned char* tbase = lds + L_TBL + tb * 32768 + hi * 2048 + r32 * 16;
#pragma unroll
        for (int kk = 0; kk < 8; ++kk)
#pragma unroll
            for (int blk = 0; blk < 4; ++blk) { const bf16x8 af = *(const LAS bf16x8*)(tbase + kk * 4096 + blk * 512);
                acc[blk] = __builtin_amdgcn_mfma_f32_32x32x16_bf16(af, qf[kk], acc[blk], 0, 0, 0); }
        unsigned g[4][16];
#pragma unroll
        for (int blk = 0; blk < 4; ++blk)
#pragma unroll
            for (int r = 0; r < 16; ++r) g[blk][r] = (f2ord(acc[blk][r]) & ~127u) | (unsigned)(127 - (32 * blk + (r & 3) + 8 * (r >> 2)));
#pragma unroll
        for (int blk = 0; blk < 4; ++blk) bsort_desc<16>(g[blk]);
        top16_merge(g[0], g[1]); top16_merge(g[2], g[3]); top16_merge(g[0], g[2]);
#pragma unroll
        for (int i = 0; i < 16; ++i) L[tb][i] = g[0][i] ^ (unsigned)(4 * hi);
    }
    unsigned A[2][16];
#pragma unroll
    for (int p = 0; p < 2; ++p) {
        unsigned X[16], Y[16];
#pragma unroll
        for (int i = 0; i < 16; ++i) { auto rr = __builtin_amdgcn_permlane32_swap(L[p][i], L[2 + p][i], false, false); X[i] = rr[0]; Y[i] = rr[1]; }
        top16_merge(X, Y);
#pragma unroll
        for (int i = 0; i < 16; ++i) A[p][i] = X[i];
    }
    float f0[16], f1[16];
#pragma unroll
    for (int i = 0; i < 16; ++i) { f0[i] = ord2f(A[0][i] & ~127u); f1[i] = ord2f(A[1][i] & ~127u); }
    float sums[50]; unsigned keys[50];
    { int c = 0;
#pragma unroll
      for (int i = 0; i < 16; ++i)
#pragma unroll
          for (int j = 0; j < 16; ++j) if ((i + 1) * (j + 1) <= 16) { sums[c] = f0[i] + f1[j]; keys[c] = (f2ord(sums[c]) & ~63u) | (unsigned)(63 - c); ++c; } }
    unsigned G0[16], R[32];
#pragma unroll
    for (int i = 0; i < 16; ++i) G0[i] = keys[i];
#pragma unroll
    for (int i = 0; i < 32; ++i) R[i] = (i < 26) ? keys[24 + i] : 0u;
    bsort_desc<32>(R);
#pragma unroll
    for (int i = 0; i < 16; ++i) G0[i] = G0[i] > R[15 - i] ? G0[i] : R[15 - i];
    bmerge_desc<16>(G0);
#pragma unroll
    for (int i = 8; i < 16; ++i) G0[i] = G0[i] > keys[16 + 15 - i] ? G0[i] : keys[16 + 15 - i];
    unsigned thr = G0[0];
#pragma unroll
    for (int i = 1; i < 16; ++i) thr = thr < G0[i] ? thr : G0[i];
    const float s00 = sums[0], sc = rn * LOG2E;
    float w[50]; float den = 0.f;
#pragma unroll
    for (int c = 0; c < 50; ++c) { w[c] = (keys[c] >= thr) ? __builtin_amdgcn_exp2f((sums[c] - s00) * sc) : 0.f; den += w[c]; }
    const float inv = 1.f / den;
    unsigned i0[16], i1[16];
#pragma unroll
    for (int i = 0; i < 16; ++i) { i0[i] = 127u - (A[0][i] & 127u); i1[i] = 127u - (A[1][i] & 127u); }
    GAS unsigned* outp = (GAS unsigned*)(SEL + ((size_t)tok * 8 + 2 * hp + hi) * 16);
    int pos = 0;
    { int c = 0;
#pragma unroll
      for (int i = 0; i < 16; ++i)
#pragma unroll
          for (int j = 0; j < 16; ++j) if ((i + 1) * (j + 1) <= 16) { if (keys[c] >= thr) { outp[pos & 15] = ((i0[i] * 128u + i1[j]) << 16) | f2bf(w[c] * inv); ++pos; } ++c; } }
}
}

__device__ __forceinline__ float gelu_exact(float x) { return 0.5f * x * (1.0f + erff(x * 0.70710678118654752f)); }
__device__ __forceinline__ float dot2bf(unsigned a, unsigned b, float c) { typedef __bf16 b2 __attribute__((ext_vector_type(2))); return __builtin_amdgcn_fdot2_f32_bf16(__builtin_bit_cast(b2, a), __builtin_bit_cast(b2, b), c, false); }
__device__ __forceinline__ void gather_token(float* H, const unsigned* SEL, const bf16* UT, const bf16* VT, const float (&gf)[16], int t, int lane) {
    GAS f32x4* hrow = (GAS f32x4*)(H + (size_t)t * DM);
    f32x4 hv[4]; hv[0] = hrow[2 * lane]; hv[1] = hrow[2 * lane + 1]; hv[2] = hrow[128 + 2 * lane]; hv[3] = hrow[128 + 2 * lane + 1];
    float ss = 0.f;
#pragma unroll
    for (int j = 0; j < 4; ++j) ss += (hv[j].x * hv[j].x + hv[j].y * hv[j].y) + (hv[j].z * hv[j].z + hv[j].w * hv[j].w);
    const float rn = 1.f / sqrtf(wave_sum(ss) * (1.f / 1024.f) + RMS_EPS);
    unsigned xb[8];
#pragma unroll
    for (int j = 0; j < 4; ++j) { xb[2 * j] = pk2(hv[j].x * rn * gf[4 * j], hv[j].y * rn * gf[4 * j + 1]); xb[2 * j + 1] = pk2(hv[j].z * rn * gf[4 * j + 2], hv[j].w * rn * gf[4 * j + 3]); }
    const v2u ent = *(const GAS v2u*)(SEL + (size_t)t * 128 + 2 * lane);
    float out[16];
#pragma unroll
    for (int j = 0; j < 16; ++j) out[j] = 0.f;
    const int b0 = lane & 1, b1 = (lane >> 1) & 1, b2 = (lane >> 2) & 1;
    const int kmine = b0 * 4 + b1 * 2 + b2;
    for (int gi = 0; gi < 16; ++gi) {
        v4u uw[8][2], vw[8][2];
#pragma unroll
        for (int k = 0; k < 8; ++k) {
            const unsigned ev = (unsigned)__builtin_amdgcn_readlane((int)((k & 1) ? ent.y : ent.x), gi * 4 + (k >> 1));
            const unsigned e = ev >> 16;
            const GAS v4u* up = (const GAS v4u*)(UT + (size_t)e * DM) + lane; const GAS v4u* vp = (const GAS v4u*)(VT + (size_t)e * DM) + lane;
            uw[k][0] = up[0]; uw[k][1] = up[64]; vw[k][0] = vp[0]; vw[k][1] = vp[64];
        }
        float part[8];
#pragma unroll
        for (int k = 0; k < 8; ++k) { float a = 0.f, b = 0.f;
            a = dot2bf(uw[k][0].x, xb[0], a); b = dot2bf(uw[k][0].y, xb[1], b); a = dot2bf(uw[k][0].z, xb[2], a); b = dot2bf(uw[k][0].w, xb[3], b);
            a = dot2bf(uw[k][1].x, xb[4], a); b = dot2bf(uw[k][1].y, xb[5], b); a = dot2bf(uw[k][1].z, xb[6], a); b = dot2bf(uw[k][1].w, xb[7], b);
            part[k] = a + b; }
        float q4[4], q2[2], tot;
#pragma unroll
        for (int i = 0; i < 4; ++i) { const float keep = b0 ? part[i + 4] : part[i], send = b0 ? part[i] : part[i + 4]; q4[i] = keep + __shfl_xor(send, 1); }
#pragma unroll
        for (int i = 0; i < 2; ++i) { const float keep = b1 ? q4[i + 2] : q4[i], send = b1 ? q4[i] : q4[i + 2]; q2[i] = keep + __shfl_xor(send, 2); }
        { const float keep = b2 ? q2[1] : q2[0], send = b2 ? q2[0] : q2[1]; tot = keep + __shfl_xor(send, 4); }
        tot += __shfl_xor(tot, 8); tot += __shfl_xor(tot, 16); tot += __shfl_xor(tot, 32);
        const int src = gi * 4 + (kmine >> 1);
        const unsigned ex = (unsigned)__shfl((int)ent.x, src), ey = (unsigned)__shfl((int)ent.y, src);
        const float gw_ = bflo((kmine & 1) ? ey : ex);
        const float coef = gw_ * gelu_exact(tot);
#pragma unroll
        for (int k = 0; k < 8; ++k) {
            const int srcl = ((k >> 2) & 1) | (((k >> 1) & 1) << 1) | ((k & 1) << 2);
            const float c = __uint_as_float((unsigned)__builtin_amdgcn_readlane((int)__float_as_uint(coef), srcl));
#pragma unroll
            for (int hlf = 0; hlf < 2; ++hlf) { const v4u wv = vw[k][hlf];
                out[8 * hlf + 0] += c * bflo(wv.x); out[8 * hlf + 1] += c * bfhi(wv.x); out[8 * hlf + 2] += c * bflo(wv.y); out[8 * hlf + 3] += c * bfhi(wv.y);
                out[8 * hlf + 4] += c * bflo(wv.z); out[8 * hlf + 5] += c * bfhi(wv.z); out[8 * hlf + 6] += c * bflo(wv.w); out[8 * hlf + 7] += c * bfhi(wv.w); }
        }
    }
    hv[0] += (f32x4){out[0], out[1], out[2], out[3]}; hv[1] += (f32x4){out[4], out[5], out[6], out[7]};
    hv[2] += (f32x4){out[8], out[9], out[10], out[11]}; hv[3] += (f32x4){out[12], out[13], out[14], out[15]};
    hrow[2 * lane] = hv[0]; hrow[2 * lane + 1] = hv[1]; hrow[128 + 2 * lane] = hv[2]; hrow[128 + 2 * lane + 1] = hv[3];
}

#ifndef MK_SPLIT
#define MK_SPLIT 0
#endif
constexpr int NPHASE = 9;
struct Args { const float* in[21]; float* out; unsigned char* ws; int ph_lo, ph_hi; };
static_assert(sizeof(Args) == 23 * 8 + 8, "Args has no padding");

__global__ void __launch_bounds__(NWAVES * 64, 2) fwd(Args args) {
    extern __shared__ __attribute__((aligned(16))) unsigned char lds_raw[];
    LAS unsigned char* lds = (LAS unsigned char*)lds_raw;
    volatile LAS unsigned* MISC = (volatile LAS unsigned*)(lds + MISC_OFF);
    const int tid = threadIdx.x, lane = tid & 63, wave = __builtin_amdgcn_readfirstlane(tid >> 6);
    const int G = gridDim.x; const int bx = blockIdx.x; const int vcu = (G % 8 == 0) ? (bx % 8) * (G / 8) + bx / 8 : bx;
    const int gw = vcu * NWAVES + wave, NGW = G * NWAVES;
    unsigned char* ws = args.ws;
    gu32* ctl = (gu32*)(ws + WS_CTL);
    const float* x = args.in[0]; const float* mem = args.in[1]; const float* g_mix = args.in[2]; const float* w_in = args.in[3]; const float* q_gain_a = args.in[4]; const float* k_gain_a = args.in[5];
    const float* rel_bias = args.in[6]; const float* conv_w = args.in[7]; const float* g_mem = args.in[8]; const float* w_mem_kv = args.in[9]; const float* q_gain_x = args.in[10]; const float* k_gain_x = args.in[11];
    const float* w_br_attn = args.in[12]; const float* w_br_conv = args.in[13]; const float* w_br_x = args.in[14]; const float* w_out = args.in[15]; const float* g_ffn = args.in[16];
    const float* w_query = args.in[17]; const float* sub_keys = args.in[18]; const float* peer_u = args.in[19]; const float* peer_v = args.in[20];
    float* out = args.out;
    bf16* WinT = (bf16*)(ws + WS_WIN); bf16* WkvT = (bf16*)(ws + WS_WKV); bf16* WbrT = (bf16*)(ws + WS_WBR); bf16* WoutT = (bf16*)(ws + WS_WOUT); bf16* WqT = (bf16*)(ws + WS_WQ);
    bf16* SK = (bf16*)(ws + WS_SK); float* TAB = (float*)(ws + WS_TAB); float* KMEAN = (float*)(ws + WS_KMEAN); bf16* MEMN = (bf16*)(ws + WS_MEMN); bf16* KVM = (bf16*)(ws + WS_KVM);
    float* SLOTS = (float*)(ws + WS_SLOTS); unsigned* SEL = (unsigned*)(ws + WS_SEL);
    bf16* PA = (bf16*)(ws + WS_PA); bf16* PG = (bf16*)(ws + WS_PG);
    bf16* MERGED = (bf16*)(ws + PA_MERGED); bf16* HB = (bf16*)(ws + PA_HB); bf16* UT = (bf16*)(ws + PA_UT); bf16* VT = (bf16*)(ws + PA_VT); bf16* QRY = (bf16*)(ws + PG_QRY);
    bf16* HN = (bf16*)out;
    bf16* BRO = (bf16*)out;

    for (int u = tid; u < (LDS_BYTES - LDSCTL_OFF) / 4; u += NWAVES * 64) ((LAS unsigned*)(lds + LDSCTL_OFF))[u] = 0u;
    __syncthreads();
#if !MK_SPLIT
    XcdBarrier bar = xcd_barrier_post((unsigned*)(ctl + CW_BAR), MISC + 8);
#define GRID_BAR() xcd_barrier(bar)
#else
#define GRID_BAR() do {} while (0)
#endif
    const int lo = args.ph_lo, hi_ = args.ph_hi;
#ifndef PH_MASK
#define PH_MASK 0x1ff
#endif
#define IN(k) ((((PH_MASK) >> (k)) & 1) && lo <= (k) && (k) < hi_)
#define BOTH(k) (IN(k) && IN((k) + 1))

    if (IN(0)) {
        P0Args a{x, mem, g_mix, w_in, rel_bias, g_mem, w_mem_kv, w_br_attn, w_br_conv, w_br_x, w_out, g_ffn, w_query, sub_keys, WinT, WkvT, WbrT, WoutT, WqT, SK, HN, MEMN, TAB};
        p0_prologue(a, lds, gw, NGW, wave, lane);
        if (BOTH(0)) GRID_BAR();
    }
    if (IN(1)) {
        { pg8::Gemm g{HN, WinT, T, PW, DM}; pg8::GOrder S; S.init(T, PW, G, bx); pg8::EpiProj E{PA, PG};
          pg8::gemm_phase<pg8::EpiProj, pg8::GOrder, true, true>(lds + RING_OFF, g, S, E); }
        { const int nfull = (64 * 26) % G; const int coff = (nfull + 32 <= G) ? bx - nfull : bx;
          pg8::Gemm g{MEMN, WkvT, NBATCH * MEMLEN, 1024, DM}; pg8::GOrder S; S.init(NBATCH * MEMLEN, 1024, G, coff); pg8::EpiBf16<0> E{KVM, 1024, nullptr, 0, 0, 1.f};
          pg8::gemm_phase<pg8::EpiBf16<0>, pg8::GOrder, true, true>(lds + RING_OFF, g, S, E); }
        if (BOTH(1)) GRID_BAR();
    }
    if (IN(2)) {
        p2_fixup(PA, KVM, KMEAN, q_gain_a, k_gain_a, q_gain_x, k_gain_x, gw, NGW, lane);
        if (BOTH(2)) GRID_BAR();
    }
    if (IN(3)) {
        for (int v = vcu; v < 256; v += G) {
            const int bh = v >> 2, b = bh >> 3, h = bh & 7, s = v & 3;
#pragma unroll 1
            for (int pass = 0; pass < 2; ++pass) { const int qb = pass ? 7 - s : s;
                const bf16* Qp = PA + (size_t)(b * SEQ + qb * 256) * PAW + COL_QA + h * 64;
                const bf16* Kp = PA + (size_t)(b * SEQ) * PAW + COL_KA + h * 64; const bf16* Vp = PA + (size_t)(b * SEQ) * PAW + COL_VA + h * 64;
                bf16* Op = BRO + (size_t)(b * SEQ + qb * 256) * 512 + h * 64;
                att::attn_unit<64, true>(Qp, PAW, Kp, Vp, PAW, Op, qb, KMEAN + (size_t)bh * 512, TAB + h * 2048, lds + RING_OFF, tid, wave, lane); }
            { const int bb = v >> 5, hx = (v >> 3) & 3, qt = v & 7;
                const bf16* Qp = PA + (size_t)(bb * SEQ + qt * 256) * PAW + COL_QX + hx * 128;
                const bf16* Kp = KVM + (size_t)(bb * MEMLEN) * 1024 + hx * 128; const bf16* Vp = Kp + 512;
                bf16* Op = BRO + (size_t)2 * T * 512 + (size_t)(bb * SEQ + qt * 256) * 512 + hx * 128;
                att::attn_unit<128, false>(Qp, PAW, Kp, Vp, 1024, Op, 0, nullptr, nullptr, lds + RING_OFF, tid, wave, lane); }
            conv_item(PA, conv_w, BRO + (size_t)T * 512, v, tid);
        }
        if (BOTH(3)) GRID_BAR();
    }
    if (IN(4)) {
        pg8::Gemm g{BRO, WbrT, 3 * T, 3 * 1024, 512}; pg8::BranchOrder S; S.init(G, bx); pg8::EpiBranch E{PG, MERGED};
        pg8::gemm_phase<pg8::EpiBranch, pg8::BranchOrder, true, true>(lds + RING_OFF, g, S, E);
        if (BOTH(4)) GRID_BAR();
    }
    if (IN(5)) {
        pg8::Gemm g{MERGED, WoutT, T, 1024, DM}; pg8::GOrder S; S.init(T, 1024, G, bx); pg8::EpiWout E{x, out, HB, SLOTS};
        pg8::gemm_phase<pg8::EpiWout, pg8::GOrder, true, true>(lds + RING_OFF, g, S, E);
        if (BOTH(5)) GRID_BAR();
    }
    if (IN(6)) {
        pg8::Gemm g{HB, WqT, T, 2048, DM}; pg8::GOrder S; S.init(T, 2048, G, bx); pg8::EpiBf16<0> E{QRY, 2048, nullptr, 0, 0, 1.f};
        pg8::gemm_phase<pg8::EpiBf16<0>, pg8::GOrder, true, true>(lds + RING_OFF, g, S, E);
        if (BOTH(6)) GRID_BAR();
    }
    if (IN(7)) {
        for (int v = vcu; v < 256; v += G) { pk::topk_unit(QRY, SK, SLOTS, SEL, lds + RING_OFF, v, tid, wave, lane); __syncthreads(); }
        for (int m = gw; m < 2 * NEXP; m += NGW) { if (m < NEXP) cvt_row_to_bf16(peer_u + (size_t)m * DM, UT + (size_t)m * DM, lane); else cvt_row_to_bf16(peer_v + (size_t)(m - NEXP) * DM, VT + (size_t)(m - NEXP) * DM, lane); }
        if (BOTH(7)) GRID_BAR();
    }
    if (IN(8)) {
        float gf[16];
#pragma unroll
        for (int j = 0; j < 4; ++j)
#pragma unroll
            for (int e = 0; e < 4; ++e) gf[4 * j + e] = g_ffn[(j >> 1) * 512 + 8 * lane + (j & 1) * 4 + e];
        for (int t = gw; t < T; t += NGW) gather_token(out, SEL, UT, VT, gf, t, lane);
    }
#undef IN
#undef BOTH
}

extern "C" void kernel_launch(void* const* d_in, const int* in_sizes, int n_in, void* d_out, int out_size, void* d_ws, size_t ws_size, hipStream_t stream) {
    static int grid = 0;
    if (grid == 0) {
        if (n_in != 21 || out_size != T * DM || ws_size < WS_END) { fprintf(stderr, "kernel_launch: unexpected shapes (n_in %d, out %d, ws %zu)\n", n_in, out_size, ws_size); grid = -1; return; }
        int dev = 0, cus = 0, per_cu = 0;
        if (hipGetDevice(&dev) != hipSuccess || hipDeviceGetAttribute(&cus, hipDeviceAttributeMultiprocessorCount, dev) != hipSuccess) { grid = -1; return; }
        if (hipFuncSetAttribute((const void*)fwd, hipFuncAttributeMaxDynamicSharedMemorySize, LDS_BYTES) != hipSuccess) { fprintf(stderr, "kernel_launch: hipFuncSetAttribute failed\n"); grid = -1; return; }
        if (hipOccupancyMaxActiveBlocksPerMultiprocessor(&per_cu, (const void*)fwd, NWAVES * 64, LDS_BYTES) != hipSuccess || per_cu < 1) { fprintf(stderr, "kernel_launch: occupancy query reports %d\n", per_cu); }
        (void)hipGetLastError();
        grid = cus;
    }
    if (grid < 0) return;
    (void)hipMemsetAsync((char*)d_ws + WS_CTL, 0, CTL_ZERO_BYTES, stream);
    Args a{};
    for (int i = 0; i < 21; ++i) a.in[i] = (const float*)d_in[i];
    a.out = (float*)d_out; a.ws = (unsigned char*)d_ws;
#if MK_SPLIT
    for (int p = 0; p < NPHASE; ++p) { a.ph_lo = p; a.ph_hi = p + 1; hipLaunchKernelGGL(fwd, dim3(grid), dim3(NWAVES * 64), LDS_BYTES, stream, a); }
#else
    a.ph_lo = 0; a.ph_hi = NPHASE;
    hipLaunchKernelGGL(fwd, dim3(grid), dim3(NWAVES * 64), LDS_BYTES, stream, a);
#endif
}
```

```cpp
#include <hip/hip_runtime.h>
#include <hip/hip_bf16.h>
#include <cstdio>
#include <cstdint>
#include <cmath>
namespace pg8 {
#define PG8_LAS __attribute__((address_space(3)))
typedef unsigned short bf16_t;
typedef short bf16x8 __attribute__((ext_vector_type(8)));
typedef float f32x4 __attribute__((ext_vector_type(4)));
typedef unsigned u32x4 __attribute__((ext_vector_type(4)));
constexpr int BM = 256, BK = 64, HALF = 128, HTB = HALF * BK * 2  , STAGE_BYTES = 8 * HTB, NXCD = 8, WGM = 8;

__host__ __device__ __forceinline__ int lds_byte(int r, int c) { const int st = (r >> 4) * 2 + (c >> 5), rr = r & 15, cc = c & 31, ob = rr * 64 + cc * 2; return st * 1024 + (ob ^ (((ob >> 9) & 1) << 5)); }
__host__ __device__ __forceinline__ void stage_rc(int b, int& R, int& C) { const int st = b / 1024, sb = b % 1024, swz = sb ^ (((sb >> 9) & 1) << 5); R = (st >> 1) * 16 + swz / 64; C = (st & 1) * 32 + (swz % 64) / 2; }
__host__ __device__ __forceinline__ int perm32(int rho) { const int n = rho >> 4, i = rho & 15; return 8 * (i >> 2) + 4 * n + (i & 3); }

struct Unit { int pm, pn; };
struct Gemm { const bf16_t* A; const bf16_t* Bt; int M, N, K; };

struct StaticOrder {
    int nM, nN, nwg, G, c;
    __host__ __device__ void init(int M, int N, int G_, int c_) { nM = M / BM; nN = N / BM; nwg = nM * nN; G = G_; c = c_; }
    __host__ __device__ bool next(int i, Unit& u) const {
        const long L = (long)i * G + c; if (L >= nwg) return false;
        int wgid = (int)L; { const int q = nwg / NXCD, r = nwg % NXCD, xcd = wgid % NXCD, off = wgid / NXCD; wgid = (xcd < r ? xcd * (q + 1) : r * (q + 1) + (xcd - r) * q) + off; }
        const int nig = WGM * nN, gid = wgid / nig, fm = gid * WGM, gsz = (nM - fm) < WGM ? (nM - fm) : WGM;
        u.pm = fm + ((wgid % nig) % gsz); u.pn = (wgid % nig) / gsz; return true;
    }
    __device__ __forceinline__ void a_ready(const Unit&) const {}
    __device__ __forceinline__ void done(const Unit&) const {}
};

__device__ __forceinline__ unsigned cvt_pk_bf16(float lo, float hi) { unsigned r; asm volatile("v_cvt_pk_bf16_f32 %0, %1, %2" : "=v"(r) : "v"(lo), "v"(hi)); return r; }
typedef float f32x2 __attribute__((ext_vector_type(2)));
__device__ __forceinline__ f32x2 gelu_pk(f32x2 v) {
    const f32x2 av = __builtin_elementwise_abs(v), d = av * 0.2316418882f + 1.0f;
    f32x2 t; t.x = __builtin_amdgcn_rcpf(d.x); t.y = __builtin_amdgcn_rcpf(d.y);
    f32x2 q = t * 0.5307027145f + (-0.7265760135f); q = q * t + 0.7107068705f; q = q * t + (-0.142248368f); q = q * t + 0.127414796f; q = q * t;
    const f32x2 s = (v * v) * (-0.72134752044f);
    f32x2 e; e.x = __builtin_amdgcn_exp2f(s.x); e.y = __builtin_amdgcn_exp2f(s.y);
    const f32x2 m = v * (q * e), r = v - m;
    f32x2 o; o.x = v.x < 0.f ? m.x : r.x; o.y = v.y < 0.f ? m.y : r.y; return o;
}

template <int ACT  > struct EpiBf16 {
    static constexpr bool PERM = true, AFTER_DRAIN = false; static_assert(ACT == 0 || ACT == 1, "EpiBf16: ACT is 0 (none) or 1 (gelu_pk)");
    bf16_t* O; int ldc; const float* bias; int split_cols; size_t split_stride; float scale0;
    __device__ __forceinline__ void operator()(const f32x4 (&acc)[2][2][4][2], const Unit& u, int wr, int wc, int fr, int fq) const {
        const int row0 = u.pm * BM + wr * 64 + fr; int colt = u.pn * BM; bf16_t* base = O;
        float sc = 1.f; if (split_cols) { const int t = colt / split_cols; base += (size_t)t * split_stride; colt -= t * split_cols; if (t == 0) sc = scale0; }
        const int col0 = colt + wc * 32 + 8 * fq, bcol0 = u.pn * BM + wc * 32 + 8 * fq;
        f32x4 bv[2][2];
#pragma unroll
        for (int bj = 0; bj < 2; ++bj)
#pragma unroll
            for (int n = 0; n < 2; ++n) bv[bj][n] = bias ? *(const f32x4*)(bias + bcol0 + bj * HALF + 4 * n) : (f32x4){0.f, 0.f, 0.f, 0.f};
#pragma unroll
        for (int ai = 0; ai < 2; ++ai)
#pragma unroll
            for (int m = 0; m < 4; ++m) { bf16_t* rowp = base + (size_t)(row0 + ai * HALF + m * 16) * ldc + col0;
#pragma unroll
                for (int bj = 0; bj < 2; ++bj) { f32x4 v0 = acc[ai][bj][m][0] + bv[bj][0], v1 = acc[ai][bj][m][1] + bv[bj][1];
                    if (ACT == 1) { f32x2 a = gelu_pk((f32x2){v0[0], v0[1]}), b = gelu_pk((f32x2){v0[2], v0[3]}), c = gelu_pk((f32x2){v1[0], v1[1]}), d = gelu_pk((f32x2){v1[2], v1[3]});
                        v0 = (f32x4){a.x, a.y, b.x, b.y}; v1 = (f32x4){c.x, c.y, d.x, d.y}; }
                    v0 = v0 * sc; v1 = v1 * sc; u32x4 w; w.x = cvt_pk_bf16(v0[0], v0[1]); w.y = cvt_pk_bf16(v0[2], v0[3]); w.z = cvt_pk_bf16(v1[0], v1[1]); w.w = cvt_pk_bf16(v1[2], v1[3]);
                    *(u32x4*)(rowp + bj * HALF) = w; } }
    }
};


struct GOrder {
    int nM, nN, nwg, G, c;
    __host__ __device__ void init(int M, int N, int G_, int c_) { nM = M / BM; nN = N / BM; nwg = nM * nN; G = G_; c = c_; }
    __host__ __device__ bool next(int i, Unit& u) const {
        if (c < 0) return false;
        const long L = (long)i * G + c; if (L >= nwg) return false;
        int wgid = (int)L; { const int q = nwg / NXCD, r = nwg % NXCD, xcd = wgid % NXCD, off = wgid / NXCD; wgid = (xcd < r ? xcd * (q + 1) : r * (q + 1) + (xcd - r) * q) + off; }
        const int nig = WGM * nN, gid = wgid / nig, fm = gid * WGM, gsz = (nM - fm) < WGM ? (nM - fm) : WGM;
        u.pm = fm + ((wgid % nig) % gsz); u.pn = (wgid % nig) / gsz; return true;
    }
    __device__ __forceinline__ void a_ready(const Unit&) const {}
    __device__ __forceinline__ void done(const Unit&) const {}
};
struct BranchOrder {
    GOrder g;
    __device__ void init(int G, int c) { g.init(16384, 1024, G, c); }
    __device__ bool next(int i, Unit& u) const { Unit t; if (!g.next(i / 3, t)) return false; const int br = i % 3; u.pm = 64 * br + t.pm; u.pn = 4 * br + t.pn; return true; }
    __device__ __forceinline__ void a_ready(const Unit&) const {}
    __device__ __forceinline__ void done(const Unit&) const {}
};
__device__ __forceinline__ float bf_lo(unsigned w) { return __builtin_bit_cast(float, w << 16); }
__device__ __forceinline__ float bf_hi(unsigned w) { return __builtin_bit_cast(float, w & 0xffff0000u); }
__device__ __forceinline__ float sigmoid_f(float x) { return __builtin_amdgcn_rcpf(1.0f + __builtin_amdgcn_exp2f(-1.4426950408889634f * x)); }
struct EpiProj {
    static constexpr bool PERM = true, AFTER_DRAIN = false;
    bf16_t* PA; bf16_t* PG;
    __device__ __forceinline__ void operator()(const f32x4 (&acc)[2][2][4][2], const Unit& u, int wr, int wc, int fr, int fq) const {
        const bool gate = u.pn >= 14;
        bf16_t* base = gate ? PG : PA; const int ldc = gate ? 3072 : 3584; const int colt = gate ? (u.pn - 14) * BM : u.pn * BM;
        const int row0 = u.pm * BM + wr * 64 + fr, col0 = colt + wc * 32 + 8 * fq;
#pragma unroll
        for (int ai = 0; ai < 2; ++ai)
#pragma unroll
            for (int m = 0; m < 4; ++m) { bf16_t* rowp = base + (size_t)(row0 + ai * HALF + m * 16) * ldc + col0;
#pragma unroll
                for (int bj = 0; bj < 2; ++bj) { f32x4 v0 = acc[ai][bj][m][0], v1 = acc[ai][bj][m][1];
                    if (gate) {
#pragma unroll
                        for (int e = 0; e < 4; ++e) { v0[e] = sigmoid_f(v0[e]); v1[e] = sigmoid_f(v1[e]); } }
                    u32x4 w; w.x = cvt_pk_bf16(v0[0], v0[1]); w.y = cvt_pk_bf16(v0[2], v0[3]); w.z = cvt_pk_bf16(v1[0], v1[1]); w.w = cvt_pk_bf16(v1[2], v1[3]);
                    *(u32x4*)(rowp + bj * HALF) = w; } }
    }
};
struct EpiBranch {
    static constexpr bool PERM = true, AFTER_DRAIN = false;
    const bf16_t* PG; bf16_t* MG;
    __device__ __forceinline__ void operator()(const f32x4 (&acc)[2][2][4][2], const Unit& u, int wr, int wc, int fr, int fq) const {
        const int br = u.pm >> 6, tm = u.pm & 63, tn = u.pn & 3;
        const int row0 = tm * BM + wr * 64 + fr, col0 = tn * BM + wc * 32 + 8 * fq;
#pragma unroll
        for (int ai = 0; ai < 2; ++ai)
#pragma unroll
            for (int m = 0; m < 4; ++m) { const size_t row = (size_t)(row0 + ai * HALF + m * 16);
#pragma unroll
                for (int bj = 0; bj < 2; ++bj) { const int col = col0 + bj * HALF;
                    const u32x4 g = *(const u32x4*)(PG + row * 3072 + br * 1024 + col);
                    f32x4 v0 = acc[ai][bj][m][0], v1 = acc[ai][bj][m][1];
                    v0[0] *= bf_lo(g.x); v0[1] *= bf_hi(g.x); v0[2] *= bf_lo(g.y); v0[3] *= bf_hi(g.y);
                    v1[0] *= bf_lo(g.z); v1[1] *= bf_hi(g.z); v1[2] *= bf_lo(g.w); v1[3] *= bf_hi(g.w);
                    bf16_t* mp = MG + row * 1024 + col;
                    if (br > 0) { const u32x4 p = *(const u32x4*)mp;
                        v0[0] += bf_lo(p.x); v0[1] += bf_hi(p.x); v0[2] += bf_lo(p.y); v0[3] += bf_hi(p.y);
                        v1[0] += bf_lo(p.z); v1[1] += bf_hi(p.z); v1[2] += bf_lo(p.w); v1[3] += bf_hi(p.w); }
                    u32x4 w; w.x = cvt_pk_bf16(v0[0], v0[1]); w.y = cvt_pk_bf16(v0[2], v0[3]); w.z = cvt_pk_bf16(v1[0], v1[1]); w.w = cvt_pk_bf16(v1[2], v1[3]);
                    *(u32x4*)mp = w; } }
    }
};
struct EpiWout {
    static constexpr bool PERM = false, AFTER_DRAIN = false;
    const float* X; float* H; bf16_t* HB; float* SL;
    __device__ __forceinline__ void operator()(const f32x4 (&acc)[2][2][4][2], const Unit& u, int wr, int wc, int fr, int fq) const {
        const int row0 = u.pm * BM + wr * 64 + fr, col0 = u.pn * BM + wc * 32 + 4 * fq;
#pragma unroll
        for (int ai = 0; ai < 2; ++ai)
#pragma unroll
            for (int m = 0; m < 4; ++m) { const size_t row = (size_t)(row0 + ai * HALF + m * 16); float ss = 0.f;
#pragma unroll
                for (int bj = 0; bj < 2; ++bj)
#pragma unroll
                    for (int n = 0; n < 2; ++n) { const size_t off = row * 1024 + col0 + bj * HALF + n * 16;
                        const f32x4 xv = *(const f32x4*)(X + off); const f32x4 hv = xv + acc[ai][bj][m][n];
                        *(f32x4*)(H + off) = hv; ss += (hv[0] * hv[0] + hv[1] * hv[1]) + (hv[2] * hv[2] + hv[3] * hv[3]);
                        typedef unsigned u32x2v __attribute__((ext_vector_type(2))); u32x2v w; w.x = cvt_pk_bf16(hv[0], hv[1]); w.y = cvt_pk_bf16(hv[2], hv[3]);
                        *(u32x2v*)(HB + off) = w; }
                ss += __shfl_xor(ss, 16); ss += __shfl_xor(ss, 32);
                if (fq == 0) SL[row * 16 + u.pn * 4 + wc] = ss; }
    }
};
template <class Epi, class Sched, bool ALIGN_EPI = false, bool SP2 = false>
__device__ __forceinline__ void gemm_phase(PG8_LAS unsigned char* lds, const Gemm g, const Sched& S, const Epi& E) {
    const int tid = threadIdx.x, wid = __builtin_amdgcn_readfirstlane(tid >> 6), lane = tid & 63, wr = wid >> 2, wc = wid & 3, fr = lane & 15, fq = lane >> 4;
    const int K = g.K, nt = K / BK;
    unsigned voffA[2], voffB[2];
#pragma unroll
    for (int i = 0; i < 2; ++i) { int R, C; stage_rc(tid * 16 + i * 8192, R, C); const int Rb = Epi::PERM ? ((R & ~31) + perm32(R & 31)) : R;
        voffA[i] = (unsigned)(R * K + C) * 2u; voffB[i] = (unsigned)(Rb * K + C) * 2u; }
    const size_t kstep = (size_t)(BK * 2);
    const size_t hstep = (size_t)HALF * K * 2;
    const size_t tstep = 2 * hstep;
    const unsigned ldsw = (unsigned)wid * 1024u;
    const int aoff = lds_byte(wr * 64 + fr, fq * 8), boff = lds_byte(wc * 32 + fr, fq * 8);
#define PG8_SA(b, h) (((b) * 2 + (h)) * HTB)
#define PG8_SB(b, h) ((4 + (b) * 2 + (h)) * HTB)
#define PG8_STAGE(bufoff, gbase, voff) do { _Pragma("unroll") for (int _i = 0; _i < 2; ++_i) \
        __builtin_amdgcn_global_load_lds((const unsigned*)((const char*)(gbase) + (voff)[_i]), (PG8_LAS unsigned*)(lds + (bufoff) + ldsw + _i * 8192), 16, 0, 0); } while (0)
#define PG8_LDA(dst, b, h) do { _Pragma("unroll") for (int m = 0; m < 4; ++m) _Pragma("unroll") for (int k = 0; k < 2; ++k) dst[m][k] = *(const PG8_LAS bf16x8*)(lds + PG8_SA(b, h) + aoff + m * 2048 + k * 1024); } while (0)
#define PG8_LDB(dst, b, h) do { _Pragma("unroll") for (int n = 0; n < 2; ++n) _Pragma("unroll") for (int k = 0; k < 2; ++k) dst[n][k] = *(const PG8_LAS bf16x8*)(lds + PG8_SB(b, h) + boff + n * 2048 + k * 1024); } while (0)
#define PG8_MMA(ai, bj, At, Bt) do { __builtin_amdgcn_s_setprio(1); _Pragma("unroll") for (int m = 0; m < 4; ++m) _Pragma("unroll") for (int n = 0; n < 2; ++n) _Pragma("unroll") for (int k = 0; k < 2; ++k) \
        acc[ai][bj][m][n] = __builtin_amdgcn_mfma_f32_16x16x32_bf16(Bt[n][k], At[m][k], acc[ai][bj][m][n], 0, 0, 0); __builtin_amdgcn_s_setprio(0); } while (0)
#define PG8_WAIT_V(n) asm volatile("s_waitcnt vmcnt(" #n ")" ::: "memory")
#define PG8_WAIT_L(n) asm volatile("s_waitcnt lgkmcnt(" #n ")" ::: "memory")
#define PG8_BAR __builtin_amdgcn_s_barrier()
#define PG8_SCHED __builtin_amdgcn_sched_barrier(0)
    Unit cur, nxt; int ui = 0;
    if (!S.next(0, cur)) return;
    f32x4 acc[2][2][4][2];
#pragma unroll
    for (int a = 0; a < 2; ++a)
#pragma unroll
        for (int b = 0; b < 2; ++b)
#pragma unroll
            for (int m = 0; m < 4; ++m)
#pragma unroll
                for (int n = 0; n < 2; ++n) acc[a][b][m][n] = (f32x4){0.f, 0.f, 0.f, 0.f};
    bf16x8 At[4][2], B0[2][2], B1[2][2];
    const char* cA = (const char*)g.A + (size_t)cur.pm * tstep; const char* cB = (const char*)g.Bt + (size_t)cur.pn * tstep;
    S.a_ready(cur);
    if constexpr (SP2) {
        PG8_STAGE(PG8_SB(0, 0), cB, voffB); PG8_STAGE(PG8_SB(0, 1), cB + hstep, voffB); PG8_STAGE(PG8_SA(0, 0), cA, voffA); PG8_STAGE(PG8_SA(0, 1), cA + hstep, voffA);
        if (wr == 1) PG8_BAR;
        PG8_WAIT_V(2); PG8_BAR;
        PG8_STAGE(PG8_SB(1, 0), cB + kstep, voffB); PG8_STAGE(PG8_SA(1, 0), cA + kstep, voffA); PG8_STAGE(PG8_SB(1, 1), cB + hstep + kstep, voffB);
        PG8_WAIT_V(6); PG8_BAR;
    } else {
        PG8_STAGE(PG8_SB(0, 0), cB, voffB); PG8_STAGE(PG8_SA(0, 0), cA, voffA); PG8_STAGE(PG8_SB(0, 1), cB + hstep, voffB); PG8_STAGE(PG8_SA(0, 1), cA + hstep, voffA);
        if (wr == 1) PG8_BAR;
        PG8_WAIT_V(4); PG8_BAR;
        PG8_STAGE(PG8_SB(1, 0), cB + kstep, voffB); PG8_STAGE(PG8_SA(1, 0), cA + kstep, voffA); PG8_STAGE(PG8_SB(1, 1), cB + hstep + kstep, voffB);
        PG8_WAIT_V(6); PG8_BAR;
    }
    for (;;) {
        const bool has_next = S.next(ui + 1, nxt);
        const char* nA = has_next ? (const char*)g.A + (size_t)nxt.pm * tstep : cA; const char* nB = has_next ? (const char*)g.Bt + (size_t)nxt.pn * tstep : cB;
        for (int t = 0; t < nt; t += 2) {
            const bool last = (t == nt - 2);
            const char* a1 = cA + (size_t)(t + 1) * kstep;
            const char* a2 = last ? nA : cA + (size_t)(t + 2) * kstep; const char* b2 = last ? nB : cB + (size_t)(t + 2) * kstep;
            const char* a3 = a2 + kstep; const char* b3 = b2 + kstep;
            if (last && has_next) S.a_ready(nxt);
            if constexpr (SP2) {
            PG8_LDB(B0, 0, 0); PG8_LDB(B1, 0, 1); PG8_SCHED; PG8_LDA(At, 0, 0); PG8_STAGE(PG8_SA(1, 1), a1 + hstep, voffA);
            PG8_WAIT_V(8); PG8_WAIT_L(0); PG8_BAR; PG8_MMA(0, 0, At, B0); PG8_MMA(0, 1, At, B1); PG8_BAR; PG8_SCHED;
            PG8_LDA(At, 0, 1); PG8_STAGE(PG8_SB(0, 0), b2, voffB); PG8_STAGE(PG8_SB(0, 1), b2 + hstep, voffB); PG8_STAGE(PG8_SA(0, 0), a2, voffA);
            PG8_WAIT_V(8); PG8_WAIT_L(0); PG8_BAR; PG8_MMA(1, 0, At, B0); PG8_MMA(1, 1, At, B1); PG8_BAR; PG8_SCHED;
            PG8_LDB(B0, 1, 0); PG8_LDB(B1, 1, 1); PG8_SCHED; PG8_LDA(At, 1, 0); PG8_STAGE(PG8_SA(0, 1), a2 + hstep, voffA);
            PG8_WAIT_V(8); PG8_WAIT_L(0); PG8_BAR; PG8_MMA(0, 0, At, B0); PG8_MMA(0, 1, At, B1); PG8_BAR; PG8_SCHED;
            PG8_LDA(At, 1, 1); PG8_STAGE(PG8_SB(1, 0), b3, voffB); PG8_STAGE(PG8_SB(1, 1), b3 + hstep, voffB); PG8_STAGE(PG8_SA(1, 0), a3, voffA);
            PG8_WAIT_V(8); PG8_WAIT_L(0); PG8_BAR; PG8_MMA(1, 0, At, B0); PG8_MMA(1, 1, At, B1); PG8_BAR; PG8_SCHED;
            } else {
            PG8_LDB(B0, 0, 0); PG8_SCHED; PG8_LDA(At, 0, 0); PG8_STAGE(PG8_SA(1, 1), a1 + hstep, voffA);
            PG8_WAIT_L(8); PG8_BAR; PG8_WAIT_L(0); PG8_MMA(0, 0, At, B0); PG8_BAR; PG8_SCHED;
            PG8_LDB(B1, 0, 1); PG8_STAGE(PG8_SB(0, 0), b2, voffB);
            PG8_BAR; PG8_WAIT_L(0); PG8_MMA(0, 1, At, B1); PG8_BAR;
            PG8_LDA(At, 0, 1); PG8_STAGE(PG8_SA(0, 0), a2, voffA);
            PG8_BAR; PG8_WAIT_L(0); PG8_MMA(1, 0, At, B0); PG8_BAR; PG8_SCHED;
            PG8_STAGE(PG8_SB(0, 1), b2 + hstep, voffB);
            PG8_WAIT_V(6); PG8_BAR; PG8_MMA(1, 1, At, B1); PG8_BAR;
            PG8_LDB(B0, 1, 0); PG8_SCHED; PG8_LDA(At, 1, 0); PG8_STAGE(PG8_SA(0, 1), a2 + hstep, voffA);
            PG8_WAIT_L(8); PG8_BAR; PG8_WAIT_L(0); PG8_MMA(0, 0, At, B0); PG8_BAR; PG8_SCHED;
            PG8_LDB(B1, 1, 1); PG8_STAGE(PG8_SB(1, 0), b3, voffB);
            PG8_BAR; PG8_WAIT_L(0); PG8_MMA(0, 1, At, B1); PG8_BAR;
            PG8_LDA(At, 1, 1); PG8_STAGE(PG8_SA(1, 0), a3, voffA);
            PG8_BAR; PG8_WAIT_L(0); PG8_MMA(1, 0, At, B0); PG8_BAR; PG8_SCHED;
            PG8_STAGE(PG8_SB(1, 1), b3 + hstep, voffB);
            PG8_WAIT_V(6); PG8_BAR; PG8_MMA(1, 1, At, B1); PG8_BAR;
            }
        }
        if constexpr (ALIGN_EPI) { if (wr == 0) PG8_BAR; }
        if constexpr (!Epi::AFTER_DRAIN) { E(acc, cur, wr, wc, fr, fq); S.done(cur); }
        if (!has_next) break;
#pragma unroll
        for (int a = 0; a < 2; ++a)
#pragma unroll
            for (int b = 0; b < 2; ++b)
#pragma unroll
                for (int m = 0; m < 4; ++m)
#pragma unroll
                    for (int n = 0; n < 2; ++n) acc[a][b][m][n] = (f32x4){0.f, 0.f, 0.f, 0.f};
        cur = nxt; cA = nA; cB = nB; ++ui;
        if constexpr (ALIGN_EPI) { if (wr == 1) PG8_BAR; }
    }
    PG8_WAIT_V(0);
    if constexpr (!ALIGN_EPI) { if (wr == 0) PG8_BAR; }
    PG8_BAR;
    if constexpr (Epi::AFTER_DRAIN) { E.fused(acc, cur, wr, wc, fr, fq, lds, wid, lane); S.done(cur); }
#undef PG8_SA
#undef PG8_SB
#undef PG8_STAGE
#undef PG8_LDA
#undef PG8_LDB
#undef PG8_MMA
#undef PG8_WAIT_V
#undef PG8_WAIT_L
#undef PG8_BAR
#undef PG8_SCHED
}
}

constexpr int NWAVES = 8;
constexpr int T = 16384, DM = 1024, SEQ = 2048, NBATCH = 8, MEMLEN = 256;
constexpr int PW = 6656, PAW = 3584, PGW = 3072;
constexpr int COL_QA = 0, COL_KA = 512, COL_VA = 1024, COL_UC = 1536, COL_BC = 2048, COL_CC = 2560, COL_QX = 3072;
constexpr float RMS_EPS = 1e-6f, LOG2E = 1.4426950408889634f;
constexpr float C2A = 0.125f * LOG2E;
constexpr float C2X = 0.08838834764831845f * LOG2E;
constexpr int NEXP = 16384;

constexpr size_t MiB = 1u << 20;
constexpr size_t WS_CTL = 0, CTL_ZERO_BYTES = 1 * MiB;
constexpr size_t WS_WIN = 1 * MiB;
constexpr size_t WS_WKV = 14 * MiB;
constexpr size_t WS_WBR = 16 * MiB;
constexpr size_t WS_WOUT = 19 * MiB;
constexpr size_t WS_WQ = 21 * MiB;
constexpr size_t WS_SK = 25 * MiB;
constexpr size_t WS_TAB = 25 * MiB + 512 * 1024;
constexpr size_t WS_KMEAN = WS_TAB + 64 * 1024;
constexpr size_t WS_MEMN = 26 * MiB;
constexpr size_t WS_KVM = 30 * MiB;
constexpr size_t WS_SLOTS = 34 * MiB;
constexpr size_t WS_SEL = 35 * MiB;
constexpr size_t WS_SU = 43 * MiB, WS_SV = 43 * MiB + 65536;
constexpr size_t WS_PA = 44 * MiB;
constexpr size_t WS_PG = 156 * MiB;
constexpr size_t WS_END = 252 * MiB;
constexpr size_t PA_MERGED = WS_PA, PA_HB = WS_PA + 32 * MiB, PA_UT = WS_PA + 64 * MiB, PA_VT = WS_PA;
constexpr size_t PG_QRY = WS_PG;
constexpr int CW_BAR = 4096;

constexpr int RING_OFF = 0, RING_BYTES = 131072;
constexpr int LDSCTL_OFF = RING_BYTES, MISC_OFF = LDSCTL_OFF + 320;
constexpr int LDS_BYTES = 147456;

#define GAS __attribute__((address_space(1)))
#define LAS __attribute__((address_space(3)))
typedef unsigned short bf16;
typedef unsigned v4u __attribute__((ext_vector_type(4)));
typedef unsigned v2u __attribute__((ext_vector_type(2)));
typedef float f32x4 __attribute__((ext_vector_type(4)));
typedef float f32x16 __attribute__((ext_vector_type(16)));
typedef short bf16x8 __attribute__((ext_vector_type(8)));
typedef short s16x4 __attribute__((ext_vector_type(4)));
typedef GAS unsigned gu32;
#define RLX_AGENT __ATOMIC_RELAXED, __HIP_MEMORY_SCOPE_AGENT
#define LDS_WAIT() asm volatile("s_waitcnt lgkmcnt(0)" ::: "memory")
#define VM_WAIT() asm volatile("s_waitcnt vmcnt(0)" ::: "memory")
__device__ __forceinline__ unsigned f2bf(float f) { unsigned u = __builtin_bit_cast(unsigned, f); return (u + 0x7fffu + ((u >> 16) & 1u)) >> 16; }
__device__ __forceinline__ unsigned pk2(float lo, float hi) { return f2bf(lo) | (f2bf(hi) << 16); }
__device__ __forceinline__ float bflo(unsigned w) { return __builtin_bit_cast(float, w << 16); }
__device__ __forceinline__ float bfhi(unsigned w) { return __builtin_bit_cast(float, w & 0xffff0000u); }
__device__ __forceinline__ float wave_sum(float v) {
#pragma unroll
    for (int o = 1; o < 64; o <<= 1) v += __shfl_xor(v, o);
    return v;
}
#define XB_TMO      128
#define XB_XCNT(j)  (256  + 64 * (j))
#define XB_XSUB(j)  (1280 + 64 * (j))
#define XB_XGEN(j)  (2304 + 64 * (j))
#define XB_TOP      3328
#define XB_TOPGEN   3392
#define XCD_BAR_WORDS 3456
#define XB_SPIN_CAP (1u << 18)

__device__ __forceinline__ unsigned xb_ld(unsigned* p)              { return __hip_atomic_load(p, __ATOMIC_RELAXED, __HIP_MEMORY_SCOPE_AGENT); }
__device__ __forceinline__ unsigned xb_add(unsigned* p, unsigned v) { return __hip_atomic_fetch_add(p, v, __ATOMIC_RELAXED, __HIP_MEMORY_SCOPE_AGENT); }
__device__ __forceinline__ unsigned xb_xcc_id() { return (unsigned)__builtin_amdgcn_s_getreg((3 << 11) | 20) & 0xFu; }
#define XB_SPIN(cond, bar) do { unsigned _sp = 0; while (cond) { __builtin_amdgcn_s_sleep(1); \
    if ((++_sp & 255u) == 0u) { if (xb_ld(&(bar)[XB_TMO])) break; if (_sp > XB_SPIN_CAP) { atomicAdd(&(bar)[XB_TMO], 1u); break; } } } } while (0)

struct XcdBarrier {
    unsigned* bar; unsigned x;
    volatile LAS unsigned* st;
};

__device__ __forceinline__ XcdBarrier xcd_barrier_post(unsigned* bar, volatile LAS unsigned* st) {
    XcdBarrier b; b.bar = bar; b.x = xb_xcc_id(); b.st = st;
    if (threadIdx.x == 0) (void)xb_add(&bar[XB_XCNT(b.x)], 1u);
    return b;
}
__device__ __forceinline__ void xcd_barrier_complete(unsigned* bar, unsigned x, unsigned& nloc, unsigned& nx) {
    const unsigned G = gridDim.x * gridDim.y * gridDim.z;
    unsigned sum, cnt, mine, sp = 0u;
    for (;;) {
        sum = 0u; cnt = 0u; mine = 0u;
#pragma unroll
        for (unsigned j = 0; j < 16; ++j) { const unsigned c = xb_ld(&bar[XB_XCNT(j)]); sum += c; cnt += (c > 0u) ? 1u : 0u; mine = (j == x) ? c : mine; }
        if (sum == G) break;
        __builtin_amdgcn_s_sleep(1);
        if ((++sp & 255u) == 0u) { if (xb_ld(&bar[XB_TMO])) break; if (sp > XB_SPIN_CAP) { atomicAdd(&bar[XB_TMO], 1u); break; } }
    }
    nloc = mine > 0u ? mine : 1u; nx = cnt > 0u ? cnt : 1u;
}

__device__ __forceinline__ void xcd_barrier(const XcdBarrier& b) {
    asm volatile("s_waitcnt vmcnt(0)" ::: "memory");
    __syncthreads();
    if (threadIdx.x == 0) {
        unsigned* bar = b.bar;
        __builtin_amdgcn_s_waitcnt(0);
        unsigned nloc = b.st[0], nx = b.st[1];
        if (nloc == 0u) { xcd_barrier_complete(bar, b.x, nloc, nx); b.st[0] = nloc; b.st[1] = nx; }
        const unsigned old = xb_add(&bar[XB_XSUB(b.x)], 1u);
        const unsigned gen = old / nloc;
        if (old + 1u == (gen + 1u) * nloc) {
            __builtin_amdgcn_fence(__ATOMIC_RELEASE, "agent");
            asm volatile("s_waitcnt vmcnt(0)" ::: "memory");
            const unsigned og = xb_add(&bar[XB_TOP], 1u);
            const unsigned tg = og / nx;
            if (og + 1u == (tg + 1u) * nx) xb_add(&bar[XB_TOPGEN], 1u);
            else XB_SPIN(xb_ld(&bar[XB_TOPGEN]) == tg, bar);
            __builtin_amdgcn_fence(__ATOMIC_ACQUIRE, "agent");
            xb_add(&bar[XB_XGEN(b.x)], 1u);
            asm volatile("s_waitcnt vmcnt(0)" ::: "memory");
        } else {
            XB_SPIN(xb_ld(&bar[XB_XGEN(b.x)]) == gen, bar);
            __builtin_amdgcn_fence(__ATOMIC_ACQUIRE, "agent");
            asm volatile("s_waitcnt vmcnt(0)" ::: "memory");
        }
    }
    __syncthreads();
}

__device__ __forceinline__ void p0_transpose_item(const float* W, int K, int N, bf16* WT, int row_off, const float* ksc, LAS float* scr, int item, int lane) {
    const int nblk = N / 32, kb = item / nblk, nb = item % nblk, k0 = 64 * kb, n0 = 32 * nb;
#pragma unroll 8
    for (int i = 0; i < 32; ++i) { const int kk = 2 * i + (lane >> 5); float v = W[(size_t)(k0 + kk) * N + n0 + (lane & 31)]; if (ksc) v *= ksc[k0 + kk]; scr[kk * 33 + (lane & 31)] = v; }
    LDS_WAIT(); asm volatile("" ::: "memory");
    const int c = lane & 7;
#pragma unroll
    for (int j = 0; j < 4; ++j) { const int n = (lane >> 3) + 8 * j; const LAS float* s = scr + (8 * c) * 33 + n;
        v4u o; o.x = pk2(s[0 * 33], s[1 * 33]); o.y = pk2(s[2 * 33], s[3 * 33]); o.z = pk2(s[4 * 33], s[5 * 33]); o.w = pk2(s[6 * 33], s[7 * 33]);
        *(GAS v4u*)(WT + (size_t)(row_off + n0 + n) * K + k0 + 8 * c) = o; }
    LDS_WAIT(); asm volatile("" ::: "memory");
}
__device__ __forceinline__ void rms_row_to_bf16(const float* xrow, const float* g, bf16* orow, int lane) {
    const GAS f32x4* xr = (const GAS f32x4*)xrow + lane; const GAS f32x4* gr = (const GAS f32x4*)g + lane;
    f32x4 v[4]; float s = 0.f;
#pragma unroll
    for (int j = 0; j < 4; ++j) { v[j] = xr[64 * j]; s += (v[j].x * v[j].x + v[j].y * v[j].y) + (v[j].z * v[j].z + v[j].w * v[j].w); }
    const float r = 1.f / sqrtf(wave_sum(s) * (1.f / 1024.f) + RMS_EPS);
    GAS unsigned long long* o8 = (GAS unsigned long long*)orow + lane;
#pragma unroll
    for (int j = 0; j < 4; ++j) { const f32x4 gv = gr[64 * j];
        o8[64 * j] = (unsigned long long)pk2(v[j].x * r * gv.x, v[j].y * r * gv.y) | ((unsigned long long)pk2(v[j].z * r * gv.z, v[j].w * r * gv.w) << 32); }
}
__device__ __forceinline__ void cvt_row_to_bf16(const float* xrow, bf16* orow, int lane) {
    const GAS f32x4* xr = (const GAS f32x4*)xrow + lane; GAS unsigned long long* o8 = (GAS unsigned long long*)orow + lane;
    f32x4 v[4];
#pragma unroll
    for (int j = 0; j < 4; ++j) v[j] = xr[64 * j];
#pragma unroll
    for (int j = 0; j < 4; ++j) o8[64 * j] = (unsigned long long)pk2(v[j].x, v[j].y) | ((unsigned long long)pk2(v[j].z, v[j].w) << 32);
}
__device__ __forceinline__ int rel_bucket_dev(int d) {
    if (d < 16) return d;
    int b = 16;
    b += (d >= 21); b += (d >= 27); b += (d >= 35); b += (d >= 46); b += (d >= 59); b += (d >= 77); b += (d >= 99); b += (d >= 128);
    b += (d >= 166); b += (d >= 216); b += (d >= 280); b += (d >= 363); b += (d >= 470); b += (d >= 609); b += (d >= 790);
    return b;
}
struct P0Args { const float *x, *mem, *g_mix, *w_in, *rel_bias, *g_mem, *w_mem_kv, *w_br_attn, *w_br_conv, *w_br_x, *w_out, *g_ffn, *w_query, *sub_keys;
                bf16 *WinT, *WkvT, *WbrT, *WoutT, *WqT, *SK, *HN, *MEMN; float* TAB; };
__device__ __forceinline__ void p0_prologue(const P0Args& a, LAS unsigned char* lds, int gw, int NGW, int wave, int lane) {
    LAS float* scr = (LAS float*)(lds + RING_OFF + wave * 16384);
    constexpr int I_IN = (DM / 64) * (PW / 32), I_KV = (DM / 64) * (1024 / 32), I_BR = (512 / 64) * (1024 / 32), I_OUT = (DM / 64) * (1024 / 32), I_Q = (DM / 64) * (2048 / 32);
    constexpr int NITEMS = I_IN + I_KV + 3 * I_BR + I_OUT + I_Q;
    for (int it = gw; it < NITEMS; it += NGW) {
        int r = it;
        if (r < I_IN) { p0_transpose_item(a.w_in, DM, PW, a.WinT, 0, nullptr, scr, r, lane); continue; } r -= I_IN;
        if (r < I_KV) { p0_transpose_item(a.w_mem_kv, DM, 1024, a.WkvT, 0, nullptr, scr, r, lane); continue; } r -= I_KV;
        if (r < I_BR) { p0_transpose_item(a.w_br_attn, 512, 1024, a.WbrT, 0, nullptr, scr, r, lane); continue; } r -= I_BR;
        if (r < I_BR) { p0_transpose_item(a.w_br_conv, 512, 1024, a.WbrT, 1024, nullptr, scr, r, lane); continue; } r -= I_BR;
        if (r < I_BR) { p0_transpose_item(a.w_br_x, 512, 1024, a.WbrT, 2048, nullptr, scr, r, lane); continue; } r -= I_BR;
        if (r < I_OUT) { p0_transpose_item(a.w_out, DM, 1024, a.WoutT, 0, nullptr, scr, r, lane); continue; } r -= I_OUT;
        p0_transpose_item(a.w_query, DM, 2048, a.WqT, 0, a.g_ffn, scr, r, lane);
    }
    for (int m = gw; m < T; m += NGW) rms_row_to_bf16(a.x + (size_t)m * DM, a.g_mix, a.HN + (size_t)m * DM, lane);
    for (int m = gw; m < NBATCH * MEMLEN; m += NGW) rms_row_to_bf16(a.mem + (size_t)m * DM, a.g_mem, a.MEMN + (size_t)m * DM, lane);
    for (int m = gw; m < 256; m += NGW) cvt_row_to_bf16(a.sub_keys + (size_t)m * 1024, a.SK + (size_t)m * 1024, lane);
    for (int m = gw; m < 256; m += NGW) {
        const int idx = m * 64 + lane, h = idx >> 11, d = idx & 2047;
        a.TAB[idx] = a.rel_bias[rel_bucket_dev(d) * 8 + h] * LOG2E;
    }
}

template <int DH> __device__ __forceinline__ void fix_item(bf16* buf, size_t pitch, int row0, int col0, const float* gain, float gscale, float* kmean, int lane) {
    constexpr int LPR = DH / 8, RPI = 64 / LPR;
    const int sub = lane / LPR, ch = lane % LPR;
    float g[8], cs[8];
#pragma unroll
    for (int j = 0; j < 8; ++j) { g[j] = gain[ch * 8 + j] * gscale; cs[j] = 0.f; }
    for (int it = 0; it < 256 / RPI; ++it) {
        GAS v4u* p = (GAS v4u*)(buf + (size_t)(row0 + it * RPI + sub) * pitch + col0 + ch * 8);
        const v4u w = *p;
        float x[8] = {bflo(w.x), bfhi(w.x), bflo(w.y), bfhi(w.y), bflo(w.z), bfhi(w.z), bflo(w.w), bfhi(w.w)};
        float ss = 0.f;
#pragma unroll
        for (int j = 0; j < 8; ++j) ss += x[j] * x[j];
#pragma unroll
        for (int o = 1; o < LPR; o <<= 1) ss += __shfl_xor(ss, o);
        const float r = 1.f / sqrtf(ss * (1.f / DH) + RMS_EPS);
#pragma unroll
        for (int j = 0; j < 8; ++j) { x[j] = x[j] * r * g[j]; cs[j] += x[j]; }
        v4u o; o.x = pk2(x[0], x[1]); o.y = pk2(x[2], x[3]); o.z = pk2(x[4], x[5]); o.w = pk2(x[6], x[7]);
        *p = o;
    }
    if (kmean) {
#pragma unroll
        for (int j = 0; j < 8; ++j) {
#pragma unroll
            for (int o = LPR; o < 64; o <<= 1) cs[j] += __shfl_xor(cs[j], o);
        }
        if (sub == 0) {
#pragma unroll
            for (int j = 0; j < 8; ++j) kmean[ch * 8 + j] = cs[j] * (1.f / 256.f);
        }
    }
}
__device__ __forceinline__ void p2_fixup(bf16* PA, bf16* KVM, float* KMEAN, const float* q_gain_a, const float* k_gain_a, const float* q_gain_x, const float* k_gain_x, int gw, int NGW, int lane) {
    constexpr int N_A = 512, N_X = 256, N_KX = 32, NIT = 2 * N_A + N_X + N_KX;
    for (int it = gw; it < NIT; it += NGW) {
        int r = it;
        if (r < N_A) { const int b = r >> 6, h = (r >> 3) & 7, n = r & 7;
            fix_item<64>(PA, PAW, b * SEQ + n * 256, COL_KA + h * 64, k_gain_a, 1.0f, KMEAN + (size_t)((b * 8 + h) * 8 + n) * 64, lane); continue; } r -= N_A;
        if (r < N_A) { const int b = r >> 6, h = (r >> 3) & 7, n = r & 7;
            fix_item<64>(PA, PAW, b * SEQ + n * 256, COL_QA + h * 64, q_gain_a, C2A, nullptr, lane); continue; } r -= N_A;
        if (r < N_X) { const int b = r >> 5, h = (r >> 3) & 3, n = r & 7;
            fix_item<128>(PA, PAW, b * SEQ + n * 256, COL_QX + h * 128, q_gain_x, C2X, nullptr, lane); continue; } r -= N_X;
        { const int b = r >> 2, h = r & 3;
            fix_item<128>(KVM, 1024, b * MEMLEN, h * 128, k_gain_x, 1.0f, nullptr, lane); }
    }
}

namespace att {
constexpr int L_K = 0, L_V = 16384, L_TAB = 32768, TAB_PAD = 256, L_KM = L_TAB + (TAB_PAD + 2048) * 4  , L_SEL = L_KM + 2048  , L_WSF = L_SEL + 1024  ,
              L_OST = L_WSF + NWAVES * 256  , L_END = L_OST + NWAVES * 8192  ;
static_assert(L_END <= RING_BYTES, "attention LDS map");
__device__ __forceinline__ int crow(int r, int hi) { return (r & 3) + 8 * (r >> 2) + 4 * hi; }
__device__ __forceinline__ void glds16(const void* gsrc, unsigned lds_dst) { unsigned keep;
    asm volatile("s_mov_b32 %0, m0\n\ts_mov_b32 m0, %2\n\ts_nop 0\n\tglobal_load_lds_dwordx4 %1, off\n\ts_mov_b32 m0, %0" : "=&s"(keep) : "v"(gsrc), "s"(lds_dst) : "memory"); }
__device__ __forceinline__ unsigned cvtpk(float lo, float hi) { typedef float f2 __attribute__((ext_vector_type(2))); typedef __bf16 b2 __attribute__((ext_vector_type(2))); f2 v = {lo, hi}; b2 b = __builtin_convertvector(v, b2); return __builtin_bit_cast(unsigned, b); }
__device__ __forceinline__ float rowmax(const f32x16& p0, const f32x16& p1) {
    float a = fmaxf(p0[0], p1[0]);
#pragma unroll
    for (int r = 1; r < 16; ++r) a = fmaxf(a, fmaxf(p0[r], p1[r]));
    auto rr = __builtin_amdgcn_permlane32_swap(__float_as_uint(a), __float_as_uint(a), false, false);
    return fmaxf(__uint_as_float(rr[0]), __uint_as_float(rr[1]));
}
template <int ND0> __device__ __forceinline__ void qkt(f32x16& p0, f32x16& p1, const LAS unsigned char* Kslot, const bf16x8* qr, int r32, int hi) {
    const LAS unsigned char* kb = Kslot + hi * 1024 + r32 * 16;
    p0 = f32x16{}; p1 = f32x16{};
#pragma unroll
    for (int d0 = 0; d0 < ND0; ++d0) {
        const bf16x8 b0 = *(const LAS bf16x8*)(kb + d0 * 2048);
        const bf16x8 b1 = *(const LAS bf16x8*)(kb + d0 * 2048 + 512);
        p0 = __builtin_amdgcn_mfma_f32_32x32x16_bf16(b0, qr[d0], p0, 0, 0, 0);
        p1 = __builtin_amdgcn_mfma_f32_32x32x16_bf16(b1, qr[d0], p1, 0, 0, 0);
    }
}
template <int NDB> __device__ __forceinline__ void pv(f32x16* o, int vb, bf16x8 pa0, bf16x8 pa1, bf16x8 pa2, bf16x8 pa3) {
#pragma unroll
    for (int d0 = 0; d0 < NDB; ++d0) { s16x4 lo[4], hi[4];
#pragma unroll
        for (int ks = 0; ks < 4; ++ks) {
            asm volatile("ds_read_b64_tr_b16 %0,%1 offset:%c2" : "=&v"(lo[ks]) : "v"(vb), "i"(d0 * 4096 + ks * 1024) : "memory");
            asm volatile("ds_read_b64_tr_b16 %0,%1 offset:%c2" : "=&v"(hi[ks]) : "v"(vb), "i"(d0 * 4096 + ks * 1024 + 512) : "memory"); }
        asm volatile("s_waitcnt lgkmcnt(0)" ::: "memory"); __builtin_amdgcn_sched_barrier(0);
#define ATT_PK(k) (bf16x8){lo[k][0], lo[k][1], lo[k][2], lo[k][3], hi[k][0], hi[k][1], hi[k][2], hi[k][3]}
        o[d0] = __builtin_amdgcn_mfma_f32_32x32x16_bf16(pa0, ATT_PK(0), o[d0], 0, 0, 0);
        o[d0] = __builtin_amdgcn_mfma_f32_32x32x16_bf16(pa1, ATT_PK(1), o[d0], 0, 0, 0);
        o[d0] = __builtin_amdgcn_mfma_f32_32x32x16_bf16(pa2, ATT_PK(2), o[d0], 0, 0, 0);
        o[d0] = __builtin_amdgcn_mfma_f32_32x32x16_bf16(pa3, ATT_PK(3), o[d0], 0, 0, 0);
#undef ATT_PK
    }
}
#define ATT_BAR() asm volatile("s_waitcnt lgkmcnt(0)\n\ts_barrier" ::: "memory")
#define ATT_WAIT_BAR() asm volatile("s_waitcnt vmcnt(0) lgkmcnt(0)\n\ts_barrier" ::: "memory")

template <int DH, bool MOBA> __device__ __forceinline__ void attn_unit(const bf16* Qp, size_t qpitch, const bf16* Kp, const bf16* Vp, size_t kpitch, bf16* Op, int qb, const float* kmean_bh, const float* tab_h,
                                                                   LAS unsigned char* lds, int tid, int wid, int lane) {
    constexpr int ND0 = DH / 16, NDB = DH / 32, NPIECE = DH / 64;
    const int r32 = lane & 31, hi = lane >> 5;
    const unsigned lds0 = (unsigned)(uintptr_t)lds;
    LAS float* wsf = (LAS float*)(lds + L_WSF) + wid * 64;
    ATT_BAR();
    int my_sel = 0;
    if (MOBA) {
        LAS float* tl = (LAS float*)(lds + L_TAB);
        for (int i = tid; i < TAB_PAD + 2048; i += NWAVES * 64) tl[i] = (i < TAB_PAD) ? 0.f : tab_h[i - TAB_PAD];
        LAS float* km = (LAS float*)(lds + L_KM);
        for (int i = tid; i < 512; i += NWAVES * 64) km[i] = kmean_bh[i];
        ATT_BAR();
        if (tid < 256) {
            int sel = 0;
            if (qb <= 3) sel = (1 << qb) - 1;
            else {
                const GAS v4u* qrow = (const GAS v4u*)(Qp + (size_t)tid * qpitch);
                v4u qw[8];
#pragma unroll
                for (int c = 0; c < 8; ++c) qw[c] = qrow[c];
                float b1 = -INFINITY, b2 = -INFINITY, b3 = -INFINITY; int i1 = 0, i2 = 0, i3 = 0;
#pragma unroll 1
                for (int n = 0; n < qb; ++n) { float s = 0.f; const LAS f32x4* kr = (const LAS f32x4*)(km + n * 64);
#pragma unroll
                    for (int c = 0; c < 8; ++c) { const f32x4 ka = kr[2 * c], kb2 = kr[2 * c + 1]; const v4u w = qw[c];
                        s += bflo(w.x) * ka.x; s += bfhi(w.x) * ka.y; s += bflo(w.y) * ka.z; s += bfhi(w.y) * ka.w;
                        s += bflo(w.z) * kb2.x; s += bfhi(w.z) * kb2.y; s += bflo(w.w) * kb2.z; s += bfhi(w.w) * kb2.w; }
                    if (s > b1) { b3 = b2; i3 = i2; b2 = b1; i2 = i1; b1 = s; i1 = n; }
                    else if (s > b2) { b3 = b2; i3 = i2; b2 = s; i2 = n; }
                    else if (s > b3) { b3 = s; i3 = n; } }
                sel = (1 << i1) | (1 << i2) | (1 << i3);
            }
            ((LAS int*)(lds + L_SEL))[tid] = sel;
        }
        ATT_BAR();
        my_sel = ((LAS int*)(lds + L_SEL))[wid * 32 + r32];
    }
    bf16x8 qr[ND0];
    { const bf16* Qw = Qp + (size_t)(wid * 32 + r32) * qpitch + hi * 8;
#pragma unroll
      for (int d0 = 0; d0 < ND0; ++d0) qr[d0] = *(const GAS bf16x8*)(Qw + d0 * 16); }
    float m_run = -INFINITY, l_run = 0.f;
    f32x16 o[NDB];
#pragma unroll
    for (int d = 0; d < NDB; ++d) o[d] = f32x16{};
    const int vb0 = (int)(lds0 + L_V) + ((lane >> 4) & 1) * 32 + (lane & 3) * 8 + (4 * hi + ((lane & 15) >> 2)) * 64;
    const int qrel = wid * 32 + r32;
    const int ntiles = MOBA ? 4 + 4 * qb : 4;
    for (int tt = 0; tt < ntiles; ++tt) {
        int kb, j; bool own;
        if (MOBA) { if (tt < 4) { kb = qb; j = tt; own = true; } else { kb = (tt - 4) >> 2; j = (tt - 4) & 3; own = false; } }
        else { kb = 0; j = tt; own = false; }
        const int key0 = kb * 256 + j * 64;
        ATT_BAR();
#pragma unroll
        for (int pc = 0; pc < NPIECE; ++pc) { const int p = wid + 8 * pc;
            glds16(Kp + (size_t)(key0 + lane) * kpitch + p * 8, (unsigned)__builtin_amdgcn_readfirstlane(lds0 + L_K + p * 1024));
            glds16(Vp + (size_t)(key0 + 16 * (p & 3) + (lane >> 2)) * kpitch + (p >> 2) * 32 + (lane & 3) * 8, (unsigned)__builtin_amdgcn_readfirstlane(lds0 + L_V + p * 1024)); }
        ATT_WAIT_BAR();
        if (MOBA && own && 64 * j > wid * 32 + 31) continue;
        f32x16 p0, p1;
        qkt<ND0>(p0, p1, lds + L_K, qr, r32, hi);
        if (MOBA) {
            const int dbase = (qb - kb) * 256 + qrel - 64 * j - 4 * hi;
            const LAS float* tp = (const LAS float*)(lds + L_TAB) + TAB_PAD + dbase - 63;
            const bool lane_ok = own ? true : (((my_sel >> kb) & 1) != 0);
#pragma unroll
            for (int r = 0; r < 16; ++r) { const int c = (r & 3) + 8 * (r >> 2);
                const bool v0 = own ? (dbase - c >= 0) : lane_ok, v1 = own ? (dbase - c - 32 >= 0) : lane_ok;
                p0[r] = v0 ? p0[r] + tp[63 - c] : -INFINITY; p1[r] = v1 ? p1[r] + tp[31 - c] : -INFINITY; }
        }
        const float rm = rowmax(p0, p1);
        const float m_new = fmaxf(m_run, rm);
        const float alpha = __builtin_amdgcn_exp2f(m_run - m_new);
        float ps = 0.f;
#pragma unroll
        for (int r = 0; r < 16; ++r) { p0[r] = __builtin_amdgcn_exp2f(p0[r] - m_new); p1[r] = __builtin_amdgcn_exp2f(p1[r] - m_new); ps += p0[r] + p1[r]; }
        l_run = l_run * alpha + ps;
        if (!__all(m_new == m_run)) {
            if (hi == 0) wsf[r32] = alpha;
            LDS_WAIT();
#pragma unroll
            for (int r = 0; r < 16; ++r) { const float f = wsf[crow(r, hi)];
#pragma unroll
                for (int d = 0; d < NDB; ++d) o[d][r] *= f; }
        }
        m_run = m_new;
        v4u pw0, pw1, pw2, pw3;
        pw0 = (v4u){cvtpk(p0[0], p0[1]), cvtpk(p0[2], p0[3]), cvtpk(p0[4], p0[5]), cvtpk(p0[6], p0[7])};
        pw1 = (v4u){cvtpk(p0[8], p0[9]), cvtpk(p0[10], p0[11]), cvtpk(p0[12], p0[13]), cvtpk(p0[14], p0[15])};
        pw2 = (v4u){cvtpk(p1[0], p1[1]), cvtpk(p1[2], p1[3]), cvtpk(p1[4], p1[5]), cvtpk(p1[6], p1[7])};
        pw3 = (v4u){cvtpk(p1[8], p1[9]), cvtpk(p1[10], p1[11]), cvtpk(p1[12], p1[13]), cvtpk(p1[14], p1[15])};
        pv<NDB>(o, vb0, __builtin_bit_cast(bf16x8, pw0), __builtin_bit_cast(bf16x8, pw1), __builtin_bit_cast(bf16x8, pw2), __builtin_bit_cast(bf16x8, pw3));
    }
    { auto rr = __builtin_amdgcn_permlane32_swap(__float_as_uint(l_run), __float_as_uint(l_run), false, false); l_run = __uint_as_float(rr[0]) + __uint_as_float(rr[1]); }
    if (hi == 0) wsf[32 + r32] = l_run;
    LDS_WAIT();
    LAS bf16* stg = (LAS bf16*)(lds + L_OST + wid * 8192);
#pragma unroll
    for (int r = 0; r < 16; ++r) { const int orow = crow(r, hi); const float rl = __builtin_amdgcn_rcpf(wsf[32 + orow]);
#pragma unroll
        for (int d = 0; d < NDB; ++d) stg[orow * DH + d * 32 + r32] = (bf16)f2bf(o[d][r] * rl); }
    LDS_WAIT();
    constexpr int CPR = DH / 8;
    int lane2 = lane; asm volatile("" : "+v"(lane2));
#pragma unroll
    for (int i = 0; i < (32 * CPR) / 64; ++i) { const int idx = i * 64 + lane2, row = idx / CPR, ch = idx % CPR;
        const v4u v = *(const LAS v4u*)(stg + row * DH + ch * 8);
        *(GAS v4u*)(Op + (size_t)(wid * 32 + row) * 512 + ch * 8) = v; }
}
#undef ATT_BAR
#undef ATT_WAIT_BAR
}

__device__ __forceinline__ void conv_item(const bf16* PA, const float* conv_w, bf16* CO, int item, int tid) {
    const int ch = (tid & 63) * 8, r0 = item * 64 + (tid >> 6) * 8;
    float w0[8], w1[8], w2[8];
#pragma unroll
    for (int j = 0; j < 8; ++j) { w0[j] = conv_w[ch + j]; w1[j] = conv_w[512 + ch + j]; w2[j] = conv_w[1024 + ch + j]; }
    float pm2[8], pm1[8];
#pragma unroll
    for (int j = 0; j < 8; ++j) { pm2[j] = 0.f; pm1[j] = 0.f; }
    auto load8 = [&](int row, int col, float* o) { const v4u w = *(const GAS v4u*)(PA + (size_t)row * PAW + col + ch);
        o[0] = bflo(w.x); o[1] = bfhi(w.x); o[2] = bflo(w.y); o[3] = bfhi(w.y); o[4] = bflo(w.z); o[5] = bfhi(w.z); o[6] = bflo(w.w); o[7] = bfhi(w.w); };
    const int s0 = r0 & (SEQ - 1);
    if (s0 >= 2) { float a[8], b[8]; load8(r0 - 2, COL_CC, a); load8(r0 - 2, COL_UC, b);
#pragma unroll
        for (int j = 0; j < 8; ++j) pm2[j] = a[j] * b[j]; }
    if (s0 >= 1) { float a[8], b[8]; load8(r0 - 1, COL_CC, a); load8(r0 - 1, COL_UC, b);
#pragma unroll
        for (int j = 0; j < 8; ++j) pm1[j] = a[j] * b[j]; }
#pragma unroll
    for (int i = 0; i < 8; ++i) { const int row = r0 + i; float c[8], u[8], bb[8], y[8];
        load8(row, COL_CC, c); load8(row, COL_UC, u); load8(row, COL_BC, bb);
#pragma unroll
        for (int j = 0; j < 8; ++j) { const float cur = c[j] * u[j]; y[j] = bb[j] * (w0[j] * pm2[j] + w1[j] * pm1[j] + w2[j] * cur); pm2[j] = pm1[j]; pm1[j] = cur; }
        v4u o; o.x = pk2(y[0], y[1]); o.y = pk2(y[2], y[3]); o.z = pk2(y[4], y[5]); o.w = pk2(y[6], y[7]);
        *(GAS v4u*)(CO + (size_t)row * 512 + ch) = o; }
}

namespace pk {
template <int N> __device__ __forceinline__ void bsort_desc(unsigned (&a)[N]) {
#pragma unroll
    for (int k = 2; k <= N; k <<= 1) {
#pragma unroll
        for (int j = k >> 1; j > 0; j >>= 1) {
#pragma unroll
            for (int i = 0; i < N; ++i) { const int l = i ^ j;
                if (l > i) { const unsigned x = a[i], y = a[l]; const unsigned mx = x > y ? x : y, mn = x > y ? y : x;
                    if ((i & k) == 0) { a[i] = mx; a[l] = mn; } else { a[i] = mn; a[l] = mx; } } } } }
}
template <int N> __device__ __forceinline__ void bmerge_desc(unsigned (&a)[N]) {
#pragma unroll
    for (int j = N >> 1; j > 0; j >>= 1) {
#pragma unroll
        for (int i = 0; i < N; ++i) { const int l = i ^ j; if (l > i) { const unsigned x = a[i], y = a[l]; a[i] = x > y ? x : y; a[l] = x > y ? y : x; } } }
}
__device__ __forceinline__ void top16_merge(unsigned (&x)[16], const unsigned (&y)[16]) {
#pragma unroll
    for (int i = 0; i < 16; ++i) x[i] = x[i] > y[15 - i] ? x[i] : y[15 - i];
    bmerge_desc<16>(x);
}
__device__ __forceinline__ unsigned f2ord(float f) { const unsigned u = __float_as_uint(f); return u ^ ((unsigned)((int)u >> 31) | 0x80000000u); }
__device__ __forceinline__ float ord2f(unsigned o) { return __uint_as_float(o ^ ((o & 0x80000000u) ? 0x80000000u : 0xFFFFFFFFu)); }

constexpr int L_TBL = 0;
__device__ __forceinline__ void topk_unit(const bf16* QRY, const bf16* SK, const float* SLOTS, unsigned* SEL, LAS unsigned char* lds, int v, int tid, int wid, int lane) {
    const int hp = v & 3, t0 = ((v >> 2) * 8 + wid) * 32, r32 = lane & 31, hi = lane >> 5;
    for (int tb = 0; tb < 4; ++tb) { const bf16* src = SK + (size_t)(((2 * hp + (tb >> 1)) * 2 + (tb & 1)) * 128) * 128;
        for (int idx = tid; idx < 2048; idx += NWAVES * 64) { const int key = idx >> 4, c16 = idx & 15;
            const v4u w = *(const GAS v4u*)(src + key * 128 + c16 * 8);
            *(LAS v4u*)(lds + L_TBL + tb * 32768 + (c16 * 4 + (key >> 5)) * 512 + (key & 31) * 16) = w; } }
    asm volatile("s_waitcnt vmcnt(0) lgkmcnt(0)\n\ts_barrier" ::: "memory");
    const int tok = t0 + r32;
    float rn; { const GAS f32x4* sl = (const GAS f32x4*)(SLOTS + (size_t)tok * 16); const f32x4 a = sl[0], b = sl[1], c = sl[2], d = sl[3];
        const float ss = ((a.x + a.y) + (a.z + a.w)) + ((b.x + b.y) + (b.z + b.w)) + ((c.x + c.y) + (c.z + c.w)) + ((d.x + d.y) + (d.z + d.w));
        rn = 1.f / sqrtf(ss * (1.f / 1024.f) + RMS_EPS); }
    unsigned L[4][16];
#pragma unroll
    for (int tb = 0; tb < 4; ++tb) {
        const int hh = tb >> 1, p = tb & 1;
        const bf16* qp = QRY + (size_t)tok * 2048 + ((2 * hp + hh) * 2 + p) * 128 + hi * 8;
        bf16x8 qf[8];
#pragma unroll
        for (int kk = 0; kk < 8; ++kk) qf[kk] = *(const GAS bf16x8*)(qp + kk * 16);
        f32x16 acc[4];
#pragma unroll
        for (int blk = 0; blk < 4; ++blk) acc[blk] = f32x16{};
        const LAS unsigned char* tbase = lds + L_TBL + tb * 32768 + hi * 2048 + r32 * 16;
#pragma unroll
        for (int kk = 0; kk < 8; ++kk)
#pragma unroll
            for (int blk = 0; blk < 4; ++blk) { const bf16x8 af = *(const LAS bf16x8*)(tbase + kk * 4096 + blk * 512);
                acc[blk] = __builtin_amdgcn_mfma_f32_32x32x16_bf16(af, qf[kk], acc[blk], 0, 0, 0); }
        unsigned g[4][16];
#pragma unroll
        for (int blk = 0; blk < 4; ++blk)
#pragma unroll
            for (int r = 0; r < 16; ++r) g[blk][r] = (f2ord(acc[blk][r]) & ~127u) | (unsigned)(127 - (32 * blk + (r & 3) + 8 * (r >> 2)));
#pragma unroll
        for (int blk = 0; blk < 4; ++blk) bsort_desc<16>(g[blk]);
        top16_merge(g[0], g[1]); top16_merge(g[2], g[3]); top16_merge(g[0], g[2]);
#pragma unroll
        for (int i = 0; i < 16; ++i) L[tb][i] = g[0][i] ^ (unsigned)(4 * hi);
    }
    unsigned A[2][16];
#pragma unroll
    for (int p = 0; p < 2; ++p) {
        unsigned X[16], Y[16];
#pragma unroll
        for (int i = 0; i < 16; ++i) { auto rr = __builtin_amdgcn_permlane32_swap(L[p][i], L[2 + p][i], false, false); X[i] = rr[0]; Y[i] = rr[1]; }
        top16_merge(X, Y);
#pragma unroll
        for (int i = 0; i < 16; ++i) A[p][i] = X[i];
    }
    float f0[16], f1[16];
#pragma unroll
    for (int i = 0; i < 16; ++i) { f0[i] = ord2f(A[0][i] & ~127u); f1[i] = ord2f(A[1][i] & ~127u); }
    float sums[50]; unsigned keys[50];
    { int c = 0;
#pragma unroll
      for (int i = 0; i < 16; ++i)
#pragma unroll
          for (int j = 0; j < 16; ++j) if ((i + 1) * (j + 1) <= 16) { sums[c] = f0[i] + f1[j]; keys[c] = (f2ord(sums[c]) & ~63u) | (unsigned)(63 - c); ++c; } }
    unsigned G0[16], R[32];
#pragma unroll
    for (int i = 0; i < 16; ++i) G0[i] = keys[i];
#pragma unroll
    for (int i = 0; i < 32; ++i) R[i] = (i < 26) ? keys[24 + i] : 0u;
    bsort_desc<32>(R);
#pragma unroll
    for (int i = 0; i < 16; ++i) G0[i] = G0[i] > R[15 - i] ? G0[i] : R[15 - i];
    bmerge_desc<16>(G0);
#pragma unroll
    for (int i = 8; i < 16; ++i) G0[i] = G0[i] > keys[16 + 15 - i] ? G0[i] : keys[16 + 15 - i];
    unsigned thr = G0[0];
#pragma unroll
    for (int i = 1; i < 16; ++i) thr = thr < G0[i] ? thr : G0[i];
    const float s00 = sums[0], sc = rn * LOG2E;
    float w[50]; float den = 0.f;
#pragma unroll
    for (int c = 0; c < 50; ++c) { w[c] = (keys[c] >= thr) ? __builtin_amdgcn_exp2f((sums[c] - s00) * sc) : 0.f; den += w[c]; }
    const float inv = 1.f / den;
    unsigned i0[16], i1[16];
#pragma unroll
    for (int i = 0; i < 16; ++i) { i0[i] = 127u - (A[0][i] & 127u); i1[i] = 127u - (A[1][i] & 127u); }
    GAS unsigned* outp = (GAS unsigned*)(SEL + ((size_t)tok * 8 + 2 * hp + hi) * 16);
    int pos = 0;
    { int c = 0;
#pragma unroll
      for (int i = 0; i < 16; ++i)
#pragma unroll
          for (int j = 0; j < 16; ++j) if ((i + 1) * (j + 1) <= 16) { if (keys[c] >= thr) { outp[pos & 15] = ((i0[i] * 128u + i1[j]) << 16) | f2bf(w[c] * inv); ++pos; } ++c; } }
}
}

template <bool OFFSET> __device__ __forceinline__ void quant_row(const float* xrow, unsigned char* qrow, float* scale, int lane) {
    const GAS f32x4* xr = (const GAS f32x4*)xrow + 4 * lane; f32x4 v[4]; float am = 0.f;
#pragma unroll
    for (int j = 0; j < 4; ++j) { v[j] = xr[j]; am = fmaxf(am, fmaxf(fmaxf(fabsf(v[j].x), fabsf(v[j].y)), fmaxf(fabsf(v[j].z), fabsf(v[j].w)))); }
#pragma unroll
    for (int o = 1; o < 64; o <<= 1) am = fmaxf(am, __shfl_xor(am, o));
    const float s = am > 0.f ? am * (1.f / 127.f) : 1.f, is = 1.f / s;
    v4u o;
#pragma unroll
    for (int j = 0; j < 4; ++j) { const int a = (int)rintf(v[j].x * is), b = (int)rintf(v[j].y * is), c = (int)rintf(v[j].z * is), d = (int)rintf(v[j].w * is);
        const int off = OFFSET ? 128 : 0;
        o[j] = (unsigned)((a + off) & 0xff) | ((unsigned)((b + off) & 0xff) << 8) | ((unsigned)((c + off) & 0xff) << 16) | ((unsigned)((d + off) & 0xff) << 24); }
    *((GAS v4u*)qrow + lane) = o;
    if (lane == 0) *scale = s;
}
__device__ __forceinline__ float gelu_exact(float x) { return 0.5f * x * (1.0f + erff(x * 0.70710678118654752f)); }
__device__ __forceinline__ void gather_token(const float* H, float* OUTP, const unsigned* SEL, const unsigned char* UQ, const unsigned char* VQ, const float* SU, const float* SV, const float (&gf)[16], int t, int lane) {
    const GAS f32x4* hrow = (const GAS f32x4*)(H + (size_t)t * DM) + 4 * lane; GAS f32x4* orow = (GAS f32x4*)(OUTP + (size_t)t * DM) + 4 * lane;
    f32x4 hv[4];
#pragma unroll
    for (int j = 0; j < 4; ++j) hv[j] = hrow[j];
    float ss = 0.f;
#pragma unroll
    for (int j = 0; j < 4; ++j) ss += (hv[j].x * hv[j].x + hv[j].y * hv[j].y) + (hv[j].z * hv[j].z + hv[j].w * hv[j].w);
    const float rn = 1.f / sqrtf(wave_sum(ss) * (1.f / 1024.f) + RMS_EPS);
    float xn[16]; float am = 0.f;
#pragma unroll
    for (int j = 0; j < 4; ++j)
#pragma unroll
        for (int e = 0; e < 4; ++e) { xn[4 * j + e] = hv[j][e] * rn * gf[4 * j + e]; am = fmaxf(am, fabsf(xn[4 * j + e])); }
#pragma unroll
    for (int o = 1; o < 64; o <<= 1) am = fmaxf(am, __shfl_xor(am, o));
    const float sx = am > 0.f ? am * (1.f / 127.f) : 1.f, isx = 1.f / sx;
    int xq[4];
#pragma unroll
    for (int j = 0; j < 4; ++j) { const int a = (int)rintf(xn[4 * j] * isx), b = (int)rintf(xn[4 * j + 1] * isx), c = (int)rintf(xn[4 * j + 2] * isx), d = (int)rintf(xn[4 * j + 3] * isx);
        xq[j] = (int)((unsigned)(a & 0xff) | ((unsigned)(b & 0xff) << 8) | ((unsigned)(c & 0xff) << 16) | ((unsigned)(d & 0xff) << 24)); }
    const v2u ent = *(const GAS v2u*)(SEL + (size_t)t * 128 + 2 * lane);
    float out[16];
#pragma unroll
    for (int j = 0; j < 16; ++j) out[j] = 0.f;
    float csum = 0.f;
    const int b0 = lane & 1, b1 = (lane >> 1) & 1, b2 = (lane >> 2) & 1;
    const int kmine = b0 * 4 + b1 * 2 + b2;
    for (int gi = 0; gi < 16; ++gi) {
        v4u uw[8], vw[8];
#pragma unroll
        for (int k = 0; k < 8; ++k) {
            const unsigned ev = (unsigned)__builtin_amdgcn_readlane((int)((k & 1) ? ent.y : ent.x), gi * 4 + (k >> 1));
            const unsigned e = ev >> 16;
            uw[k] = *((const GAS v4u*)(UQ + (size_t)e * DM) + lane); vw[k] = *((const GAS v4u*)(VQ + (size_t)e * DM) + lane);
        }
        const int src = gi * 4 + (kmine >> 1);
        const unsigned ex = (unsigned)__shfl((int)ent.x, src), ey = (unsigned)__shfl((int)ent.y, src);
        const unsigned em = (kmine & 1) ? ey : ex;
        const float su = *(const GAS float*)(SU + (em >> 16)), sv = *(const GAS float*)(SV + (em >> 16));
        int part[8];
#pragma unroll
        for (int k = 0; k < 8; ++k) { int a = __builtin_amdgcn_sdot4((int)uw[k].x, xq[0], 0, false); a = __builtin_amdgcn_sdot4((int)uw[k].y, xq[1], a, false);
            a = __builtin_amdgcn_sdot4((int)uw[k].z, xq[2], a, false); part[k] = __builtin_amdgcn_sdot4((int)uw[k].w, xq[3], a, false); }
        int q4[4], q2[2], tot;
#pragma unroll
        for (int i = 0; i < 4; ++i) { const int keep = b0 ? part[i + 4] : part[i], send = b0 ? part[i] : part[i + 4]; q4[i] = keep + __shfl_xor(send, 1); }
#pragma unroll
        for (int i = 0; i < 2; ++i) { const int keep = b1 ? q4[i + 2] : q4[i], send = b1 ? q4[i] : q4[i + 2]; q2[i] = keep + __shfl_xor(send, 2); }
        { const int keep = b2 ? q2[1] : q2[0], send = b2 ? q2[0] : q2[1]; tot = keep + __shfl_xor(send, 4); }
        tot += __shfl_xor(tot, 8); tot += __shfl_xor(tot, 16); tot += __shfl_xor(tot, 32);
        const float coef = bflo(em) * gelu_exact((float)tot * (su * sx)) * sv;
#pragma unroll
        for (int k = 0; k < 8; ++k) {
            const int srcl = ((k >> 2) & 1) | (((k >> 1) & 1) << 1) | ((k & 1) << 2);
            const float c = __uint_as_float((unsigned)__builtin_amdgcn_readlane((int)__float_as_uint(coef), srcl));
            csum += c;
#pragma unroll
            for (int j = 0; j < 4; ++j) { const unsigned wv = vw[k][j];
                out[4 * j + 0] += c * (float)(wv & 0xffu); out[4 * j + 1] += c * (float)((wv >> 8) & 0xffu); out[4 * j + 2] += c * (float)((wv >> 16) & 0xffu); out[4 * j + 3] += c * (float)(wv >> 24); }
        }
    }
    const float corr = -128.f * csum;
#pragma unroll
    for (int j = 0; j < 4; ++j) { hv[j] += (f32x4){out[4 * j] + corr, out[4 * j + 1] + corr, out[4 * j + 2] + corr, out[4 * j + 3] + corr}; orow[j] = hv[j]; }
}

#ifndef MK_SPLIT
#define MK_SPLIT 0
#endif
constexpr int NPHASE = 9;
#ifndef PROBE_PH
#define PROBE_PH -1
#endif
#ifndef PROBE_N
#define PROBE_N 1
#endif
#define REPS(k) (((k) == PROBE_PH) ? 1 + PROBE_N : 1)
struct Args { const float* in[21]; float* out; unsigned char* ws; int ph_lo, ph_hi; };
static_assert(sizeof(Args) == 23 * 8 + 8, "Args has no padding");

__global__ void __launch_bounds__(NWAVES * 64, 2) fwd(Args args) {
    extern __shared__ __attribute__((aligned(16))) unsigned char lds_raw[];
    LAS unsigned char* lds = (LAS unsigned char*)lds_raw;
    volatile LAS unsigned* MISC = (volatile LAS unsigned*)(lds + MISC_OFF);
    const int tid = threadIdx.x, lane = tid & 63, wave = __builtin_amdgcn_readfirstlane(tid >> 6);
    const int G = gridDim.x; const int bx = blockIdx.x; const int vcu = (G % 8 == 0) ? (bx % 8) * (G / 8) + bx / 8 : bx;
    const int gw = vcu * NWAVES + wave, NGW = G * NWAVES;
    unsigned char* ws = args.ws;
    gu32* ctl = (gu32*)(ws + WS_CTL);
    const float* x = args.in[0]; const float* mem = args.in[1]; const float* g_mix = args.in[2]; const float* w_in = args.in[3]; const float* q_gain_a = args.in[4]; const float* k_gain_a = args.in[5];
    const float* rel_bias = args.in[6]; const float* conv_w = args.in[7]; const float* g_mem = args.in[8]; const float* w_mem_kv = args.in[9]; const float* q_gain_x = args.in[10]; const float* k_gain_x = args.in[11];
    const float* w_br_attn = args.in[12]; const float* w_br_conv = args.in[13]; const float* w_br_x = args.in[14]; const float* w_out = args.in[15]; const float* g_ffn = args.in[16];
    const float* w_query = args.in[17]; const float* sub_keys = args.in[18]; const float* peer_u = args.in[19]; const float* peer_v = args.in[20];
    float* out = args.out;
    bf16* WinT = (bf16*)(ws + WS_WIN); bf16* WkvT = (bf16*)(ws + WS_WKV); bf16* WbrT = (bf16*)(ws + WS_WBR); bf16* WoutT = (bf16*)(ws + WS_WOUT); bf16* WqT = (bf16*)(ws + WS_WQ);
    bf16* SK = (bf16*)(ws + WS_SK); float* TAB = (float*)(ws + WS_TAB); float* KMEAN = (float*)(ws + WS_KMEAN); bf16* MEMN = (bf16*)(ws + WS_MEMN); bf16* KVM = (bf16*)(ws + WS_KVM);
    float* SLOTS = (float*)(ws + WS_SLOTS); unsigned* SEL = (unsigned*)(ws + WS_SEL);
    bf16* PA = (bf16*)(ws + WS_PA); bf16* PG = (bf16*)(ws + WS_PG);
    bf16* MERGED = (bf16*)(ws + PA_MERGED); bf16* HB = (bf16*)(ws + PA_HB); unsigned char* UQ = ws + PA_UT; unsigned char* VQ = ws + PA_VT; float* SU = (float*)(ws + WS_SU); float* SV = (float*)(ws + WS_SV); bf16* QRY = (bf16*)(ws + PG_QRY);
    bf16* HN = (bf16*)out;
    bf16* BRO = (bf16*)out;

    for (int u = tid; u < (LDS_BYTES - LDSCTL_OFF) / 4; u += NWAVES * 64) ((LAS unsigned*)(lds + LDSCTL_OFF))[u] = 0u;
    __syncthreads();
#if !MK_SPLIT
    XcdBarrier bar = xcd_barrier_post((unsigned*)(ctl + CW_BAR), MISC + 8);
#define GRID_BAR() xcd_barrier(bar)
#else
#define GRID_BAR() do {} while (0)
#endif
    const int lo = args.ph_lo, hi_ = args.ph_hi;
#ifndef PH_MASK
#define PH_MASK 0x1ff
#endif
#define IN(k) ((((PH_MASK) >> (k)) & 1) && lo <= (k) && (k) < hi_)
#define BOTH(k) (IN(k) && IN((k) + 1))

    if (IN(0)) {
        P0Args a{x, mem, g_mix, w_in, rel_bias, g_mem, w_mem_kv, w_br_attn, w_br_conv, w_br_x, w_out, g_ffn, w_query, sub_keys, WinT, WkvT, WbrT, WoutT, WqT, SK, HN, MEMN, TAB};
        p0_prologue(a, lds, gw, NGW, wave, lane);
        if (BOTH(0)) GRID_BAR();
    }
    if (IN(1)) for (int rep = 0; rep < REPS(1); ++rep) {
        { pg8::Gemm g{HN, WinT, T, PW, DM}; pg8::GOrder S; S.init(T, PW, G, bx); pg8::EpiProj E{PA, PG};
          pg8::gemm_phase<pg8::EpiProj, pg8::GOrder, true, true>(lds + RING_OFF, g, S, E); }
        { const int nfull = (64 * 26) % G; const int coff = (nfull + 32 <= G) ? bx - nfull : bx;
          pg8::Gemm g{MEMN, WkvT, NBATCH * MEMLEN, 1024, DM}; pg8::GOrder S; S.init(NBATCH * MEMLEN, 1024, G, coff); pg8::EpiBf16<0> E{KVM, 1024, nullptr, 0, 0, 1.f};
          pg8::gemm_phase<pg8::EpiBf16<0>, pg8::GOrder, true, true>(lds + RING_OFF, g, S, E); }
        if (BOTH(1) && rep == REPS(1) - 1) GRID_BAR();
    }
    if (IN(2)) {
        p2_fixup(PA, KVM, KMEAN, q_gain_a, k_gain_a, q_gain_x, k_gain_x, gw, NGW, lane);
        if (BOTH(2)) GRID_BAR();
    }
    if (IN(3)) for (int rep = 0; rep < REPS(3); ++rep) {
        for (int v = vcu; v < 256; v += G) {
            const int bh = v >> 2, b = bh >> 3, h = bh & 7, s = v & 3;
#pragma unroll 1
            for (int pass = 0; pass < 2; ++pass) { const int qb = pass ? 7 - s : s;
                const bf16* Qp = PA + (size_t)(b * SEQ + qb * 256) * PAW + COL_QA + h * 64;
                const bf16* Kp = PA + (size_t)(b * SEQ) * PAW + COL_KA + h * 64; const bf16* Vp = PA + (size_t)(b * SEQ) * PAW + COL_VA + h * 64;
                bf16* Op = BRO + (size_t)(b * SEQ + qb * 256) * 512 + h * 64;
                att::attn_unit<64, true>(Qp, PAW, Kp, Vp, PAW, Op, qb, KMEAN + (size_t)bh * 512, TAB + h * 2048, lds + RING_OFF, tid, wave, lane); }
            { const int bb = v >> 5, hx = (v >> 3) & 3, qt = v & 7;
                const bf16* Qp = PA + (size_t)(bb * SEQ + qt * 256) * PAW + COL_QX + hx * 128;
                const bf16* Kp = KVM + (size_t)(bb * MEMLEN) * 1024 + hx * 128; const bf16* Vp = Kp + 512;
                bf16* Op = BRO + (size_t)2 * T * 512 + (size_t)(bb * SEQ + qt * 256) * 512 + hx * 128;
                att::attn_unit<128, false>(Qp, PAW, Kp, Vp, 1024, Op, 0, nullptr, nullptr, lds + RING_OFF, tid, wave, lane); }
            conv_item(PA, conv_w, BRO + (size_t)T * 512, v, tid);
        }
        if (BOTH(3) && rep == REPS(3) - 1) GRID_BAR();
    }
    if (IN(4)) {
        pg8::Gemm g{BRO, WbrT, 3 * T, 3 * 1024, 512}; pg8::BranchOrder S; S.init(G, bx); pg8::EpiBranch E{PG, MERGED};
        pg8::gemm_phase<pg8::EpiBranch, pg8::BranchOrder, true, true>(lds + RING_OFF, g, S, E);
        if (BOTH(4)) GRID_BAR();
    }
    if (IN(5)) {
        pg8::Gemm g{MERGED, WoutT, T, 1024, DM}; pg8::GOrder S; S.init(T, 1024, G, bx); pg8::EpiWout E{x, out, HB, SLOTS};
        pg8::gemm_phase<pg8::EpiWout, pg8::GOrder, true, true>(lds + RING_OFF, g, S, E);
        if (BOTH(5)) GRID_BAR();
    }
    if (IN(6)) {
        pg8::Gemm g{HB, WqT, T, 2048, DM}; pg8::GOrder S; S.init(T, 2048, G, bx); pg8::EpiBf16<0> E{QRY, 2048, nullptr, 0, 0, 1.f};
        pg8::gemm_phase<pg8::EpiBf16<0>, pg8::GOrder, true, true>(lds + RING_OFF, g, S, E);
        if (BOTH(6)) GRID_BAR();
    }
    if (IN(7)) for (int rep = 0; rep < REPS(7); ++rep) {
        for (int v = vcu; v < 256; v += G) { pk::topk_unit(QRY, SK, SLOTS, SEL, lds + RING_OFF, v, tid, wave, lane); __syncthreads(); }
        for (int m = gw; m < 2 * NEXP; m += NGW) { if (m < NEXP) quant_row<false>(peer_u + (size_t)m * DM, UQ + (size_t)m * DM, SU + m, lane); else quant_row<true>(peer_v + (size_t)(m - NEXP) * DM, VQ + (size_t)(m - NEXP) * DM, SV + (m - NEXP), lane); }
        if (BOTH(7) && rep == REPS(7) - 1) GRID_BAR();
    }
    if (IN(8)) {
        float gf[16];
#pragma unroll
        for (int j = 0; j < 4; ++j)
#pragma unroll
            for (int e = 0; e < 4; ++e) gf[4 * j + e] = g_ffn[16 * lane + 4 * j + e];
        for (int rep = 0; rep < REPS(8); ++rep) { float* dst = (rep == REPS(8) - 1) ? out : (float*)QRY;
            for (int t = gw; t < T; t += NGW) gather_token(out, dst, SEL, UQ, VQ, SU, SV, gf, t, lane); }
    }
#undef IN
#undef BOTH
}

extern "C" void kernel_launch(void* const* d_in, const int* in_sizes, int n_in, void* d_out, int out_size, void* d_ws, size_t ws_size, hipStream_t stream) {
    static int grid = 0;
    if (grid == 0) {
        if (n_in != 21 || out_size != T * DM || ws_size < WS_END) { fprintf(stderr, "kernel_launch: unexpected shapes (n_in %d, out %d, ws %zu)\n", n_in, out_size, ws_size); grid = -1; return; }
        int dev = 0, cus = 0, per_cu = 0;
        if (hipGetDevice(&dev) != hipSuccess || hipDeviceGetAttribute(&cus, hipDeviceAttributeMultiprocessorCount, dev) != hipSuccess) { grid = -1; return; }
        if (hipFuncSetAttribute((const void*)fwd, hipFuncAttributeMaxDynamicSharedMemorySize, LDS_BYTES) != hipSuccess) { fprintf(stderr, "kernel_launch: hipFuncSetAttribute failed\n"); grid = -1; return; }
        if (hipOccupancyMaxActiveBlocksPerMultiprocessor(&per_cu, (const void*)fwd, NWAVES * 64, LDS_BYTES) != hipSuccess || per_cu < 1) { fprintf(stderr, "kernel_launch: occupancy query reports %d\n", per_cu); }
        (void)hipGetLastError();
        grid = cus;
    }
    if (grid < 0) return;
    (void)hipMemsetAsync((char*)d_ws + WS_CTL, 0, CTL_ZERO_BYTES, stream);
    Args a{};
    for (int i = 0; i < 21; ++i) a.in[i] = (const float*)d_in[i];
    a.out = (float*)d_out; a.ws = (unsigned char*)d_ws;
#if MK_SPLIT
    for (int p = 0; p < NPHASE; ++p) { a.ph_lo = p; a.ph_hi = p + 1; hipLaunchKernelGGL(fwd, dim3(grid), dim3(NWAVES * 64), LDS_BYTES, stream, a); }
#else
    a.ph_lo = 0; a.ph_hi = NPHASE;
    hipLaunchKernelGGL(fwd, dim3(grid), dim3(NWAVES * 64), LDS_BYTES, stream, a);
#endif
}
```

```cpp
#include <hip/hip_runtime.h>
#include <hip/hip_bf16.h>
#include <cstdio>
#include <cstdint>
#include <cmath>
namespace pg8 {
#define PG8_LAS __attribute__((address_space(3)))
typedef unsigned short bf16_t;
typedef short bf16x8 __attribute__((ext_vector_type(8)));
typedef float f32x4 __attribute__((ext_vector_type(4)));
typedef unsigned u32x4 __attribute__((ext_vector_type(4)));
constexpr int BM = 256, BK = 64, HALF = 128, HTB = HALF * BK * 2  , STAGE_BYTES = 8 * HTB, NXCD = 8, WGM = 8;

__host__ __device__ __forceinline__ int lds_byte(int r, int c) { const int st = (r >> 4) * 2 + (c >> 5), rr = r & 15, cc = c & 31, ob = rr * 64 + cc * 2; return st * 1024 + (ob ^ (((ob >> 9) & 1) << 5)); }
__host__ __device__ __forceinline__ void stage_rc(int b, int& R, int& C) { const int st = b / 1024, sb = b % 1024, swz = sb ^ (((sb >> 9) & 1) << 5); R = (st >> 1) * 16 + swz / 64; C = (st & 1) * 32 + (swz % 64) / 2; }
__host__ __device__ __forceinline__ int perm32(int rho) { const int n = rho >> 4, i = rho & 15; return 8 * (i >> 2) + 4 * n + (i & 3); }

struct Unit { int pm, pn; };
struct Gemm { const bf16_t* A; const bf16_t* Bt; int M, N, K; };

struct StaticOrder {
    int nM, nN, nwg, G, c;
    __host__ __device__ void init(int M, int N, int G_, int c_) { nM = M / BM; nN = N / BM; nwg = nM * nN; G = G_; c = c_; }
    __host__ __device__ bool next(int i, Unit& u) const {
        const long L = (long)i * G + c; if (L >= nwg) return false;
        int wgid = (int)L; { const int q = nwg / NXCD, r = nwg % NXCD, xcd = wgid % NXCD, off = wgid / NXCD; wgid = (xcd < r ? xcd * (q + 1) : r * (q + 1) + (xcd - r) * q) + off; }
        const int nig = WGM * nN, gid = wgid / nig, fm = gid * WGM, gsz = (nM - fm) < WGM ? (nM - fm) : WGM;
        u.pm = fm + ((wgid % nig) % gsz); u.pn = (wgid % nig) / gsz; return true;
    }
    __device__ __forceinline__ void a_ready(const Unit&) const {}
    __device__ __forceinline__ void done(const Unit&) const {}
};

__device__ __forceinline__ unsigned cvt_pk_bf16(float lo, float hi) { unsigned r; asm volatile("v_cvt_pk_bf16_f32 %0, %1, %2" : "=v"(r) : "v"(lo), "v"(hi)); return r; }
typedef float f32x2 __attribute__((ext_vector_type(2)));
__device__ __forceinline__ f32x2 gelu_pk(f32x2 v) {
    const f32x2 av = __builtin_elementwise_abs(v), d = av * 0.2316418882f + 1.0f;
    f32x2 t; t.x = __builtin_amdgcn_rcpf(d.x); t.y = __builtin_amdgcn_rcpf(d.y);
    f32x2 q = t * 0.5307027145f + (-0.7265760135f); q = q * t + 0.7107068705f; q = q * t + (-0.142248368f); q = q * t + 0.127414796f; q = q * t;
    const f32x2 s = (v * v) * (-0.72134752044f);
    f32x2 e; e.x = __builtin_amdgcn_exp2f(s.x); e.y = __builtin_amdgcn_exp2f(s.y);
    const f32x2 m = v * (q * e), r = v - m;
    f32x2 o; o.x = v.x < 0.f ? m.x : r.x; o.y = v.y < 0.f ? m.y : r.y; return o;
}

template <int ACT  > struct EpiBf16 {
    static constexpr bool PERM = true, AFTER_DRAIN = false; static_assert(ACT == 0 || ACT == 1, "EpiBf16: ACT is 0 (none) or 1 (gelu_pk)");
    bf16_t* O; int ldc; const float* bias; int split_cols; size_t split_stride; float scale0;
    __device__ __forceinline__ void operator()(const f32x4 (&acc)[2][2][4][2], const Unit& u, int wr, int wc, int fr, int fq) const {
        const int row0 = u.pm * BM + wr * 64 + fr; int colt = u.pn * BM; bf16_t* base = O;
        float sc = 1.f; if (split_cols) { const int t = colt / split_cols; base += (size_t)t * split_stride; colt -= t * split_cols; if (t == 0) sc = scale0; }
        const int col0 = colt + wc * 32 + 8 * fq, bcol0 = u.pn * BM + wc * 32 + 8 * fq;
        f32x4 bv[2][2];
#pragma unroll
        for (int bj = 0; bj < 2; ++bj)
#pragma unroll
            for (int n = 0; n < 2; ++n) bv[bj][n] = bias ? *(const f32x4*)(bias + bcol0 + bj * HALF + 4 * n) : (f32x4){0.f, 0.f, 0.f, 0.f};
#pragma unroll
        for (int ai = 0; ai < 2; ++ai)
#pragma unroll
            for (int m = 0; m < 4; ++m) { bf16_t* rowp = base + (size_t)(row0 + ai * HALF + m * 16) * ldc + col0;
#pragma unroll
                for (int bj = 0; bj < 2; ++bj) { f32x4 v0 = acc[ai][bj][m][0] + bv[bj][0], v1 = acc[ai][bj][m][1] + bv[bj][1];
                    if (ACT == 1) { f32x2 a = gelu_pk((f32x2){v0[0], v0[1]}), b = gelu_pk((f32x2){v0[2], v0[3]}), c = gelu_pk((f32x2){v1[0], v1[1]}), d = gelu_pk((f32x2){v1[2], v1[3]});
                        v0 = (f32x4){a.x, a.y, b.x, b.y}; v1 = (f32x4){c.x, c.y, d.x, d.y}; }
                    v0 = v0 * sc; v1 = v1 * sc; u32x4 w; w.x = cvt_pk_bf16(v0[0], v0[1]); w.y = cvt_pk_bf16(v0[2], v0[3]); w.z = cvt_pk_bf16(v1[0], v1[1]); w.w = cvt_pk_bf16(v1[2], v1[3]);
                    *(u32x4*)(rowp + bj * HALF) = w; } }
    }
};


struct GOrder {
    int nM, nN, nwg, G, c;
    __host__ __device__ void init(int M, int N, int G_, int c_) { nM = M / BM; nN = N / BM; nwg = nM * nN; G = G_; c = c_; }
    __host__ __device__ bool next(int i, Unit& u) const {
        if (c < 0) return false;
        const long L = (long)i * G + c; if (L >= nwg) return false;
        int wgid = (int)L; { const int q = nwg / NXCD, r = nwg % NXCD, xcd = wgid % NXCD, off = wgid / NXCD; wgid = (xcd < r ? xcd * (q + 1) : r * (q + 1) + (xcd - r) * q) + off; }
        const int nig = WGM * nN, gid = wgid / nig, fm = gid * WGM, gsz = (nM - fm) < WGM ? (nM - fm) : WGM;
        u.pm = fm + ((wgid % nig) % gsz); u.pn = (wgid % nig) / gsz; return true;
    }
    __device__ __forceinline__ void a_ready(const Unit&) const {}
    __device__ __forceinline__ void done(const Unit&) const {}
};
struct BranchOrder {
    GOrder g;
    __device__ void init(int G, int c) { g.init(16384, 1024, G, c); }
    __device__ bool next(int i, Unit& u) const { Unit t; if (!g.next(i / 3, t)) return false; const int br = i % 3; u.pm = 64 * br + t.pm; u.pn = 4 * br + t.pn; return true; }
    __device__ __forceinline__ void a_ready(const Unit&) const {}
    __device__ __forceinline__ void done(const Unit&) const {}
};
__device__ __forceinline__ float bf_lo(unsigned w) { return __builtin_bit_cast(float, w << 16); }
__device__ __forceinline__ float bf_hi(unsigned w) { return __builtin_bit_cast(float, w & 0xffff0000u); }
__device__ __forceinline__ float sigmoid_f(float x) { return __builtin_amdgcn_rcpf(1.0f + __builtin_amdgcn_exp2f(-1.4426950408889634f * x)); }
struct EpiProj {
    static constexpr bool PERM = true, AFTER_DRAIN = false;
    bf16_t* PA; bf16_t* PG;
    __device__ __forceinline__ void operator()(const f32x4 (&acc)[2][2][4][2], const Unit& u, int wr, int wc, int fr, int fq) const {
        const bool gate = u.pn >= 14;
        bf16_t* base = gate ? PG : PA; const int ldc = gate ? 3072 : 3584; const int colt = gate ? (u.pn - 14) * BM : u.pn * BM;
        const int row0 = u.pm * BM + wr * 64 + fr, col0 = colt + wc * 32 + 8 * fq;
#pragma unroll
        for (int ai = 0; ai < 2; ++ai)
#pragma unroll
            for (int m = 0; m < 4; ++m) { bf16_t* rowp = base + (size_t)(row0 + ai * HALF + m * 16) * ldc + col0;
#pragma unroll
                for (int bj = 0; bj < 2; ++bj) { f32x4 v0 = acc[ai][bj][m][0], v1 = acc[ai][bj][m][1];
                    if (gate) {
#pragma unroll
                        for (int e = 0; e < 4; ++e) { v0[e] = sigmoid_f(v0[e]); v1[e] = sigmoid_f(v1[e]); } }
                    u32x4 w; w.x = cvt_pk_bf16(v0[0], v0[1]); w.y = cvt_pk_bf16(v0[2], v0[3]); w.z = cvt_pk_bf16(v1[0], v1[1]); w.w = cvt_pk_bf16(v1[2], v1[3]);
                    *(u32x4*)(rowp + bj * HALF) = w; } }
    }
};
struct EpiBranch {
    static constexpr bool PERM = true, AFTER_DRAIN = false;
    const bf16_t* PG; bf16_t* MG;
    __device__ __forceinline__ void operator()(const f32x4 (&acc)[2][2][4][2], const Unit& u, int wr, int wc, int fr, int fq) const {
        const int br = u.pm >> 6, tm = u.pm & 63, tn = u.pn & 3;
        const int row0 = tm * BM + wr * 64 + fr, col0 = tn * BM + wc * 32 + 8 * fq;
#pragma unroll
        for (int ai = 0; ai < 2; ++ai)
#pragma unroll
            for (int m = 0; m < 4; ++m) { const size_t row = (size_t)(row0 + ai * HALF + m * 16);
#pragma unroll
                for (int bj = 0; bj < 2; ++bj) { const int col = col0 + bj * HALF;
                    const u32x4 g = *(const u32x4*)(PG + row * 3072 + br * 1024 + col);
                    f32x4 v0 = acc[ai][bj][m][0], v1 = acc[ai][bj][m][1];
                    v0[0] *= bf_lo(g.x); v0[1] *= bf_hi(g.x); v0[2] *= bf_lo(g.y); v0[3] *= bf_hi(g.y);
                    v1[0] *= bf_lo(g.z); v1[1] *= bf_hi(g.z); v1[2] *= bf_lo(g.w); v1[3] *= bf_hi(g.w);
                    bf16_t* mp = MG + row * 1024 + col;
                    if (br > 0) { const u32x4 p = *(const u32x4*)mp;
                        v0[0] += bf_lo(p.x); v0[1] += bf_hi(p.x); v0[2] += bf_lo(p.y); v0[3] += bf_hi(p.y);
                        v1[0] += bf_lo(p.z); v1[1] += bf_hi(p.z); v1[2] += bf_lo(p.w); v1[3] += bf_hi(p.w); }
                    u32x4 w; w.x = cvt_pk_bf16(v0[0], v0[1]); w.y = cvt_pk_bf16(v0[2], v0[3]); w.z = cvt_pk_bf16(v1[0], v1[1]); w.w = cvt_pk_bf16(v1[2], v1[3]);
                    *(u32x4*)mp = w; } }
    }
};
struct EpiWout {
    static constexpr bool PERM = false, AFTER_DRAIN = false;
    const float* X; float* H; bf16_t* HB; float* SL;
    __device__ __forceinline__ void operator()(const f32x4 (&acc)[2][2][4][2], const Unit& u, int wr, int wc, int fr, int fq) const {
        const int row0 = u.pm * BM + wr * 64 + fr, col0 = u.pn * BM + wc * 32 + 4 * fq;
#pragma unroll
        for (int ai = 0; ai < 2; ++ai)
#pragma unroll
            for (int m = 0; m < 4; ++m) { const size_t row = (size_t)(row0 + ai * HALF + m * 16); float ss = 0.f;
#pragma unroll
                for (int bj = 0; bj < 2; ++bj)
#pragma unroll
                    for (int n = 0; n < 2; ++n) { const size_t off = row * 1024 + col0 + bj * HALF + n * 16;
                        const f32x4 xv = *(const f32x4*)(X + off); const f32x4 hv = xv + acc[ai][bj][m][n];
                        *(f32x4*)(H + off) = hv; ss += (hv[0] * hv[0] + hv[1] * hv[1]) + (hv[2] * hv[2] + hv[3] * hv[3]);
                        typedef unsigned u32x2v __attribute__((ext_vector_type(2))); u32x2v w; w.x = cvt_pk_bf16(hv[0], hv[1]); w.y = cvt_pk_bf16(hv[2], hv[3]);
                        *(u32x2v*)(HB + off) = w; }
                ss += __shfl_xor(ss, 16); ss += __shfl_xor(ss, 32);
                if (fq == 0) SL[row * 16 + u.pn * 4 + wc] = ss; }
    }
};
template <class Epi, class Sched, bool ALIGN_EPI = false, bool SP2 = false>
__device__ __forceinline__ void gemm_phase(PG8_LAS unsigned char* lds, const Gemm g, const Sched& S, const Epi& E) {
    const int tid = threadIdx.x, wid = __builtin_amdgcn_readfirstlane(tid >> 6), lane = tid & 63, wr = wid >> 2, wc = wid & 3, fr = lane & 15, fq = lane >> 4;
    const int K = g.K, nt = K / BK;
    unsigned voffA[2], voffB[2];
#pragma unroll
    for (int i = 0; i < 2; ++i) { int R, C; stage_rc(tid * 16 + i * 8192, R, C); const int Rb = Epi::PERM ? ((R & ~31) + perm32(R & 31)) : R;
        voffA[i] = (unsigned)(R * K + C) * 2u; voffB[i] = (unsigned)(Rb * K + C) * 2u; }
    const size_t kstep = (size_t)(BK * 2);
    const size_t hstep = (size_t)HALF * K * 2;
    const size_t tstep = 2 * hstep;
    const unsigned ldsw = (unsigned)wid * 1024u;
    const int aoff = lds_byte(wr * 64 + fr, fq * 8), boff = lds_byte(wc * 32 + fr, fq * 8);
#define PG8_SA(b, h) (((b) * 2 + (h)) * HTB)
#define PG8_SB(b, h) ((4 + (b) * 2 + (h)) * HTB)
#define PG8_STAGE(bufoff, gbase, voff) do { _Pragma("unroll") for (int _i = 0; _i < 2; ++_i) \
        __builtin_amdgcn_global_load_lds((const unsigned*)((const char*)(gbase) + (voff)[_i]), (PG8_LAS unsigned*)(lds + (bufoff) + ldsw + _i * 8192), 16, 0, 0); } while (0)
#define PG8_LDA(dst, b, h) do { _Pragma("unroll") for (int m = 0; m < 4; ++m) _Pragma("unroll") for (int k = 0; k < 2; ++k) dst[m][k] = *(const PG8_LAS bf16x8*)(lds + PG8_SA(b, h) + aoff + m * 2048 + k * 1024); } while (0)
#define PG8_LDB(dst, b, h) do { _Pragma("unroll") for (int n = 0; n < 2; ++n) _Pragma("unroll") for (int k = 0; k < 2; ++k) dst[n][k] = *(const PG8_LAS bf16x8*)(lds + PG8_SB(b, h) + boff + n * 2048 + k * 1024); } while (0)
#define PG8_MMA(ai, bj, At, Bt) do { __builtin_amdgcn_s_setprio(1); _Pragma("unroll") for (int m = 0; m < 4; ++m) _Pragma("unroll") for (int n = 0; n < 2; ++n) _Pragma("unroll") for (int k = 0; k < 2; ++k) \
        acc[ai][bj][m][n] = __builtin_amdgcn_mfma_f32_16x16x32_bf16(Bt[n][k], At[m][k], acc[ai][bj][m][n], 0, 0, 0); __builtin_amdgcn_s_setprio(0); } while (0)
#define PG8_WAIT_V(n) asm volatile("s_waitcnt vmcnt(" #n ")" ::: "memory")
#define PG8_WAIT_L(n) asm volatile("s_waitcnt lgkmcnt(" #n ")" ::: "memory")
#define PG8_BAR __builtin_amdgcn_s_barrier()
#define PG8_SCHED __builtin_amdgcn_sched_barrier(0)
    Unit cur, nxt; int ui = 0;
    if (!S.next(0, cur)) return;
    f32x4 acc[2][2][4][2];
#pragma unroll
    for (int a = 0; a < 2; ++a)
#pragma unroll
        for (int b = 0; b < 2; ++b)
#pragma unroll
            for (int m = 0; m < 4; ++m)
#pragma unroll
                for (int n = 0; n < 2; ++n) acc[a][b][m][n] = (f32x4){0.f, 0.f, 0.f, 0.f};
    bf16x8 At[4][2], B0[2][2], B1[2][2];
    const char* cA = (const char*)g.A + (size_t)cur.pm * tstep; const char* cB = (const char*)g.Bt + (size_t)cur.pn * tstep;
    S.a_ready(cur);
    if constexpr (SP2) {
        PG8_STAGE(PG8_SB(0, 0), cB, voffB); PG8_STAGE(PG8_SB(0, 1), cB + hstep, voffB); PG8_STAGE(PG8_SA(0, 0), cA, voffA); PG8_STAGE(PG8_SA(0, 1), cA + hstep, voffA);
        if (wr == 1) PG8_BAR;
        PG8_WAIT_V(2); PG8_BAR;
        PG8_STAGE(PG8_SB(1, 0), cB + kstep, voffB); PG8_STAGE(PG8_SA(1, 0), cA + kstep, voffA); PG8_STAGE(PG8_SB(1, 1), cB + hstep + kstep, voffB);
        PG8_WAIT_V(6); PG8_BAR;
    } else {
        PG8_STAGE(PG8_SB(0, 0), cB, voffB); PG8_STAGE(PG8_SA(0, 0), cA, voffA); PG8_STAGE(PG8_SB(0, 1), cB + hstep, voffB); PG8_STAGE(PG8_SA(0, 1), cA + hstep, voffA);
        if (wr == 1) PG8_BAR;
        PG8_WAIT_V(4); PG8_BAR;
        PG8_STAGE(PG8_SB(1, 0), cB + kstep, voffB); PG8_STAGE(PG8_SA(1, 0), cA + kstep, voffA); PG8_STAGE(PG8_SB(1, 1), cB + hstep + kstep, voffB);
        PG8_WAIT_V(6); PG8_BAR;
    }
    for (;;) {
        const bool has_next = S.next(ui + 1, nxt);
        const char* nA = has_next ? (const char*)g.A + (size_t)nxt.pm * tstep : cA; const char* nB = has_next ? (const char*)g.Bt + (size_t)nxt.pn * tstep : cB;
        for (int t = 0; t < nt; t += 2) {
            const bool last = (t == nt - 2);
            const char* a1 = cA + (size_t)(t + 1) * kstep;
            const char* a2 = last ? nA : cA + (size_t)(t + 2) * kstep; const char* b2 = last ? nB : cB + (size_t)(t + 2) * kstep;
            const char* a3 = a2 + kstep; const char* b3 = b2 + kstep;
            if (last && has_next) S.a_ready(nxt);
            if constexpr (SP2) {
            PG8_LDB(B0, 0, 0); PG8_LDB(B1, 0, 1); PG8_SCHED; PG8_LDA(At, 0, 0); PG8_STAGE(PG8_SA(1, 1), a1 + hstep, voffA);
            PG8_WAIT_V(8); PG8_WAIT_L(0); PG8_BAR; PG8_MMA(0, 0, At, B0); PG8_MMA(0, 1, At, B1); PG8_BAR; PG8_SCHED;
            PG8_LDA(At, 0, 1); PG8_STAGE(PG8_SB(0, 0), b2, voffB); PG8_STAGE(PG8_SB(0, 1), b2 + hstep, voffB); PG8_STAGE(PG8_SA(0, 0), a2, voffA);
            PG8_WAIT_V(8); PG8_WAIT_L(0); PG8_BAR; PG8_MMA(1, 0, At, B0); PG8_MMA(1, 1, At, B1); PG8_BAR; PG8_SCHED;
            PG8_LDB(B0, 1, 0); PG8_LDB(B1, 1, 1); PG8_SCHED; PG8_LDA(At, 1, 0); PG8_STAGE(PG8_SA(0, 1), a2 + hstep, voffA);
            PG8_WAIT_V(8); PG8_WAIT_L(0); PG8_BAR; PG8_MMA(0, 0, At, B0); PG8_MMA(0, 1, At, B1); PG8_BAR; PG8_SCHED;
            PG8_LDA(At, 1, 1); PG8_STAGE(PG8_SB(1, 0), b3, voffB); PG8_STAGE(PG8_SB(1, 1), b3 + hstep, voffB); PG8_STAGE(PG8_SA(1, 0), a3, voffA);
            PG8_WAIT_V(8); PG8_WAIT_L(0); PG8_BAR; PG8_MMA(1, 0, At, B0); PG8_MMA(1, 1, At, B1); PG8_BAR; PG8_SCHED;
            } else {
            PG8_LDB(B0, 0, 0); PG8_SCHED; PG8_LDA(At, 0, 0); PG8_STAGE(PG8_SA(1, 1), a1 + hstep, voffA);
            PG8_WAIT_L(8); PG8_BAR; PG8_WAIT_L(0); PG8_MMA(0, 0, At, B0); PG8_BAR; PG8_SCHED;
            PG8_LDB(B1, 0, 1); PG8_STAGE(PG8_SB(0, 0), b2, voffB);
            PG8_BAR; PG8_WAIT_L(0); PG8_MMA(0, 1, At, B1); PG8_BAR;
            PG8_LDA(At, 0, 1); PG8_STAGE(PG8_SA(0, 0), a2, voffA);
            PG8_BAR; PG8_WAIT_L(0); PG8_MMA(1, 0, At, B0); PG8_BAR; PG8_SCHED;
            PG8_STAGE(PG8_SB(0, 1), b2 + hstep, voffB);
            PG8_WAIT_V(6); PG8_BAR; PG8_MMA(1, 1, At, B1); PG8_BAR;
            PG8_LDB(B0, 1, 0); PG8_SCHED; PG8_LDA(At, 1, 0); PG8_STAGE(PG8_SA(0, 1), a2 + hstep, voffA);
            PG8_WAIT_L(8); PG8_BAR; PG8_WAIT_L(0); PG8_MMA(0, 0, At, B0); PG8_BAR; PG8_SCHED;
            PG8_LDB(B1, 1, 1); PG8_STAGE(PG8_SB(1, 0), b3, voffB);
            PG8_BAR; PG8_WAIT_L(0); PG8_MMA(0, 1, At, B1); PG8_BAR;
            PG8_LDA(At, 1, 1); PG8_STAGE(PG8_SA(1, 0), a3, voffA);
            PG8_BAR; PG8_WAIT_L(0); PG8_MMA(1, 0, At, B0); PG8_BAR; PG8_SCHED;
            PG8_STAGE(PG8_SB(1, 1), b3 + hstep, voffB);
            PG8_WAIT_V(6); PG8_BAR; PG8_MMA(1, 1, At, B1); PG8_BAR;
            }
        }
        if constexpr (ALIGN_EPI) { if (wr == 0) PG8_BAR; }
        if constexpr (!Epi::AFTER_DRAIN) { E(acc, cur, wr, wc, fr, fq); S.done(cur); }
        if (!has_next) break;
#pragma unroll
        for (int a = 0; a < 2; ++a)
#pragma unroll
            for (int b = 0; b < 2; ++b)
#pragma unroll
                for (int m = 0; m < 4; ++m)
#pragma unroll
                    for (int n = 0; n < 2; ++n) acc[a][b][m][n] = (f32x4){0.f, 0.f, 0.f, 0.f};
        cur = nxt; cA = nA; cB = nB; ++ui;
        if constexpr (ALIGN_EPI) { if (wr == 1) PG8_BAR; }
    }
    PG8_WAIT_V(0);
    if constexpr (!ALIGN_EPI) { if (wr == 0) PG8_BAR; }
    PG8_BAR;
    if constexpr (Epi::AFTER_DRAIN) { E.fused(acc, cur, wr, wc, fr, fq, lds, wid, lane); S.done(cur); }
#undef PG8_SA
#undef PG8_SB
#undef PG8_STAGE
#undef PG8_LDA
#undef PG8_LDB
#undef PG8_MMA
#undef PG8_WAIT_V
#undef PG8_WAIT_L
#undef PG8_BAR
#undef PG8_SCHED
}
}

constexpr int NWAVES = 8;
constexpr int T = 16384, DM = 1024, SEQ = 2048, NBATCH = 8, MEMLEN = 256;
constexpr int PW = 6656, PAW = 3584, PGW = 3072;
constexpr int COL_QA = 0, COL_KA = 512, COL_VA = 1024, COL_UC = 1536, COL_BC = 2048, COL_CC = 2560, COL_QX = 3072;
constexpr float RMS_EPS = 1e-6f, LOG2E = 1.4426950408889634f;
constexpr float C2A = 0.125f * LOG2E;
constexpr float C2X = 0.08838834764831845f * LOG2E;
constexpr int NEXP = 16384;

constexpr size_t MiB = 1u << 20;
constexpr size_t WS_CTL = 0, CTL_ZERO_BYTES = 1 * MiB;
constexpr size_t WS_WIN = 1 * MiB;
constexpr size_t WS_WKV = 14 * MiB;
constexpr size_t WS_WBR = 16 * MiB;
constexpr size_t WS_WOUT = 19 * MiB;
constexpr size_t WS_WQ = 21 * MiB;
constexpr size_t WS_SK = 25 * MiB;
constexpr size_t WS_TAB = 25 * MiB + 512 * 1024;
constexpr size_t WS_KMEAN = WS_TAB + 64 * 1024;
constexpr size_t WS_MEMN = 26 * MiB;
constexpr size_t WS_KVM = 30 * MiB;
constexpr size_t WS_SLOTS = 34 * MiB;
constexpr size_t WS_SEL = 35 * MiB;
constexpr size_t WS_SU = 43 * MiB, WS_SV = 43 * MiB + 65536;
constexpr size_t WS_PA = 44 * MiB;
constexpr size_t WS_PG = 156 * MiB;
constexpr size_t WS_END = 252 * MiB;
constexpr size_t PA_MERGED = WS_PA, PA_HB = WS_PA + 32 * MiB, PA_UT = WS_PA + 64 * MiB, PA_VT = WS_PA;
constexpr size_t PG_QRY = WS_PG;
constexpr int CW_BAR = 4096;

constexpr int RING_OFF = 0, RING_BYTES = 131072;
constexpr int LDSCTL_OFF = RING_BYTES, MISC_OFF = LDSCTL_OFF + 320;
constexpr int LDS_BYTES = 147456;

#define GAS __attribute__((address_space(1)))
#define LAS __attribute__((address_space(3)))
typedef unsigned short bf16;
typedef unsigned v4u __attribute__((ext_vector_type(4)));
typedef unsigned v2u __attribute__((ext_vector_type(2)));
typedef float f32x4 __attribute__((ext_vector_type(4)));
typedef float f32x16 __attribute__((ext_vector_type(16)));
typedef short bf16x8 __attribute__((ext_vector_type(8)));
typedef short s16x4 __attribute__((ext_vector_type(4)));
typedef GAS unsigned gu32;
#define RLX_AGENT __ATOMIC_RELAXED, __HIP_MEMORY_SCOPE_AGENT
#define LDS_WAIT() asm volatile("s_waitcnt lgkmcnt(0)" ::: "memory")
#define VM_WAIT() asm volatile("s_waitcnt vmcnt(0)" ::: "memory")
__device__ __forceinline__ unsigned f2bf(float f) { unsigned u = __builtin_bit_cast(unsigned, f); return (u + 0x7fffu + ((u >> 16) & 1u)) >> 16; }
__device__ __forceinline__ unsigned pk2(float lo, float hi) { return f2bf(lo) | (f2bf(hi) << 16); }
__device__ __forceinline__ float bflo(unsigned w) { return __builtin_bit_cast(float, w << 16); }
__device__ __forceinline__ float bfhi(unsigned w) { return __builtin_bit_cast(float, w & 0xffff0000u); }
__device__ __forceinline__ float wave_sum(float v) {
#pragma unroll
    for (int o = 1; o < 64; o <<= 1) v += __shfl_xor(v, o);
    return v;
}
#define XB_TMO      128
#define XB_XCNT(j)  (256  + 64 * (j))
#define XB_XSUB(j)  (1280 + 64 * (j))
#define XB_XGEN(j)  (2304 + 64 * (j))
#define XB_TOP      3328
#define XB_TOPGEN   3392
#define XCD_BAR_WORDS 3456
#define XB_SPIN_CAP (1u << 18)

__device__ __forceinline__ unsigned xb_ld(unsigned* p)              { return __hip_atomic_load(p, __ATOMIC_RELAXED, __HIP_MEMORY_SCOPE_AGENT); }
__device__ __forceinline__ unsigned xb_add(unsigned* p, unsigned v) { return __hip_atomic_fetch_add(p, v, __ATOMIC_RELAXED, __HIP_MEMORY_SCOPE_AGENT); }
__device__ __forceinline__ unsigned xb_xcc_id() { return (unsigned)__builtin_amdgcn_s_getreg((3 << 11) | 20) & 0xFu; }
#define XB_SPIN(cond, bar) do { unsigned _sp = 0; while (cond) { __builtin_amdgcn_s_sleep(1); \
    if ((++_sp & 255u) == 0u) { if (xb_ld(&(bar)[XB_TMO])) break; if (_sp > XB_SPIN_CAP) { atomicAdd(&(bar)[XB_TMO], 1u); break; } } } } while (0)

struct XcdBarrier {
    unsigned* bar; unsigned x;
    volatile LAS unsigned* st;
};

__device__ __forceinline__ XcdBarrier xcd_barrier_post(unsigned* bar, volatile LAS unsigned* st) {
    XcdBarrier b; b.bar = bar; b.x = xb_xcc_id(); b.st = st;
    if (threadIdx.x == 0) (void)xb_add(&bar[XB_XCNT(b.x)], 1u);
    return b;
}
__device__ __forceinline__ void xcd_barrier_complete(unsigned* bar, unsigned x, unsigned& nloc, unsigned& nx) {
    const unsigned G = gridDim.x * gridDim.y * gridDim.z;
    unsigned sum, cnt, mine, sp = 0u;
    for (;;) {
        sum = 0u; cnt = 0u; mine = 0u;
#pragma unroll
        for (unsigned j = 0; j < 16; ++j) { const unsigned c = xb_ld(&bar[XB_XCNT(j)]); sum += c; cnt += (c > 0u) ? 1u : 0u; mine = (j == x) ? c : mine; }
        if (sum == G) break;
        __builtin_amdgcn_s_sleep(1);
        if ((++sp & 255u) == 0u) { if (xb_ld(&bar[XB_TMO])) break; if (sp > XB_SPIN_CAP) { atomicAdd(&bar[XB_TMO], 1u); break; } }
    }
    nloc = mine > 0u ? mine : 1u; nx = cnt > 0u ? cnt : 1u;
}

__device__ __forceinline__ void xcd_barrier(const XcdBarrier& b) {
    asm volatile("s_waitcnt vmcnt(0)" ::: "memory");
    __syncthreads();
    if (threadIdx.x == 0) {
        unsigned* bar = b.bar;
        __builtin_amdgcn_s_waitcnt(0);
        unsigned nloc = b.st[0], nx = b.st[1];
        if (nloc == 0u) { xcd_barrier_complete(bar, b.x, nloc, nx); b.st[0] = nloc; b.st[1] = nx; }
        const unsigned old = xb_add(&bar[XB_XSUB(b.x)], 1u);
        const unsigned gen = old / nloc;
        if (old + 1u == (gen + 1u) * nloc) {
            __builtin_amdgcn_fence(__ATOMIC_RELEASE, "agent");
            asm volatile("s_waitcnt vmcnt(0)" ::: "memory");
            const unsigned og = xb_add(&bar[XB_TOP], 1u);
            const unsigned tg = og / nx;
            if (og + 1u == (tg + 1u) * nx) xb_add(&bar[XB_TOPGEN], 1u);
            else XB_SPIN(xb_ld(&bar[XB_TOPGEN]) == tg, bar);
            __builtin_amdgcn_fence(__ATOMIC_ACQUIRE, "agent");
            xb_add(&bar[XB_XGEN(b.x)], 1u);
            asm volatile("s_waitcnt vmcnt(0)" ::: "memory");
        } else {
            XB_SPIN(xb_ld(&bar[XB_XGEN(b.x)]) == gen, bar);
            __builtin_amdgcn_fence(__ATOMIC_ACQUIRE, "agent");
            asm volatile("s_waitcnt vmcnt(0)" ::: "memory");
        }
    }
    __syncthreads();
}

__device__ __forceinline__ void p0_transpose_item(const float* W, int K, int N, bf16* WT, int row_off, const float* ksc, LAS float* scr, int item, int lane) {
    const int nblk = N / 32, kb = item / nblk, nb = item % nblk, k0 = 64 * kb, n0 = 32 * nb;
#pragma unroll 8
    for (int i = 0; i < 32; ++i) { const int kk = 2 * i + (lane >> 5); float v = W[(size_t)(k0 + kk) * N + n0 + (lane & 31)]; if (ksc) v *= ksc[k0 + kk]; scr[kk * 33 + (lane & 31)] = v; }
    LDS_WAIT(); asm volatile("" ::: "memory");
    const int c = lane & 7;
#pragma unroll
    for (int j = 0; j < 4; ++j) { const int n = (lane >> 3) + 8 * j; const LAS float* s = scr + (8 * c) * 33 + n;
        v4u o; o.x = pk2(s[0 * 33], s[1 * 33]); o.y = pk2(s[2 * 33], s[3 * 33]); o.z = pk2(s[4 * 33], s[5 * 33]); o.w = pk2(s[6 * 33], s[7 * 33]);
        *(GAS v4u*)(WT + (size_t)(row_off + n0 + n) * K + k0 + 8 * c) = o; }
    LDS_WAIT(); asm volatile("" ::: "memory");
}
__device__ __forceinline__ void rms_row_to_bf16(const float* xrow, const float* g, bf16* orow, int lane) {
    const GAS f32x4* xr = (const GAS f32x4*)xrow + lane; const GAS f32x4* gr = (const GAS f32x4*)g + lane;
    f32x4 v[4]; float s = 0.f;
#pragma unroll
    for (int j = 0; j < 4; ++j) { v[j] = xr[64 * j]; s += (v[j].x * v[j].x + v[j].y * v[j].y) + (v[j].z * v[j].z + v[j].w * v[j].w); }
    const float r = 1.f / sqrtf(wave_sum(s) * (1.f / 1024.f) + RMS_EPS);
    GAS unsigned long long* o8 = (GAS unsigned long long*)orow + lane;
#pragma unroll
    for (int j = 0; j < 4; ++j) { const f32x4 gv = gr[64 * j];
        o8[64 * j] = (unsigned long long)pk2(v[j].x * r * gv.x, v[j].y * r * gv.y) | ((unsigned long long)pk2(v[j].z * r * gv.z, v[j].w * r * gv.w) << 32); }
}
__device__ __forceinline__ void cvt_row_to_bf16(const float* xrow, bf16* orow, int lane) {
    const GAS f32x4* xr = (const GAS f32x4*)xrow + lane; GAS unsigned long long* o8 = (GAS unsigned long long*)orow + lane;
    f32x4 v[4];
#pragma unroll
    for (int j = 0; j < 4; ++j) v[j] = xr[64 * j];
#pragma unroll
    for (int j = 0; j < 4; ++j) o8[64 * j] = (unsigned long long)pk2(v[j].x, v[j].y) | ((unsigned long long)pk2(v[j].z, v[j].w) << 32);
}
__device__ __forceinline__ int rel_bucket_dev(int d) {
    if (d < 16) return d;
    int b = 16;
    b += (d >= 21); b += (d >= 27); b += (d >= 35); b += (d >= 46); b += (d >= 59); b += (d >= 77); b += (d >= 99); b += (d >= 128);
    b += (d >= 166); b += (d >= 216); b += (d >= 280); b += (d >= 363); b += (d >= 470); b += (d >= 609); b += (d >= 790);
    return b;
}
struct P0Args { const float *x, *mem, *g_mix, *w_in, *rel_bias, *g_mem, *w_mem_kv, *w_br_attn, *w_br_conv, *w_br_x, *w_out, *g_ffn, *w_query, *sub_keys;
                bf16 *WinT, *WkvT, *WbrT, *WoutT, *WqT, *SK, *HN, *MEMN; float* TAB; };
__device__ __forceinline__ void p0_prologue(const P0Args& a, LAS unsigned char* lds, int gw, int NGW, int wave, int lane) {
    LAS float* scr = (LAS float*)(lds + RING_OFF + wave * 16384);
    constexpr int I_IN = (DM / 64) * (PW / 32), I_KV = (DM / 64) * (1024 / 32), I_BR = (512 / 64) * (1024 / 32), I_OUT = (DM / 64) * (1024 / 32), I_Q = (DM / 64) * (2048 / 32);
    constexpr int NITEMS = I_IN + I_KV + 3 * I_BR + I_OUT + I_Q;
    for (int it = gw; it < NITEMS; it += NGW) {
        int r = it;
        if (r < I_IN) { p0_transpose_item(a.w_in, DM, PW, a.WinT, 0, nullptr, scr, r, lane); continue; } r -= I_IN;
        if (r < I_KV) { p0_transpose_item(a.w_mem_kv, DM, 1024, a.WkvT, 0, nullptr, scr, r, lane); continue; } r -= I_KV;
        if (r < I_BR) { p0_transpose_item(a.w_br_attn, 512, 1024, a.WbrT, 0, nullptr, scr, r, lane); continue; } r -= I_BR;
        if (r < I_BR) { p0_transpose_item(a.w_br_conv, 512, 1024, a.WbrT, 1024, nullptr, scr, r, lane); continue; } r -= I_BR;
        if (r < I_BR) { p0_transpose_item(a.w_br_x, 512, 1024, a.WbrT, 2048, nullptr, scr, r, lane); continue; } r -= I_BR;
        if (r < I_OUT) { p0_transpose_item(a.w_out, DM, 1024, a.WoutT, 0, nullptr, scr, r, lane); continue; } r -= I_OUT;
        p0_transpose_item(a.w_query, DM, 2048, a.WqT, 0, a.g_ffn, scr, r, lane);
    }
    for (int m = gw; m < T; m += NGW) rms_row_to_bf16(a.x + (size_t)m * DM, a.g_mix, a.HN + (size_t)m * DM, lane);
    for (int m = gw; m < NBATCH * MEMLEN; m += NGW) rms_row_to_bf16(a.mem + (size_t)m * DM, a.g_mem, a.MEMN + (size_t)m * DM, lane);
    for (int m = gw; m < 256; m += NGW) cvt_row_to_bf16(a.sub_keys + (size_t)m * 1024, a.SK + (size_t)m * 1024, lane);
    for (int m = gw; m < 256; m += NGW) {
        const int idx = m * 64 + lane, h = idx >> 11, d = idx & 2047;
        a.TAB[idx] = a.rel_bias[rel_bucket_dev(d) * 8 + h] * LOG2E;
    }
}

template <int DH> __device__ __forceinline__ void fix_item(bf16* buf, size_t pitch, int row0, int col0, const float* gain, float gscale, float* kmean, LAS float* red, int wave, int lane) {
    constexpr int LPR = DH / 8, RPI = 64 / LPR, NIT = 32 / RPI;
    const int sub = lane / LPR, ch = lane % LPR;
    float g[8], cs[8];
#pragma unroll
    for (int j = 0; j < 8; ++j) { g[j] = gain[ch * 8 + j] * gscale; cs[j] = 0.f; }
    v4u w[NIT];
#pragma unroll
    for (int it = 0; it < NIT; ++it) w[it] = *(const GAS v4u*)(buf + (size_t)(row0 + wave * 32 + it * RPI + sub) * pitch + col0 + ch * 8);
#pragma unroll
    for (int it = 0; it < NIT; ++it) {
        float x[8] = {bflo(w[it].x), bfhi(w[it].x), bflo(w[it].y), bfhi(w[it].y), bflo(w[it].z), bfhi(w[it].z), bflo(w[it].w), bfhi(w[it].w)};
        float ss = 0.f;
#pragma unroll
        for (int j = 0; j < 8; ++j) ss += x[j] * x[j];
#pragma unroll
        for (int o = 1; o < LPR; o <<= 1) ss += __shfl_xor(ss, o);
        const float r = 1.f / sqrtf(ss * (1.f / DH) + RMS_EPS);
#pragma unroll
        for (int j = 0; j < 8; ++j) { x[j] = x[j] * r * g[j]; cs[j] += x[j]; }
        v4u o; o.x = pk2(x[0], x[1]); o.y = pk2(x[2], x[3]); o.z = pk2(x[4], x[5]); o.w = pk2(x[6], x[7]);
        *(GAS v4u*)(buf + (size_t)(row0 + wave * 32 + it * RPI + sub) * pitch + col0 + ch * 8) = o;
    }
    if (kmean) {
#pragma unroll
        for (int j = 0; j < 8; ++j) {
#pragma unroll
            for (int o = LPR; o < 64; o <<= 1) cs[j] += __shfl_xor(cs[j], o);
        }
        if (sub == 0) {
#pragma unroll
            for (int j = 0; j < 8; ++j) red[wave * DH + ch * 8 + j] = cs[j];
        }
        asm volatile("s_waitcnt lgkmcnt(0)\n\ts_barrier" ::: "memory");
        if (wave == 0 && lane < DH) { float s = 0.f;
#pragma unroll
            for (int w8 = 0; w8 < 8; ++w8) s += red[w8 * DH + lane];
            kmean[lane] = s * (1.f / 256.f); }
        asm volatile("s_waitcnt lgkmcnt(0)\n\ts_barrier" ::: "memory");
    }
}
__device__ __forceinline__ void p2_fixup(bf16* PA, bf16* KVM, float* KMEAN, const float* q_gain_a, const float* k_gain_a, const float* q_gain_x, const float* k_gain_x, LAS unsigned char* lds, int vcu, int G, int wave, int lane) {
    constexpr int N_A = 512, N_X = 256, N_KX = 32, NIT = 2 * N_A + N_X + N_KX;
    LAS float* red = (LAS float*)lds;
    for (int it = vcu; it < NIT; it += G) {
        int r = it;
        if (r < N_A) { const int b = r >> 6, h = (r >> 3) & 7, n = r & 7;
            fix_item<64>(PA, PAW, b * SEQ + n * 256, COL_KA + h * 64, k_gain_a, 1.0f, KMEAN + (size_t)((b * 8 + h) * 8 + n) * 64, red, wave, lane); continue; } r -= N_A;
        if (r < N_A) { const int b = r >> 6, h = (r >> 3) & 7, n = r & 7;
            fix_item<64>(PA, PAW, b * SEQ + n * 256, COL_QA + h * 64, q_gain_a, C2A, nullptr, red, wave, lane); continue; } r -= N_A;
        if (r < N_X) { const int b = r >> 5, h = (r >> 3) & 3, n = r & 7;
            fix_item<128>(PA, PAW, b * SEQ + n * 256, COL_QX + h * 128, q_gain_x, C2X, nullptr, red, wave, lane); continue; } r -= N_X;
        { const int b = r >> 2, h = r & 3;
            fix_item<128>(KVM, 1024, b * MEMLEN, h * 128, k_gain_x, 1.0f, nullptr, red, wave, lane); }
    }
}

namespace att {
constexpr int L_K = 0, L_V = 16384, L_TAB = 32768, TAB_PAD = 256, L_KM = L_TAB + (TAB_PAD + 2048) * 4  , L_SEL = L_KM + 2048  , L_WSF = L_SEL + 1024  ,
              L_OST = L_WSF + NWAVES * 256  , L_END = L_OST + NWAVES * 8192  ;
static_assert(L_END <= RING_BYTES, "attention LDS map");
__device__ __forceinline__ int crow(int r, int hi) { return (r & 3) + 8 * (r >> 2) + 4 * hi; }
__device__ __forceinline__ void glds16(const void* gsrc, unsigned lds_dst) { unsigned keep;
    asm volatile("s_mov_b32 %0, m0\n\ts_mov_b32 m0, %2\n\ts_nop 0\n\tglobal_load_lds_dwordx4 %1, off\n\ts_mov_b32 m0, %0" : "=&s"(keep) : "v"(gsrc), "s"(lds_dst) : "memory"); }
__device__ __forceinline__ unsigned cvtpk(float lo, float hi) { typedef float f2 __attribute__((ext_vector_type(2))); typedef __bf16 b2 __attribute__((ext_vector_type(2))); f2 v = {lo, hi}; b2 b = __builtin_convertvector(v, b2); return __builtin_bit_cast(unsigned, b); }
__device__ __forceinline__ float rowmax(const f32x16& p0, const f32x16& p1) {
    float a = fmaxf(p0[0], p1[0]);
#pragma unroll
    for (int r = 1; r < 16; ++r) a = fmaxf(a, fmaxf(p0[r], p1[r]));
    auto rr = __builtin_amdgcn_permlane32_swap(__float_as_uint(a), __float_as_uint(a), false, false);
    return fmaxf(__uint_as_float(rr[0]), __uint_as_float(rr[1]));
}
template <int ND0> __device__ __forceinline__ void qkt(f32x16& p0, f32x16& p1, const LAS unsigned char* Kslot, const bf16x8* qr, int r32, int hi) {
    const LAS unsigned char* kb = Kslot + hi * 1024 + r32 * 16;
    p0 = f32x16{}; p1 = f32x16{};
#pragma unroll
    for (int d0 = 0; d0 < ND0; ++d0) {
        const bf16x8 b0 = *(const LAS bf16x8*)(kb + d0 * 2048);
        const bf16x8 b1 = *(const LAS bf16x8*)(kb + d0 * 2048 + 512);
        p0 = __builtin_amdgcn_mfma_f32_32x32x16_bf16(b0, qr[d0], p0, 0, 0, 0);
        p1 = __builtin_amdgcn_mfma_f32_32x32x16_bf16(b1, qr[d0], p1, 0, 0, 0);
    }
}
template <int NDB> __device__ __forceinline__ void pv(f32x16* o, int vb, bf16x8 pa0, bf16x8 pa1, bf16x8 pa2, bf16x8 pa3) {
#pragma unroll
    for (int d0 = 0; d0 < NDB; ++d0) { s16x4 lo[4], hi[4];
#pragma unroll
        for (int ks = 0; ks < 4; ++ks) {
            asm volatile("ds_read_b64_tr_b16 %0,%1 offset:%c2" : "=&v"(lo[ks]) : "v"(vb), "i"(d0 * 4096 + ks * 1024) : "memory");
            asm volatile("ds_read_b64_tr_b16 %0,%1 offset:%c2" : "=&v"(hi[ks]) : "v"(vb), "i"(d0 * 4096 + ks * 1024 + 512) : "memory"); }
        asm volatile("s_waitcnt lgkmcnt(0)" ::: "memory"); __builtin_amdgcn_sched_barrier(0);
#define ATT_PK(k) (bf16x8){lo[k][0], lo[k][1], lo[k][2], lo[k][3], hi[k][0], hi[k][1], hi[k][2], hi[k][3]}
        o[d0] = __builtin_amdgcn_mfma_f32_32x32x16_bf16(pa0, ATT_PK(0), o[d0], 0, 0, 0);
        o[d0] = __builtin_amdgcn_mfma_f32_32x32x16_bf16(pa1, ATT_PK(1), o[d0], 0, 0, 0);
        o[d0] = __builtin_amdgcn_mfma_f32_32x32x16_bf16(pa2, ATT_PK(2), o[d0], 0, 0, 0);
        o[d0] = __builtin_amdgcn_mfma_f32_32x32x16_bf16(pa3, ATT_PK(3), o[d0], 0, 0, 0);
#undef ATT_PK
    }
}
#define ATT_BAR() asm volatile("s_waitcnt lgkmcnt(0)\n\ts_barrier" ::: "memory")
#define ATT_WAIT_BAR() asm volatile("s_waitcnt vmcnt(0) lgkmcnt(0)\n\ts_barrier" ::: "memory")

template <int DH, bool MOBA> __device__ __forceinline__ void attn_unit(const bf16* Qp, size_t qpitch, const bf16* Kp, const bf16* Vp, size_t kpitch, bf16* Op, int qb, const float* kmean_bh, const float* tab_h,
                                                                   LAS unsigned char* lds, int tid, int wid, int lane) {
    constexpr int ND0 = DH / 16, NDB = DH / 32, NPIECE = DH / 64;
    const int r32 = lane & 31, hi = lane >> 5;
    const unsigned lds0 = (unsigned)(uintptr_t)lds;
    LAS float* wsf = (LAS float*)(lds + L_WSF) + wid * 64;
    ATT_BAR();
    int my_sel = 0;
    if (MOBA) {
        LAS float* tl = (LAS float*)(lds + L_TAB);
        for (int i = tid; i < TAB_PAD + 2048; i += NWAVES * 64) tl[i] = (i < TAB_PAD) ? 0.f : tab_h[i - TAB_PAD];
        LAS float* km = (LAS float*)(lds + L_KM);
        for (int i = tid; i < 512; i += NWAVES * 64) km[i] = kmean_bh[i];
        ATT_BAR();
        if (tid < 256) {
            int sel = 0;
            if (qb <= 3) sel = (1 << qb) - 1;
            else {
                const GAS v4u* qrow = (const GAS v4u*)(Qp + (size_t)tid * qpitch);
                v4u qw[8];
#pragma unroll
                for (int c = 0; c < 8; ++c) qw[c] = qrow[c];
                float b1 = -INFINITY, b2 = -INFINITY, b3 = -INFINITY; int i1 = 0, i2 = 0, i3 = 0;
#pragma unroll 1
                for (int n = 0; n < qb; ++n) { float s = 0.f; const LAS f32x4* kr = (const LAS f32x4*)(km + n * 64);
#pragma unroll
                    for (int c = 0; c < 8; ++c) { const f32x4 ka = kr[2 * c], kb2 = kr[2 * c + 1]; const v4u w = qw[c];
                        s += bflo(w.x) * ka.x; s += bfhi(w.x) * ka.y; s += bflo(w.y) * ka.z; s += bfhi(w.y) * ka.w;
                        s += bflo(w.z) * kb2.x; s += bfhi(w.z) * kb2.y; s += bflo(w.w) * kb2.z; s += bfhi(w.w) * kb2.w; }
                    if (s > b1) { b3 = b2; i3 = i2; b2 = b1; i2 = i1; b1 = s; i1 = n; }
                    else if (s > b2) { b3 = b2; i3 = i2; b2 = s; i2 = n; }
                    else if (s > b3) { b3 = s; i3 = n; } }
                sel = (1 << i1) | (1 << i2) | (1 << i3);
            }
            ((LAS int*)(lds + L_SEL))[tid] = sel;
        }
        ATT_BAR();
        my_sel = ((LAS int*)(lds + L_SEL))[wid * 32 + r32];
    }
    bf16x8 qr[ND0];
    { const bf16* Qw = Qp + (size_t)(wid * 32 + r32) * qpitch + hi * 8;
#pragma unroll
      for (int d0 = 0; d0 < ND0; ++d0) qr[d0] = *(const GAS bf16x8*)(Qw + d0 * 16); }
    float m_run = -INFINITY, l_run = 0.f;
    f32x16 o[NDB];
#pragma unroll
    for (int d = 0; d < NDB; ++d) o[d] = f32x16{};
    const int vb0 = (int)(lds0 + L_V) + ((lane >> 4) & 1) * 32 + (lane & 3) * 8 + (4 * hi + ((lane & 15) >> 2)) * 64;
    const int qrel = wid * 32 + r32;
    const int ntiles = MOBA ? 4 + 4 * qb : 4;
    for (int tt = 0; tt < ntiles; ++tt) {
        int kb, j; bool own;
        if (MOBA) { if (tt < 4) { kb = qb; j = tt; own = true; } else { kb = (tt - 4) >> 2; j = (tt - 4) & 3; own = false; } }
        else { kb = 0; j = tt; own = false; }
        const int key0 = kb * 256 + j * 64;
        ATT_BAR();
#pragma unroll
        for (int pc = 0; pc < NPIECE; ++pc) { const int p = wid + 8 * pc;
            glds16(Kp + (size_t)(key0 + lane) * kpitch + p * 8, (unsigned)__builtin_amdgcn_readfirstlane(lds0 + L_K + p * 1024));
            glds16(Vp + (size_t)(key0 + 16 * (p & 3) + (lane >> 2)) * kpitch + (p >> 2) * 32 + (lane & 3) * 8, (unsigned)__builtin_amdgcn_readfirstlane(lds0 + L_V + p * 1024)); }
        ATT_WAIT_BAR();
        if (MOBA && own && 64 * j > wid * 32 + 31) continue;
        f32x16 p0, p1;
        qkt<ND0>(p0, p1, lds + L_K, qr, r32, hi);
        if (MOBA) {
            const int dbase = (qb - kb) * 256 + qrel - 64 * j - 4 * hi;
            const LAS float* tp = (const LAS float*)(lds + L_TAB) + TAB_PAD + dbase - 63;
            const bool lane_ok = own ? true : (((my_sel >> kb) & 1) != 0);
#pragma unroll
            for (int r = 0; r < 16; ++r) { const int c = (r & 3) + 8 * (r >> 2);
                const bool v0 = own ? (dbase - c >= 0) : lane_ok, v1 = own ? (dbase - c - 32 >= 0) : lane_ok;
                p0[r] = v0 ? p0[r] + tp[63 - c] : -INFINITY; p1[r] = v1 ? p1[r] + tp[31 - c] : -INFINITY; }
        }
        const float rm = rowmax(p0, p1);
        const float m_new = fmaxf(m_run, rm);
        const float alpha = __builtin_amdgcn_exp2f(m_run - m_new);
        float ps = 0.f;
#pragma unroll
        for (int r = 0; r < 16; ++r) { p0[r] = __builtin_amdgcn_exp2f(p0[r] - m_new); p1[r] = __builtin_amdgcn_exp2f(p1[r] - m_new); ps += p0[r] + p1[r]; }
        l_run = l_run * alpha + ps;
        if (!__all(m_new == m_run)) {
            if (hi == 0) wsf[r32] = alpha;
            LDS_WAIT();
#pragma unroll
            for (int r = 0; r < 16; ++r) { const float f = wsf[crow(r, hi)];
#pragma unroll
                for (int d = 0; d < NDB; ++d) o[d][r] *= f; }
        }
        m_run = m_new;
        v4u pw0, pw1, pw2, pw3;
        pw0 = (v4u){cvtpk(p0[0], p0[1]), cvtpk(p0[2], p0[3]), cvtpk(p0[4], p0[5]), cvtpk(p0[6], p0[7])};
        pw1 = (v4u){cvtpk(p0[8], p0[9]), cvtpk(p0[10], p0[11]), cvtpk(p0[12], p0[13]), cvtpk(p0[14], p0[15])};
        pw2 = (v4u){cvtpk(p1[0], p1[1]), cvtpk(p1[2], p1[3]), cvtpk(p1[4], p1[5]), cvtpk(p1[6], p1[7])};
        pw3 = (v4u){cvtpk(p1[8], p1[9]), cvtpk(p1[10], p1[11]), cvtpk(p1[12], p1[13]), cvtpk(p1[14], p1[15])};
        pv<NDB>(o, vb0, __builtin_bit_cast(bf16x8, pw0), __builtin_bit_cast(bf16x8, pw1), __builtin_bit_cast(bf16x8, pw2), __builtin_bit_cast(bf16x8, pw3));
    }
    { auto rr = __builtin_amdgcn_permlane32_swap(__float_as_uint(l_run), __float_as_uint(l_run), false, false); l_run = __uint_as_float(rr[0]) + __uint_as_float(rr[1]); }
    if (hi == 0) wsf[32 + r32] = l_run;
    LDS_WAIT();
    LAS bf16* stg = (LAS bf16*)(lds + L_OST + wid * 8192);
#pragma unroll
    for (int r = 0; r < 16; ++r) { const int orow = crow(r, hi); const float rl = __builtin_amdgcn_rcpf(wsf[32 + orow]);
#pragma unroll
        for (int d = 0; d < NDB; ++d) stg[orow * DH + d * 32 + r32] = (bf16)f2bf(o[d][r] * rl); }
    LDS_WAIT();
    constexpr int CPR = DH / 8;
    int lane2 = lane; asm volatile("" : "+v"(lane2));
#pragma unroll
    for (int i = 0; i < (32 * CPR) / 64; ++i) { const int idx = i * 64 + lane2, row = idx / CPR, ch = idx % CPR;
        const v4u v = *(const LAS v4u*)(stg + row * DH + ch * 8);
        *(GAS v4u*)(Op + (size_t)(wid * 32 + row) * 512 + ch * 8) = v; }
}
#undef ATT_BAR
#undef ATT_WAIT_BAR
}

__device__ __forceinline__ void conv_item(const bf16* PA, const float* conv_w, bf16* CO, int item, int tid) {
    const int ch = (tid & 63) * 8, r0 = item * 64 + (tid >> 6) * 8;
    float w0[8], w1[8], w2[8];
#pragma unroll
    for (int j = 0; j < 8; ++j) { w0[j] = conv_w[ch + j]; w1[j] = conv_w[512 + ch + j]; w2[j] = conv_w[1024 + ch + j]; }
    float pm2[8], pm1[8];
#pragma unroll
    for (int j = 0; j < 8; ++j) { pm2[j] = 0.f; pm1[j] = 0.f; }
    auto load8 = [&](int row, int col, float* o) { const v4u w = *(const GAS v4u*)(PA + (size_t)row * PAW + col + ch);
        o[0] = bflo(w.x); o[1] = bfhi(w.x); o[2] = bflo(w.y); o[3] = bfhi(w.y); o[4] = bflo(w.z); o[5] = bfhi(w.z); o[6] = bflo(w.w); o[7] = bfhi(w.w); };
    const int s0 = r0 & (SEQ - 1);
    if (s0 >= 2) { float a[8], b[8]; load8(r0 - 2, COL_CC, a); load8(r0 - 2, COL_UC, b);
#pragma unroll
        for (int j = 0; j < 8; ++j) pm2[j] = a[j] * b[j]; }
    if (s0 >= 1) { float a[8], b[8]; load8(r0 - 1, COL_CC, a); load8(r0 - 1, COL_UC, b);
#pragma unroll
        for (int j = 0; j < 8; ++j) pm1[j] = a[j] * b[j]; }
#pragma unroll
    for (int i = 0; i < 8; ++i) { const int row = r0 + i; float c[8], u[8], bb[8], y[8];
        load8(row, COL_CC, c); load8(row, COL_UC, u); load8(row, COL_BC, bb);
#pragma unroll
        for (int j = 0; j < 8; ++j) { const float cur = c[j] * u[j]; y[j] = bb[j] * (w0[j] * pm2[j] + w1[j] * pm1[j] + w2[j] * cur); pm2[j] = pm1[j]; pm1[j] = cur; }
        v4u o; o.x = pk2(y[0], y[1]); o.y = pk2(y[2], y[3]); o.z = pk2(y[4], y[5]); o.w = pk2(y[6], y[7]);
        *(GAS v4u*)(CO + (size_t)row * 512 + ch) = o; }
}

namespace pk {
template <int N> __device__ __forceinline__ void bsort_desc(unsigned (&a)[N]) {
#pragma unroll
    for (int k = 2; k <= N; k <<= 1) {
#pragma unroll
        for (int j = k >> 1; j > 0; j >>= 1) {
#pragma unroll
            for (int i = 0; i < N; ++i) { const int l = i ^ j;
                if (l > i) { const unsigned x = a[i], y = a[l]; const unsigned mx = x > y ? x : y, mn = x > y ? y : x;
                    if ((i & k) == 0) { a[i] = mx; a[l] = mn; } else { a[i] = mn; a[l] = mx; } } } } }
}
template <int N> __device__ __forceinline__ void bmerge_desc(unsigned (&a)[N]) {
#pragma unroll
    for (int j = N >> 1; j > 0; j >>= 1) {
#pragma unroll
        for (int i = 0; i < N; ++i) { const int l = i ^ j; if (l > i) { const unsigned x = a[i], y = a[l]; a[i] = x > y ? x : y; a[l] = x > y ? y : x; } } }
}
__device__ __forceinline__ void top16_merge(unsigned (&x)[16], const unsigned (&y)[16]) {
#pragma unroll
    for (int i = 0; i < 16; ++i) x[i] = x[i] > y[15 - i] ? x[i] : y[15 - i];
    bmerge_desc<16>(x);
}
__device__ __forceinline__ unsigned f2ord(float f) { const unsigned u = __float_as_uint(f); return u ^ ((unsigned)((int)u >> 31) | 0x80000000u); }
__device__ __forceinline__ float ord2f(unsigned o) { return __uint_as_float(o ^ ((o & 0x80000000u) ? 0x80000000u : 0xFFFFFFFFu)); }

constexpr int L_TBL = 0;
__device__ __forceinline__ void topk_unit(const bf16* QRY, const bf16* SK, const float* SLOTS, unsigned* SEL, LAS unsigned char* lds, int v, int tid, int wid, int lane) {
    const int hp = v & 3, t0 = ((v >> 2) * 8 + wid) * 32, r32 = lane & 31, hi = lane >> 5;
    for (int tb = 0; tb < 4; ++tb) { const bf16* src = SK + (size_t)(((2 * hp + (tb >> 1)) * 2 + (tb & 1)) * 128) * 128;
        for (int idx = tid; idx < 2048; idx += NWAVES * 64) { const int key = idx >> 4, c16 = idx & 15;
            const v4u w = *(const GAS v4u*)(src + key * 128 + c16 * 8);
            *(LAS v4u*)(lds + L_TBL + tb * 32768 + (c16 * 4 + (key >> 5)) * 512 + (key & 31) * 16) = w; } }
    asm volatile("s_waitcnt vmcnt(0) lgkmcnt(0)\n\ts_barrier" ::: "memory");
    const int tok = t0 + r32;
    float rn; { const GAS f32x4* sl = (const GAS f32x4*)(SLOTS + (size_t)tok * 16); const f32x4 a = sl[0], b = sl[1], c = sl[2], d = sl[3];
        const float ss = ((a.x + a.y) + (a.z + a.w)) + ((b.x + b.y) + (b.z + b.w)) + ((c.x + c.y) + (c.z + c.w)) + ((d.x + d.y) + (d.z + d.w));
        rn = 1.f / sqrtf(ss * (1.f / 1024.f) + RMS_EPS); }
    unsigned L[4][16];
#pragma unroll
    for (int tb = 0; tb < 4; ++tb) {
        const int hh = tb >> 1, p = tb & 1;
        const bf16* qp = QRY + (size_t)tok * 2048 + ((2 * hp + hh) * 2 + p) * 128 + hi * 8;
        bf16x8 qf[8];
#pragma unroll
        for (int kk = 0; kk < 8; ++kk) qf[kk] = *(const GAS bf16x8*)(qp + kk * 16);
        f32x16 acc[4];
#pragma unroll
        for (int blk = 0; blk < 4; ++blk) acc[blk] = f32x16{};
        const LAS unsigned char* tbase = lds + L_TBL + tb * 32768 + hi * 2048 + r32 * 16;
#pragma unroll
        for (int kk = 0; kk < 8; ++kk)
#pragma unroll
            for (int blk = 0; blk < 4; ++blk) { const bf16x8 af = *(const LAS bf16x8*)(tbase + kk * 4096 + blk * 512);
                acc[blk] = __builtin_amdgcn_mfma_f32_32x32x16_bf16(af, qf[kk], acc[blk], 0, 0, 0); }
        unsigned g[4][16];
#pragma unroll
        for (int blk = 0; blk < 4; ++blk)
#pragma unroll
            for (int r = 0; r < 16; ++r) g[blk][r] = (f2ord(acc[blk][r]) & ~127u) | (unsigned)(127 - (32 * blk + (r & 3) + 8 * (r >> 2)));
#pragma unroll
        for (int blk = 0; blk < 4; ++blk) bsort_desc<16>(g[blk]);
        top16_merge(g[0], g[1]); top16_merge(g[2], g[3]); top16_merge(g[0], g[2]);
#pragma unroll
        for (int i = 0; i < 16; ++i) L[tb][i] = g[0][i] ^ (unsigned)(4 * hi);
    }
    unsigned A[2][16];
#pragma unroll
    for (int p = 0; p < 2; ++p) {
        unsigned X[16], Y[16];
#pragma unroll
        for (int i = 0; i < 16; ++i) { auto rr = __builtin_amdgcn_permlane32_swap(L[p][i], L[2 + p][i], false, false); X[i] = rr[0]; Y[i] = rr[1]; }
        top16_merge(X, Y);
#pragma unroll
        for (int i = 0; i < 16; ++i) A[p][i] = X[i];
    }
    float f0[16], f1[16];
#pragma unroll
    for (int i = 0; i < 16; ++i) { f0[i] = ord2f(A[0][i] & ~127u); f1[i] = ord2f(A[1][i] & ~127u); }
    float sums[50]; unsigned keys[50];
    { int c = 0;
#pragma unroll
      for (int i = 0; i < 16; ++i)
#pragma unroll
          for (int j = 0; j < 16; ++j) if ((i + 1) * (j + 1) <= 16) { sums[c] = f0[i] + f1[j]; keys[c] = (f2ord(sums[c]) & ~63u) | (unsigned)(63 - c); ++c; } }
    unsigned G0[16], R[32];
#pragma unroll
    for (int i = 0; i < 16; ++i) G0[i] = keys[i];
#pragma unroll
    for (int i = 0; i < 32; ++i) R[i] = (i < 26) ? keys[24 + i] : 0u;
    bsort_desc<32>(R);
#pragma unroll
    for (int i = 0; i < 16; ++i) G0[i] = G0[i] > R[15 - i] ? G0[i] : R[15 - i];
    bmerge_desc<16>(G0);
#pragma unroll
    for (int i = 8; i < 16; ++i) G0[i] = G0[i] > keys[16 + 15 - i] ? G0[i] : keys[16 + 15 - i];
    unsigned thr = G0[0];
#pragma unroll
    for (int i = 1; i < 16; ++i) thr = thr < G0[i] ? thr : G0[i];
    const float s00 = sums[0], sc = rn * LOG2E;
    float w[50]; float den = 0.f;
#pragma unroll
    for (int c = 0; c < 50; ++c) { w[c] = (keys[c] >= thr) ? __builtin_amdgcn_exp2f((sums[c] - s00) * sc) : 0.f; den += w[c]; }
    const float inv = 1.f / den;
    unsigned i0[16], i1[16];
#pragma unroll
    for (int i = 0; i < 16; ++i) { i0[i] = 127u - (A[0][i] & 127u); i1[i] = 127u - (A[1][i] & 127u); }
    GAS unsigned* outp = (GAS unsigned*)(SEL + ((size_t)tok * 8 + 2 * hp + hi) * 16);
    int pos = 0;
    { int c = 0;
#pragma unroll
      for (int i = 0; i < 16; ++i)
#pragma unroll
          for (int j = 0; j < 16; ++j) if ((i + 1) * (j + 1) <= 16) { if (keys[c] >= thr) { outp[pos & 15] = ((i0[i] * 128u + i1[j]) << 16) | f2bf(w[c] * inv); ++pos; } ++c; } }
}
}

template <bool OFFSET> __device__ __forceinline__ void quant_row(const float* xrow, unsigned char* qrow, float* scale, int lane) {
    const GAS f32x4* xr = (const GAS f32x4*)xrow + 4 * lane; f32x4 v[4]; float am = 0.f;
#pragma unroll
    for (int j = 0; j < 4; ++j) { v[j] = xr[j]; am = fmaxf(am, fmaxf(fmaxf(fabsf(v[j].x), fabsf(v[j].y)), fmaxf(fabsf(v[j].z), fabsf(v[j].w)))); }
#pragma unroll
    for (int o = 1; o < 64; o <<= 1) am = fmaxf(am, __shfl_xor(am, o));
    const float s = am > 0.f ? am * (1.f / 127.f) : 1.f, is = 1.f / s;
    v4u o;
#pragma unroll
    for (int j = 0; j < 4; ++j) { const int a = (int)rintf(v[j].x * is), b = (int)rintf(v[j].y * is), c = (int)rintf(v[j].z * is), d = (int)rintf(v[j].w * is);
        const int off = OFFSET ? 128 : 0;
        o[j] = (unsigned)((a + off) & 0xff) | ((unsigned)((b + off) & 0xff) << 8) | ((unsigned)((c + off) & 0xff) << 16) | ((unsigned)((d + off) & 0xff) << 24); }
    *((GAS v4u*)qrow + lane) = o;
    if (lane == 0) *scale = s;
}
__device__ __forceinline__ float gelu_exact(float x) { return 0.5f * x * (1.0f + erff(x * 0.70710678118654752f)); }
__device__ __forceinline__ void gather_token(const float* H, float* OUTP, const unsigned* SEL, const unsigned char* UQ, const unsigned char* VQ, const float* SU, const float* SV, const float (&gf)[16], int t, int lane) {
    const GAS f32x4* hrow = (const GAS f32x4*)(H + (size_t)t * DM) + 4 * lane; GAS f32x4* orow = (GAS f32x4*)(OUTP + (size_t)t * DM) + 4 * lane;
    f32x4 hv[4];
#pragma unroll
    for (int j = 0; j < 4; ++j) hv[j] = hrow[j];
    float ss = 0.f;
#pragma unroll
    for (int j = 0; j < 4; ++j) ss += (hv[j].x * hv[j].x + hv[j].y * hv[j].y) + (hv[j].z * hv[j].z + hv[j].w * hv[j].w);
    const float rn = 1.f / sqrtf(wave_sum(ss) * (1.f / 1024.f) + RMS_EPS);
    float xn[16]; float am = 0.f;
#pragma unroll
    for (int j = 0; j < 4; ++j)
#pragma unroll
        for (int e = 0; e < 4; ++e) { xn[4 * j + e] = hv[j][e] * rn * gf[4 * j + e]; am = fmaxf(am, fabsf(xn[4 * j + e])); }
#pragma unroll
    for (int o = 1; o < 64; o <<= 1) am = fmaxf(am, __shfl_xor(am, o));
    const float sx = am > 0.f ? am * (1.f / 127.f) : 1.f, isx = 1.f / sx;
    int xq[4];
#pragma unroll
    for (int j = 0; j < 4; ++j) { const int a = (int)rintf(xn[4 * j] * isx), b = (int)rintf(xn[4 * j + 1] * isx), c = (int)rintf(xn[4 * j + 2] * isx), d = (int)rintf(xn[4 * j + 3] * isx);
        xq[j] = (int)((unsigned)(a & 0xff) | ((unsigned)(b & 0xff) << 8) | ((unsigned)(c & 0xff) << 16) | ((unsigned)(d & 0xff) << 24)); }
    const v2u ent = *(const GAS v2u*)(SEL + (size_t)t * 128 + 2 * lane);
    float out[16];
#pragma unroll
    for (int j = 0; j < 16; ++j) out[j] = 0.f;
    float csum = 0.f;
    const int b0 = lane & 1, b1 = (lane >> 1) & 1, b2 = (lane >> 2) & 1;
    const int kmine = b0 * 4 + b1 * 2 + b2;
    for (int gi = 0; gi < 16; ++gi) {
        v4u uw[8], vw[8];
#pragma unroll
        for (int k = 0; k < 8; ++k) {
            const unsigned ev = (unsigned)__builtin_amdgcn_readlane((int)((k & 1) ? ent.y : ent.x), gi * 4 + (k >> 1));
            const unsigned e = ev >> 16;
            uw[k] = *((const GAS v4u*)(UQ + (size_t)e * DM) + lane); vw[k] = *((const GAS v4u*)(VQ + (size_t)e * DM) + lane);
        }
        const int src = gi * 4 + (kmine >> 1);
        const unsigned ex = (unsigned)__shfl((int)ent.x, src), ey = (unsigned)__shfl((int)ent.y, src);
        const unsigned em = (kmine & 1) ? ey : ex;
        const float su = *(const GAS float*)(SU + (em >> 16)), sv = *(const GAS float*)(SV + (em >> 16));
        int part[8];
#pragma unroll
        for (int k = 0; k < 8; ++k) { int a = __builtin_amdgcn_sdot4((int)uw[k].x, xq[0], 0, false); a = __builtin_amdgcn_sdot4((int)uw[k].y, xq[1], a, false);
            a = __builtin_amdgcn_sdot4((int)uw[k].z, xq[2], a, false); part[k] = __builtin_amdgcn_sdot4((int)uw[k].w, xq[3], a, false); }
        int q4[4], q2[2], tot;
#pragma unroll
        for (int i = 0; i < 4; ++i) { const int keep = b0 ? part[i + 4] : part[i], send = b0 ? part[i] : part[i + 4]; q4[i] = keep + __shfl_xor(send, 1); }
#pragma unroll
        for (int i = 0; i < 2; ++i) { const int keep = b1 ? q4[i + 2] : q4[i], send = b1 ? q4[i] : q4[i + 2]; q2[i] = keep + __shfl_xor(send, 2); }
        { const int keep = b2 ? q2[1] : q2[0], send = b2 ? q2[0] : q2[1]; tot = keep + __shfl_xor(send, 4); }
        tot += __shfl_xor(tot, 8); tot += __shfl_xor(tot, 16); tot += __shfl_xor(tot, 32);
        const float coef = bflo(em) * gelu_exact((float)tot * (su * sx)) * sv;
#pragma unroll
        for (int k = 0; k < 8; ++k) {
            const int srcl = ((k >> 2) & 1) | (((k >> 1) & 1) << 1) | ((k & 1) << 2);
            const float c = __uint_as_float((unsigned)__builtin_amdgcn_readlane((int)__float_as_uint(coef), srcl));
            csum += c;
#pragma unroll
            for (int j = 0; j < 4; ++j) { const unsigned wv = vw[k][j];
                out[4 * j + 0] += c * (float)(wv & 0xffu); out[4 * j + 1] += c * (float)((wv >> 8) & 0xffu); out[4 * j + 2] += c * (float)((wv >> 16) & 0xffu); out[4 * j + 3] += c * (float)(wv >> 24); }
        }
    }
    const float corr = -128.f * csum;
#pragma unroll
    for (int j = 0; j < 4; ++j) { hv[j] += (f32x4){out[4 * j] + corr, out[4 * j + 1] + corr, out[4 * j + 2] + corr, out[4 * j + 3] + corr}; orow[j] = hv[j]; }
}

#ifndef MK_SPLIT
#define MK_SPLIT 0
#endif
constexpr int NPHASE = 9;
#ifndef PROBE_PH
#define PROBE_PH -1
#endif
#ifndef PROBE_N
#define PROBE_N 1
#endif
#define REPS(k) (((k) == PROBE_PH) ? 1 + PROBE_N : 1)
struct Args { const float* in[21]; float* out; unsigned char* ws; int ph_lo, ph_hi; };
static_assert(sizeof(Args) == 23 * 8 + 8, "Args has no padding");

__global__ void __launch_bounds__(NWAVES * 64, 2) fwd(Args args) {
    extern __shared__ __attribute__((aligned(16))) unsigned char lds_raw[];
    LAS unsigned char* lds = (LAS unsigned char*)lds_raw;
    volatile LAS unsigned* MISC = (volatile LAS unsigned*)(lds + MISC_OFF);
    const int tid = threadIdx.x, lane = tid & 63, wave = __builtin_amdgcn_readfirstlane(tid >> 6);
    const int G = gridDim.x; const int bx = blockIdx.x; const int vcu = (G % 8 == 0) ? (bx % 8) * (G / 8) + bx / 8 : bx;
    const int gw = vcu * NWAVES + wave, NGW = G * NWAVES;
    unsigned char* ws = args.ws;
    gu32* ctl = (gu32*)(ws + WS_CTL);
    const float* x = args.in[0]; const float* mem = args.in[1]; const float* g_mix = args.in[2]; const float* w_in = args.in[3]; const float* q_gain_a = args.in[4]; const float* k_gain_a = args.in[5];
    const float* rel_bias = args.in[6]; const float* conv_w = args.in[7]; const float* g_mem = args.in[8]; const float* w_mem_kv = args.in[9]; const float* q_gain_x = args.in[10]; const float* k_gain_x = args.in[11];
    const float* w_br_attn = args.in[12]; const float* w_br_conv = args.in[13]; const float* w_br_x = args.in[14]; const float* w_out = args.in[15]; const float* g_ffn = args.in[16];
    const float* w_query = args.in[17]; const float* sub_keys = args.in[18]; const float* peer_u = args.in[19]; const float* peer_v = args.in[20];
    float* out = args.out;
    bf16* WinT = (bf16*)(ws + WS_WIN); bf16* WkvT = (bf16*)(ws + WS_WKV); bf16* WbrT = (bf16*)(ws + WS_WBR); bf16* WoutT = (bf16*)(ws + WS_WOUT); bf16* WqT = (bf16*)(ws + WS_WQ);
    bf16* SK = (bf16*)(ws + WS_SK); float* TAB = (float*)(ws + WS_TAB); float* KMEAN = (float*)(ws + WS_KMEAN); bf16* MEMN = (bf16*)(ws + WS_MEMN); bf16* KVM = (bf16*)(ws + WS_KVM);
    float* SLOTS = (float*)(ws + WS_SLOTS); unsigned* SEL = (unsigned*)(ws + WS_SEL);
    bf16* PA = (bf16*)(ws + WS_PA); bf16* PG = (bf16*)(ws + WS_PG);
    bf16* MERGED = (bf16*)(ws + PA_MERGED); bf16* HB = (bf16*)(ws + PA_HB); unsigned char* UQ = ws + PA_UT; unsigned char* VQ = ws + PA_VT; float* SU = (float*)(ws + WS_SU); float* SV = (float*)(ws + WS_SV); bf16* QRY = (bf16*)(ws + PG_QRY);
    bf16* HN = (bf16*)out;
    bf16* BRO = (bf16*)out;

    for (int u = tid; u < (LDS_BYTES - LDSCTL_OFF) / 4; u += NWAVES * 64) ((LAS unsigned*)(lds + LDSCTL_OFF))[u] = 0u;
    __syncthreads();
#if !MK_SPLIT
    XcdBarrier bar = xcd_barrier_post((unsigned*)(ctl + CW_BAR), MISC + 8);
#define GRID_BAR() xcd_barrier(bar)
#else
#define GRID_BAR() do {} while (0)
#endif
    const int lo = args.ph_lo, hi_ = args.ph_hi;
#ifndef PH_MASK
#define PH_MASK 0x1ff
#endif
#define IN(k) ((((PH_MASK) >> (k)) & 1) && lo <= (k) && (k) < hi_)
#define BOTH(k) (IN(k) && IN((k) + 1))

    if (IN(0)) for (int rep = 0; rep < REPS(0); ++rep) {
        P0Args a{x, mem, g_mix, w_in, rel_bias, g_mem, w_mem_kv, w_br_attn, w_br_conv, w_br_x, w_out, g_ffn, w_query, sub_keys, WinT, WkvT, WbrT, WoutT, WqT, SK, HN, MEMN, TAB};
        p0_prologue(a, lds, gw, NGW, wave, lane);
        if (BOTH(0) && rep == REPS(0) - 1) GRID_BAR();
    }
    if (IN(1)) for (int rep = 0; rep < REPS(1); ++rep) {
        { pg8::Gemm g{HN, WinT, T, PW, DM}; pg8::GOrder S; S.init(T, PW, G, bx); pg8::EpiProj E{PA, PG};
          pg8::gemm_phase<pg8::EpiProj, pg8::GOrder, true, true>(lds + RING_OFF, g, S, E); }
        { const int nfull = (64 * 26) % G; const int coff = (nfull + 32 <= G) ? bx - nfull : bx;
          pg8::Gemm g{MEMN, WkvT, NBATCH * MEMLEN, 1024, DM}; pg8::GOrder S; S.init(NBATCH * MEMLEN, 1024, G, coff); pg8::EpiBf16<0> E{KVM, 1024, nullptr, 0, 0, 1.f};
          pg8::gemm_phase<pg8::EpiBf16<0>, pg8::GOrder, true, true>(lds + RING_OFF, g, S, E); }
        if (BOTH(1) && rep == REPS(1) - 1) GRID_BAR();
    }
    if (IN(2)) {
        p2_fixup(PA, KVM, KMEAN, q_gain_a, k_gain_a, q_gain_x, k_gain_x, lds + RING_OFF, vcu, G, wave, lane);
        if (BOTH(2)) GRID_BAR();
    }
    if (IN(3)) for (int rep = 0; rep < REPS(3); ++rep) {
        for (int v = vcu; v < 256; v += G) {
            const int bh = v >> 2, b = bh >> 3, h = bh & 7, s = v & 3;
#pragma unroll 1
            for (int pass = 0; pass < 2; ++pass) { const int qb = pass ? 7 - s : s;
                const bf16* Qp = PA + (size_t)(b * SEQ + qb * 256) * PAW + COL_QA + h * 64;
                const bf16* Kp = PA + (size_t)(b * SEQ) * PAW + COL_KA + h * 64; const bf16* Vp = PA + (size_t)(b * SEQ) * PAW + COL_VA + h * 64;
                bf16* Op = BRO + (size_t)(b * SEQ + qb * 256) * 512 + h * 64;
                att::attn_unit<64, true>(Qp, PAW, Kp, Vp, PAW, Op, qb, KMEAN + (size_t)bh * 512, TAB + h * 2048, lds + RING_OFF, tid, wave, lane); }
            { const int bb = v >> 5, hx = (v >> 3) & 3, qt = v & 7;
                const bf16* Qp = PA + (size_t)(bb * SEQ + qt * 256) * PAW + COL_QX + hx * 128;
                const bf16* Kp = KVM + (size_t)(bb * MEMLEN) * 1024 + hx * 128; const bf16* Vp = Kp + 512;
                bf16* Op = BRO + (size_t)2 * T * 512 + (size_t)(bb * SEQ + qt * 256) * 512 + hx * 128;
                att::attn_unit<128, false>(Qp, PAW, Kp, Vp, 1024, Op, 0, nullptr, nullptr, lds + RING_OFF, tid, wave, lane); }
            conv_item(PA, conv_w, BRO + (size_t)T * 512, v, tid);
        }
        if (BOTH(3) && rep == REPS(3) - 1) GRID_BAR();
    }
    if (IN(4)) for (int rep = 0; rep < REPS(4); ++rep) {
        pg8::Gemm g{BRO, WbrT, 3 * T, 3 * 1024, 512}; pg8::BranchOrder S; S.init(G, bx); pg8::EpiBranch E{PG, MERGED};
        pg8::gemm_phase<pg8::EpiBranch, pg8::BranchOrder, true, true>(lds + RING_OFF, g, S, E);
        if (BOTH(4) && rep == REPS(4) - 1) GRID_BAR();
    }
    if (IN(5)) for (int rep = 0; rep < REPS(5); ++rep) {
        pg8::Gemm g{MERGED, WoutT, T, 1024, DM}; pg8::GOrder S; S.init(T, 1024, G, bx); pg8::EpiWout E{x, out, HB, SLOTS};
        pg8::gemm_phase<pg8::EpiWout, pg8::GOrder, true, true>(lds + RING_OFF, g, S, E);
        if (BOTH(5) && rep == REPS(5) - 1) GRID_BAR();
    }
    if (IN(6)) for (int rep = 0; rep < REPS(6); ++rep) {
        pg8::Gemm g{HB, WqT, T, 2048, DM}; pg8::GOrder S; S.init(T, 2048, G, bx); pg8::EpiBf16<0> E{QRY, 2048, nullptr, 0, 0, 1.f};
        pg8::gemm_phase<pg8::EpiBf16<0>, pg8::GOrder, true, true>(lds + RING_OFF, g, S, E);
        if (BOTH(6) && rep == REPS(6) - 1) GRID_BAR();
    }
    if (IN(7)) for (int rep = 0; rep < REPS(7); ++rep) {
        for (int v = vcu; v < 256; v += G) { pk::topk_unit(QRY, SK, SLOTS, SEL, lds + RING_OFF, v, tid, wave, lane); __syncthreads(); }
        for (int m = gw; m < 2 * NEXP; m += NGW) { if (m < NEXP) quant_row<false>(peer_u + (size_t)m * DM, UQ + (size_t)m * DM, SU + m, lane); else quant_row<true>(peer_v + (size_t)(m - NEXP) * DM, VQ + (size_t)(m - NEXP) * DM, SV + (m - NEXP), lane); }
        if (BOTH(7) && rep == REPS(7) - 1) GRID_BAR();
    }
    if (IN(8)) {
        float gf[16];
#pragma unroll
        for (int j = 0; j < 4; ++j)
#pragma unroll
            for (int e = 0; e < 4; ++e) gf[4 * j + e] = g_ffn[16 * lane + 4 * j + e];
        for (int rep = 0; rep < REPS(8); ++rep) { float* dst = (rep == REPS(8) - 1) ? out : (float*)QRY;
            for (int t = gw; t < T; t += NGW) gather_token(out, dst, SEL, UQ, VQ, SU, SV, gf, t, lane); }
    }
#undef IN
#undef BOTH
}

extern "C" void kernel_launch(void* const* d_in, const int* in_sizes, int n_in, void* d_out, int out_size, void* d_ws, size_t ws_size, hipStream_t stream) {
    static int grid = 0;
    if (grid == 0) {
        if (n_in != 21 || out_size != T * DM || ws_size < WS_END) { fprintf(stderr, "kernel_launch: unexpected shapes (n_in %d, out %d, ws %zu)\n", n_in, out_size, ws_size); grid = -1; return; }
        int dev = 0, cus = 0, per_cu = 0;
        if (hipGetDevice(&dev) != hipSuccess || hipDeviceGetAttribute(&cus, hipDeviceAttributeMultiprocessorCount, dev) != hipSuccess) { grid = -1; return; }
        if (hipFuncSetAttribute((const void*)fwd, hipFuncAttributeMaxDynamicSharedMemorySize, LDS_BYTES) != hipSuccess) { fprintf(stderr, "kernel_launch: hipFuncSetAttribute failed\n"); grid = -1; return; }
        if (hipOccupancyMaxActiveBlocksPerMultiprocessor(&per_cu, (const void*)fwd, NWAVES * 64, LDS_BYTES) != hipSuccess || per_cu < 1) { fprintf(stderr, "kernel_launch: occupancy query reports %d\n", per_cu); }
        (void)hipGetLastError();
        grid = cus;
    }
    if (grid < 0) return;
    (void)hipMemsetAsync((char*)d_ws + WS_CTL, 0, CTL_ZERO_BYTES, stream);
    Args a{};
    for (int i = 0; i < 21; ++i) a.in[i] = (const float*)d_in[i];
    a.out = (float*)d_out; a.ws = (unsigned char*)d_ws;
#if MK_SPLIT
    for (int p = 0; p < NPHASE; ++p) { a.ph_lo = p; a.ph_hi = p + 1; hipLaunchKernelGGL(fwd, dim3(grid), dim3(NWAVES * 64), LDS_BYTES, stream, a); }
#else
    a.ph_lo = 0; a.ph_hi = NPHASE;
    hipLaunchKernelGGL(fwd, dim3(grid), dim3(NWAVES * 64), LDS_BYTES, stream, a);
#endif
}
```

```cpp
#include <hip/hip_runtime.h>
#include <hip/hip_bf16.h>
#include <cstdio>
#include <cstdint>
#include <cmath>
namespace pg8 {
#define PG8_LAS __attribute__((address_space(3)))
typedef unsigned short bf16_t;
typedef short bf16x8 __attribute__((ext_vector_type(8)));
typedef float f32x4 __attribute__((ext_vector_type(4)));
typedef unsigned u32x4 __attribute__((ext_vector_type(4)));
constexpr int BM = 256, BK = 64, HALF = 128, HTB = HALF * BK * 2  , STAGE_BYTES = 8 * HTB, NXCD = 8, WGM = 8;

__host__ __device__ __forceinline__ int lds_byte(int r, int c) { const int st = (r >> 4) * 2 + (c >> 5), rr = r & 15, cc = c & 31, ob = rr * 64 + cc * 2; return st * 1024 + (ob ^ (((ob >> 9) & 1) << 5)); }
__host__ __device__ __forceinline__ void stage_rc(int b, int& R, int& C) { const int st = b / 1024, sb = b % 1024, swz = sb ^ (((sb >> 9) & 1) << 5); R = (st >> 1) * 16 + swz / 64; C = (st & 1) * 32 + (swz % 64) / 2; }
__host__ __device__ __forceinline__ int perm32(int rho) { const int n = rho >> 4, i = rho & 15; return 8 * (i >> 2) + 4 * n + (i & 3); }

struct Unit { int pm, pn; };
struct Gemm { const bf16_t* A; const bf16_t* Bt; int M, N, K; };

struct StaticOrder {
    int nM, nN, nwg, G, c;
    __host__ __device__ void init(int M, int N, int G_, int c_) { nM = M / BM; nN = N / BM; nwg = nM * nN; G = G_; c = c_; }
    __host__ __device__ bool next(int i, Unit& u) const {
        const long L = (long)i * G + c; if (L >= nwg) return false;
        int wgid = (int)L; { const int q = nwg / NXCD, r = nwg % NXCD, xcd = wgid % NXCD, off = wgid / NXCD; wgid = (xcd < r ? xcd * (q + 1) : r * (q + 1) + (xcd - r) * q) + off; }
        const int nig = WGM * nN, gid = wgid / nig, fm = gid * WGM, gsz = (nM - fm) < WGM ? (nM - fm) : WGM;
        u.pm = fm + ((wgid % nig) % gsz); u.pn = (wgid % nig) / gsz; return true;
    }
    __device__ __forceinline__ void a_ready(const Unit&) const {}
    __device__ __forceinline__ void done(const Unit&) const {}
};

__device__ __forceinline__ unsigned cvt_pk_bf16(float lo, float hi) { unsigned r; asm volatile("v_cvt_pk_bf16_f32 %0, %1, %2" : "=v"(r) : "v"(lo), "v"(hi)); return r; }
typedef float f32x2 __attribute__((ext_vector_type(2)));
__device__ __forceinline__ f32x2 gelu_pk(f32x2 v) {
    const f32x2 av = __builtin_elementwise_abs(v), d = av * 0.2316418882f + 1.0f;
    f32x2 t; t.x = __builtin_amdgcn_rcpf(d.x); t.y = __builtin_amdgcn_rcpf(d.y);
    f32x2 q = t * 0.5307027145f + (-0.7265760135f); q = q * t + 0.7107068705f; q = q * t + (-0.142248368f); q = q * t + 0.127414796f; q = q * t;
    const f32x2 s = (v * v) * (-0.72134752044f);
    f32x2 e; e.x = __builtin_amdgcn_exp2f(s.x); e.y = __builtin_amdgcn_exp2f(s.y);
    const f32x2 m = v * (q * e), r = v - m;
    f32x2 o; o.x = v.x < 0.f ? m.x : r.x; o.y = v.y < 0.f ? m.y : r.y; return o;
}

template <int ACT  > struct EpiBf16 {
    static constexpr bool PERM = true, AFTER_DRAIN = false; static_assert(ACT == 0 || ACT == 1, "EpiBf16: ACT is 0 (none) or 1 (gelu_pk)");
    bf16_t* O; int ldc; const float* bias; int split_cols; size_t split_stride; float scale0;
    __device__ __forceinline__ void operator()(const f32x4 (&acc)[2][2][4][2], const Unit& u, int wr, int wc, int fr, int fq) const {
        const int row0 = u.pm * BM + wr * 64 + fr; int colt = u.pn * BM; bf16_t* base = O;
        float sc = 1.f; if (split_cols) { const int t = colt / split_cols; base += (size_t)t * split_stride; colt -= t * split_cols; if (t == 0) sc = scale0; }
        const int col0 = colt + wc * 32 + 8 * fq, bcol0 = u.pn * BM + wc * 32 + 8 * fq;
        f32x4 bv[2][2];
#pragma unroll
        for (int bj = 0; bj < 2; ++bj)
#pragma unroll
            for (int n = 0; n < 2; ++n) bv[bj][n] = bias ? *(const f32x4*)(bias + bcol0 + bj * HALF + 4 * n) : (f32x4){0.f, 0.f, 0.f, 0.f};
#pragma unroll
        for (int ai = 0; ai < 2; ++ai)
#pragma unroll
            for (int m = 0; m < 4; ++m) { bf16_t* rowp = base + (size_t)(row0 + ai * HALF + m * 16) * ldc + col0;
#pragma unroll
                for (int bj = 0; bj < 2; ++bj) { f32x4 v0 = acc[ai][bj][m][0] + bv[bj][0], v1 = acc[ai][bj][m][1] + bv[bj][1];
                    if (ACT == 1) { f32x2 a = gelu_pk((f32x2){v0[0], v0[1]}), b = gelu_pk((f32x2){v0[2], v0[3]}), c = gelu_pk((f32x2){v1[0], v1[1]}), d = gelu_pk((f32x2){v1[2], v1[3]});
                        v0 = (f32x4){a.x, a.y, b.x, b.y}; v1 = (f32x4){c.x, c.y, d.x, d.y}; }
                    v0 = v0 * sc; v1 = v1 * sc; u32x4 w; w.x = cvt_pk_bf16(v0[0], v0[1]); w.y = cvt_pk_bf16(v0[2], v0[3]); w.z = cvt_pk_bf16(v1[0], v1[1]); w.w = cvt_pk_bf16(v1[2], v1[3]);
                    *(u32x4*)(rowp + bj * HALF) = w; } }
    }
};


struct GOrder {
    int nM, nN, nwg, G, c;
    __host__ __device__ void init(int M, int N, int G_, int c_) { nM = M / BM; nN = N / BM; nwg = nM * nN; G = G_; c = c_; }
    __host__ __device__ bool next(int i, Unit& u) const {
        if (c < 0) return false;
        const long L = (long)i * G + c; if (L >= nwg) return false;
        int wgid = (int)L; { const int q = nwg / NXCD, r = nwg % NXCD, xcd = wgid % NXCD, off = wgid / NXCD; wgid = (xcd < r ? xcd * (q + 1) : r * (q + 1) + (xcd - r) * q) + off; }
        const int nig = WGM * nN, gid = wgid / nig, fm = gid * WGM, gsz = (nM - fm) < WGM ? (nM - fm) : WGM;
        u.pm = fm + ((wgid % nig) % gsz); u.pn = (wgid % nig) / gsz; return true;
    }
    __device__ __forceinline__ void a_ready(const Unit&) const {}
    __device__ __forceinline__ void done(const Unit&) const {}
};
struct BranchOrder {
    GOrder g;
    __device__ void init(int G, int c) { g.init(16384, 1024, G, c); }
    __device__ bool next(int i, Unit& u) const { Unit t; if (!g.next(i / 3, t)) return false; const int br = i % 3; u.pm = 64 * br + t.pm; u.pn = 4 * br + t.pn; return true; }
    __device__ __forceinline__ void a_ready(const Unit&) const {}
    __device__ __forceinline__ void done(const Unit&) const {}
};
__device__ __forceinline__ float bf_lo(unsigned w) { return __builtin_bit_cast(float, w << 16); }
__device__ __forceinline__ float bf_hi(unsigned w) { return __builtin_bit_cast(float, w & 0xffff0000u); }
__device__ __forceinline__ float sigmoid_f(float x) { return __builtin_amdgcn_rcpf(1.0f + __builtin_amdgcn_exp2f(-1.4426950408889634f * x)); }
struct EpiProj {
    static constexpr bool PERM = true, AFTER_DRAIN = false;
    bf16_t* PA; bf16_t* PG;
    __device__ __forceinline__ void operator()(const f32x4 (&acc)[2][2][4][2], const Unit& u, int wr, int wc, int fr, int fq) const {
        const bool gate = u.pn >= 14;
        bf16_t* base = gate ? PG : PA; const int ldc = gate ? 3072 : 3584; const int colt = gate ? (u.pn - 14) * BM : u.pn * BM;
        const int row0 = u.pm * BM + wr * 64 + fr, col0 = colt + wc * 32 + 8 * fq;
#pragma unroll
        for (int ai = 0; ai < 2; ++ai)
#pragma unroll
            for (int m = 0; m < 4; ++m) { bf16_t* rowp = base + (size_t)(row0 + ai * HALF + m * 16) * ldc + col0;
#pragma unroll
                for (int bj = 0; bj < 2; ++bj) { f32x4 v0 = acc[ai][bj][m][0], v1 = acc[ai][bj][m][1];
                    if (gate) {
#pragma unroll
                        for (int e = 0; e < 4; ++e) { v0[e] = sigmoid_f(v0[e]); v1[e] = sigmoid_f(v1[e]); } }
                    u32x4 w; w.x = cvt_pk_bf16(v0[0], v0[1]); w.y = cvt_pk_bf16(v0[2], v0[3]); w.z = cvt_pk_bf16(v1[0], v1[1]); w.w = cvt_pk_bf16(v1[2], v1[3]);
                    *(u32x4*)(rowp + bj * HALF) = w; } }
    }
};
struct EpiBranch {
    static constexpr bool PERM = true, AFTER_DRAIN = false;
    const bf16_t* PG; bf16_t* MG;
    __device__ __forceinline__ void operator()(const f32x4 (&acc)[2][2][4][2], const Unit& u, int wr, int wc, int fr, int fq) const {
        const int br = u.pm >> 6, tm = u.pm & 63, tn = u.pn & 3;
        const int row0 = tm * BM + wr * 64 + fr, col0 = tn * BM + wc * 32 + 8 * fq;
#pragma unroll
        for (int ai = 0; ai < 2; ++ai)
#pragma unroll
            for (int m = 0; m < 4; ++m) { const size_t row = (size_t)(row0 + ai * HALF + m * 16);
#pragma unroll
                for (int bj = 0; bj < 2; ++bj) { const int col = col0 + bj * HALF;
                    const u32x4 g = *(const u32x4*)(PG + row * 3072 + br * 1024 + col);
                    f32x4 v0 = acc[ai][bj][m][0], v1 = acc[ai][bj][m][1];
                    v0[0] *= bf_lo(g.x); v0[1] *= bf_hi(g.x); v0[2] *= bf_lo(g.y); v0[3] *= bf_hi(g.y);
                    v1[0] *= bf_lo(g.z); v1[1] *= bf_hi(g.z); v1[2] *= bf_lo(g.w); v1[3] *= bf_hi(g.w);
                    bf16_t* mp = MG + row * 1024 + col;
                    if (br > 0) { const u32x4 p = *(const u32x4*)mp;
                        v0[0] += bf_lo(p.x); v0[1] += bf_hi(p.x); v0[2] += bf_lo(p.y); v0[3] += bf_hi(p.y);
                        v1[0] += bf_lo(p.z); v1[1] += bf_hi(p.z); v1[2] += bf_lo(p.w); v1[3] += bf_hi(p.w); }
                    u32x4 w; w.x = cvt_pk_bf16(v0[0], v0[1]); w.y = cvt_pk_bf16(v0[2], v0[3]); w.z = cvt_pk_bf16(v1[0], v1[1]); w.w = cvt_pk_bf16(v1[2], v1[3]);
                    *(u32x4*)mp = w; } }
    }
};
struct EpiWout {
    static constexpr bool PERM = false, AFTER_DRAIN = false;
    const float* X; float* H; bf16_t* HB; float* SL;
    __device__ __forceinline__ void operator()(const f32x4 (&acc)[2][2][4][2], const Unit& u, int wr, int wc, int fr, int fq) const {
        const int row0 = u.pm * BM + wr * 64 + fr, col0 = u.pn * BM + wc * 32 + 4 * fq;
#pragma unroll
        for (int ai = 0; ai < 2; ++ai)
#pragma unroll
            for (int m = 0; m < 4; ++m) { const size_t row = (size_t)(row0 + ai * HALF + m * 16); float ss = 0.f;
#pragma unroll
                for (int bj = 0; bj < 2; ++bj)
#pragma unroll
                    for (int n = 0; n < 2; ++n) { const size_t off = row * 1024 + col0 + bj * HALF + n * 16;
                        const f32x4 xv = *(const f32x4*)(X + off); const f32x4 hv = xv + acc[ai][bj][m][n];
                        *(f32x4*)(H + off) = hv; ss += (hv[0] * hv[0] + hv[1] * hv[1]) + (hv[2] * hv[2] + hv[3] * hv[3]);
                        typedef unsigned u32x2v __attribute__((ext_vector_type(2))); u32x2v w; w.x = cvt_pk_bf16(hv[0], hv[1]); w.y = cvt_pk_bf16(hv[2], hv[3]);
                        *(u32x2v*)(HB + off) = w; }
                ss += __shfl_xor(ss, 16); ss += __shfl_xor(ss, 32);
                if (fq == 0) SL[row * 16 + u.pn * 4 + wc] = ss; }
    }
};
template <class Epi, class Sched, bool ALIGN_EPI = false, bool SP2 = false>
__device__ __forceinline__ void gemm_phase(PG8_LAS unsigned char* lds, const Gemm g, const Sched& S, const Epi& E) {
    const int tid = threadIdx.x, wid = __builtin_amdgcn_readfirstlane(tid >> 6), lane = tid & 63, wr = wid >> 2, wc = wid & 3, fr = lane & 15, fq = lane >> 4;
    const int K = g.K, nt = K / BK;
    unsigned voffA[2], voffB[2];
#pragma unroll
    for (int i = 0; i < 2; ++i) { int R, C; stage_rc(tid * 16 + i * 8192, R, C); const int Rb = Epi::PERM ? ((R & ~31) + perm32(R & 31)) : R;
        voffA[i] = (unsigned)(R * K + C) * 2u; voffB[i] = (unsigned)(Rb * K + C) * 2u; }
    const size_t kstep = (size_t)(BK * 2);
    const size_t hstep = (size_t)HALF * K * 2;
    const size_t tstep = 2 * hstep;
    const unsigned ldsw = (unsigned)wid * 1024u;
    const int aoff = lds_byte(wr * 64 + fr, fq * 8), boff = lds_byte(wc * 32 + fr, fq * 8);
#define PG8_SA(b, h) (((b) * 2 + (h)) * HTB)
#define PG8_SB(b, h) ((4 + (b) * 2 + (h)) * HTB)
#define PG8_STAGE(bufoff, gbase, voff) do { _Pragma("unroll") for (int _i = 0; _i < 2; ++_i) \
        __builtin_amdgcn_global_load_lds((const unsigned*)((const char*)(gbase) + (voff)[_i]), (PG8_LAS unsigned*)(lds + (bufoff) + ldsw + _i * 8192), 16, 0, 0); } while (0)
#define PG8_LDA(dst, b, h) do { _Pragma("unroll") for (int m = 0; m < 4; ++m) _Pragma("unroll") for (int k = 0; k < 2; ++k) dst[m][k] = *(const PG8_LAS bf16x8*)(lds + PG8_SA(b, h) + aoff + m * 2048 + k * 1024); } while (0)
#define PG8_LDB(dst, b, h) do { _Pragma("unroll") for (int n = 0; n < 2; ++n) _Pragma("unroll") for (int k = 0; k < 2; ++k) dst[n][k] = *(const PG8_LAS bf16x8*)(lds + PG8_SB(b, h) + boff + n * 2048 + k * 1024); } while (0)
#define PG8_MMA(ai, bj, At, Bt) do { __builtin_amdgcn_s_setprio(1); _Pragma("unroll") for (int m = 0; m < 4; ++m) _Pragma("unroll") for (int n = 0; n < 2; ++n) _Pragma("unroll") for (int k = 0; k < 2; ++k) \
        acc[ai][bj][m][n] = __builtin_amdgcn_mfma_f32_16x16x32_bf16(Bt[n][k], At[m][k], acc[ai][bj][m][n], 0, 0, 0); __builtin_amdgcn_s_setprio(0); } while (0)
#define PG8_WAIT_V(n) asm volatile("s_waitcnt vmcnt(" #n ")" ::: "memory")
#define PG8_WAIT_L(n) asm volatile("s_waitcnt lgkmcnt(" #n ")" ::: "memory")
#define PG8_BAR __builtin_amdgcn_s_barrier()
#define PG8_SCHED __builtin_amdgcn_sched_barrier(0)
    Unit cur, nxt; int ui = 0;
    if (!S.next(0, cur)) return;
    f32x4 acc[2][2][4][2];
#pragma unroll
    for (int a = 0; a < 2; ++a)
#pragma unroll
        for (int b = 0; b < 2; ++b)
#pragma unroll
            for (int m = 0; m < 4; ++m)
#pragma unroll
                for (int n = 0; n < 2; ++n) acc[a][b][m][n] = (f32x4){0.f, 0.f, 0.f, 0.f};
    bf16x8 At[4][2], B0[2][2], B1[2][2];
    const char* cA = (const char*)g.A + (size_t)cur.pm * tstep; const char* cB = (const char*)g.Bt + (size_t)cur.pn * tstep;
    S.a_ready(cur);
    if constexpr (SP2) {
        PG8_STAGE(PG8_SB(0, 0), cB, voffB); PG8_STAGE(PG8_SB(0, 1), cB + hstep, voffB); PG8_STAGE(PG8_SA(0, 0), cA, voffA); PG8_STAGE(PG8_SA(0, 1), cA + hstep, voffA);
        if (wr == 1) PG8_BAR;
        PG8_WAIT_V(2); PG8_BAR;
        PG8_STAGE(PG8_SB(1, 0), cB + kstep, voffB); PG8_STAGE(PG8_SA(1, 0), cA + kstep, voffA); PG8_STAGE(PG8_SB(1, 1), cB + hstep + kstep, voffB);
        PG8_WAIT_V(6); PG8_BAR;
    } else {
        PG8_STAGE(PG8_SB(0, 0), cB, voffB); PG8_STAGE(PG8_SA(0, 0), cA, voffA); PG8_STAGE(PG8_SB(0, 1), cB + hstep, voffB); PG8_STAGE(PG8_SA(0, 1), cA + hstep, voffA);
        if (wr == 1) PG8_BAR;
        PG8_WAIT_V(4); PG8_BAR;
        PG8_STAGE(PG8_SB(1, 0), cB + kstep, voffB); PG8_STAGE(PG8_SA(1, 0), cA + kstep, voffA); PG8_STAGE(PG8_SB(1, 1), cB + hstep + kstep, voffB);
        PG8_WAIT_V(6); PG8_BAR;
    }
    for (;;) {
        const bool has_next = S.next(ui + 1, nxt);
        const char* nA = has_next ? (const char*)g.A + (size_t)nxt.pm * tstep : cA; const char* nB = has_next ? (const char*)g.Bt + (size_t)nxt.pn * tstep : cB;
        for (int t = 0; t < nt; t += 2) {
            const bool last = (t == nt - 2);
            const char* a1 = cA + (size_t)(t + 1) * kstep;
            const char* a2 = last ? nA : cA + (size_t)(t + 2) * kstep; const char* b2 = last ? nB : cB + (size_t)(t + 2) * kstep;
            const char* a3 = a2 + kstep; const char* b3 = b2 + kstep;
            if (last && has_next) S.a_ready(nxt);
            if constexpr (SP2) {
            PG8_LDB(B0, 0, 0); PG8_LDB(B1, 0, 1); PG8_SCHED; PG8_LDA(At, 0, 0); PG8_STAGE(PG8_SA(1, 1), a1 + hstep, voffA);
            PG8_WAIT_V(8); PG8_WAIT_L(0); PG8_BAR; PG8_MMA(0, 0, At, B0); PG8_MMA(0, 1, At, B1); PG8_BAR; PG8_SCHED;
            PG8_LDA(At, 0, 1); PG8_STAGE(PG8_SB(0, 0), b2, voffB); PG8_STAGE(PG8_SB(0, 1), b2 + hstep, voffB); PG8_STAGE(PG8_SA(0, 0), a2, voffA);
            PG8_WAIT_V(8); PG8_WAIT_L(0); PG8_BAR; PG8_MMA(1, 0, At, B0); PG8_MMA(1, 1, At, B1); PG8_BAR; PG8_SCHED;
            PG8_LDB(B0, 1, 0); PG8_LDB(B1, 1, 1); PG8_SCHED; PG8_LDA(At, 1, 0); PG8_STAGE(PG8_SA(0, 1), a2 + hstep, voffA);
            PG8_WAIT_V(8); PG8_WAIT_L(0); PG8_BAR; PG8_MMA(0, 0, At, B0); PG8_MMA(0, 1, At, B1); PG8_BAR; PG8_SCHED;
            PG8_LDA(At, 1, 1); PG8_STAGE(PG8_SB(1, 0), b3, voffB); PG8_STAGE(PG8_SB(1, 1), b3 + hstep, voffB); PG8_STAGE(PG8_SA(1, 0), a3, voffA);
            PG8_WAIT_V(8); PG8_WAIT_L(0); PG8_BAR; PG8_MMA(1, 0, At, B0); PG8_MMA(1, 1, At, B1); PG8_BAR; PG8_SCHED;
            } else {
            PG8_LDB(B0, 0, 0); PG8_SCHED; PG8_LDA(At, 0, 0); PG8_STAGE(PG8_SA(1, 1), a1 + hstep, voffA);
            PG8_WAIT_L(8); PG8_BAR; PG8_WAIT_L(0); PG8_MMA(0, 0, At, B0); PG8_BAR; PG8_SCHED;
            PG8_LDB(B1, 0, 1); PG8_STAGE(PG8_SB(0, 0), b2, voffB);
            PG8_BAR; PG8_WAIT_L(0); PG8_MMA(0, 1, At, B1); PG8_BAR;
            PG8_LDA(At, 0, 1); PG8_STAGE(PG8_SA(0, 0), a2, voffA);
            PG8_BAR; PG8_WAIT_L(0); PG8_MMA(1, 0, At, B0); PG8_BAR; PG8_SCHED;
            PG8_STAGE(PG8_SB(0, 1), b2 + hstep, voffB);
            PG8_WAIT_V(6); PG8_BAR; PG8_MMA(1, 1, At, B1); PG8_BAR;
            PG8_LDB(B0, 1, 0); PG8_SCHED; PG8_LDA(At, 1, 0); PG8_STAGE(PG8_SA(0, 1), a2 + hstep, voffA);
            PG8_WAIT_L(8); PG8_BAR; PG8_WAIT_L(0); PG8_MMA(0, 0, At, B0); PG8_BAR; PG8_SCHED;
            PG8_LDB(B1, 1, 1); PG8_STAGE(PG8_SB(1, 0), b3, voffB);
            PG8_BAR; PG8_WAIT_L(0); PG8_MMA(0, 1, At, B1); PG8_BAR;
            PG8_LDA(At, 1, 1); PG8_STAGE(PG8_SA(1, 0), a3, voffA);
            PG8_BAR; PG8_WAIT_L(0); PG8_MMA(1, 0, At, B0); PG8_BAR; PG8_SCHED;
            PG8_STAGE(PG8_SB(1, 1), b3 + hstep, voffB);
            PG8_WAIT_V(6); PG8_BAR; PG8_MMA(1, 1, At, B1); PG8_BAR;
            }
        }
        if constexpr (ALIGN_EPI) { if (wr == 0) PG8_BAR; }
        if constexpr (!Epi::AFTER_DRAIN) { E(acc, cur, wr, wc, fr, fq); S.done(cur); }
        if (!has_next) break;
#pragma unroll
        for (int a = 0; a < 2; ++a)
#pragma unroll
            for (int b = 0; b < 2; ++b)
#pragma unroll
                for (int m = 0; m < 4; ++m)
#pragma unroll
                    for (int n = 0; n < 2; ++n) acc[a][b][m][n] = (f32x4){0.f, 0.f, 0.f, 0.f};
        cur = nxt; cA = nA; cB = nB; ++ui;
        if constexpr (ALIGN_EPI) { if (wr == 1) PG8_BAR; }
    }
    PG8_WAIT_V(0);
    if constexpr (!ALIGN_EPI) { if (wr == 0) PG8_BAR; }
    PG8_BAR;
    if constexpr (Epi::AFTER_DRAIN) { E.fused(acc, cur, wr, wc, fr, fq, lds, wid, lane); S.done(cur); }
#undef PG8_SA
#undef PG8_SB
#undef PG8_STAGE
#undef PG8_LDA
#undef PG8_LDB
#undef PG8_MMA
#undef PG8_WAIT_V
#undef PG8_WAIT_L
#undef PG8_BAR
#undef PG8_SCHED
}
}

constexpr int NWAVES = 8;
constexpr int T = 16384, DM = 1024, SEQ = 2048, NBATCH = 8, MEMLEN = 256;
constexpr int PW = 6656, PAW = 3584, PGW = 3072;
constexpr int COL_QA = 0, COL_KA = 512, COL_VA = 1024, COL_UC = 1536, COL_BC = 2048, COL_CC = 2560, COL_QX = 3072;
constexpr float RMS_EPS = 1e-6f, LOG2E = 1.4426950408889634f;
constexpr float C2A = 0.125f * LOG2E;
constexpr float C2X = 0.08838834764831845f * LOG2E;
constexpr int NEXP = 16384;

constexpr size_t MiB = 1u << 20;
constexpr size_t WS_CTL = 0, CTL_ZERO_BYTES = 1 * MiB;
constexpr size_t WS_WIN = 1 * MiB;
constexpr size_t WS_WKV = 14 * MiB;
constexpr size_t WS_WBR = 16 * MiB;
constexpr size_t WS_WOUT = 19 * MiB;
constexpr size_t WS_WQ = 21 * MiB;
constexpr size_t WS_SK = 25 * MiB;
constexpr size_t WS_TAB = 25 * MiB + 512 * 1024;
constexpr size_t WS_KMEAN = WS_TAB + 64 * 1024;
constexpr size_t WS_MEMN = 26 * MiB;
constexpr size_t WS_KVM = 30 * MiB;
constexpr size_t WS_SLOTS = 34 * MiB;
constexpr size_t WS_SEL = 35 * MiB;
constexpr size_t WS_SU = 43 * MiB, WS_SV = 43 * MiB + 65536, WS_SX = 43 * MiB + 2 * 65536, WS_CS = 43 * MiB + 3 * 65536;
constexpr size_t WS_PA = 44 * MiB;
constexpr size_t WS_PG = 156 * MiB;
constexpr size_t WS_END = 252 * MiB;
constexpr size_t PA_MERGED = WS_PA, PA_HB = WS_PA + 32 * MiB, PA_UT = WS_PA + 64 * MiB, PA_VT = WS_PA;
constexpr size_t PG_QRY = WS_PG, PG_PART = WS_PG, PG_COEF = WS_PG + 64 * MiB, PA_XQ = WS_PA + 32 * MiB;
constexpr int CW_QU = 8192, CW_QV = 8192 + 512;
constexpr int CW_BAR = 4096;

constexpr int RING_OFF = 0, RING_BYTES = 131072;
constexpr int LDSCTL_OFF = RING_BYTES, MISC_OFF = LDSCTL_OFF + 320;
constexpr int LDS_BYTES = 147456;

#define GAS __attribute__((address_space(1)))
#define LAS __attribute__((address_space(3)))
typedef unsigned short bf16;
typedef unsigned v4u __attribute__((ext_vector_type(4)));
typedef unsigned v2u __attribute__((ext_vector_type(2)));
typedef float f32x4 __attribute__((ext_vector_type(4)));
typedef float f32x16 __attribute__((ext_vector_type(16)));
typedef short bf16x8 __attribute__((ext_vector_type(8)));
typedef short s16x4 __attribute__((ext_vector_type(4)));
typedef GAS unsigned gu32;
#define RLX_AGENT __ATOMIC_RELAXED, __HIP_MEMORY_SCOPE_AGENT
#define LDS_WAIT() asm volatile("s_waitcnt lgkmcnt(0)" ::: "memory")
#define VM_WAIT() asm volatile("s_waitcnt vmcnt(0)" ::: "memory")
__device__ __forceinline__ unsigned f2bf(float f) { unsigned u = __builtin_bit_cast(unsigned, f); return (u + 0x7fffu + ((u >> 16) & 1u)) >> 16; }
__device__ __forceinline__ unsigned pk2(float lo, float hi) { return f2bf(lo) | (f2bf(hi) << 16); }
__device__ __forceinline__ float bflo(unsigned w) { return __builtin_bit_cast(float, w << 16); }
__device__ __forceinline__ float bfhi(unsigned w) { return __builtin_bit_cast(float, w & 0xffff0000u); }
__device__ __forceinline__ float wave_sum(float v) {
#pragma unroll
    for (int o = 1; o < 64; o <<= 1) v += __shfl_xor(v, o);
    return v;
}
#define XB_TMO      128
#define XB_XCNT(j)  (256  + 64 * (j))
#define XB_XSUB(j)  (1280 + 64 * (j))
#define XB_XGEN(j)  (2304 + 64 * (j))
#define XB_TOP      3328
#define XB_TOPGEN   3392
#define XCD_BAR_WORDS 3456
#define XB_SPIN_CAP (1u << 18)

__device__ __forceinline__ unsigned xb_ld(unsigned* p)              { return __hip_atomic_load(p, __ATOMIC_RELAXED, __HIP_MEMORY_SCOPE_AGENT); }
__device__ __forceinline__ unsigned xb_add(unsigned* p, unsigned v) { return __hip_atomic_fetch_add(p, v, __ATOMIC_RELAXED, __HIP_MEMORY_SCOPE_AGENT); }
__device__ __forceinline__ unsigned xb_xcc_id() { return (unsigned)__builtin_amdgcn_s_getreg((3 << 11) | 20) & 0xFu; }
#define XB_SPIN(cond, bar) do { unsigned _sp = 0; while (cond) { __builtin_amdgcn_s_sleep(1); \
    if ((++_sp & 255u) == 0u) { if (xb_ld(&(bar)[XB_TMO])) break; if (_sp > XB_SPIN_CAP) { atomicAdd(&(bar)[XB_TMO], 1u); break; } } } } while (0)

struct XcdBarrier {
    unsigned* bar; unsigned x;
    volatile LAS unsigned* st;
};

__device__ __forceinline__ XcdBarrier xcd_barrier_post(unsigned* bar, volatile LAS unsigned* st) {
    XcdBarrier b; b.bar = bar; b.x = xb_xcc_id(); b.st = st;
    if (threadIdx.x == 0) (void)xb_add(&bar[XB_XCNT(b.x)], 1u);
    return b;
}
__device__ __forceinline__ void xcd_barrier_complete(unsigned* bar, unsigned x, unsigned& nloc, unsigned& nx) {
    const unsigned G = gridDim.x * gridDim.y * gridDim.z;
    unsigned sum, cnt, mine, sp = 0u;
    for (;;) {
        sum = 0u; cnt = 0u; mine = 0u;
#pragma unroll
        for (unsigned j = 0; j < 16; ++j) { const unsigned c = xb_ld(&bar[XB_XCNT(j)]); sum += c; cnt += (c > 0u) ? 1u : 0u; mine = (j == x) ? c : mine; }
        if (sum == G) break;
        __builtin_amdgcn_s_sleep(1);
        if ((++sp & 255u) == 0u) { if (xb_ld(&bar[XB_TMO])) break; if (sp > XB_SPIN_CAP) { atomicAdd(&bar[XB_TMO], 1u); break; } }
    }
    nloc = mine > 0u ? mine : 1u; nx = cnt > 0u ? cnt : 1u;
}

__device__ __forceinline__ void xcd_barrier(const XcdBarrier& b) {
    asm volatile("s_waitcnt vmcnt(0)" ::: "memory");
    __syncthreads();
    if (threadIdx.x == 0) {
        unsigned* bar = b.bar;
        __builtin_amdgcn_s_waitcnt(0);
        unsigned nloc = b.st[0], nx = b.st[1];
        if (nloc == 0u) { xcd_barrier_complete(bar, b.x, nloc, nx); b.st[0] = nloc; b.st[1] = nx; }
        const unsigned old = xb_add(&bar[XB_XSUB(b.x)], 1u);
        const unsigned gen = old / nloc;
        if (old + 1u == (gen + 1u) * nloc) {
            __builtin_amdgcn_fence(__ATOMIC_RELEASE, "agent");
            asm volatile("s_waitcnt vmcnt(0)" ::: "memory");
            const unsigned og = xb_add(&bar[XB_TOP], 1u);
            const unsigned tg = og / nx;
            if (og + 1u == (tg + 1u) * nx) xb_add(&bar[XB_TOPGEN], 1u);
            else XB_SPIN(xb_ld(&bar[XB_TOPGEN]) == tg, bar);
            __builtin_amdgcn_fence(__ATOMIC_ACQUIRE, "agent");
            xb_add(&bar[XB_XGEN(b.x)], 1u);
            asm volatile("s_waitcnt vmcnt(0)" ::: "memory");
        } else {
            XB_SPIN(xb_ld(&bar[XB_XGEN(b.x)]) == gen, bar);
            __builtin_amdgcn_fence(__ATOMIC_ACQUIRE, "agent");
            asm volatile("s_waitcnt vmcnt(0)" ::: "memory");
        }
    }
    __syncthreads();
}

__device__ __forceinline__ void p0_transpose_item(const float* W, int K, int N, bf16* WT, int row_off, const float* ksc, LAS float* scr, int item, int lane) {
    const int nblk = N / 32, kb = item / nblk, nb = item % nblk, k0 = 64 * kb, n0 = 32 * nb;
#pragma unroll 8
    for (int i = 0; i < 32; ++i) { const int kk = 2 * i + (lane >> 5); float v = W[(size_t)(k0 + kk) * N + n0 + (lane & 31)]; if (ksc) v *= ksc[k0 + kk]; scr[kk * 33 + (lane & 31)] = v; }
    LDS_WAIT(); asm volatile("" ::: "memory");
    const int c = lane & 7;
#pragma unroll
    for (int j = 0; j < 4; ++j) { const int n = (lane >> 3) + 8 * j; const LAS float* s = scr + (8 * c) * 33 + n;
        v4u o; o.x = pk2(s[0 * 33], s[1 * 33]); o.y = pk2(s[2 * 33], s[3 * 33]); o.z = pk2(s[4 * 33], s[5 * 33]); o.w = pk2(s[6 * 33], s[7 * 33]);
        *(GAS v4u*)(WT + (size_t)(row_off + n0 + n) * K + k0 + 8 * c) = o; }
    LDS_WAIT(); asm volatile("" ::: "memory");
}
__device__ __forceinline__ void rms_row_to_bf16(const float* xrow, const float* g, bf16* orow, int lane) {
    const GAS f32x4* xr = (const GAS f32x4*)xrow + lane; const GAS f32x4* gr = (const GAS f32x4*)g + lane;
    f32x4 v[4]; float s = 0.f;
#pragma unroll
    for (int j = 0; j < 4; ++j) { v[j] = xr[64 * j]; s += (v[j].x * v[j].x + v[j].y * v[j].y) + (v[j].z * v[j].z + v[j].w * v[j].w); }
    const float r = 1.f / sqrtf(wave_sum(s) * (1.f / 1024.f) + RMS_EPS);
    GAS unsigned long long* o8 = (GAS unsigned long long*)orow + lane;
#pragma unroll
    for (int j = 0; j < 4; ++j) { const f32x4 gv = gr[64 * j];
        o8[64 * j] = (unsigned long long)pk2(v[j].x * r * gv.x, v[j].y * r * gv.y) | ((unsigned long long)pk2(v[j].z * r * gv.z, v[j].w * r * gv.w) << 32); }
}
__device__ __forceinline__ void cvt_row_to_bf16(const float* xrow, bf16* orow, int lane) {
    const GAS f32x4* xr = (const GAS f32x4*)xrow + lane; GAS unsigned long long* o8 = (GAS unsigned long long*)orow + lane;
    f32x4 v[4];
#pragma unroll
    for (int j = 0; j < 4; ++j) v[j] = xr[64 * j];
#pragma unroll
    for (int j = 0; j < 4; ++j) o8[64 * j] = (unsigned long long)pk2(v[j].x, v[j].y) | ((unsigned long long)pk2(v[j].z, v[j].w) << 32);
}
__device__ __forceinline__ int rel_bucket_dev(int d) {
    if (d < 16) return d;
    int b = 16;
    b += (d >= 21); b += (d >= 27); b += (d >= 35); b += (d >= 46); b += (d >= 59); b += (d >= 77); b += (d >= 99); b += (d >= 128);
    b += (d >= 166); b += (d >= 216); b += (d >= 280); b += (d >= 363); b += (d >= 470); b += (d >= 609); b += (d >= 790);
    return b;
}
struct P0Args { const float *x, *mem, *g_mix, *w_in, *rel_bias, *g_mem, *w_mem_kv, *w_br_attn, *w_br_conv, *w_br_x, *w_out, *g_ffn, *w_query, *sub_keys;
                bf16 *WinT, *WkvT, *WbrT, *WoutT, *WqT, *SK, *HN, *MEMN; float* TAB; };
__device__ __forceinline__ void p0_prologue(const P0Args& a, LAS unsigned char* lds, int gw, int NGW, int wave, int lane) {
    LAS float* scr = (LAS float*)(lds + RING_OFF + wave * 16384);
    constexpr int I_IN = (DM / 64) * (PW / 32), I_KV = (DM / 64) * (1024 / 32), I_BR = (512 / 64) * (1024 / 32), I_OUT = (DM / 64) * (1024 / 32), I_Q = (DM / 64) * (2048 / 32);
    constexpr int NITEMS = I_IN + I_KV + 3 * I_BR + I_OUT + I_Q;
    for (int it = gw; it < NITEMS; it += NGW) {
        int r = it;
        if (r < I_IN) { p0_transpose_item(a.w_in, DM, PW, a.WinT, 0, nullptr, scr, r, lane); continue; } r -= I_IN;
        if (r < I_KV) { p0_transpose_item(a.w_mem_kv, DM, 1024, a.WkvT, 0, nullptr, scr, r, lane); continue; } r -= I_KV;
        if (r < I_BR) { p0_transpose_item(a.w_br_attn, 512, 1024, a.WbrT, 0, nullptr, scr, r, lane); continue; } r -= I_BR;
        if (r < I_BR) { p0_transpose_item(a.w_br_conv, 512, 1024, a.WbrT, 1024, nullptr, scr, r, lane); continue; } r -= I_BR;
        if (r < I_BR) { p0_transpose_item(a.w_br_x, 512, 1024, a.WbrT, 2048, nullptr, scr, r, lane); continue; } r -= I_BR;
        if (r < I_OUT) { p0_transpose_item(a.w_out, DM, 1024, a.WoutT, 0, nullptr, scr, r, lane); continue; } r -= I_OUT;
        p0_transpose_item(a.w_query, DM, 2048, a.WqT, 0, a.g_ffn, scr, r, lane);
    }
    for (int m = gw; m < T; m += NGW) rms_row_to_bf16(a.x + (size_t)m * DM, a.g_mix, a.HN + (size_t)m * DM, lane);
    for (int m = gw; m < NBATCH * MEMLEN; m += NGW) rms_row_to_bf16(a.mem + (size_t)m * DM, a.g_mem, a.MEMN + (size_t)m * DM, lane);
    for (int m = gw; m < 256; m += NGW) cvt_row_to_bf16(a.sub_keys + (size_t)m * 1024, a.SK + (size_t)m * 1024, lane);
    for (int m = gw; m < 256; m += NGW) {
        const int idx = m * 64 + lane, h = idx >> 11, d = idx & 2047;
        a.TAB[idx] = a.rel_bias[rel_bucket_dev(d) * 8 + h] * LOG2E;
    }
}

template <int DH> __device__ __forceinline__ void fix_item(bf16* buf, size_t pitch, int row0, int col0, const float* gain, float gscale, float* kmean, LAS float* red, int wave, int lane) {
    constexpr int LPR = DH / 8, RPI = 64 / LPR, NIT = 32 / RPI;
    const int sub = lane / LPR, ch = lane % LPR;
    float g[8], cs[8];
#pragma unroll
    for (int j = 0; j < 8; ++j) { g[j] = gain[ch * 8 + j] * gscale; cs[j] = 0.f; }
    v4u w[NIT];
#pragma unroll
    for (int it = 0; it < NIT; ++it) w[it] = *(const GAS v4u*)(buf + (size_t)(row0 + wave * 32 + it * RPI + sub) * pitch + col0 + ch * 8);
#pragma unroll
    for (int it = 0; it < NIT; ++it) {
        float x[8] = {bflo(w[it].x), bfhi(w[it].x), bflo(w[it].y), bfhi(w[it].y), bflo(w[it].z), bfhi(w[it].z), bflo(w[it].w), bfhi(w[it].w)};
        float ss = 0.f;
#pragma unroll
        for (int j = 0; j < 8; ++j) ss += x[j] * x[j];
#pragma unroll
        for (int o = 1; o < LPR; o <<= 1) ss += __shfl_xor(ss, o);
        const float r = 1.f / sqrtf(ss * (1.f / DH) + RMS_EPS);
#pragma unroll
        for (int j = 0; j < 8; ++j) { x[j] = x[j] * r * g[j]; cs[j] += x[j]; }
        v4u o; o.x = pk2(x[0], x[1]); o.y = pk2(x[2], x[3]); o.z = pk2(x[4], x[5]); o.w = pk2(x[6], x[7]);
        *(GAS v4u*)(buf + (size_t)(row0 + wave * 32 + it * RPI + sub) * pitch + col0 + ch * 8) = o;
    }
    if (kmean) {
#pragma unroll
        for (int j = 0; j < 8; ++j) {
#pragma unroll
            for (int o = LPR; o < 64; o <<= 1) cs[j] += __shfl_xor(cs[j], o);
        }
        if (sub == 0) {
#pragma unroll
            for (int j = 0; j < 8; ++j) red[wave * DH + ch * 8 + j] = cs[j];
        }
        asm volatile("s_waitcnt lgkmcnt(0)\n\ts_barrier" ::: "memory");
        if (wave == 0 && lane < DH) { float s = 0.f;
#pragma unroll
            for (int w8 = 0; w8 < 8; ++w8) s += red[w8 * DH + lane];
            kmean[lane] = s * (1.f / 256.f); }
        asm volatile("s_waitcnt lgkmcnt(0)\n\ts_barrier" ::: "memory");
    }
}
__device__ __forceinline__ void p2_fixup(bf16* PA, bf16* KVM, float* KMEAN, const float* q_gain_a, const float* k_gain_a, const float* q_gain_x, const float* k_gain_x, LAS unsigned char* lds, int vcu, int G, int wave, int lane) {
    constexpr int N_A = 512, N_X = 256, N_KX = 32, NIT = 2 * N_A + N_X + N_KX;
    LAS float* red = (LAS float*)lds;
    for (int it = vcu; it < NIT; it += G) {
        int r = it;
        if (r < N_A) { const int b = r >> 6, h = (r >> 3) & 7, n = r & 7;
            fix_item<64>(PA, PAW, b * SEQ + n * 256, COL_KA + h * 64, k_gain_a, 1.0f, KMEAN + (size_t)((b * 8 + h) * 8 + n) * 64, red, wave, lane); continue; } r -= N_A;
        if (r < N_A) { const int b = r >> 6, h = (r >> 3) & 7, n = r & 7;
            fix_item<64>(PA, PAW, b * SEQ + n * 256, COL_QA + h * 64, q_gain_a, C2A, nullptr, red, wave, lane); continue; } r -= N_A;
        if (r < N_X) { const int b = r >> 5, h = (r >> 3) & 3, n = r & 7;
            fix_item<128>(PA, PAW, b * SEQ + n * 256, COL_QX + h * 128, q_gain_x, C2X, nullptr, red, wave, lane); continue; } r -= N_X;
        { const int b = r >> 2, h = r & 3;
            fix_item<128>(KVM, 1024, b * MEMLEN, h * 128, k_gain_x, 1.0f, nullptr, red, wave, lane); }
    }
}

namespace att {
constexpr int L_K = 0, L_V = 16384, L_TAB = 32768, TAB_PAD = 256, L_KM = L_TAB + (TAB_PAD + 2048) * 4  , L_SEL = L_KM + 2048  , L_WSF = L_SEL + 1024  ,
              L_OST = L_WSF + NWAVES * 256  , L_END = L_OST + NWAVES * 8192  ;
static_assert(L_END <= RING_BYTES, "attention LDS map");
__device__ __forceinline__ int crow(int r, int hi) { return (r & 3) + 8 * (r >> 2) + 4 * hi; }
__device__ __forceinline__ void glds16(const void* gsrc, unsigned lds_dst) { unsigned keep;
    asm volatile("s_mov_b32 %0, m0\n\ts_mov_b32 m0, %2\n\ts_nop 0\n\tglobal_load_lds_dwordx4 %1, off\n\ts_mov_b32 m0, %0" : "=&s"(keep) : "v"(gsrc), "s"(lds_dst) : "memory"); }
__device__ __forceinline__ unsigned cvtpk(float lo, float hi) { typedef float f2 __attribute__((ext_vector_type(2))); typedef __bf16 b2 __attribute__((ext_vector_type(2))); f2 v = {lo, hi}; b2 b = __builtin_convertvector(v, b2); return __builtin_bit_cast(unsigned, b); }
__device__ __forceinline__ float rowmax(const f32x16& p0, const f32x16& p1) {
    float a = fmaxf(p0[0], p1[0]);
#pragma unroll
    for (int r = 1; r < 16; ++r) a = fmaxf(a, fmaxf(p0[r], p1[r]));
    auto rr = __builtin_amdgcn_permlane32_swap(__float_as_uint(a), __float_as_uint(a), false, false);
    return fmaxf(__uint_as_float(rr[0]), __uint_as_float(rr[1]));
}
template <int ND0> __device__ __forceinline__ void qkt(f32x16& p0, f32x16& p1, const LAS unsigned char* Kslot, const bf16x8* qr, int r32, int hi) {
    const LAS unsigned char* kb = Kslot + hi * 1024 + r32 * 16;
    p0 = f32x16{}; p1 = f32x16{};
#pragma unroll
    for (int d0 = 0; d0 < ND0; ++d0) {
        const bf16x8 b0 = *(const LAS bf16x8*)(kb + d0 * 2048);
        const bf16x8 b1 = *(const LAS bf16x8*)(kb + d0 * 2048 + 512);
        p0 = __builtin_amdgcn_mfma_f32_32x32x16_bf16(b0, qr[d0], p0, 0, 0, 0);
        p1 = __builtin_amdgcn_mfma_f32_32x32x16_bf16(b1, qr[d0], p1, 0, 0, 0);
    }
}
template <int NDB> __device__ __forceinline__ void pv(f32x16* o, int vb, bf16x8 pa0, bf16x8 pa1, bf16x8 pa2, bf16x8 pa3) {
#pragma unroll
    for (int d0 = 0; d0 < NDB; ++d0) { s16x4 lo[4], hi[4];
#pragma unroll
        for (int ks = 0; ks < 4; ++ks) {
            asm volatile("ds_read_b64_tr_b16 %0,%1 offset:%c2" : "=&v"(lo[ks]) : "v"(vb), "i"(d0 * 4096 + ks * 1024) : "memory");
            asm volatile("ds_read_b64_tr_b16 %0,%1 offset:%c2" : "=&v"(hi[ks]) : "v"(vb), "i"(d0 * 4096 + ks * 1024 + 512) : "memory"); }
        asm volatile("s_waitcnt lgkmcnt(0)" ::: "memory"); __builtin_amdgcn_sched_barrier(0);
#define ATT_PK(k) (bf16x8){lo[k][0], lo[k][1], lo[k][2], lo[k][3], hi[k][0], hi[k][1], hi[k][2], hi[k][3]}
        o[d0] = __builtin_amdgcn_mfma_f32_32x32x16_bf16(pa0, ATT_PK(0), o[d0], 0, 0, 0);
        o[d0] = __builtin_amdgcn_mfma_f32_32x32x16_bf16(pa1, ATT_PK(1), o[d0], 0, 0, 0);
        o[d0] = __builtin_amdgcn_mfma_f32_32x32x16_bf16(pa2, ATT_PK(2), o[d0], 0, 0, 0);
        o[d0] = __builtin_amdgcn_mfma_f32_32x32x16_bf16(pa3, ATT_PK(3), o[d0], 0, 0, 0);
#undef ATT_PK
    }
}
#define ATT_BAR() asm volatile("s_waitcnt lgkmcnt(0)\n\ts_barrier" ::: "memory")
#define ATT_WAIT_BAR() asm volatile("s_waitcnt vmcnt(0) lgkmcnt(0)\n\ts_barrier" ::: "memory")

template <int DH, bool MOBA> __device__ __forceinline__ void attn_unit(const bf16* Qp, size_t qpitch, const bf16* Kp, const bf16* Vp, size_t kpitch, bf16* Op, int qb, const float* kmean_bh, const float* tab_h,
                                                                   LAS unsigned char* lds, int tid, int wid, int lane) {
    constexpr int ND0 = DH / 16, NDB = DH / 32, NPIECE = DH / 64;
    const int r32 = lane & 31, hi = lane >> 5;
    const unsigned lds0 = (unsigned)(uintptr_t)lds;
    LAS float* wsf = (LAS float*)(lds + L_WSF) + wid * 64;
    ATT_BAR();
    int my_sel = 0;
    if (MOBA) {
        LAS float* tl = (LAS float*)(lds + L_TAB);
        for (int i = tid; i < TAB_PAD + 2048; i += NWAVES * 64) tl[i] = (i < TAB_PAD) ? 0.f : tab_h[i - TAB_PAD];
        LAS float* km = (LAS float*)(lds + L_KM);
        for (int i = tid; i < 512; i += NWAVES * 64) km[i] = kmean_bh[i];
        ATT_BAR();
        if (tid < 256) {
            int sel = 0;
            if (qb <= 3) sel = (1 << qb) - 1;
            else {
                const GAS v4u* qrow = (const GAS v4u*)(Qp + (size_t)tid * qpitch);
                v4u qw[8];
#pragma unroll
                for (int c = 0; c < 8; ++c) qw[c] = qrow[c];
                float b1 = -INFINITY, b2 = -INFINITY, b3 = -INFINITY; int i1 = 0, i2 = 0, i3 = 0;
#pragma unroll 1
                for (int n = 0; n < qb; ++n) { float s = 0.f; const LAS f32x4* kr = (const LAS f32x4*)(km + n * 64);
#pragma unroll
                    for (int c = 0; c < 8; ++c) { const f32x4 ka = kr[2 * c], kb2 = kr[2 * c + 1]; const v4u w = qw[c];
                        s += bflo(w.x) * ka.x; s += bfhi(w.x) * ka.y; s += bflo(w.y) * ka.z; s += bfhi(w.y) * ka.w;
                        s += bflo(w.z) * kb2.x; s += bfhi(w.z) * kb2.y; s += bflo(w.w) * kb2.z; s += bfhi(w.w) * kb2.w; }
                    if (s > b1) { b3 = b2; i3 = i2; b2 = b1; i2 = i1; b1 = s; i1 = n; }
                    else if (s > b2) { b3 = b2; i3 = i2; b2 = s; i2 = n; }
                    else if (s > b3) { b3 = s; i3 = n; } }
                sel = (1 << i1) | (1 << i2) | (1 << i3);
            }
            ((LAS int*)(lds + L_SEL))[tid] = sel;
        }
        ATT_BAR();
        my_sel = ((LAS int*)(lds + L_SEL))[wid * 32 + r32];
    }
    bf16x8 qr[ND0];
    { const bf16* Qw = Qp + (size_t)(wid * 32 + r32) * qpitch + hi * 8;
#pragma unroll
      for (int d0 = 0; d0 < ND0; ++d0) qr[d0] = *(const GAS bf16x8*)(Qw + d0 * 16); }
    float m_run = -INFINITY, l_run = 0.f;
    f32x16 o[NDB];
#pragma unroll
    for (int d = 0; d < NDB; ++d) o[d] = f32x16{};
    const int vb0 = (int)(lds0 + L_V) + ((lane >> 4) & 1) * 32 + (lane & 3) * 8 + (4 * hi + ((lane & 15) >> 2)) * 64;
    const int qrel = wid * 32 + r32;
    const int ntiles = MOBA ? 4 + 4 * qb : 4;
    for (int tt = 0; tt < ntiles; ++tt) {
        int kb, j; bool own;
        if (MOBA) { if (tt < 4) { kb = qb; j = tt; own = true; } else { kb = (tt - 4) >> 2; j = (tt - 4) & 3; own = false; } }
        else { kb = 0; j = tt; own = false; }
        const int key0 = kb * 256 + j * 64;
        ATT_BAR();
#pragma unroll
        for (int pc = 0; pc < NPIECE; ++pc) { const int p = wid + 8 * pc;
            glds16(Kp + (size_t)(key0 + lane) * kpitch + p * 8, (unsigned)__builtin_amdgcn_readfirstlane(lds0 + L_K + p * 1024));
            glds16(Vp + (size_t)(key0 + 16 * (p & 3) + (lane >> 2)) * kpitch + (p >> 2) * 32 + (lane & 3) * 8, (unsigned)__builtin_amdgcn_readfirstlane(lds0 + L_V + p * 1024)); }
        ATT_WAIT_BAR();
        if (MOBA && own && 64 * j > wid * 32 + 31) continue;
        f32x16 p0, p1;
        qkt<ND0>(p0, p1, lds + L_K, qr, r32, hi);
        if (MOBA) {
            const int dbase = (qb - kb) * 256 + qrel - 64 * j - 4 * hi;
            const LAS float* tp = (const LAS float*)(lds + L_TAB) + TAB_PAD + dbase - 63;
            const bool lane_ok = own ? true : (((my_sel >> kb) & 1) != 0);
#pragma unroll
            for (int r = 0; r < 16; ++r) { const int c = (r & 3) + 8 * (r >> 2);
                const bool v0 = own ? (dbase - c >= 0) : lane_ok, v1 = own ? (dbase - c - 32 >= 0) : lane_ok;
                p0[r] = v0 ? p0[r] + tp[63 - c] : -INFINITY; p1[r] = v1 ? p1[r] + tp[31 - c] : -INFINITY; }
        }
        const float rm = rowmax(p0, p1);
        const float m_new = fmaxf(m_run, rm);
        const float alpha = __builtin_amdgcn_exp2f(m_run - m_new);
        float ps = 0.f;
#pragma unroll
        for (int r = 0; r < 16; ++r) { p0[r] = __builtin_amdgcn_exp2f(p0[r] - m_new); p1[r] = __builtin_amdgcn_exp2f(p1[r] - m_new); ps += p0[r] + p1[r]; }
        l_run = l_run * alpha + ps;
        if (!__all(m_new == m_run)) {
            if (hi == 0) wsf[r32] = alpha;
            LDS_WAIT();
#pragma unroll
            for (int r = 0; r < 16; ++r) { const float f = wsf[crow(r, hi)];
#pragma unroll
                for (int d = 0; d < NDB; ++d) o[d][r] *= f; }
        }
        m_run = m_new;
        v4u pw0, pw1, pw2, pw3;
        pw0 = (v4u){cvtpk(p0[0], p0[1]), cvtpk(p0[2], p0[3]), cvtpk(p0[4], p0[5]), cvtpk(p0[6], p0[7])};
        pw1 = (v4u){cvtpk(p0[8], p0[9]), cvtpk(p0[10], p0[11]), cvtpk(p0[12], p0[13]), cvtpk(p0[14], p0[15])};
        pw2 = (v4u){cvtpk(p1[0], p1[1]), cvtpk(p1[2], p1[3]), cvtpk(p1[4], p1[5]), cvtpk(p1[6], p1[7])};
        pw3 = (v4u){cvtpk(p1[8], p1[9]), cvtpk(p1[10], p1[11]), cvtpk(p1[12], p1[13]), cvtpk(p1[14], p1[15])};
        pv<NDB>(o, vb0, __builtin_bit_cast(bf16x8, pw0), __builtin_bit_cast(bf16x8, pw1), __builtin_bit_cast(bf16x8, pw2), __builtin_bit_cast(bf16x8, pw3));
    }
    { auto rr = __builtin_amdgcn_permlane32_swap(__float_as_uint(l_run), __float_as_uint(l_run), false, false); l_run = __uint_as_float(rr[0]) + __uint_as_float(rr[1]); }
    if (hi == 0) wsf[32 + r32] = l_run;
    LDS_WAIT();
    LAS bf16* stg = (LAS bf16*)(lds + L_OST + wid * 8192);
#pragma unroll
    for (int r = 0; r < 16; ++r) { const int orow = crow(r, hi); const float rl = __builtin_amdgcn_rcpf(wsf[32 + orow]);
#pragma unroll
        for (int d = 0; d < NDB; ++d) stg[orow * DH + d * 32 + r32] = (bf16)f2bf(o[d][r] * rl); }
    LDS_WAIT();
    constexpr int CPR = DH / 8;
    int lane2 = lane; asm volatile("" : "+v"(lane2));
#pragma unroll
    for (int i = 0; i < (32 * CPR) / 64; ++i) { const int idx = i * 64 + lane2, row = idx / CPR, ch = idx % CPR;
        const v4u v = *(const LAS v4u*)(stg + row * DH + ch * 8);
        *(GAS v4u*)(Op + (size_t)(wid * 32 + row) * 512 + ch * 8) = v; }
}
#undef ATT_BAR
#undef ATT_WAIT_BAR
}

__device__ __forceinline__ void conv_item(const bf16* PA, const float* conv_w, bf16* CO, int item, int tid) {
    const int ch = (tid & 63) * 8, r0 = item * 64 + (tid >> 6) * 8;
    float w0[8], w1[8], w2[8];
#pragma unroll
    for (int j = 0; j < 8; ++j) { w0[j] = conv_w[ch + j]; w1[j] = conv_w[512 + ch + j]; w2[j] = conv_w[1024 + ch + j]; }
    float pm2[8], pm1[8];
#pragma unroll
    for (int j = 0; j < 8; ++j) { pm2[j] = 0.f; pm1[j] = 0.f; }
    auto load8 = [&](int row, int col, float* o) { const v4u w = *(const GAS v4u*)(PA + (size_t)row * PAW + col + ch);
        o[0] = bflo(w.x); o[1] = bfhi(w.x); o[2] = bflo(w.y); o[3] = bfhi(w.y); o[4] = bflo(w.z); o[5] = bfhi(w.z); o[6] = bflo(w.w); o[7] = bfhi(w.w); };
    const int s0 = r0 & (SEQ - 1);
    if (s0 >= 2) { float a[8], b[8]; load8(r0 - 2, COL_CC, a); load8(r0 - 2, COL_UC, b);
#pragma unroll
        for (int j = 0; j < 8; ++j) pm2[j] = a[j] * b[j]; }
    if (s0 >= 1) { float a[8], b[8]; load8(r0 - 1, COL_CC, a); load8(r0 - 1, COL_UC, b);
#pragma unroll
        for (int j = 0; j < 8; ++j) pm1[j] = a[j] * b[j]; }
#pragma unroll
    for (int i = 0; i < 8; ++i) { const int row = r0 + i; float c[8], u[8], bb[8], y[8];
        load8(row, COL_CC, c); load8(row, COL_UC, u); load8(row, COL_BC, bb);
#pragma unroll
        for (int j = 0; j < 8; ++j) { const float cur = c[j] * u[j]; y[j] = bb[j] * (w0[j] * pm2[j] + w1[j] * pm1[j] + w2[j] * cur); pm2[j] = pm1[j]; pm1[j] = cur; }
        v4u o; o.x = pk2(y[0], y[1]); o.y = pk2(y[2], y[3]); o.z = pk2(y[4], y[5]); o.w = pk2(y[6], y[7]);
        *(GAS v4u*)(CO + (size_t)row * 512 + ch) = o; }
}

namespace pk {
template <int N> __device__ __forceinline__ void bsort_desc(unsigned (&a)[N]) {
#pragma unroll
    for (int k = 2; k <= N; k <<= 1) {
#pragma unroll
        for (int j = k >> 1; j > 0; j >>= 1) {
#pragma unroll
            for (int i = 0; i < N; ++i) { const int l = i ^ j;
                if (l > i) { const unsigned x = a[i], y = a[l]; const unsigned mx = x > y ? x : y, mn = x > y ? y : x;
                    if ((i & k) == 0) { a[i] = mx; a[l] = mn; } else { a[i] = mn; a[l] = mx; } } } } }
}
template <int N> __device__ __forceinline__ void bmerge_desc(unsigned (&a)[N]) {
#pragma unroll
    for (int j = N >> 1; j > 0; j >>= 1) {
#pragma unroll
        for (int i = 0; i < N; ++i) { const int l = i ^ j; if (l > i) { const unsigned x = a[i], y = a[l]; a[i] = x > y ? x : y; a[l] = x > y ? y : x; } } }
}
__device__ __forceinline__ void top16_merge(unsigned (&x)[16], const unsigned (&y)[16]) {
#pragma unroll
    for (int i = 0; i < 16; ++i) x[i] = x[i] > y[15 - i] ? x[i] : y[15 - i];
    bmerge_desc<16>(x);
}
__device__ __forceinline__ unsigned f2ord(float f) { const unsigned u = __float_as_uint(f); return u ^ ((unsigned)((int)u >> 31) | 0x80000000u); }
__device__ __forceinline__ float ord2f(unsigned o) { return __uint_as_float(o ^ ((o & 0x80000000u) ? 0x80000000u : 0xFFFFFFFFu)); }

constexpr int L_TBL = 0;
__device__ __forceinline__ void topk_unit(const bf16* QRY, const bf16* SK, const float* SLOTS, unsigned* SEL, LAS unsigned char* lds, int v, int tid, int wid, int lane) {
    const int hp = v & 3, t0 = ((v >> 2) * 8 + wid) * 32, r32 = lane & 31, hi = lane >> 5;
    for (int tb = 0; tb < 4; ++tb) { const bf16* src = SK + (size_t)(((2 * hp + (tb >> 1)) * 2 + (tb & 1)) * 128) * 128;
        for (int idx = tid; idx < 2048; idx += NWAVES * 64) { const int key = idx >> 4, c16 = idx & 15;
            const v4u w = *(const GAS v4u*)(src + key * 128 + c16 * 8);
            *(LAS v4u*)(lds + L_TBL + tb * 32768 + (c16 * 4 + (key >> 5)) * 512 + (key & 31) * 16) = w; } }
    asm volatile("s_waitcnt vmcnt(0) lgkmcnt(0)\n\ts_barrier" ::: "memory");
    const int tok = t0 + r32;
    float rn; { const GAS f32x4* sl = (const GAS f32x4*)(SLOTS + (size_t)tok * 16); const f32x4 a = sl[0], b = sl[1], c = sl[2], d = sl[3];
        const float ss = ((a.x + a.y) + (a.z + a.w)) + ((b.x + b.y) + (b.z + b.w)) + ((c.x + c.y) + (c.z + c.w)) + ((d.x + d.y) + (d.z + d.w));
        rn = 1.f / sqrtf(ss * (1.f / 1024.f) + RMS_EPS); }
    unsigned L[4][16];
#pragma unroll
    for (int tb = 0; tb < 4; ++tb) {
        const int hh = tb >> 1, p = tb & 1;
        const bf16* qp = QRY + (size_t)tok * 2048 + ((2 * hp + hh) * 2 + p) * 128 + hi * 8;
        bf16x8 qf[8];
#pragma unroll
        for (int kk = 0; kk < 8; ++kk) qf[kk] = *(const GAS bf16x8*)(qp + kk * 16);
        f32x16 acc[4];
#pragma unroll
        for (int blk = 0; blk < 4; ++blk) acc[blk] = f32x16{};
        const LAS unsigned char* tbase = lds + L_TBL + tb * 32768 + hi * 2048 + r32 * 16;
#pragma unroll
        for (int kk = 0; kk < 8; ++kk)
#pragma unroll
            for (int blk = 0; blk < 4; ++blk) { const bf16x8 af = *(const LAS bf16x8*)(tbase + kk * 4096 + blk * 512);
                acc[blk] = __builtin_amdgcn_mfma_f32_32x32x16_bf16(af, qf[kk], acc[blk], 0, 0, 0); }
        unsigned g[4][16];
#pragma unroll
        for (int blk = 0; blk < 4; ++blk)
#pragma unroll
            for (int r = 0; r < 16; ++r) g[blk][r] = (f2ord(acc[blk][r]) & ~127u) | (unsigned)(127 - (32 * blk + (r & 3) + 8 * (r >> 2)));
#pragma unroll
        for (int blk = 0; blk < 4; ++blk) bsort_desc<16>(g[blk]);
        top16_merge(g[0], g[1]); top16_merge(g[2], g[3]); top16_merge(g[0], g[2]);
#pragma unroll
        for (int i = 0; i < 16; ++i) L[tb][i] = g[0][i] ^ (unsigned)(4 * hi);
    }
    unsigned A[2][16];
#pragma unroll
    for (int p = 0; p < 2; ++p) {
        unsigned X[16], Y[16];
#pragma unroll
        for (int i = 0; i < 16; ++i) { auto rr = __builtin_amdgcn_permlane32_swap(L[p][i], L[2 + p][i], false, false); X[i] = rr[0]; Y[i] = rr[1]; }
        top16_merge(X, Y);
#pragma unroll
        for (int i = 0; i < 16; ++i) A[p][i] = X[i];
    }
    float f0[16], f1[16];
#pragma unroll
    for (int i = 0; i < 16; ++i) { f0[i] = ord2f(A[0][i] & ~127u); f1[i] = ord2f(A[1][i] & ~127u); }
    float sums[50]; unsigned keys[50];
    { int c = 0;
#pragma unroll
      for (int i = 0; i < 16; ++i)
#pragma unroll
          for (int j = 0; j < 16; ++j) if ((i + 1) * (j + 1) <= 16) { sums[c] = f0[i] + f1[j]; keys[c] = (f2ord(sums[c]) & ~63u) | (unsigned)(63 - c); ++c; } }
    unsigned G0[16], R[32];
#pragma unroll
    for (int i = 0; i < 16; ++i) G0[i] = keys[i];
#pragma unroll
    for (int i = 0; i < 32; ++i) R[i] = (i < 26) ? keys[24 + i] : 0u;
    bsort_desc<32>(R);
#pragma unroll
    for (int i = 0; i < 16; ++i) G0[i] = G0[i] > R[15 - i] ? G0[i] : R[15 - i];
    bmerge_desc<16>(G0);
#pragma unroll
    for (int i = 8; i < 16; ++i) G0[i] = G0[i] > keys[16 + 15 - i] ? G0[i] : keys[16 + 15 - i];
    unsigned thr = G0[0];
#pragma unroll
    for (int i = 1; i < 16; ++i) thr = thr < G0[i] ? thr : G0[i];
    const float s00 = sums[0], sc = rn * LOG2E;
    float w[50]; float den = 0.f;
#pragma unroll
    for (int c = 0; c < 50; ++c) { w[c] = (keys[c] >= thr) ? __builtin_amdgcn_exp2f((sums[c] - s00) * sc) : 0.f; den += w[c]; }
    const float inv = 1.f / den;
    unsigned i0[16], i1[16];
#pragma unroll
    for (int i = 0; i < 16; ++i) { i0[i] = 127u - (A[0][i] & 127u); i1[i] = 127u - (A[1][i] & 127u); }
    GAS unsigned* outp = (GAS unsigned*)(SEL + ((size_t)tok * 8 + 2 * hp + hi) * 16);
    int pos = 0;
    { int c = 0;
#pragma unroll
      for (int i = 0; i < 16; ++i)
#pragma unroll
          for (int j = 0; j < 16; ++j) if ((i + 1) * (j + 1) <= 16) { if (keys[c] >= thr) { outp[pos & 15] = ((i0[i] * 128u + i1[j]) << 16) | f2bf(w[c] * inv); ++pos; } ++c; } }
}
}

constexpr size_t SLICE_BYTES = (size_t)NEXP * 128;
template <bool OFFSET> __device__ __forceinline__ void quant_row_sliced(const float* xrow, unsigned char* qtab, int e, float* scale, int lane) {
    const GAS f32x4* xr = (const GAS f32x4*)xrow + 4 * lane; f32x4 v[4]; float am = 0.f;
#pragma unroll
    for (int j = 0; j < 4; ++j) { v[j] = xr[j]; am = fmaxf(am, fmaxf(fmaxf(fabsf(v[j].x), fabsf(v[j].y)), fmaxf(fabsf(v[j].z), fabsf(v[j].w)))); }
#pragma unroll
    for (int o = 1; o < 64; o <<= 1) am = fmaxf(am, __shfl_xor(am, o));
    const float s = am > 0.f ? am * (1.f / 127.f) : 1.f, is = 1.f / s;
    v4u o;
#pragma unroll
    for (int j = 0; j < 4; ++j) { const int a = (int)rintf(v[j].x * is), b = (int)rintf(v[j].y * is), c = (int)rintf(v[j].z * is), d = (int)rintf(v[j].w * is);
        const int off = OFFSET ? 128 : 0;
        o[j] = (unsigned)((a + off) & 0xff) | ((unsigned)((b + off) & 0xff) << 8) | ((unsigned)((c + off) & 0xff) << 16) | ((unsigned)((d + off) & 0xff) << 24); }
    *(GAS v4u*)(qtab + (size_t)(lane >> 3) * SLICE_BYTES + (size_t)e * 128 + (lane & 7) * 16) = o;
    if (lane == 0) *scale = s;
}
__device__ __forceinline__ void quant_x(const float* H, unsigned char* XQ, float* SX, const float (&gf)[16], int t, int lane) {
    const GAS f32x4* hrow = (const GAS f32x4*)(H + (size_t)t * DM) + 4 * lane;
    f32x4 hv[4];
#pragma unroll
    for (int j = 0; j < 4; ++j) hv[j] = hrow[j];
    float ss = 0.f;
#pragma unroll
    for (int j = 0; j < 4; ++j) ss += (hv[j].x * hv[j].x + hv[j].y * hv[j].y) + (hv[j].z * hv[j].z + hv[j].w * hv[j].w);
    const float rn = 1.f / sqrtf(wave_sum(ss) * (1.f / 1024.f) + RMS_EPS);
    float xn[16]; float am = 0.f;
#pragma unroll
    for (int j = 0; j < 4; ++j)
#pragma unroll
        for (int e = 0; e < 4; ++e) { xn[4 * j + e] = hv[j][e] * rn * gf[4 * j + e]; am = fmaxf(am, fabsf(xn[4 * j + e])); }
#pragma unroll
    for (int o = 1; o < 64; o <<= 1) am = fmaxf(am, __shfl_xor(am, o));
    const float sx = am > 0.f ? am * (1.f / 127.f) : 1.f, isx = 1.f / sx;
    v4u o;
#pragma unroll
    for (int j = 0; j < 4; ++j) { const int a = (int)rintf(xn[4 * j] * isx), b = (int)rintf(xn[4 * j + 1] * isx), c = (int)rintf(xn[4 * j + 2] * isx), d = (int)rintf(xn[4 * j + 3] * isx);
        o[j] = (unsigned)(a & 0xff) | ((unsigned)(b & 0xff) << 8) | ((unsigned)(c & 0xff) << 16) | ((unsigned)(d & 0xff) << 24); }
    *((GAS v4u*)(XQ + (size_t)t * DM) + lane) = o;
    if (lane == 0) SX[t] = sx;
}
__device__ __forceinline__ float gelu_exact(float x) { return 0.5f * x * (1.0f + erff(x * 0.70710678118654752f)); }
__device__ __forceinline__ int dpp_i(int v, int ctrl_is) {
    return ctrl_is == 0 ? __builtin_amdgcn_update_dpp(0, v, 0x141, 0xf, 0xf, true) : ctrl_is == 1 ? __builtin_amdgcn_update_dpp(0, v, 0xB1, 0xf, 0xf, true) : __builtin_amdgcn_update_dpp(0, v, 0x4E, 0xf, 0xf, true);
}
constexpr int QCHUNK = 8;
__device__ __forceinline__ int q_take(unsigned* q, int lane) {
    unsigned v = 0; if (lane == 0) v = __hip_atomic_fetch_add(q, (unsigned)QCHUNK, __ATOMIC_RELAXED, __HIP_MEMORY_SCOPE_AGENT);
    return (int)__builtin_amdgcn_readfirstlane(v);
}
__device__ __forceinline__ void gather_u(const unsigned* SEL, const unsigned char* XQ, const unsigned char* UQS, int* PART, unsigned* queues, int xcc, int lane) {
    const int grp = lane >> 3, ch = lane & 7, c0 = ch & 1, c1 = (ch >> 1) & 1, c2 = (ch >> 2) & 1;
    for (int qi = 0; qi < 8; ++qi) { const int x = (xcc + qi) & 7;
        const unsigned char* tab = UQS + (size_t)x * SLICE_BYTES + ch * 16;
        int* part = PART + (size_t)x * T * 128;
        int tb = q_take(queues + 64 * x, lane);
        while (tb < T) {
            const int tb_next = q_take(queues + 64 * x, lane);
#pragma unroll 1
            for (int ti = 0; ti < QCHUNK; ++ti) { const int t = tb + ti;
                const v4u xq = *(const GAS v4u*)(XQ + (size_t)t * DM + x * 128 + ch * 16);
                unsigned E[16];
#pragma unroll
                for (int g = 0; g < 16; ++g) E[g] = *(const GAS unsigned*)(SEL + (size_t)t * 128 + g * 8 + grp);
                v4u w[16];
#pragma unroll
                for (int g = 0; g < 16; ++g) w[g] = *(const GAS v4u*)(tab + (size_t)(E[g] >> 16) * 128);
                int p[16];
#pragma unroll
                for (int g = 0; g < 16; ++g) { int a = __builtin_amdgcn_sdot4((int)w[g].x, (int)xq.x, 0, false); a = __builtin_amdgcn_sdot4((int)w[g].y, (int)xq.y, a, false);
                    a = __builtin_amdgcn_sdot4((int)w[g].z, (int)xq.z, a, false); p[g] = __builtin_amdgcn_sdot4((int)w[g].w, (int)xq.w, a, false); }
                int q8[8], q4[4], q2[2];
#pragma unroll
                for (int i = 0; i < 8; ++i) { const int keep = c2 ? p[i + 8] : p[i], send = c2 ? p[i] : p[i + 8]; q8[i] = keep + dpp_i(send, 0); }
#pragma unroll
                for (int i = 0; i < 4; ++i) { const int keep = c0 ? q8[i + 4] : q8[i], send = c0 ? q8[i] : q8[i + 4]; q4[i] = keep + dpp_i(send, 1); }
#pragma unroll
                for (int i = 0; i < 2; ++i) { const int keep = c1 ? q4[i + 2] : q4[i], send = c1 ? q4[i] : q4[i + 2]; q2[i] = keep + dpp_i(send, 2); }
                const int g0 = 8 * c2 + 4 * c0 + 2 * c1;
                part[(size_t)t * 128 + g0 * 8 + grp] = q2[0]; part[(size_t)t * 128 + (g0 + 1) * 8 + grp] = q2[1];
            }
            tb = tb_next;
        }
    }
}
__device__ __forceinline__ void gather_coef(const unsigned* SEL, const int* PART, const float* SU, const float* SV, const float* SX, float* COEF, float* CS, int t, int lane) {
    typedef int i2 __attribute__((ext_vector_type(2))); typedef float f2 __attribute__((ext_vector_type(2)));
    const v2u ent = *(const GAS v2u*)(SEL + (size_t)t * 128 + 2 * lane);
    i2 acc = {0, 0};
#pragma unroll
    for (int x = 0; x < 8; ++x) { const i2 pp = *(const GAS i2*)(PART + ((size_t)x * T + t) * 128 + 2 * lane); acc += pp; }
    const unsigned e0 = ent.x >> 16, e1 = ent.y >> 16;
    const float su0 = SU[e0], sv0 = SV[e0], su1 = SU[e1], sv1 = SV[e1];
    const float sx = __hip_atomic_load(SX + t, __ATOMIC_RELAXED, __HIP_MEMORY_SCOPE_AGENT);
    const float k0 = bflo(ent.x) * gelu_exact((float)acc.x * (su0 * sx)) * sv0, k1 = bflo(ent.y) * gelu_exact((float)acc.y * (su1 * sx)) * sv1;
    *(GAS f2*)(COEF + (size_t)t * 128 + 2 * lane) = (f2){k0, k1};
    const float cs = wave_sum(k0 + k1);
    if (lane == 0) CS[t] = cs;
}
__device__ __forceinline__ void gather_v(const unsigned* SEL, const float* COEF, const float* CS, const unsigned char* VQS, float* HO, unsigned* queues, int xcc, int lane) {
    typedef float f2 __attribute__((ext_vector_type(2)));
    const int grp = lane >> 3, ch = lane & 7, g0 = grp & 1, g1 = (grp >> 1) & 1, g2 = (grp >> 2) & 1;
    for (int qi = 0; qi < 8; ++qi) { const int x = (xcc + qi) & 7;
        const unsigned char* tab = VQS + (size_t)x * SLICE_BYTES + ch * 16;
        int tb = q_take(queues + 64 * x, lane);
        while (tb < T) {
            const int tb_next = q_take(queues + 64 * x, lane);
#pragma unroll 1
            for (int ti = 0; ti < QCHUNK; ++ti) { const int t = tb + ti;
                unsigned E[16]; float C[16];
#pragma unroll
                for (int g = 0; g < 16; ++g) { E[g] = *(const GAS unsigned*)(SEL + (size_t)t * 128 + g * 8 + grp); C[g] = *(const GAS float*)(COEF + (size_t)t * 128 + g * 8 + grp); }
                v4u w[16];
#pragma unroll
                for (int g = 0; g < 16; ++g) w[g] = *(const GAS v4u*)(tab + (size_t)(E[g] >> 16) * 128);
                const int col = x * 128 + ch * 16 + 8 * g0 + 4 * g1 + 2 * g2;
                const f2 hv = *(const GAS f2*)(HO + (size_t)t * DM + col);
                const float corr = -128.f * __hip_atomic_load(CS + t, __ATOMIC_RELAXED, __HIP_MEMORY_SCOPE_AGENT);
                float acc[16];
#pragma unroll
                for (int j = 0; j < 16; ++j) acc[j] = 0.f;
#pragma unroll
                for (int g = 0; g < 16; ++g) { const float c = C[g];
#pragma unroll
                    for (int j = 0; j < 4; ++j) { const unsigned wv = w[g][j];
                        acc[4 * j + 0] += c * (float)(wv & 0xffu); acc[4 * j + 1] += c * (float)((wv >> 8) & 0xffu); acc[4 * j + 2] += c * (float)((wv >> 16) & 0xffu); acc[4 * j + 3] += c * (float)(wv >> 24); } }
                float r8[8], r4[4], r2[2];
#pragma unroll
                for (int i = 0; i < 8; ++i) { const float keep = g0 ? acc[i + 8] : acc[i], send = g0 ? acc[i] : acc[i + 8]; r8[i] = keep + __shfl_xor(send, 8); }
#pragma unroll
                for (int i = 0; i < 4; ++i) { const float keep = g1 ? r8[i + 4] : r8[i], send = g1 ? r8[i] : r8[i + 4]; r4[i] = keep + __shfl_xor(send, 16); }
#pragma unroll
                for (int i = 0; i < 2; ++i) { const float keep = g2 ? r4[i + 2] : r4[i], send = g2 ? r4[i] : r4[i + 2]; r2[i] = keep + __shfl_xor(send, 32); }
                *(GAS f2*)(HO + (size_t)t * DM + col) = (f2){hv.x + r2[0] + corr, hv.y + r2[1] + corr};
            }
            tb = tb_next;
        }
    }
}

#ifndef MK_SPLIT
#define MK_SPLIT 0
#endif
constexpr int NPHASE = 11;
#ifndef PROBE_PH
#define PROBE_PH -1
#endif
#ifndef PROBE_N
#define PROBE_N 1
#endif
#define REPS(k) (((k) == PROBE_PH) ? 1 + PROBE_N : 1)
struct Args { const float* in[21]; float* out; unsigned char* ws; int ph_lo, ph_hi; };
static_assert(sizeof(Args) == 23 * 8 + 8, "Args has no padding");

__global__ void __launch_bounds__(NWAVES * 64, 2) fwd(Args args) {
    extern __shared__ __attribute__((aligned(16))) unsigned char lds_raw[];
    LAS unsigned char* lds = (LAS unsigned char*)lds_raw;
    volatile LAS unsigned* MISC = (volatile LAS unsigned*)(lds + MISC_OFF);
    const int tid = threadIdx.x, lane = tid & 63, wave = __builtin_amdgcn_readfirstlane(tid >> 6);
    const int G = gridDim.x; const int bx = blockIdx.x; const int vcu = (G % 8 == 0) ? (bx % 8) * (G / 8) + bx / 8 : bx;
    const int gw = vcu * NWAVES + wave, NGW = G * NWAVES;
    unsigned char* ws = args.ws;
    gu32* ctl = (gu32*)(ws + WS_CTL);
    const float* x = args.in[0]; const float* mem = args.in[1]; const float* g_mix = args.in[2]; const float* w_in = args.in[3]; const float* q_gain_a = args.in[4]; const float* k_gain_a = args.in[5];
    const float* rel_bias = args.in[6]; const float* conv_w = args.in[7]; const float* g_mem = args.in[8]; const float* w_mem_kv = args.in[9]; const float* q_gain_x = args.in[10]; const float* k_gain_x = args.in[11];
    const float* w_br_attn = args.in[12]; const float* w_br_conv = args.in[13]; const float* w_br_x = args.in[14]; const float* w_out = args.in[15]; const float* g_ffn = args.in[16];
    const float* w_query = args.in[17]; const float* sub_keys = args.in[18]; const float* peer_u = args.in[19]; const float* peer_v = args.in[20];
    float* out = args.out;
    bf16* WinT = (bf16*)(ws + WS_WIN); bf16* WkvT = (bf16*)(ws + WS_WKV); bf16* WbrT = (bf16*)(ws + WS_WBR); bf16* WoutT = (bf16*)(ws + WS_WOUT); bf16* WqT = (bf16*)(ws + WS_WQ);
    bf16* SK = (bf16*)(ws + WS_SK); float* TAB = (float*)(ws + WS_TAB); float* KMEAN = (float*)(ws + WS_KMEAN); bf16* MEMN = (bf16*)(ws + WS_MEMN); bf16* KVM = (bf16*)(ws + WS_KVM);
    float* SLOTS = (float*)(ws + WS_SLOTS); unsigned* SEL = (unsigned*)(ws + WS_SEL);
    bf16* PA = (bf16*)(ws + WS_PA); bf16* PG = (bf16*)(ws + WS_PG);
    bf16* MERGED = (bf16*)(ws + PA_MERGED); bf16* HB = (bf16*)(ws + PA_HB); unsigned char* UQ = ws + PA_UT; unsigned char* VQ = ws + PA_VT; float* SU = (float*)(ws + WS_SU); float* SV = (float*)(ws + WS_SV); float* SX = (float*)(ws + WS_SX); float* CS = (float*)(ws + WS_CS);
    unsigned char* XQ = ws + PA_XQ; int* PART = (int*)(ws + PG_PART); float* COEF = (float*)(ws + PG_COEF); bf16* QRY = (bf16*)(ws + PG_QRY);
    bf16* HN = (bf16*)out;
    bf16* BRO = (bf16*)out;

    for (int u = tid; u < (LDS_BYTES - LDSCTL_OFF) / 4; u += NWAVES * 64) ((LAS unsigned*)(lds + LDSCTL_OFF))[u] = 0u;
    __syncthreads();
#if !MK_SPLIT
    XcdBarrier bar = xcd_barrier_post((unsigned*)(ctl + CW_BAR), MISC + 8);
#define GRID_BAR() xcd_barrier(bar)
#else
#define GRID_BAR() do {} while (0)
#endif
    const int lo = args.ph_lo, hi_ = args.ph_hi;
#ifndef PH_MASK
#define PH_MASK 0x7ff
#endif
#define IN(k) ((((PH_MASK) >> (k)) & 1) && lo <= (k) && (k) < hi_)
#define BOTH(k) (IN(k) && IN((k) + 1))

    if (IN(0)) for (int rep = 0; rep < REPS(0); ++rep) {
        P0Args a{x, mem, g_mix, w_in, rel_bias, g_mem, w_mem_kv, w_br_attn, w_br_conv, w_br_x, w_out, g_ffn, w_query, sub_keys, WinT, WkvT, WbrT, WoutT, WqT, SK, HN, MEMN, TAB};
        p0_prologue(a, lds, gw, NGW, wave, lane);
        if (BOTH(0) && rep == REPS(0) - 1) GRID_BAR();
    }
    if (IN(1)) for (int rep = 0; rep < REPS(1); ++rep) {
        { pg8::Gemm g{HN, WinT, T, PW, DM}; pg8::GOrder S; S.init(T, PW, G, bx); pg8::EpiProj E{PA, PG};
          pg8::gemm_phase<pg8::EpiProj, pg8::GOrder, true, true>(lds + RING_OFF, g, S, E); }
        { const int nfull = (64 * 26) % G; const int coff = (nfull + 32 <= G) ? bx - nfull : bx;
          pg8::Gemm g{MEMN, WkvT, NBATCH * MEMLEN, 1024, DM}; pg8::GOrder S; S.init(NBATCH * MEMLEN, 1024, G, coff); pg8::EpiBf16<0> E{KVM, 1024, nullptr, 0, 0, 1.f};
          pg8::gemm_phase<pg8::EpiBf16<0>, pg8::GOrder, true, true>(lds + RING_OFF, g, S, E); }
        if (BOTH(1) && rep == REPS(1) - 1) GRID_BAR();
    }
    if (IN(2)) {
        p2_fixup(PA, KVM, KMEAN, q_gain_a, k_gain_a, q_gain_x, k_gain_x, lds + RING_OFF, vcu, G, wave, lane);
        if (BOTH(2)) GRID_BAR();
    }
    if (IN(3)) for (int rep = 0; rep < REPS(3); ++rep) {
        for (int v = vcu; v < 256; v += G) {
            const int bh = v >> 2, b = bh >> 3, h = bh & 7, s = v & 3;
#pragma unroll 1
            for (int pass = 0; pass < 2; ++pass) { const int qb = pass ? 7 - s : s;
                const bf16* Qp = PA + (size_t)(b * SEQ + qb * 256) * PAW + COL_QA + h * 64;
                const bf16* Kp = PA + (size_t)(b * SEQ) * PAW + COL_KA + h * 64; const bf16* Vp = PA + (size_t)(b * SEQ) * PAW + COL_VA + h * 64;
                bf16* Op = BRO + (size_t)(b * SEQ + qb * 256) * 512 + h * 64;
                att::attn_unit<64, true>(Qp, PAW, Kp, Vp, PAW, Op, qb, KMEAN + (size_t)bh * 512, TAB + h * 2048, lds + RING_OFF, tid, wave, lane); }
            { const int bb = v >> 5, hx = (v >> 3) & 3, qt = v & 7;
                const bf16* Qp = PA + (size_t)(bb * SEQ + qt * 256) * PAW + COL_QX + hx * 128;
                const bf16* Kp = KVM + (size_t)(bb * MEMLEN) * 1024 + hx * 128; const bf16* Vp = Kp + 512;
                bf16* Op = BRO + (size_t)2 * T * 512 + (size_t)(bb * SEQ + qt * 256) * 512 + hx * 128;
                att::attn_unit<128, false>(Qp, PAW, Kp, Vp, 1024, Op, 0, nullptr, nullptr, lds + RING_OFF, tid, wave, lane); }
            conv_item(PA, conv_w, BRO + (size_t)T * 512, v, tid);
        }
        if (BOTH(3) && rep == REPS(3) - 1) GRID_BAR();
    }
    if (IN(4)) for (int rep = 0; rep < REPS(4); ++rep) {
        pg8::Gemm g{BRO, WbrT, 3 * T, 3 * 1024, 512}; pg8::BranchOrder S; S.init(G, bx); pg8::EpiBranch E{PG, MERGED};
        pg8::gemm_phase<pg8::EpiBranch, pg8::BranchOrder, true, true>(lds + RING_OFF, g, S, E);
        if (BOTH(4) && rep == REPS(4) - 1) GRID_BAR();
    }
    if (IN(5)) for (int rep = 0; rep < REPS(5); ++rep) {
        pg8::Gemm g{MERGED, WoutT, T, 1024, DM}; pg8::GOrder S; S.init(T, 1024, G, bx); pg8::EpiWout E{x, out, HB, SLOTS};
        pg8::gemm_phase<pg8::EpiWout, pg8::GOrder, true, true>(lds + RING_OFF, g, S, E);
        if (BOTH(5) && rep == REPS(5) - 1) GRID_BAR();
    }
    if (IN(6)) for (int rep = 0; rep < REPS(6); ++rep) {
        pg8::Gemm g{HB, WqT, T, 2048, DM}; pg8::GOrder S; S.init(T, 2048, G, bx); pg8::EpiBf16<0> E{QRY, 2048, nullptr, 0, 0, 1.f};
        pg8::gemm_phase<pg8::EpiBf16<0>, pg8::GOrder, true, true>(lds + RING_OFF, g, S, E);
        if (BOTH(6) && rep == REPS(6) - 1) GRID_BAR();
    }
    if (IN(7)) for (int rep = 0; rep < REPS(7); ++rep) {
        for (int v = vcu; v < 256; v += G) { pk::topk_unit(QRY, SK, SLOTS, SEL, lds + RING_OFF, v, tid, wave, lane); __syncthreads(); }
        for (int m = gw; m < 2 * NEXP; m += NGW) { if (m < NEXP) quant_row_sliced<false>(peer_u + (size_t)m * DM, UQ, m, SU + m, lane); else quant_row_sliced<true>(peer_v + (size_t)(m - NEXP) * DM, VQ, m - NEXP, SV + (m - NEXP), lane); }
        { float gf[16];
#pragma unroll
          for (int j = 0; j < 16; ++j) gf[j] = g_ffn[16 * lane + j];
          for (int t = gw; t < T; t += NGW) quant_x(out, XQ, SX, gf, t, lane); }
        if (BOTH(7) && rep == REPS(7) - 1) GRID_BAR();
    }
#if !MK_SPLIT
    const int xcc = (int)bar.x & 7;
#else
    const int xcc = (int)(xb_xcc_id() & 7u);
#endif
    if (IN(8)) {
        gather_u(SEL, XQ, UQ, PART, (unsigned*)(ctl + CW_QU), xcc, lane);
        if (BOTH(8)) GRID_BAR();
    }
    if (IN(9)) {
        for (int t = gw; t < T; t += NGW) gather_coef(SEL, PART, SU, SV, SX, COEF, CS, t, lane);
        if (BOTH(9)) GRID_BAR();
    }
    if (IN(10)) {
        gather_v(SEL, COEF, CS, VQ, out, (unsigned*)(ctl + CW_QV), xcc, lane);
    }
#undef IN
#undef BOTH
}

extern "C" void kernel_launch(void* const* d_in, const int* in_sizes, int n_in, void* d_out, int out_size, void* d_ws, size_t ws_size, hipStream_t stream) {
    static int grid = 0;
    if (grid == 0) {
        if (n_in != 21 || out_size != T * DM || ws_size < WS_END) { fprintf(stderr, "kernel_launch: unexpected shapes (n_in %d, out %d, ws %zu)\n", n_in, out_size, ws_size); grid = -1; return; }
        int dev = 0, cus = 0, per_cu = 0;
        if (hipGetDevice(&dev) != hipSuccess || hipDeviceGetAttribute(&cus, hipDeviceAttributeMultiprocessorCount, dev) != hipSuccess) { grid = -1; return; }
        if (hipFuncSetAttribute((const void*)fwd, hipFuncAttributeMaxDynamicSharedMemorySize, LDS_BYTES) != hipSuccess) { fprintf(stderr, "kernel_launch: hipFuncSetAttribute failed\n"); grid = -1; return; }
        if (hipOccupancyMaxActiveBlocksPerMultiprocessor(&per_cu, (const void*)fwd, NWAVES * 64, LDS_BYTES) != hipSuccess || per_cu < 1) { fprintf(stderr, "kernel_launch: occupancy query reports %d\n", per_cu); }
        (void)hipGetLastError();
        grid = cus;
    }
    if (grid < 0) return;
    (void)hipMemsetAsync((char*)d_ws + WS_CTL, 0, CTL_ZERO_BYTES, stream);
    Args a{};
    for (int i = 0; i < 21; ++i) a.in[i] = (const float*)d_in[i];
    a.out = (float*)d_out; a.ws = (unsigned char*)d_ws;
#if MK_SPLIT
    for (int p = 0; p < NPHASE; ++p) { a.ph_lo = p; a.ph_hi = p + 1; hipLaunchKernelGGL(fwd, dim3(grid), dim3(NWAVES * 64), LDS_BYTES, stream, a); }
#else
    a.ph_lo = 0; a.ph_hi = NPHASE;
    hipLaunchKernelGGL(fwd, dim3(grid), dim3(NWAVES * 64), LDS_BYTES, stream, a);
#endif
}
```

```cpp
#include <hip/hip_runtime.h>
#include <hip/hip_bf16.h>
#include <cstdio>
#include <cstdint>
#include <cmath>
namespace pg8 {
#define PG8_LAS __attribute__((address_space(3)))
typedef unsigned short bf16_t;
typedef short bf16x8 __attribute__((ext_vector_type(8)));
typedef float f32x4 __attribute__((ext_vector_type(4)));
typedef unsigned u32x4 __attribute__((ext_vector_type(4)));
constexpr int BM = 256, BK = 64, HALF = 128, HTB = HALF * BK * 2  , STAGE_BYTES = 8 * HTB, NXCD = 8, WGM = 8;

__host__ __device__ __forceinline__ int lds_byte(int r, int c) { const int st = (r >> 4) * 2 + (c >> 5), rr = r & 15, cc = c & 31, ob = rr * 64 + cc * 2; return st * 1024 + (ob ^ (((ob >> 9) & 1) << 5)); }
__host__ __device__ __forceinline__ void stage_rc(int b, int& R, int& C) { const int st = b / 1024, sb = b % 1024, swz = sb ^ (((sb >> 9) & 1) << 5); R = (st >> 1) * 16 + swz / 64; C = (st & 1) * 32 + (swz % 64) / 2; }
__host__ __device__ __forceinline__ int perm32(int rho) { const int n = rho >> 4, i = rho & 15; return 8 * (i >> 2) + 4 * n + (i & 3); }

struct Unit { int pm, pn; };
struct Gemm { const bf16_t* A; const bf16_t* Bt; int M, N, K; };

struct StaticOrder {
    int nM, nN, nwg, G, c;
    __host__ __device__ void init(int M, int N, int G_, int c_) { nM = M / BM; nN = N / BM; nwg = nM * nN; G = G_; c = c_; }
    __host__ __device__ bool next(int i, Unit& u) const {
        const long L = (long)i * G + c; if (L >= nwg) return false;
        int wgid = (int)L; { const int q = nwg / NXCD, r = nwg % NXCD, xcd = wgid % NXCD, off = wgid / NXCD; wgid = (xcd < r ? xcd * (q + 1) : r * (q + 1) + (xcd - r) * q) + off; }
        const int nig = WGM * nN, gid = wgid / nig, fm = gid * WGM, gsz = (nM - fm) < WGM ? (nM - fm) : WGM;
        u.pm = fm + ((wgid % nig) % gsz); u.pn = (wgid % nig) / gsz; return true;
    }
    __device__ __forceinline__ void a_ready(const Unit&) const {}
    __device__ __forceinline__ void done(const Unit&) const {}
};

__device__ __forceinline__ unsigned cvt_pk_bf16(float lo, float hi) { unsigned r; asm volatile("v_cvt_pk_bf16_f32 %0, %1, %2" : "=v"(r) : "v"(lo), "v"(hi)); return r; }
typedef float f32x2 __attribute__((ext_vector_type(2)));
__device__ __forceinline__ f32x2 gelu_pk(f32x2 v) {
    const f32x2 av = __builtin_elementwise_abs(v), d = av * 0.2316418882f + 1.0f;
    f32x2 t; t.x = __builtin_amdgcn_rcpf(d.x); t.y = __builtin_amdgcn_rcpf(d.y);
    f32x2 q = t * 0.5307027145f + (-0.7265760135f); q = q * t + 0.7107068705f; q = q * t + (-0.142248368f); q = q * t + 0.127414796f; q = q * t;
    const f32x2 s = (v * v) * (-0.72134752044f);
    f32x2 e; e.x = __builtin_amdgcn_exp2f(s.x); e.y = __builtin_amdgcn_exp2f(s.y);
    const f32x2 m = v * (q * e), r = v - m;
    f32x2 o; o.x = v.x < 0.f ? m.x : r.x; o.y = v.y < 0.f ? m.y : r.y; return o;
}

template <int ACT  > struct EpiBf16 {
    static constexpr bool PERM = true, AFTER_DRAIN = false; static_assert(ACT == 0 || ACT == 1, "EpiBf16: ACT is 0 (none) or 1 (gelu_pk)");
    bf16_t* O; int ldc; const float* bias; int split_cols; size_t split_stride; float scale0;
    __device__ __forceinline__ void operator()(const f32x4 (&acc)[2][2][4][2], const Unit& u, int wr, int wc, int fr, int fq) const {
        const int row0 = u.pm * BM + wr * 64 + fr; int colt = u.pn * BM; bf16_t* base = O;
        float sc = 1.f; if (split_cols) { const int t = colt / split_cols; base += (size_t)t * split_stride; colt -= t * split_cols; if (t == 0) sc = scale0; }
        const int col0 = colt + wc * 32 + 8 * fq, bcol0 = u.pn * BM + wc * 32 + 8 * fq;
        f32x4 bv[2][2];
#pragma unroll
        for (int bj = 0; bj < 2; ++bj)
#pragma unroll
            for (int n = 0; n < 2; ++n) bv[bj][n] = bias ? *(const f32x4*)(bias + bcol0 + bj * HALF + 4 * n) : (f32x4){0.f, 0.f, 0.f, 0.f};
#pragma unroll
        for (int ai = 0; ai < 2; ++ai)
#pragma unroll
            for (int m = 0; m < 4; ++m) { bf16_t* rowp = base + (size_t)(row0 + ai * HALF + m * 16) * ldc + col0;
#pragma unroll
                for (int bj = 0; bj < 2; ++bj) { f32x4 v0 = acc[ai][bj][m][0] + bv[bj][0], v1 = acc[ai][bj][m][1] + bv[bj][1];
                    if (ACT == 1) { f32x2 a = gelu_pk((f32x2){v0[0], v0[1]}), b = gelu_pk((f32x2){v0[2], v0[3]}), c = gelu_pk((f32x2){v1[0], v1[1]}), d = gelu_pk((f32x2){v1[2], v1[3]});
                        v0 = (f32x4){a.x, a.y, b.x, b.y}; v1 = (f32x4){c.x, c.y, d.x, d.y}; }
                    v0 = v0 * sc; v1 = v1 * sc; u32x4 w; w.x = cvt_pk_bf16(v0[0], v0[1]); w.y = cvt_pk_bf16(v0[2], v0[3]); w.z = cvt_pk_bf16(v1[0], v1[1]); w.w = cvt_pk_bf16(v1[2], v1[3]);
                    *(u32x4*)(rowp + bj * HALF) = w; } }
    }
};


struct GOrder {
    int nM, nN, nwg, G, c;
    __host__ __device__ void init(int M, int N, int G_, int c_) { nM = M / BM; nN = N / BM; nwg = nM * nN; G = G_; c = c_; }
    __host__ __device__ bool next(int i, Unit& u) const {
        if (c < 0) return false;
        const long L = (long)i * G + c; if (L >= nwg) return false;
        int wgid = (int)L; { const int q = nwg / NXCD, r = nwg % NXCD, xcd = wgid % NXCD, off = wgid / NXCD; wgid = (xcd < r ? xcd * (q + 1) : r * (q + 1) + (xcd - r) * q) + off; }
        const int nig = WGM * nN, gid = wgid / nig, fm = gid * WGM, gsz = (nM - fm) < WGM ? (nM - fm) : WGM;
        u.pm = fm + ((wgid % nig) % gsz); u.pn = (wgid % nig) / gsz; return true;
    }
    __device__ __forceinline__ void a_ready(const Unit&) const {}
    __device__ __forceinline__ void done(const Unit&) const {}
};
struct BranchOrder {
    GOrder g;
    __device__ void init(int G, int c) { g.init(16384, 1024, G, c); }
    __device__ bool next(int i, Unit& u) const { Unit t; if (!g.next(i / 3, t)) return false; const int br = i % 3; u.pm = 64 * br + t.pm; u.pn = 4 * br + t.pn; return true; }
    __device__ __forceinline__ void a_ready(const Unit&) const {}
    __device__ __forceinline__ void done(const Unit&) const {}
};
__device__ __forceinline__ float bf_lo(unsigned w) { return __builtin_bit_cast(float, w << 16); }
__device__ __forceinline__ float bf_hi(unsigned w) { return __builtin_bit_cast(float, w & 0xffff0000u); }
__device__ __forceinline__ float sigmoid_f(float x) { return __builtin_amdgcn_rcpf(1.0f + __builtin_amdgcn_exp2f(-1.4426950408889634f * x)); }
struct EpiProj {
    static constexpr bool PERM = true, AFTER_DRAIN = false;
    bf16_t* PA; bf16_t* PG;
    __device__ __forceinline__ void operator()(const f32x4 (&acc)[2][2][4][2], const Unit& u, int wr, int wc, int fr, int fq) const {
        const bool gate = u.pn >= 14;
        bf16_t* base = gate ? PG : PA; const int ldc = gate ? 3072 : 3584; const int colt = gate ? (u.pn - 14) * BM : u.pn * BM;
        const int row0 = u.pm * BM + wr * 64 + fr, col0 = colt + wc * 32 + 8 * fq;
#pragma unroll
        for (int ai = 0; ai < 2; ++ai)
#pragma unroll
            for (int m = 0; m < 4; ++m) { bf16_t* rowp = base + (size_t)(row0 + ai * HALF + m * 16) * ldc + col0;
#pragma unroll
                for (int bj = 0; bj < 2; ++bj) { f32x4 v0 = acc[ai][bj][m][0], v1 = acc[ai][bj][m][1];
                    if (gate) {
#pragma unroll
                        for (int e = 0; e < 4; ++e) { v0[e] = sigmoid_f(v0[e]); v1[e] = sigmoid_f(v1[e]); } }
                    u32x4 w; w.x = cvt_pk_bf16(v0[0], v0[1]); w.y = cvt_pk_bf16(v0[2], v0[3]); w.z = cvt_pk_bf16(v1[0], v1[1]); w.w = cvt_pk_bf16(v1[2], v1[3]);
                    *(u32x4*)(rowp + bj * HALF) = w; } }
    }
};
struct EpiBranch {
    static constexpr bool PERM = true, AFTER_DRAIN = false;
    const bf16_t* PG; bf16_t* MG;
    __device__ __forceinline__ void operator()(const f32x4 (&acc)[2][2][4][2], const Unit& u, int wr, int wc, int fr, int fq) const {
        const int br = u.pm >> 6, tm = u.pm & 63, tn = u.pn & 3;
        const int row0 = tm * BM + wr * 64 + fr, col0 = tn * BM + wc * 32 + 8 * fq;
#pragma unroll
        for (int ai = 0; ai < 2; ++ai)
#pragma unroll
            for (int m = 0; m < 4; ++m) { const size_t row = (size_t)(row0 + ai * HALF + m * 16);
#pragma unroll
                for (int bj = 0; bj < 2; ++bj) { const int col = col0 + bj * HALF;
                    const u32x4 g = *(const u32x4*)(PG + row * 3072 + br * 1024 + col);
                    f32x4 v0 = acc[ai][bj][m][0], v1 = acc[ai][bj][m][1];
                    v0[0] *= bf_lo(g.x); v0[1] *= bf_hi(g.x); v0[2] *= bf_lo(g.y); v0[3] *= bf_hi(g.y);
                    v1[0] *= bf_lo(g.z); v1[1] *= bf_hi(g.z); v1[2] *= bf_lo(g.w); v1[3] *= bf_hi(g.w);
                    bf16_t* mp = MG + row * 1024 + col;
                    if (br > 0) { const u32x4 p = *(const u32x4*)mp;
                        v0[0] += bf_lo(p.x); v0[1] += bf_hi(p.x); v0[2] += bf_lo(p.y); v0[3] += bf_hi(p.y);
                        v1[0] += bf_lo(p.z); v1[1] += bf_hi(p.z); v1[2] += bf_lo(p.w); v1[3] += bf_hi(p.w); }
                    u32x4 w; w.x = cvt_pk_bf16(v0[0], v0[1]); w.y = cvt_pk_bf16(v0[2], v0[3]); w.z = cvt_pk_bf16(v1[0], v1[1]); w.w = cvt_pk_bf16(v1[2], v1[3]);
                    *(u32x4*)mp = w; } }
    }
};
struct EpiWout {
    static constexpr bool PERM = false, AFTER_DRAIN = false;
    const float* X; float* H; bf16_t* HB; float* SL;
    __device__ __forceinline__ void operator()(const f32x4 (&acc)[2][2][4][2], const Unit& u, int wr, int wc, int fr, int fq) const {
        const int row0 = u.pm * BM + wr * 64 + fr, col0 = u.pn * BM + wc * 32 + 4 * fq;
#pragma unroll
        for (int ai = 0; ai < 2; ++ai)
#pragma unroll
            for (int m = 0; m < 4; ++m) { const size_t row = (size_t)(row0 + ai * HALF + m * 16); float ss = 0.f;
#pragma unroll
                for (int bj = 0; bj < 2; ++bj)
#pragma unroll
                    for (int n = 0; n < 2; ++n) { const size_t off = row * 1024 + col0 + bj * HALF + n * 16;
                        const f32x4 xv = *(const f32x4*)(X + off); const f32x4 hv = xv + acc[ai][bj][m][n];
                        *(f32x4*)(H + off) = hv; ss += (hv[0] * hv[0] + hv[1] * hv[1]) + (hv[2] * hv[2] + hv[3] * hv[3]);
                        typedef unsigned u32x2v __attribute__((ext_vector_type(2))); u32x2v w; w.x = cvt_pk_bf16(hv[0], hv[1]); w.y = cvt_pk_bf16(hv[2], hv[3]);
                        *(u32x2v*)(HB + off) = w; }
                ss += __shfl_xor(ss, 16); ss += __shfl_xor(ss, 32);
                if (fq == 0) SL[row * 16 + u.pn * 4 + wc] = ss; }
    }
};
template <class Epi, class Sched, bool ALIGN_EPI = false, bool SP2 = false>
__device__ __forceinline__ void gemm_phase(PG8_LAS unsigned char* lds, const Gemm g, const Sched& S, const Epi& E) {
    const int tid = threadIdx.x, wid = __builtin_amdgcn_readfirstlane(tid >> 6), lane = tid & 63, wr = wid >> 2, wc = wid & 3, fr = lane & 15, fq = lane >> 4;
    const int K = g.K, nt = K / BK;
    unsigned voffA[2], voffB[2];
#pragma unroll
    for (int i = 0; i < 2; ++i) { int R, C; stage_rc(tid * 16 + i * 8192, R, C); const int Rb = Epi::PERM ? ((R & ~31) + perm32(R & 31)) : R;
        voffA[i] = (unsigned)(R * K + C) * 2u; voffB[i] = (unsigned)(Rb * K + C) * 2u; }
    const size_t kstep = (size_t)(BK * 2);
    const size_t hstep = (size_t)HALF * K * 2;
    const size_t tstep = 2 * hstep;
    const unsigned ldsw = (unsigned)wid * 1024u;
    const int aoff = lds_byte(wr * 64 + fr, fq * 8), boff = lds_byte(wc * 32 + fr, fq * 8);
#define PG8_SA(b, h) (((b) * 2 + (h)) * HTB)
#define PG8_SB(b, h) ((4 + (b) * 2 + (h)) * HTB)
#define PG8_STAGE(bufoff, gbase, voff) do { _Pragma("unroll") for (int _i = 0; _i < 2; ++_i) \
        __builtin_amdgcn_global_load_lds((const unsigned*)((const char*)(gbase) + (voff)[_i]), (PG8_LAS unsigned*)(lds + (bufoff) + ldsw + _i * 8192), 16, 0, 0); } while (0)
#define PG8_LDA(dst, b, h) do { _Pragma("unroll") for (int m = 0; m < 4; ++m) _Pragma("unroll") for (int k = 0; k < 2; ++k) dst[m][k] = *(const PG8_LAS bf16x8*)(lds + PG8_SA(b, h) + aoff + m * 2048 + k * 1024); } while (0)
#define PG8_LDB(dst, b, h) do { _Pragma("unroll") for (int n = 0; n < 2; ++n) _Pragma("unroll") for (int k = 0; k < 2; ++k) dst[n][k] = *(const PG8_LAS bf16x8*)(lds + PG8_SB(b, h) + boff + n * 2048 + k * 1024); } while (0)
#define PG8_MMA(ai, bj, At, Bt) do { __builtin_amdgcn_s_setprio(1); _Pragma("unroll") for (int m = 0; m < 4; ++m) _Pragma("unroll") for (int n = 0; n < 2; ++n) _Pragma("unroll") for (int k = 0; k < 2; ++k) \
        acc[ai][bj][m][n] = __builtin_amdgcn_mfma_f32_16x16x32_bf16(Bt[n][k], At[m][k], acc[ai][bj][m][n], 0, 0, 0); __builtin_amdgcn_s_setprio(0); } while (0)
#define PG8_WAIT_V(n) asm volatile("s_waitcnt vmcnt(" #n ")" ::: "memory")
#define PG8_WAIT_L(n) asm volatile("s_waitcnt lgkmcnt(" #n ")" ::: "memory")
#define PG8_BAR __builtin_amdgcn_s_barrier()
#define PG8_SCHED __builtin_amdgcn_sched_barrier(0)
    Unit cur, nxt; int ui = 0;
    if (!S.next(0, cur)) return;
    f32x4 acc[2][2][4][2];
#pragma unroll
    for (int a = 0; a < 2; ++a)
#pragma unroll
        for (int b = 0; b < 2; ++b)
#pragma unroll
            for (int m = 0; m < 4; ++m)
#pragma unroll
                for (int n = 0; n < 2; ++n) acc[a][b][m][n] = (f32x4){0.f, 0.f, 0.f, 0.f};
    bf16x8 At[4][2], B0[2][2], B1[2][2];
    const char* cA = (const char*)g.A + (size_t)cur.pm * tstep; const char* cB = (const char*)g.Bt + (size_t)cur.pn * tstep;
    S.a_ready(cur);
    if constexpr (SP2) {
        PG8_STAGE(PG8_SB(0, 0), cB, voffB); PG8_STAGE(PG8_SB(0, 1), cB + hstep, voffB); PG8_STAGE(PG8_SA(0, 0), cA, voffA); PG8_STAGE(PG8_SA(0, 1), cA + hstep, voffA);
        if (wr == 1) PG8_BAR;
        PG8_WAIT_V(2); PG8_BAR;
        PG8_STAGE(PG8_SB(1, 0), cB + kstep, voffB); PG8_STAGE(PG8_SA(1, 0), cA + kstep, voffA); PG8_STAGE(PG8_SB(1, 1), cB + hstep + kstep, voffB);
        PG8_WAIT_V(6); PG8_BAR;
    } else {
        PG8_STAGE(PG8_SB(0, 0), cB, voffB); PG8_STAGE(PG8_SA(0, 0), cA, voffA); PG8_STAGE(PG8_SB(0, 1), cB + hstep, voffB); PG8_STAGE(PG8_SA(0, 1), cA + hstep, voffA);
        if (wr == 1) PG8_BAR;
        PG8_WAIT_V(4); PG8_BAR;
        PG8_STAGE(PG8_SB(1, 0), cB + kstep, voffB); PG8_STAGE(PG8_SA(1, 0), cA + kstep, voffA); PG8_STAGE(PG8_SB(1, 1), cB + hstep + kstep, voffB);
        PG8_WAIT_V(6); PG8_BAR;
    }
    for (;;) {
        const bool has_next = S.next(ui + 1, nxt);
        const char* nA = has_next ? (const char*)g.A + (size_t)nxt.pm * tstep : cA; const char* nB = has_next ? (const char*)g.Bt + (size_t)nxt.pn * tstep : cB;
        for (int t = 0; t < nt; t += 2) {
            const bool last = (t == nt - 2);
            const char* a1 = cA + (size_t)(t + 1) * kstep;
            const char* a2 = last ? nA : cA + (size_t)(t + 2) * kstep; const char* b2 = last ? nB : cB + (size_t)(t + 2) * kstep;
            const char* a3 = a2 + kstep; const char* b3 = b2 + kstep;
            if (last && has_next) S.a_ready(nxt);
            if constexpr (SP2) {
            PG8_LDB(B0, 0, 0); PG8_LDB(B1, 0, 1); PG8_SCHED; PG8_LDA(At, 0, 0); PG8_STAGE(PG8_SA(1, 1), a1 + hstep, voffA);
            PG8_WAIT_V(8); PG8_WAIT_L(0); PG8_BAR; PG8_MMA(0, 0, At, B0); PG8_MMA(0, 1, At, B1); PG8_BAR; PG8_SCHED;
            PG8_LDA(At, 0, 1); PG8_STAGE(PG8_SB(0, 0), b2, voffB); PG8_STAGE(PG8_SB(0, 1), b2 + hstep, voffB); PG8_STAGE(PG8_SA(0, 0), a2, voffA);
            PG8_WAIT_V(8); PG8_WAIT_L(0); PG8_BAR; PG8_MMA(1, 0, At, B0); PG8_MMA(1, 1, At, B1); PG8_BAR; PG8_SCHED;
            PG8_LDB(B0, 1, 0); PG8_LDB(B1, 1, 1); PG8_SCHED; PG8_LDA(At, 1, 0); PG8_STAGE(PG8_SA(0, 1), a2 + hstep, voffA);
            PG8_WAIT_V(8); PG8_WAIT_L(0); PG8_BAR; PG8_MMA(0, 0, At, B0); PG8_MMA(0, 1, At, B1); PG8_BAR; PG8_SCHED;
            PG8_LDA(At, 1, 1); PG8_STAGE(PG8_SB(1, 0), b3, voffB); PG8_STAGE(PG8_SB(1, 1), b3 + hstep, voffB); PG8_STAGE(PG8_SA(1, 0), a3, voffA);
            PG8_WAIT_V(8); PG8_WAIT_L(0); PG8_BAR; PG8_MMA(1, 0, At, B0); PG8_MMA(1, 1, At, B1); PG8_BAR; PG8_SCHED;
            } else {
            PG8_LDB(B0, 0, 0); PG8_SCHED; PG8_LDA(At, 0, 0); PG8_STAGE(PG8_SA(1, 1), a1 + hstep, voffA);
            PG8_WAIT_L(8); PG8_BAR; PG8_WAIT_L(0); PG8_MMA(0, 0, At, B0); PG8_BAR; PG8_SCHED;
            PG8_LDB(B1, 0, 1); PG8_STAGE(PG8_SB(0, 0), b2, voffB);
            PG8_BAR; PG8_WAIT_L(0); PG8_MMA(0, 1, At, B1); PG8_BAR;
            PG8_LDA(At, 0, 1); PG8_STAGE(PG8_SA(0, 0), a2, voffA);
            PG8_BAR; PG8_WAIT_L(0); PG8_MMA(1, 0, At, B0); PG8_BAR; PG8_SCHED;
            PG8_STAGE(PG8_SB(0, 1), b2 + hstep, voffB);
            PG8_WAIT_V(6); PG8_BAR; PG8_MMA(1, 1, At, B1); PG8_BAR;
            PG8_LDB(B0, 1, 0); PG8_SCHED; PG8_LDA(At, 1, 0); PG8_STAGE(PG8_SA(0, 1), a2 + hstep, voffA);
            PG8_WAIT_L(8); PG8_BAR; PG8_WAIT_L(0); PG8_MMA(0, 0, At, B0); PG8_BAR; PG8_SCHED;
            PG8_LDB(B1, 1, 1); PG8_STAGE(PG8_SB(1, 0), b3, voffB);
            PG8_BAR; PG8_WAIT_L(0); PG8_MMA(0, 1, At, B1); PG8_BAR;
            PG8_LDA(At, 1, 1); PG8_STAGE(PG8_SA(1, 0), a3, voffA);
            PG8_BAR; PG8_WAIT_L(0); PG8_MMA(1, 0, At, B0); PG8_BAR; PG8_SCHED;
            PG8_STAGE(PG8_SB(1, 1), b3 + hstep, voffB);
            PG8_WAIT_V(6); PG8_BAR; PG8_MMA(1, 1, At, B1); PG8_BAR;
            }
        }
        if constexpr (ALIGN_EPI) { if (wr == 0) PG8_BAR; }
        if constexpr (!Epi::AFTER_DRAIN) { E(acc, cur, wr, wc, fr, fq); S.done(cur); }
        if (!has_next) break;
#pragma unroll
        for (int a = 0; a < 2; ++a)
#pragma unroll
            for (int b = 0; b < 2; ++b)
#pragma unroll
                for (int m = 0; m < 4; ++m)
#pragma unroll
                    for (int n = 0; n < 2; ++n) acc[a][b][m][n] = (f32x4){0.f, 0.f, 0.f, 0.f};
        cur = nxt; cA = nA; cB = nB; ++ui;
        if constexpr (ALIGN_EPI) { if (wr == 1) PG8_BAR; }
    }
    PG8_WAIT_V(0);
    if constexpr (!ALIGN_EPI) { if (wr == 0) PG8_BAR; }
    PG8_BAR;
    if constexpr (Epi::AFTER_DRAIN) { E.fused(acc, cur, wr, wc, fr, fq, lds, wid, lane); S.done(cur); }
#undef PG8_SA
#undef PG8_SB
#undef PG8_STAGE
#undef PG8_LDA
#undef PG8_LDB
#undef PG8_MMA
#undef PG8_WAIT_V
#undef PG8_WAIT_L
#undef PG8_BAR
#undef PG8_SCHED
}
}

constexpr int NWAVES = 8;
constexpr int T = 16384, DM = 1024, SEQ = 2048, NBATCH = 8, MEMLEN = 256;
constexpr int PW = 6656, PAW = 3584, PGW = 3072;
constexpr int COL_QA = 0, COL_KA = 512, COL_VA = 1024, COL_UC = 1536, COL_BC = 2048, COL_CC = 2560, COL_QX = 3072;
constexpr float RMS_EPS = 1e-6f, LOG2E = 1.4426950408889634f;
constexpr float C2A = 0.125f * LOG2E;
constexpr float C2X = 0.08838834764831845f * LOG2E;
constexpr int NEXP = 16384;

constexpr size_t MiB = 1u << 20;
constexpr size_t WS_CTL = 0, CTL_ZERO_BYTES = 1 * MiB;
constexpr size_t WS_WIN = 1 * MiB;
constexpr size_t WS_WKV = 14 * MiB;
constexpr size_t WS_WBR = 16 * MiB;
constexpr size_t WS_WOUT = 19 * MiB;
constexpr size_t WS_WQ = 21 * MiB;
constexpr size_t WS_SK = 25 * MiB;
constexpr size_t WS_TAB = 25 * MiB + 512 * 1024;
constexpr size_t WS_KMEAN = WS_TAB + 64 * 1024;
constexpr size_t WS_MEMN = 26 * MiB;
constexpr size_t WS_KVM = 30 * MiB;
constexpr size_t WS_SLOTS = 34 * MiB;
constexpr size_t WS_SEL = 35 * MiB;
constexpr size_t WS_SU = 43 * MiB, WS_SV = 43 * MiB + 65536, WS_SX = 43 * MiB + 2 * 65536, WS_CS = 43 * MiB + 3 * 65536;
constexpr size_t WS_PA = 44 * MiB;
constexpr size_t WS_PG = 156 * MiB;
constexpr size_t WS_END = 252 * MiB;
constexpr size_t PA_MERGED = WS_PA, PA_HB = WS_PA + 32 * MiB, PA_UT = WS_PA + 64 * MiB, PA_VT = WS_PA;
constexpr size_t PG_QRY = WS_PG, PG_PART = WS_PG, PG_COEF = WS_PG + 64 * MiB, PA_XQ = WS_PA + 32 * MiB;
constexpr int CW_QU = 8192, CW_QV = 8192 + 512;
constexpr int CW_BAR = 4096;

constexpr int RING_OFF = 0, RING_BYTES = 131072;
constexpr int LDSCTL_OFF = RING_BYTES, MISC_OFF = LDSCTL_OFF + 320;
constexpr int LDS_BYTES = 147456;

#define GAS __attribute__((address_space(1)))
#define LAS __attribute__((address_space(3)))
typedef unsigned short bf16;
typedef unsigned v4u __attribute__((ext_vector_type(4)));
typedef unsigned v2u __attribute__((ext_vector_type(2)));
typedef float f32x4 __attribute__((ext_vector_type(4)));
typedef float f32x16 __attribute__((ext_vector_type(16)));
typedef short bf16x8 __attribute__((ext_vector_type(8)));
typedef short s16x4 __attribute__((ext_vector_type(4)));
typedef GAS unsigned gu32;
#define RLX_AGENT __ATOMIC_RELAXED, __HIP_MEMORY_SCOPE_AGENT
#define LDS_WAIT() asm volatile("s_waitcnt lgkmcnt(0)" ::: "memory")
#define VM_WAIT() asm volatile("s_waitcnt vmcnt(0)" ::: "memory")
__device__ __forceinline__ unsigned f2bf(float f) { unsigned u = __builtin_bit_cast(unsigned, f); return (u + 0x7fffu + ((u >> 16) & 1u)) >> 16; }
__device__ __forceinline__ unsigned pk2(float lo, float hi) { return f2bf(lo) | (f2bf(hi) << 16); }
__device__ __forceinline__ float bflo(unsigned w) { return __builtin_bit_cast(float, w << 16); }
__device__ __forceinline__ float bfhi(unsigned w) { return __builtin_bit_cast(float, w & 0xffff0000u); }
__device__ __forceinline__ float wave_sum(float v) {
#pragma unroll
    for (int o = 1; o < 64; o <<= 1) v += __shfl_xor(v, o);
    return v;
}
#define XB_TMO      128
#define XB_XCNT(j)  (256  + 64 * (j))
#define XB_XSUB(j)  (1280 + 64 * (j))
#define XB_XGEN(j)  (2304 + 64 * (j))
#define XB_TOP      3328
#define XB_TOPGEN   3392
#define XCD_BAR_WORDS 3456
#define XB_SPIN_CAP (1u << 18)

__device__ __forceinline__ unsigned xb_ld(unsigned* p)              { return __hip_atomic_load(p, __ATOMIC_RELAXED, __HIP_MEMORY_SCOPE_AGENT); }
__device__ __forceinline__ unsigned xb_add(unsigned* p, unsigned v) { return __hip_atomic_fetch_add(p, v, __ATOMIC_RELAXED, __HIP_MEMORY_SCOPE_AGENT); }
__device__ __forceinline__ unsigned xb_xcc_id() { return (unsigned)__builtin_amdgcn_s_getreg((3 << 11) | 20) & 0xFu; }
#define XB_SPIN(cond, bar) do { unsigned _sp = 0; while (cond) { __builtin_amdgcn_s_sleep(1); \
    if ((++_sp & 255u) == 0u) { if (xb_ld(&(bar)[XB_TMO])) break; if (_sp > XB_SPIN_CAP) { atomicAdd(&(bar)[XB_TMO], 1u); break; } } } } while (0)

struct XcdBarrier {
    unsigned* bar; unsigned x;
    volatile LAS unsigned* st;
};

__device__ __forceinline__ XcdBarrier xcd_barrier_post(unsigned* bar, volatile LAS unsigned* st) {
    XcdBarrier b; b.bar = bar; b.x = xb_xcc_id(); b.st = st;
    if (threadIdx.x == 0) (void)xb_add(&bar[XB_XCNT(b.x)], 1u);
    return b;
}
__device__ __forceinline__ void xcd_barrier_complete(unsigned* bar, unsigned x, unsigned& nloc, unsigned& nx) {
    const unsigned G = gridDim.x * gridDim.y * gridDim.z;
    unsigned sum, cnt, mine, sp = 0u;
    for (;;) {
        sum = 0u; cnt = 0u; mine = 0u;
#pragma unroll
        for (unsigned j = 0; j < 16; ++j) { const unsigned c = xb_ld(&bar[XB_XCNT(j)]); sum += c; cnt += (c > 0u) ? 1u : 0u; mine = (j == x) ? c : mine; }
        if (sum == G) break;
        __builtin_amdgcn_s_sleep(1);
        if ((++sp & 255u) == 0u) { if (xb_ld(&bar[XB_TMO])) break; if (sp > XB_SPIN_CAP) { atomicAdd(&bar[XB_TMO], 1u); break; } }
    }
    nloc = mine > 0u ? mine : 1u; nx = cnt > 0u ? cnt : 1u;
}

__device__ __forceinline__ void xcd_barrier(const XcdBarrier& b) {
    asm volatile("s_waitcnt vmcnt(0)" ::: "memory");
    __syncthreads();
    if (threadIdx.x == 0) {
        unsigned* bar = b.bar;
        __builtin_amdgcn_s_waitcnt(0);
        unsigned nloc = b.st[0], nx = b.st[1];
        if (nloc == 0u) { xcd_barrier_complete(bar, b.x, nloc, nx); b.st[0] = nloc; b.st[1] = nx; }
        const unsigned old = xb_add(&bar[XB_XSUB(b.x)], 1u);
        const unsigned gen = old / nloc;
        if (old + 1u == (gen + 1u) * nloc) {
            __builtin_amdgcn_fence(__ATOMIC_RELEASE, "agent");
            asm volatile("s_waitcnt vmcnt(0)" ::: "memory");
            const unsigned og = xb_add(&bar[XB_TOP], 1u);
            const unsigned tg = og / nx;
            if (og + 1u == (tg + 1u) * nx) xb_add(&bar[XB_TOPGEN], 1u);
            else XB_SPIN(xb_ld(&bar[XB_TOPGEN]) == tg, bar);
            __builtin_amdgcn_fence(__ATOMIC_ACQUIRE, "agent");
            xb_add(&bar[XB_XGEN(b.x)], 1u);
            asm volatile("s_waitcnt vmcnt(0)" ::: "memory");
        } else {
            XB_SPIN(xb_ld(&bar[XB_XGEN(b.x)]) == gen, bar);
            __builtin_amdgcn_fence(__ATOMIC_ACQUIRE, "agent");
            asm volatile("s_waitcnt vmcnt(0)" ::: "memory");
        }
    }
    __syncthreads();
}

__device__ __forceinline__ void p0_transpose_item(const float* W, int K, int N, bf16* WT, int row_off, const float* ksc, LAS float* scr, int item, int lane) {
    const int nblk = N / 32, kb = item / nblk, nb = item % nblk, k0 = 64 * kb, n0 = 32 * nb;
#pragma unroll 8
    for (int i = 0; i < 32; ++i) { const int kk = 2 * i + (lane >> 5); float v = W[(size_t)(k0 + kk) * N + n0 + (lane & 31)]; if (ksc) v *= ksc[k0 + kk]; scr[kk * 33 + (lane & 31)] = v; }
    LDS_WAIT(); asm volatile("" ::: "memory");
    const int c = lane & 7;
#pragma unroll
    for (int j = 0; j < 4; ++j) { const int n = (lane >> 3) + 8 * j; const LAS float* s = scr + (8 * c) * 33 + n;
        v4u o; o.x = pk2(s[0 * 33], s[1 * 33]); o.y = pk2(s[2 * 33], s[3 * 33]); o.z = pk2(s[4 * 33], s[5 * 33]); o.w = pk2(s[6 * 33], s[7 * 33]);
        *(GAS v4u*)(WT + (size_t)(row_off + n0 + n) * K + k0 + 8 * c) = o; }
    LDS_WAIT(); asm volatile("" ::: "memory");
}
template <int NR> __device__ __forceinline__ void rms_rows_to_bf16(const float* X, const float* g, bf16* O, int m0, int ms, int mend, int lane) {
    const GAS f32x4* gr = (const GAS f32x4*)g + lane;
    f32x4 v[NR][4];
#pragma unroll
    for (int r = 0; r < NR; ++r) { const int m = (m0 + r * ms < mend) ? m0 + r * ms : mend - 1; const GAS f32x4* xr = (const GAS f32x4*)(X + (size_t)m * DM) + lane;
#pragma unroll
        for (int j = 0; j < 4; ++j) v[r][j] = xr[64 * j]; }
    f32x4 gv[4];
#pragma unroll
    for (int j = 0; j < 4; ++j) gv[j] = gr[64 * j];
#pragma unroll
    for (int r = 0; r < NR; ++r) { float s = 0.f;
#pragma unroll
        for (int j = 0; j < 4; ++j) s += (v[r][j].x * v[r][j].x + v[r][j].y * v[r][j].y) + (v[r][j].z * v[r][j].z + v[r][j].w * v[r][j].w);
        const float rr = 1.f / sqrtf(wave_sum(s) * (1.f / 1024.f) + RMS_EPS);
        if (m0 + r * ms < mend) { GAS unsigned long long* o8 = (GAS unsigned long long*)(O + (size_t)(m0 + r * ms) * DM) + lane;
#pragma unroll
            for (int j = 0; j < 4; ++j) o8[64 * j] = (unsigned long long)pk2(v[r][j].x * rr * gv[j].x, v[r][j].y * rr * gv[j].y) | ((unsigned long long)pk2(v[r][j].z * rr * gv[j].z, v[r][j].w * rr * gv[j].w) << 32); } }
}
__device__ __forceinline__ void cvt_row_to_bf16(const float* xrow, bf16* orow, int lane) {
    const GAS f32x4* xr = (const GAS f32x4*)xrow + lane; GAS unsigned long long* o8 = (GAS unsigned long long*)orow + lane;
    f32x4 v[4];
#pragma unroll
    for (int j = 0; j < 4; ++j) v[j] = xr[64 * j];
#pragma unroll
    for (int j = 0; j < 4; ++j) o8[64 * j] = (unsigned long long)pk2(v[j].x, v[j].y) | ((unsigned long long)pk2(v[j].z, v[j].w) << 32);
}
__device__ __forceinline__ int rel_bucket_dev(int d) {
    if (d < 16) return d;
    int b = 16;
    b += (d >= 21); b += (d >= 27); b += (d >= 35); b += (d >= 46); b += (d >= 59); b += (d >= 77); b += (d >= 99); b += (d >= 128);
    b += (d >= 166); b += (d >= 216); b += (d >= 280); b += (d >= 363); b += (d >= 470); b += (d >= 609); b += (d >= 790);
    return b;
}
struct P0Args { const float *x, *mem, *g_mix, *w_in, *rel_bias, *g_mem, *w_mem_kv, *w_br_attn, *w_br_conv, *w_br_x, *w_out, *g_ffn, *w_query, *sub_keys;
                bf16 *WinT, *WkvT, *WbrT, *WoutT, *WqT, *SK, *HN, *MEMN; float* TAB; };
__device__ __forceinline__ void p0_prologue(const P0Args& a, LAS unsigned char* lds, int gw, int NGW, int wave, int lane) {
    LAS float* scr = (LAS float*)(lds + RING_OFF + wave * 16384);
    constexpr int I_IN = (DM / 64) * (PW / 32), I_KV = (DM / 64) * (1024 / 32), I_BR = (512 / 64) * (1024 / 32), I_OUT = (DM / 64) * (1024 / 32), I_Q = (DM / 64) * (2048 / 32);
    constexpr int NITEMS = I_IN + I_KV + 3 * I_BR + I_OUT + I_Q;
    for (int it = gw; it < NITEMS; it += NGW) {
        int r = it;
        if (r < I_IN) { p0_transpose_item(a.w_in, DM, PW, a.WinT, 0, nullptr, scr, r, lane); continue; } r -= I_IN;
        if (r < I_KV) { p0_transpose_item(a.w_mem_kv, DM, 1024, a.WkvT, 0, nullptr, scr, r, lane); continue; } r -= I_KV;
        if (r < I_BR) { p0_transpose_item(a.w_br_attn, 512, 1024, a.WbrT, 0, nullptr, scr, r, lane); continue; } r -= I_BR;
        if (r < I_BR) { p0_transpose_item(a.w_br_conv, 512, 1024, a.WbrT, 1024, nullptr, scr, r, lane); continue; } r -= I_BR;
        if (r < I_BR) { p0_transpose_item(a.w_br_x, 512, 1024, a.WbrT, 2048, nullptr, scr, r, lane); continue; } r -= I_BR;
        if (r < I_OUT) { p0_transpose_item(a.w_out, DM, 1024, a.WoutT, 0, nullptr, scr, r, lane); continue; } r -= I_OUT;
        p0_transpose_item(a.w_query, DM, 2048, a.WqT, 0, a.g_ffn, scr, r, lane);
    }
    for (int m = gw; m < T; m += 4 * NGW) rms_rows_to_bf16<4>(a.x, a.g_mix, a.HN, m, NGW, T, lane);
    for (int m = gw; m < NBATCH * MEMLEN; m += NGW) rms_rows_to_bf16<1>(a.mem, a.g_mem, a.MEMN, m, NGW, NBATCH * MEMLEN, lane);
    for (int m = gw; m < 256; m += NGW) cvt_row_to_bf16(a.sub_keys + (size_t)m * 1024, a.SK + (size_t)m * 1024, lane);
    for (int m = gw; m < 256; m += NGW) {
        const int idx = m * 64 + lane, h = idx >> 11, d = idx & 2047;
        a.TAB[idx] = a.rel_bias[rel_bucket_dev(d) * 8 + h] * LOG2E;
    }
}

template <int DH> __device__ __forceinline__ void fix_item(bf16* buf, size_t pitch, int row0, int col0, const float* gain, float gscale, float* kmean, LAS float* red, int wave, int lane) {
    constexpr int LPR = DH / 8, RPI = 64 / LPR, NIT = 32 / RPI;
    const int sub = lane / LPR, ch = lane % LPR;
    float g[8], cs[8];
#pragma unroll
    for (int j = 0; j < 8; ++j) { g[j] = gain[ch * 8 + j] * gscale; cs[j] = 0.f; }
    v4u w[NIT];
#pragma unroll
    for (int it = 0; it < NIT; ++it) w[it] = *(const GAS v4u*)(buf + (size_t)(row0 + wave * 32 + it * RPI + sub) * pitch + col0 + ch * 8);
#pragma unroll
    for (int it = 0; it < NIT; ++it) {
        float x[8] = {bflo(w[it].x), bfhi(w[it].x), bflo(w[it].y), bfhi(w[it].y), bflo(w[it].z), bfhi(w[it].z), bflo(w[it].w), bfhi(w[it].w)};
        float ss = 0.f;
#pragma unroll
        for (int j = 0; j < 8; ++j) ss += x[j] * x[j];
#pragma unroll
        for (int o = 1; o < LPR; o <<= 1) ss += __shfl_xor(ss, o);
        const float r = 1.f / sqrtf(ss * (1.f / DH) + RMS_EPS);
#pragma unroll
        for (int j = 0; j < 8; ++j) { x[j] = x[j] * r * g[j]; cs[j] += x[j]; }
        v4u o; o.x = pk2(x[0], x[1]); o.y = pk2(x[2], x[3]); o.z = pk2(x[4], x[5]); o.w = pk2(x[6], x[7]);
        *(GAS v4u*)(buf + (size_t)(row0 + wave * 32 + it * RPI + sub) * pitch + col0 + ch * 8) = o;
    }
    if (kmean) {
#pragma unroll
        for (int j = 0; j < 8; ++j) {
#pragma unroll
            for (int o = LPR; o < 64; o <<= 1) cs[j] += __shfl_xor(cs[j], o);
        }
        if (sub == 0) {
#pragma unroll
            for (int j = 0; j < 8; ++j) red[wave * DH + ch * 8 + j] = cs[j];
        }
        asm volatile("s_waitcnt lgkmcnt(0)\n\ts_barrier" ::: "memory");
        if (wave == 0 && lane < DH) { float s = 0.f;
#pragma unroll
            for (int w8 = 0; w8 < 8; ++w8) s += red[w8 * DH + lane];
            kmean[lane] = s * (1.f / 256.f); }
        asm volatile("s_waitcnt lgkmcnt(0)\n\ts_barrier" ::: "memory");
    }
}
__device__ __forceinline__ void p2_fixup(bf16* PA, bf16* KVM, float* KMEAN, const float* q_gain_a, const float* k_gain_a, const float* q_gain_x, const float* k_gain_x, LAS unsigned char* lds, int vcu, int G, int wave, int lane) {
    constexpr int N_A = 512, N_X = 256, N_KX = 32, NIT = 2 * N_A + N_X + N_KX;
    LAS float* red = (LAS float*)lds;
    for (int it = vcu; it < NIT; it += G) {
        int r = it;
        if (r < N_A) { const int b = r >> 6, h = (r >> 3) & 7, n = r & 7;
            fix_item<64>(PA, PAW, b * SEQ + n * 256, COL_KA + h * 64, k_gain_a, 1.0f, KMEAN + (size_t)((b * 8 + h) * 8 + n) * 64, red, wave, lane); continue; } r -= N_A;
        if (r < N_A) { const int b = r >> 6, h = (r >> 3) & 7, n = r & 7;
            fix_item<64>(PA, PAW, b * SEQ + n * 256, COL_QA + h * 64, q_gain_a, C2A, nullptr, red, wave, lane); continue; } r -= N_A;
        if (r < N_X) { const int b = r >> 5, h = (r >> 3) & 3, n = r & 7;
            fix_item<128>(PA, PAW, b * SEQ + n * 256, COL_QX + h * 128, q_gain_x, C2X, nullptr, red, wave, lane); continue; } r -= N_X;
        { const int b = r >> 2, h = r & 3;
            fix_item<128>(KVM, 1024, b * MEMLEN, h * 128, k_gain_x, 1.0f, nullptr, red, wave, lane); }
    }
}

namespace att {
constexpr int L_K = 0, L_V = 16384, L_BUF = 32768  , L_OST = 0  ,
              L_TAB = 65536, TAB_PAD = 256, L_KM = L_TAB + (TAB_PAD + 2048) * 4, L_SEL = L_KM + 2048, L_WSF = L_SEL + 1024, L_END = L_WSF + NWAVES * 256;
static_assert(L_END <= RING_BYTES, "attention LDS map");
__device__ __forceinline__ int crow(int r, int hi) { return (r & 3) + 8 * (r >> 2) + 4 * hi; }
__device__ __forceinline__ void glds16(const void* gsrc, unsigned lds_dst) { unsigned keep;
    asm volatile("s_mov_b32 %0, m0\n\ts_mov_b32 m0, %2\n\ts_nop 0\n\tglobal_load_lds_dwordx4 %1, off\n\ts_mov_b32 m0, %0" : "=&s"(keep) : "v"(gsrc), "s"(lds_dst) : "memory"); }
__device__ __forceinline__ unsigned cvtpk(float lo, float hi) { typedef float f2 __attribute__((ext_vector_type(2))); typedef __bf16 b2 __attribute__((ext_vector_type(2))); f2 v = {lo, hi}; b2 b = __builtin_convertvector(v, b2); return __builtin_bit_cast(unsigned, b); }
__device__ __forceinline__ float rowmax(const f32x16& p0, const f32x16& p1) {
    float a = fmaxf(p0[0], p1[0]);
#pragma unroll
    for (int r = 1; r < 16; ++r) a = fmaxf(a, fmaxf(p0[r], p1[r]));
    auto rr = __builtin_amdgcn_permlane32_swap(__float_as_uint(a), __float_as_uint(a), false, false);
    return fmaxf(__uint_as_float(rr[0]), __uint_as_float(rr[1]));
}
template <int ND0> __device__ __forceinline__ void qkt(f32x16& p0, f32x16& p1, const LAS unsigned char* Kslot, const bf16x8* qr, int r32, int hi) {
    const LAS unsigned char* kb = Kslot + hi * 1024 + r32 * 16;
    p0 = f32x16{}; p1 = f32x16{};
#pragma unroll
    for (int d0 = 0; d0 < ND0; ++d0) {
        const bf16x8 b0 = *(const LAS bf16x8*)(kb + d0 * 2048);
        const bf16x8 b1 = *(const LAS bf16x8*)(kb + d0 * 2048 + 512);
        p0 = __builtin_amdgcn_mfma_f32_32x32x16_bf16(b0, qr[d0], p0, 0, 0, 0);
        p1 = __builtin_amdgcn_mfma_f32_32x32x16_bf16(b1, qr[d0], p1, 0, 0, 0);
    }
}
template <int NDB> __device__ __forceinline__ void pv(f32x16* o, int vb, bf16x8 pa0, bf16x8 pa1, bf16x8 pa2, bf16x8 pa3) {
#pragma unroll
    for (int d0 = 0; d0 < NDB; ++d0) { s16x4 lo[4], hi[4];
#pragma unroll
        for (int ks = 0; ks < 4; ++ks) {
            asm volatile("ds_read_b64_tr_b16 %0,%1 offset:%c2" : "=&v"(lo[ks]) : "v"(vb), "i"(d0 * 4096 + ks * 1024) : "memory");
            asm volatile("ds_read_b64_tr_b16 %0,%1 offset:%c2" : "=&v"(hi[ks]) : "v"(vb), "i"(d0 * 4096 + ks * 1024 + 512) : "memory"); }
        asm volatile("s_waitcnt lgkmcnt(0)" ::: "memory"); __builtin_amdgcn_sched_barrier(0);
#define ATT_PK(k) (bf16x8){lo[k][0], lo[k][1], lo[k][2], lo[k][3], hi[k][0], hi[k][1], hi[k][2], hi[k][3]}
        o[d0] = __builtin_amdgcn_mfma_f32_32x32x16_bf16(pa0, ATT_PK(0), o[d0], 0, 0, 0);
        o[d0] = __builtin_amdgcn_mfma_f32_32x32x16_bf16(pa1, ATT_PK(1), o[d0], 0, 0, 0);
        o[d0] = __builtin_amdgcn_mfma_f32_32x32x16_bf16(pa2, ATT_PK(2), o[d0], 0, 0, 0);
        o[d0] = __builtin_amdgcn_mfma_f32_32x32x16_bf16(pa3, ATT_PK(3), o[d0], 0, 0, 0);
#undef ATT_PK
    }
}
#define ATT_BAR() asm volatile("s_waitcnt lgkmcnt(0)\n\ts_barrier" ::: "memory")
#define ATT_WAIT_BAR() asm volatile("s_waitcnt vmcnt(0) lgkmcnt(0)\n\ts_barrier" ::: "memory")

template <int DH, bool MOBA> __device__ __forceinline__ void attn_unit(const bf16* Qp, size_t qpitch, const bf16* Kp, const bf16* Vp, size_t kpitch, bf16* Op, int qb, const float* kmean_bh, const float* tab_h,
                                                                   LAS unsigned char* lds, int tid, int wid, int lane) {
    constexpr int ND0 = DH / 16, NDB = DH / 32, NPIECE = DH / 64;
    const int r32 = lane & 31, hi = lane >> 5;
    const unsigned lds0 = (unsigned)(uintptr_t)lds;
    LAS float* wsf = (LAS float*)(lds + L_WSF) + wid * 64;
    ATT_BAR();
    int my_sel = 0;
    if (MOBA) {
        LAS float* tl = (LAS float*)(lds + L_TAB);
        for (int i = tid; i < TAB_PAD + 2048; i += NWAVES * 64) tl[i] = (i < TAB_PAD) ? 0.f : tab_h[i - TAB_PAD];
        LAS float* km = (LAS float*)(lds + L_KM);
        for (int i = tid; i < 512; i += NWAVES * 64) km[i] = kmean_bh[i];
        ATT_BAR();
        if (tid < 256) {
            int sel = 0;
            if (qb <= 3) sel = (1 << qb) - 1;
            else {
                const GAS v4u* qrow = (const GAS v4u*)(Qp + (size_t)tid * qpitch);
                v4u qw[8];
#pragma unroll
                for (int c = 0; c < 8; ++c) qw[c] = qrow[c];
                float b1 = -INFINITY, b2 = -INFINITY, b3 = -INFINITY; int i1 = 0, i2 = 0, i3 = 0;
#pragma unroll 1
                for (int n = 0; n < qb; ++n) { float s = 0.f; const LAS f32x4* kr = (const LAS f32x4*)(km + n * 64);
#pragma unroll
                    for (int c = 0; c < 8; ++c) { const f32x4 ka = kr[2 * c], kb2 = kr[2 * c + 1]; const v4u w = qw[c];
                        s += bflo(w.x) * ka.x; s += bfhi(w.x) * ka.y; s += bflo(w.y) * ka.z; s += bfhi(w.y) * ka.w;
                        s += bflo(w.z) * kb2.x; s += bfhi(w.z) * kb2.y; s += bflo(w.w) * kb2.z; s += bfhi(w.w) * kb2.w; }
                    if (s > b1) { b3 = b2; i3 = i2; b2 = b1; i2 = i1; b1 = s; i1 = n; }
                    else if (s > b2) { b3 = b2; i3 = i2; b2 = s; i2 = n; }
                    else if (s > b3) { b3 = s; i3 = n; } }
                sel = (1 << i1) | (1 << i2) | (1 << i3);
            }
            ((LAS int*)(lds + L_SEL))[tid] = sel;
        }
        ATT_BAR();
        my_sel = ((LAS int*)(lds + L_SEL))[wid * 32 + r32];
    }
    bf16x8 qr[ND0];
    { const bf16* Qw = Qp + (size_t)(wid * 32 + r32) * qpitch + hi * 8;
#pragma unroll
      for (int d0 = 0; d0 < ND0; ++d0) qr[d0] = *(const GAS bf16x8*)(Qw + d0 * 16); }
    float m_run = -INFINITY, l_run = 0.f;
    f32x16 o[NDB];
#pragma unroll
    for (int d = 0; d < NDB; ++d) o[d] = f32x16{};
    const int vb0 = (int)(lds0 + L_V) + ((lane >> 4) & 1) * 32 + (lane & 3) * 8 + (4 * hi + ((lane & 15) >> 2)) * 64;
    const int qrel = wid * 32 + r32;
    const int ntiles = MOBA ? 4 + 4 * qb : 4;
    auto issue_tile = [&](int tt) {
        int kb_, j_; if (MOBA) { if (tt < 4) { kb_ = qb; j_ = tt; } else { kb_ = (tt - 4) >> 2; j_ = (tt - 4) & 3; } } else { kb_ = 0; j_ = tt; }
        const int key0_ = kb_ * 256 + j_ * 64; const unsigned bo = (unsigned)(tt & 1) * L_BUF;
#pragma unroll
        for (int pc = 0; pc < NPIECE; ++pc) { const int p = wid + 8 * pc;
            glds16(Kp + (size_t)(key0_ + lane) * kpitch + p * 8, (unsigned)__builtin_amdgcn_readfirstlane(lds0 + bo + L_K + p * 1024));
            glds16(Vp + (size_t)(key0_ + 16 * (p & 3) + (lane >> 2)) * kpitch + (p >> 2) * 32 + (lane & 3) * 8, (unsigned)__builtin_amdgcn_readfirstlane(lds0 + bo + L_V + p * 1024)); }
    };
    issue_tile(0);
    for (int tt = 0; tt < ntiles; ++tt) {
        int kb, j; bool own;
        if (MOBA) { if (tt < 4) { kb = qb; j = tt; own = true; } else { kb = (tt - 4) >> 2; j = (tt - 4) & 3; own = false; } }
        else { kb = 0; j = tt; own = false; }
        ATT_WAIT_BAR();
        if (tt + 1 < ntiles) issue_tile(tt + 1);
        if (MOBA && own && 64 * j > wid * 32 + 31) continue;
        const unsigned bo = (unsigned)(tt & 1) * L_BUF;
        f32x16 p0, p1;
        qkt<ND0>(p0, p1, lds + bo + L_K, qr, r32, hi);
        if (MOBA) {
            const int dbase = (qb - kb) * 256 + qrel - 64 * j - 4 * hi;
            const LAS float* tp = (const LAS float*)(lds + L_TAB) + TAB_PAD + dbase - 63;
            const float lane_neg = (own || (((my_sel >> kb) & 1) != 0)) ? 0.f : -INFINITY;
            float bz0[16], bz1[16];
#pragma unroll
            for (int r = 0; r < 16; ++r) { const int c = (r & 3) + 8 * (r >> 2); bz0[r] = tp[63 - c]; bz1[r] = tp[31 - c]; }
#pragma unroll
            for (int r = 0; r < 16; ++r) { const int c = (r & 3) + 8 * (r >> 2);
                const float n0 = own ? ((dbase - c >= 0) ? 0.f : -INFINITY) : lane_neg, n1 = own ? ((dbase - c - 32 >= 0) ? 0.f : -INFINITY) : lane_neg;
                p0[r] = (p0[r] + bz0[r]) + n0; p1[r] = (p1[r] + bz1[r]) + n1; }
        }
        const float rm = rowmax(p0, p1);
        const float m_new = fmaxf(m_run, rm);
        const float alpha = __builtin_amdgcn_exp2f(m_run - m_new);
        float ps = 0.f;
#pragma unroll
        for (int r = 0; r < 16; ++r) { p0[r] = __builtin_amdgcn_exp2f(p0[r] - m_new); p1[r] = __builtin_amdgcn_exp2f(p1[r] - m_new); ps += p0[r] + p1[r]; }
        l_run = l_run * alpha + ps;
        if (!__all(m_new == m_run)) {
            if (hi == 0) wsf[r32] = alpha;
            LDS_WAIT();
#pragma unroll
            for (int r = 0; r < 16; ++r) { const float f = wsf[crow(r, hi)];
#pragma unroll
                for (int d = 0; d < NDB; ++d) o[d][r] *= f; }
        }
        m_run = m_new;
        v4u pw0, pw1, pw2, pw3;
        pw0 = (v4u){cvtpk(p0[0], p0[1]), cvtpk(p0[2], p0[3]), cvtpk(p0[4], p0[5]), cvtpk(p0[6], p0[7])};
        pw1 = (v4u){cvtpk(p0[8], p0[9]), cvtpk(p0[10], p0[11]), cvtpk(p0[12], p0[13]), cvtpk(p0[14], p0[15])};
        pw2 = (v4u){cvtpk(p1[0], p1[1]), cvtpk(p1[2], p1[3]), cvtpk(p1[4], p1[5]), cvtpk(p1[6], p1[7])};
        pw3 = (v4u){cvtpk(p1[8], p1[9]), cvtpk(p1[10], p1[11]), cvtpk(p1[12], p1[13]), cvtpk(p1[14], p1[15])};
        pv<NDB>(o, vb0 + (int)bo, __builtin_bit_cast(bf16x8, pw0), __builtin_bit_cast(bf16x8, pw1), __builtin_bit_cast(bf16x8, pw2), __builtin_bit_cast(bf16x8, pw3));
    }
    { auto rr = __builtin_amdgcn_permlane32_swap(__float_as_uint(l_run), __float_as_uint(l_run), false, false); l_run = __uint_as_float(rr[0]) + __uint_as_float(rr[1]); }
    if (hi == 0) wsf[32 + r32] = l_run;
    ATT_BAR();
    LAS bf16* stg = (LAS bf16*)(lds + L_OST + wid * 8192);
#pragma unroll
    for (int r = 0; r < 16; ++r) { const int orow = crow(r, hi); const float rl = __builtin_amdgcn_rcpf(wsf[32 + orow]);
#pragma unroll
        for (int d = 0; d < NDB; ++d) stg[orow * DH + d * 32 + r32] = (bf16)f2bf(o[d][r] * rl); }
    LDS_WAIT();
    constexpr int CPR = DH / 8;
    int lane2 = lane; asm volatile("" : "+v"(lane2));
#pragma unroll
    for (int i = 0; i < (32 * CPR) / 64; ++i) { const int idx = i * 64 + lane2, row = idx / CPR, ch = idx % CPR;
        const v4u v = *(const LAS v4u*)(stg + row * DH + ch * 8);
        *(GAS v4u*)(Op + (size_t)(wid * 32 + row) * 512 + ch * 8) = v; }
}
#undef ATT_BAR
#undef ATT_WAIT_BAR
}

__device__ __forceinline__ void conv_item(const bf16* PA, const float* conv_w, bf16* CO, int item, int tid) {
    const int ch = (tid & 63) * 8, r0 = item * 64 + (tid >> 6) * 8;
    float w0[8], w1[8], w2[8];
#pragma unroll
    for (int j = 0; j < 8; ++j) { w0[j] = conv_w[ch + j]; w1[j] = conv_w[512 + ch + j]; w2[j] = conv_w[1024 + ch + j]; }
    float pm2[8], pm1[8];
#pragma unroll
    for (int j = 0; j < 8; ++j) { pm2[j] = 0.f; pm1[j] = 0.f; }
    auto load8 = [&](int row, int col, float* o) { const v4u w = *(const GAS v4u*)(PA + (size_t)row * PAW + col + ch);
        o[0] = bflo(w.x); o[1] = bfhi(w.x); o[2] = bflo(w.y); o[3] = bfhi(w.y); o[4] = bflo(w.z); o[5] = bfhi(w.z); o[6] = bflo(w.w); o[7] = bfhi(w.w); };
    const int s0 = r0 & (SEQ - 1);
    if (s0 >= 2) { float a[8], b[8]; load8(r0 - 2, COL_CC, a); load8(r0 - 2, COL_UC, b);
#pragma unroll
        for (int j = 0; j < 8; ++j) pm2[j] = a[j] * b[j]; }
    if (s0 >= 1) { float a[8], b[8]; load8(r0 - 1, COL_CC, a); load8(r0 - 1, COL_UC, b);
#pragma unroll
        for (int j = 0; j < 8; ++j) pm1[j] = a[j] * b[j]; }
#pragma unroll
    for (int i = 0; i < 8; ++i) { const int row = r0 + i; float c[8], u[8], bb[8], y[8];
        load8(row, COL_CC, c); load8(row, COL_UC, u); load8(row, COL_BC, bb);
#pragma unroll
        for (int j = 0; j < 8; ++j) { const float cur = c[j] * u[j]; y[j] = bb[j] * (w0[j] * pm2[j] + w1[j] * pm1[j] + w2[j] * cur); pm2[j] = pm1[j]; pm1[j] = cur; }
        v4u o; o.x = pk2(y[0], y[1]); o.y = pk2(y[2], y[3]); o.z = pk2(y[4], y[5]); o.w = pk2(y[6], y[7]);
        *(GAS v4u*)(CO + (size_t)row * 512 + ch) = o; }
}

namespace pk {
template <int N> __device__ __forceinline__ void bsort_desc(unsigned (&a)[N]) {
#pragma unroll
    for (int k = 2; k <= N; k <<= 1) {
#pragma unroll
        for (int j = k >> 1; j > 0; j >>= 1) {
#pragma unroll
            for (int i = 0; i < N; ++i) { const int l = i ^ j;
                if (l > i) { const unsigned x = a[i], y = a[l]; const unsigned mx = x > y ? x : y, mn = x > y ? y : x;
                    if ((i & k) == 0) { a[i] = mx; a[l] = mn; } else { a[i] = mn; a[l] = mx; } } } } }
}
template <int N> __device__ __forceinline__ void bmerge_desc(unsigned (&a)[N]) {
#pragma unroll
    for (int j = N >> 1; j > 0; j >>= 1) {
#pragma unroll
        for (int i = 0; i < N; ++i) { const int l = i ^ j; if (l > i) { const unsigned x = a[i], y = a[l]; a[i] = x > y ? x : y; a[l] = x > y ? y : x; } } }
}
__device__ __forceinline__ void top16_merge(unsigned (&x)[16], const unsigned (&y)[16]) {
#pragma unroll
    for (int i = 0; i < 16; ++i) x[i] = x[i] > y[15 - i] ? x[i] : y[15 - i];
    bmerge_desc<16>(x);
}
__device__ __forceinline__ unsigned f2ord(float f) { const unsigned u = __float_as_uint(f); return u ^ ((unsigned)((int)u >> 31) | 0x80000000u); }
__device__ __forceinline__ float ord2f(unsigned o) { return __uint_as_float(o ^ ((o & 0x80000000u) ? 0x80000000u : 0xFFFFFFFFu)); }

constexpr int L_TBL = 0;
__device__ __forceinline__ void topk_unit(const bf16* QRY, const bf16* SK, const float* SLOTS, unsigned* SEL, LAS unsigned char* lds, int v, int tid, int wid, int lane) {
    const int hp = v & 3, t0 = ((v >> 2) * 8 + wid) * 32, r32 = lane & 31, hi = lane >> 5;
    for (int tb = 0; tb < 4; ++tb) { const bf16* src = SK + (size_t)(((2 * hp + (tb >> 1)) * 2 + (tb & 1)) * 128) * 128;
        for (int idx = tid; idx < 2048; idx += NWAVES * 64) { const int key = idx >> 4, c16 = idx & 15;
            const v4u w = *(const GAS v4u*)(src + key * 128 + c16 * 8);
            *(LAS v4u*)(lds + L_TBL + tb * 32768 + (c16 * 4 + (key >> 5)) * 512 + (key & 31) * 16) = w; } }
    asm volatile("s_waitcnt vmcnt(0) lgkmcnt(0)\n\ts_barrier" ::: "memory");
    const int tok = t0 + r32;
    float rn; { const GAS f32x4* sl = (const GAS f32x4*)(SLOTS + (size_t)tok * 16); const f32x4 a = sl[0], b = sl[1], c = sl[2], d = sl[3];
        const float ss = ((a.x + a.y) + (a.z + a.w)) + ((b.x + b.y) + (b.z + b.w)) + ((c.x + c.y) + (c.z + c.w)) + ((d.x + d.y) + (d.z + d.w));
        rn = 1.f / sqrtf(ss * (1.f / 1024.f) + RMS_EPS); }
    unsigned L[4][16];
#pragma unroll
    for (int tb = 0; tb < 4; ++tb) {
        const int hh = tb >> 1, p = tb & 1;
        const bf16* qp = QRY + (size_t)tok * 2048 + ((2 * hp + hh) * 2 + p) * 128 + hi * 8;
        bf16x8 qf[8];
#pragma unroll
        for (int kk = 0; kk < 8; ++kk) qf[kk] = *(const GAS bf16x8*)(qp + kk * 16);
        f32x16 acc[4];
#pragma unroll
        for (int blk = 0; blk < 4; ++blk) acc[blk] = f32x16{};
        const LAS unsigned char* tbase = lds + L_TBL + tb * 32768 + hi * 2048 + r32 * 16;
#pragma unroll
        for (int kk = 0; kk < 8; ++kk)
#pragma unroll
            for (int blk = 0; blk < 4; ++blk) { const bf16x8 af = *(const LAS bf16x8*)(tbase + kk * 4096 + blk * 512);
                acc[blk] = __builtin_amdgcn_mfma_f32_32x32x16_bf16(af, qf[kk], acc[blk], 0, 0, 0); }
        unsigned g[4][16];
#pragma unroll
        for (int blk = 0; blk < 4; ++blk)
#pragma unroll
            for (int r = 0; r < 16; ++r) g[blk][r] = (f2ord(acc[blk][r]) & ~127u) | (unsigned)(127 - (32 * blk + (r & 3) + 8 * (r >> 2)));
#pragma unroll
        for (int blk = 0; blk < 4; ++blk) bsort_desc<16>(g[blk]);
        top16_merge(g[0], g[1]); top16_merge(g[2], g[3]); top16_merge(g[0], g[2]);
#pragma unroll
        for (int i = 0; i < 16; ++i) L[tb][i] = g[0][i] ^ (unsigned)(4 * hi);
    }
    unsigned A[2][16];
#pragma unroll
    for (int p = 0; p < 2; ++p) {
        unsigned X[16], Y[16];
#pragma unroll
        for (int i = 0; i < 16; ++i) { auto rr = __builtin_amdgcn_permlane32_swap(L[p][i], L[2 + p][i], false, false); X[i] = rr[0]; Y[i] = rr[1]; }
        top16_merge(X, Y);
#pragma unroll
        for (int i = 0; i < 16; ++i) A[p][i] = X[i];
    }
    float f0[16], f1[16];
#pragma unroll
    for (int i = 0; i < 16; ++i) { f0[i] = ord2f(A[0][i] & ~127u); f1[i] = ord2f(A[1][i] & ~127u); }
    float sums[50]; unsigned keys[50];
    { int c = 0;
#pragma unroll
      for (int i = 0; i < 16; ++i)
#pragma unroll
          for (int j = 0; j < 16; ++j) if ((i + 1) * (j + 1) <= 16) { sums[c] = f0[i] + f1[j]; keys[c] = (f2ord(sums[c]) & ~63u) | (unsigned)(63 - c); ++c; } }
    unsigned G0[16], R[32];
#pragma unroll
    for (int i = 0; i < 16; ++i) G0[i] = keys[i];
#pragma unroll
    for (int i = 0; i < 32; ++i) R[i] = (i < 26) ? keys[24 + i] : 0u;
    bsort_desc<32>(R);
#pragma unroll
    for (int i = 0; i < 16; ++i) G0[i] = G0[i] > R[15 - i] ? G0[i] : R[15 - i];
    bmerge_desc<16>(G0);
#pragma unroll
    for (int i = 8; i < 16; ++i) G0[i] = G0[i] > keys[16 + 15 - i] ? G0[i] : keys[16 + 15 - i];
    unsigned thr = G0[0];
#pragma unroll
    for (int i = 1; i < 16; ++i) thr = thr < G0[i] ? thr : G0[i];
    const float s00 = sums[0], sc = rn * LOG2E;
    float w[50]; float den = 0.f;
#pragma unroll
    for (int c = 0; c < 50; ++c) { w[c] = (keys[c] >= thr) ? __builtin_amdgcn_exp2f((sums[c] - s00) * sc) : 0.f; den += w[c]; }
    const float inv = 1.f / den;
    unsigned i0[16], i1[16];
#pragma unroll
    for (int i = 0; i < 16; ++i) { i0[i] = 127u - (A[0][i] & 127u); i1[i] = 127u - (A[1][i] & 127u); }
    GAS unsigned* outp = (GAS unsigned*)(SEL + ((size_t)tok * 8 + 2 * hp + hi) * 16);
    int pos = 0;
    { int c = 0;
#pragma unroll
      for (int i = 0; i < 16; ++i)
#pragma unroll
          for (int j = 0; j < 16; ++j) if ((i + 1) * (j + 1) <= 16) { if (keys[c] >= thr) { outp[pos & 15] = ((i0[i] * 128u + i1[j]) << 16) | f2bf(w[c] * inv); ++pos; } ++c; } }
}
}

constexpr size_t SLICE_BYTES = (size_t)NEXP * 128;
template <bool OFFSET, int NR> __device__ __forceinline__ void quant_rows_sliced(const float* X, unsigned char* qtab, float* scale, int e0, int es, int eend, int lane) {
    f32x4 v[NR][4];
#pragma unroll
    for (int r = 0; r < NR; ++r) { const int e = (e0 + r * es < eend) ? e0 + r * es : eend - 1; const GAS f32x4* xr = (const GAS f32x4*)(X + (size_t)e * DM) + 4 * lane;
#pragma unroll
        for (int j = 0; j < 4; ++j) v[r][j] = xr[j]; }
#pragma unroll
    for (int r = 0; r < NR; ++r) { float am = 0.f;
#pragma unroll
        for (int j = 0; j < 4; ++j) am = fmaxf(am, fmaxf(fmaxf(fabsf(v[r][j].x), fabsf(v[r][j].y)), fmaxf(fabsf(v[r][j].z), fabsf(v[r][j].w))));
#pragma unroll
        for (int o = 1; o < 64; o <<= 1) am = fmaxf(am, __shfl_xor(am, o));
        const float s = am > 0.f ? am * (1.f / 127.f) : 1.f, is = 1.f / s;
        v4u o;
#pragma unroll
        for (int j = 0; j < 4; ++j) { const int a = (int)rintf(v[r][j].x * is), b = (int)rintf(v[r][j].y * is), c = (int)rintf(v[r][j].z * is), d = (int)rintf(v[r][j].w * is);
            const int off = OFFSET ? 128 : 0;
            o[j] = (unsigned)((a + off) & 0xff) | ((unsigned)((b + off) & 0xff) << 8) | ((unsigned)((c + off) & 0xff) << 16) | ((unsigned)((d + off) & 0xff) << 24); }
        const int e = e0 + r * es;
        if (e < eend) { *(GAS v4u*)(qtab + (size_t)(lane >> 3) * SLICE_BYTES + (size_t)e * 128 + (lane & 7) * 16) = o; if (lane == 0) scale[e] = s; } }
}
template <int NR> __device__ __forceinline__ void quant_x(const float* H, unsigned char* XQ, float* SX, const float (&gf)[16], int t0, int ts, int lane) {
    f32x4 hv[NR][4];
#pragma unroll
    for (int r = 0; r < NR; ++r) { const int t = (t0 + r * ts < T) ? t0 + r * ts : T - 1; const GAS f32x4* hrow = (const GAS f32x4*)(H + (size_t)t * DM) + 4 * lane;
#pragma unroll
        for (int j = 0; j < 4; ++j) hv[r][j] = hrow[j]; }
#pragma unroll
    for (int r = 0; r < NR; ++r) { float ss = 0.f;
#pragma unroll
        for (int j = 0; j < 4; ++j) ss += (hv[r][j].x * hv[r][j].x + hv[r][j].y * hv[r][j].y) + (hv[r][j].z * hv[r][j].z + hv[r][j].w * hv[r][j].w);
        const float rn = 1.f / sqrtf(wave_sum(ss) * (1.f / 1024.f) + RMS_EPS);
        float xn[16]; float am = 0.f;
#pragma unroll
        for (int j = 0; j < 4; ++j)
#pragma unroll
            for (int e = 0; e < 4; ++e) { xn[4 * j + e] = hv[r][j][e] * rn * gf[4 * j + e]; am = fmaxf(am, fabsf(xn[4 * j + e])); }
#pragma unroll
        for (int o = 1; o < 64; o <<= 1) am = fmaxf(am, __shfl_xor(am, o));
        const float sx = am > 0.f ? am * (1.f / 127.f) : 1.f, isx = 1.f / sx;
        v4u o;
#pragma unroll
        for (int j = 0; j < 4; ++j) { const int a = (int)rintf(xn[4 * j] * isx), b = (int)rintf(xn[4 * j + 1] * isx), c = (int)rintf(xn[4 * j + 2] * isx), d = (int)rintf(xn[4 * j + 3] * isx);
            o[j] = (unsigned)(a & 0xff) | ((unsigned)(b & 0xff) << 8) | ((unsigned)(c & 0xff) << 16) | ((unsigned)(d & 0xff) << 24); }
        const int t = t0 + r * ts;
        if (t < T) { *((GAS v4u*)(XQ + (size_t)t * DM) + lane) = o; if (lane == 0) SX[t] = sx; } }
}
__device__ __forceinline__ float gelu_exact(float x) { return 0.5f * x * (1.0f + erff(x * 0.70710678118654752f)); }
__device__ __forceinline__ int dpp_i(int v, int ctrl_is) {
    return ctrl_is == 0 ? __builtin_amdgcn_update_dpp(0, v, 0x141, 0xf, 0xf, true) : ctrl_is == 1 ? __builtin_amdgcn_update_dpp(0, v, 0xB1, 0xf, 0xf, true) : __builtin_amdgcn_update_dpp(0, v, 0x4E, 0xf, 0xf, true);
}
constexpr int QCHUNK = 8;
__device__ __forceinline__ int q_take(unsigned* q, int lane) {
    unsigned v = 0; if (lane == 0) v = __hip_atomic_fetch_add(q, (unsigned)QCHUNK, __ATOMIC_RELAXED, __HIP_MEMORY_SCOPE_AGENT);
    return (int)__builtin_amdgcn_readfirstlane(v);
}
struct TokStream {
    unsigned* q; int cur, end, nxt;
    __device__ __forceinline__ void open(unsigned* q_, int lane) { q = q_; cur = q_take(q, lane); end = cur + QCHUNK; nxt = q_take(q, lane); }
    __device__ __forceinline__ int next(int lane) { const int t = cur; if (t >= T) return T; ++cur; if (cur == end) { cur = nxt; end = cur + QCHUNK; if (cur < T) nxt = q_take(q, lane); } return t; }
};
struct UMeta { unsigned E[16]; v4u xq; };
__device__ __forceinline__ void u_meta(UMeta& m, const unsigned* SEL, const unsigned char* XQ, int t, int x, int grp, int ch) {
#pragma unroll
    for (int g = 0; g < 16; ++g) m.E[g] = *(const GAS unsigned*)(SEL + (size_t)t * 128 + g * 8 + grp);
    m.xq = *(const GAS v4u*)(XQ + (size_t)t * DM + x * 128 + ch * 16);
}
__device__ __forceinline__ void u_rows(v4u (&w)[16], const UMeta& m, const unsigned char* tab, unsigned choff) {
#pragma unroll
    for (int g = 0; g < 16; ++g) w[g] = *(const GAS v4u*)(tab + (unsigned)((m.E[g] >> 16) * 128u + choff));
}
__device__ __forceinline__ void u_compute(const v4u (&w)[16], const v4u xc, int* prow, int grp, int c0, int c1, int c2) {
    int p[16];
#pragma unroll
    for (int g = 0; g < 16; ++g) { int a = __builtin_amdgcn_sdot4((int)w[g].x, (int)xc.x, 0, false); a = __builtin_amdgcn_sdot4((int)w[g].y, (int)xc.y, a, false);
        a = __builtin_amdgcn_sdot4((int)w[g].z, (int)xc.z, a, false); p[g] = __builtin_amdgcn_sdot4((int)w[g].w, (int)xc.w, a, false); }
    int q8[8], q4[4], q2[2];
#pragma unroll
    for (int i = 0; i < 8; ++i) { const int keep = c2 ? p[i + 8] : p[i], send = c2 ? p[i] : p[i + 8]; q8[i] = keep + dpp_i(send, 0); }
#pragma unroll
    for (int i = 0; i < 4; ++i) { const int keep = c0 ? q8[i + 4] : q8[i], send = c0 ? q8[i] : q8[i + 4]; q4[i] = keep + dpp_i(send, 1); }
#pragma unroll
    for (int i = 0; i < 2; ++i) { const int keep = c1 ? q4[i + 2] : q4[i], send = c1 ? q4[i] : q4[i + 2]; q2[i] = keep + dpp_i(send, 2); }
    const int g0 = 8 * c2 + 4 * c0 + 2 * c1;
    __builtin_nontemporal_store(q2[0], prow + g0 * 8 + grp); __builtin_nontemporal_store(q2[1], prow + (g0 + 1) * 8 + grp);
}
__device__ __forceinline__ void gather_u(const unsigned* SEL, const unsigned char* XQ, const unsigned char* UQS, int* PART, int* dummy, unsigned* queues, int xcc, int lane) {
    const int grp = lane >> 3, ch = lane & 7, c0 = ch & 1, c1 = (ch >> 1) & 1, c2 = (ch >> 2) & 1;
    for (int qi = 0; qi < 8; ++qi) { const int x = (xcc + qi) & 7;
        const unsigned char* tab = UQS + (size_t)x * SLICE_BYTES; const unsigned choff = (unsigned)ch * 16u;
        int* part = PART + (size_t)x * T * 128;
        TokStream S; S.open(queues + 64 * x, lane);
        int tA = S.next(lane), tB = S.next(lane);
        if (tA >= T) continue;
        UMeta M; v4u W0[16], W1[16]; v4u X0, X1;
        u_meta(M, SEL, XQ, tA, x, grp, ch); u_rows(W0, M, tab, choff); X0 = M.xq;
        u_meta(M, SEL, XQ, tB < T ? tB : T - 1, x, grp, ch);
        while (tA < T) {
            const int tC = S.next(lane);
            u_rows(W1, M, tab, choff); X1 = M.xq;
            u_meta(M, SEL, XQ, tC < T ? tC : T - 1, x, grp, ch);
            u_compute(W0, X0, part + (size_t)tA * 128, grp, c0, c1, c2);
            const int tD = S.next(lane);
            u_rows(W0, M, tab, choff); X0 = M.xq;
            u_meta(M, SEL, XQ, tD < T ? tD : T - 1, x, grp, ch);
            u_compute(W1, X1, tB < T ? part + (size_t)tB * 128 : dummy, grp, c0, c1, c2);
            tA = tC; tB = tD;
        }
    }
}
__device__ __forceinline__ void gather_coef(const unsigned* SEL, const int* PART, const float* SU, const float* SV, const float* SX, unsigned* COEF, float* CS, int t, int lane) {
    typedef int i2 __attribute__((ext_vector_type(2)));
    const v2u ent = *(const GAS v2u*)(SEL + (size_t)t * 128 + 2 * lane);
    i2 acc = {0, 0};
#pragma unroll
    for (int x = 0; x < 8; ++x) { const i2 pp = *(const GAS i2*)(PART + ((size_t)x * T + t) * 128 + 2 * lane); acc += pp; }
    const unsigned e0 = ent.x >> 16, e1 = ent.y >> 16;
    const float su0 = SU[e0], sv0 = SV[e0], su1 = SU[e1], sv1 = SV[e1];
    const float sx = __hip_atomic_load(SX + t, __ATOMIC_RELAXED, __HIP_MEMORY_SCOPE_AGENT);
    const float k0 = bflo(ent.x) * gelu_exact((float)acc.x * (su0 * sx)) * sv0, k1 = bflo(ent.y) * gelu_exact((float)acc.y * (su1 * sx)) * sv1;
    const unsigned w0 = (e0 << 16) | f2bf(k0), w1 = (e1 << 16) | f2bf(k1);
    *(GAS v2u*)(COEF + (size_t)t * 128 + 2 * lane) = (v2u){w0, w1};
    const float cs = wave_sum(bflo(w0) + bflo(w1));
    if (lane == 0) CS[t] = cs;
}
struct VMeta { unsigned E[16]; };
__device__ __forceinline__ void v_meta(VMeta& m, const unsigned* COEF, int t, int grp) {
#pragma unroll
    for (int g = 0; g < 16; ++g) m.E[g] = *(const GAS unsigned*)(COEF + (size_t)t * 128 + g * 8 + grp);
}
__device__ __forceinline__ void v_rows(v4u (&w)[16], unsigned (&c)[16], const VMeta& m, const unsigned char* tab, unsigned choff) {
#pragma unroll
    for (int g = 0; g < 16; ++g) { w[g] = *(const GAS v4u*)(tab + (unsigned)((m.E[g] >> 16) * 128u + choff)); c[g] = m.E[g]; }
}
__device__ __forceinline__ void v_compute_(const v4u (&w)[16], const unsigned (&C)[16], const float* CS, const float* hin, float* hout, int t, int g0, int g1, int g2) {
    typedef float f2 __attribute__((ext_vector_type(2)));
    const f2 hv = __builtin_nontemporal_load((const GAS f2*)hin);
    const float corr = -128.f * __hip_atomic_load(CS + t, __ATOMIC_RELAXED, __HIP_MEMORY_SCOPE_AGENT);
    float acc[16];
#pragma unroll
    for (int j = 0; j < 16; ++j) acc[j] = 0.f;
#pragma unroll
    for (int g = 0; g < 16; ++g) { const float c = bflo(C[g]);
#pragma unroll
        for (int j = 0; j < 4; ++j) { const unsigned wv = w[g][j];
            acc[4 * j + 0] += c * (float)(wv & 0xffu); acc[4 * j + 1] += c * (float)((wv >> 8) & 0xffu); acc[4 * j + 2] += c * (float)((wv >> 16) & 0xffu); acc[4 * j + 3] += c * (float)(wv >> 24); } }
    float r8[8], r4[4], r2[2];
#pragma unroll
    for (int i = 0; i < 8; ++i) { const float keep = g0 ? acc[i + 8] : acc[i], send = g0 ? acc[i] : acc[i + 8]; r8[i] = keep + __shfl_xor(send, 8); }
#pragma unroll
    for (int i = 0; i < 4; ++i) { const float keep = g1 ? r8[i + 4] : r8[i], send = g1 ? r8[i] : r8[i + 4]; r4[i] = keep + __shfl_xor(send, 16); }
#pragma unroll
    for (int i = 0; i < 2; ++i) { const float keep = g2 ? r4[i + 2] : r4[i], send = g2 ? r4[i] : r4[i + 2]; r2[i] = keep + __shfl_xor(send, 32); }
    __builtin_nontemporal_store((f2){hv.x + r2[0] + corr, hv.y + r2[1] + corr}, (GAS f2*)hout);
}
__device__ __forceinline__ void gather_v(const unsigned* COEF, const float* CS, const unsigned char* VQS, const float* HI, float* HO, float* dummy, unsigned* queues, int xcc, int lane) {
    const int grp = lane >> 3, ch = lane & 7, g0 = grp & 1, g1 = (grp >> 1) & 1, g2 = (grp >> 2) & 1;
    for (int qi = 0; qi < 8; ++qi) { const int x = (xcc + qi) & 7;
        const unsigned char* tab = VQS + (size_t)x * SLICE_BYTES; const unsigned choff = (unsigned)ch * 16u;
        const int col = x * 128 + ch * 16 + 8 * g0 + 4 * g1 + 2 * g2;
        TokStream S; S.open(queues + 64 * x, lane);
        int tA = S.next(lane), tB = S.next(lane);
        if (tA >= T) continue;
        VMeta M; v4u W0[16], W1[16]; unsigned C0[16], C1[16];
        v_meta(M, COEF, tA, grp); v_rows(W0, C0, M, tab, choff);
        v_meta(M, COEF, tB < T ? tB : T - 1, grp);
        while (tA < T) {
            const int tC = S.next(lane);
            v_rows(W1, C1, M, tab, choff);
            v_meta(M, COEF, tC < T ? tC : T - 1, grp);
            v_compute_(W0, C0, CS, HI + (size_t)tA * DM + col, HO + (size_t)tA * DM + col, tA, g0, g1, g2);
            const int tD = S.next(lane);
            v_rows(W0, C0, M, tab, choff);
            v_meta(M, COEF, tD < T ? tD : T - 1, grp);
            { const int tb = tB < T ? tB : T - 1; v_compute_(W1, C1, CS, HI + (size_t)tb * DM + col, tB < T ? HO + (size_t)tB * DM + col : dummy + 2 * lane, tb, g0, g1, g2); }
            tA = tC; tB = tD;
        }
    }
}

#ifndef MK_SPLIT
#define MK_SPLIT 0
#endif
constexpr int NPHASE = 11;
#ifndef PROBE_PH
#define PROBE_PH -1
#endif
#ifndef PROBE_N
#define PROBE_N 1
#endif
#define REPS(k) (((k) == PROBE_PH) ? 1 + PROBE_N : 1)
struct Args { const float* in[21]; float* out; unsigned char* ws; int ph_lo, ph_hi; };
static_assert(sizeof(Args) == 23 * 8 + 8, "Args has no padding");

__global__ void __launch_bounds__(NWAVES * 64, 2) fwd(Args args) {
    extern __shared__ __attribute__((aligned(16))) unsigned char lds_raw[];
    LAS unsigned char* lds = (LAS unsigned char*)lds_raw;
    volatile LAS unsigned* MISC = (volatile LAS unsigned*)(lds + MISC_OFF);
    const int tid = threadIdx.x, lane = tid & 63, wave = __builtin_amdgcn_readfirstlane(tid >> 6);
    const int G = gridDim.x; const int bx = blockIdx.x; const int vcu = (G % 8 == 0) ? (bx % 8) * (G / 8) + bx / 8 : bx;
    const int gw = vcu * NWAVES + wave, NGW = G * NWAVES;
    unsigned char* ws = args.ws;
    gu32* ctl = (gu32*)(ws + WS_CTL);
    const float* x = args.in[0]; const float* mem = args.in[1]; const float* g_mix = args.in[2]; const float* w_in = args.in[3]; const float* q_gain_a = args.in[4]; const float* k_gain_a = args.in[5];
    const float* rel_bias = args.in[6]; const float* conv_w = args.in[7]; const float* g_mem = args.in[8]; const float* w_mem_kv = args.in[9]; const float* q_gain_x = args.in[10]; const float* k_gain_x = args.in[11];
    const float* w_br_attn = args.in[12]; const float* w_br_conv = args.in[13]; const float* w_br_x = args.in[14]; const float* w_out = args.in[15]; const float* g_ffn = args.in[16];
    const float* w_query = args.in[17]; const float* sub_keys = args.in[18]; const float* peer_u = args.in[19]; const float* peer_v = args.in[20];
    float* out = args.out;
    bf16* WinT = (bf16*)(ws + WS_WIN); bf16* WkvT = (bf16*)(ws + WS_WKV); bf16* WbrT = (bf16*)(ws + WS_WBR); bf16* WoutT = (bf16*)(ws + WS_WOUT); bf16* WqT = (bf16*)(ws + WS_WQ);
    bf16* SK = (bf16*)(ws + WS_SK); float* TAB = (float*)(ws + WS_TAB); float* KMEAN = (float*)(ws + WS_KMEAN); bf16* MEMN = (bf16*)(ws + WS_MEMN); bf16* KVM = (bf16*)(ws + WS_KVM);
    float* SLOTS = (float*)(ws + WS_SLOTS); unsigned* SEL = (unsigned*)(ws + WS_SEL);
    bf16* PA = (bf16*)(ws + WS_PA); bf16* PG = (bf16*)(ws + WS_PG);
    bf16* MERGED = (bf16*)(ws + PA_MERGED); bf16* HB = (bf16*)(ws + PA_HB); unsigned char* UQ = ws + PA_UT; unsigned char* VQ = ws + PA_VT; float* SU = (float*)(ws + WS_SU); float* SV = (float*)(ws + WS_SV); float* SX = (float*)(ws + WS_SX); float* CS = (float*)(ws + WS_CS);
    unsigned char* XQ = ws + PA_XQ; int* PART = (int*)(ws + PG_PART); unsigned* COEF = (unsigned*)(ws + PG_COEF); bf16* QRY = (bf16*)(ws + PG_QRY);
    bf16* HN = (bf16*)out;
    bf16* BRO = (bf16*)out;

    for (int u = tid; u < (LDS_BYTES - LDSCTL_OFF) / 4; u += NWAVES * 64) ((LAS unsigned*)(lds + LDSCTL_OFF))[u] = 0u;
    __syncthreads();
#if !MK_SPLIT
    XcdBarrier bar = xcd_barrier_post((unsigned*)(ctl + CW_BAR), MISC + 8);
#define GRID_BAR() xcd_barrier(bar)
#else
#define GRID_BAR() do {} while (0)
#endif
    const int lo = args.ph_lo, hi_ = args.ph_hi;
#ifndef PH_MASK
#define PH_MASK 0x7ff
#endif
#define IN(k) ((((PH_MASK) >> (k)) & 1) && lo <= (k) && (k) < hi_)
#define BOTH(k) (IN(k) && IN((k) + 1))

    if (IN(0)) for (int rep = 0; rep < REPS(0); ++rep) {
        P0Args a{x, mem, g_mix, w_in, rel_bias, g_mem, w_mem_kv, w_br_attn, w_br_conv, w_br_x, w_out, g_ffn, w_query, sub_keys, WinT, WkvT, WbrT, WoutT, WqT, SK, HN, MEMN, TAB};
        p0_prologue(a, lds, gw, NGW, wave, lane);
        if (BOTH(0) && rep == REPS(0) - 1) GRID_BAR();
    }
    if (IN(1)) for (int rep = 0; rep < REPS(1); ++rep) {
        { pg8::Gemm g{HN, WinT, T, PW, DM}; pg8::GOrder S; S.init(T, PW, G, bx); pg8::EpiProj E{PA, PG};
          pg8::gemm_phase<pg8::EpiProj, pg8::GOrder, true, true>(lds + RING_OFF, g, S, E); }
        { const int nfull = (64 * 26) % G; const int coff = (nfull + 32 <= G) ? bx - nfull : bx;
          pg8::Gemm g{MEMN, WkvT, NBATCH * MEMLEN, 1024, DM}; pg8::GOrder S; S.init(NBATCH * MEMLEN, 1024, G, coff); pg8::EpiBf16<0> E{KVM, 1024, nullptr, 0, 0, 1.f};
          pg8::gemm_phase<pg8::EpiBf16<0>, pg8::GOrder, true, true>(lds + RING_OFF, g, S, E); }
        if (BOTH(1) && rep == REPS(1) - 1) GRID_BAR();
    }
#if defined(PROBE_BARS) && !MK_SPLIT
    if (IN(1)) for (int i = 0; i < PROBE_BARS; ++i) GRID_BAR();
#endif
    if (IN(2)) {
        p2_fixup(PA, KVM, KMEAN, q_gain_a, k_gain_a, q_gain_x, k_gain_x, lds + RING_OFF, vcu, G, wave, lane);
        if (BOTH(2)) GRID_BAR();
    }
    if (IN(3)) for (int rep = 0; rep < REPS(3); ++rep) {
        for (int v = vcu; v < 256; v += G) {
            const int bh = v >> 2, b = bh >> 3, h = bh & 7, s = v & 3;
#pragma unroll 1
            for (int pass = 0; pass < 2; ++pass) { const int qb = pass ? 7 - s : s;
                const bf16* Qp = PA + (size_t)(b * SEQ + qb * 256) * PAW + COL_QA + h * 64;
                const bf16* Kp = PA + (size_t)(b * SEQ) * PAW + COL_KA + h * 64; const bf16* Vp = PA + (size_t)(b * SEQ) * PAW + COL_VA + h * 64;
                bf16* Op = BRO + (size_t)(b * SEQ + qb * 256) * 512 + h * 64;
                att::attn_unit<64, true>(Qp, PAW, Kp, Vp, PAW, Op, qb, KMEAN + (size_t)bh * 512, TAB + h * 2048, lds + RING_OFF, tid, wave, lane); }
            { const int bb = v >> 5, hx = (v >> 3) & 3, qt = v & 7;
                const bf16* Qp = PA + (size_t)(bb * SEQ + qt * 256) * PAW + COL_QX + hx * 128;
                const bf16* Kp = KVM + (size_t)(bb * MEMLEN) * 1024 + hx * 128; const bf16* Vp = Kp + 512;
                bf16* Op = BRO + (size_t)2 * T * 512 + (size_t)(bb * SEQ + qt * 256) * 512 + hx * 128;
                att::attn_unit<128, false>(Qp, PAW, Kp, Vp, 1024, Op, 0, nullptr, nullptr, lds + RING_OFF, tid, wave, lane); }
            conv_item(PA, conv_w, BRO + (size_t)T * 512, v, tid);
        }
        if (BOTH(3) && rep == REPS(3) - 1) GRID_BAR();
    }
    if (IN(4)) for (int rep = 0; rep < REPS(4); ++rep) {
        pg8::Gemm g{BRO, WbrT, 3 * T, 3 * 1024, 512}; pg8::BranchOrder S; S.init(G, bx); pg8::EpiBranch E{PG, MERGED};
        pg8::gemm_phase<pg8::EpiBranch, pg8::BranchOrder, true, true>(lds + RING_OFF, g, S, E);
        if (BOTH(4) && rep == REPS(4) - 1) GRID_BAR();
    }
    if (IN(5)) for (int rep = 0; rep < REPS(5); ++rep) {
        pg8::Gemm g{MERGED, WoutT, T, 1024, DM}; pg8::GOrder S; S.init(T, 1024, G, bx); pg8::EpiWout E{x, out, HB, SLOTS};
        pg8::gemm_phase<pg8::EpiWout, pg8::GOrder, true, true>(lds + RING_OFF, g, S, E);
        if (BOTH(5) && rep == REPS(5) - 1) GRID_BAR();
    }
    if (IN(6)) for (int rep = 0; rep < REPS(6); ++rep) {
        pg8::Gemm g{HB, WqT, T, 2048, DM}; pg8::GOrder S; S.init(T, 2048, G, bx); pg8::EpiBf16<0> E{QRY, 2048, nullptr, 0, 0, 1.f};
        pg8::gemm_phase<pg8::EpiBf16<0>, pg8::GOrder, true, true>(lds + RING_OFF, g, S, E);
        if (BOTH(6) && rep == REPS(6) - 1) GRID_BAR();
    }
    if (IN(7)) for (int rep = 0; rep < REPS(7); ++rep) {
        for (int v = vcu; v < 256; v += G) { pk::topk_unit(QRY, SK, SLOTS, SEL, lds + RING_OFF, v, tid, wave, lane); __syncthreads(); }
        for (int m = gw; m < NEXP; m += 4 * NGW) quant_rows_sliced<false, 4>(peer_u, UQ, SU, m, NGW, NEXP, lane);
        for (int m = gw; m < NEXP; m += 4 * NGW) quant_rows_sliced<true, 4>(peer_v, VQ, SV, m, NGW, NEXP, lane);
        { float gf[16];
#pragma unroll
          for (int j = 0; j < 16; ++j) gf[j] = g_ffn[16 * lane + j];
          for (int t = gw; t < T; t += 4 * NGW) quant_x<4>(out, XQ, SX, gf, t, NGW, lane); }
        if (BOTH(7) && rep == REPS(7) - 1) GRID_BAR();
    }
#if !MK_SPLIT
    const int xcc = (int)bar.x & 7;
#else
    const int xcc = (int)(xb_xcc_id() & 7u);
#endif
    if (IN(8)) for (int rep = 0; rep < REPS(8); ++rep) {
        gather_u(SEL, XQ, UQ, PART, (int*)(ws + WS_END), (unsigned*)(ctl + CW_QU + 1024 * rep), xcc, lane);
        if (BOTH(8) && rep == REPS(8) - 1) GRID_BAR();
    }
    if (IN(9)) for (int rep = 0; rep < REPS(9); ++rep) {
        for (int t = gw; t < T; t += NGW) gather_coef(SEL, PART, SU, SV, SX, COEF, CS, t, lane);
        if (BOTH(9) && rep == REPS(9) - 1) GRID_BAR();
    }
    if (IN(10)) for (int rep = 0; rep < REPS(10); ++rep) {
        gather_v(COEF, CS, VQ, out, (rep == REPS(10) - 1) ? out : (float*)PART, (float*)(ws + WS_END), (unsigned*)(ctl + CW_QV + 1024 * rep), xcc, lane);
    }
#undef IN
#undef BOTH
}

extern "C" void kernel_launch(void* const* d_in, const int* in_sizes, int n_in, void* d_out, int out_size, void* d_ws, size_t ws_size, hipStream_t stream) {
    static int grid = 0;
    if (grid == 0) {
        if (n_in != 21 || out_size != T * DM || ws_size < WS_END + 4096) { fprintf(stderr, "kernel_launch: unexpected shapes (n_in %d, out %d, ws %zu)\n", n_in, out_size, ws_size); grid = -1; return; }
        int dev = 0, cus = 0, per_cu = 0;
        if (hipGetDevice(&dev) != hipSuccess || hipDeviceGetAttribute(&cus, hipDeviceAttributeMultiprocessorCount, dev) != hipSuccess) { grid = -1; return; }
        if (hipFuncSetAttribute((const void*)fwd, hipFuncAttributeMaxDynamicSharedMemorySize, LDS_BYTES) != hipSuccess) { fprintf(stderr, "kernel_launch: hipFuncSetAttribute failed\n"); grid = -1; return; }
        if (hipOccupancyMaxActiveBlocksPerMultiprocessor(&per_cu, (const void*)fwd, NWAVES * 64, LDS_BYTES) != hipSuccess || per_cu < 1) { fprintf(stderr, "kernel_launch: occupancy query reports %d\n", per_cu); }
        (void)hipGetLastError();
        grid = cus;
    }
    if (grid < 0) return;
    (void)hipMemsetAsync((char*)d_ws + WS_CTL, 0, CTL_ZERO_BYTES, stream);
    Args a{};
    for (int i = 0; i < 21; ++i) a.in[i] = (const float*)d_in[i];
    a.out = (float*)d_out; a.ws = (unsigned char*)d_ws;
#if MK_SPLIT
    for (int p = 0; p < NPHASE; ++p) { a.ph_lo = p; a.ph_hi = p + 1; hipLaunchKernelGGL(fwd, dim3(grid), dim3(NWAVES * 64), LDS_BYTES, stream, a); }
#else
    a.ph_lo = 0; a.ph_hi = NPHASE;
    hipLaunchKernelGGL(fwd, dim3(grid), dim3(NWAVES * 64), LDS_BYTES, stream, a);
#endif
}
```

```cpp
#include <hip/hip_runtime.h>
#include <hip/hip_bf16.h>
#include <cstdio>
#include <cstdint>
#include <cmath>
namespace pg8 {
#define PG8_LAS __attribute__((address_space(3)))
typedef unsigned short bf16_t;
typedef short bf16x8 __attribute__((ext_vector_type(8)));
typedef float f32x4 __attribute__((ext_vector_type(4)));
typedef unsigned u32x4 __attribute__((ext_vector_type(4)));
constexpr int BM = 256, BK = 64, HALF = 128, HTB = HALF * BK * 2  , STAGE_BYTES = 8 * HTB, NXCD = 8, WGM = 8;

__host__ __device__ __forceinline__ int lds_byte(int r, int c) { const int st = (r >> 4) * 2 + (c >> 5), rr = r & 15, cc = c & 31, ob = rr * 64 + cc * 2; return st * 1024 + (ob ^ (((ob >> 9) & 1) << 5)); }
__host__ __device__ __forceinline__ void stage_rc(int b, int& R, int& C) { const int st = b / 1024, sb = b % 1024, swz = sb ^ (((sb >> 9) & 1) << 5); R = (st >> 1) * 16 + swz / 64; C = (st & 1) * 32 + (swz % 64) / 2; }
__host__ __device__ __forceinline__ int perm32(int rho) { const int n = rho >> 4, i = rho & 15; return 8 * (i >> 2) + 4 * n + (i & 3); }

struct Unit { int pm, pn; };
struct Gemm { const bf16_t* A; const bf16_t* Bt; int M, N, K; };

struct StaticOrder {
    int nM, nN, nwg, G, c;
    __host__ __device__ void init(int M, int N, int G_, int c_) { nM = M / BM; nN = N / BM; nwg = nM * nN; G = G_; c = c_; }
    __host__ __device__ bool next(int i, Unit& u) const {
        const long L = (long)i * G + c; if (L >= nwg) return false;
        int wgid = (int)L; { const int q = nwg / NXCD, r = nwg % NXCD, xcd = wgid % NXCD, off = wgid / NXCD; wgid = (xcd < r ? xcd * (q + 1) : r * (q + 1) + (xcd - r) * q) + off; }
        const int nig = WGM * nN, gid = wgid / nig, fm = gid * WGM, gsz = (nM - fm) < WGM ? (nM - fm) : WGM;
        u.pm = fm + ((wgid % nig) % gsz); u.pn = (wgid % nig) / gsz; return true;
    }
    __device__ __forceinline__ void a_ready(const Unit&) const {}
    __device__ __forceinline__ void done(const Unit&) const {}
};

__device__ __forceinline__ unsigned cvt_pk_bf16(float lo, float hi) { unsigned r; asm volatile("v_cvt_pk_bf16_f32 %0, %1, %2" : "=v"(r) : "v"(lo), "v"(hi)); return r; }
typedef float f32x2 __attribute__((ext_vector_type(2)));
__device__ __forceinline__ f32x2 gelu_pk(f32x2 v) {
    const f32x2 av = __builtin_elementwise_abs(v), d = av * 0.2316418882f + 1.0f;
    f32x2 t; t.x = __builtin_amdgcn_rcpf(d.x); t.y = __builtin_amdgcn_rcpf(d.y);
    f32x2 q = t * 0.5307027145f + (-0.7265760135f); q = q * t + 0.7107068705f; q = q * t + (-0.142248368f); q = q * t + 0.127414796f; q = q * t;
    const f32x2 s = (v * v) * (-0.72134752044f);
    f32x2 e; e.x = __builtin_amdgcn_exp2f(s.x); e.y = __builtin_amdgcn_exp2f(s.y);
    const f32x2 m = v * (q * e), r = v - m;
    f32x2 o; o.x = v.x < 0.f ? m.x : r.x; o.y = v.y < 0.f ? m.y : r.y; return o;
}

template <int ACT  > struct EpiBf16 {
    static constexpr bool PERM = true, AFTER_DRAIN = false, HEAD64 = false; static_assert(ACT == 0 || ACT == 1, "EpiBf16: ACT is 0 (none) or 1 (gelu_pk)");
    bf16_t* O; int ldc; const float* bias; int split_cols; size_t split_stride; float scale0;
    __device__ __forceinline__ void operator()(const f32x4 (&acc)[2][2][4][2], const Unit& u, int wr, int wc, int fr, int fq) const {
        const int row0 = u.pm * BM + wr * 64 + fr; int colt = u.pn * BM; bf16_t* base = O;
        float sc = 1.f; if (split_cols) { const int t = colt / split_cols; base += (size_t)t * split_stride; colt -= t * split_cols; if (t == 0) sc = scale0; }
        const int col0 = colt + wc * 32 + 8 * fq, bcol0 = u.pn * BM + wc * 32 + 8 * fq;
        f32x4 bv[2][2];
#pragma unroll
        for (int bj = 0; bj < 2; ++bj)
#pragma unroll
            for (int n = 0; n < 2; ++n) bv[bj][n] = bias ? *(const f32x4*)(bias + bcol0 + bj * HALF + 4 * n) : (f32x4){0.f, 0.f, 0.f, 0.f};
#pragma unroll
        for (int ai = 0; ai < 2; ++ai)
#pragma unroll
            for (int m = 0; m < 4; ++m) { bf16_t* rowp = base + (size_t)(row0 + ai * HALF + m * 16) * ldc + col0;
#pragma unroll
                for (int bj = 0; bj < 2; ++bj) { f32x4 v0 = acc[ai][bj][m][0] + bv[bj][0], v1 = acc[ai][bj][m][1] + bv[bj][1];
                    if (ACT == 1) { f32x2 a = gelu_pk((f32x2){v0[0], v0[1]}), b = gelu_pk((f32x2){v0[2], v0[3]}), c = gelu_pk((f32x2){v1[0], v1[1]}), d = gelu_pk((f32x2){v1[2], v1[3]});
                        v0 = (f32x4){a.x, a.y, b.x, b.y}; v1 = (f32x4){c.x, c.y, d.x, d.y}; }
                    v0 = v0 * sc; v1 = v1 * sc; u32x4 w; w.x = cvt_pk_bf16(v0[0], v0[1]); w.y = cvt_pk_bf16(v0[2], v0[3]); w.z = cvt_pk_bf16(v1[0], v1[1]); w.w = cvt_pk_bf16(v1[2], v1[3]);
                    *(u32x4*)(rowp + bj * HALF) = w; } }
    }
};


struct GOrder {
    int nM, nN, nwg, G, c;
    __host__ __device__ void init(int M, int N, int G_, int c_) { nM = M / BM; nN = N / BM; nwg = nM * nN; G = G_; c = c_; }
    __host__ __device__ bool next(int i, Unit& u) const {
        if (c < 0) return false;
        const long L = (long)i * G + c; if (L >= nwg) return false;
        int wgid = (int)L; { const int q = nwg / NXCD, r = nwg % NXCD, xcd = wgid % NXCD, off = wgid / NXCD; wgid = (xcd < r ? xcd * (q + 1) : r * (q + 1) + (xcd - r) * q) + off; }
        const int nig = WGM * nN, gid = wgid / nig, fm = gid * WGM, gsz = (nM - fm) < WGM ? (nM - fm) : WGM;
        u.pm = fm + ((wgid % nig) % gsz); u.pn = (wgid % nig) / gsz; return true;
    }
    __device__ __forceinline__ void a_ready(const Unit&) const {}
    __device__ __forceinline__ void done(const Unit&) const {}
};
struct BranchOrder {
    GOrder g;
    __device__ void init(int G, int c) { g.init(16384, 1024, G, c); }
#if defined(PROBE_P4X2)
    __device__ bool next(int i, Unit& u) const { Unit t; if (i >= 6 || !g.next(0, t)) return false; const int br = i % 3; u.pm = 64 * br + t.pm; u.pn = 4 * br + t.pn; return true; }
#else
    __device__ bool next(int i, Unit& u) const { Unit t; if (!g.next(i / 3, t)) return false; const int br = i % 3; u.pm = 64 * br + t.pm; u.pn = 4 * br + t.pn; return true; }
#endif
    __device__ __forceinline__ void a_ready(const Unit&) const {}
    __device__ __forceinline__ void done(const Unit&) const {}
};
__device__ __forceinline__ float bf_lo(unsigned w) { return __builtin_bit_cast(float, w << 16); }
__device__ __forceinline__ float bf_hi(unsigned w) { return __builtin_bit_cast(float, w & 0xffff0000u); }
__device__ __forceinline__ float sigmoid_f(float x) { return __builtin_amdgcn_rcpf(1.0f + __builtin_amdgcn_exp2f(-1.4426950408889634f * x)); }
struct EpiProj {
    static constexpr bool PERM = true, AFTER_DRAIN = false, HEAD64 = true;
    bf16_t* PA; bf16_t* PG; const float* gq; const float* gk; float* KMEAN; float qscale, eps;
    __device__ __forceinline__ void operator()(const f32x4 (&acc)[2][2][4][2], const Unit& u, int wr, int wc, int fr, int fq) const {
        const bool gate = u.pn >= 14; const int mode = u.pn < 2 ? 1 : (u.pn < 4 ? 2 : 0);
        bf16_t* base = gate ? PG : PA; const int ldc = gate ? 3072 : 3584; const int colt = gate ? (u.pn - 14) * BM : u.pn * BM;
        const int row0 = u.pm * BM + wr * 64 + fr, col0 = colt + wc * 64 + 8 * fq;
        f32x4 gn[2][2]; f32x4 cs[2][2];
#pragma unroll
        for (int bj = 0; bj < 2; ++bj)
#pragma unroll
            for (int n = 0; n < 2; ++n) { cs[bj][n] = (f32x4){0.f, 0.f, 0.f, 0.f}; gn[bj][n] = (f32x4){1.f, 1.f, 1.f, 1.f};
                if (mode) { const float* gp = (mode == 1 ? gq : gk) + 32 * bj + 8 * fq + 4 * n; const float sc = mode == 1 ? qscale : 1.0f; gn[bj][n] = (f32x4){gp[0] * sc, gp[1] * sc, gp[2] * sc, gp[3] * sc}; } }
#pragma unroll
        for (int ai = 0; ai < 2; ++ai)
#pragma unroll
            for (int m = 0; m < 4; ++m) { bf16_t* rowp = base + (size_t)(row0 + ai * HALF + m * 16) * ldc + col0;
                float r = 1.f;
                if (mode) { float ss = 0.f;
#pragma unroll
                    for (int bj = 0; bj < 2; ++bj)
#pragma unroll
                        for (int n = 0; n < 2; ++n) { const f32x4 v = acc[ai][bj][m][n]; ss += (v[0] * v[0] + v[1] * v[1]) + (v[2] * v[2] + v[3] * v[3]); }
                    ss += __shfl_xor(ss, 16); ss += __shfl_xor(ss, 32);
                    r = 1.0f / sqrtf(ss * (1.f / 64.f) + eps); }
#pragma unroll
                for (int bj = 0; bj < 2; ++bj) { f32x4 v0 = acc[ai][bj][m][0], v1 = acc[ai][bj][m][1];
                    if (gate) {
#pragma unroll
                        for (int e = 0; e < 4; ++e) { v0[e] = sigmoid_f(v0[e]); v1[e] = sigmoid_f(v1[e]); } }
                    if (mode) { v0 = v0 * r * gn[bj][0]; v1 = v1 * r * gn[bj][1]; if (mode == 2) { cs[bj][0] += v0; cs[bj][1] += v1; } }
                    u32x4 w; w.x = cvt_pk_bf16(v0[0], v0[1]); w.y = cvt_pk_bf16(v0[2], v0[3]); w.z = cvt_pk_bf16(v1[0], v1[1]); w.w = cvt_pk_bf16(v1[2], v1[3]);
                    *(u32x4*)(rowp + bj * 32) = w; } }
        if (mode == 2) {
            const int b = u.pm >> 3, nb = u.pm & 7, head = (u.pn - 2) * 4 + wc;
            float* km = KMEAN + (size_t)((b * 8 + head) * 8 + nb) * 64 + 8 * fq;
#pragma unroll
            for (int bj = 0; bj < 2; ++bj)
#pragma unroll
                for (int n = 0; n < 2; ++n)
#pragma unroll
                    for (int e = 0; e < 4; ++e) { float s = cs[bj][n][e];
                        s += __shfl_xor(s, 1); s += __shfl_xor(s, 2); s += __shfl_xor(s, 4); s += __shfl_xor(s, 8);
                        if (fr == 0) atomicAdd(km + 32 * bj + 4 * n + e, s * (1.f / 256.f)); }
        }
    }
};
struct EpiBranch {
    static constexpr bool PERM = true, AFTER_DRAIN = false, HEAD64 = false;
    const bf16_t* PG; bf16_t* MG;
    __device__ __forceinline__ void operator()(const f32x4 (&acc)[2][2][4][2], const Unit& u, int wr, int wc, int fr, int fq) const {
        const int br = u.pm >> 6, tm = u.pm & 63, tn = u.pn & 3;
        const int row0 = tm * BM + wr * 64 + fr, col0 = tn * BM + wc * 32 + 8 * fq;
#pragma unroll
        for (int ai = 0; ai < 2; ++ai) {
            u32x4 g[4][2], p[4][2];
#pragma unroll
            for (int m = 0; m < 4; ++m)
#pragma unroll
                for (int bj = 0; bj < 2; ++bj) { const size_t row = (size_t)(row0 + ai * HALF + m * 16); const int col = col0 + bj * HALF;
                    g[m][bj] = *(const u32x4*)(PG + row * 3072 + br * 1024 + col);
                    p[m][bj] = (br > 0) ? *(const u32x4*)(MG + row * 1024 + col) : (u32x4){0u, 0u, 0u, 0u}; }
#pragma unroll
            for (int m = 0; m < 4; ++m)
#pragma unroll
                for (int bj = 0; bj < 2; ++bj) { const size_t row = (size_t)(row0 + ai * HALF + m * 16); const int col = col0 + bj * HALF;
                    const u32x4 gg = g[m][bj], pp = p[m][bj];
                    f32x4 v0 = acc[ai][bj][m][0], v1 = acc[ai][bj][m][1];
                    v0[0] = v0[0] * bf_lo(gg.x) + bf_lo(pp.x); v0[1] = v0[1] * bf_hi(gg.x) + bf_hi(pp.x); v0[2] = v0[2] * bf_lo(gg.y) + bf_lo(pp.y); v0[3] = v0[3] * bf_hi(gg.y) + bf_hi(pp.y);
                    v1[0] = v1[0] * bf_lo(gg.z) + bf_lo(pp.z); v1[1] = v1[1] * bf_hi(gg.z) + bf_hi(pp.z); v1[2] = v1[2] * bf_lo(gg.w) + bf_lo(pp.w); v1[3] = v1[3] * bf_hi(gg.w) + bf_hi(pp.w);
                    u32x4 w; w.x = cvt_pk_bf16(v0[0], v0[1]); w.y = cvt_pk_bf16(v0[2], v0[3]); w.z = cvt_pk_bf16(v1[0], v1[1]); w.w = cvt_pk_bf16(v1[2], v1[3]);
                    *(u32x4*)(MG + row * 1024 + col) = w; }
        }
    }
};
struct EpiWout {
    static constexpr bool PERM = false, AFTER_DRAIN = false, HEAD64 = false;
    const float* X; float* H; bf16_t* HB; float* SL;
    __device__ __forceinline__ void operator()(const f32x4 (&acc)[2][2][4][2], const Unit& u, int wr, int wc, int fr, int fq) const {
        typedef unsigned u32x2v __attribute__((ext_vector_type(2)));
        const int row0 = u.pm * BM + wr * 64 + fr, col0 = u.pn * BM + wc * 32 + 4 * fq;
#pragma unroll
        for (int ai = 0; ai < 2; ++ai)
#pragma unroll
            for (int mh = 0; mh < 2; ++mh) {
                f32x4 xv[2][2][2];
#pragma unroll
                for (int mm = 0; mm < 2; ++mm)
#pragma unroll
                    for (int bj = 0; bj < 2; ++bj)
#pragma unroll
                        for (int n = 0; n < 2; ++n) xv[mm][bj][n] = *(const f32x4*)(X + (size_t)(row0 + ai * HALF + (2 * mh + mm) * 16) * 1024 + col0 + bj * HALF + n * 16);
#pragma unroll
                for (int mm = 0; mm < 2; ++mm) { const int m = 2 * mh + mm; const size_t row = (size_t)(row0 + ai * HALF + m * 16); float ss = 0.f;
#pragma unroll
                    for (int bj = 0; bj < 2; ++bj)
#pragma unroll
                        for (int n = 0; n < 2; ++n) { const size_t off = row * 1024 + col0 + bj * HALF + n * 16;
                            const f32x4 hv = xv[mm][bj][n] + acc[ai][bj][m][n];
                            *(f32x4*)(H + off) = hv; ss += (hv[0] * hv[0] + hv[1] * hv[1]) + (hv[2] * hv[2] + hv[3] * hv[3]);
                            u32x2v w; w.x = cvt_pk_bf16(hv[0], hv[1]); w.y = cvt_pk_bf16(hv[2], hv[3]);
                            *(u32x2v*)(HB + off) = w; }
                    ss += __shfl_xor(ss, 16); ss += __shfl_xor(ss, 32);
                    if (fq == 0) SL[row * 16 + u.pn * 4 + wc] = ss; }
            }
    }
};
template <class Epi, class Sched, bool ALIGN_EPI = false, bool SP2 = false>
__device__ __forceinline__ void gemm_phase(PG8_LAS unsigned char* lds, const Gemm g, const Sched& S, const Epi& E) {
    const int tid = threadIdx.x, wid = __builtin_amdgcn_readfirstlane(tid >> 6), lane = tid & 63, wr = wid >> 2, wc = wid & 3, fr = lane & 15, fq = lane >> 4;
    const int K = g.K, nt = K / BK;
    unsigned voffA[2], voffB[2];
#pragma unroll
    for (int i = 0; i < 2; ++i) { int R, C; stage_rc(tid * 16 + i * 8192, R, C); const int Rb = Epi::HEAD64 ? (64 * (R >> 5) + perm32(R & 31)) : (Epi::PERM ? ((R & ~31) + perm32(R & 31)) : R);
        voffA[i] = (unsigned)(R * K + C) * 2u; voffB[i] = (unsigned)(Rb * K + C) * 2u; }
    const size_t kstep = (size_t)(BK * 2);
    const size_t hstep = (size_t)HALF * K * 2;
    const size_t hstepB = Epi::HEAD64 ? (size_t)32 * K * 2 : hstep;
    const size_t tstep = 2 * hstep;
    const unsigned ldsw = (unsigned)wid * 1024u;
    const int aoff = lds_byte(wr * 64 + fr, fq * 8), boff = lds_byte(wc * 32 + fr, fq * 8);
#define PG8_SA(b, h) (((b) * 2 + (h)) * HTB)
#define PG8_SB(b, h) ((4 + (b) * 2 + (h)) * HTB)
#define PG8_STAGE(bufoff, gbase, voff) do { _Pragma("unroll") for (int _i = 0; _i < 2; ++_i) \
        __builtin_amdgcn_global_load_lds((const unsigned*)((const char*)(gbase) + (voff)[_i]), (PG8_LAS unsigned*)(lds + (bufoff) + ldsw + _i * 8192), 16, 0, 0); } while (0)
#define PG8_LDA(dst, b, h) do { _Pragma("unroll") for (int m = 0; m < 4; ++m) _Pragma("unroll") for (int k = 0; k < 2; ++k) dst[m][k] = *(const PG8_LAS bf16x8*)(lds + PG8_SA(b, h) + aoff + m * 2048 + k * 1024); } while (0)
#define PG8_LDB(dst, b, h) do { _Pragma("unroll") for (int n = 0; n < 2; ++n) _Pragma("unroll") for (int k = 0; k < 2; ++k) dst[n][k] = *(const PG8_LAS bf16x8*)(lds + PG8_SB(b, h) + boff + n * 2048 + k * 1024); } while (0)
#define PG8_MMA(ai, bj, At, Bt) do { __builtin_amdgcn_s_setprio(1); _Pragma("unroll") for (int m = 0; m < 4; ++m) _Pragma("unroll") for (int n = 0; n < 2; ++n) _Pragma("unroll") for (int k = 0; k < 2; ++k) \
        acc[ai][bj][m][n] = __builtin_amdgcn_mfma_f32_16x16x32_bf16(Bt[n][k], At[m][k], acc[ai][bj][m][n], 0, 0, 0); __builtin_amdgcn_s_setprio(0); } while (0)
#define PG8_WAIT_V(n) asm volatile("s_waitcnt vmcnt(" #n ")" ::: "memory")
#define PG8_WAIT_L(n) asm volatile("s_waitcnt lgkmcnt(" #n ")" ::: "memory")
#define PG8_BAR __builtin_amdgcn_s_barrier()
#define PG8_SCHED __builtin_amdgcn_sched_barrier(0)
    Unit cur, nxt; int ui = 0;
    if (!S.next(0, cur)) return;
    f32x4 acc[2][2][4][2];
#pragma unroll
    for (int a = 0; a < 2; ++a)
#pragma unroll
        for (int b = 0; b < 2; ++b)
#pragma unroll
            for (int m = 0; m < 4; ++m)
#pragma unroll
                for (int n = 0; n < 2; ++n) acc[a][b][m][n] = (f32x4){0.f, 0.f, 0.f, 0.f};
    bf16x8 At[4][2], B0[2][2], B1[2][2];
    const char* cA = (const char*)g.A + (size_t)cur.pm * tstep; const char* cB = (const char*)g.Bt + (size_t)cur.pn * tstep;
    S.a_ready(cur);
    if constexpr (SP2) {
        PG8_STAGE(PG8_SB(0, 0), cB, voffB); PG8_STAGE(PG8_SB(0, 1), cB + hstepB, voffB); PG8_STAGE(PG8_SA(0, 0), cA, voffA); PG8_STAGE(PG8_SA(0, 1), cA + hstep, voffA);
        if (wr == 1) PG8_BAR;
        PG8_WAIT_V(2); PG8_BAR;
        PG8_STAGE(PG8_SB(1, 0), cB + kstep, voffB); PG8_STAGE(PG8_SA(1, 0), cA + kstep, voffA); PG8_STAGE(PG8_SB(1, 1), cB + hstepB + kstep, voffB);
        PG8_WAIT_V(6); PG8_BAR;
    } else {
        PG8_STAGE(PG8_SB(0, 0), cB, voffB); PG8_STAGE(PG8_SA(0, 0), cA, voffA); PG8_STAGE(PG8_SB(0, 1), cB + hstepB, voffB); PG8_STAGE(PG8_SA(0, 1), cA + hstep, voffA);
        if (wr == 1) PG8_BAR;
        PG8_WAIT_V(4); PG8_BAR;
        PG8_STAGE(PG8_SB(1, 0), cB + kstep, voffB); PG8_STAGE(PG8_SA(1, 0), cA + kstep, voffA); PG8_STAGE(PG8_SB(1, 1), cB + hstepB + kstep, voffB);
        PG8_WAIT_V(6); PG8_BAR;
    }
    for (;;) {
        const bool has_next = S.next(ui + 1, nxt);
        const char* nA = has_next ? (const char*)g.A + (size_t)nxt.pm * tstep : cA; const char* nB = has_next ? (const char*)g.Bt + (size_t)nxt.pn * tstep : cB;
        for (int t = 0; t < nt; t += 2) {
            const bool last = (t == nt - 2);
            const char* a1 = cA + (size_t)(t + 1) * kstep;
            const char* a2 = last ? nA : cA + (size_t)(t + 2) * kstep; const char* b2 = last ? nB : cB + (size_t)(t + 2) * kstep;
            const char* a3 = a2 + kstep; const char* b3 = b2 + kstep;
            if (last && has_next) S.a_ready(nxt);
            if constexpr (SP2) {
            PG8_LDB(B0, 0, 0); PG8_LDB(B1, 0, 1); PG8_SCHED; PG8_LDA(At, 0, 0); PG8_STAGE(PG8_SA(1, 1), a1 + hstep, voffA);
            PG8_WAIT_V(8); PG8_WAIT_L(0); PG8_BAR; PG8_MMA(0, 0, At, B0); PG8_MMA(0, 1, At, B1); PG8_BAR; PG8_SCHED;
            PG8_LDA(At, 0, 1); PG8_STAGE(PG8_SB(0, 0), b2, voffB); PG8_STAGE(PG8_SB(0, 1), b2 + hstepB, voffB); PG8_STAGE(PG8_SA(0, 0), a2, voffA);
            PG8_WAIT_V(8); PG8_WAIT_L(0); PG8_BAR; PG8_MMA(1, 0, At, B0); PG8_MMA(1, 1, At, B1); PG8_BAR; PG8_SCHED;
            PG8_LDB(B0, 1, 0); PG8_LDB(B1, 1, 1); PG8_SCHED; PG8_LDA(At, 1, 0); PG8_STAGE(PG8_SA(0, 1), a2 + hstep, voffA);
            PG8_WAIT_V(8); PG8_WAIT_L(0); PG8_BAR; PG8_MMA(0, 0, At, B0); PG8_MMA(0, 1, At, B1); PG8_BAR; PG8_SCHED;
            PG8_LDA(At, 1, 1); PG8_STAGE(PG8_SB(1, 0), b3, voffB); PG8_STAGE(PG8_SB(1, 1), b3 + hstepB, voffB); PG8_STAGE(PG8_SA(1, 0), a3, voffA);
            PG8_WAIT_V(8); PG8_WAIT_L(0); PG8_BAR; PG8_MMA(1, 0, At, B0); PG8_MMA(1, 1, At, B1); PG8_BAR; PG8_SCHED;
            } else {
            PG8_LDB(B0, 0, 0); PG8_SCHED; PG8_LDA(At, 0, 0); PG8_STAGE(PG8_SA(1, 1), a1 + hstep, voffA);
            PG8_WAIT_L(8); PG8_BAR; PG8_WAIT_L(0); PG8_MMA(0, 0, At, B0); PG8_BAR; PG8_SCHED;
            PG8_LDB(B1, 0, 1); PG8_STAGE(PG8_SB(0, 0), b2, voffB);
            PG8_BAR; PG8_WAIT_L(0); PG8_MMA(0, 1, At, B1); PG8_BAR;
            PG8_LDA(At, 0, 1); PG8_STAGE(PG8_SA(0, 0), a2, voffA);
            PG8_BAR; PG8_WAIT_L(0); PG8_MMA(1, 0, At, B0); PG8_BAR; PG8_SCHED;
            PG8_STAGE(PG8_SB(0, 1), b2 + hstepB, voffB);
            PG8_WAIT_V(6); PG8_BAR; PG8_MMA(1, 1, At, B1); PG8_BAR;
            PG8_LDB(B0, 1, 0); PG8_SCHED; PG8_LDA(At, 1, 0); PG8_STAGE(PG8_SA(0, 1), a2 + hstep, voffA);
            PG8_WAIT_L(8); PG8_BAR; PG8_WAIT_L(0); PG8_MMA(0, 0, At, B0); PG8_BAR; PG8_SCHED;
            PG8_LDB(B1, 1, 1); PG8_STAGE(PG8_SB(1, 0), b3, voffB);
            PG8_BAR; PG8_WAIT_L(0); PG8_MMA(0, 1, At, B1); PG8_BAR;
            PG8_LDA(At, 1, 1); PG8_STAGE(PG8_SA(1, 0), a3, voffA);
            PG8_BAR; PG8_WAIT_L(0); PG8_MMA(1, 0, At, B0); PG8_BAR; PG8_SCHED;
            PG8_STAGE(PG8_SB(1, 1), b3 + hstepB, voffB);
            PG8_WAIT_V(6); PG8_BAR; PG8_MMA(1, 1, At, B1); PG8_BAR;
            }
        }
        if constexpr (ALIGN_EPI) { if (wr == 0) PG8_BAR; }
        if constexpr (!Epi::AFTER_DRAIN) { E(acc, cur, wr, wc, fr, fq); S.done(cur); }
        if (!has_next) break;
#pragma unroll
        for (int a = 0; a < 2; ++a)
#pragma unroll
            for (int b = 0; b < 2; ++b)
#pragma unroll
                for (int m = 0; m < 4; ++m)
#pragma unroll
                    for (int n = 0; n < 2; ++n) acc[a][b][m][n] = (f32x4){0.f, 0.f, 0.f, 0.f};
        cur = nxt; cA = nA; cB = nB; ++ui;
        if constexpr (ALIGN_EPI) { if (wr == 1) PG8_BAR; }
    }
    PG8_WAIT_V(0);
    if constexpr (!ALIGN_EPI) { if (wr == 0) PG8_BAR; }
    PG8_BAR;
    if constexpr (Epi::AFTER_DRAIN) { E.fused(acc, cur, wr, wc, fr, fq, lds, wid, lane); S.done(cur); }
#undef PG8_SA
#undef PG8_SB
#undef PG8_STAGE
#undef PG8_LDA
#undef PG8_LDB
#undef PG8_MMA
#undef PG8_WAIT_V
#undef PG8_WAIT_L
#undef PG8_BAR
#undef PG8_SCHED
}
}

constexpr int NWAVES = 8;
constexpr int T = 16384, DM = 1024, SEQ = 2048, NBATCH = 8, MEMLEN = 256;
constexpr int PW = 6656, PAW = 3584, PGW = 3072;
constexpr int COL_QA = 0, COL_KA = 512, COL_VA = 1024, COL_UC = 1536, COL_BC = 2048, COL_CC = 2560, COL_QX = 3072;
constexpr float RMS_EPS = 1e-6f, LOG2E = 1.4426950408889634f;
constexpr float C2A = 0.125f * LOG2E;
constexpr float C2X = 0.08838834764831845f * LOG2E;
constexpr int NEXP = 16384;

constexpr size_t MiB = 1u << 20;
constexpr size_t WS_CTL = 0, CTL_ZERO_BYTES = 1 * MiB;
constexpr size_t WS_WIN = 1 * MiB;
constexpr size_t WS_WKV = 14 * MiB;
constexpr size_t WS_WBR = 16 * MiB;
constexpr size_t WS_WOUT = 19 * MiB;
constexpr size_t WS_WQ = 21 * MiB;
constexpr size_t WS_SK = 25 * MiB;
constexpr size_t WS_TAB = 25 * MiB + 512 * 1024;
constexpr size_t WS_KMEAN = WS_CTL + 256 * 1024;
constexpr size_t WS_MEMN = 26 * MiB;
constexpr size_t WS_KVM = 30 * MiB;
constexpr size_t WS_SLOTS = 34 * MiB;
constexpr size_t WS_SEL = 35 * MiB;
constexpr size_t WS_SU = 43 * MiB, WS_SV = 43 * MiB + 65536, WS_SX = 43 * MiB + 2 * 65536, WS_CS = 43 * MiB + 3 * 65536;
constexpr size_t WS_PA = 44 * MiB;
constexpr size_t WS_PG = 156 * MiB;
constexpr size_t WS_END = 252 * MiB;
constexpr size_t PA_MERGED = WS_PA, PA_HB = WS_PA + 32 * MiB, PA_UT = WS_PA + 64 * MiB, PA_VT = WS_PA;
constexpr size_t PG_QRY = WS_PG, PG_PART = WS_PG, PG_COEF = WS_PG + 64 * MiB, PA_XQ = WS_PA + 32 * MiB;
constexpr int CW_QU = 8192, CW_QV = 8192 + 512;
constexpr int CW_BAR = 4096;

constexpr int RING_OFF = 0, RING_BYTES = 131072;
constexpr int LDSCTL_OFF = RING_BYTES, MISC_OFF = LDSCTL_OFF + 320;
constexpr int LDS_BYTES = 147456;

#define GAS __attribute__((address_space(1)))
#define LAS __attribute__((address_space(3)))
typedef unsigned short bf16;
typedef unsigned v4u __attribute__((ext_vector_type(4)));
typedef unsigned v2u __attribute__((ext_vector_type(2)));
typedef float f32x4 __attribute__((ext_vector_type(4)));
typedef float f32x16 __attribute__((ext_vector_type(16)));
typedef short bf16x8 __attribute__((ext_vector_type(8)));
typedef short s16x4 __attribute__((ext_vector_type(4)));
typedef GAS unsigned gu32;
#define RLX_AGENT __ATOMIC_RELAXED, __HIP_MEMORY_SCOPE_AGENT
#define LDS_WAIT() asm volatile("s_waitcnt lgkmcnt(0)" ::: "memory")
#define VM_WAIT() asm volatile("s_waitcnt vmcnt(0)" ::: "memory")
__device__ __forceinline__ unsigned f2bf(float f) { unsigned u = __builtin_bit_cast(unsigned, f); return (u + 0x7fffu + ((u >> 16) & 1u)) >> 16; }
__device__ __forceinline__ unsigned pk2(float lo, float hi) { return f2bf(lo) | (f2bf(hi) << 16); }
__device__ __forceinline__ float bflo(unsigned w) { return __builtin_bit_cast(float, w << 16); }
__device__ __forceinline__ float bfhi(unsigned w) { return __builtin_bit_cast(float, w & 0xffff0000u); }
__device__ __forceinline__ float wave_sum(float v) {
#pragma unroll
    for (int o = 1; o < 64; o <<= 1) v += __shfl_xor(v, o);
    return v;
}
#define XB_TMO      128
#define XB_XCNT(j)  (256  + 64 * (j))
#define XB_XSUB(j)  (1280 + 64 * (j))
#define XB_XGEN(j)  (2304 + 64 * (j))
#define XB_TOP      3328
#define XB_TOPGEN   3392
#define XCD_BAR_WORDS 3456
#define XB_SPIN_CAP (1u << 18)

__device__ __forceinline__ unsigned xb_ld(unsigned* p)              { return __hip_atomic_load(p, __ATOMIC_RELAXED, __HIP_MEMORY_SCOPE_AGENT); }
__device__ __forceinline__ unsigned xb_add(unsigned* p, unsigned v) { return __hip_atomic_fetch_add(p, v, __ATOMIC_RELAXED, __HIP_MEMORY_SCOPE_AGENT); }
__device__ __forceinline__ unsigned xb_xcc_id() { return (unsigned)__builtin_amdgcn_s_getreg((3 << 11) | 20) & 0xFu; }
#define XB_SPIN(cond, bar) do { unsigned _sp = 0; while (cond) { __builtin_amdgcn_s_sleep(1); \
    if ((++_sp & 255u) == 0u) { if (xb_ld(&(bar)[XB_TMO])) break; if (_sp > XB_SPIN_CAP) { atomicAdd(&(bar)[XB_TMO], 1u); break; } } } } while (0)

struct XcdBarrier {
    unsigned* bar; unsigned x;
    volatile LAS unsigned* st;
};

__device__ __forceinline__ XcdBarrier xcd_barrier_post(unsigned* bar, volatile LAS unsigned* st) {
    XcdBarrier b; b.bar = bar; b.x = xb_xcc_id(); b.st = st;
    if (threadIdx.x == 0) (void)xb_add(&bar[XB_XCNT(b.x)], 1u);
    return b;
}
__device__ __forceinline__ void xcd_barrier_complete(unsigned* bar, unsigned x, unsigned& nloc, unsigned& nx) {
    const unsigned G = gridDim.x * gridDim.y * gridDim.z;
    unsigned sum, cnt, mine, sp = 0u;
    for (;;) {
        sum = 0u; cnt = 0u; mine = 0u;
#pragma unroll
        for (unsigned j = 0; j < 16; ++j) { const unsigned c = xb_ld(&bar[XB_XCNT(j)]); sum += c; cnt += (c > 0u) ? 1u : 0u; mine = (j == x) ? c : mine; }
        if (sum == G) break;
        __builtin_amdgcn_s_sleep(1);
        if ((++sp & 255u) == 0u) { if (xb_ld(&bar[XB_TMO])) break; if (sp > XB_SPIN_CAP) { atomicAdd(&bar[XB_TMO], 1u); break; } }
    }
    nloc = mine > 0u ? mine : 1u; nx = cnt > 0u ? cnt : 1u;
}

__device__ __forceinline__ void xcd_barrier(const XcdBarrier& b) {
    asm volatile("s_waitcnt vmcnt(0)" ::: "memory");
    __syncthreads();
    if (threadIdx.x == 0) {
        unsigned* bar = b.bar;
        __builtin_amdgcn_s_waitcnt(0);
        unsigned nloc = b.st[0], nx = b.st[1];
        if (nloc == 0u) { xcd_barrier_complete(bar, b.x, nloc, nx); b.st[0] = nloc; b.st[1] = nx; }
        const unsigned old = xb_add(&bar[XB_XSUB(b.x)], 1u);
        const unsigned gen = old / nloc;
        if (old + 1u == (gen + 1u) * nloc) {
            __builtin_amdgcn_fence(__ATOMIC_RELEASE, "agent");
            asm volatile("s_waitcnt vmcnt(0)" ::: "memory");
            const unsigned og = xb_add(&bar[XB_TOP], 1u);
            const unsigned tg = og / nx;
            if (og + 1u == (tg + 1u) * nx) xb_add(&bar[XB_TOPGEN], 1u);
            else XB_SPIN(xb_ld(&bar[XB_TOPGEN]) == tg, bar);
            __builtin_amdgcn_fence(__ATOMIC_ACQUIRE, "agent");
            xb_add(&bar[XB_XGEN(b.x)], 1u);
            asm volatile("s_waitcnt vmcnt(0)" ::: "memory");
        } else {
            XB_SPIN(xb_ld(&bar[XB_XGEN(b.x)]) == gen, bar);
            __builtin_amdgcn_fence(__ATOMIC_ACQUIRE, "agent");
            asm volatile("s_waitcnt vmcnt(0)" ::: "memory");
        }
    }
    __syncthreads();
}

__device__ __forceinline__ void p0_transpose_item(const float* W, int K, int N, bf16* WT, int row_off, const float* ksc, LAS float* scr, int item, int lane) {
    const int nblk = N / 32, kb = item / nblk, nb = item % nblk, k0 = 64 * kb, n0 = 32 * nb;
#pragma unroll 8
    for (int i = 0; i < 32; ++i) { const int kk = 2 * i + (lane >> 5); float v = W[(size_t)(k0 + kk) * N + n0 + (lane & 31)]; if (ksc) v *= ksc[k0 + kk]; scr[kk * 33 + (lane & 31)] = v; }
    LDS_WAIT(); asm volatile("" ::: "memory");
    const int c = lane & 7;
#pragma unroll
    for (int j = 0; j < 4; ++j) { const int n = (lane >> 3) + 8 * j; const LAS float* s = scr + (8 * c) * 33 + n;
        v4u o; o.x = pk2(s[0 * 33], s[1 * 33]); o.y = pk2(s[2 * 33], s[3 * 33]); o.z = pk2(s[4 * 33], s[5 * 33]); o.w = pk2(s[6 * 33], s[7 * 33]);
        *(GAS v4u*)(WT + (size_t)(row_off + n0 + n) * K + k0 + 8 * c) = o; }
    LDS_WAIT(); asm volatile("" ::: "memory");
}
template <int NR> __device__ __forceinline__ void rms_rows_to_bf16(const float* X, const float* g, bf16* O, int m0, int ms, int mend, int lane) {
    const GAS f32x4* gr = (const GAS f32x4*)g + lane;
    f32x4 v[NR][4];
#pragma unroll
    for (int r = 0; r < NR; ++r) { const int m = (m0 + r * ms < mend) ? m0 + r * ms : mend - 1; const GAS f32x4* xr = (const GAS f32x4*)(X + (size_t)m * DM) + lane;
#pragma unroll
        for (int j = 0; j < 4; ++j) v[r][j] = xr[64 * j]; }
    f32x4 gv[4];
#pragma unroll
    for (int j = 0; j < 4; ++j) gv[j] = gr[64 * j];
#pragma unroll
    for (int r = 0; r < NR; ++r) { float s = 0.f;
#pragma unroll
        for (int j = 0; j < 4; ++j) s += (v[r][j].x * v[r][j].x + v[r][j].y * v[r][j].y) + (v[r][j].z * v[r][j].z + v[r][j].w * v[r][j].w);
        const float rr = 1.f / sqrtf(wave_sum(s) * (1.f / 1024.f) + RMS_EPS);
        if (m0 + r * ms < mend) { GAS unsigned long long* o8 = (GAS unsigned long long*)(O + (size_t)(m0 + r * ms) * DM) + lane;
#pragma unroll
            for (int j = 0; j < 4; ++j) o8[64 * j] = (unsigned long long)pk2(v[r][j].x * rr * gv[j].x, v[r][j].y * rr * gv[j].y) | ((unsigned long long)pk2(v[r][j].z * rr * gv[j].z, v[r][j].w * rr * gv[j].w) << 32); } }
}
__device__ __forceinline__ void cvt_row_to_bf16(const float* xrow, bf16* orow, int lane) {
    const GAS f32x4* xr = (const GAS f32x4*)xrow + lane; GAS unsigned long long* o8 = (GAS unsigned long long*)orow + lane;
    f32x4 v[4];
#pragma unroll
    for (int j = 0; j < 4; ++j) v[j] = xr[64 * j];
#pragma unroll
    for (int j = 0; j < 4; ++j) o8[64 * j] = (unsigned long long)pk2(v[j].x, v[j].y) | ((unsigned long long)pk2(v[j].z, v[j].w) << 32);
}
__device__ __forceinline__ int rel_bucket_dev(int d) {
    if (d < 16) return d;
    int b = 16;
    b += (d >= 21); b += (d >= 27); b += (d >= 35); b += (d >= 46); b += (d >= 59); b += (d >= 77); b += (d >= 99); b += (d >= 128);
    b += (d >= 166); b += (d >= 216); b += (d >= 280); b += (d >= 363); b += (d >= 470); b += (d >= 609); b += (d >= 790);
    return b;
}
struct P0Args { const float *x, *mem, *g_mix, *w_in, *rel_bias, *g_mem, *w_mem_kv, *w_br_attn, *w_br_conv, *w_br_x, *w_out, *g_ffn, *w_query, *sub_keys;
                bf16 *WinT, *WkvT, *WbrT, *WoutT, *WqT, *SK, *HN, *MEMN; float* TAB; };
__device__ __forceinline__ void p0_prologue(const P0Args& a, LAS unsigned char* lds, int gw, int NGW, int wave, int lane) {
    LAS float* scr = (LAS float*)(lds + RING_OFF + wave * 16384);
    constexpr int I_IN = (DM / 64) * (PW / 32), I_KV = (DM / 64) * (1024 / 32), I_BR = (512 / 64) * (1024 / 32), I_OUT = (DM / 64) * (1024 / 32), I_Q = (DM / 64) * (2048 / 32);
    constexpr int NITEMS = I_IN + I_KV + 3 * I_BR + I_OUT + I_Q;
    for (int it = gw; it < NITEMS; it += NGW) {
        int r = it;
        if (r < I_IN) { p0_transpose_item(a.w_in, DM, PW, a.WinT, 0, nullptr, scr, r, lane); continue; } r -= I_IN;
        if (r < I_KV) { p0_transpose_item(a.w_mem_kv, DM, 1024, a.WkvT, 0, nullptr, scr, r, lane); continue; } r -= I_KV;
        if (r < I_BR) { p0_transpose_item(a.w_br_attn, 512, 1024, a.WbrT, 0, nullptr, scr, r, lane); continue; } r -= I_BR;
        if (r < I_BR) { p0_transpose_item(a.w_br_conv, 512, 1024, a.WbrT, 1024, nullptr, scr, r, lane); continue; } r -= I_BR;
        if (r < I_BR) { p0_transpose_item(a.w_br_x, 512, 1024, a.WbrT, 2048, nullptr, scr, r, lane); continue; } r -= I_BR;
        if (r < I_OUT) { p0_transpose_item(a.w_out, DM, 1024, a.WoutT, 0, nullptr, scr, r, lane); continue; } r -= I_OUT;
        p0_transpose_item(a.w_query, DM, 2048, a.WqT, 0, a.g_ffn, scr, r, lane);
    }
    for (int m = gw; m < T; m += 4 * NGW) rms_rows_to_bf16<4>(a.x, a.g_mix, a.HN, m, NGW, T, lane);
    for (int m = gw; m < NBATCH * MEMLEN; m += NGW) rms_rows_to_bf16<1>(a.mem, a.g_mem, a.MEMN, m, NGW, NBATCH * MEMLEN, lane);
    for (int m = gw; m < 256; m += NGW) cvt_row_to_bf16(a.sub_keys + (size_t)m * 1024, a.SK + (size_t)m * 1024, lane);
    for (int m = gw; m < 256; m += NGW) {
        const int idx = m * 64 + lane, h = idx >> 11, d = idx & 2047;
        a.TAB[idx] = a.rel_bias[rel_bucket_dev(d) * 8 + h] * LOG2E;
    }
}

template <int DH> __device__ __forceinline__ void fix_item(bf16* buf, size_t pitch, int row0, int col0, const float* gain, float gscale, float* kmean, LAS float* red, int wave, int lane) {
    constexpr int LPR = DH / 8, RPI = 64 / LPR, NIT = 32 / RPI;
    const int sub = lane / LPR, ch = lane % LPR;
    float g[8], cs[8];
#pragma unroll
    for (int j = 0; j < 8; ++j) { g[j] = gain[ch * 8 + j] * gscale; cs[j] = 0.f; }
    v4u w[NIT];
#pragma unroll
    for (int it = 0; it < NIT; ++it) w[it] = *(const GAS v4u*)(buf + (size_t)(row0 + wave * 32 + it * RPI + sub) * pitch + col0 + ch * 8);
#pragma unroll
    for (int it = 0; it < NIT; ++it) {
        float x[8] = {bflo(w[it].x), bfhi(w[it].x), bflo(w[it].y), bfhi(w[it].y), bflo(w[it].z), bfhi(w[it].z), bflo(w[it].w), bfhi(w[it].w)};
        float ss = 0.f;
#pragma unroll
        for (int j = 0; j < 8; ++j) ss += x[j] * x[j];
#pragma unroll
        for (int o = 1; o < LPR; o <<= 1) ss += __shfl_xor(ss, o);
        const float r = 1.f / sqrtf(ss * (1.f / DH) + RMS_EPS);
#pragma unroll
        for (int j = 0; j < 8; ++j) { x[j] = x[j] * r * g[j]; cs[j] += x[j]; }
        v4u o; o.x = pk2(x[0], x[1]); o.y = pk2(x[2], x[3]); o.z = pk2(x[4], x[5]); o.w = pk2(x[6], x[7]);
        *(GAS v4u*)(buf + (size_t)(row0 + wave * 32 + it * RPI + sub) * pitch + col0 + ch * 8) = o;
    }
    if (kmean) {
#pragma unroll
        for (int j = 0; j < 8; ++j) {
#pragma unroll
            for (int o = LPR; o < 64; o <<= 1) cs[j] += __shfl_xor(cs[j], o);
        }
        if (sub == 0) {
#pragma unroll
            for (int j = 0; j < 8; ++j) red[wave * DH + ch * 8 + j] = cs[j];
        }
        asm volatile("s_waitcnt lgkmcnt(0)\n\ts_barrier" ::: "memory");
        if (wave == 0 && lane < DH) { float s = 0.f;
#pragma unroll
            for (int w8 = 0; w8 < 8; ++w8) s += red[w8 * DH + lane];
            kmean[lane] = s * (1.f / 256.f); }
        asm volatile("s_waitcnt lgkmcnt(0)\n\ts_barrier" ::: "memory");
    }
}
__device__ __forceinline__ void p2_fixup(bf16* PA, bf16* KVM, float* KMEAN, const float* q_gain_a, const float* k_gain_a, const float* q_gain_x, const float* k_gain_x, LAS unsigned char* lds, int vcu, int G, int wave, int lane) {
    constexpr int N_A = 512, N_X = 256, N_KX = 32, NIT = 2 * N_A + N_X + N_KX;
    LAS float* red = (LAS float*)lds;
    for (int it = vcu; it < NIT; it += G) {
        int r = it;
        if (r < N_A) { const int b = r >> 6, h = (r >> 3) & 7, n = r & 7;
            fix_item<64>(PA, PAW, b * SEQ + n * 256, COL_KA + h * 64, k_gain_a, 1.0f, KMEAN + (size_t)((b * 8 + h) * 8 + n) * 64, red, wave, lane); continue; } r -= N_A;
        if (r < N_A) { const int b = r >> 6, h = (r >> 3) & 7, n = r & 7;
            fix_item<64>(PA, PAW, b * SEQ + n * 256, COL_QA + h * 64, q_gain_a, C2A, nullptr, red, wave, lane); continue; } r -= N_A;
        if (r < N_X) { const int b = r >> 5, h = (r >> 3) & 3, n = r & 7;
            fix_item<128>(PA, PAW, b * SEQ + n * 256, COL_QX + h * 128, q_gain_x, C2X, nullptr, red, wave, lane); continue; } r -= N_X;
        { const int b = r >> 2, h = r & 3;
            fix_item<128>(KVM, 1024, b * MEMLEN, h * 128, k_gain_x, 1.0f, nullptr, red, wave, lane); }
    }
}

namespace att {
constexpr int L_K = 0, L_V = 16384, L_BUF = 32768  , L_OST = 0  ,
              L_TAB = 65536, TAB_PAD = 256, L_KM = L_TAB + (TAB_PAD + 2048) * 4, L_SEL = L_KM + 2048, L_WSF = L_SEL + 1024, L_END = L_WSF + NWAVES * 256;
static_assert(L_END <= RING_BYTES, "attention LDS map");
__device__ __forceinline__ int crow(int r, int hi) { return (r & 3) + 8 * (r >> 2) + 4 * hi; }
__device__ __forceinline__ void glds16(const void* gsrc, unsigned lds_dst) { unsigned keep;
    asm volatile("s_mov_b32 %0, m0\n\ts_mov_b32 m0, %2\n\ts_nop 0\n\tglobal_load_lds_dwordx4 %1, off\n\ts_mov_b32 m0, %0" : "=&s"(keep) : "v"(gsrc), "s"(lds_dst) : "memory"); }
__device__ __forceinline__ unsigned cvtpk(float lo, float hi) { typedef float f2 __attribute__((ext_vector_type(2))); typedef __bf16 b2 __attribute__((ext_vector_type(2))); f2 v = {lo, hi}; b2 b = __builtin_convertvector(v, b2); return __builtin_bit_cast(unsigned, b); }
__device__ __forceinline__ float rowmax(const f32x16& p0, const f32x16& p1) {
    float a = fmaxf(p0[0], p1[0]);
#pragma unroll
    for (int r = 1; r < 16; ++r) a = fmaxf(a, fmaxf(p0[r], p1[r]));
    auto rr = __builtin_amdgcn_permlane32_swap(__float_as_uint(a), __float_as_uint(a), false, false);
    return fmaxf(__uint_as_float(rr[0]), __uint_as_float(rr[1]));
}
template <int ND0> __device__ __forceinline__ void qkt(f32x16& p0, f32x16& p1, const LAS unsigned char* Kslot, const bf16x8* qr, int r32, int hi) {
    const LAS unsigned char* kb = Kslot + hi * 1024 + r32 * 16;
    p0 = f32x16{}; p1 = f32x16{};
#pragma unroll
    for (int d0 = 0; d0 < ND0; ++d0) {
        const bf16x8 b0 = *(const LAS bf16x8*)(kb + d0 * 2048);
        const bf16x8 b1 = *(const LAS bf16x8*)(kb + d0 * 2048 + 512);
        p0 = __builtin_amdgcn_mfma_f32_32x32x16_bf16(b0, qr[d0], p0, 0, 0, 0);
        p1 = __builtin_amdgcn_mfma_f32_32x32x16_bf16(b1, qr[d0], p1, 0, 0, 0);
    }
}
template <int NDB> __device__ __forceinline__ void pv(f32x16* o, int vb, bf16x8 pa0, bf16x8 pa1, bf16x8 pa2, bf16x8 pa3) {
#pragma unroll
    for (int d0 = 0; d0 < NDB; ++d0) { s16x4 lo[4], hi[4];
#pragma unroll
        for (int ks = 0; ks < 4; ++ks) {
            asm volatile("ds_read_b64_tr_b16 %0,%1 offset:%c2" : "=&v"(lo[ks]) : "v"(vb), "i"(d0 * 4096 + ks * 1024) : "memory");
            asm volatile("ds_read_b64_tr_b16 %0,%1 offset:%c2" : "=&v"(hi[ks]) : "v"(vb), "i"(d0 * 4096 + ks * 1024 + 512) : "memory"); }
        asm volatile("s_waitcnt lgkmcnt(0)" ::: "memory"); __builtin_amdgcn_sched_barrier(0);
#define ATT_PK(k) (bf16x8){lo[k][0], lo[k][1], lo[k][2], lo[k][3], hi[k][0], hi[k][1], hi[k][2], hi[k][3]}
        o[d0] = __builtin_amdgcn_mfma_f32_32x32x16_bf16(pa0, ATT_PK(0), o[d0], 0, 0, 0);
        o[d0] = __builtin_amdgcn_mfma_f32_32x32x16_bf16(pa1, ATT_PK(1), o[d0], 0, 0, 0);
        o[d0] = __builtin_amdgcn_mfma_f32_32x32x16_bf16(pa2, ATT_PK(2), o[d0], 0, 0, 0);
        o[d0] = __builtin_amdgcn_mfma_f32_32x32x16_bf16(pa3, ATT_PK(3), o[d0], 0, 0, 0);
#undef ATT_PK
    }
}
#define ATT_BAR() asm volatile("s_waitcnt lgkmcnt(0)\n\ts_barrier" ::: "memory")
#define ATT_WAIT_BAR() asm volatile("s_waitcnt vmcnt(0) lgkmcnt(0)\n\ts_barrier" ::: "memory")

template <int DH, bool MOBA> __device__ __forceinline__ void attn_unit(const bf16* Qp, size_t qpitch, const bf16* Kp, const bf16* Vp, size_t kpitch, bf16* Op, int qb, const float* kmean_bh, const float* tab_h, const float* gq, const float* gk,
                                                                   LAS unsigned char* lds, int tid, int wid, int lane) {
    constexpr int ND0 = DH / 16, NDB = DH / 32, NPIECE = DH / 64;
    asm volatile("" : "+v"(tid), "+v"(lane));
    const int r32 = lane & 31, hi = lane >> 5;
    const unsigned lds0 = (unsigned)(uintptr_t)lds;
    LAS float* wsf = (LAS float*)(lds + L_WSF) + wid * 64;
    ATT_BAR();
    int my_sel = 0;
    if (MOBA) {
        LAS float* tl = (LAS float*)(lds + L_TAB);
        for (int i = tid; i < TAB_PAD + 2048; i += NWAVES * 64) tl[i] = (i < TAB_PAD) ? 0.f : tab_h[i - TAB_PAD];
        LAS float* km = (LAS float*)(lds + L_KM);
        for (int i = tid; i < 512; i += NWAVES * 64) km[i] = kmean_bh[i];
        ATT_BAR();
        if (tid < 256) {
            int sel = 0;
            if (qb <= 3) sel = (1 << qb) - 1;
            else {
                const GAS v4u* qrow = (const GAS v4u*)(Qp + (size_t)tid * qpitch);
                v4u qw[8];
#pragma unroll
                for (int c = 0; c < 8; ++c) qw[c] = qrow[c];
                float b1 = -INFINITY, b2 = -INFINITY, b3 = -INFINITY; int i1 = 0, i2 = 0, i3 = 0;
#pragma unroll 1
                for (int n = 0; n < qb; ++n) { float s = 0.f; const LAS f32x4* kr = (const LAS f32x4*)(km + n * 64);
#pragma unroll
                    for (int c = 0; c < 8; ++c) { const f32x4 ka = kr[2 * c], kb2 = kr[2 * c + 1]; const v4u w = qw[c];
                        s += bflo(w.x) * ka.x; s += bfhi(w.x) * ka.y; s += bflo(w.y) * ka.z; s += bfhi(w.y) * ka.w;
                        s += bflo(w.z) * kb2.x; s += bfhi(w.z) * kb2.y; s += bflo(w.w) * kb2.z; s += bfhi(w.w) * kb2.w; }
                    if (s > b1) { b3 = b2; i3 = i2; b2 = b1; i2 = i1; b1 = s; i1 = n; }
                    else if (s > b2) { b3 = b2; i3 = i2; b2 = s; i2 = n; }
                    else if (s > b3) { b3 = s; i3 = n; } }
                sel = (1 << i1) | (1 << i2) | (1 << i3);
            }
            ((LAS int*)(lds + L_SEL))[tid] = sel;
        }
        ATT_BAR();
        my_sel = ((LAS int*)(lds + L_SEL))[wid * 32 + r32];
    }
    bf16x8 qr[ND0];
    { const bf16* Qw = Qp + (size_t)(wid * 32 + r32) * qpitch + hi * 8;
#pragma unroll
      for (int d0 = 0; d0 < ND0; ++d0) qr[d0] = *(const GAS bf16x8*)(Qw + d0 * 16); }
    if (!MOBA) {
        LAS float* rk = (LAS float*)(lds + L_KM);
        { const int key = tid >> 1, half = tid & 1; const GAS v4u* kr = (const GAS v4u*)(Kp + (size_t)key * kpitch + half * 64); float ss = 0.f;
#pragma unroll
          for (int c = 0; c < 8; ++c) { const v4u w = kr[c]; const float a0 = bflo(w.x), a1 = bfhi(w.x), a2 = bflo(w.y), a3 = bfhi(w.y), a4 = bflo(w.z), a5 = bfhi(w.z), a6 = bflo(w.w), a7 = bfhi(w.w);
              ss += (a0 * a0 + a1 * a1) + (a2 * a2 + a3 * a3) + (a4 * a4 + a5 * a5) + (a6 * a6 + a7 * a7); }
          ss += __shfl_xor(ss, 1);
          if (half == 0) rk[key] = 1.0f / sqrtf(ss * (1.f / 128.f) + RMS_EPS); }
        float qs = 0.f;
#pragma unroll
        for (int d0 = 0; d0 < ND0; ++d0) { const v4u w = __builtin_bit_cast(v4u, qr[d0]); const float a0 = bflo(w.x), a1 = bfhi(w.x), a2 = bflo(w.y), a3 = bfhi(w.y), a4 = bflo(w.z), a5 = bfhi(w.z), a6 = bflo(w.w), a7 = bfhi(w.w);
            qs += (a0 * a0 + a1 * a1) + (a2 * a2 + a3 * a3) + (a4 * a4 + a5 * a5) + (a6 * a6 + a7 * a7); }
        { auto rr = __builtin_amdgcn_permlane32_swap(__float_as_uint(qs), __float_as_uint(qs), false, false); qs = __uint_as_float(rr[0]) + __uint_as_float(rr[1]); }
        const float rq = C2X / sqrtf(qs * (1.f / 128.f) + RMS_EPS);
        int hi8 = hi * 8; asm volatile("" : "+v"(hi8));
#pragma unroll
        for (int d0 = 0; d0 < ND0; ++d0) { const v4u w = __builtin_bit_cast(v4u, qr[d0]);
            const f32x4 ga = *(const GAS f32x4*)(gq + d0 * 16 + hi8), gb = *(const GAS f32x4*)(gq + d0 * 16 + hi8 + 4), ka = *(const GAS f32x4*)(gk + d0 * 16 + hi8), kb2 = *(const GAS f32x4*)(gk + d0 * 16 + hi8 + 4);
            v4u o; o.x = cvtpk(bflo(w.x) * rq * ga.x * ka.x, bfhi(w.x) * rq * ga.y * ka.y); o.y = cvtpk(bflo(w.y) * rq * ga.z * ka.z, bfhi(w.y) * rq * ga.w * ka.w);
            o.z = cvtpk(bflo(w.z) * rq * gb.x * kb2.x, bfhi(w.z) * rq * gb.y * kb2.y); o.w = cvtpk(bflo(w.w) * rq * gb.z * kb2.z, bfhi(w.w) * rq * gb.w * kb2.w);
            qr[d0] = __builtin_bit_cast(bf16x8, o); }
    }
    float m_run = -INFINITY, l_run = 0.f;
    f32x16 o[NDB];
#pragma unroll
    for (int d = 0; d < NDB; ++d) o[d] = f32x16{};
    const int vb0 = (int)(lds0 + L_V) + ((lane >> 4) & 1) * 32 + (lane & 3) * 8 + (4 * hi + ((lane & 15) >> 2)) * 64;
    const int qrel = wid * 32 + r32;
    const int ntiles = MOBA ? 4 + 4 * qb : 4;
    auto issue_tile = [&](int tt) {
        int kb_, j_; if (MOBA) { if (tt < 4) { kb_ = qb; j_ = tt; } else { kb_ = (tt - 4) >> 2; j_ = (tt - 4) & 3; } } else { kb_ = 0; j_ = tt; }
        const int key0_ = kb_ * 256 + j_ * 64; const unsigned bo = (unsigned)(tt & 1) * L_BUF;
#pragma unroll
        for (int pc = 0; pc < NPIECE; ++pc) { const int p = wid + 8 * pc;
            glds16(Kp + (size_t)(key0_ + lane) * kpitch + p * 8, (unsigned)__builtin_amdgcn_readfirstlane(lds0 + bo + L_K + p * 1024));
            glds16(Vp + (size_t)(key0_ + 16 * (p & 3) + (lane >> 2)) * kpitch + (p >> 2) * 32 + (lane & 3) * 8, (unsigned)__builtin_amdgcn_readfirstlane(lds0 + bo + L_V + p * 1024)); }
    };
    issue_tile(0);
    for (int tt = 0; tt < ntiles; ++tt) {
        int kb, j; bool own;
        if (MOBA) { if (tt < 4) { kb = qb; j = tt; own = true; } else { kb = (tt - 4) >> 2; j = (tt - 4) & 3; own = false; } }
        else { kb = 0; j = tt; own = false; }
        ATT_WAIT_BAR();
        if (tt + 1 < ntiles) issue_tile(tt + 1);
        if (MOBA && own && 64 * j > wid * 32 + 31) continue;
        const unsigned bo = (unsigned)(tt & 1) * L_BUF;
        f32x16 p0, p1;
        qkt<ND0>(p0, p1, lds + bo + L_K, qr, r32, hi);
        if (MOBA) {
            const int dbase = (qb - kb) * 256 + qrel - 64 * j - 4 * hi;
            const LAS float* tp = (const LAS float*)(lds + L_TAB) + TAB_PAD + dbase - 63;
            const float lane_neg = (own || (((my_sel >> kb) & 1) != 0)) ? 0.f : -INFINITY;
            float bz0[16], bz1[16];
#pragma unroll
            for (int r = 0; r < 16; ++r) { const int c = (r & 3) + 8 * (r >> 2); bz0[r] = tp[63 - c]; bz1[r] = tp[31 - c]; }
#pragma unroll
            for (int r = 0; r < 16; ++r) { const int c = (r & 3) + 8 * (r >> 2);
                const float n0 = own ? ((dbase - c >= 0) ? 0.f : -INFINITY) : lane_neg, n1 = own ? ((dbase - c - 32 >= 0) ? 0.f : -INFINITY) : lane_neg;
                p0[r] = (p0[r] + bz0[r]) + n0; p1[r] = (p1[r] + bz1[r]) + n1; }
        }
        if (!MOBA) { const LAS float* rkp = (const LAS float*)(lds + L_KM) + j * 64 + 4 * hi;
#pragma unroll
            for (int r = 0; r < 16; ++r) { const int c = (r & 3) + 8 * (r >> 2); p0[r] *= rkp[c]; p1[r] *= rkp[c + 32]; } }
        const float rm = rowmax(p0, p1);
        const float m_new = fmaxf(m_run, rm);
        const float alpha = __builtin_amdgcn_exp2f(m_run - m_new);
        float ps = 0.f;
#pragma unroll
        for (int r = 0; r < 16; ++r) { p0[r] = __builtin_amdgcn_exp2f(p0[r] - m_new); p1[r] = __builtin_amdgcn_exp2f(p1[r] - m_new); ps += p0[r] + p1[r]; }
        l_run = l_run * alpha + ps;
        if (!__all(m_new == m_run)) {
            if (hi == 0) wsf[r32] = alpha;
            LDS_WAIT();
#pragma unroll
            for (int r = 0; r < 16; ++r) { const float f = wsf[crow(r, hi)];
#pragma unroll
                for (int d = 0; d < NDB; ++d) o[d][r] *= f; }
        }
        m_run = m_new;
        v4u pw0, pw1, pw2, pw3;
        pw0 = (v4u){cvtpk(p0[0], p0[1]), cvtpk(p0[2], p0[3]), cvtpk(p0[4], p0[5]), cvtpk(p0[6], p0[7])};
        pw1 = (v4u){cvtpk(p0[8], p0[9]), cvtpk(p0[10], p0[11]), cvtpk(p0[12], p0[13]), cvtpk(p0[14], p0[15])};
        pw2 = (v4u){cvtpk(p1[0], p1[1]), cvtpk(p1[2], p1[3]), cvtpk(p1[4], p1[5]), cvtpk(p1[6], p1[7])};
        pw3 = (v4u){cvtpk(p1[8], p1[9]), cvtpk(p1[10], p1[11]), cvtpk(p1[12], p1[13]), cvtpk(p1[14], p1[15])};
        pv<NDB>(o, vb0 + (int)bo, __builtin_bit_cast(bf16x8, pw0), __builtin_bit_cast(bf16x8, pw1), __builtin_bit_cast(bf16x8, pw2), __builtin_bit_cast(bf16x8, pw3));
    }
    { auto rr = __builtin_amdgcn_permlane32_swap(__float_as_uint(l_run), __float_as_uint(l_run), false, false); l_run = __uint_as_float(rr[0]) + __uint_as_float(rr[1]); }
    if (hi == 0) wsf[32 + r32] = l_run;
    ATT_BAR();
    LAS bf16* stg = (LAS bf16*)(lds + L_OST + wid * 8192);
#pragma unroll
    for (int r = 0; r < 16; ++r) { const int orow = crow(r, hi); const float rl = __builtin_amdgcn_rcpf(wsf[32 + orow]);
#pragma unroll
        for (int d = 0; d < NDB; ++d) stg[orow * DH + d * 32 + r32] = (bf16)f2bf(o[d][r] * rl); }
    LDS_WAIT();
    constexpr int CPR = DH / 8;
    int lane2 = lane; asm volatile("" : "+v"(lane2));
#pragma unroll
    for (int i = 0; i < (32 * CPR) / 64; ++i) { const int idx = i * 64 + lane2, row = idx / CPR, ch = idx % CPR;
        const v4u v = *(const LAS v4u*)(stg + row * DH + ch * 8);
        *(GAS v4u*)(Op + (size_t)(wid * 32 + row) * 512 + ch * 8) = v; }
}
#undef ATT_BAR
#undef ATT_WAIT_BAR
}

__device__ __forceinline__ void conv_item(const bf16* PA, const float* conv_w, bf16* CO, int item, int tid) {
    asm volatile("" : "+v"(tid));
    const int ch = (tid & 63) * 8, r0 = item * 64 + (tid >> 6) * 8;
    float w0[8], w1[8], w2[8];
#pragma unroll
    for (int j = 0; j < 8; ++j) { w0[j] = conv_w[ch + j]; w1[j] = conv_w[512 + ch + j]; w2[j] = conv_w[1024 + ch + j]; }
    float pm2[8], pm1[8];
#pragma unroll
    for (int j = 0; j < 8; ++j) { pm2[j] = 0.f; pm1[j] = 0.f; }
    auto load8 = [&](int row, int col, float* o) { const v4u w = *(const GAS v4u*)(PA + (size_t)row * PAW + col + ch);
        o[0] = bflo(w.x); o[1] = bfhi(w.x); o[2] = bflo(w.y); o[3] = bfhi(w.y); o[4] = bflo(w.z); o[5] = bfhi(w.z); o[6] = bflo(w.w); o[7] = bfhi(w.w); };
    const int s0 = r0 & (SEQ - 1);
    if (s0 >= 2) { float a[8], b[8]; load8(r0 - 2, COL_CC, a); load8(r0 - 2, COL_UC, b);
#pragma unroll
        for (int j = 0; j < 8; ++j) pm2[j] = a[j] * b[j]; }
    if (s0 >= 1) { float a[8], b[8]; load8(r0 - 1, COL_CC, a); load8(r0 - 1, COL_UC, b);
#pragma unroll
        for (int j = 0; j < 8; ++j) pm1[j] = a[j] * b[j]; }
#pragma unroll
    for (int i = 0; i < 8; ++i) { const int row = r0 + i; float c[8], u[8], bb[8], y[8];
        load8(row, COL_CC, c); load8(row, COL_UC, u); load8(row, COL_BC, bb);
#pragma unroll
        for (int j = 0; j < 8; ++j) { const float cur = c[j] * u[j]; y[j] = bb[j] * (w0[j] * pm2[j] + w1[j] * pm1[j] + w2[j] * cur); pm2[j] = pm1[j]; pm1[j] = cur; }
        v4u o; o.x = pk2(y[0], y[1]); o.y = pk2(y[2], y[3]); o.z = pk2(y[4], y[5]); o.w = pk2(y[6], y[7]);
        *(GAS v4u*)(CO + (size_t)row * 512 + ch) = o; }
}

namespace pk {
template <int N> __device__ __forceinline__ void bsort_desc(unsigned (&a)[N]) {
#pragma unroll
    for (int k = 2; k <= N; k <<= 1) {
#pragma unroll
        for (int j = k >> 1; j > 0; j >>= 1) {
#pragma unroll
            for (int i = 0; i < N; ++i) { const int l = i ^ j;
                if (l > i) { const unsigned x = a[i], y = a[l]; const unsigned mx = x > y ? x : y, mn = x > y ? y : x;
                    if ((i & k) == 0) { a[i] = mx; a[l] = mn; } else { a[i] = mn; a[l] = mx; } } } } }
}
template <int N> __device__ __forceinline__ void bmerge_desc(unsigned (&a)[N]) {
#pragma unroll
    for (int j = N >> 1; j > 0; j >>= 1) {
#pragma unroll
        for (int i = 0; i < N; ++i) { const int l = i ^ j; if (l > i) { const unsigned x = a[i], y = a[l]; a[i] = x > y ? x : y; a[l] = x > y ? y : x; } } }
}
__device__ __forceinline__ void top16_merge(unsigned (&x)[16], const unsigned (&y)[16]) {
#pragma unroll
    for (int i = 0; i < 16; ++i) x[i] = x[i] > y[15 - i] ? x[i] : y[15 - i];
    bmerge_desc<16>(x);
}
__device__ __forceinline__ unsigned f2ord(float f) { const unsigned u = __float_as_uint(f); return u ^ ((unsigned)((int)u >> 31) | 0x80000000u); }
__device__ __forceinline__ float ord2f(unsigned o) { return __uint_as_float(o ^ ((o & 0x80000000u) ? 0x80000000u : 0xFFFFFFFFu)); }

constexpr int L_TBL = 0;
__device__ __forceinline__ void topk_unit(const bf16* QRY, const bf16* SK, const float* SLOTS, unsigned* SEL, LAS unsigned char* lds, int v, int tid, int wid, int lane) {
    const int hp = v & 3, t0 = ((v >> 2) * 8 + wid) * 32, r32 = lane & 31, hi = lane >> 5;
    for (int tb = 0; tb < 4; ++tb) { const bf16* src = SK + (size_t)(((2 * hp + (tb >> 1)) * 2 + (tb & 1)) * 128) * 128;
        for (int idx = tid; idx < 2048; idx += NWAVES * 64) { const int key = idx >> 4, c16 = idx & 15;
            const v4u w = *(const GAS v4u*)(src + key * 128 + c16 * 8);
            *(LAS v4u*)(lds + L_TBL + tb * 32768 + (c16 * 4 + (key >> 5)) * 512 + (key & 31) * 16) = w; } }
    asm volatile("s_waitcnt vmcnt(0) lgkmcnt(0)\n\ts_barrier" ::: "memory");
    const int tok = t0 + r32;
    float rn; { const GAS f32x4* sl = (const GAS f32x4*)(SLOTS + (size_t)tok * 16); const f32x4 a = sl[0], b = sl[1], c = sl[2], d = sl[3];
        const float ss = ((a.x + a.y) + (a.z + a.w)) + ((b.x + b.y) + (b.z + b.w)) + ((c.x + c.y) + (c.z + c.w)) + ((d.x + d.y) + (d.z + d.w));
        rn = 1.f / sqrtf(ss * (1.f / 1024.f) + RMS_EPS); }
    unsigned L[4][16];
#pragma unroll
    for (int tb = 0; tb < 4; ++tb) {
        const int hh = tb >> 1, p = tb & 1;
        const bf16* qp = QRY + (size_t)tok * 2048 + ((2 * hp + hh) * 2 + p) * 128 + hi * 8;
        bf16x8 qf[8];
#pragma unroll
        for (int kk = 0; kk < 8; ++kk) qf[kk] = *(const GAS bf16x8*)(qp + kk * 16);
        f32x16 acc[4];
#pragma unroll
        for (int blk = 0; blk < 4; ++blk) acc[blk] = f32x16{};
        const LAS unsigned char* tbase = lds + L_TBL + tb * 32768 + hi * 2048 + r32 * 16;
#pragma unroll
        for (int kk = 0; kk < 8; ++kk)
#pragma unroll
            for (int blk = 0; blk < 4; ++blk) { const bf16x8 af = *(const LAS bf16x8*)(tbase + kk * 4096 + blk * 512);
                acc[blk] = __builtin_amdgcn_mfma_f32_32x32x16_bf16(af, qf[kk], acc[blk], 0, 0, 0); }
        unsigned g[4][16];
#pragma unroll
        for (int blk = 0; blk < 4; ++blk)
#pragma unroll
            for (int r = 0; r < 16; ++r) g[blk][r] = (f2ord(acc[blk][r]) & ~127u) | (unsigned)(127 - (32 * blk + (r & 3) + 8 * (r >> 2)));
#pragma unroll
        for (int blk = 0; blk < 4; ++blk) bsort_desc<16>(g[blk]);
        top16_merge(g[0], g[1]); top16_merge(g[2], g[3]); top16_merge(g[0], g[2]);
#pragma unroll
        for (int i = 0; i < 16; ++i) L[tb][i] = g[0][i] ^ (unsigned)(4 * hi);
    }
    unsigned A[2][16];
#pragma unroll
    for (int p = 0; p < 2; ++p) {
        unsigned X[16], Y[16];
#pragma unroll
        for (int i = 0; i < 16; ++i) { auto rr = __builtin_amdgcn_permlane32_swap(L[p][i], L[2 + p][i], false, false); X[i] = rr[0]; Y[i] = rr[1]; }
        top16_merge(X, Y);
#pragma unroll
        for (int i = 0; i < 16; ++i) A[p][i] = X[i];
    }
    float f0[16], f1[16];
#pragma unroll
    for (int i = 0; i < 16; ++i) { f0[i] = ord2f(A[0][i] & ~127u); f1[i] = ord2f(A[1][i] & ~127u); }
    float sums[50]; unsigned keys[50];
    { int c = 0;
#pragma unroll
      for (int i = 0; i < 16; ++i)
#pragma unroll
          for (int j = 0; j < 16; ++j) if ((i + 1) * (j + 1) <= 16) { sums[c] = f0[i] + f1[j]; keys[c] = (f2ord(sums[c]) & ~63u) | (unsigned)(63 - c); ++c; } }
    unsigned G0[16], R[32];
#pragma unroll
    for (int i = 0; i < 16; ++i) G0[i] = keys[i];
#pragma unroll
    for (int i = 0; i < 32; ++i) R[i] = (i < 26) ? keys[24 + i] : 0u;
    bsort_desc<32>(R);
#pragma unroll
    for (int i = 0; i < 16; ++i) G0[i] = G0[i] > R[15 - i] ? G0[i] : R[15 - i];
    bmerge_desc<16>(G0);
#pragma unroll
    for (int i = 8; i < 16; ++i) G0[i] = G0[i] > keys[16 + 15 - i] ? G0[i] : keys[16 + 15 - i];
    unsigned thr = G0[0];
#pragma unroll
    for (int i = 1; i < 16; ++i) thr = thr < G0[i] ? thr : G0[i];
    const float s00 = sums[0], sc = rn * LOG2E;
    float w[50]; float den = 0.f;
#pragma unroll
    for (int c = 0; c < 50; ++c) { w[c] = (keys[c] >= thr) ? __builtin_amdgcn_exp2f((sums[c] - s00) * sc) : 0.f; den += w[c]; }
    const float inv = 1.f / den;
    unsigned i0[16], i1[16];
#pragma unroll
    for (int i = 0; i < 16; ++i) { i0[i] = 127u - (A[0][i] & 127u); i1[i] = 127u - (A[1][i] & 127u); }
    GAS unsigned* outp = (GAS unsigned*)(SEL + ((size_t)tok * 8 + 2 * hp + hi) * 16);
    int pos = 0;
    { int c = 0;
#pragma unroll
      for (int i = 0; i < 16; ++i)
#pragma unroll
          for (int j = 0; j < 16; ++j) if ((i + 1) * (j + 1) <= 16) { if (keys[c] >= thr) { outp[pos & 15] = ((i0[i] * 128u + i1[j]) << 16) | f2bf(w[c] * inv); ++pos; } ++c; } }
}
}

constexpr size_t SLICE_BYTES = (size_t)NEXP * 128;
template <bool OFFSET, int NR> __device__ __forceinline__ void quant_rows_sliced(const float* X, unsigned char* qtab, float* scale, int e0, int es, int eend, int lane) {
    f32x4 v[NR][4];
#pragma unroll
    for (int r = 0; r < NR; ++r) { const int e = (e0 + r * es < eend) ? e0 + r * es : eend - 1; const GAS f32x4* xr = (const GAS f32x4*)(X + (size_t)e * DM) + 4 * lane;
#pragma unroll
        for (int j = 0; j < 4; ++j) v[r][j] = xr[j]; }
#pragma unroll
    for (int r = 0; r < NR; ++r) { float am = 0.f;
#pragma unroll
        for (int j = 0; j < 4; ++j) am = fmaxf(am, fmaxf(fmaxf(fabsf(v[r][j].x), fabsf(v[r][j].y)), fmaxf(fabsf(v[r][j].z), fabsf(v[r][j].w))));
#pragma unroll
        for (int o = 1; o < 64; o <<= 1) am = fmaxf(am, __shfl_xor(am, o));
        const float s = am > 0.f ? am * (1.f / 127.f) : 1.f, is = 1.f / s;
        v4u o;
#pragma unroll
        for (int j = 0; j < 4; ++j) { const int a = (int)rintf(v[r][j].x * is), b = (int)rintf(v[r][j].y * is), c = (int)rintf(v[r][j].z * is), d = (int)rintf(v[r][j].w * is);
            const int off = OFFSET ? 128 : 0;
            o[j] = (unsigned)((a + off) & 0xff) | ((unsigned)((b + off) & 0xff) << 8) | ((unsigned)((c + off) & 0xff) << 16) | ((unsigned)((d + off) & 0xff) << 24); }
        const int e = e0 + r * es;
        if (e < eend) { *(GAS v4u*)(qtab + (size_t)(lane >> 3) * SLICE_BYTES + (size_t)e * 128 + (lane & 7) * 16) = o; if (lane == 0) scale[e] = s; } }
}
template <int NR> __device__ __forceinline__ void quant_x(const float* H, unsigned char* XQ, float* SX, const float (&gf)[16], int t0, int ts, int lane) {
    f32x4 hv[NR][4];
#pragma unroll
    for (int r = 0; r < NR; ++r) { const int t = (t0 + r * ts < T) ? t0 + r * ts : T - 1; const GAS f32x4* hrow = (const GAS f32x4*)(H + (size_t)t * DM) + 4 * lane;
#pragma unroll
        for (int j = 0; j < 4; ++j) hv[r][j] = hrow[j]; }
#pragma unroll
    for (int r = 0; r < NR; ++r) { float ss = 0.f;
#pragma unroll
        for (int j = 0; j < 4; ++j) ss += (hv[r][j].x * hv[r][j].x + hv[r][j].y * hv[r][j].y) + (hv[r][j].z * hv[r][j].z + hv[r][j].w * hv[r][j].w);
        const float rn = 1.f / sqrtf(wave_sum(ss) * (1.f / 1024.f) + RMS_EPS);
        float xn[16]; float am = 0.f;
#pragma unroll
        for (int j = 0; j < 4; ++j)
#pragma unroll
            for (int e = 0; e < 4; ++e) { xn[4 * j + e] = hv[r][j][e] * rn * gf[4 * j + e]; am = fmaxf(am, fabsf(xn[4 * j + e])); }
#pragma unroll
        for (int o = 1; o < 64; o <<= 1) am = fmaxf(am, __shfl_xor(am, o));
        const float sx = am > 0.f ? am * (1.f / 127.f) : 1.f, isx = 1.f / sx;
        v4u o;
#pragma unroll
        for (int j = 0; j < 4; ++j) { const int a = (int)rintf(xn[4 * j] * isx), b = (int)rintf(xn[4 * j + 1] * isx), c = (int)rintf(xn[4 * j + 2] * isx), d = (int)rintf(xn[4 * j + 3] * isx);
            o[j] = (unsigned)(a & 0xff) | ((unsigned)(b & 0xff) << 8) | ((unsigned)(c & 0xff) << 16) | ((unsigned)(d & 0xff) << 24); }
        const int t = t0 + r * ts;
        if (t < T) { *((GAS v4u*)(XQ + (size_t)t * DM) + lane) = o; if (lane == 0) SX[t] = sx; } }
}
__device__ __forceinline__ float gelu_exact(float x) { return 0.5f * x * (1.0f + erff(x * 0.70710678118654752f)); }
__device__ __forceinline__ int dpp_i(int v, int ctrl_is) {
    return ctrl_is == 0 ? __builtin_amdgcn_update_dpp(0, v, 0x141, 0xf, 0xf, true) : ctrl_is == 1 ? __builtin_amdgcn_update_dpp(0, v, 0xB1, 0xf, 0xf, true) : __builtin_amdgcn_update_dpp(0, v, 0x4E, 0xf, 0xf, true);
}
constexpr int QCHUNK = 8;
__device__ __forceinline__ int q_take(unsigned* q, int lane) {
    unsigned v = 0; if (lane == 0) v = __hip_atomic_fetch_add(q, (unsigned)QCHUNK, __ATOMIC_RELAXED, __HIP_MEMORY_SCOPE_AGENT);
    return (int)__builtin_amdgcn_readfirstlane(v);
}
struct TokStream {
    unsigned* q; int cur, end, nxt;
    __device__ __forceinline__ void open(unsigned* q_, int lane) { q = q_; cur = q_take(q, lane); end = cur + QCHUNK; nxt = q_take(q, lane); }
    __device__ __forceinline__ int next(int lane) { const int t = cur; if (t >= T) return T; ++cur; if (cur == end) { cur = nxt; end = cur + QCHUNK; if (cur < T) nxt = q_take(q, lane); } return t; }
};
struct UMeta { unsigned E[16]; v4u xq; };
__device__ __forceinline__ void u_meta(UMeta& m, const unsigned* SEL, const unsigned char* XQ, int t, int x, int grp, int ch) {
#pragma unroll
    for (int g = 0; g < 16; ++g) m.E[g] = *(const GAS unsigned*)(SEL + (size_t)t * 128 + g * 8 + grp);
    m.xq = *(const GAS v4u*)(XQ + (size_t)t * DM + x * 128 + ch * 16);
}
__device__ __forceinline__ void u_rows(v4u (&w)[16], const UMeta& m, const unsigned char* tab, unsigned choff) {
#pragma unroll
    for (int g = 0; g < 16; ++g) w[g] = *(const GAS v4u*)(tab + (unsigned)((m.E[g] >> 16) * 128u + choff));
}
__device__ __forceinline__ void u_compute(const v4u (&w)[16], const v4u xc, int* prow, int grp, int c0, int c1, int c2) {
    int p[16];
#pragma unroll
    for (int g = 0; g < 16; ++g) { int a = __builtin_amdgcn_sdot4((int)w[g].x, (int)xc.x, 0, false); a = __builtin_amdgcn_sdot4((int)w[g].y, (int)xc.y, a, false);
        a = __builtin_amdgcn_sdot4((int)w[g].z, (int)xc.z, a, false); p[g] = __builtin_amdgcn_sdot4((int)w[g].w, (int)xc.w, a, false); }
    int q8[8], q4[4], q2[2];
#pragma unroll
    for (int i = 0; i < 8; ++i) { const int keep = c2 ? p[i + 8] : p[i], send = c2 ? p[i] : p[i + 8]; q8[i] = keep + dpp_i(send, 0); }
#pragma unroll
    for (int i = 0; i < 4; ++i) { const int keep = c0 ? q8[i + 4] : q8[i], send = c0 ? q8[i] : q8[i + 4]; q4[i] = keep + dpp_i(send, 1); }
#pragma unroll
    for (int i = 0; i < 2; ++i) { const int keep = c1 ? q4[i + 2] : q4[i], send = c1 ? q4[i] : q4[i + 2]; q2[i] = keep + dpp_i(send, 2); }
    const int g0 = 8 * c2 + 4 * c0 + 2 * c1;
    __builtin_nontemporal_store(q2[0], prow + g0 * 8 + grp); __builtin_nontemporal_store(q2[1], prow + (g0 + 1) * 8 + grp);
}
__device__ __forceinline__ void gather_u(const unsigned* SEL, const unsigned char* XQ, const unsigned char* UQS, int* PART, int* dummy, unsigned* queues, int xcc, int lane) {
    const int grp = lane >> 3, ch = lane & 7, c0 = ch & 1, c1 = (ch >> 1) & 1, c2 = (ch >> 2) & 1;
    for (int qi = 0; qi < 8; ++qi) { const int x = (xcc + qi) & 7;
        const unsigned char* tab = UQS + (size_t)x * SLICE_BYTES; const unsigned choff = (unsigned)ch * 16u;
        int* part = PART + (size_t)x * T * 128;
        TokStream S; S.open(queues + 64 * x, lane);
        int tA = S.next(lane), tB = S.next(lane);
        if (tA >= T) continue;
        UMeta M; v4u W0[16], W1[16]; v4u X0, X1;
        u_meta(M, SEL, XQ, tA, x, grp, ch); u_rows(W0, M, tab, choff); X0 = M.xq;
        u_meta(M, SEL, XQ, tB < T ? tB : T - 1, x, grp, ch);
        while (tA < T) {
            const int tC = S.next(lane);
            u_rows(W1, M, tab, choff); X1 = M.xq;
            u_meta(M, SEL, XQ, tC < T ? tC : T - 1, x, grp, ch);
            u_compute(W0, X0, part + (size_t)tA * 128, grp, c0, c1, c2);
            const int tD = S.next(lane);
            u_rows(W0, M, tab, choff); X0 = M.xq;
            u_meta(M, SEL, XQ, tD < T ? tD : T - 1, x, grp, ch);
            u_compute(W1, X1, tB < T ? part + (size_t)tB * 128 : dummy, grp, c0, c1, c2);
            tA = tC; tB = tD;
        }
    }
}
__device__ __forceinline__ void gather_coef(const unsigned* SEL, const int* PART, const float* SU, const float* SV, const float* SX, unsigned* COEF, float* CS, int t, int lane) {
    typedef int i2 __attribute__((ext_vector_type(2)));
    const v2u ent = *(const GAS v2u*)(SEL + (size_t)t * 128 + 2 * lane);
    i2 acc = {0, 0};
#pragma unroll
    for (int x = 0; x < 8; ++x) { const i2 pp = *(const GAS i2*)(PART + ((size_t)x * T + t) * 128 + 2 * lane); acc += pp; }
    const unsigned e0 = ent.x >> 16, e1 = ent.y >> 16;
    const float su0 = SU[e0], sv0 = SV[e0], su1 = SU[e1], sv1 = SV[e1];
    const float sx = __hip_atomic_load(SX + t, __ATOMIC_RELAXED, __HIP_MEMORY_SCOPE_AGENT);
    const float k0 = bflo(ent.x) * gelu_exact((float)acc.x * (su0 * sx)) * sv0, k1 = bflo(ent.y) * gelu_exact((float)acc.y * (su1 * sx)) * sv1;
    const unsigned w0 = (e0 << 16) | f2bf(k0), w1 = (e1 << 16) | f2bf(k1);
    *(GAS v2u*)(COEF + (size_t)t * 128 + 2 * lane) = (v2u){w0, w1};
    const float cs = wave_sum(bflo(w0) + bflo(w1));
    if (lane == 0) CS[t] = cs;
}
struct VMeta { unsigned E[16]; };
__device__ __forceinline__ void v_meta(VMeta& m, const unsigned* COEF, int t, int grp) {
#pragma unroll
    for (int g = 0; g < 16; ++g) m.E[g] = *(const GAS unsigned*)(COEF + (size_t)t * 128 + g * 8 + grp);
}
__device__ __forceinline__ void v_rows(v4u (&w)[16], unsigned (&c)[16], const VMeta& m, const unsigned char* tab, unsigned choff) {
#pragma unroll
    for (int g = 0; g < 16; ++g) { w[g] = *(const GAS v4u*)(tab + (unsigned)((m.E[g] >> 16) * 128u + choff)); c[g] = m.E[g]; }
}
__device__ __forceinline__ void v_compute_(const v4u (&w)[16], const unsigned (&C)[16], const float* CS, const float* hin, float* hout, int t, int g0, int g1, int g2) {
    typedef float f2 __attribute__((ext_vector_type(2)));
    const f2 hv = __builtin_nontemporal_load((const GAS f2*)hin);
    const float corr = -128.f * __hip_atomic_load(CS + t, __ATOMIC_RELAXED, __HIP_MEMORY_SCOPE_AGENT);
    float acc[16];
#pragma unroll
    for (int j = 0; j < 16; ++j) acc[j] = 0.f;
#pragma unroll
    for (int g = 0; g < 16; ++g) { const float c = bflo(C[g]);
#pragma unroll
        for (int j = 0; j < 4; ++j) { const unsigned wv = w[g][j];
            acc[4 * j + 0] += c * (float)(wv & 0xffu); acc[4 * j + 1] += c * (float)((wv >> 8) & 0xffu); acc[4 * j + 2] += c * (float)((wv >> 16) & 0xffu); acc[4 * j + 3] += c * (float)(wv >> 24); } }
    float r8[8], r4[4], r2[2];
#pragma unroll
    for (int i = 0; i < 8; ++i) { const float keep = g0 ? acc[i + 8] : acc[i], send = g0 ? acc[i] : acc[i + 8]; r8[i] = keep + __shfl_xor(send, 8); }
#pragma unroll
    for (int i = 0; i < 4; ++i) { const float keep = g1 ? r8[i + 4] : r8[i], send = g1 ? r8[i] : r8[i + 4]; r4[i] = keep + __shfl_xor(send, 16); }
#pragma unroll
    for (int i = 0; i < 2; ++i) { const float keep = g2 ? r4[i + 2] : r4[i], send = g2 ? r4[i] : r4[i + 2]; r2[i] = keep + __shfl_xor(send, 32); }
    __builtin_nontemporal_store((f2){hv.x + r2[0] + corr, hv.y + r2[1] + corr}, (GAS f2*)hout);
}
__device__ __forceinline__ void gather_v(const unsigned* COEF, const float* CS, const unsigned char* VQS, const float* HI, float* HO, float* dummy, unsigned* queues, int xcc, int lane) {
    const int grp = lane >> 3, ch = lane & 7, g0 = grp & 1, g1 = (grp >> 1) & 1, g2 = (grp >> 2) & 1;
    for (int qi = 0; qi < 8; ++qi) { const int x = (xcc + qi) & 7;
        const unsigned char* tab = VQS + (size_t)x * SLICE_BYTES; const unsigned choff = (unsigned)ch * 16u;
        const int col = x * 128 + ch * 16 + 8 * g0 + 4 * g1 + 2 * g2;
        TokStream S; S.open(queues + 64 * x, lane);
        int tA = S.next(lane), tB = S.next(lane);
        if (tA >= T) continue;
        VMeta M; v4u W0[16], W1[16]; unsigned C0[16], C1[16];
        v_meta(M, COEF, tA, grp); v_rows(W0, C0, M, tab, choff);
        v_meta(M, COEF, tB < T ? tB : T - 1, grp);
        while (tA < T) {
            const int tC = S.next(lane);
            v_rows(W1, C1, M, tab, choff);
            v_meta(M, COEF, tC < T ? tC : T - 1, grp);
            v_compute_(W0, C0, CS, HI + (size_t)tA * DM + col, HO + (size_t)tA * DM + col, tA, g0, g1, g2);
            const int tD = S.next(lane);
            v_rows(W0, C0, M, tab, choff);
            v_meta(M, COEF, tD < T ? tD : T - 1, grp);
            { const int tb = tB < T ? tB : T - 1; v_compute_(W1, C1, CS, HI + (size_t)tb * DM + col, tB < T ? HO + (size_t)tB * DM + col : dummy + 2 * lane, tb, g0, g1, g2); }
            tA = tC; tB = tD;
        }
    }
}

#ifndef MK_SPLIT
#define MK_SPLIT 0
#endif
constexpr int NPHASE = 11;
#ifndef PROBE_PH
#define PROBE_PH -1
#endif
#ifndef PROBE_N
#define PROBE_N 1
#endif
#define REPS(k) (((k) == PROBE_PH) ? 1 + PROBE_N : 1)
struct Args { const float* in[21]; float* out; unsigned char* ws; int ph_lo, ph_hi; };
static_assert(sizeof(Args) == 23 * 8 + 8, "Args has no padding");

__global__ void __launch_bounds__(NWAVES * 64, 2) fwd(Args args) {
    extern __shared__ __attribute__((aligned(16))) unsigned char lds_raw[];
    LAS unsigned char* lds = (LAS unsigned char*)lds_raw;
    volatile LAS unsigned* MISC = (volatile LAS unsigned*)(lds + MISC_OFF);
    const int tid = threadIdx.x, lane = tid & 63, wave = __builtin_amdgcn_readfirstlane(tid >> 6);
    const int G = gridDim.x; const int bx = blockIdx.x; const int vcu = (G % 8 == 0) ? (bx % 8) * (G / 8) + bx / 8 : bx;
    const int gw = vcu * NWAVES + wave, NGW = G * NWAVES;
    unsigned char* ws = args.ws;
    gu32* ctl = (gu32*)(ws + WS_CTL);
    const float* x = args.in[0]; const float* mem = args.in[1]; const float* g_mix = args.in[2]; const float* w_in = args.in[3]; const float* q_gain_a = args.in[4]; const float* k_gain_a = args.in[5];
    const float* rel_bias = args.in[6]; const float* conv_w = args.in[7]; const float* g_mem = args.in[8]; const float* w_mem_kv = args.in[9]; const float* q_gain_x = args.in[10]; const float* k_gain_x = args.in[11];
    const float* w_br_attn = args.in[12]; const float* w_br_conv = args.in[13]; const float* w_br_x = args.in[14]; const float* w_out = args.in[15]; const float* g_ffn = args.in[16];
    const float* w_query = args.in[17]; const float* sub_keys = args.in[18]; const float* peer_u = args.in[19]; const float* peer_v = args.in[20];
    float* out = args.out;
    bf16* WinT = (bf16*)(ws + WS_WIN); bf16* WkvT = (bf16*)(ws + WS_WKV); bf16* WbrT = (bf16*)(ws + WS_WBR); bf16* WoutT = (bf16*)(ws + WS_WOUT); bf16* WqT = (bf16*)(ws + WS_WQ);
    bf16* SK = (bf16*)(ws + WS_SK); float* TAB = (float*)(ws + WS_TAB); float* KMEAN = (float*)(ws + WS_KMEAN); bf16* MEMN = (bf16*)(ws + WS_MEMN); bf16* KVM = (bf16*)(ws + WS_KVM);
    float* SLOTS = (float*)(ws + WS_SLOTS); unsigned* SEL = (unsigned*)(ws + WS_SEL);
    bf16* PA = (bf16*)(ws + WS_PA); bf16* PG = (bf16*)(ws + WS_PG);
    bf16* MERGED = (bf16*)(ws + PA_MERGED); bf16* HB = (bf16*)(ws + PA_HB); unsigned char* UQ = ws + PA_UT; unsigned char* VQ = ws + PA_VT; float* SU = (float*)(ws + WS_SU); float* SV = (float*)(ws + WS_SV); float* SX = (float*)(ws + WS_SX); float* CS = (float*)(ws + WS_CS);
    unsigned char* XQ = ws + PA_XQ; int* PART = (int*)(ws + PG_PART); unsigned* COEF = (unsigned*)(ws + PG_COEF); bf16* QRY = (bf16*)(ws + PG_QRY);
    bf16* HN = (bf16*)out;
    bf16* BRO = (bf16*)out;

    for (int u = tid; u < (LDS_BYTES - LDSCTL_OFF) / 4; u += NWAVES * 64) ((LAS unsigned*)(lds + LDSCTL_OFF))[u] = 0u;
    __syncthreads();
#if !MK_SPLIT
    XcdBarrier bar = xcd_barrier_post((unsigned*)(ctl + CW_BAR), MISC + 8);
#define GRID_BAR() xcd_barrier(bar)
#else
#define GRID_BAR() do {} while (0)
#endif
    const int lo = args.ph_lo, hi_ = args.ph_hi;
#ifndef PH_MASK
#define PH_MASK 0x7ff
#endif
#define IN(k) ((((PH_MASK) >> (k)) & 1) && lo <= (k) && (k) < hi_)
#define BOTH(k) (IN(k) && IN((k) + 1))

    if (IN(0)) for (int rep = 0; rep < REPS(0); ++rep) {
        P0Args a{x, mem, g_mix, w_in, rel_bias, g_mem, w_mem_kv, w_br_attn, w_br_conv, w_br_x, w_out, g_ffn, w_query, sub_keys, WinT, WkvT, WbrT, WoutT, WqT, SK, HN, MEMN, TAB};
        p0_prologue(a, lds, gw, NGW, wave, lane);
        if (BOTH(0) && rep == REPS(0) - 1) GRID_BAR();
    }
    if (IN(1)) for (int rep = 0; rep < REPS(1); ++rep) {
        { pg8::Gemm g{HN, WinT, T, PW, DM}; pg8::GOrder S; S.init(T, PW, G, bx); pg8::EpiProj E{PA, PG, q_gain_a, k_gain_a, KMEAN, C2A, RMS_EPS};
          pg8::gemm_phase<pg8::EpiProj, pg8::GOrder, true, true>(lds + RING_OFF, g, S, E); }
        { const int nfull = (64 * 26) % G; const int coff = (nfull + 32 <= G) ? bx - nfull : bx;
          pg8::Gemm g{MEMN, WkvT, NBATCH * MEMLEN, 1024, DM}; pg8::GOrder S; S.init(NBATCH * MEMLEN, 1024, G, coff); pg8::EpiBf16<0> E{KVM, 1024, nullptr, 0, 0, 1.f};
          pg8::gemm_phase<pg8::EpiBf16<0>, pg8::GOrder, true, true>(lds + RING_OFF, g, S, E); }
        if (IN(1) && IN(3) && rep == REPS(1) - 1) GRID_BAR();
    }
#if defined(PROBE_BARS) && !MK_SPLIT
    if (IN(1)) for (int i = 0; i < PROBE_BARS; ++i) GRID_BAR();
#endif
    if (IN(3)) for (int rep = 0; rep < REPS(3); ++rep) {
        for (int v = vcu; v < 256; v += G) {
            const int bh = v >> 2, b = bh >> 3, h = bh & 7, s = v & 3;
#pragma unroll 1
            for (int pass = 0; pass < 2; ++pass) { const int qb = pass ? 7 - s : s;
                const bf16* Qp = PA + (size_t)(b * SEQ + qb * 256) * PAW + COL_QA + h * 64;
                const bf16* Kp = PA + (size_t)(b * SEQ) * PAW + COL_KA + h * 64; const bf16* Vp = PA + (size_t)(b * SEQ) * PAW + COL_VA + h * 64;
                bf16* Op = BRO + (size_t)(b * SEQ + qb * 256) * 512 + h * 64;
                att::attn_unit<64, true>(Qp, PAW, Kp, Vp, PAW, Op, qb, KMEAN + (size_t)bh * 512, TAB + h * 2048, nullptr, nullptr, lds + RING_OFF, tid, wave, lane); }
            { const int bb = v >> 5, hx = (v >> 3) & 3, qt = v & 7;
                const bf16* Qp = PA + (size_t)(bb * SEQ + qt * 256) * PAW + COL_QX + hx * 128;
                const bf16* Kp = KVM + (size_t)(bb * MEMLEN) * 1024 + hx * 128; const bf16* Vp = Kp + 512;
                bf16* Op = BRO + (size_t)2 * T * 512 + (size_t)(bb * SEQ + qt * 256) * 512 + hx * 128;
                att::attn_unit<128, false>(Qp, PAW, Kp, Vp, 1024, Op, 0, nullptr, nullptr, q_gain_x, k_gain_x, lds + RING_OFF, tid, wave, lane); }
            conv_item(PA, conv_w, BRO + (size_t)T * 512, v, tid);
        }
        if (BOTH(3) && rep == REPS(3) - 1) GRID_BAR();
    }
    if (IN(4)) for (int rep = 0; rep < REPS(4); ++rep) {
        pg8::Gemm g{BRO, WbrT, 3 * T, 3 * 1024, 512}; pg8::BranchOrder S; S.init(G, bx); pg8::EpiBranch E{PG, MERGED};
        pg8::gemm_phase<pg8::EpiBranch, pg8::BranchOrder, true, true>(lds + RING_OFF, g, S, E);
        if (BOTH(4) && rep == REPS(4) - 1) GRID_BAR();
    }
    if (IN(5)) for (int rep = 0; rep < REPS(5); ++rep) {
        pg8::Gemm g{MERGED, WoutT, T, 1024, DM}; pg8::GOrder S; S.init(T, 1024, G, bx); pg8::EpiWout E{x, out, HB, SLOTS};
        pg8::gemm_phase<pg8::EpiWout, pg8::GOrder, true, true>(lds + RING_OFF, g, S, E);
        if (BOTH(5) && rep == REPS(5) - 1) GRID_BAR();
    }
    if (IN(6)) for (int rep = 0; rep < REPS(6); ++rep) {
        pg8::Gemm g{HB, WqT, T, 2048, DM}; pg8::GOrder S; S.init(T, 2048, G, bx); pg8::EpiBf16<0> E{QRY, 2048, nullptr, 0, 0, 1.f};
        pg8::gemm_phase<pg8::EpiBf16<0>, pg8::GOrder, true, true>(lds + RING_OFF, g, S, E);
        if (BOTH(6) && rep == REPS(6) - 1) GRID_BAR();
    }
    if (IN(7)) for (int rep = 0; rep < REPS(7); ++rep) {
        for (int v = vcu; v < 256; v += G) { pk::topk_unit(QRY, SK, SLOTS, SEL, lds + RING_OFF, v, tid, wave, lane); __syncthreads(); }
        for (int m = gw; m < NEXP; m += 4 * NGW) quant_rows_sliced<false, 4>(peer_u, UQ, SU, m, NGW, NEXP, lane);
        for (int m = gw; m < NEXP; m += 4 * NGW) quant_rows_sliced<true, 4>(peer_v, VQ, SV, m, NGW, NEXP, lane);
        { float gf[16];
#pragma unroll
          for (int j = 0; j < 16; ++j) gf[j] = g_ffn[16 * lane + j];
          for (int t = gw; t < T; t += 4 * NGW) quant_x<4>(out, XQ, SX, gf, t, NGW, lane); }
        if (BOTH(7) && rep == REPS(7) - 1) GRID_BAR();
    }
#if !MK_SPLIT
    const int xcc = (int)bar.x & 7;
#else
    const int xcc = (int)(xb_xcc_id() & 7u);
#endif
    if (IN(8)) for (int rep = 0; rep < REPS(8); ++rep) {
        gather_u(SEL, XQ, UQ, PART, (int*)(ws + WS_END), (unsigned*)(ctl + CW_QU + 1024 * rep), xcc, lane);
        if (BOTH(8) && rep == REPS(8) - 1) GRID_BAR();
    }
    if (IN(9)) for (int rep = 0; rep < REPS(9); ++rep) {
        for (int t = gw; t < T; t += NGW) gather_coef(SEL, PART, SU, SV, SX, COEF, CS, t, lane);
        if (BOTH(9) && rep == REPS(9) - 1) GRID_BAR();
    }
    if (IN(10)) for (int rep = 0; rep < REPS(10); ++rep) {
        gather_v(COEF, CS, VQ, out, (rep == REPS(10) - 1) ? out : (float*)PART, (float*)(ws + WS_END), (unsigned*)(ctl + CW_QV + 1024 * rep), xcc, lane);
    }
#undef IN
#undef BOTH
}

extern "C" void kernel_launch(void* const* d_in, const int* in_sizes, int n_in, void* d_out, int out_size, void* d_ws, size_t ws_size, hipStream_t stream) {
    static int grid = 0;
    if (grid == 0) {
        if (n_in != 21 || out_size != T * DM || ws_size < WS_END + 4096) { fprintf(stderr, "kernel_launch: unexpected shapes (n_in %d, out %d, ws %zu)\n", n_in, out_size, ws_size); grid = -1; return; }
        int dev = 0, cus = 0, per_cu = 0;
        if (hipGetDevice(&dev) != hipSuccess || hipDeviceGetAttribute(&cus, hipDeviceAttributeMultiprocessorCount, dev) != hipSuccess) { grid = -1; return; }
        if (hipFuncSetAttribute((const void*)fwd, hipFuncAttributeMaxDynamicSharedMemorySize, LDS_BYTES) != hipSuccess) { fprintf(stderr, "kernel_launch: hipFuncSetAttribute failed\n"); grid = -1; return; }
        if (hipOccupancyMaxActiveBlocksPerMultiprocessor(&per_cu, (const void*)fwd, NWAVES * 64, LDS_BYTES) != hipSuccess || per_cu < 1) { fprintf(stderr, "kernel_launch: occupancy query reports %d\n", per_cu); }
        (void)hipGetLastError();
        grid = cus;
    }
    if (grid < 0) return;
    (void)hipMemsetAsync((char*)d_ws + WS_CTL, 0, CTL_ZERO_BYTES, stream);
    Args a{};
    for (int i = 0; i < 21; ++i) a.in[i] = (const float*)d_in[i];
    a.out = (float*)d_out; a.ws = (unsigned char*)d_ws;
#if MK_SPLIT
    for (int p = 0; p < NPHASE; ++p) { a.ph_lo = p; a.ph_hi = p + 1; hipLaunchKernelGGL(fwd, dim3(grid), dim3(NWAVES * 64), LDS_BYTES, stream, a); }
#else
    a.ph_lo = 0; a.ph_hi = NPHASE;
    hipLaunchKernelGGL(fwd, dim3(grid), dim3(NWAVES * 64), LDS_BYTES, stream, a);
#endif
}
```

```cpp
#include <hip/hip_runtime.h>
#include <hip/hip_bf16.h>
#include <cstdio>
#include <cstdint>
#include <cmath>
namespace pg8 {
#define PG8_LAS __attribute__((address_space(3)))
typedef unsigned short bf16_t;
typedef short bf16x8 __attribute__((ext_vector_type(8)));
typedef float f32x4 __attribute__((ext_vector_type(4)));
typedef unsigned u32x4 __attribute__((ext_vector_type(4)));
typedef int i32x4 __attribute__((ext_vector_type(4)));
constexpr int BM = 256, BK = 64, HALF = 128, HTB = HALF * BK * 2  , STAGE_BYTES = 8 * HTB, NXCD = 8, WGM = 8;

__host__ __device__ __forceinline__ int lds_byte(int r, int c) { const int st = (r >> 4) * 2 + (c >> 5), rr = r & 15, cc = c & 31, ob = rr * 64 + cc * 2; return st * 1024 + (ob ^ (((ob >> 9) & 1) << 5)); }
__host__ __device__ __forceinline__ void stage_rc(int b, int& R, int& C) { const int st = b / 1024, sb = b % 1024, swz = sb ^ (((sb >> 9) & 1) << 5); R = (st >> 1) * 16 + swz / 64; C = (st & 1) * 32 + (swz % 64) / 2; }
__host__ __device__ __forceinline__ int perm32(int rho) { const int n = rho >> 4, i = rho & 15; return 8 * (i >> 2) + 4 * n + (i & 3); }

struct Unit { int pm, pn; };
struct Gemm { const bf16_t* A; const bf16_t* Bt; int M, N, K; };

struct StaticOrder {
    int nM, nN, nwg, G, c;
    __host__ __device__ void init(int M, int N, int G_, int c_) { nM = M / BM; nN = N / BM; nwg = nM * nN; G = G_; c = c_; }
    __host__ __device__ bool next(int i, Unit& u) const {
        const long L = (long)i * G + c; if (L >= nwg) return false;
        int wgid = (int)L; { const int q = nwg / NXCD, r = nwg % NXCD, xcd = wgid % NXCD, off = wgid / NXCD; wgid = (xcd < r ? xcd * (q + 1) : r * (q + 1) + (xcd - r) * q) + off; }
        const int nig = WGM * nN, gid = wgid / nig, fm = gid * WGM, gsz = (nM - fm) < WGM ? (nM - fm) : WGM;
        u.pm = fm + ((wgid % nig) % gsz); u.pn = (wgid % nig) / gsz; return true;
    }
    __device__ __forceinline__ void a_ready(const Unit&) const {}
    __device__ __forceinline__ void done(const Unit&) const {}
};

__device__ __forceinline__ unsigned cvt_pk_bf16(float lo, float hi) { unsigned r; asm volatile("v_cvt_pk_bf16_f32 %0, %1, %2" : "=v"(r) : "v"(lo), "v"(hi)); return r; }
typedef float f32x2 __attribute__((ext_vector_type(2)));
__device__ __forceinline__ f32x2 gelu_pk(f32x2 v) {
    const f32x2 av = __builtin_elementwise_abs(v), d = av * 0.2316418882f + 1.0f;
    f32x2 t; t.x = __builtin_amdgcn_rcpf(d.x); t.y = __builtin_amdgcn_rcpf(d.y);
    f32x2 q = t * 0.5307027145f + (-0.7265760135f); q = q * t + 0.7107068705f; q = q * t + (-0.142248368f); q = q * t + 0.127414796f; q = q * t;
    const f32x2 s = (v * v) * (-0.72134752044f);
    f32x2 e; e.x = __builtin_amdgcn_exp2f(s.x); e.y = __builtin_amdgcn_exp2f(s.y);
    const f32x2 m = v * (q * e), r = v - m;
    f32x2 o; o.x = v.x < 0.f ? m.x : r.x; o.y = v.y < 0.f ? m.y : r.y; return o;
}

template <int ACT  > struct EpiBf16 {
    static constexpr bool PERM = true, AFTER_DRAIN = false, HEAD64 = false; static_assert(ACT == 0 || ACT == 1 || ACT == 2, "EpiBf16: ACT is 0 (none), 1 (gelu_pk) or 2 (sigmoid)");
    bf16_t* O; int ldc; const float* bias; int split_cols; size_t split_stride; float scale0;
    __device__ __forceinline__ void operator()(const f32x4 (&acc)[2][2][4][2], const Unit& u, int wr, int wc, int fr, int fq) const {
        const int row0 = u.pm * BM + wr * 64 + fr; int colt = u.pn * BM; bf16_t* base = O;
        float sc = 1.f; if (split_cols) { const int t = colt / split_cols; base += (size_t)t * split_stride; colt -= t * split_cols; if (t == 0) sc = scale0; }
        const int col0 = colt + wc * 32 + 8 * fq, bcol0 = u.pn * BM + wc * 32 + 8 * fq;
        f32x4 bv[2][2];
#pragma unroll
        for (int bj = 0; bj < 2; ++bj)
#pragma unroll
            for (int n = 0; n < 2; ++n) bv[bj][n] = bias ? *(const f32x4*)(bias + bcol0 + bj * HALF + 4 * n) : (f32x4){0.f, 0.f, 0.f, 0.f};
#pragma unroll
        for (int ai = 0; ai < 2; ++ai)
#pragma unroll
            for (int m = 0; m < 4; ++m) { bf16_t* rowp = base + (size_t)(row0 + ai * HALF + m * 16) * ldc + col0;
#pragma unroll
                for (int bj = 0; bj < 2; ++bj) { f32x4 v0 = acc[ai][bj][m][0] + bv[bj][0], v1 = acc[ai][bj][m][1] + bv[bj][1];
                    if (ACT == 1) { f32x2 a = gelu_pk((f32x2){v0[0], v0[1]}), b = gelu_pk((f32x2){v0[2], v0[3]}), c = gelu_pk((f32x2){v1[0], v1[1]}), d = gelu_pk((f32x2){v1[2], v1[3]});
                        v0 = (f32x4){a.x, a.y, b.x, b.y}; v1 = (f32x4){c.x, c.y, d.x, d.y}; }
                    if (ACT == 2) { _Pragma("unroll") for (int e_ = 0; e_ < 4; ++e_) { v0[e_] = __builtin_amdgcn_rcpf(1.0f + __builtin_amdgcn_exp2f(-1.4426950408889634f * v0[e_])); v1[e_] = __builtin_amdgcn_rcpf(1.0f + __builtin_amdgcn_exp2f(-1.4426950408889634f * v1[e_])); } }
                    v0 = v0 * sc; v1 = v1 * sc; u32x4 w; w.x = cvt_pk_bf16(v0[0], v0[1]); w.y = cvt_pk_bf16(v0[2], v0[3]); w.z = cvt_pk_bf16(v1[0], v1[1]); w.w = cvt_pk_bf16(v1[2], v1[3]);
                    *(u32x4*)(rowp + bj * HALF) = w; } }
    }
};


struct GOrder {
    int nM, nN, nwg, G, c;
    __host__ __device__ void init(int M, int N, int G_, int c_) { nM = M / BM; nN = N / BM; nwg = nM * nN; G = G_; c = c_; }
    __host__ __device__ bool next(int i, Unit& u) const {
        if (c < 0) return false;
        const long L = (long)i * G + c; if (L >= nwg) return false;
        int wgid = (int)L; { const int q = nwg / NXCD, r = nwg % NXCD, xcd = wgid % NXCD, off = wgid / NXCD; wgid = (xcd < r ? xcd * (q + 1) : r * (q + 1) + (xcd - r) * q) + off; }
        const int nig = WGM * nN, gid = wgid / nig, fm = gid * WGM, gsz = (nM - fm) < WGM ? (nM - fm) : WGM;
        u.pm = fm + ((wgid % nig) % gsz); u.pn = (wgid % nig) / gsz; return true;
    }
    __device__ __forceinline__ void a_ready(const Unit&) const {}
    __device__ __forceinline__ void done(const Unit&) const {}
};
struct BranchOrder {
    GOrder g;
    __device__ void init(int G, int c) { g.init(16384, 1024, G, c); }
#if defined(PROBE_P4X2)
    __device__ bool next(int i, Unit& u) const { Unit t; if (i >= 6 || !g.next(0, t)) return false; const int br = i % 3; u.pm = 64 * br + t.pm; u.pn = 4 * br + t.pn; return true; }
#else
    __device__ bool next(int i, Unit& u) const { Unit t; if (!g.next(i / 3, t)) return false; const int br = i % 3; u.pm = 64 * br + t.pm; u.pn = 4 * br + t.pn; return true; }
#endif
    __device__ __forceinline__ void a_ready(const Unit&) const {}
    __device__ __forceinline__ void done(const Unit&) const {}
};
__device__ __forceinline__ float bf_lo(unsigned w) { return __builtin_bit_cast(float, w << 16); }
__device__ __forceinline__ float bf_hi(unsigned w) { return __builtin_bit_cast(float, w & 0xffff0000u); }
__device__ __forceinline__ float sigmoid_f(float x) { return __builtin_amdgcn_rcpf(1.0f + __builtin_amdgcn_exp2f(-1.4426950408889634f * x)); }
struct EpiProj {
    static constexpr bool PERM = true, AFTER_DRAIN = false, HEAD64 = true;
    bf16_t* PA; bf16_t* PG; const float* gq; const float* gk; float* KMEAN; float qscale, eps; const float* SA; const float* SB;
    __device__ __forceinline__ void operator()(const f32x4 (&acc)[2][2][4][2], const Unit& u, int wr, int wc, int fr, int fq) const {
        f32x4 sbv[2][2];
        { const float* sp = SB + u.pn * BM + wc * 64 + 8 * fq;
#pragma unroll
          for (int bj = 0; bj < 2; ++bj)
#pragma unroll
              for (int n = 0; n < 2; ++n) sbv[bj][n] = *(const f32x4*)(sp + 32 * bj + 4 * n); }
#define EPQ(ai, bj, m, n, sa) ({ const i32x4 a_ = __builtin_bit_cast(i32x4, acc[ai][bj][m][n]); const f32x4 s_ = sbv[bj][n] * (sa); (f32x4){(float)a_[0] * s_[0], (float)a_[1] * s_[1], (float)a_[2] * s_[2], (float)a_[3] * s_[3]}; })
        const bool gate = u.pn >= 14; const int mode = u.pn < 2 ? 1 : (u.pn < 4 ? 2 : 0);
        bf16_t* base = gate ? PG : PA; const int ldc = gate ? 3072 : 3584; const int colt = gate ? (u.pn - 14) * BM : u.pn * BM;
        const int row0 = u.pm * BM + wr * 64 + fr, col0 = colt + wc * 64 + 8 * fq;
        f32x4 gn[2][2]; f32x4 cs[2][2];
#pragma unroll
        for (int bj = 0; bj < 2; ++bj)
#pragma unroll
            for (int n = 0; n < 2; ++n) { cs[bj][n] = (f32x4){0.f, 0.f, 0.f, 0.f}; gn[bj][n] = (f32x4){1.f, 1.f, 1.f, 1.f};
                if (mode) { const float* gp = (mode == 1 ? gq : gk) + 32 * bj + 8 * fq + 4 * n; const float sc = mode == 1 ? qscale : 1.0f; gn[bj][n] = (f32x4){gp[0] * sc, gp[1] * sc, gp[2] * sc, gp[3] * sc}; } }
#pragma unroll
        for (int ai = 0; ai < 2; ++ai)
#pragma unroll
            for (int m = 0; m < 4; ++m) { bf16_t* rowp = base + (size_t)(row0 + ai * HALF + m * 16) * ldc + col0;
                const float sa = SA[row0 + ai * HALF + m * 16];
                float r = 1.f;
                if (mode) { float ss = 0.f;
#pragma unroll
                    for (int bj = 0; bj < 2; ++bj)
#pragma unroll
                        for (int n = 0; n < 2; ++n) { const f32x4 v = EPQ(ai, bj, m, n, sa); ss += (v[0] * v[0] + v[1] * v[1]) + (v[2] * v[2] + v[3] * v[3]); }
                    ss += __shfl_xor(ss, 16); ss += __shfl_xor(ss, 32);
                    r = 1.0f / sqrtf(ss * (1.f / 64.f) + eps); }
#pragma unroll
                for (int bj = 0; bj < 2; ++bj) { f32x4 v0 = EPQ(ai, bj, m, 0, sa), v1 = EPQ(ai, bj, m, 1, sa);
                    if (gate) {
#pragma unroll
                        for (int e = 0; e < 4; ++e) { v0[e] = sigmoid_f(v0[e]); v1[e] = sigmoid_f(v1[e]); } }
                    if (mode) { v0 = v0 * r * gn[bj][0]; v1 = v1 * r * gn[bj][1]; if (mode == 2) { cs[bj][0] += v0; cs[bj][1] += v1; } }
                    if (gate) {
                        typedef unsigned u32x2g __attribute__((ext_vector_type(2))); unsigned q[8];
#pragma unroll
                        for (int e = 0; e < 4; ++e) { q[e] = (unsigned)__builtin_rintf(v0[e] * 255.f); q[4 + e] = (unsigned)__builtin_rintf(v1[e] * 255.f); }
                        u32x2g wq; wq.x = q[0] | (q[1] << 8) | (q[2] << 16) | (q[3] << 24); wq.y = q[4] | (q[5] << 8) | (q[6] << 16) | (q[7] << 24);
                        *(u32x2g*)((unsigned char*)PG + (size_t)(row0 + ai * HALF + m * 16) * 3072 + col0 + bj * 32) = wq;
                    } else {
                    u32x4 w; w.x = cvt_pk_bf16(v0[0], v0[1]); w.y = cvt_pk_bf16(v0[2], v0[3]); w.z = cvt_pk_bf16(v1[0], v1[1]); w.w = cvt_pk_bf16(v1[2], v1[3]);
                    *(u32x4*)(rowp + bj * 32) = w; } } }
        if (mode == 2) {
            const int b = u.pm >> 3, nb = u.pm & 7, head = (u.pn - 2) * 4 + wc;
            float* km = KMEAN + (size_t)((b * 8 + head) * 8 + nb) * 64 + 8 * fq;
#pragma unroll
            for (int bj = 0; bj < 2; ++bj)
#pragma unroll
                for (int n = 0; n < 2; ++n)
#pragma unroll
                    for (int e = 0; e < 4; ++e) { float s = cs[bj][n][e];
                        s += __shfl_xor(s, 1); s += __shfl_xor(s, 2); s += __shfl_xor(s, 4); s += __shfl_xor(s, 8);
                        if (fr == 0) atomicAdd(km + 32 * bj + 4 * n + e, s * (1.f / 256.f)); }
        }
    }
};
struct EpiBranch {
    static constexpr bool PERM = true, AFTER_DRAIN = false, HEAD64 = false;
    const bf16_t* PG; bf16_t* MG;
    __device__ __forceinline__ void operator()(const f32x4 (&acc)[2][2][4][2], const Unit& u, int wr, int wc, int fr, int fq) const {
        const int br = u.pm >> 6, tm = u.pm & 63, tn = u.pn & 3;
        const int row0 = tm * BM + wr * 64 + fr, col0 = tn * BM + wc * 32 + 8 * fq;
#pragma unroll
        for (int ai = 0; ai < 2; ++ai) {
            typedef unsigned u32x2g __attribute__((ext_vector_type(2)));
            u32x2g g[4][2]; u32x4 p[4][2];
#pragma unroll
            for (int m = 0; m < 4; ++m)
#pragma unroll
                for (int bj = 0; bj < 2; ++bj) { const size_t row = (size_t)(row0 + ai * HALF + m * 16); const int col = col0 + bj * HALF;
                    g[m][bj] = *(const u32x2g*)((const unsigned char*)PG + row * 3072 + br * 1024 + col);
                    p[m][bj] = (br > 0) ? *(const u32x4*)(MG + row * 1024 + col) : (u32x4){0u, 0u, 0u, 0u}; }
#pragma unroll
            for (int m = 0; m < 4; ++m)
#pragma unroll
                for (int bj = 0; bj < 2; ++bj) { const size_t row = (size_t)(row0 + ai * HALF + m * 16); const int col = col0 + bj * HALF;
                    const u32x2g gg = g[m][bj]; const u32x4 pp = p[m][bj]; constexpr float GS = 1.f / 255.f;
                    f32x4 v0 = acc[ai][bj][m][0], v1 = acc[ai][bj][m][1];
                    v0[0] = v0[0] * ((float)(gg.x & 0xffu) * GS) + bf_lo(pp.x); v0[1] = v0[1] * ((float)((gg.x >> 8) & 0xffu) * GS) + bf_hi(pp.x); v0[2] = v0[2] * ((float)((gg.x >> 16) & 0xffu) * GS) + bf_lo(pp.y); v0[3] = v0[3] * ((float)(gg.x >> 24) * GS) + bf_hi(pp.y);
                    v1[0] = v1[0] * ((float)(gg.y & 0xffu) * GS) + bf_lo(pp.z); v1[1] = v1[1] * ((float)((gg.y >> 8) & 0xffu) * GS) + bf_hi(pp.z); v1[2] = v1[2] * ((float)((gg.y >> 16) & 0xffu) * GS) + bf_lo(pp.w); v1[3] = v1[3] * ((float)(gg.y >> 24) * GS) + bf_hi(pp.w);
                    u32x4 w; w.x = cvt_pk_bf16(v0[0], v0[1]); w.y = cvt_pk_bf16(v0[2], v0[3]); w.z = cvt_pk_bf16(v1[0], v1[1]); w.w = cvt_pk_bf16(v1[2], v1[3]);
                    *(u32x4*)(MG + row * 1024 + col) = w; }
        }
    }
};
struct EpiWout {
    static constexpr bool PERM = false, AFTER_DRAIN = false, HEAD64 = false;
    const float* X; float* H; bf16_t* HB; float* SL;
    __device__ __forceinline__ void operator()(const f32x4 (&acc)[2][2][4][2], const Unit& u, int wr, int wc, int fr, int fq) const {
        typedef unsigned u32x2v __attribute__((ext_vector_type(2)));
        const int row0 = u.pm * BM + wr * 64 + fr, col0 = u.pn * BM + wc * 32 + 4 * fq;
#pragma unroll
        for (int ai = 0; ai < 2; ++ai)
#pragma unroll
            for (int mh = 0; mh < 2; ++mh) {
                f32x4 xv[2][2][2];
#pragma unroll
                for (int mm = 0; mm < 2; ++mm)
#pragma unroll
                    for (int bj = 0; bj < 2; ++bj)
#pragma unroll
                        for (int n = 0; n < 2; ++n) xv[mm][bj][n] = *(const f32x4*)(X + (size_t)(row0 + ai * HALF + (2 * mh + mm) * 16) * 1024 + col0 + bj * HALF + n * 16);
#pragma unroll
                for (int mm = 0; mm < 2; ++mm) { const int m = 2 * mh + mm; const size_t row = (size_t)(row0 + ai * HALF + m * 16); float ss = 0.f;
#pragma unroll
                    for (int bj = 0; bj < 2; ++bj)
#pragma unroll
                        for (int n = 0; n < 2; ++n) { const size_t off = row * 1024 + col0 + bj * HALF + n * 16;
                            const f32x4 hv = xv[mm][bj][n] + acc[ai][bj][m][n];
                            ss += (hv[0] * hv[0] + hv[1] * hv[1]) + (hv[2] * hv[2] + hv[3] * hv[3]);
                            u32x2v w; w.x = cvt_pk_bf16(hv[0], hv[1]); w.y = cvt_pk_bf16(hv[2], hv[3]);
                            *(u32x2v*)(HB + off) = w; }
                    ss += __shfl_xor(ss, 16); ss += __shfl_xor(ss, 32);
                    if (fq == 0) SL[row * 16 + u.pn * 4 + wc] = ss; }
            }
    }
};
template <class Epi, class Sched, bool ALIGN_EPI = false, bool SP2 = false, bool I8 = false>
__device__ __forceinline__ void gemm_phase(PG8_LAS unsigned char* lds, const Gemm g, const Sched& S, const Epi& E) {
    const int tid = threadIdx.x, wid = __builtin_amdgcn_readfirstlane(tid >> 6), lane = tid & 63, wr = wid >> 2, wc = wid & 3, fr = lane & 15, fq = lane >> 4;
    const int K = g.K, nt = K / BK;
    unsigned voffA[2], voffB[2];
#pragma unroll
    for (int i = 0; i < 2; ++i) { int R, C; stage_rc(tid * 16 + i * 8192, R, C); const int Rb = Epi::HEAD64 ? (64 * (R >> 5) + perm32(R & 31)) : (Epi::PERM ? ((R & ~31) + perm32(R & 31)) : R);
        voffA[i] = (unsigned)(R * K + C) * 2u; voffB[i] = (unsigned)(Rb * K + C) * 2u; }
    const size_t kstep = (size_t)(BK * 2);
    const size_t hstep = (size_t)HALF * K * 2;
    const size_t hstepB = Epi::HEAD64 ? (size_t)32 * K * 2 : hstep;
    const size_t tstep = 2 * hstep;
    const unsigned ldsw = (unsigned)wid * 1024u;
    const int aoff = lds_byte(wr * 64 + fr, fq * 8), boff = lds_byte(wc * 32 + fr, fq * 8);
#define PG8_SA(b, h) (((b) * 2 + (h)) * HTB)
#define PG8_SB(b, h) ((4 + (b) * 2 + (h)) * HTB)
#define PG8_STAGE(bufoff, gbase, voff) do { _Pragma("unroll") for (int _i = 0; _i < 2; ++_i) \
        __builtin_amdgcn_global_load_lds((const unsigned*)((const char*)(gbase) + (voff)[_i]), (PG8_LAS unsigned*)(lds + (bufoff) + ldsw + _i * 8192), 16, 0, 0); } while (0)
#define PG8_LDA(dst, b, h) do { _Pragma("unroll") for (int m = 0; m < 4; ++m) _Pragma("unroll") for (int k = 0; k < 2; ++k) dst[m][k] = *(const PG8_LAS bf16x8*)(lds + PG8_SA(b, h) + aoff + m * 2048 + k * 1024); } while (0)
#define PG8_LDB(dst, b, h) do { _Pragma("unroll") for (int n = 0; n < 2; ++n) _Pragma("unroll") for (int k = 0; k < 2; ++k) dst[n][k] = *(const PG8_LAS bf16x8*)(lds + PG8_SB(b, h) + boff + n * 2048 + k * 1024); } while (0)
#define PG8_MMA(ai, bj, At, Bt) do { __builtin_amdgcn_s_setprio(1); _Pragma("unroll") for (int m = 0; m < 4; ++m) _Pragma("unroll") for (int n = 0; n < 2; ++n) _Pragma("unroll") for (int k = 0; k < 2; ++k) \
        { if constexpr (I8) acc[ai][bj][m][n] = __builtin_bit_cast(f32x4, __builtin_amdgcn_mfma_i32_16x16x64_i8(__builtin_bit_cast(i32x4, Bt[n][k]), __builtin_bit_cast(i32x4, At[m][k]), __builtin_bit_cast(i32x4, acc[ai][bj][m][n]), 0, 0, 0)); \
          else acc[ai][bj][m][n] = __builtin_amdgcn_mfma_f32_16x16x32_bf16(Bt[n][k], At[m][k], acc[ai][bj][m][n], 0, 0, 0); } __builtin_amdgcn_s_setprio(0); } while (0)
#define PG8_WAIT_V(n) asm volatile("s_waitcnt vmcnt(" #n ")" ::: "memory")
#define PG8_WAIT_L(n) asm volatile("s_waitcnt lgkmcnt(" #n ")" ::: "memory")
#define PG8_BAR __builtin_amdgcn_s_barrier()
#define PG8_SCHED __builtin_amdgcn_sched_barrier(0)
    Unit cur, nxt; int ui = 0;
    if (!S.next(0, cur)) return;
    f32x4 acc[2][2][4][2];
#pragma unroll
    for (int a = 0; a < 2; ++a)
#pragma unroll
        for (int b = 0; b < 2; ++b)
#pragma unroll
            for (int m = 0; m < 4; ++m)
#pragma unroll
                for (int n = 0; n < 2; ++n) acc[a][b][m][n] = (f32x4){0.f, 0.f, 0.f, 0.f};
    bf16x8 At[4][2], B0[2][2], B1[2][2];
    const char* cA = (const char*)g.A + (size_t)cur.pm * tstep; const char* cB = (const char*)g.Bt + (size_t)cur.pn * tstep;
    S.a_ready(cur);
    if constexpr (SP2) {
        PG8_STAGE(PG8_SB(0, 0), cB, voffB); PG8_STAGE(PG8_SB(0, 1), cB + hstepB, voffB); PG8_STAGE(PG8_SA(0, 0), cA, voffA); PG8_STAGE(PG8_SA(0, 1), cA + hstep, voffA);
        if (wr == 1) PG8_BAR;
        PG8_WAIT_V(2); PG8_BAR;
        PG8_STAGE(PG8_SB(1, 0), cB + kstep, voffB); PG8_STAGE(PG8_SA(1, 0), cA + kstep, voffA); PG8_STAGE(PG8_SB(1, 1), cB + hstepB + kstep, voffB);
        PG8_WAIT_V(6); PG8_BAR;
    } else {
        PG8_STAGE(PG8_SB(0, 0), cB, voffB); PG8_STAGE(PG8_SA(0, 0), cA, voffA); PG8_STAGE(PG8_SB(0, 1), cB + hstepB, voffB); PG8_STAGE(PG8_SA(0, 1), cA + hstep, voffA);
        if (wr == 1) PG8_BAR;
        PG8_WAIT_V(4); PG8_BAR;
        PG8_STAGE(PG8_SB(1, 0), cB + kstep, voffB); PG8_STAGE(PG8_SA(1, 0), cA + kstep, voffA); PG8_STAGE(PG8_SB(1, 1), cB + hstepB + kstep, voffB);
        PG8_WAIT_V(6); PG8_BAR;
    }
    for (;;) {
        const bool has_next = S.next(ui + 1, nxt);
        const char* nA = has_next ? (const char*)g.A + (size_t)nxt.pm * tstep : cA; const char* nB = has_next ? (const char*)g.Bt + (size_t)nxt.pn * tstep : cB;
        for (int t = 0; t < nt; t += 2) {
            const bool last = (t == nt - 2);
            const char* a1 = cA + (size_t)(t + 1) * kstep;
            const char* a2 = last ? nA : cA + (size_t)(t + 2) * kstep; const char* b2 = last ? nB : cB + (size_t)(t + 2) * kstep;
            const char* a3 = a2 + kstep; const char* b3 = b2 + kstep;
            if (last && has_next) S.a_ready(nxt);
            if constexpr (SP2) {
            PG8_LDB(B0, 0, 0); PG8_LDB(B1, 0, 1); PG8_SCHED; PG8_LDA(At, 0, 0); PG8_STAGE(PG8_SA(1, 1), a1 + hstep, voffA);
            PG8_WAIT_V(8); PG8_WAIT_L(0); PG8_BAR; PG8_MMA(0, 0, At, B0); PG8_MMA(0, 1, At, B1); PG8_BAR; PG8_SCHED;
            PG8_LDA(At, 0, 1); PG8_STAGE(PG8_SB(0, 0), b2, voffB); PG8_STAGE(PG8_SB(0, 1), b2 + hstepB, voffB); PG8_STAGE(PG8_SA(0, 0), a2, voffA);
            PG8_WAIT_V(8); PG8_WAIT_L(0); PG8_BAR; PG8_MMA(1, 0, At, B0); PG8_MMA(1, 1, At, B1); PG8_BAR; PG8_SCHED;
            PG8_LDB(B0, 1, 0); PG8_LDB(B1, 1, 1); PG8_SCHED; PG8_LDA(At, 1, 0); PG8_STAGE(PG8_SA(0, 1), a2 + hstep, voffA);
            PG8_WAIT_V(8); PG8_WAIT_L(0); PG8_BAR; PG8_MMA(0, 0, At, B0); PG8_MMA(0, 1, At, B1); PG8_BAR; PG8_SCHED;
            PG8_LDA(At, 1, 1); PG8_STAGE(PG8_SB(1, 0), b3, voffB); PG8_STAGE(PG8_SB(1, 1), b3 + hstepB, voffB); PG8_STAGE(PG8_SA(1, 0), a3, voffA);
            PG8_WAIT_V(8); PG8_WAIT_L(0); PG8_BAR; PG8_MMA(1, 0, At, B0); PG8_MMA(1, 1, At, B1); PG8_BAR; PG8_SCHED;
            } else {
            PG8_LDB(B0, 0, 0); PG8_SCHED; PG8_LDA(At, 0, 0); PG8_STAGE(PG8_SA(1, 1), a1 + hstep, voffA);
            PG8_WAIT_L(8); PG8_BAR; PG8_WAIT_L(0); PG8_MMA(0, 0, At, B0); PG8_BAR; PG8_SCHED;
            PG8_LDB(B1, 0, 1); PG8_STAGE(PG8_SB(0, 0), b2, voffB);
            PG8_BAR; PG8_WAIT_L(0); PG8_MMA(0, 1, At, B1); PG8_BAR;
            PG8_LDA(At, 0, 1); PG8_STAGE(PG8_SA(0, 0), a2, voffA);
            PG8_BAR; PG8_WAIT_L(0); PG8_MMA(1, 0, At, B0); PG8_BAR; PG8_SCHED;
            PG8_STAGE(PG8_SB(0, 1), b2 + hstepB, voffB);
            PG8_WAIT_V(6); PG8_BAR; PG8_MMA(1, 1, At, B1); PG8_BAR;
            PG8_LDB(B0, 1, 0); PG8_SCHED; PG8_LDA(At, 1, 0); PG8_STAGE(PG8_SA(0, 1), a2 + hstep, voffA);
            PG8_WAIT_L(8); PG8_BAR; PG8_WAIT_L(0); PG8_MMA(0, 0, At, B0); PG8_BAR; PG8_SCHED;
            PG8_LDB(B1, 1, 1); PG8_STAGE(PG8_SB(1, 0), b3, voffB);
            PG8_BAR; PG8_WAIT_L(0); PG8_MMA(0, 1, At, B1); PG8_BAR;
            PG8_LDA(At, 1, 1); PG8_STAGE(PG8_SA(1, 0), a3, voffA);
            PG8_BAR; PG8_WAIT_L(0); PG8_MMA(1, 0, At, B0); PG8_BAR; PG8_SCHED;
            PG8_STAGE(PG8_SB(1, 1), b3 + hstepB, voffB);
            PG8_WAIT_V(6); PG8_BAR; PG8_MMA(1, 1, At, B1); PG8_BAR;
            }
        }
        if constexpr (ALIGN_EPI) { if (wr == 0) PG8_BAR; }
        if constexpr (!Epi::AFTER_DRAIN) { E(acc, cur, wr, wc, fr, fq); S.done(cur); }
        if (!has_next) break;
#pragma unroll
        for (int a = 0; a < 2; ++a)
#pragma unroll
            for (int b = 0; b < 2; ++b)
#pragma unroll
                for (int m = 0; m < 4; ++m)
#pragma unroll
                    for (int n = 0; n < 2; ++n) acc[a][b][m][n] = (f32x4){0.f, 0.f, 0.f, 0.f};
        cur = nxt; cA = nA; cB = nB; ++ui;
        if constexpr (ALIGN_EPI) { if (wr == 1) PG8_BAR; }
    }
    PG8_WAIT_V(0);
    if constexpr (!ALIGN_EPI) { if (wr == 0) PG8_BAR; }
    PG8_BAR;
    if constexpr (Epi::AFTER_DRAIN) { E.fused(acc, cur, wr, wc, fr, fq, lds, wid, lane); S.done(cur); }
#undef PG8_SA
#undef PG8_SB
#undef PG8_STAGE
#undef PG8_LDA
#undef PG8_LDB
#undef PG8_MMA
#undef PG8_WAIT_V
#undef PG8_WAIT_L
#undef PG8_BAR
#undef PG8_SCHED
}
}

constexpr int NWAVES = 8;
constexpr int T = 16384, DM = 1024, SEQ = 2048, NBATCH = 8, MEMLEN = 256;
constexpr int PW = 6656, PAW = 3584, PGW = 3072;
constexpr int COL_QA = 0, COL_KA = 512, COL_VA = 1024, COL_UC = 1536, COL_BC = 2048, COL_CC = 2560, COL_QX = 3072;
constexpr float RMS_EPS = 1e-6f, LOG2E = 1.4426950408889634f;
constexpr float C2A = 0.125f * LOG2E;
constexpr float C2X = 0.08838834764831845f * LOG2E;
constexpr int NEXP = 16384;

constexpr size_t MiB = 1u << 20;
constexpr size_t WS_CTL = 0, CTL_ZERO_BYTES = 1 * MiB;
constexpr size_t WS_WIN = 1 * MiB;
constexpr size_t WS_WKV = 14 * MiB;
constexpr size_t WS_WBR = 16 * MiB;
constexpr size_t WS_WOUT = 19 * MiB;
constexpr size_t WS_WQ = 21 * MiB;
constexpr size_t WS_SK = 25 * MiB;
constexpr size_t WS_TAB = 25 * MiB + 512 * 1024;
constexpr size_t WS_KMEAN = WS_CTL + 256 * 1024;
constexpr size_t WS_MEMN = 26 * MiB;
constexpr size_t WS_KVM = 30 * MiB;
constexpr size_t WS_SLOTS = 34 * MiB;
constexpr size_t WS_SEL = 35 * MiB;
constexpr size_t WS_SU = 43 * MiB, WS_SV = 43 * MiB + 65536, WS_SX = 43 * MiB + 2 * 65536, WS_CS = 43 * MiB + 3 * 65536, WS_CM = 43 * MiB + 4 * 65536, WS_XS = 43 * MiB + 5 * 65536, WS_SA = 43 * MiB + 6 * 65536, WS_SB = 43 * MiB + 7 * 65536;
constexpr size_t WS_PA = 44 * MiB;
constexpr size_t WS_PG = 156 * MiB;
constexpr size_t WS_END = 252 * MiB;
constexpr size_t PA_MERGED = WS_PA, PA_HB = WS_PA + 32 * MiB, PA_UT = WS_PA + 64 * MiB, PA_VT = WS_PA;
constexpr size_t PG_QRY = WS_PG, PG_PART = WS_PG, PG_COEF = WS_PG + 64 * MiB, PA_XQ = WS_PG + 80 * MiB;
constexpr int CW_QU = 8192, CW_QV = 8192 + 2048, CW_RANK = 8192 + 4096 + 8192;
constexpr int CW_BAR = 4096;

constexpr int RING_OFF = 0, RING_BYTES = 131072;
constexpr int LDSCTL_OFF = RING_BYTES, MISC_OFF = LDSCTL_OFF + 320;
constexpr int LDS_BYTES = 147456;

#define GAS __attribute__((address_space(1)))
#define LAS __attribute__((address_space(3)))
typedef unsigned short bf16;
typedef unsigned v4u __attribute__((ext_vector_type(4)));
typedef unsigned v2u __attribute__((ext_vector_type(2)));
typedef float f32x4 __attribute__((ext_vector_type(4)));
typedef float f32x16 __attribute__((ext_vector_type(16)));
typedef short bf16x8 __attribute__((ext_vector_type(8)));
typedef short s16x4 __attribute__((ext_vector_type(4)));
typedef GAS unsigned gu32;
#define RLX_AGENT __ATOMIC_RELAXED, __HIP_MEMORY_SCOPE_AGENT
#define LDS_WAIT() asm volatile("s_waitcnt lgkmcnt(0)" ::: "memory")
#define VM_WAIT() asm volatile("s_waitcnt vmcnt(0)" ::: "memory")
__device__ __forceinline__ unsigned f2bf(float f) { unsigned u = __builtin_bit_cast(unsigned, f); return (u + 0x7fffu + ((u >> 16) & 1u)) >> 16; }
__device__ __forceinline__ unsigned pk2(float lo, float hi) { return f2bf(lo) | (f2bf(hi) << 16); }
__device__ __forceinline__ float bflo(unsigned w) { return __builtin_bit_cast(float, w << 16); }
__device__ __forceinline__ float bfhi(unsigned w) { return __builtin_bit_cast(float, w & 0xffff0000u); }
__device__ __forceinline__ float wave_sum(float v) {
#pragma unroll
    for (int o = 1; o < 64; o <<= 1) v += __shfl_xor(v, o);
    return v;
}
#define XB_TMO      128
#define XB_XCNT(j)  (256  + 64 * (j))
#define XB_XSUB(j)  (1280 + 64 * (j))
#define XB_XGEN(j)  (2304 + 64 * (j))
#define XB_TOP      3328
#define XB_TOPGEN   3392
#define XCD_BAR_WORDS 3456
#define XB_SPIN_CAP (1u << 18)

__device__ __forceinline__ unsigned xb_ld(unsigned* p)              { return __hip_atomic_load(p, __ATOMIC_RELAXED, __HIP_MEMORY_SCOPE_AGENT); }
__device__ __forceinline__ unsigned xb_add(unsigned* p, unsigned v) { return __hip_atomic_fetch_add(p, v, __ATOMIC_RELAXED, __HIP_MEMORY_SCOPE_AGENT); }
__device__ __forceinline__ unsigned xb_xcc_id() { return (unsigned)__builtin_amdgcn_s_getreg((3 << 11) | 20) & 0xFu; }
#define XB_SPIN(cond, bar) do { unsigned _sp = 0; while (cond) { __builtin_amdgcn_s_sleep(1); \
    if ((++_sp & 255u) == 0u) { if (xb_ld(&(bar)[XB_TMO])) break; if (_sp > XB_SPIN_CAP) { atomicAdd(&(bar)[XB_TMO], 1u); break; } } } } while (0)

struct XcdBarrier {
    unsigned* bar; unsigned x;
    volatile LAS unsigned* st;
};

__device__ __forceinline__ XcdBarrier xcd_barrier_post(unsigned* bar, volatile LAS unsigned* st) {
    XcdBarrier b; b.bar = bar; b.x = xb_xcc_id(); b.st = st;
    if (threadIdx.x == 0) (void)xb_add(&bar[XB_XCNT(b.x)], 1u);
    return b;
}
__device__ __forceinline__ void xcd_barrier_complete(unsigned* bar, unsigned x, unsigned& nloc, unsigned& nx) {
    const unsigned G = gridDim.x * gridDim.y * gridDim.z;
    unsigned sum, cnt, mine, sp = 0u;
    for (;;) {
        sum = 0u; cnt = 0u; mine = 0u;
#pragma unroll
        for (unsigned j = 0; j < 16; ++j) { const unsigned c = xb_ld(&bar[XB_XCNT(j)]); sum += c; cnt += (c > 0u) ? 1u : 0u; mine = (j == x) ? c : mine; }
        if (sum == G) break;
        __builtin_amdgcn_s_sleep(1);
        if ((++sp & 255u) == 0u) { if (xb_ld(&bar[XB_TMO])) break; if (sp > XB_SPIN_CAP) { atomicAdd(&bar[XB_TMO], 1u); break; } }
    }
    nloc = mine > 0u ? mine : 1u; nx = cnt > 0u ? cnt : 1u;
}

__device__ __forceinline__ void xcd_barrier(const XcdBarrier& b) {
    asm volatile("s_waitcnt vmcnt(0)" ::: "memory");
    __syncthreads();
    if (threadIdx.x == 0) {
        unsigned* bar = b.bar;
        __builtin_amdgcn_s_waitcnt(0);
        unsigned nloc = b.st[0], nx = b.st[1];
        if (nloc == 0u) { xcd_barrier_complete(bar, b.x, nloc, nx); b.st[0] = nloc; b.st[1] = nx; }
        const unsigned old = xb_add(&bar[XB_XSUB(b.x)], 1u);
        const unsigned gen = old / nloc;
        if (old + 1u == (gen + 1u) * nloc) {
            __builtin_amdgcn_fence(__ATOMIC_RELEASE, "agent");
            asm volatile("s_waitcnt vmcnt(0)" ::: "memory");
            const unsigned og = xb_add(&bar[XB_TOP], 1u);
            const unsigned tg = og / nx;
            if (og + 1u == (tg + 1u) * nx) xb_add(&bar[XB_TOPGEN], 1u);
            else XB_SPIN(xb_ld(&bar[XB_TOPGEN]) == tg, bar);
            __builtin_amdgcn_fence(__ATOMIC_ACQUIRE, "agent");
            xb_add(&bar[XB_XGEN(b.x)], 1u);
            asm volatile("s_waitcnt vmcnt(0)" ::: "memory");
        } else {
            XB_SPIN(xb_ld(&bar[XB_XGEN(b.x)]) == gen, bar);
            __builtin_amdgcn_fence(__ATOMIC_ACQUIRE, "agent");
            asm volatile("s_waitcnt vmcnt(0)" ::: "memory");
        }
    }
    __syncthreads();
}

__device__ __forceinline__ void p0_transpose_item(const float* W, int K, int N, bf16* WT, int row_off, const float* ksc, LAS float* scr, int item, int lane) {
    const int nblk = N / 32, kb = item / nblk, nb = item % nblk, k0 = 64 * kb, n0 = 32 * nb;
#pragma unroll 8
    for (int i = 0; i < 32; ++i) { const int kk = 2 * i + (lane >> 5); float v = W[(size_t)(k0 + kk) * N + n0 + (lane & 31)]; if (ksc) v *= ksc[k0 + kk]; scr[kk * 33 + (lane & 31)] = v; }
    LDS_WAIT(); asm volatile("" ::: "memory");
    const int c = lane & 7;
#pragma unroll
    for (int j = 0; j < 4; ++j) { const int n = (lane >> 3) + 8 * j; const LAS float* s = scr + (8 * c) * 33 + n;
        v4u o; o.x = pk2(s[0 * 33], s[1 * 33]); o.y = pk2(s[2 * 33], s[3 * 33]); o.z = pk2(s[4 * 33], s[5 * 33]); o.w = pk2(s[6 * 33], s[7 * 33]);
        *(GAS v4u*)(WT + (size_t)(row_off + n0 + n) * K + k0 + 8 * c) = o; }
    LDS_WAIT(); asm volatile("" ::: "memory");
}
template <int NR> __device__ __forceinline__ void rms_rows_to_bf16(const float* X, const float* g, bf16* O, int m0, int ms, int mend, int lane) {
    const GAS f32x4* gr = (const GAS f32x4*)g + lane;
    f32x4 v[NR][4];
#pragma unroll
    for (int r = 0; r < NR; ++r) { const int m = (m0 + r * ms < mend) ? m0 + r * ms : mend - 1; const GAS f32x4* xr = (const GAS f32x4*)(X + (size_t)m * DM) + lane;
#pragma unroll
        for (int j = 0; j < 4; ++j) v[r][j] = xr[64 * j]; }
    f32x4 gv[4];
#pragma unroll
    for (int j = 0; j < 4; ++j) gv[j] = gr[64 * j];
#pragma unroll
    for (int r = 0; r < NR; ++r) { float s = 0.f;
#pragma unroll
        for (int j = 0; j < 4; ++j) s += (v[r][j].x * v[r][j].x + v[r][j].y * v[r][j].y) + (v[r][j].z * v[r][j].z + v[r][j].w * v[r][j].w);
        const float rr = 1.f / sqrtf(wave_sum(s) * (1.f / 1024.f) + RMS_EPS);
        if (m0 + r * ms < mend) { GAS unsigned long long* o8 = (GAS unsigned long long*)(O + (size_t)(m0 + r * ms) * DM) + lane;
#pragma unroll
            for (int j = 0; j < 4; ++j) o8[64 * j] = (unsigned long long)pk2(v[r][j].x * rr * gv[j].x, v[r][j].y * rr * gv[j].y) | ((unsigned long long)pk2(v[r][j].z * rr * gv[j].z, v[r][j].w * rr * gv[j].w) << 32); } }
}
template <int NR> __device__ __forceinline__ void rms_rows_to_i8(const float* X, const float* g, unsigned char* O, float* SA, int m0, int ms, int mend, int lane) {
    const GAS f32x4* gr = (const GAS f32x4*)g + lane;
    f32x4 v[NR][4];
#pragma unroll
    for (int r = 0; r < NR; ++r) { const int m = (m0 + r * ms < mend) ? m0 + r * ms : mend - 1; const GAS f32x4* xr = (const GAS f32x4*)(X + (size_t)m * DM) + lane;
#pragma unroll
        for (int j = 0; j < 4; ++j) v[r][j] = xr[64 * j]; }
    f32x4 gv[4];
#pragma unroll
    for (int j = 0; j < 4; ++j) gv[j] = gr[64 * j];
#pragma unroll
    for (int r = 0; r < NR; ++r) { float s = 0.f;
#pragma unroll
        for (int j = 0; j < 4; ++j) s += (v[r][j].x * v[r][j].x + v[r][j].y * v[r][j].y) + (v[r][j].z * v[r][j].z + v[r][j].w * v[r][j].w);
        const float rr = 1.f / sqrtf(wave_sum(s) * (1.f / 1024.f) + RMS_EPS);
        float am = 0.f;
#pragma unroll
        for (int j = 0; j < 4; ++j) { v[r][j] = v[r][j] * rr * gv[j]; am = fmaxf(am, fmaxf(fmaxf(fabsf(v[r][j].x), fabsf(v[r][j].y)), fmaxf(fabsf(v[r][j].z), fabsf(v[r][j].w)))); }
#pragma unroll
        for (int o = 1; o < 64; o <<= 1) am = fmaxf(am, __shfl_xor(am, o));
        const float sa = am > 0.f ? am * (1.f / 127.f) : 1.f, is = 1.f / sa;
        if (m0 + r * ms < mend) { GAS unsigned* o4 = (GAS unsigned*)(O + (size_t)(m0 + r * ms) * DM) + lane;
#pragma unroll
            for (int j = 0; j < 4; ++j) { const int a = (int)rintf(v[r][j].x * is), b = (int)rintf(v[r][j].y * is), c = (int)rintf(v[r][j].z * is), d = (int)rintf(v[r][j].w * is);
                o4[64 * j] = (unsigned)(a & 0xff) | ((unsigned)(b & 0xff) << 8) | ((unsigned)(c & 0xff) << 16) | ((unsigned)(d & 0xff) << 24); }
            if (lane == 0) SA[m0 + r * ms] = sa; } }
}
__device__ __forceinline__ void p0_quant_cols_wg(const float* W, int N, unsigned char* WT8, float* SB, LAS unsigned char* lds, int nb, int wave, int lane) {
    LAS float* scr = (LAS float*)(lds + RING_OFF + wave * 16384);
    LAS float* red = (LAS float*)(lds + RING_OFF + 8448);
    const int n0 = 32 * nb, kr = lane >> 3, nq = lane & 7;
    f32x4 v[16];
#pragma unroll
    for (int i = 0; i < 16; ++i) v[i] = *(const GAS f32x4*)(W + (size_t)(128 * wave + 8 * i + kr) * N + n0 + 4 * nq);
    f32x4 am = {0.f, 0.f, 0.f, 0.f};
#pragma unroll
    for (int i = 0; i < 16; ++i)
#pragma unroll
        for (int e = 0; e < 4; ++e) am[e] = fmaxf(am[e], fabsf(v[i][e]));
#pragma unroll
    for (int o = 8; o < 64; o <<= 1)
#pragma unroll
        for (int e = 0; e < 4; ++e) am[e] = fmaxf(am[e], __shfl_xor(am[e], o));
    if (lane < 8) *(LAS f32x4*)(red + wave * 32 + 4 * nq) = am;
    __syncthreads();
    f32x4 cm = *(const LAS f32x4*)(red + 4 * nq);
#pragma unroll
    for (int w = 1; w < 8; ++w) { const f32x4 o = *(const LAS f32x4*)(red + w * 32 + 4 * nq);
#pragma unroll
        for (int e = 0; e < 4; ++e) cm[e] = fmaxf(cm[e], o[e]); }
    f32x4 inv, sb;
#pragma unroll
    for (int e = 0; e < 4; ++e) { inv[e] = cm[e] > 0.f ? 127.f / cm[e] : 0.f; sb[e] = cm[e] > 0.f ? cm[e] * (1.f / 127.f) : 1.f; }
    if (wave == 0 && lane < 8) *(GAS f32x4*)(SB + n0 + 4 * nq) = sb;
#pragma unroll
    for (int half = 0; half < 2; ++half) {
#pragma unroll
        for (int i = 0; i < 8; ++i) { const int kk = 8 * i + kr;
#pragma unroll
            for (int e = 0; e < 4; ++e) scr[kk * 33 + 4 * nq + e] = v[8 * half + i][e] * inv[e]; }
        LDS_WAIT(); asm volatile("" ::: "memory");
        const int c = lane & 7;
#pragma unroll
        for (int j = 0; j < 4; ++j) { const int n = (lane >> 3) + 8 * j; const LAS float* s = scr + (8 * c) * 33 + n;
            unsigned q[8];
#pragma unroll
            for (int e = 0; e < 8; ++e) q[e] = (unsigned)((int)rintf(s[e * 33]) & 0xff);
            v2u o; o.x = q[0] | (q[1] << 8) | (q[2] << 16) | (q[3] << 24); o.y = q[4] | (q[5] << 8) | (q[6] << 16) | (q[7] << 24);
            *(GAS v2u*)(WT8 + (size_t)(n0 + n) * DM + 128 * wave + 64 * half + 8 * c) = o; }
        LDS_WAIT(); asm volatile("" ::: "memory");
    }
    __syncthreads();
}
__device__ __forceinline__ void cvt_row_to_bf16(const float* xrow, bf16* orow, int lane) {
    const GAS f32x4* xr = (const GAS f32x4*)xrow + lane; GAS unsigned long long* o8 = (GAS unsigned long long*)orow + lane;
    f32x4 v[4];
#pragma unroll
    for (int j = 0; j < 4; ++j) v[j] = xr[64 * j];
#pragma unroll
    for (int j = 0; j < 4; ++j) o8[64 * j] = (unsigned long long)pk2(v[j].x, v[j].y) | ((unsigned long long)pk2(v[j].z, v[j].w) << 32);
}
__device__ __forceinline__ int rel_bucket_dev(int d) {
    if (d < 16) return d;
    int b = 16;
    b += (d >= 21); b += (d >= 27); b += (d >= 35); b += (d >= 46); b += (d >= 59); b += (d >= 77); b += (d >= 99); b += (d >= 128);
    b += (d >= 166); b += (d >= 216); b += (d >= 280); b += (d >= 363); b += (d >= 470); b += (d >= 609); b += (d >= 790);
    return b;
}
struct P0Args { const float *x, *mem, *g_mix, *w_in, *rel_bias, *g_mem, *w_mem_kv, *w_br_attn, *w_br_conv, *w_br_x, *w_out, *g_ffn, *w_query, *sub_keys;
                bf16 *WinT, *WkvT, *WbrT, *WoutT, *WqT, *SK, *HN, *MEMN; float* TAB; float *SA, *SB; };
__device__ __forceinline__ void p0_transposes(const P0Args& a, LAS unsigned char* lds, int part, int gw, int NGW, int wave, int lane) {
    LAS float* scr = (LAS float*)(lds + RING_OFF + wave * 16384);
    constexpr int I_IN = (DM / 64) * (PW / 32), I_KV = (DM / 64) * (1024 / 32), I_BR = (512 / 64) * (1024 / 32), I_OUT = (DM / 64) * (1024 / 32), I_Q = (DM / 64) * (2048 / 32);
    if (part == 0) {
        for (int nb = gw / NWAVES; nb < PW / 32; nb += NGW / NWAVES) p0_quant_cols_wg(a.w_in, PW, (unsigned char*)a.WinT, a.SB, lds, nb, wave, lane);
        for (int it = gw; it < I_KV; it += NGW) p0_transpose_item(a.w_mem_kv, DM, 1024, a.WkvT, 0, nullptr, scr, it, lane);
    } else {
        for (int it = gw; it < 3 * I_BR + I_OUT + I_Q; it += NGW) {
            int r = it;
            if (r < I_BR) { p0_transpose_item(a.w_br_attn, 512, 1024, a.WbrT, 0, nullptr, scr, r, lane); continue; } r -= I_BR;
            if (r < I_BR) { p0_transpose_item(a.w_br_conv, 512, 1024, a.WbrT, 1024, nullptr, scr, r, lane); continue; } r -= I_BR;
            if (r < I_BR) { p0_transpose_item(a.w_br_x, 512, 1024, a.WbrT, 2048, nullptr, scr, r, lane); continue; } r -= I_BR;
            if (r < I_OUT) { p0_transpose_item(a.w_out, DM, 1024, a.WoutT, 0, nullptr, scr, r, lane); continue; } r -= I_OUT;
            p0_transpose_item(a.w_query, DM, 2048, a.WqT, 0, a.g_ffn, scr, r, lane);
        }
    }
}
__device__ __forceinline__ void p0_prologue(const P0Args& a, LAS unsigned char* lds, bool late_part1, int gw, int NGW, int wave, int lane) {
    p0_transposes(a, lds, 0, gw, NGW, wave, lane);
    if (!late_part1) p0_transposes(a, lds, 1, gw, NGW, wave, lane);
    for (int m = gw; m < T; m += 4 * NGW) rms_rows_to_i8<4>(a.x, a.g_mix, (unsigned char*)a.HN, a.SA, m, NGW, T, lane);
    for (int m = gw; m < NBATCH * MEMLEN; m += NGW) rms_rows_to_bf16<1>(a.mem, a.g_mem, a.MEMN, m, NGW, NBATCH * MEMLEN, lane);
    for (int m = gw; m < 256; m += NGW) cvt_row_to_bf16(a.sub_keys + (size_t)m * 1024, a.SK + (size_t)m * 1024, lane);
    for (int m = gw; m < 256; m += NGW) {
        const int idx = m * 64 + lane, h = idx >> 11, d = idx & 2047;
        a.TAB[idx] = a.rel_bias[rel_bucket_dev(d) * 8 + h] * LOG2E;
    }
}

template <int DH> __device__ __forceinline__ void fix_item(bf16* buf, size_t pitch, int row0, int col0, const float* gain, float gscale, float* kmean, LAS float* red, int wave, int lane) {
    constexpr int LPR = DH / 8, RPI = 64 / LPR, NIT = 32 / RPI;
    const int sub = lane / LPR, ch = lane % LPR;
    float g[8], cs[8];
#pragma unroll
    for (int j = 0; j < 8; ++j) { g[j] = gain[ch * 8 + j] * gscale; cs[j] = 0.f; }
    v4u w[NIT];
#pragma unroll
    for (int it = 0; it < NIT; ++it) w[it] = *(const GAS v4u*)(buf + (size_t)(row0 + wave * 32 + it * RPI + sub) * pitch + col0 + ch * 8);
#pragma unroll
    for (int it = 0; it < NIT; ++it) {
        float x[8] = {bflo(w[it].x), bfhi(w[it].x), bflo(w[it].y), bfhi(w[it].y), bflo(w[it].z), bfhi(w[it].z), bflo(w[it].w), bfhi(w[it].w)};
        float ss = 0.f;
#pragma unroll
        for (int j = 0; j < 8; ++j) ss += x[j] * x[j];
#pragma unroll
        for (int o = 1; o < LPR; o <<= 1) ss += __shfl_xor(ss, o);
        const float r = 1.f / sqrtf(ss * (1.f / DH) + RMS_EPS);
#pragma unroll
        for (int j = 0; j < 8; ++j) { x[j] = x[j] * r * g[j]; cs[j] += x[j]; }
        v4u o; o.x = pk2(x[0], x[1]); o.y = pk2(x[2], x[3]); o.z = pk2(x[4], x[5]); o.w = pk2(x[6], x[7]);
        *(GAS v4u*)(buf + (size_t)(row0 + wave * 32 + it * RPI + sub) * pitch + col0 + ch * 8) = o;
    }
    if (kmean) {
#pragma unroll
        for (int j = 0; j < 8; ++j) {
#pragma unroll
            for (int o = LPR; o < 64; o <<= 1) cs[j] += __shfl_xor(cs[j], o);
        }
        if (sub == 0) {
#pragma unroll
            for (int j = 0; j < 8; ++j) red[wave * DH + ch * 8 + j] = cs[j];
        }
        asm volatile("s_waitcnt lgkmcnt(0)\n\ts_barrier" ::: "memory");
        if (wave == 0 && lane < DH) { float s = 0.f;
#pragma unroll
            for (int w8 = 0; w8 < 8; ++w8) s += red[w8 * DH + lane];
            kmean[lane] = s * (1.f / 256.f); }
        asm volatile("s_waitcnt lgkmcnt(0)\n\ts_barrier" ::: "memory");
    }
}
__device__ __forceinline__ void p2_fixup(bf16* PA, bf16* KVM, float* KMEAN, const float* q_gain_a, const float* k_gain_a, const float* q_gain_x, const float* k_gain_x, LAS unsigned char* lds, int vcu, int G, int wave, int lane) {
    constexpr int N_A = 512, N_X = 256, N_KX = 32, NIT = 2 * N_A + N_X + N_KX;
    LAS float* red = (LAS float*)lds;
    for (int it = vcu; it < NIT; it += G) {
        int r = it;
        if (r < N_A) { const int b = r >> 6, h = (r >> 3) & 7, n = r & 7;
            fix_item<64>(PA, PAW, b * SEQ + n * 256, COL_KA + h * 64, k_gain_a, 1.0f, KMEAN + (size_t)((b * 8 + h) * 8 + n) * 64, red, wave, lane); continue; } r -= N_A;
        if (r < N_A) { const int b = r >> 6, h = (r >> 3) & 7, n = r & 7;
            fix_item<64>(PA, PAW, b * SEQ + n * 256, COL_QA + h * 64, q_gain_a, C2A, nullptr, red, wave, lane); continue; } r -= N_A;
        if (r < N_X) { const int b = r >> 5, h = (r >> 3) & 3, n = r & 7;
            fix_item<128>(PA, PAW, b * SEQ + n * 256, COL_QX + h * 128, q_gain_x, C2X, nullptr, red, wave, lane); continue; } r -= N_X;
        { const int b = r >> 2, h = r & 3;
            fix_item<128>(KVM, 1024, b * MEMLEN, h * 128, k_gain_x, 1.0f, nullptr, red, wave, lane); }
    }
}

namespace att {
constexpr int L_K = 0, L_V = 16384, L_BUF = 32768  , L_OST = 0  ,
              L_TAB = 65536, TAB_PAD = 256, L_KM = L_TAB + (TAB_PAD + 2048) * 4, L_SEL = L_KM + 2048, L_WSF = L_SEL + 1024, L_END = L_WSF + NWAVES * 256;
static_assert(L_END <= RING_BYTES, "attention LDS map");
__device__ __forceinline__ int crow(int r, int hi) { return (r & 3) + 8 * (r >> 2) + 4 * hi; }
__device__ __forceinline__ void glds16(const void* gsrc, unsigned lds_dst) { unsigned keep;
    asm volatile("s_mov_b32 %0, m0\n\ts_mov_b32 m0, %2\n\ts_nop 0\n\tglobal_load_lds_dwordx4 %1, off\n\ts_mov_b32 m0, %0" : "=&s"(keep) : "v"(gsrc), "s"(lds_dst) : "memory"); }
__device__ __forceinline__ unsigned cvtpk(float lo, float hi) { typedef float f2 __attribute__((ext_vector_type(2))); typedef __bf16 b2 __attribute__((ext_vector_type(2))); f2 v = {lo, hi}; b2 b = __builtin_convertvector(v, b2); return __builtin_bit_cast(unsigned, b); }
__device__ __forceinline__ float rowmax(const f32x16& p0, const f32x16& p1) {
    float a = fmaxf(p0[0], p1[0]);
#pragma unroll
    for (int r = 1; r < 16; ++r) a = fmaxf(a, fmaxf(p0[r], p1[r]));
    auto rr = __builtin_amdgcn_permlane32_swap(__float_as_uint(a), __float_as_uint(a), false, false);
    return fmaxf(__uint_as_float(rr[0]), __uint_as_float(rr[1]));
}
template <int ND0> __device__ __forceinline__ void qkt(f32x16& p0, f32x16& p1, const LAS unsigned char* Kslot, const bf16x8* qr, int r32, int hi) {
    const LAS unsigned char* kb = Kslot + hi * 1024 + r32 * 16;
#pragma unroll
    for (int d0 = 0; d0 < ND0; ++d0) {
        const bf16x8 b0 = *(const LAS bf16x8*)(kb + d0 * 2048);
        const bf16x8 b1 = *(const LAS bf16x8*)(kb + d0 * 2048 + 512);
        p0 = __builtin_amdgcn_mfma_f32_32x32x16_bf16(b0, qr[d0], p0, 0, 0, 0);
        p1 = __builtin_amdgcn_mfma_f32_32x32x16_bf16(b1, qr[d0], p1, 0, 0, 0);
    }
}
template <int NDB> __device__ __forceinline__ void pv(f32x16* o, int vb, bf16x8 pa0, bf16x8 pa1, bf16x8 pa2, bf16x8 pa3) {
#pragma unroll
    for (int d0 = 0; d0 < NDB; ++d0) { s16x4 lo[4], hi[4];
#pragma unroll
        for (int ks = 0; ks < 4; ++ks) {
            asm volatile("ds_read_b64_tr_b16 %0,%1 offset:%c2" : "=&v"(lo[ks]) : "v"(vb), "i"(d0 * 4096 + ks * 1024) : "memory");
            asm volatile("ds_read_b64_tr_b16 %0,%1 offset:%c2" : "=&v"(hi[ks]) : "v"(vb), "i"(d0 * 4096 + ks * 1024 + 512) : "memory"); }
        asm volatile("s_waitcnt lgkmcnt(0)" ::: "memory"); __builtin_amdgcn_sched_barrier(0);
#define ATT_PK(k) (bf16x8){lo[k][0], lo[k][1], lo[k][2], lo[k][3], hi[k][0], hi[k][1], hi[k][2], hi[k][3]}
        o[d0] = __builtin_amdgcn_mfma_f32_32x32x16_bf16(pa0, ATT_PK(0), o[d0], 0, 0, 0);
        o[d0] = __builtin_amdgcn_mfma_f32_32x32x16_bf16(pa1, ATT_PK(1), o[d0], 0, 0, 0);
        o[d0] = __builtin_amdgcn_mfma_f32_32x32x16_bf16(pa2, ATT_PK(2), o[d0], 0, 0, 0);
        o[d0] = __builtin_amdgcn_mfma_f32_32x32x16_bf16(pa3, ATT_PK(3), o[d0], 0, 0, 0);
#undef ATT_PK
    }
}
#define ATT_BAR() asm volatile("s_waitcnt lgkmcnt(0)\n\ts_barrier" ::: "memory")
#define ATT_WAIT_BAR() asm volatile("s_waitcnt vmcnt(0) lgkmcnt(0)\n\ts_barrier" ::: "memory")

template <int DH, bool MOBA> __device__ __forceinline__ void attn_unit(const bf16* Qp, size_t qpitch, const bf16* Kp, const bf16* Vp, size_t kpitch, bf16* Op, int qb, const float* kmean_bh, const float* tab_h, const float* gq, const float* gk,
                                                                   LAS unsigned char* lds, int tid, int wid, int lane) {
    constexpr int ND0 = DH / 16, NDB = DH / 32, NPIECE = DH / 64;
    asm volatile("" : "+v"(tid), "+v"(lane));
    const int r32 = lane & 31, hi = lane >> 5;
    const unsigned lds0 = (unsigned)(uintptr_t)lds;
    LAS float* wsf = (LAS float*)(lds + L_WSF) + wid * 64;
    ATT_BAR();
    int my_sel = 0;
    if (MOBA) {
        LAS float* tl = (LAS float*)(lds + L_TAB);
        for (int i = tid; i < TAB_PAD + 2048; i += NWAVES * 64) tl[i] = (i < TAB_PAD) ? -INFINITY : tab_h[i - TAB_PAD];
        LAS float* km = (LAS float*)(lds + L_KM);
        for (int i = tid; i < 512; i += NWAVES * 64) km[i] = kmean_bh[i];
        ATT_BAR();
        if (tid < 256) {
            int sel = 0;
            if (qb <= 3) sel = (1 << qb) - 1;
            else {
                const GAS v4u* qrow = (const GAS v4u*)(Qp + (size_t)tid * qpitch);
                v4u qw[8];
#pragma unroll
                for (int c = 0; c < 8; ++c) qw[c] = qrow[c];
                float b1 = -INFINITY, b2 = -INFINITY, b3 = -INFINITY; int i1 = 0, i2 = 0, i3 = 0;
#pragma unroll 1
                for (int n = 0; n < qb; ++n) { float s = 0.f; const LAS f32x4* kr = (const LAS f32x4*)(km + n * 64);
#pragma unroll
                    for (int c = 0; c < 8; ++c) { const f32x4 ka = kr[2 * c], kb2 = kr[2 * c + 1]; const v4u w = qw[c];
                        s += bflo(w.x) * ka.x; s += bfhi(w.x) * ka.y; s += bflo(w.y) * ka.z; s += bfhi(w.y) * ka.w;
                        s += bflo(w.z) * kb2.x; s += bfhi(w.z) * kb2.y; s += bflo(w.w) * kb2.z; s += bfhi(w.w) * kb2.w; }
                    if (s > b1) { b3 = b2; i3 = i2; b2 = b1; i2 = i1; b1 = s; i1 = n; }
                    else if (s > b2) { b3 = b2; i3 = i2; b2 = s; i2 = n; }
                    else if (s > b3) { b3 = s; i3 = n; } }
                sel = (1 << i1) | (1 << i2) | (1 << i3);
            }
            ((LAS int*)(lds + L_SEL))[tid] = sel;
        }
        ATT_BAR();
        my_sel = ((LAS int*)(lds + L_SEL))[wid * 32 + r32];
    }
    bf16x8 qr[ND0];
    { const bf16* Qw = Qp + (size_t)(wid * 32 + r32) * qpitch + hi * 8;
#pragma unroll
      for (int d0 = 0; d0 < ND0; ++d0) qr[d0] = *(const GAS bf16x8*)(Qw + d0 * 16); }
    if (!MOBA) {
        LAS float* rk = (LAS float*)(lds + L_KM);
        { const int key = tid >> 1, half = tid & 1; const GAS v4u* kr = (const GAS v4u*)(Kp + (size_t)key * kpitch + half * 64); float ss = 0.f;
#pragma unroll
          for (int c = 0; c < 8; ++c) { const v4u w = kr[c]; const float a0 = bflo(w.x), a1 = bfhi(w.x), a2 = bflo(w.y), a3 = bfhi(w.y), a4 = bflo(w.z), a5 = bfhi(w.z), a6 = bflo(w.w), a7 = bfhi(w.w);
              ss += (a0 * a0 + a1 * a1) + (a2 * a2 + a3 * a3) + (a4 * a4 + a5 * a5) + (a6 * a6 + a7 * a7); }
          ss += __shfl_xor(ss, 1);
          if (half == 0) rk[key] = 1.0f / sqrtf(ss * (1.f / 128.f) + RMS_EPS); }
        float qs = 0.f;
#pragma unroll
        for (int d0 = 0; d0 < ND0; ++d0) { const v4u w = __builtin_bit_cast(v4u, qr[d0]); const float a0 = bflo(w.x), a1 = bfhi(w.x), a2 = bflo(w.y), a3 = bfhi(w.y), a4 = bflo(w.z), a5 = bfhi(w.z), a6 = bflo(w.w), a7 = bfhi(w.w);
            qs += (a0 * a0 + a1 * a1) + (a2 * a2 + a3 * a3) + (a4 * a4 + a5 * a5) + (a6 * a6 + a7 * a7); }
        { auto rr = __builtin_amdgcn_permlane32_swap(__float_as_uint(qs), __float_as_uint(qs), false, false); qs = __uint_as_float(rr[0]) + __uint_as_float(rr[1]); }
        const float rq = C2X / sqrtf(qs * (1.f / 128.f) + RMS_EPS);
        int hi8 = hi * 8; asm volatile("" : "+v"(hi8));
#pragma unroll
        for (int d0 = 0; d0 < ND0; ++d0) { const v4u w = __builtin_bit_cast(v4u, qr[d0]);
            const f32x4 ga = *(const GAS f32x4*)(gq + d0 * 16 + hi8), gb = *(const GAS f32x4*)(gq + d0 * 16 + hi8 + 4), ka = *(const GAS f32x4*)(gk + d0 * 16 + hi8), kb2 = *(const GAS f32x4*)(gk + d0 * 16 + hi8 + 4);
            v4u o; o.x = cvtpk(bflo(w.x) * rq * ga.x * ka.x, bfhi(w.x) * rq * ga.y * ka.y); o.y = cvtpk(bflo(w.y) * rq * ga.z * ka.z, bfhi(w.y) * rq * ga.w * ka.w);
            o.z = cvtpk(bflo(w.z) * rq * gb.x * kb2.x, bfhi(w.z) * rq * gb.y * kb2.y); o.w = cvtpk(bflo(w.w) * rq * gb.z * kb2.z, bfhi(w.w) * rq * gb.w * kb2.w);
            qr[d0] = __builtin_bit_cast(bf16x8, o); }
    }
    float m_ref = 0.f, l_run = 0.f;
    constexpr float THR = 8.0f;
    float bfar = 0.f; if (MOBA) bfar = ((const LAS float*)(lds + L_TAB))[TAB_PAD + 2047];
    f32x16 o[NDB];
#pragma unroll
    for (int d = 0; d < NDB; ++d) o[d] = f32x16{};
    const int vb0 = (int)(lds0 + L_V) + ((lane >> 4) & 1) * 32 + (lane & 3) * 8 + (4 * hi + ((lane & 15) >> 2)) * 64;
    const int qrel = wid * 32 + r32;
    const int ntiles = MOBA ? 4 + 4 * qb : 4;
    constexpr int SUB = (DH == 64) ? 2 : 1;
    const int nsteps = ntiles / SUB;
    auto issue_step = [&](int st) {
#pragma unroll
        for (int sub = 0; sub < SUB; ++sub) { const int tt = st * SUB + sub;
            int kb_, j_; if (MOBA) { if (tt < 4) { kb_ = qb; j_ = tt; } else { kb_ = (tt - 4) >> 2; j_ = (tt - 4) & 3; } } else { kb_ = 0; j_ = tt; }
            const int key0_ = kb_ * 256 + j_ * 64; const unsigned bo_ = (unsigned)(st & 1) * L_BUF + (unsigned)sub * 8192u;
#pragma unroll
            for (int pc = 0; pc < NPIECE; ++pc) { const int p = wid + 8 * pc;
                glds16(Kp + (size_t)(key0_ + lane) * kpitch + p * 8, (unsigned)__builtin_amdgcn_readfirstlane(lds0 + bo_ + L_K + p * 1024));
                glds16(Vp + (size_t)(key0_ + 16 * (p & 3) + (lane >> 2)) * kpitch + (p >> 2) * 32 + (lane & 3) * 8, (unsigned)__builtin_amdgcn_readfirstlane(lds0 + bo_ + L_V + p * 1024)); } }
    };
    issue_step(0);
    for (int st = 0; st < nsteps; ++st) {
        ATT_WAIT_BAR();
        if (st + 1 < nsteps) issue_step(st + 1);
#pragma unroll 1
      for (int sub = 0; sub < SUB; ++sub) { const int tt = st * SUB + sub;
        int kb, j; bool own;
        if (MOBA) { if (tt < 4) { kb = qb; j = tt; own = true; } else { kb = (tt - 4) >> 2; j = (tt - 4) & 3; own = false; } }
        else { kb = 0; j = tt; own = false; }
        if (MOBA && own && 64 * j > wid * 32 + 31) continue;
        const unsigned bo = (unsigned)(st & 1) * L_BUF + (unsigned)sub * 8192u;
        f32x16 p0, p1;
        if (MOBA) {
            const float base = ((own || (((my_sel >> kb) & 1) != 0)) ? 0.f : -INFINITY) - m_ref;
            if (!own && qb - kb >= 5) {
                const float cb = base + bfar;
#pragma unroll
                for (int r = 0; r < 16; ++r) { p0[r] = cb; p1[r] = cb; }
            } else {
                const int dbase = (qb - kb) * 256 + qrel - 64 * j - 4 * hi;
                const LAS float* tp = (const LAS float*)(lds + L_TAB) + TAB_PAD + dbase - 63;
#pragma unroll
                for (int r = 0; r < 16; ++r) { const int c = (r & 3) + 8 * (r >> 2); p0[r] = tp[63 - c] + base; p1[r] = tp[31 - c] + base; }
            }
            qkt<ND0>(p0, p1, lds + bo + L_K, qr, r32, hi);
        } else {
            p0 = f32x16{}; p1 = f32x16{};
            qkt<ND0>(p0, p1, lds + bo + L_K, qr, r32, hi);
            const LAS float* rkp = (const LAS float*)(lds + L_KM) + j * 64 + 4 * hi;
#pragma unroll
            for (int r = 0; r < 16; ++r) { const int c = (r & 3) + 8 * (r >> 2); p0[r] = p0[r] * rkp[c] - m_ref; p1[r] = p1[r] * rkp[c + 32] - m_ref; }
        }
        const float rm = rowmax(p0, p1);
        if (__any(rm > THR)) {
            const float dl = fmaxf(rm, 0.f); m_ref += dl;
#pragma unroll
            for (int r = 0; r < 16; ++r) { p0[r] -= dl; p1[r] -= dl; }
            const float f = __builtin_amdgcn_exp2f(-dl); l_run *= f;
            if (hi == 0) wsf[r32] = f;
            LDS_WAIT();
#pragma unroll
            for (int r = 0; r < 16; ++r) { const float ff = wsf[crow(r, hi)];
#pragma unroll
                for (int d = 0; d < NDB; ++d) o[d][r] *= ff; }
        }
        float ps = 0.f;
#pragma unroll
        for (int r = 0; r < 16; ++r) { p0[r] = __builtin_amdgcn_exp2f(p0[r]); p1[r] = __builtin_amdgcn_exp2f(p1[r]); ps += p0[r] + p1[r]; }
        l_run += ps;
        v4u pw0, pw1, pw2, pw3;
        pw0 = (v4u){cvtpk(p0[0], p0[1]), cvtpk(p0[2], p0[3]), cvtpk(p0[4], p0[5]), cvtpk(p0[6], p0[7])};
        pw1 = (v4u){cvtpk(p0[8], p0[9]), cvtpk(p0[10], p0[11]), cvtpk(p0[12], p0[13]), cvtpk(p0[14], p0[15])};
        pw2 = (v4u){cvtpk(p1[0], p1[1]), cvtpk(p1[2], p1[3]), cvtpk(p1[4], p1[5]), cvtpk(p1[6], p1[7])};
        pw3 = (v4u){cvtpk(p1[8], p1[9]), cvtpk(p1[10], p1[11]), cvtpk(p1[12], p1[13]), cvtpk(p1[14], p1[15])};
        pv<NDB>(o, vb0 + (int)bo, __builtin_bit_cast(bf16x8, pw0), __builtin_bit_cast(bf16x8, pw1), __builtin_bit_cast(bf16x8, pw2), __builtin_bit_cast(bf16x8, pw3));
      }
    }
    { auto rr = __builtin_amdgcn_permlane32_swap(__float_as_uint(l_run), __float_as_uint(l_run), false, false); l_run = __uint_as_float(rr[0]) + __uint_as_float(rr[1]); }
    if (hi == 0) wsf[32 + r32] = l_run;
    ATT_BAR();
    LAS bf16* stg = (LAS bf16*)(lds + L_OST + wid * 8192);
#pragma unroll
    for (int r = 0; r < 16; ++r) { const int orow = crow(r, hi); const float rl = __builtin_amdgcn_rcpf(wsf[32 + orow]);
#pragma unroll
        for (int d = 0; d < NDB; ++d) stg[orow * DH + d * 32 + r32] = (bf16)f2bf(o[d][r] * rl); }
    LDS_WAIT();
    constexpr int CPR = DH / 8;
    int lane2 = lane; asm volatile("" : "+v"(lane2));
#pragma unroll
    for (int i = 0; i < (32 * CPR) / 64; ++i) { const int idx = i * 64 + lane2, row = idx / CPR, ch = idx % CPR;
        const v4u v = *(const LAS v4u*)(stg + row * DH + ch * 8);
        *(GAS v4u*)(Op + (size_t)(wid * 32 + row) * 512 + ch * 8) = v; }
}
#undef ATT_BAR
#undef ATT_WAIT_BAR
}

__device__ __forceinline__ void conv_item(const bf16* PA, const float* conv_w, bf16* CO, int item, int tid) {
    asm volatile("" : "+v"(tid));
    const int ch = (tid & 63) * 8, r0 = item * 64 + (tid >> 6) * 8;
    float w0[8], w1[8], w2[8];
#pragma unroll
    for (int j = 0; j < 8; ++j) { w0[j] = conv_w[ch + j]; w1[j] = conv_w[512 + ch + j]; w2[j] = conv_w[1024 + ch + j]; }
    float pm2[8], pm1[8];
#pragma unroll
    for (int j = 0; j < 8; ++j) { pm2[j] = 0.f; pm1[j] = 0.f; }
    auto load8 = [&](int row, int col, float* o) { const v4u w = *(const GAS v4u*)(PA + (size_t)row * PAW + col + ch);
        o[0] = bflo(w.x); o[1] = bfhi(w.x); o[2] = bflo(w.y); o[3] = bfhi(w.y); o[4] = bflo(w.z); o[5] = bfhi(w.z); o[6] = bflo(w.w); o[7] = bfhi(w.w); };
    const int s0 = r0 & (SEQ - 1);
    if (s0 >= 2) { float a[8], b[8]; load8(r0 - 2, COL_CC, a); load8(r0 - 2, COL_UC, b);
#pragma unroll
        for (int j = 0; j < 8; ++j) pm2[j] = a[j] * b[j]; }
    if (s0 >= 1) { float a[8], b[8]; load8(r0 - 1, COL_CC, a); load8(r0 - 1, COL_UC, b);
#pragma unroll
        for (int j = 0; j < 8; ++j) pm1[j] = a[j] * b[j]; }
#pragma unroll
    for (int i = 0; i < 8; ++i) { const int row = r0 + i; float c[8], u[8], bb[8], y[8];
        load8(row, COL_CC, c); load8(row, COL_UC, u); load8(row, COL_BC, bb);
#pragma unroll
        for (int j = 0; j < 8; ++j) { const float cur = c[j] * u[j]; y[j] = bb[j] * (w0[j] * pm2[j] + w1[j] * pm1[j] + w2[j] * cur); pm2[j] = pm1[j]; pm1[j] = cur; }
        v4u o; o.x = pk2(y[0], y[1]); o.y = pk2(y[2], y[3]); o.z = pk2(y[4], y[5]); o.w = pk2(y[6], y[7]);
        *(GAS v4u*)(CO + (size_t)row * 512 + ch) = o; }
}

namespace pk {
template <int N> __device__ __forceinline__ void bsort_desc(unsigned (&a)[N]) {
#pragma unroll
    for (int k = 2; k <= N; k <<= 1) {
#pragma unroll
        for (int j = k >> 1; j > 0; j >>= 1) {
#pragma unroll
            for (int i = 0; i < N; ++i) { const int l = i ^ j;
                if (l > i) { const unsigned x = a[i], y = a[l]; const unsigned mx = x > y ? x : y, mn = x > y ? y : x;
                    if ((i & k) == 0) { a[i] = mx; a[l] = mn; } else { a[i] = mn; a[l] = mx; } } } } }
}
template <int N> __device__ __forceinline__ void bmerge_desc(unsigned (&a)[N]) {
#pragma unroll
    for (int j = N >> 1; j > 0; j >>= 1) {
#pragma unroll
        for (int i = 0; i < N; ++i) { const int l = i ^ j; if (l > i) { const unsigned x = a[i], y = a[l]; a[i] = x > y ? x : y; a[l] = x > y ? y : x; } } }
}
__device__ __forceinline__ void top16_merge(unsigned (&x)[16], const unsigned (&y)[16]) {
#pragma unroll
    for (int i = 0; i < 16; ++i) x[i] = x[i] > y[15 - i] ? x[i] : y[15 - i];
    bmerge_desc<16>(x);
}
__device__ __forceinline__ unsigned f2ord(float f) { const unsigned u = __float_as_uint(f); return u ^ ((unsigned)((int)u >> 31) | 0x80000000u); }
__device__ __forceinline__ float ord2f(unsigned o) { return __uint_as_float(o ^ ((o & 0x80000000u) ? 0x80000000u : 0xFFFFFFFFu)); }

constexpr int L_TBL = 0;
__device__ __forceinline__ void topk_fill(const bf16* SK, LAS unsigned char* lds, int hp, int tid) {
    for (int tb = 0; tb < 4; ++tb) { const bf16* src = SK + (size_t)(((2 * hp + (tb >> 1)) * 2 + (tb & 1)) * 128) * 128;
        for (int idx = tid; idx < 2048; idx += NWAVES * 64) { const int key = idx >> 4, c16 = idx & 15;
            const v4u w = *(const GAS v4u*)(src + key * 128 + c16 * 8);
            *(LAS v4u*)(lds + L_TBL + tb * 32768 + (c16 * 4 + (key >> 5)) * 512 + (key & 31) * 16) = w; } }
    asm volatile("s_waitcnt vmcnt(0) lgkmcnt(0)\n\ts_barrier" ::: "memory");
}
__device__ __forceinline__ void topk_task(const bf16* QRY, const float* SLOTS, unsigned* SEL, LAS unsigned char* lds, int hp, int t0, int lane) {
    asm volatile("" : "+v"(lane));
    const int r32 = lane & 31, hi = lane >> 5;
    const int tok = t0 + r32;
    float rn; { const GAS f32x4* sl = (const GAS f32x4*)(SLOTS + (size_t)tok * 16); const f32x4 a = sl[0], b = sl[1], c = sl[2], d = sl[3];
        const float ss = ((a.x + a.y) + (a.z + a.w)) + ((b.x + b.y) + (b.z + b.w)) + ((c.x + c.y) + (c.z + c.w)) + ((d.x + d.y) + (d.z + d.w));
        rn = 1.f / sqrtf(ss * (1.f / 1024.f) + RMS_EPS); }
    unsigned L[4][16];
#pragma unroll
    for (int tb = 0; tb < 4; ++tb) {
        const int hh = tb >> 1, p = tb & 1;
        const bf16* qp = QRY + (size_t)tok * 2048 + ((2 * hp + hh) * 2 + p) * 128 + hi * 8;
        bf16x8 qf[8];
#pragma unroll
        for (int kk = 0; kk < 8; ++kk) qf[kk] = *(const GAS bf16x8*)(qp + kk * 16);
        f32x16 acc[4];
#pragma unroll
        for (int blk = 0; blk < 4; ++blk) acc[blk] = f32x16{};
        const LAS unsigned char* tbase = lds + L_TBL + tb * 32768 + hi * 2048 + r32 * 16;
#pragma unroll
        for (int kk = 0; kk < 8; ++kk)
#pragma unroll
            for (int blk = 0; blk < 4; ++blk) { const bf16x8 af = *(const LAS bf16x8*)(tbase + kk * 4096 + blk * 512);
                acc[blk] = __builtin_amdgcn_mfma_f32_32x32x16_bf16(af, qf[kk], acc[blk], 0, 0, 0); }
        unsigned g[4][16];
#pragma unroll
        for (int blk = 0; blk < 4; ++blk)
#pragma unroll
            for (int r = 0; r < 16; ++r) g[blk][r] = (f2ord(acc[blk][r]) & ~127u) | (unsigned)(127 - (32 * blk + (r & 3) + 8 * (r >> 2)));
#pragma unroll
        for (int blk = 0; blk < 4; ++blk) bsort_desc<16>(g[blk]);
        top16_merge(g[0], g[1]); top16_merge(g[2], g[3]); top16_merge(g[0], g[2]);
#pragma unroll
        for (int i = 0; i < 16; ++i) L[tb][i] = g[0][i] ^ (unsigned)(4 * hi);
    }
    unsigned A[2][16];
#pragma unroll
    for (int p = 0; p < 2; ++p) {
        unsigned X[16], Y[16];
#pragma unroll
        for (int i = 0; i < 16; ++i) { auto rr = __builtin_amdgcn_permlane32_swap(L[p][i], L[2 + p][i], false, false); X[i] = rr[0]; Y[i] = rr[1]; }
        top16_merge(X, Y);
#pragma unroll
        for (int i = 0; i < 16; ++i) A[p][i] = X[i];
    }
    float f0[16], f1[16];
#pragma unroll
    for (int i = 0; i < 16; ++i) { f0[i] = ord2f(A[0][i] & ~127u); f1[i] = ord2f(A[1][i] & ~127u); }
    float sums[50]; unsigned keys[50];
    { int c = 0;
#pragma unroll
      for (int i = 0; i < 16; ++i)
#pragma unroll
          for (int j = 0; j < 16; ++j) if ((i + 1) * (j + 1) <= 16) { sums[c] = f0[i] + f1[j]; keys[c] = (f2ord(sums[c]) & ~63u) | (unsigned)(63 - c); ++c; } }
    unsigned G0[16], R[32];
#pragma unroll
    for (int i = 0; i < 16; ++i) G0[i] = keys[i];
#pragma unroll
    for (int i = 0; i < 32; ++i) R[i] = (i < 26) ? keys[24 + i] : 0u;
    bsort_desc<32>(R);
#pragma unroll
    for (int i = 0; i < 16; ++i) G0[i] = G0[i] > R[15 - i] ? G0[i] : R[15 - i];
    bmerge_desc<16>(G0);
#pragma unroll
    for (int i = 8; i < 16; ++i) G0[i] = G0[i] > keys[16 + 15 - i] ? G0[i] : keys[16 + 15 - i];
    unsigned thr = G0[0];
#pragma unroll
    for (int i = 1; i < 16; ++i) thr = thr < G0[i] ? thr : G0[i];
    const float s00 = sums[0], sc = rn * LOG2E;
    float w[50]; float den = 0.f;
#pragma unroll
    for (int c = 0; c < 50; ++c) { w[c] = (keys[c] >= thr) ? __builtin_amdgcn_exp2f((sums[c] - s00) * sc) : 0.f; den += w[c]; }
    const float inv = 1.f / den;
    unsigned i0[16], i1[16];
#pragma unroll
    for (int i = 0; i < 16; ++i) { i0[i] = 127u - (A[0][i] & 127u); i1[i] = 127u - (A[1][i] & 127u); }
    GAS unsigned* outp = (GAS unsigned*)(SEL + ((size_t)tok * 8 + 2 * hp + hi) * 16);
    int pos = 0;
    { int c = 0;
#pragma unroll
      for (int i = 0; i < 16; ++i)
#pragma unroll
          for (int j = 0; j < 16; ++j) if ((i + 1) * (j + 1) <= 16) { if (keys[c] >= thr) { outp[pos & 15] = ((i0[i] * 128u + i1[j]) << 16) | f2bf(w[c] * inv); ++pos; } ++c; } }
}
}

constexpr size_t SLICE_BYTES = (size_t)NEXP * 128;
constexpr int TH = T / 2;
__device__ __forceinline__ unsigned nib4(float a, float b, float c, float d, float is, int off) {
    const int n0 = min(max((int)floorf(a * is), -8), 7) + off, n1 = min(max((int)floorf(b * is), -8), 7) + off, n2 = min(max((int)floorf(c * is), -8), 7) + off, n3 = min(max((int)floorf(d * is), -8), 7) + off;
    return (unsigned)(n0 & 15) | ((unsigned)(n1 & 15) << 8) | ((unsigned)(n2 & 15) << 16) | ((unsigned)(n3 & 15) << 24);
}
template <int NR, bool OFFLO> __device__ __forceinline__ void quant_rows_i4(const float* X, unsigned char* qtab, float* scale, int e0, int es, int eend, int lane) {
    f32x4 v[NR][4];
#pragma unroll
    for (int r = 0; r < NR; ++r) { const int e = (e0 + r * es < eend) ? e0 + r * es : eend - 1; const GAS f32x4* xr = (const GAS f32x4*)(X + (size_t)e * DM) + lane;
#pragma unroll
        for (int j = 0; j < 4; ++j) v[r][j] = xr[64 * j]; }
#pragma unroll
    for (int r = 0; r < NR; ++r) { float ss = 0.f;
#pragma unroll
        for (int j = 0; j < 4; ++j) ss += (v[r][j].x * v[r][j].x + v[r][j].y * v[r][j].y) + (v[r][j].z * v[r][j].z + v[r][j].w * v[r][j].w);
        ss = wave_sum(ss);
        const float step = ss > 0.f ? 0.3352f * sqrtf(ss * (1.f / 1024.f)) : 1.f, is = 1.f / step;
        const int e = e0 + r * es;
        const unsigned twoc = (OFFLO && !(lane & 1)) ? 0u : 0x08080808u;
#pragma unroll
        for (int j = 0; j < 4; ++j) {
            const f32x4 y = v[r][j] * is + 7.5f;
            unsigned z[4];
#pragma unroll
            for (int e = 0; e < 4; ++e) z[e] = __builtin_bit_cast(unsigned, __builtin_amdgcn_fmed3f(y[e], -0.5f, 15.0f) + 8388864.0f);
            const unsigned o = (__builtin_amdgcn_perm(z[1], z[0], 0x0c0c0400u) | __builtin_amdgcn_perm(z[3], z[2], 0x04000c0cu)) ^ twoc;
            const unsigned po = (unsigned)__builtin_amdgcn_update_dpp(0, (int)o, 0xB1, 0xf, 0xf, true);
            if (e < eend && !(lane & 1)) *(GAS unsigned*)(qtab + (size_t)j * SLICE_BYTES + (size_t)e * 128 + (lane >> 1) * 4) = o | (po << 4); }
        if (e < eend && lane == 0) scale[e] = 0.5f * step; }
}
template <int NR> __device__ __forceinline__ void quant_x(const bf16* HB, unsigned char* XQ, float* SX, int* XS, const float (&gf)[16], int t0, int ts, int lane) {
    f32x4 hv[NR][4];
#pragma unroll
    for (int r = 0; r < NR; ++r) { const int t = (t0 + r * ts < T) ? t0 + r * ts : T - 1; const GAS v2u* hrow = (const GAS v2u*)(HB + (size_t)t * DM) + lane;
#pragma unroll
        for (int j = 0; j < 4; ++j) { const v2u w = hrow[64 * j]; hv[r][j] = (f32x4){bflo(w.x), bfhi(w.x), bflo(w.y), bfhi(w.y)}; } }
#pragma unroll
    for (int r = 0; r < NR; ++r) { float ss = 0.f;
#pragma unroll
        for (int j = 0; j < 4; ++j) ss += (hv[r][j].x * hv[r][j].x + hv[r][j].y * hv[r][j].y) + (hv[r][j].z * hv[r][j].z + hv[r][j].w * hv[r][j].w);
        const float rn = 1.f / sqrtf(wave_sum(ss) * (1.f / 1024.f) + RMS_EPS);
        float xn[16]; float am = 0.f;
#pragma unroll
        for (int j = 0; j < 4; ++j)
#pragma unroll
            for (int e = 0; e < 4; ++e) { xn[4 * j + e] = hv[r][j][e] * rn * gf[4 * j + e]; am = fmaxf(am, fabsf(xn[4 * j + e])); }
#pragma unroll
        for (int o = 1; o < 64; o <<= 1) am = fmaxf(am, __shfl_xor(am, o));
        const float sx = am > 0.f ? am * (1.f / 119.f) : 1.f, isx = 1.f / sx;
        const int t = t0 + r * ts;
        float qsf = 0.f;
#pragma unroll
        for (int j = 0; j < 4; ++j) {
            unsigned zh[4], zl[4];
#pragma unroll
            for (int e = 0; e < 4; ++e) { const float q = __builtin_rintf(xn[4 * j + e] * isx), qh = __builtin_floorf(q * 0.0625f + 0.5f), ql = q - 16.f * qh; qsf += q;
                zh[e] = __builtin_bit_cast(unsigned, qh + 12582912.0f); zl[e] = __builtin_bit_cast(unsigned, ql + 12582912.0f); }
            const unsigned ph = (__builtin_amdgcn_perm(zh[1], zh[0], 0x0c0c0400u) | __builtin_amdgcn_perm(zh[3], zh[2], 0x04000c0cu)) & 0x0f0f0f0fu;
            const unsigned pl = (__builtin_amdgcn_perm(zl[1], zl[0], 0x0c0c0400u) | __builtin_amdgcn_perm(zl[3], zl[2], 0x04000c0cu)) & 0x0f0f0f0fu;
            const unsigned oh = (unsigned)__builtin_amdgcn_update_dpp(0, (int)ph, 0xB1, 0xf, 0xf, true), ol = (unsigned)__builtin_amdgcn_update_dpp(0, (int)pl, 0xB1, 0xf, 0xf, true);
            const unsigned word = (lane & 1) ? (ol | (pl << 4)) : (ph | (oh << 4));
            if (t < T) *(GAS unsigned*)(XQ + (size_t)t * DM + j * 256 + (lane >> 3) * 32 + (lane & 1) * 16 + ((lane & 7) >> 1) * 4) = word; }
        int qs = (int)qsf;
#pragma unroll
        for (int o = 1; o < 64; o <<= 1) qs += __shfl_xor(qs, o);
        if (t < T && lane == 0) { SX[t] = sx; XS[t] = qs; } }
}
__device__ __forceinline__ float gelu_exact(float x) { return 0.5f * x * (1.0f + erff(x * 0.70710678118654752f)); }
__device__ __forceinline__ int dpp_i(int v, int ctrl_is) {
    return ctrl_is == 0 ? __builtin_amdgcn_update_dpp(0, v, 0x141, 0xf, 0xf, true) : ctrl_is == 1 ? __builtin_amdgcn_update_dpp(0, v, 0xB1, 0xf, 0xf, true) : __builtin_amdgcn_update_dpp(0, v, 0x4E, 0xf, 0xf, true);
}
constexpr int QCHUNK = 8;
__device__ __forceinline__ int q_take(unsigned* q, int lane) {
    unsigned v = 0; if (lane == 0) v = __hip_atomic_fetch_add(q, (unsigned)QCHUNK, __ATOMIC_RELAXED, __HIP_MEMORY_SCOPE_AGENT);
    return (int)__builtin_amdgcn_readfirstlane(v);
}
struct TokStream {
    unsigned* q; int cur, end, nxt, stride;
    __device__ __forceinline__ void open_static(int c0, int W) { q = nullptr; cur = c0 * QCHUNK; end = cur + QCHUNK; nxt = 0; stride = W * QCHUNK; }
    __device__ __forceinline__ void open(unsigned* q_, int lane) { q = q_; stride = 0;
        unsigned v = 0; if (lane == 0) v = __hip_atomic_fetch_add(q, 2u * (unsigned)QCHUNK, __ATOMIC_RELAXED, __HIP_MEMORY_SCOPE_AGENT);
        cur = (int)__builtin_amdgcn_readfirstlane(v); end = cur + QCHUNK; nxt = cur + QCHUNK; }
    __device__ __forceinline__ int next(int lane) { const int t = cur; if (t >= TH) return TH; ++cur;
        if (cur == end) { if (q) { cur = nxt; end = cur + QCHUNK; if (cur < TH) nxt = q_take(q, lane); } else { cur += stride - QCHUNK; end = cur + QCHUNK; } }
        return t; }
};
struct SlicePlan { int xcc, srank, sW; unsigned cnts; };
__device__ __forceinline__ SlicePlan slice_plan(int xcc, int srank, int sW, const unsigned* xcnt  , int lane) {
    SlicePlan p; p.xcc = xcc; p.srank = srank; p.sW = sW;
    p.cnts = (sW > 0 && lane < 8) ? __hip_atomic_load(xcnt + 64 * lane, __ATOMIC_RELAXED, __HIP_MEMORY_SCOPE_AGENT) : 0u;
    return p;
}
__device__ __forceinline__ bool slice_open(TokStream& S, const SlicePlan& p, int qi, int x, unsigned* queues, int lane) {
    if (p.sW > 0 && qi == 0) { S.open_static(p.srank, p.sW); return true; }
    if (p.sW > 0 && (unsigned)__builtin_amdgcn_readlane((int)p.cnts, x) != 0u) return false;
    S.open(queues + 64 * x, lane); return true;
}
#define MEM_ORDER() asm volatile("" ::: "memory")
#ifdef PROBE_MASKV
#define PROBE_EMASK & emask
#define PROBE_EARG , unsigned emask
#define PROBE_EPASS , emask
#else
#define PROBE_EMASK
#define PROBE_EARG
#define PROBE_EPASS
#endif
__device__ __forceinline__ unsigned bperm(int src_lane4, unsigned v) { return (unsigned)__builtin_amdgcn_ds_bpermute(src_lane4, (int)v); }
struct UEnt { v2u R; unsigned x; };
__device__ __forceinline__ void u_ent(UEnt& E, const unsigned* SEL, const unsigned char* XQ, int t, int cs, int lane) {
    E.x = *(const GAS unsigned*)(XQ + (size_t)t * DM + cs * 256 + 4 * lane);
    E.R = *(const GAS v2u*)(SEL + (size_t)t * 128 + 2 * lane);
}
__device__ __forceinline__ void u_rows(v4u (&w)[16], unsigned& xr, const UEnt& E, int lane, const unsigned char* tab, unsigned choff PROBE_EARG) {
    const v2u R = E.R;
    const int gb = (lane >> 3) * 32;
#pragma unroll
    for (int g = 0; g < 16; ++g) { const unsigned e = bperm(gb + 4 * (g >> 1), (g & 1) ? R.y : R.x);
        w[g] = *(const GAS v4u*)(tab + (unsigned)(((e >> 16) PROBE_EMASK) * 128u + choff)); }
    xr = E.x;
}
__device__ __forceinline__ int dot8z(unsigned a, unsigned b) { int r; asm("v_dot8_i32_i4 %0, %1, %2, 0" : "=v"(r) : "v"(a), "v"(b)); return r; }
__device__ __forceinline__ void u_compute(const v4u (&w)[16], const unsigned xr, int* prow, int grp, int ch, int c0, int c1, int c2) {
    int p[16];
    v4u xh, xl;
#pragma unroll
    for (int j = 0; j < 4; ++j) { xh[j] = bperm(32 * ch + 4 * j, xr); xl[j] = bperm(32 * ch + 16 + 4 * j, xr); }
#pragma unroll
    for (int g = 0; g < 16; ++g) { int ah = dot8z(w[g][0], xh[0]), al = dot8z(w[g][0], xl[0]);
#pragma unroll
        for (int j = 1; j < 4; ++j) { ah = __builtin_amdgcn_sdot8((int)w[g][j], (int)xh[j], ah, false); al = __builtin_amdgcn_sdot8((int)w[g][j], (int)xl[j], al, false); }
        p[g] = (ah << 4) + al; }
    int q8[8], q4[4], q2[2];
#pragma unroll
    for (int i = 0; i < 8; ++i) { const int keep = c2 ? p[i + 8] : p[i], send = c2 ? p[i] : p[i + 8]; q8[i] = keep + dpp_i(send, 0); }
#pragma unroll
    for (int i = 0; i < 4; ++i) { const int keep = c0 ? q8[i + 4] : q8[i], send = c0 ? q8[i] : q8[i + 4]; q4[i] = keep + dpp_i(send, 1); }
#pragma unroll
    for (int i = 0; i < 2; ++i) { const int keep = c1 ? q4[i + 2] : q4[i], send = c1 ? q4[i] : q4[i + 2]; q2[i] = keep + dpp_i(send, 2); }
    const int g0 = 8 * c2 + 4 * c0 + 2 * c1;
    typedef int i2 __attribute__((ext_vector_type(2)));
    *(GAS i2*)(prow + grp * 16 + g0) = (i2){q2[0], q2[1]};
}
__device__ __forceinline__ void gather_u(const unsigned* SEL0, const unsigned char* XQ0, const unsigned char* UQS, int* PART, int* dummy, unsigned* queues, const SlicePlan& plan, int lane PROBE_EARG) {
    const int grp = lane >> 3, ch = lane & 7, c0 = ch & 1, c1 = (ch >> 1) & 1, c2 = (ch >> 2) & 1;
    for (int qi = 0; qi < 8; ++qi) { const int x = (plan.xcc + qi) & 7, cs = x & 3, tb = (x >> 2) * TH;
        TokStream S; if (!slice_open(S, plan, qi, x, queues, lane)) continue;
        const unsigned char* tab = UQS + (size_t)cs * SLICE_BYTES; const unsigned choff = (unsigned)ch * 16u;
        int* part = PART + ((size_t)cs * T + tb) * 128;
        const unsigned* SEL = SEL0 + (size_t)tb * 128; const unsigned char* XQ = XQ0 + (size_t)tb * DM;
        int tA = S.next(lane), tB = S.next(lane);
        if (tA >= TH) continue;
        UEnt EA, EB; v4u W0[16], W1[16]; unsigned X0, X1;
        u_ent(EA, SEL, XQ, tA, cs, lane); u_ent(EB, SEL, XQ, tB < TH ? tB : TH - 1, cs, lane); MEM_ORDER();
        u_rows(W0, X0, EA, lane, tab, choff PROBE_EPASS); MEM_ORDER();
        while (tA < TH) {
            const int tC = S.next(lane);
            u_ent(EA, SEL, XQ, tC < TH ? tC : TH - 1, cs, lane); MEM_ORDER();
            u_rows(W1, X1, EB, lane, tab, choff PROBE_EPASS); MEM_ORDER();
            u_compute(W0, X0, part + (size_t)tA * 128, grp, ch, c0, c1, c2); MEM_ORDER();
            const int tD = S.next(lane);
            u_ent(EB, SEL, XQ, tD < TH ? tD : TH - 1, cs, lane); MEM_ORDER();
            u_rows(W0, X0, EA, lane, tab, choff PROBE_EPASS); MEM_ORDER();
            u_compute(W1, X1, tB < TH ? part + (size_t)tB * 128 : dummy, grp, ch, c0, c1, c2); MEM_ORDER();
            tA = tC; tB = tD;
        }
    }
}
template <int NR> __device__ __forceinline__ void gather_coef(const unsigned* SEL, const int* PART, const float* SU, const float* SV, const float* SX, const int* XS, signed char* CQ, unsigned* EO, float* SCL, int* CSM, int t0, int ts, int lane) {
    typedef int i2 __attribute__((ext_vector_type(2)));
    v2u ent[NR]; i2 acc[NR]; float sx[NR]; int xs[NR]; int tt[NR];
#pragma unroll
    for (int r = 0; r < NR; ++r) { tt[r] = (t0 + r * ts < T) ? t0 + r * ts : T - 1; ent[r] = *(const GAS v2u*)(SEL + (size_t)tt[r] * 128 + 2 * lane);
        sx[r] = __hip_atomic_load(SX + tt[r], __ATOMIC_RELAXED, __HIP_MEMORY_SCOPE_AGENT);
        xs[r] = __hip_atomic_load(XS + tt[r], __ATOMIC_RELAXED, __HIP_MEMORY_SCOPE_AGENT);
        acc[r] = (i2){0, 0}; }
#pragma unroll
    for (int r = 0; r < NR; ++r)
#pragma unroll
        for (int x = 0; x < 4; ++x) { const i2 pp = *(const GAS i2*)(PART + ((size_t)x * T + tt[r]) * 128 + 2 * lane); acc[r] += pp; }
    float su0[NR], sv0[NR], su1[NR], sv1[NR];
#pragma unroll
    for (int r = 0; r < NR; ++r) { const unsigned e0 = ent[r].x >> 16, e1 = ent[r].y >> 16; su0[r] = SU[e0]; sv0[r] = SV[e0]; su1[r] = SU[e1]; sv1[r] = SV[e1]; }
#pragma unroll
    for (int r = 0; r < NR; ++r) {
        const float k0 = bflo(ent[r].x) * gelu_exact((float)(2 * acc[r].x + xs[r]) * (su0[r] * sx[r])) * sv0[r], k1 = bflo(ent[r].y) * gelu_exact((float)(2 * acc[r].y + xs[r]) * (su1[r] * sx[r])) * sv1[r];
        float am = fmaxf(fabsf(k0), fabsf(k1));
#pragma unroll
        for (int o = 1; o < 64; o <<= 1) am = fmaxf(am, __shfl_xor(am, o));
        const float sc = am > 0.f ? am * (1.f / 127.f) : 1.f, isc = 1.f / sc;
        const int c0 = (int)rintf(k0 * isc), c1 = (int)rintf(k1 * isc);
        int csum = c0 + c1;
#pragma unroll
        for (int o = 1; o < 64; o <<= 1) csum += __shfl_xor(csum, o);
        if (t0 + r * ts < T) {
            GAS unsigned short* cq = (GAS unsigned short*)((GAS signed char*)CQ + (size_t)tt[r] * 128);
            cq[lane] = (unsigned short)((unsigned)(c0 & 0xff) | ((unsigned)(c1 & 0xff) << 8));
            *(GAS v2u*)(EO + (size_t)tt[r] * 128 + 2 * lane) = (v2u){(ent[r].x >> 16) * 128u, (ent[r].y >> 16) * 128u};
            if (lane == 0) { SCL[tt[r]] = sc * 0.125f; CSM[tt[r]] = 8 * csum; } } }
}
typedef int v4i __attribute__((ext_vector_type(4)));
typedef float vf4 __attribute__((ext_vector_type(4)));
struct VCoef { v4i A; float sc; int cs; v4u hb0, hb1; };
struct VEnt { VCoef c; v2u R; };
__device__ __forceinline__ void v_ent(VEnt& E, const unsigned* EO, const signed char* CQ, const float* SCL, const int* CSM, const bf16* HIcol, int t, int lane) {
    const int ic = lane & 3, kb = lane >> 4;
    E.c.A = *(const GAS v4i*)((const GAS signed char*)CQ + (size_t)t * 128 + (2 * kb + (ic & 1)) * 16);
    E.c.sc = __hip_atomic_load(SCL + t, __ATOMIC_RELAXED, __HIP_MEMORY_SCOPE_AGENT);
    E.c.cs = __hip_atomic_load(CSM + t, __ATOMIC_RELAXED, __HIP_MEMORY_SCOPE_AGENT);
    E.c.hb0 = *(const GAS v4u*)(HIcol + (size_t)t * DM);
    E.c.hb1 = *(const GAS v4u*)(HIcol + (size_t)t * DM + 16);
    E.R = *(const GAS v2u*)(EO + (size_t)t * 128 + 2 * lane);
}
__device__ __forceinline__ void v_rows(v4u (&w)[16], VCoef& c, const VEnt& E, int lane, const unsigned char* tab, unsigned choff) {
    const int gb = (lane >> 3) * 32; const v2u R = E.R;
#pragma unroll
    for (int g = 0; g < 16; ++g) { const unsigned eo = bperm(gb + 4 * (g >> 1), (g & 1) ? R.y : R.x); w[g] = *(const GAS v4u*)(tab + (unsigned)(eo + choff)); }
    c = E.c;
}
__device__ __forceinline__ unsigned permb(unsigned hi, unsigned lo, unsigned sel) { return __builtin_amdgcn_perm(hi, lo, sel); }
__device__ __forceinline__ int ror8(int v) { return __builtin_amdgcn_update_dpp(0, v, 0x128, 0xf, 0xf, true); }
__device__ __forceinline__ void v_compute(const v4u (&w)[16], const VCoef& C, float* hout, bool half, bool storer, bool arow) {
    const v4i CA = arow ? C.A : (v4i){0, 0, 0, 0};
    const int k15 = -15 * C.cs;
#pragma unroll
    for (int jp = 0; jp < 2; ++jp) {
        int tr[2][4], th[2][4];
#pragma unroll
        for (int jj = 0; jj < 2; ++jj) { const int j = 2 * jp + jj;
            unsigned K[4][4];
#pragma unroll
            for (int q = 0; q < 4; ++q) { const unsigned a = w[4 * q][j], b = w[4 * q + 1][j], c = w[4 * q + 2][j], d = w[4 * q + 3][j];
                const unsigned t0 = permb(a, b, 0x01050004u), t1 = permb(a, b, 0x03070206u), t2 = permb(c, d, 0x01050004u), t3 = permb(c, d, 0x03070206u);
                K[q][0] = permb(t2, t0, 0x05040100u); K[q][1] = permb(t2, t0, 0x07060302u); K[q][2] = permb(t3, t1, 0x05040100u); K[q][3] = permb(t3, t1, 0x07060302u); }
#pragma unroll
            for (int k = 0; k < 4; ++k) {
                const v4i Br = {(int)K[0][k], (int)K[1][k], (int)K[2][k], (int)K[3][k]};
                const v4i Bh = {(int)(K[0][k] & 0xF0F0F0F0u), (int)(K[1][k] & 0xF0F0F0F0u), (int)(K[2][k] & 0xF0F0F0F0u), (int)(K[3][k] & 0xF0F0F0F0u)};
                const v4i Dr = __builtin_amdgcn_mfma_i32_16x16x64_i8(CA, Br, (v4i){0, 0, 0, 0}, 0, 0, 0);
                const v4i Dh = __builtin_amdgcn_mfma_i32_16x16x64_i8(CA, Bh, (v4i){0, 0, 0, 0}, 0, 0, 0);
                tr[jj][k] = jj ? Dr[1] + ror8(Dr[0]) : Dr[0] + ror8(Dr[1]);
                th[jj][k] = jj ? Dh[1] + ror8(Dh[0]) : Dh[0] + ror8(Dh[1]); }
        }
        int lo[4], hi[4];
#pragma unroll
        for (int k = 0; k < 4; ++k) { const int d0 = tr[0][k] - th[0][k], d1 = tr[1][k] - th[1][k]; lo[k] = half ? d1 : d0; hi[k] = half ? th[1][k] : th[0][k];
            asm volatile("" : "+v"(lo[k]), "+v"(hi[k])); }
        const v4u hb = jp ? C.hb1 : C.hb0;
        const float h8[8] = {bflo(hb.x), bfhi(hb.x), bflo(hb.y), bfhi(hb.y), bflo(hb.z), bfhi(hb.z), bflo(hb.w), bfhi(hb.w)};
        vf4 o0, o1;
#pragma unroll
        for (int k = 0; k < 4; ++k) { o0[k] = h8[k] + C.sc * (float)((lo[k] << 4) + k15);
                                      o1[k] = h8[4 + k] + C.sc * (float)(hi[k] + C.cs); }
        if (storer) { __builtin_nontemporal_store(o0, (GAS vf4*)(hout + 16 * jp)); __builtin_nontemporal_store(o1, (GAS vf4*)(hout + 16 * jp) + 1); }
    }
}
__device__ __forceinline__ void gather_v(const unsigned* EO0, const signed char* CQ0, const float* SCL0, const int* CSM0, const unsigned char* VQS, const bf16* HI0, float* HO0, float* dummy, unsigned* queues, const SlicePlan& plan, int lane) {
    const int ch = lane & 7; const bool half = ((lane >> 3) & 1) != 0, storer = lane < 16, arow = (lane & 15) < 2;
    for (int qi = 0; qi < 8; ++qi) { const int x = (plan.xcc + qi) & 7, cs = x & 3, tb = (x >> 2) * TH;
        TokStream S; if (!slice_open(S, plan, qi, x, queues, lane)) continue;
        const unsigned char* tab = VQS + (size_t)cs * SLICE_BYTES; const unsigned choff = (unsigned)ch * 16u;
        const int col = cs * 256 + ch * 32 + (half ? 8 : 0);
        const unsigned* EO = EO0 + (size_t)tb * 128; const signed char* CQ = CQ0 + (size_t)tb * 128; const float* SCL = SCL0 + tb; const int* CSM = CSM0 + tb;
        const bf16* HI = HI0 + (size_t)tb * DM + col; float* HO = HO0 + (size_t)tb * DM + col;
        int tA = S.next(lane), tB = S.next(lane);
        if (tA >= TH) continue;
        VEnt EA, EB; v4u W0[16], W1[16]; VCoef C0, C1;
        v_ent(EA, EO, CQ, SCL, CSM, HI, tA, lane); v_ent(EB, EO, CQ, SCL, CSM, HI, tB < TH ? tB : TH - 1, lane); MEM_ORDER();
        v_rows(W0, C0, EA, lane, tab, choff); MEM_ORDER();
        while (tA < TH) {
            const int tC = S.next(lane);
            v_ent(EA, EO, CQ, SCL, CSM, HI, tC < TH ? tC : TH - 1, lane); MEM_ORDER();
            v_rows(W1, C1, EB, lane, tab, choff); MEM_ORDER();
            v_compute(W0, C0, HO + (size_t)tA * DM, half, storer, arow); MEM_ORDER();
            const int tD = S.next(lane);
            v_ent(EB, EO, CQ, SCL, CSM, HI, tD < TH ? tD : TH - 1, lane); MEM_ORDER();
            v_rows(W0, C0, EA, lane, tab, choff); MEM_ORDER();
            v_compute(W1, C1, tB < TH ? HO + (size_t)tB * DM : dummy + 32 * (lane & 15), half, storer, arow); MEM_ORDER();
            tA = tC; tB = tD;
        }
    }
}

#ifndef MK_SPLIT
#define MK_SPLIT 0
#endif
constexpr int NPHASE = 11;
typedef SlicePlan pk_plan_t;
#ifndef PROBE_PH
#define PROBE_PH -1
#endif
#ifndef PROBE_N
#define PROBE_N 1
#endif
#define REPS(k) (((k) == PROBE_PH) ? 1 + PROBE_N : 1)
struct Args { const float* in[21]; float* out; unsigned char* ws; int ph_lo, ph_hi; };
static_assert(sizeof(Args) == 23 * 8 + 8, "Args has no padding");

__global__ void __launch_bounds__(NWAVES * 64, 2) fwd(Args args) {
    extern __shared__ __attribute__((aligned(16))) unsigned char lds_raw[];
    LAS unsigned char* lds = (LAS unsigned char*)lds_raw;
    volatile LAS unsigned* MISC = (volatile LAS unsigned*)(lds + MISC_OFF);
    const int tid = threadIdx.x, lane = tid & 63, wave = __builtin_amdgcn_readfirstlane(tid >> 6);
    const int G = gridDim.x; const int bx = blockIdx.x; const int vcu = (G % 8 == 0) ? (bx % 8) * (G / 8) + bx / 8 : bx;
    const int gw = vcu * NWAVES + wave, NGW = G * NWAVES;
    unsigned char* ws = args.ws;
    gu32* ctl = (gu32*)(ws + WS_CTL);
    const float* x = args.in[0]; const float* mem = args.in[1]; const float* g_mix = args.in[2]; const float* w_in = args.in[3]; const float* q_gain_a = args.in[4]; const float* k_gain_a = args.in[5];
    const float* rel_bias = args.in[6]; const float* conv_w = args.in[7]; const float* g_mem = args.in[8]; const float* w_mem_kv = args.in[9]; const float* q_gain_x = args.in[10]; const float* k_gain_x = args.in[11];
    const float* w_br_attn = args.in[12]; const float* w_br_conv = args.in[13]; const float* w_br_x = args.in[14]; const float* w_out = args.in[15]; const float* g_ffn = args.in[16];
    const float* w_query = args.in[17]; const float* sub_keys = args.in[18]; const float* peer_u = args.in[19]; const float* peer_v = args.in[20];
    float* out = args.out;
    bf16* WinT = (bf16*)(ws + WS_WIN); bf16* WkvT = (bf16*)(ws + WS_WKV); bf16* WbrT = (bf16*)(ws + WS_WBR); bf16* WoutT = (bf16*)(ws + WS_WOUT); bf16* WqT = (bf16*)(ws + WS_WQ);
    bf16* SK = (bf16*)(ws + WS_SK); float* TAB = (float*)(ws + WS_TAB); float* KMEAN = (float*)(ws + WS_KMEAN); bf16* MEMN = (bf16*)(ws + WS_MEMN); bf16* KVM = (bf16*)(ws + WS_KVM);
    float* SLOTS = (float*)(ws + WS_SLOTS); unsigned* SEL = (unsigned*)(ws + WS_SEL);
    bf16* PA = (bf16*)(ws + WS_PA); bf16* PG = (bf16*)(ws + WS_PG);
    bf16* MERGED = (bf16*)(ws + PA_MERGED); bf16* HB = (bf16*)(ws + PA_HB); unsigned char* UQ = ws + PA_UT; unsigned char* VQ = ws + PA_VT; float* SU = (float*)(ws + WS_SU); float* SV = (float*)(ws + WS_SV); int* CM = (int*)(ws + WS_CM); float* SAq = (float*)(ws + WS_SA); float* SBq = (float*)(ws + WS_SB); int* XSM = (int*)(ws + WS_XS); float* SX = (float*)(ws + WS_SX); float* CS = (float*)(ws + WS_CS);
    unsigned char* XQ = ws + PA_XQ; int* PART = (int*)(ws + PG_PART); signed char* CQ = (signed char*)(ws + PG_COEF); unsigned* EO = (unsigned*)(ws + PG_COEF + 8 * MiB); bf16* QRY = (bf16*)(ws + PG_QRY);
    bf16* HN = (bf16*)out;
    bf16* BRO = (bf16*)out;

    for (int u = tid; u < (LDS_BYTES - LDSCTL_OFF) / 4; u += NWAVES * 64) ((LAS unsigned*)(lds + LDSCTL_OFF))[u] = 0u;
    __syncthreads();
#if !MK_SPLIT
    XcdBarrier bar = xcd_barrier_post((unsigned*)(ctl + CW_BAR), MISC + 8);
    if (tid == 0) MISC[10] = __hip_atomic_fetch_add((unsigned*)(ctl + CW_RANK) + 64 * (bar.x & 7u), 1u, __ATOMIC_RELAXED, __HIP_MEMORY_SCOPE_AGENT);
#define GRID_BAR() xcd_barrier(bar)
#else
#define GRID_BAR() do {} while (0)
#endif
    const int lo = args.ph_lo, hi_ = args.ph_hi;
#ifndef PH_MASK
#define PH_MASK 0x7ff
#endif
#define IN(k) ((((PH_MASK) >> (k)) & 1) && lo <= (k) && (k) < hi_)
#define BOTH(k) (IN(k) && IN((k) + 1))

    const P0Args p0a{x, mem, g_mix, w_in, rel_bias, g_mem, w_mem_kv, w_br_attn, w_br_conv, w_br_x, w_out, g_ffn, w_query, sub_keys, WinT, WkvT, WbrT, WoutT, WqT, SK, HN, MEMN, TAB, SAq, SBq};
    const int n_busy = (64 * 26) % G + 32; const bool late_w = IN(0) && IN(1) && n_busy < G;
    if (IN(0)) for (int rep = 0; rep < REPS(0); ++rep) {
        p0_prologue(p0a, lds, late_w, gw, NGW, wave, lane);
        if (BOTH(0) && rep == REPS(0) - 1) GRID_BAR();
    }
    if (IN(1)) for (int rep = 0; rep < REPS(1); ++rep) {
        { pg8::Gemm g{HN, WinT, T, PW, DM / 2}; pg8::GOrder S; S.init(T, PW, G, bx); pg8::EpiProj E{PA, PG, q_gain_a, k_gain_a, KMEAN, C2A, RMS_EPS, SAq, SBq};
          pg8::gemm_phase<pg8::EpiProj, pg8::GOrder, true, true, true>(lds + RING_OFF, g, S, E); }
        { const int nfull = (64 * 26) % G; const int coff = (nfull + 32 <= G) ? bx - nfull : bx;
          pg8::Gemm g{MEMN, WkvT, NBATCH * MEMLEN, 1024, DM}; pg8::GOrder S; S.init(NBATCH * MEMLEN, 1024, G, coff); pg8::EpiBf16<0> E{KVM, 1024, nullptr, 0, 0, 1.f};
          pg8::gemm_phase<pg8::EpiBf16<0>, pg8::GOrder, true, true>(lds + RING_OFF, g, S, E); }
        if (late_w && rep == 0 && bx >= n_busy) p0_transposes(p0a, lds, 1, (bx - n_busy) * NWAVES + wave, (G - n_busy) * NWAVES, wave, lane);
        if (IN(1) && IN(3) && rep == REPS(1) - 1) GRID_BAR();
    }
#if defined(PROBE_BARS) && !MK_SPLIT
    if (IN(1)) for (int i = 0; i < PROBE_BARS; ++i) GRID_BAR();
#endif
    if (IN(3)) for (int rep = 0; rep < REPS(3); ++rep) {
        for (int v = vcu; v < 256; v += G) {
            const int bh = v >> 2, b = bh >> 3, h = bh & 7, s = v & 3;
#pragma unroll 1
            for (int pass = 0; pass < 2; ++pass) { const int qb = pass ? 7 - s : s;
                const bf16* Qp = PA + (size_t)(b * SEQ + qb * 256) * PAW + COL_QA + h * 64;
                const bf16* Kp = PA + (size_t)(b * SEQ) * PAW + COL_KA + h * 64; const bf16* Vp = PA + (size_t)(b * SEQ) * PAW + COL_VA + h * 64;
                bf16* Op = BRO + (size_t)(b * SEQ + qb * 256) * 512 + h * 64;
                att::attn_unit<64, true>(Qp, PAW, Kp, Vp, PAW, Op, qb, KMEAN + (size_t)bh * 512, TAB + h * 2048, nullptr, nullptr, lds + RING_OFF, tid, wave, lane); }
            { const int bb = v >> 5, hx = (v >> 3) & 3, qt = v & 7;
                const bf16* Qp = PA + (size_t)(bb * SEQ + qt * 256) * PAW + COL_QX + hx * 128;
                const bf16* Kp = KVM + (size_t)(bb * MEMLEN) * 1024 + hx * 128; const bf16* Vp = Kp + 512;
                bf16* Op = BRO + (size_t)2 * T * 512 + (size_t)(bb * SEQ + qt * 256) * 512 + hx * 128;
                att::attn_unit<128, false>(Qp, PAW, Kp, Vp, 1024, Op, 0, nullptr, nullptr, q_gain_x, k_gain_x, lds + RING_OFF, tid, wave, lane); }
            conv_item(PA, conv_w, BRO + (size_t)T * 512, v, tid);
        }
        if (BOTH(3) && rep == REPS(3) - 1) GRID_BAR();
    }
    if (IN(4)) for (int rep = 0; rep < REPS(4); ++rep) {
        pg8::Gemm g{BRO, WbrT, 3 * T, 3 * 1024, 512}; pg8::BranchOrder S; S.init(G, bx); pg8::EpiBranch E{PG, MERGED};
        pg8::gemm_phase<pg8::EpiBranch, pg8::BranchOrder, true, true>(lds + RING_OFF, g, S, E);
        if (BOTH(4) && rep == REPS(4) - 1) GRID_BAR();
    }
    if (IN(5)) for (int rep = 0; rep < REPS(5); ++rep) {
        pg8::Gemm g{MERGED, WoutT, T, 1024, DM}; pg8::GOrder S; S.init(T, 1024, G, bx); pg8::EpiWout E{x, out, HB, SLOTS};
        pg8::gemm_phase<pg8::EpiWout, pg8::GOrder, true, true>(lds + RING_OFF, g, S, E);
        if (BOTH(5) && rep == REPS(5) - 1) GRID_BAR();
    }
    if (IN(6)) for (int rep = 0; rep < REPS(6); ++rep) {
        pg8::Gemm g{HB, WqT, T, 2048, DM}; pg8::GOrder S; S.init(T, 2048, G, bx); pg8::EpiBf16<0> E{QRY, 2048, nullptr, 0, 0, 1.f};
        pg8::gemm_phase<pg8::EpiBf16<0>, pg8::GOrder, true, true>(lds + RING_OFF, g, S, E);
        if (BOTH(6) && rep == REPS(6) - 1) GRID_BAR();
    }
    if (IN(7)) for (int rep = 0; rep < REPS(7); ++rep) {
        for (int v = vcu; v < 256; v += G) {
            pk::topk_fill(SK, lds + RING_OFF, v & 3, tid);
            if (wave < 4) {
#pragma unroll 1
                for (int r2 = 0; r2 < 2; ++r2) pk::topk_task(QRY, SLOTS, SEL, lds + RING_OFF, v & 3, ((v >> 2) * 8 + wave * 2 + r2) * 32, lane);
            } else if (v == vcu) {
                const int qgw = vcu * 4 + (wave - 4), QNGW = G * 4;
                for (int m = qgw; m < NEXP; m += 4 * QNGW) quant_rows_i4<4, false>(peer_u, UQ, SU, m, QNGW, NEXP, lane);
                for (int m = qgw; m < NEXP; m += 4 * QNGW) quant_rows_i4<4, true>(peer_v, VQ, SV, m, QNGW, NEXP, lane);
                float gf[16];
#pragma unroll
                for (int j = 0; j < 16; ++j) gf[j] = g_ffn[4 * lane + 256 * (j >> 2) + (j & 3)];
                for (int t = qgw; t < T; t += 4 * QNGW) quant_x<4>(HB, XQ, SX, XSM, gf, t, QNGW, lane);
            }
            __syncthreads();
        }
        if (BOTH(7) && rep == REPS(7) - 1) GRID_BAR();
    }
#if !MK_SPLIT
    const int xcc = (int)bar.x & 7;
    const int nloc = (int)__builtin_amdgcn_readfirstlane((int)MISC[8]), wrank = (int)__builtin_amdgcn_readfirstlane((int)MISC[10]);
    const pk_plan_t plan = slice_plan(xcc, wrank * NWAVES + wave, nloc * NWAVES, (const unsigned*)(ctl + CW_BAR) + XB_XCNT(0), lane);
#else
    const int xcc = (int)(xb_xcc_id() & 7u);
    const pk_plan_t plan = slice_plan(xcc, 0, 0, nullptr, lane);
#endif
    if (IN(8)) for (int rep = 0; rep < REPS(8); ++rep) {
        #ifdef PROBE_MASKV
        gather_u(SEL, XQ, UQ, PART, (int*)(ws + WS_END), (unsigned*)(ctl + CW_QU + 4096 * rep), plan, lane, (rep == REPS(8) - 1) ? 0xffffu : (unsigned)PROBE_MASKV);
#else
        gather_u(SEL, XQ, UQ, PART, (int*)(ws + WS_END), (unsigned*)(ctl + CW_QU + 4096 * rep), plan, lane);
#endif
        if (BOTH(8) && rep == REPS(8) - 1) GRID_BAR();
    }
    if (IN(9)) for (int rep = 0; rep < REPS(9); ++rep) {
        for (int t = gw; t < T; t += 4 * NGW) gather_coef<4>(SEL, PART, SU, SV, SX, XSM, CQ, EO, CS, CM, t, NGW, lane);
        if (BOTH(9) && rep == REPS(9) - 1) GRID_BAR();
    }
    if (IN(10)) for (int rep = 0; rep < REPS(10); ++rep) {
        gather_v(EO, CQ, CS, CM, VQ, HB, (rep == REPS(10) - 1) ? out : (float*)PART, (float*)(ws + WS_END), (unsigned*)(ctl + CW_QV + 4096 * rep), plan, lane);
    }
#undef IN
#undef BOTH
}

extern "C" void kernel_launch(void* const* d_in, const int* in_sizes, int n_in, void* d_out, int out_size, void* d_ws, size_t ws_size, hipStream_t stream) {
    static int grid = 0;
    if (grid == 0) {
        if (n_in != 21 || out_size != T * DM || ws_size < WS_END + 4096) { fprintf(stderr, "kernel_launch: unexpected shapes (n_in %d, out %d, ws %zu)\n", n_in, out_size, ws_size); grid = -1; return; }
        int dev = 0, cus = 0, per_cu = 0;
        if (hipGetDevice(&dev) != hipSuccess || hipDeviceGetAttribute(&cus, hipDeviceAttributeMultiprocessorCount, dev) != hipSuccess) { grid = -1; return; }
        if (hipFuncSetAttribute((const void*)fwd, hipFuncAttributeMaxDynamicSharedMemorySize, LDS_BYTES) != hipSuccess) { fprintf(stderr, "kernel_launch: hipFuncSetAttribute failed\n"); grid = -1; return; }
        if (hipOccupancyMaxActiveBlocksPerMultiprocessor(&per_cu, (const void*)fwd, NWAVES * 64, LDS_BYTES) != hipSuccess || per_cu < 1) { fprintf(stderr, "kernel_launch: occupancy query reports %d\n", per_cu); }
        (void)hipGetLastError();
        grid = cus;
    }
    if (grid < 0) return;
    (void)hipMemsetAsync((char*)d_ws + WS_CTL, 0, CTL_ZERO_BYTES, stream);
    Args a{};
    for (int i = 0; i < 21; ++i) a.in[i] = (const float*)d_in[i];
    a.out = (float*)d_out; a.ws = (unsigned char*)d_ws;
#if MK_SPLIT
    for (int p = 0; p < NPHASE; ++p) { a.ph_lo = p; a.ph_hi = p + 1; hipLaunchKernelGGL(fwd, dim3(grid), dim3(NWAVES * 64), LDS_BYTES, stream, a); }
#else
#if defined(PROBE_UPTO)
    a.ph_lo = 0; a.ph_hi = PROBE_UPTO + 1;
    hipLaunchKernelGGL(fwd, dim3(grid), dim3(NWAVES * 64), LDS_BYTES, stream, a);
    (void)hipMemsetAsync((char*)d_ws + WS_CTL, 0, CTL_ZERO_BYTES, stream);
#endif
    a.ph_lo = 0; a.ph_hi = NPHASE;
    hipLaunchKernelGGL(fwd, dim3(grid), dim3(NWAVES * 64), LDS_BYTES, stream, a);
#endif
}
```

```cpp
#define P7_NRQ 8
#include <hip/hip_runtime.h>
#include <hip/hip_bf16.h>
#include <cstdio>
#include <cstdint>
#include <cmath>
namespace pg8 {
#define PG8_LAS __attribute__((address_space(3)))
typedef unsigned short bf16_t;
typedef short bf16x8 __attribute__((ext_vector_type(8)));
typedef float f32x4 __attribute__((ext_vector_type(4)));
typedef unsigned u32x4 __attribute__((ext_vector_type(4)));
typedef int i32x4 __attribute__((ext_vector_type(4)));
constexpr int BM = 256, BK = 64, HALF = 128, HTB = HALF * BK * 2  , STAGE_BYTES = 8 * HTB, NXCD = 8, WGM = 8;

__host__ __device__ __forceinline__ int lds_byte(int r, int c) { const int st = (r >> 4) * 2 + (c >> 5), rr = r & 15, cc = c & 31, ob = rr * 64 + cc * 2; return st * 1024 + (ob ^ (((ob >> 9) & 1) << 5)); }
__host__ __device__ __forceinline__ void stage_rc(int b, int& R, int& C) { const int st = b / 1024, sb = b % 1024, swz = sb ^ (((sb >> 9) & 1) << 5); R = (st >> 1) * 16 + swz / 64; C = (st & 1) * 32 + (swz % 64) / 2; }
__host__ __device__ __forceinline__ int perm32(int rho) { const int n = rho >> 4, i = rho & 15; return 8 * (i >> 2) + 4 * n + (i & 3); }

struct Unit { int pm, pn; };
struct Gemm { const bf16_t* A; const bf16_t* Bt; int M, N, K; };

struct StaticOrder {
    int nM, nN, nwg, G, c;
    __host__ __device__ void init(int M, int N, int G_, int c_) { nM = M / BM; nN = N / BM; nwg = nM * nN; G = G_; c = c_; }
    __host__ __device__ bool next(int i, Unit& u) const {
        const long L = (long)i * G + c; if (L >= nwg) return false;
        int wgid = (int)L; { const int q = nwg / NXCD, r = nwg % NXCD, xcd = wgid % NXCD, off = wgid / NXCD; wgid = (xcd < r ? xcd * (q + 1) : r * (q + 1) + (xcd - r) * q) + off; }
        const int nig = WGM * nN, gid = wgid / nig, fm = gid * WGM, gsz = (nM - fm) < WGM ? (nM - fm) : WGM;
        u.pm = fm + ((wgid % nig) % gsz); u.pn = (wgid % nig) / gsz; return true;
    }
    __device__ __forceinline__ void a_ready(const Unit&) const {}
    __device__ __forceinline__ void done(const Unit&) const {}
};

__device__ __forceinline__ unsigned cvt_pk_bf16(float lo, float hi) { unsigned r; asm volatile("v_cvt_pk_bf16_f32 %0, %1, %2" : "=v"(r) : "v"(lo), "v"(hi)); return r; }
typedef float f32x2 __attribute__((ext_vector_type(2)));
__device__ __forceinline__ f32x2 gelu_pk(f32x2 v) {
    const f32x2 av = __builtin_elementwise_abs(v), d = av * 0.2316418882f + 1.0f;
    f32x2 t; t.x = __builtin_amdgcn_rcpf(d.x); t.y = __builtin_amdgcn_rcpf(d.y);
    f32x2 q = t * 0.5307027145f + (-0.7265760135f); q = q * t + 0.7107068705f; q = q * t + (-0.142248368f); q = q * t + 0.127414796f; q = q * t;
    const f32x2 s = (v * v) * (-0.72134752044f);
    f32x2 e; e.x = __builtin_amdgcn_exp2f(s.x); e.y = __builtin_amdgcn_exp2f(s.y);
    const f32x2 m = v * (q * e), r = v - m;
    f32x2 o; o.x = v.x < 0.f ? m.x : r.x; o.y = v.y < 0.f ? m.y : r.y; return o;
}

template <int ACT  > struct EpiBf16 {
    static constexpr bool PERM = true, AFTER_DRAIN = false, HEAD64 = false; static_assert(ACT == 0 || ACT == 1 || ACT == 2, "EpiBf16: ACT is 0 (none), 1 (gelu_pk) or 2 (sigmoid)");
    bf16_t* O; int ldc; const float* bias; int split_cols; size_t split_stride; float scale0;
    __device__ __forceinline__ void operator()(const f32x4 (&acc)[2][2][4][2], const Unit& u, int wr, int wc, int fr, int fq) const {
        const int row0 = u.pm * BM + wr * 64 + fr; int colt = u.pn * BM; bf16_t* base = O;
        float sc = 1.f; if (split_cols) { const int t = colt / split_cols; base += (size_t)t * split_stride; colt -= t * split_cols; if (t == 0) sc = scale0; }
        const int col0 = colt + wc * 32 + 8 * fq, bcol0 = u.pn * BM + wc * 32 + 8 * fq;
        f32x4 bv[2][2];
#pragma unroll
        for (int bj = 0; bj < 2; ++bj)
#pragma unroll
            for (int n = 0; n < 2; ++n) bv[bj][n] = bias ? *(const f32x4*)(bias + bcol0 + bj * HALF + 4 * n) : (f32x4){0.f, 0.f, 0.f, 0.f};
#pragma unroll
        for (int ai = 0; ai < 2; ++ai)
#pragma unroll
            for (int m = 0; m < 4; ++m) { bf16_t* rowp = base + (size_t)(row0 + ai * HALF + m * 16) * ldc + col0;
#pragma unroll
                for (int bj = 0; bj < 2; ++bj) { f32x4 v0 = acc[ai][bj][m][0] + bv[bj][0], v1 = acc[ai][bj][m][1] + bv[bj][1];
                    if (ACT == 1) { f32x2 a = gelu_pk((f32x2){v0[0], v0[1]}), b = gelu_pk((f32x2){v0[2], v0[3]}), c = gelu_pk((f32x2){v1[0], v1[1]}), d = gelu_pk((f32x2){v1[2], v1[3]});
                        v0 = (f32x4){a.x, a.y, b.x, b.y}; v1 = (f32x4){c.x, c.y, d.x, d.y}; }
                    if (ACT == 2) { _Pragma("unroll") for (int e_ = 0; e_ < 4; ++e_) { v0[e_] = __builtin_amdgcn_rcpf(1.0f + __builtin_amdgcn_exp2f(-1.4426950408889634f * v0[e_])); v1[e_] = __builtin_amdgcn_rcpf(1.0f + __builtin_amdgcn_exp2f(-1.4426950408889634f * v1[e_])); } }
                    v0 = v0 * sc; v1 = v1 * sc; u32x4 w; w.x = cvt_pk_bf16(v0[0], v0[1]); w.y = cvt_pk_bf16(v0[2], v0[3]); w.z = cvt_pk_bf16(v1[0], v1[1]); w.w = cvt_pk_bf16(v1[2], v1[3]);
                    *(u32x4*)(rowp + bj * HALF) = w; } }
    }
};


struct GOrder {
    int nM, nN, nwg, G, c;
    __host__ __device__ void init(int M, int N, int G_, int c_) { nM = M / BM; nN = N / BM; nwg = nM * nN; G = G_; c = c_; }
    __host__ __device__ bool next(int i, Unit& u) const {
        if (c < 0) return false;
        const long L = (long)i * G + c; if (L >= nwg) return false;
        int wgid = (int)L; { const int q = nwg / NXCD, r = nwg % NXCD, xcd = wgid % NXCD, off = wgid / NXCD; wgid = (xcd < r ? xcd * (q + 1) : r * (q + 1) + (xcd - r) * q) + off; }
        const int nig = WGM * nN, gid = wgid / nig, fm = gid * WGM, gsz = (nM - fm) < WGM ? (nM - fm) : WGM;
        u.pm = fm + ((wgid % nig) % gsz); u.pn = (wgid % nig) / gsz; return true;
    }
    __device__ __forceinline__ void a_ready(const Unit&) const {}
    __device__ __forceinline__ void done(const Unit&) const {}
};
struct BranchOrder {
    GOrder g;
    __device__ void init(int G, int c) { g.init(16384, 1024, G, c); }
#if defined(PROBE_P4X2)
    __device__ bool next(int i, Unit& u) const { Unit t; if (i >= 6 || !g.next(0, t)) return false; const int br = i % 3; u.pm = 64 * br + t.pm; u.pn = 4 * br + t.pn; return true; }
#else
    __device__ bool next(int i, Unit& u) const { Unit t; if (!g.next(i / 3, t)) return false; const int br = i % 3; u.pm = 64 * br + t.pm; u.pn = 4 * br + t.pn; return true; }
#endif
    __device__ __forceinline__ void a_ready(const Unit&) const {}
    __device__ __forceinline__ void done(const Unit&) const {}
};
__device__ __forceinline__ float bf_lo(unsigned w) { return __builtin_bit_cast(float, w << 16); }
__device__ __forceinline__ float bf_hi(unsigned w) { return __builtin_bit_cast(float, w & 0xffff0000u); }
__device__ __forceinline__ float sigmoid_f(float x) { return __builtin_amdgcn_rcpf(1.0f + __builtin_amdgcn_exp2f(-1.4426950408889634f * x)); }
struct EpiProj {
    static constexpr bool PERM = true, AFTER_DRAIN = false, HEAD64 = true;
    bf16_t* PA; bf16_t* PG; const float* gq; const float* gk; float* KMEAN; float qscale, eps; const float* SA; const float* SB;
    __device__ __forceinline__ void operator()(const f32x4 (&acc)[2][2][4][2], const Unit& u, int wr, int wc, int fr, int fq) const {
        f32x4 sbv[2][2];
        { const float* sp = SB + u.pn * BM + wc * 64 + 8 * fq;
#pragma unroll
          for (int bj = 0; bj < 2; ++bj)
#pragma unroll
              for (int n = 0; n < 2; ++n) sbv[bj][n] = *(const f32x4*)(sp + 32 * bj + 4 * n); }
#define EPQ(ai, bj, m, n, sa) ({ const i32x4 a_ = __builtin_bit_cast(i32x4, acc[ai][bj][m][n]); const f32x4 s_ = sbv[bj][n] * (sa); (f32x4){(float)a_[0] * s_[0], (float)a_[1] * s_[1], (float)a_[2] * s_[2], (float)a_[3] * s_[3]}; })
        const bool gate = u.pn >= 14; const int mode = u.pn < 2 ? 1 : (u.pn < 4 ? 2 : 0);
        bf16_t* base = gate ? PG : PA; const int ldc = gate ? 3072 : 3584; const int colt = gate ? (u.pn - 14) * BM : u.pn * BM;
        const int row0 = u.pm * BM + wr * 64 + fr, col0 = colt + wc * 64 + 8 * fq;
        f32x4 gn[2][2]; f32x4 cs[2][2];
#pragma unroll
        for (int bj = 0; bj < 2; ++bj)
#pragma unroll
            for (int n = 0; n < 2; ++n) { cs[bj][n] = (f32x4){0.f, 0.f, 0.f, 0.f}; gn[bj][n] = (f32x4){1.f, 1.f, 1.f, 1.f};
                if (mode) { const float* gp = (mode == 1 ? gq : gk) + 32 * bj + 8 * fq + 4 * n; const float sc = mode == 1 ? qscale : 1.0f; gn[bj][n] = (f32x4){gp[0] * sc, gp[1] * sc, gp[2] * sc, gp[3] * sc}; } }
#pragma unroll
        for (int ai = 0; ai < 2; ++ai)
#pragma unroll
            for (int m = 0; m < 4; ++m) { bf16_t* rowp = base + (size_t)(row0 + ai * HALF + m * 16) * ldc + col0;
                const float sa = SA[row0 + ai * HALF + m * 16];
                float r = 1.f;
                if (mode) { float ss = 0.f;
#pragma unroll
                    for (int bj = 0; bj < 2; ++bj)
#pragma unroll
                        for (int n = 0; n < 2; ++n) { const f32x4 v = EPQ(ai, bj, m, n, sa); ss += (v[0] * v[0] + v[1] * v[1]) + (v[2] * v[2] + v[3] * v[3]); }
                    ss += __shfl_xor(ss, 16); ss += __shfl_xor(ss, 32);
                    r = 1.0f / sqrtf(ss * (1.f / 64.f) + eps); }
#pragma unroll
                for (int bj = 0; bj < 2; ++bj) { f32x4 v0 = EPQ(ai, bj, m, 0, sa), v1 = EPQ(ai, bj, m, 1, sa);
                    if (gate) {
#pragma unroll
                        for (int e = 0; e < 4; ++e) { v0[e] = sigmoid_f(v0[e]); v1[e] = sigmoid_f(v1[e]); } }
                    if (mode) { v0 = v0 * r * gn[bj][0]; v1 = v1 * r * gn[bj][1]; if (mode == 2) { cs[bj][0] += v0; cs[bj][1] += v1; } }
                    if (gate) {
                        typedef unsigned u32x2g __attribute__((ext_vector_type(2))); unsigned q[8];
#pragma unroll
                        for (int e = 0; e < 4; ++e) { q[e] = (unsigned)__builtin_rintf(v0[e] * 255.f); q[4 + e] = (unsigned)__builtin_rintf(v1[e] * 255.f); }
                        u32x2g wq; wq.x = q[0] | (q[1] << 8) | (q[2] << 16) | (q[3] << 24); wq.y = q[4] | (q[5] << 8) | (q[6] << 16) | (q[7] << 24);
                        *(u32x2g*)((unsigned char*)PG + (size_t)(row0 + ai * HALF + m * 16) * 3072 + col0 + bj * 32) = wq;
                    } else {
                    u32x4 w; w.x = cvt_pk_bf16(v0[0], v0[1]); w.y = cvt_pk_bf16(v0[2], v0[3]); w.z = cvt_pk_bf16(v1[0], v1[1]); w.w = cvt_pk_bf16(v1[2], v1[3]);
                    *(u32x4*)(rowp + bj * 32) = w; } } }
        if (mode == 2) {
            const int b = u.pm >> 3, nb = u.pm & 7, head = (u.pn - 2) * 4 + wc;
            float* km = KMEAN + (size_t)((b * 8 + head) * 8 + nb) * 64 + 8 * fq;
#pragma unroll
            for (int bj = 0; bj < 2; ++bj)
#pragma unroll
                for (int n = 0; n < 2; ++n)
#pragma unroll
                    for (int e = 0; e < 4; ++e) { float s = cs[bj][n][e];
                        s += __shfl_xor(s, 1); s += __shfl_xor(s, 2); s += __shfl_xor(s, 4); s += __shfl_xor(s, 8);
                        if (fr == 0) atomicAdd(km + 32 * bj + 4 * n + e, s * (1.f / 256.f)); }
        }
    }
};
struct EpiBranch {
    static constexpr bool PERM = true, AFTER_DRAIN = false, HEAD64 = false;
    const bf16_t* PG; bf16_t* MG;
    __device__ __forceinline__ void operator()(const f32x4 (&acc)[2][2][4][2], const Unit& u, int wr, int wc, int fr, int fq) const {
        const int br = u.pm >> 6, tm = u.pm & 63, tn = u.pn & 3;
        const int row0 = tm * BM + wr * 64 + fr, col0 = tn * BM + wc * 32 + 8 * fq;
#pragma unroll
        for (int ai = 0; ai < 2; ++ai) {
            typedef unsigned u32x2g __attribute__((ext_vector_type(2)));
            u32x2g g[4][2]; u32x4 p[4][2];
#pragma unroll
            for (int m = 0; m < 4; ++m)
#pragma unroll
                for (int bj = 0; bj < 2; ++bj) { const size_t row = (size_t)(row0 + ai * HALF + m * 16); const int col = col0 + bj * HALF;
                    g[m][bj] = *(const u32x2g*)((const unsigned char*)PG + row * 3072 + br * 1024 + col);
                    p[m][bj] = (br > 0) ? *(const u32x4*)(MG + row * 1024 + col) : (u32x4){0u, 0u, 0u, 0u}; }
#pragma unroll
            for (int m = 0; m < 4; ++m)
#pragma unroll
                for (int bj = 0; bj < 2; ++bj) { const size_t row = (size_t)(row0 + ai * HALF + m * 16); const int col = col0 + bj * HALF;
                    const u32x2g gg = g[m][bj]; const u32x4 pp = p[m][bj]; constexpr float GS = 1.f / 255.f;
                    f32x4 v0 = acc[ai][bj][m][0], v1 = acc[ai][bj][m][1];
                    v0[0] = v0[0] * ((float)(gg.x & 0xffu) * GS) + bf_lo(pp.x); v0[1] = v0[1] * ((float)((gg.x >> 8) & 0xffu) * GS) + bf_hi(pp.x); v0[2] = v0[2] * ((float)((gg.x >> 16) & 0xffu) * GS) + bf_lo(pp.y); v0[3] = v0[3] * ((float)(gg.x >> 24) * GS) + bf_hi(pp.y);
                    v1[0] = v1[0] * ((float)(gg.y & 0xffu) * GS) + bf_lo(pp.z); v1[1] = v1[1] * ((float)((gg.y >> 8) & 0xffu) * GS) + bf_hi(pp.z); v1[2] = v1[2] * ((float)((gg.y >> 16) & 0xffu) * GS) + bf_lo(pp.w); v1[3] = v1[3] * ((float)(gg.y >> 24) * GS) + bf_hi(pp.w);
                    u32x4 w; w.x = cvt_pk_bf16(v0[0], v0[1]); w.y = cvt_pk_bf16(v0[2], v0[3]); w.z = cvt_pk_bf16(v1[0], v1[1]); w.w = cvt_pk_bf16(v1[2], v1[3]);
                    *(u32x4*)(MG + row * 1024 + col) = w; }
        }
    }
};
struct EpiWout {
    static constexpr bool PERM = false, AFTER_DRAIN = false, HEAD64 = false;
    const float* X; float* H; bf16_t* HB; float* SL;
    __device__ __forceinline__ void operator()(const f32x4 (&acc)[2][2][4][2], const Unit& u, int wr, int wc, int fr, int fq) const {
        typedef unsigned u32x2v __attribute__((ext_vector_type(2)));
        const int row0 = u.pm * BM + wr * 64 + fr, col0 = u.pn * BM + wc * 32 + 4 * fq;
#pragma unroll
        for (int ai = 0; ai < 2; ++ai)
#pragma unroll
            for (int mh = 0; mh < 2; ++mh) {
                f32x4 xv[2][2][2];
#pragma unroll
                for (int mm = 0; mm < 2; ++mm)
#pragma unroll
                    for (int bj = 0; bj < 2; ++bj)
#pragma unroll
                        for (int n = 0; n < 2; ++n) xv[mm][bj][n] = *(const f32x4*)(X + (size_t)(row0 + ai * HALF + (2 * mh + mm) * 16) * 1024 + col0 + bj * HALF + n * 16);
#pragma unroll
                for (int mm = 0; mm < 2; ++mm) { const int m = 2 * mh + mm; const size_t row = (size_t)(row0 + ai * HALF + m * 16); float ss = 0.f;
#pragma unroll
                    for (int bj = 0; bj < 2; ++bj)
#pragma unroll
                        for (int n = 0; n < 2; ++n) { const size_t off = row * 1024 + col0 + bj * HALF + n * 16;
                            const f32x4 hv = xv[mm][bj][n] + acc[ai][bj][m][n];
                            ss += (hv[0] * hv[0] + hv[1] * hv[1]) + (hv[2] * hv[2] + hv[3] * hv[3]);
                            u32x2v w; w.x = cvt_pk_bf16(hv[0], hv[1]); w.y = cvt_pk_bf16(hv[2], hv[3]);
                            *(u32x2v*)(HB + off) = w; }
                    ss += __shfl_xor(ss, 16); ss += __shfl_xor(ss, 32);
                    if (fq == 0) SL[row * 16 + u.pn * 4 + wc] = ss; }
            }
    }
};
template <class Epi, class Sched, bool ALIGN_EPI = false, bool SP2 = false, bool I8 = false>
__device__ __forceinline__ void gemm_phase(PG8_LAS unsigned char* lds, const Gemm g, const Sched& S, const Epi& E) {
    const int tid = threadIdx.x, wid = __builtin_amdgcn_readfirstlane(tid >> 6), lane = tid & 63, wr = wid >> 2, wc = wid & 3, fr = lane & 15, fq = lane >> 4;
    const int K = g.K, nt = K / BK;
    unsigned voffA[2], voffB[2];
#pragma unroll
    for (int i = 0; i < 2; ++i) { int R, C; stage_rc(tid * 16 + i * 8192, R, C); const int Rb = Epi::HEAD64 ? (64 * (R >> 5) + perm32(R & 31)) : (Epi::PERM ? ((R & ~31) + perm32(R & 31)) : R);
        voffA[i] = (unsigned)(R * K + C) * 2u; voffB[i] = (unsigned)(Rb * K + C) * 2u; }
    const size_t kstep = (size_t)(BK * 2);
    const size_t hstep = (size_t)HALF * K * 2;
    const size_t hstepB = Epi::HEAD64 ? (size_t)32 * K * 2 : hstep;
    const size_t tstep = 2 * hstep;
    const unsigned ldsw = (unsigned)wid * 1024u;
    const int aoff = lds_byte(wr * 64 + fr, fq * 8), boff = lds_byte(wc * 32 + fr, fq * 8);
#define PG8_SA(b, h) (((b) * 2 + (h)) * HTB)
#define PG8_SB(b, h) ((4 + (b) * 2 + (h)) * HTB)
#define PG8_STAGE(bufoff, gbase, voff) do { _Pragma("unroll") for (int _i = 0; _i < 2; ++_i) \
        __builtin_amdgcn_global_load_lds((const unsigned*)((const char*)(gbase) + (voff)[_i]), (PG8_LAS unsigned*)(lds + (bufoff) + ldsw + _i * 8192), 16, 0, 0); } while (0)
#define PG8_LDA(dst, b, h) do { _Pragma("unroll") for (int m = 0; m < 4; ++m) _Pragma("unroll") for (int k = 0; k < 2; ++k) dst[m][k] = *(const PG8_LAS bf16x8*)(lds + PG8_SA(b, h) + aoff + m * 2048 + k * 1024); } while (0)
#define PG8_LDB(dst, b, h) do { _Pragma("unroll") for (int n = 0; n < 2; ++n) _Pragma("unroll") for (int k = 0; k < 2; ++k) dst[n][k] = *(const PG8_LAS bf16x8*)(lds + PG8_SB(b, h) + boff + n * 2048 + k * 1024); } while (0)
#define PG8_MMA(ai, bj, At, Bt) do { __builtin_amdgcn_s_setprio(1); _Pragma("unroll") for (int m = 0; m < 4; ++m) _Pragma("unroll") for (int n = 0; n < 2; ++n) _Pragma("unroll") for (int k = 0; k < 2; ++k) \
        { if constexpr (I8) acc[ai][bj][m][n] = __builtin_bit_cast(f32x4, __builtin_amdgcn_mfma_i32_16x16x64_i8(__builtin_bit_cast(i32x4, Bt[n][k]), __builtin_bit_cast(i32x4, At[m][k]), __builtin_bit_cast(i32x4, acc[ai][bj][m][n]), 0, 0, 0)); \
          else acc[ai][bj][m][n] = __builtin_amdgcn_mfma_f32_16x16x32_bf16(Bt[n][k], At[m][k], acc[ai][bj][m][n], 0, 0, 0); } __builtin_amdgcn_s_setprio(0); } while (0)
#define PG8_WAIT_V(n) asm volatile("s_waitcnt vmcnt(" #n ")" ::: "memory")
#define PG8_WAIT_L(n) asm volatile("s_waitcnt lgkmcnt(" #n ")" ::: "memory")
#define PG8_BAR __builtin_amdgcn_s_barrier()
#define PG8_SCHED __builtin_amdgcn_sched_barrier(0)
    Unit cur, nxt; int ui = 0;
    if (!S.next(0, cur)) return;
    f32x4 acc[2][2][4][2];
#pragma unroll
    for (int a = 0; a < 2; ++a)
#pragma unroll
        for (int b = 0; b < 2; ++b)
#pragma unroll
            for (int m = 0; m < 4; ++m)
#pragma unroll
                for (int n = 0; n < 2; ++n) acc[a][b][m][n] = (f32x4){0.f, 0.f, 0.f, 0.f};
    bf16x8 At[4][2], B0[2][2], B1[2][2];
    const char* cA = (const char*)g.A + (size_t)cur.pm * tstep; const char* cB = (const char*)g.Bt + (size_t)cur.pn * tstep;
    S.a_ready(cur);
    if constexpr (SP2) {
        PG8_STAGE(PG8_SB(0, 0), cB, voffB); PG8_STAGE(PG8_SB(0, 1), cB + hstepB, voffB); PG8_STAGE(PG8_SA(0, 0), cA, voffA); PG8_STAGE(PG8_SA(0, 1), cA + hstep, voffA);
        if (wr == 1) PG8_BAR;
        PG8_WAIT_V(2); PG8_BAR;
        PG8_STAGE(PG8_SB(1, 0), cB + kstep, voffB); PG8_STAGE(PG8_SA(1, 0), cA + kstep, voffA); PG8_STAGE(PG8_SB(1, 1), cB + hstepB + kstep, voffB);
        PG8_WAIT_V(6); PG8_BAR;
    } else {
        PG8_STAGE(PG8_SB(0, 0), cB, voffB); PG8_STAGE(PG8_SA(0, 0), cA, voffA); PG8_STAGE(PG8_SB(0, 1), cB + hstepB, voffB); PG8_STAGE(PG8_SA(0, 1), cA + hstep, voffA);
        if (wr == 1) PG8_BAR;
        PG8_WAIT_V(4); PG8_BAR;
        PG8_STAGE(PG8_SB(1, 0), cB + kstep, voffB); PG8_STAGE(PG8_SA(1, 0), cA + kstep, voffA); PG8_STAGE(PG8_SB(1, 1), cB + hstepB + kstep, voffB);
        PG8_WAIT_V(6); PG8_BAR;
    }
    for (;;) {
        const bool has_next = S.next(ui + 1, nxt);
        const char* nA = has_next ? (const char*)g.A + (size_t)nxt.pm * tstep : cA; const char* nB = has_next ? (const char*)g.Bt + (size_t)nxt.pn * tstep : cB;
        for (int t = 0; t < nt; t += 2) {
            const bool last = (t == nt - 2);
            const char* a1 = cA + (size_t)(t + 1) * kstep;
            const char* a2 = last ? nA : cA + (size_t)(t + 2) * kstep; const char* b2 = last ? nB : cB + (size_t)(t + 2) * kstep;
            const char* a3 = a2 + kstep; const char* b3 = b2 + kstep;
            if (last && has_next) S.a_ready(nxt);
            if constexpr (SP2) {
            PG8_LDB(B0, 0, 0); PG8_LDB(B1, 0, 1); PG8_SCHED; PG8_LDA(At, 0, 0); PG8_STAGE(PG8_SA(1, 1), a1 + hstep, voffA);
            PG8_WAIT_V(8); PG8_WAIT_L(0); PG8_BAR; PG8_MMA(0, 0, At, B0); PG8_MMA(0, 1, At, B1); PG8_BAR; PG8_SCHED;
            PG8_LDA(At, 0, 1); PG8_STAGE(PG8_SB(0, 0), b2, voffB); PG8_STAGE(PG8_SB(0, 1), b2 + hstepB, voffB); PG8_STAGE(PG8_SA(0, 0), a2, voffA);
            PG8_WAIT_V(8); PG8_WAIT_L(0); PG8_BAR; PG8_MMA(1, 0, At, B0); PG8_MMA(1, 1, At, B1); PG8_BAR; PG8_SCHED;
            PG8_LDB(B0, 1, 0); PG8_LDB(B1, 1, 1); PG8_SCHED; PG8_LDA(At, 1, 0); PG8_STAGE(PG8_SA(0, 1), a2 + hstep, voffA);
            PG8_WAIT_V(8); PG8_WAIT_L(0); PG8_BAR; PG8_MMA(0, 0, At, B0); PG8_MMA(0, 1, At, B1); PG8_BAR; PG8_SCHED;
            PG8_LDA(At, 1, 1); PG8_STAGE(PG8_SB(1, 0), b3, voffB); PG8_STAGE(PG8_SB(1, 1), b3 + hstepB, voffB); PG8_STAGE(PG8_SA(1, 0), a3, voffA);
            PG8_WAIT_V(8); PG8_WAIT_L(0); PG8_BAR; PG8_MMA(1, 0, At, B0); PG8_MMA(1, 1, At, B1); PG8_BAR; PG8_SCHED;
            } else {
            PG8_LDB(B0, 0, 0); PG8_SCHED; PG8_LDA(At, 0, 0); PG8_STAGE(PG8_SA(1, 1), a1 + hstep, voffA);
            PG8_WAIT_L(8); PG8_BAR; PG8_WAIT_L(0); PG8_MMA(0, 0, At, B0); PG8_BAR; PG8_SCHED;
            PG8_LDB(B1, 0, 1); PG8_STAGE(PG8_SB(0, 0), b2, voffB);
            PG8_BAR; PG8_WAIT_L(0); PG8_MMA(0, 1, At, B1); PG8_BAR;
            PG8_LDA(At, 0, 1); PG8_STAGE(PG8_SA(0, 0), a2, voffA);
            PG8_BAR; PG8_WAIT_L(0); PG8_MMA(1, 0, At, B0); PG8_BAR; PG8_SCHED;
            PG8_STAGE(PG8_SB(0, 1), b2 + hstepB, voffB);
            PG8_WAIT_V(6); PG8_BAR; PG8_MMA(1, 1, At, B1); PG8_BAR;
            PG8_LDB(B0, 1, 0); PG8_SCHED; PG8_LDA(At, 1, 0); PG8_STAGE(PG8_SA(0, 1), a2 + hstep, voffA);
            PG8_WAIT_L(8); PG8_BAR; PG8_WAIT_L(0); PG8_MMA(0, 0, At, B0); PG8_BAR; PG8_SCHED;
            PG8_LDB(B1, 1, 1); PG8_STAGE(PG8_SB(1, 0), b3, voffB);
            PG8_BAR; PG8_WAIT_L(0); PG8_MMA(0, 1, At, B1); PG8_BAR;
            PG8_LDA(At, 1, 1); PG8_STAGE(PG8_SA(1, 0), a3, voffA);
            PG8_BAR; PG8_WAIT_L(0); PG8_MMA(1, 0, At, B0); PG8_BAR; PG8_SCHED;
            PG8_STAGE(PG8_SB(1, 1), b3 + hstepB, voffB);
            PG8_WAIT_V(6); PG8_BAR; PG8_MMA(1, 1, At, B1); PG8_BAR;
            }
        }
        if constexpr (ALIGN_EPI) { if (wr == 0) PG8_BAR; }
        if constexpr (!Epi::AFTER_DRAIN) { E(acc, cur, wr, wc, fr, fq); S.done(cur); }
        if (!has_next) break;
#pragma unroll
        for (int a = 0; a < 2; ++a)
#pragma unroll
            for (int b = 0; b < 2; ++b)
#pragma unroll
                for (int m = 0; m < 4; ++m)
#pragma unroll
                    for (int n = 0; n < 2; ++n) acc[a][b][m][n] = (f32x4){0.f, 0.f, 0.f, 0.f};
        cur = nxt; cA = nA; cB = nB; ++ui;
        if constexpr (ALIGN_EPI) { if (wr == 1) PG8_BAR; }
    }
    PG8_WAIT_V(0);
    if constexpr (!ALIGN_EPI) { if (wr == 0) PG8_BAR; }
    PG8_BAR;
    if constexpr (Epi::AFTER_DRAIN) { E.fused(acc, cur, wr, wc, fr, fq, lds, wid, lane); S.done(cur); }
#undef PG8_SA
#undef PG8_SB
#undef PG8_STAGE
#undef PG8_LDA
#undef PG8_LDB
#undef PG8_MMA
#undef PG8_WAIT_V
#undef PG8_WAIT_L
#undef PG8_BAR
#undef PG8_SCHED
}
}

constexpr int NWAVES = 8;
constexpr int T = 16384, DM = 1024, SEQ = 2048, NBATCH = 8, MEMLEN = 256;
constexpr int PW = 6656, PAW = 3584, PGW = 3072;
constexpr int COL_QA = 0, COL_KA = 512, COL_VA = 1024, COL_UC = 1536, COL_BC = 2048, COL_CC = 2560, COL_QX = 3072;
constexpr float RMS_EPS = 1e-6f, LOG2E = 1.4426950408889634f;
constexpr float C2A = 0.125f * LOG2E;
constexpr float C2X = 0.08838834764831845f * LOG2E;
constexpr int NEXP = 16384;

constexpr size_t MiB = 1u << 20;
constexpr size_t WS_CTL = 0, CTL_ZERO_BYTES = 1 * MiB;
constexpr size_t WS_WIN = 1 * MiB;
constexpr size_t WS_WKV = 14 * MiB;
constexpr size_t WS_WBR = 16 * MiB;
constexpr size_t WS_WOUT = 19 * MiB;
constexpr size_t WS_WQ = 21 * MiB;
constexpr size_t WS_SK = 25 * MiB;
constexpr size_t WS_TAB = 25 * MiB + 512 * 1024;
constexpr size_t WS_KMEAN = WS_CTL + 256 * 1024;
constexpr size_t WS_MEMN = 26 * MiB;
constexpr size_t WS_KVM = 30 * MiB;
constexpr size_t WS_SLOTS = 34 * MiB;
constexpr size_t WS_SEL = 35 * MiB;
constexpr size_t WS_SU = 43 * MiB, WS_SV = 43 * MiB + 65536, WS_SX = 43 * MiB + 2 * 65536, WS_CS = 43 * MiB + 3 * 65536, WS_CM = 43 * MiB + 4 * 65536, WS_XS = 43 * MiB + 5 * 65536, WS_SA = 43 * MiB + 6 * 65536, WS_SB = 43 * MiB + 7 * 65536;
constexpr size_t WS_PA = 44 * MiB;
constexpr size_t WS_PG = 156 * MiB;
constexpr size_t WS_END = 252 * MiB;
constexpr size_t PA_MERGED = WS_PA, PA_HB = WS_PA + 32 * MiB, PA_UT = WS_PA + 64 * MiB, PA_VT = WS_PA;
constexpr size_t PG_QRY = WS_PG, PG_PART = WS_PG, PG_COEF = WS_PG + 64 * MiB, PA_XQ = WS_PG + 80 * MiB;
constexpr int CW_QU = 8192, CW_QV = 8192 + 2048, CW_RANK = 8192 + 4096 + 8192;
constexpr int CW_BAR = 4096;

constexpr int RING_OFF = 0, RING_BYTES = 131072;
constexpr int LDSCTL_OFF = RING_BYTES, MISC_OFF = LDSCTL_OFF + 320;
constexpr int LDS_BYTES = 147456;

#define GAS __attribute__((address_space(1)))
#define LAS __attribute__((address_space(3)))
typedef unsigned short bf16;
typedef unsigned v4u __attribute__((ext_vector_type(4)));
typedef unsigned v2u __attribute__((ext_vector_type(2)));
typedef float f32x4 __attribute__((ext_vector_type(4)));
typedef float f32x16 __attribute__((ext_vector_type(16)));
typedef short bf16x8 __attribute__((ext_vector_type(8)));
typedef short s16x4 __attribute__((ext_vector_type(4)));
typedef GAS unsigned gu32;
#define RLX_AGENT __ATOMIC_RELAXED, __HIP_MEMORY_SCOPE_AGENT
#define LDS_WAIT() asm volatile("s_waitcnt lgkmcnt(0)" ::: "memory")
#define VM_WAIT() asm volatile("s_waitcnt vmcnt(0)" ::: "memory")
__device__ __forceinline__ unsigned f2bf(float f) { unsigned u = __builtin_bit_cast(unsigned, f); return (u + 0x7fffu + ((u >> 16) & 1u)) >> 16; }
__device__ __forceinline__ unsigned pk2(float lo, float hi) { return f2bf(lo) | (f2bf(hi) << 16); }
__device__ __forceinline__ float bflo(unsigned w) { return __builtin_bit_cast(float, w << 16); }
__device__ __forceinline__ float bfhi(unsigned w) { return __builtin_bit_cast(float, w & 0xffff0000u); }
__device__ __forceinline__ float wave_sum(float v) {
#pragma unroll
    for (int o = 1; o < 64; o <<= 1) v += __shfl_xor(v, o);
    return v;
}
#define XB_TMO      128
#define XB_XCNT(j)  (256  + 64 * (j))
#define XB_XSUB(j)  (1280 + 64 * (j))
#define XB_XGEN(j)  (2304 + 64 * (j))
#define XB_TOP      3328
#define XB_TOPGEN   3392
#define XCD_BAR_WORDS 3456
#define XB_SPIN_CAP (1u << 18)

__device__ __forceinline__ unsigned xb_ld(unsigned* p)              { return __hip_atomic_load(p, __ATOMIC_RELAXED, __HIP_MEMORY_SCOPE_AGENT); }
__device__ __forceinline__ unsigned xb_add(unsigned* p, unsigned v) { return __hip_atomic_fetch_add(p, v, __ATOMIC_RELAXED, __HIP_MEMORY_SCOPE_AGENT); }
__device__ __forceinline__ unsigned xb_xcc_id() { return (unsigned)__builtin_amdgcn_s_getreg((3 << 11) | 20) & 0xFu; }
#define XB_SPIN(cond, bar) do { unsigned _sp = 0; while (cond) { __builtin_amdgcn_s_sleep(1); \
    if ((++_sp & 255u) == 0u) { if (xb_ld(&(bar)[XB_TMO])) break; if (_sp > XB_SPIN_CAP) { atomicAdd(&(bar)[XB_TMO], 1u); break; } } } } while (0)

struct XcdBarrier {
    unsigned* bar; unsigned x;
    volatile LAS unsigned* st;
};

__device__ __forceinline__ XcdBarrier xcd_barrier_post(unsigned* bar, volatile LAS unsigned* st) {
    XcdBarrier b; b.bar = bar; b.x = xb_xcc_id(); b.st = st;
    if (threadIdx.x == 0) (void)xb_add(&bar[XB_XCNT(b.x)], 1u);
    return b;
}
__device__ __forceinline__ void xcd_barrier_complete(unsigned* bar, unsigned x, unsigned& nloc, unsigned& nx) {
    const unsigned G = gridDim.x * gridDim.y * gridDim.z;
    unsigned sum, cnt, mine, sp = 0u;
    for (;;) {
        sum = 0u; cnt = 0u; mine = 0u;
#pragma unroll
        for (unsigned j = 0; j < 16; ++j) { const unsigned c = xb_ld(&bar[XB_XCNT(j)]); sum += c; cnt += (c > 0u) ? 1u : 0u; mine = (j == x) ? c : mine; }
        if (sum == G) break;
        __builtin_amdgcn_s_sleep(1);
        if ((++sp & 255u) == 0u) { if (xb_ld(&bar[XB_TMO])) break; if (sp > XB_SPIN_CAP) { atomicAdd(&bar[XB_TMO], 1u); break; } }
    }
    nloc = mine > 0u ? mine : 1u; nx = cnt > 0u ? cnt : 1u;
}

__device__ __forceinline__ void xcd_barrier(const XcdBarrier& b) {
    asm volatile("s_waitcnt vmcnt(0)" ::: "memory");
    __syncthreads();
    if (threadIdx.x == 0) {
        unsigned* bar = b.bar;
        __builtin_amdgcn_s_waitcnt(0);
        unsigned nloc = b.st[0], nx = b.st[1];
        if (nloc == 0u) { xcd_barrier_complete(bar, b.x, nloc, nx); b.st[0] = nloc; b.st[1] = nx; }
        const unsigned old = xb_add(&bar[XB_XSUB(b.x)], 1u);
        const unsigned gen = old / nloc;
        if (old + 1u == (gen + 1u) * nloc) {
            __builtin_amdgcn_fence(__ATOMIC_RELEASE, "agent");
            asm volatile("s_waitcnt vmcnt(0)" ::: "memory");
            const unsigned og = xb_add(&bar[XB_TOP], 1u);
            const unsigned tg = og / nx;
            if (og + 1u == (tg + 1u) * nx) xb_add(&bar[XB_TOPGEN], 1u);
            else XB_SPIN(xb_ld(&bar[XB_TOPGEN]) == tg, bar);
            __builtin_amdgcn_fence(__ATOMIC_ACQUIRE, "agent");
            xb_add(&bar[XB_XGEN(b.x)], 1u);
            asm volatile("s_waitcnt vmcnt(0)" ::: "memory");
        } else {
            XB_SPIN(xb_ld(&bar[XB_XGEN(b.x)]) == gen, bar);
            __builtin_amdgcn_fence(__ATOMIC_ACQUIRE, "agent");
            asm volatile("s_waitcnt vmcnt(0)" ::: "memory");
        }
    }
    __syncthreads();
}

__device__ __forceinline__ void p0_transpose_item(const float* W, int K, int N, bf16* WT, int row_off, const float* ksc, LAS float* scr, int item, int lane) {
    const int nblk = N / 32, kb = item / nblk, nb = item % nblk, k0 = 64 * kb, n0 = 32 * nb;
#pragma unroll 8
    for (int i = 0; i < 32; ++i) { const int kk = 2 * i + (lane >> 5); float v = W[(size_t)(k0 + kk) * N + n0 + (lane & 31)]; if (ksc) v *= ksc[k0 + kk]; scr[kk * 33 + (lane & 31)] = v; }
    LDS_WAIT(); asm volatile("" ::: "memory");
    const int c = lane & 7;
#pragma unroll
    for (int j = 0; j < 4; ++j) { const int n = (lane >> 3) + 8 * j; const LAS float* s = scr + (8 * c) * 33 + n;
        v4u o; o.x = pk2(s[0 * 33], s[1 * 33]); o.y = pk2(s[2 * 33], s[3 * 33]); o.z = pk2(s[4 * 33], s[5 * 33]); o.w = pk2(s[6 * 33], s[7 * 33]);
        *(GAS v4u*)(WT + (size_t)(row_off + n0 + n) * K + k0 + 8 * c) = o; }
    LDS_WAIT(); asm volatile("" ::: "memory");
}
template <int NR> __device__ __forceinline__ void rms_rows_to_bf16(const float* X, const float* g, bf16* O, int m0, int ms, int mend, int lane) {
    const GAS f32x4* gr = (const GAS f32x4*)g + lane;
    f32x4 v[NR][4];
#pragma unroll
    for (int r = 0; r < NR; ++r) { const int m = (m0 + r * ms < mend) ? m0 + r * ms : mend - 1; const GAS f32x4* xr = (const GAS f32x4*)(X + (size_t)m * DM) + lane;
#pragma unroll
        for (int j = 0; j < 4; ++j) v[r][j] = xr[64 * j]; }
    f32x4 gv[4];
#pragma unroll
    for (int j = 0; j < 4; ++j) gv[j] = gr[64 * j];
#pragma unroll
    for (int r = 0; r < NR; ++r) { float s = 0.f;
#pragma unroll
        for (int j = 0; j < 4; ++j) s += (v[r][j].x * v[r][j].x + v[r][j].y * v[r][j].y) + (v[r][j].z * v[r][j].z + v[r][j].w * v[r][j].w);
        const float rr = 1.f / sqrtf(wave_sum(s) * (1.f / 1024.f) + RMS_EPS);
        if (m0 + r * ms < mend) { GAS unsigned long long* o8 = (GAS unsigned long long*)(O + (size_t)(m0 + r * ms) * DM) + lane;
#pragma unroll
            for (int j = 0; j < 4; ++j) o8[64 * j] = (unsigned long long)pk2(v[r][j].x * rr * gv[j].x, v[r][j].y * rr * gv[j].y) | ((unsigned long long)pk2(v[r][j].z * rr * gv[j].z, v[r][j].w * rr * gv[j].w) << 32); } }
}
template <int NR> __device__ __forceinline__ void rms_rows_to_i8(const float* X, const float* g, unsigned char* O, float* SA, int m0, int ms, int mend, int lane) {
    const GAS f32x4* gr = (const GAS f32x4*)g + lane;
    f32x4 v[NR][4];
#pragma unroll
    for (int r = 0; r < NR; ++r) { const int m = (m0 + r * ms < mend) ? m0 + r * ms : mend - 1; const GAS f32x4* xr = (const GAS f32x4*)(X + (size_t)m * DM) + lane;
#pragma unroll
        for (int j = 0; j < 4; ++j) v[r][j] = xr[64 * j]; }
    f32x4 gv[4];
#pragma unroll
    for (int j = 0; j < 4; ++j) gv[j] = gr[64 * j];
#pragma unroll
    for (int r = 0; r < NR; ++r) { float s = 0.f;
#pragma unroll
        for (int j = 0; j < 4; ++j) s += (v[r][j].x * v[r][j].x + v[r][j].y * v[r][j].y) + (v[r][j].z * v[r][j].z + v[r][j].w * v[r][j].w);
        const float rr = 1.f / sqrtf(wave_sum(s) * (1.f / 1024.f) + RMS_EPS);
        float am = 0.f;
#pragma unroll
        for (int j = 0; j < 4; ++j) { v[r][j] = v[r][j] * rr * gv[j]; am = fmaxf(am, fmaxf(fmaxf(fabsf(v[r][j].x), fabsf(v[r][j].y)), fmaxf(fabsf(v[r][j].z), fabsf(v[r][j].w)))); }
#pragma unroll
        for (int o = 1; o < 64; o <<= 1) am = fmaxf(am, __shfl_xor(am, o));
        const float sa = am > 0.f ? am * (1.f / 127.f) : 1.f, is = 1.f / sa;
        if (m0 + r * ms < mend) { GAS unsigned* o4 = (GAS unsigned*)(O + (size_t)(m0 + r * ms) * DM) + lane;
#pragma unroll
            for (int j = 0; j < 4; ++j) { const int a = (int)rintf(v[r][j].x * is), b = (int)rintf(v[r][j].y * is), c = (int)rintf(v[r][j].z * is), d = (int)rintf(v[r][j].w * is);
                o4[64 * j] = (unsigned)(a & 0xff) | ((unsigned)(b & 0xff) << 8) | ((unsigned)(c & 0xff) << 16) | ((unsigned)(d & 0xff) << 24); }
            if (lane == 0) SA[m0 + r * ms] = sa; } }
}
__device__ __forceinline__ void p0_quant_cols_wg(const float* W, int N, unsigned char* WT8, float* SB, LAS unsigned char* lds, int nb, int wave, int lane) {
    LAS float* scr = (LAS float*)(lds + RING_OFF + wave * 16384);
    LAS float* red = (LAS float*)(lds + RING_OFF + 8448);
    const int n0 = 32 * nb, kr = lane >> 3, nq = lane & 7;
    f32x4 v[16];
#pragma unroll
    for (int i = 0; i < 16; ++i) v[i] = *(const GAS f32x4*)(W + (size_t)(128 * wave + 8 * i + kr) * N + n0 + 4 * nq);
    f32x4 am = {0.f, 0.f, 0.f, 0.f};
#pragma unroll
    for (int i = 0; i < 16; ++i)
#pragma unroll
        for (int e = 0; e < 4; ++e) am[e] = fmaxf(am[e], fabsf(v[i][e]));
#pragma unroll
    for (int o = 8; o < 64; o <<= 1)
#pragma unroll
        for (int e = 0; e < 4; ++e) am[e] = fmaxf(am[e], __shfl_xor(am[e], o));
    if (lane < 8) *(LAS f32x4*)(red + wave * 32 + 4 * nq) = am;
    __syncthreads();
    f32x4 cm = *(const LAS f32x4*)(red + 4 * nq);
#pragma unroll
    for (int w = 1; w < 8; ++w) { const f32x4 o = *(const LAS f32x4*)(red + w * 32 + 4 * nq);
#pragma unroll
        for (int e = 0; e < 4; ++e) cm[e] = fmaxf(cm[e], o[e]); }
    f32x4 inv, sb;
#pragma unroll
    for (int e = 0; e < 4; ++e) { inv[e] = cm[e] > 0.f ? 127.f / cm[e] : 0.f; sb[e] = cm[e] > 0.f ? cm[e] * (1.f / 127.f) : 1.f; }
    if (wave == 0 && lane < 8) *(GAS f32x4*)(SB + n0 + 4 * nq) = sb;
#pragma unroll
    for (int half = 0; half < 2; ++half) {
#pragma unroll
        for (int i = 0; i < 8; ++i) { const int kk = 8 * i + kr;
#pragma unroll
            for (int e = 0; e < 4; ++e) scr[kk * 33 + 4 * nq + e] = v[8 * half + i][e] * inv[e]; }
        LDS_WAIT(); asm volatile("" ::: "memory");
        const int c = lane & 7;
#pragma unroll
        for (int j = 0; j < 4; ++j) { const int n = (lane >> 3) + 8 * j; const LAS float* s = scr + (8 * c) * 33 + n;
            unsigned q[8];
#pragma unroll
            for (int e = 0; e < 8; ++e) q[e] = (unsigned)((int)rintf(s[e * 33]) & 0xff);
            v2u o; o.x = q[0] | (q[1] << 8) | (q[2] << 16) | (q[3] << 24); o.y = q[4] | (q[5] << 8) | (q[6] << 16) | (q[7] << 24);
            *(GAS v2u*)(WT8 + (size_t)(n0 + n) * DM + 128 * wave + 64 * half + 8 * c) = o; }
        LDS_WAIT(); asm volatile("" ::: "memory");
    }
    __syncthreads();
}
__device__ __forceinline__ void cvt_row_to_bf16(const float* xrow, bf16* orow, int lane) {
    const GAS f32x4* xr = (const GAS f32x4*)xrow + lane; GAS unsigned long long* o8 = (GAS unsigned long long*)orow + lane;
    f32x4 v[4];
#pragma unroll
    for (int j = 0; j < 4; ++j) v[j] = xr[64 * j];
#pragma unroll
    for (int j = 0; j < 4; ++j) o8[64 * j] = (unsigned long long)pk2(v[j].x, v[j].y) | ((unsigned long long)pk2(v[j].z, v[j].w) << 32);
}
__device__ __forceinline__ int rel_bucket_dev(int d) {
    if (d < 16) return d;
    int b = 16;
    b += (d >= 21); b += (d >= 27); b += (d >= 35); b += (d >= 46); b += (d >= 59); b += (d >= 77); b += (d >= 99); b += (d >= 128);
    b += (d >= 166); b += (d >= 216); b += (d >= 280); b += (d >= 363); b += (d >= 470); b += (d >= 609); b += (d >= 790);
    return b;
}
struct P0Args { const float *x, *mem, *g_mix, *w_in, *rel_bias, *g_mem, *w_mem_kv, *w_br_attn, *w_br_conv, *w_br_x, *w_out, *g_ffn, *w_query, *sub_keys;
                bf16 *WinT, *WkvT, *WbrT, *WoutT, *WqT, *SK, *HN, *MEMN; float* TAB; float *SA, *SB; };
__device__ __forceinline__ void p0_transposes(const P0Args& a, LAS unsigned char* lds, int part, int gw, int NGW, int wave, int lane) {
    LAS float* scr = (LAS float*)(lds + RING_OFF + wave * 16384);
    constexpr int I_IN = (DM / 64) * (PW / 32), I_KV = (DM / 64) * (1024 / 32), I_BR = (512 / 64) * (1024 / 32), I_OUT = (DM / 64) * (1024 / 32), I_Q = (DM / 64) * (2048 / 32);
    if (part == 0) {
        for (int nb = gw / NWAVES; nb < PW / 32; nb += NGW / NWAVES) p0_quant_cols_wg(a.w_in, PW, (unsigned char*)a.WinT, a.SB, lds, nb, wave, lane);
        for (int it = gw; it < I_KV; it += NGW) p0_transpose_item(a.w_mem_kv, DM, 1024, a.WkvT, 0, nullptr, scr, it, lane);
    } else {
        for (int it = gw; it < 3 * I_BR + I_OUT + I_Q; it += NGW) {
            int r = it;
            if (r < I_BR) { p0_transpose_item(a.w_br_attn, 512, 1024, a.WbrT, 0, nullptr, scr, r, lane); continue; } r -= I_BR;
            if (r < I_BR) { p0_transpose_item(a.w_br_conv, 512, 1024, a.WbrT, 1024, nullptr, scr, r, lane); continue; } r -= I_BR;
            if (r < I_BR) { p0_transpose_item(a.w_br_x, 512, 1024, a.WbrT, 2048, nullptr, scr, r, lane); continue; } r -= I_BR;
            if (r < I_OUT) { p0_transpose_item(a.w_out, DM, 1024, a.WoutT, 0, nullptr, scr, r, lane); continue; } r -= I_OUT;
            p0_transpose_item(a.w_query, DM, 2048, a.WqT, 0, a.g_ffn, scr, r, lane);
        }
    }
}
__device__ __forceinline__ void p0_prologue(const P0Args& a, LAS unsigned char* lds, bool late_part1, int gw, int NGW, int wave, int lane) {
    p0_transposes(a, lds, 0, gw, NGW, wave, lane);
    if (!late_part1) p0_transposes(a, lds, 1, gw, NGW, wave, lane);
    for (int m = gw; m < T; m += 4 * NGW) rms_rows_to_i8<4>(a.x, a.g_mix, (unsigned char*)a.HN, a.SA, m, NGW, T, lane);
    for (int m = gw; m < NBATCH * MEMLEN; m += NGW) rms_rows_to_bf16<1>(a.mem, a.g_mem, a.MEMN, m, NGW, NBATCH * MEMLEN, lane);
    for (int m = gw; m < 256; m += NGW) cvt_row_to_bf16(a.sub_keys + (size_t)m * 1024, a.SK + (size_t)m * 1024, lane);
    for (int m = gw; m < 256; m += NGW) {
        const int idx = m * 64 + lane, h = idx >> 11, d = idx & 2047;
        a.TAB[idx] = a.rel_bias[rel_bucket_dev(d) * 8 + h] * LOG2E;
    }
}

template <int DH> __device__ __forceinline__ void fix_item(bf16* buf, size_t pitch, int row0, int col0, const float* gain, float gscale, float* kmean, LAS float* red, int wave, int lane) {
    constexpr int LPR = DH / 8, RPI = 64 / LPR, NIT = 32 / RPI;
    const int sub = lane / LPR, ch = lane % LPR;
    float g[8], cs[8];
#pragma unroll
    for (int j = 0; j < 8; ++j) { g[j] = gain[ch * 8 + j] * gscale; cs[j] = 0.f; }
    v4u w[NIT];
#pragma unroll
    for (int it = 0; it < NIT; ++it) w[it] = *(const GAS v4u*)(buf + (size_t)(row0 + wave * 32 + it * RPI + sub) * pitch + col0 + ch * 8);
#pragma unroll
    for (int it = 0; it < NIT; ++it) {
        float x[8] = {bflo(w[it].x), bfhi(w[it].x), bflo(w[it].y), bfhi(w[it].y), bflo(w[it].z), bfhi(w[it].z), bflo(w[it].w), bfhi(w[it].w)};
        float ss = 0.f;
#pragma unroll
        for (int j = 0; j < 8; ++j) ss += x[j] * x[j];
#pragma unroll
        for (int o = 1; o < LPR; o <<= 1) ss += __shfl_xor(ss, o);
        const float r = 1.f / sqrtf(ss * (1.f / DH) + RMS_EPS);
#pragma unroll
        for (int j = 0; j < 8; ++j) { x[j] = x[j] * r * g[j]; cs[j] += x[j]; }
        v4u o; o.x = pk2(x[0], x[1]); o.y = pk2(x[2], x[3]); o.z = pk2(x[4], x[5]); o.w = pk2(x[6], x[7]);
        *(GAS v4u*)(buf + (size_t)(row0 + wave * 32 + it * RPI + sub) * pitch + col0 + ch * 8) = o;
    }
    if (kmean) {
#pragma unroll
        for (int j = 0; j < 8; ++j) {
#pragma unroll
            for (int o = LPR; o < 64; o <<= 1) cs[j] += __shfl_xor(cs[j], o);
        }
        if (sub == 0) {
#pragma unroll
            for (int j = 0; j < 8; ++j) red[wave * DH + ch * 8 + j] = cs[j];
        }
        asm volatile("s_waitcnt lgkmcnt(0)\n\ts_barrier" ::: "memory");
        if (wave == 0 && lane < DH) { float s = 0.f;
#pragma unroll
            for (int w8 = 0; w8 < 8; ++w8) s += red[w8 * DH + lane];
            kmean[lane] = s * (1.f / 256.f); }
        asm volatile("s_waitcnt lgkmcnt(0)\n\ts_barrier" ::: "memory");
    }
}
__device__ __forceinline__ void p2_fixup(bf16* PA, bf16* KVM, float* KMEAN, const float* q_gain_a, const float* k_gain_a, const float* q_gain_x, const float* k_gain_x, LAS unsigned char* lds, int vcu, int G, int wave, int lane) {
    constexpr int N_A = 512, N_X = 256, N_KX = 32, NIT = 2 * N_A + N_X + N_KX;
    LAS float* red = (LAS float*)lds;
    for (int it = vcu; it < NIT; it += G) {
        int r = it;
        if (r < N_A) { const int b = r >> 6, h = (r >> 3) & 7, n = r & 7;
            fix_item<64>(PA, PAW, b * SEQ + n * 256, COL_KA + h * 64, k_gain_a, 1.0f, KMEAN + (size_t)((b * 8 + h) * 8 + n) * 64, red, wave, lane); continue; } r -= N_A;
        if (r < N_A) { const int b = r >> 6, h = (r >> 3) & 7, n = r & 7;
            fix_item<64>(PA, PAW, b * SEQ + n * 256, COL_QA + h * 64, q_gain_a, C2A, nullptr, red, wave, lane); continue; } r -= N_A;
        if (r < N_X) { const int b = r >> 5, h = (r >> 3) & 3, n = r & 7;
            fix_item<128>(PA, PAW, b * SEQ + n * 256, COL_QX + h * 128, q_gain_x, C2X, nullptr, red, wave, lane); continue; } r -= N_X;
        { const int b = r >> 2, h = r & 3;
            fix_item<128>(KVM, 1024, b * MEMLEN, h * 128, k_gain_x, 1.0f, nullptr, red, wave, lane); }
    }
}

namespace att {
constexpr int L_K = 0, L_V = 16384, L_BUF = 32768  , L_OST = 0  ,
              L_TAB = 65536, TAB_PAD = 256, L_KM = L_TAB + (TAB_PAD + 2048) * 4, L_SEL = L_KM + 2048, L_WSF = L_SEL + 1024, L_END = L_WSF + NWAVES * 256;
static_assert(L_END <= RING_BYTES, "attention LDS map");
__device__ __forceinline__ int crow(int r, int hi) { return (r & 3) + 8 * (r >> 2) + 4 * hi; }
__device__ __forceinline__ void glds16(const void* gsrc, unsigned lds_dst) { unsigned keep;
    asm volatile("s_mov_b32 %0, m0\n\ts_mov_b32 m0, %2\n\ts_nop 0\n\tglobal_load_lds_dwordx4 %1, off\n\ts_mov_b32 m0, %0" : "=&s"(keep) : "v"(gsrc), "s"(lds_dst) : "memory"); }
__device__ __forceinline__ unsigned cvtpk(float lo, float hi) { typedef float f2 __attribute__((ext_vector_type(2))); typedef __bf16 b2 __attribute__((ext_vector_type(2))); f2 v = {lo, hi}; b2 b = __builtin_convertvector(v, b2); return __builtin_bit_cast(unsigned, b); }
__device__ __forceinline__ float rowmax(const f32x16& p0, const f32x16& p1) {
    float a = fmaxf(p0[0], p1[0]);
#pragma unroll
    for (int r = 1; r < 16; ++r) a = fmaxf(a, fmaxf(p0[r], p1[r]));
    auto rr = __builtin_amdgcn_permlane32_swap(__float_as_uint(a), __float_as_uint(a), false, false);
    return fmaxf(__uint_as_float(rr[0]), __uint_as_float(rr[1]));
}
template <int ND0> __device__ __forceinline__ void qkt(f32x16& p0, f32x16& p1, const LAS unsigned char* Kslot, const bf16x8* qr, int r32, int hi) {
    const LAS unsigned char* kb = Kslot + hi * 1024 + r32 * 16;
#pragma unroll
    for (int d0 = 0; d0 < ND0; ++d0) {
        const bf16x8 b0 = *(const LAS bf16x8*)(kb + d0 * 2048);
        const bf16x8 b1 = *(const LAS bf16x8*)(kb + d0 * 2048 + 512);
        p0 = __builtin_amdgcn_mfma_f32_32x32x16_bf16(b0, qr[d0], p0, 0, 0, 0);
        p1 = __builtin_amdgcn_mfma_f32_32x32x16_bf16(b1, qr[d0], p1, 0, 0, 0);
    }
}
template <int NDB> __device__ __forceinline__ void pv(f32x16* o, int vb, bf16x8 pa0, bf16x8 pa1, bf16x8 pa2, bf16x8 pa3) {
#pragma unroll
    for (int d0 = 0; d0 < NDB; ++d0) { s16x4 lo[4], hi[4];
#pragma unroll
        for (int ks = 0; ks < 4; ++ks) {
            asm volatile("ds_read_b64_tr_b16 %0,%1 offset:%c2" : "=&v"(lo[ks]) : "v"(vb), "i"(d0 * 4096 + ks * 1024) : "memory");
            asm volatile("ds_read_b64_tr_b16 %0,%1 offset:%c2" : "=&v"(hi[ks]) : "v"(vb), "i"(d0 * 4096 + ks * 1024 + 512) : "memory"); }
        asm volatile("s_waitcnt lgkmcnt(0)" ::: "memory"); __builtin_amdgcn_sched_barrier(0);
#define ATT_PK(k) (bf16x8){lo[k][0], lo[k][1], lo[k][2], lo[k][3], hi[k][0], hi[k][1], hi[k][2], hi[k][3]}
        o[d0] = __builtin_amdgcn_mfma_f32_32x32x16_bf16(pa0, ATT_PK(0), o[d0], 0, 0, 0);
        o[d0] = __builtin_amdgcn_mfma_f32_32x32x16_bf16(pa1, ATT_PK(1), o[d0], 0, 0, 0);
        o[d0] = __builtin_amdgcn_mfma_f32_32x32x16_bf16(pa2, ATT_PK(2), o[d0], 0, 0, 0);
        o[d0] = __builtin_amdgcn_mfma_f32_32x32x16_bf16(pa3, ATT_PK(3), o[d0], 0, 0, 0);
#undef ATT_PK
    }
}
#define ATT_BAR() asm volatile("s_waitcnt lgkmcnt(0)\n\ts_barrier" ::: "memory")
#define ATT_WAIT_BAR() asm volatile("s_waitcnt vmcnt(0) lgkmcnt(0)\n\ts_barrier" ::: "memory")

template <int DH, bool MOBA> __device__ __forceinline__ void attn_unit(const bf16* Qp, size_t qpitch, const bf16* Kp, const bf16* Vp, size_t kpitch, bf16* Op, int qb, const float* kmean_bh, const float* tab_h, const float* gq, const float* gk,
                                                                   LAS unsigned char* lds, int tid, int wid, int lane) {
    constexpr int ND0 = DH / 16, NDB = DH / 32, NPIECE = DH / 64;
    asm volatile("" : "+v"(tid), "+v"(lane));
    const int r32 = lane & 31, hi = lane >> 5;
    const unsigned lds0 = (unsigned)(uintptr_t)lds;
    LAS float* wsf = (LAS float*)(lds + L_WSF) + wid * 64;
    ATT_BAR();
    int my_sel = 0;
    if (MOBA) {
        LAS float* tl = (LAS float*)(lds + L_TAB);
        for (int i = tid; i < TAB_PAD + 2048; i += NWAVES * 64) tl[i] = (i < TAB_PAD) ? -INFINITY : tab_h[i - TAB_PAD];
        LAS float* km = (LAS float*)(lds + L_KM);
        for (int i = tid; i < 512; i += NWAVES * 64) km[i] = kmean_bh[i];
        ATT_BAR();
        if (tid < 256) {
            int sel = 0;
            if (qb <= 3) sel = (1 << qb) - 1;
            else {
                const GAS v4u* qrow = (const GAS v4u*)(Qp + (size_t)tid * qpitch);
                v4u qw[8];
#pragma unroll
                for (int c = 0; c < 8; ++c) qw[c] = qrow[c];
                float b1 = -INFINITY, b2 = -INFINITY, b3 = -INFINITY; int i1 = 0, i2 = 0, i3 = 0;
#pragma unroll 1
                for (int n = 0; n < qb; ++n) { float s = 0.f; const LAS f32x4* kr = (const LAS f32x4*)(km + n * 64);
#pragma unroll
                    for (int c = 0; c < 8; ++c) { const f32x4 ka = kr[2 * c], kb2 = kr[2 * c + 1]; const v4u w = qw[c];
                        s += bflo(w.x) * ka.x; s += bfhi(w.x) * ka.y; s += bflo(w.y) * ka.z; s += bfhi(w.y) * ka.w;
                        s += bflo(w.z) * kb2.x; s += bfhi(w.z) * kb2.y; s += bflo(w.w) * kb2.z; s += bfhi(w.w) * kb2.w; }
                    if (s > b1) { b3 = b2; i3 = i2; b2 = b1; i2 = i1; b1 = s; i1 = n; }
                    else if (s > b2) { b3 = b2; i3 = i2; b2 = s; i2 = n; }
                    else if (s > b3) { b3 = s; i3 = n; } }
                sel = (1 << i1) | (1 << i2) | (1 << i3);
            }
            ((LAS int*)(lds + L_SEL))[tid] = sel;
        }
        ATT_BAR();
        my_sel = ((LAS int*)(lds + L_SEL))[wid * 32 + r32];
    }
    bf16x8 qr[ND0];
    { const bf16* Qw = Qp + (size_t)(wid * 32 + r32) * qpitch + hi * 8;
#pragma unroll
      for (int d0 = 0; d0 < ND0; ++d0) qr[d0] = *(const GAS bf16x8*)(Qw + d0 * 16); }
    if (!MOBA) {
        LAS float* rk = (LAS float*)(lds + L_KM);
        { const int key = tid >> 1, half = tid & 1; const GAS v4u* kr = (const GAS v4u*)(Kp + (size_t)key * kpitch + half * 64); float ss = 0.f;
#pragma unroll
          for (int c = 0; c < 8; ++c) { const v4u w = kr[c]; const float a0 = bflo(w.x), a1 = bfhi(w.x), a2 = bflo(w.y), a3 = bfhi(w.y), a4 = bflo(w.z), a5 = bfhi(w.z), a6 = bflo(w.w), a7 = bfhi(w.w);
              ss += (a0 * a0 + a1 * a1) + (a2 * a2 + a3 * a3) + (a4 * a4 + a5 * a5) + (a6 * a6 + a7 * a7); }
          ss += __shfl_xor(ss, 1);
          if (half == 0) rk[key] = 1.0f / sqrtf(ss * (1.f / 128.f) + RMS_EPS); }
        float qs = 0.f;
#pragma unroll
        for (int d0 = 0; d0 < ND0; ++d0) { const v4u w = __builtin_bit_cast(v4u, qr[d0]); const float a0 = bflo(w.x), a1 = bfhi(w.x), a2 = bflo(w.y), a3 = bfhi(w.y), a4 = bflo(w.z), a5 = bfhi(w.z), a6 = bflo(w.w), a7 = bfhi(w.w);
            qs += (a0 * a0 + a1 * a1) + (a2 * a2 + a3 * a3) + (a4 * a4 + a5 * a5) + (a6 * a6 + a7 * a7); }
        { auto rr = __builtin_amdgcn_permlane32_swap(__float_as_uint(qs), __float_as_uint(qs), false, false); qs = __uint_as_float(rr[0]) + __uint_as_float(rr[1]); }
        const float rq = C2X / sqrtf(qs * (1.f / 128.f) + RMS_EPS);
        int hi8 = hi * 8; asm volatile("" : "+v"(hi8));
#pragma unroll
        for (int d0 = 0; d0 < ND0; ++d0) { const v4u w = __builtin_bit_cast(v4u, qr[d0]);
            const f32x4 ga = *(const GAS f32x4*)(gq + d0 * 16 + hi8), gb = *(const GAS f32x4*)(gq + d0 * 16 + hi8 + 4), ka = *(const GAS f32x4*)(gk + d0 * 16 + hi8), kb2 = *(const GAS f32x4*)(gk + d0 * 16 + hi8 + 4);
            v4u o; o.x = cvtpk(bflo(w.x) * rq * ga.x * ka.x, bfhi(w.x) * rq * ga.y * ka.y); o.y = cvtpk(bflo(w.y) * rq * ga.z * ka.z, bfhi(w.y) * rq * ga.w * ka.w);
            o.z = cvtpk(bflo(w.z) * rq * gb.x * kb2.x, bfhi(w.z) * rq * gb.y * kb2.y); o.w = cvtpk(bflo(w.w) * rq * gb.z * kb2.z, bfhi(w.w) * rq * gb.w * kb2.w);
            qr[d0] = __builtin_bit_cast(bf16x8, o); }
    }
    float m_ref = 0.f, l_run = 0.f;
    constexpr float THR = 8.0f;
    float bfar = 0.f; if (MOBA) bfar = ((const LAS float*)(lds + L_TAB))[TAB_PAD + 2047];
    f32x16 o[NDB];
#pragma unroll
    for (int d = 0; d < NDB; ++d) o[d] = f32x16{};
    const int vb0 = (int)(lds0 + L_V) + ((lane >> 4) & 1) * 32 + (lane & 3) * 8 + (4 * hi + ((lane & 15) >> 2)) * 64;
    const int qrel = wid * 32 + r32;
    const int ntiles = MOBA ? 4 + 4 * qb : 4;
    constexpr int SUB = (DH == 64) ? 2 : 1;
    const int nsteps = ntiles / SUB;
    auto issue_step = [&](int st) {
#pragma unroll
        for (int sub = 0; sub < SUB; ++sub) { const int tt = st * SUB + sub;
            int kb_, j_; if (MOBA) { if (tt < 4) { kb_ = qb; j_ = tt; } else { kb_ = (tt - 4) >> 2; j_ = (tt - 4) & 3; } } else { kb_ = 0; j_ = tt; }
            const int key0_ = kb_ * 256 + j_ * 64; const unsigned bo_ = (unsigned)(st & 1) * L_BUF + (unsigned)sub * 8192u;
#pragma unroll
            for (int pc = 0; pc < NPIECE; ++pc) { const int p = wid + 8 * pc;
                glds16(Kp + (size_t)(key0_ + lane) * kpitch + p * 8, (unsigned)__builtin_amdgcn_readfirstlane(lds0 + bo_ + L_K + p * 1024));
                glds16(Vp + (size_t)(key0_ + 16 * (p & 3) + (lane >> 2)) * kpitch + (p >> 2) * 32 + (lane & 3) * 8, (unsigned)__builtin_amdgcn_readfirstlane(lds0 + bo_ + L_V + p * 1024)); } }
    };
    issue_step(0);
    for (int st = 0; st < nsteps; ++st) {
        ATT_WAIT_BAR();
        if (st + 1 < nsteps) issue_step(st + 1);
#pragma unroll 1
      for (int sub = 0; sub < SUB; ++sub) { const int tt = st * SUB + sub;
        int kb, j; bool own;
        if (MOBA) { if (tt < 4) { kb = qb; j = tt; own = true; } else { kb = (tt - 4) >> 2; j = (tt - 4) & 3; own = false; } }
        else { kb = 0; j = tt; own = false; }
        if (MOBA && own && 64 * j > wid * 32 + 31) continue;
        const unsigned bo = (unsigned)(st & 1) * L_BUF + (unsigned)sub * 8192u;
        f32x16 p0, p1;
        if (MOBA) {
            const float base = ((own || (((my_sel >> kb) & 1) != 0)) ? 0.f : -INFINITY) - m_ref;
            if (!own && qb - kb >= 5) {
                const float cb = base + bfar;
#pragma unroll
                for (int r = 0; r < 16; ++r) { p0[r] = cb; p1[r] = cb; }
            } else {
                const int dbase = (qb - kb) * 256 + qrel - 64 * j - 4 * hi;
                const LAS float* tp = (const LAS float*)(lds + L_TAB) + TAB_PAD + dbase - 63;
#pragma unroll
                for (int r = 0; r < 16; ++r) { const int c = (r & 3) + 8 * (r >> 2); p0[r] = tp[63 - c] + base; p1[r] = tp[31 - c] + base; }
            }
            qkt<ND0>(p0, p1, lds + bo + L_K, qr, r32, hi);
        } else {
            p0 = f32x16{}; p1 = f32x16{};
            qkt<ND0>(p0, p1, lds + bo + L_K, qr, r32, hi);
            const LAS float* rkp = (const LAS float*)(lds + L_KM) + j * 64 + 4 * hi;
#pragma unroll
            for (int r = 0; r < 16; ++r) { const int c = (r & 3) + 8 * (r >> 2); p0[r] = p0[r] * rkp[c] - m_ref; p1[r] = p1[r] * rkp[c + 32] - m_ref; }
        }
        const float rm = rowmax(p0, p1);
        if (__any(rm > THR)) {
            const float dl = fmaxf(rm, 0.f); m_ref += dl;
#pragma unroll
            for (int r = 0; r < 16; ++r) { p0[r] -= dl; p1[r] -= dl; }
            const float f = __builtin_amdgcn_exp2f(-dl); l_run *= f;
            if (hi == 0) wsf[r32] = f;
            LDS_WAIT();
#pragma unroll
            for (int r = 0; r < 16; ++r) { const float ff = wsf[crow(r, hi)];
#pragma unroll
                for (int d = 0; d < NDB; ++d) o[d][r] *= ff; }
        }
        float ps = 0.f;
#pragma unroll
        for (int r = 0; r < 16; ++r) { p0[r] = __builtin_amdgcn_exp2f(p0[r]); p1[r] = __builtin_amdgcn_exp2f(p1[r]); ps += p0[r] + p1[r]; }
        l_run += ps;
        v4u pw0, pw1, pw2, pw3;
        pw0 = (v4u){cvtpk(p0[0], p0[1]), cvtpk(p0[2], p0[3]), cvtpk(p0[4], p0[5]), cvtpk(p0[6], p0[7])};
        pw1 = (v4u){cvtpk(p0[8], p0[9]), cvtpk(p0[10], p0[11]), cvtpk(p0[12], p0[13]), cvtpk(p0[14], p0[15])};
        pw2 = (v4u){cvtpk(p1[0], p1[1]), cvtpk(p1[2], p1[3]), cvtpk(p1[4], p1[5]), cvtpk(p1[6], p1[7])};
        pw3 = (v4u){cvtpk(p1[8], p1[9]), cvtpk(p1[10], p1[11]), cvtpk(p1[12], p1[13]), cvtpk(p1[14], p1[15])};
        pv<NDB>(o, vb0 + (int)bo, __builtin_bit_cast(bf16x8, pw0), __builtin_bit_cast(bf16x8, pw1), __builtin_bit_cast(bf16x8, pw2), __builtin_bit_cast(bf16x8, pw3));
      }
    }
    { auto rr = __builtin_amdgcn_permlane32_swap(__float_as_uint(l_run), __float_as_uint(l_run), false, false); l_run = __uint_as_float(rr[0]) + __uint_as_float(rr[1]); }
    if (hi == 0) wsf[32 + r32] = l_run;
    ATT_BAR();
    LAS bf16* stg = (LAS bf16*)(lds + L_OST + wid * 8192);
#pragma unroll
    for (int r = 0; r < 16; ++r) { const int orow = crow(r, hi); const float rl = __builtin_amdgcn_rcpf(wsf[32 + orow]);
#pragma unroll
        for (int d = 0; d < NDB; ++d) stg[orow * DH + d * 32 + r32] = (bf16)f2bf(o[d][r] * rl); }
    LDS_WAIT();
    constexpr int CPR = DH / 8;
    int lane2 = lane; asm volatile("" : "+v"(lane2));
#pragma unroll
    for (int i = 0; i < (32 * CPR) / 64; ++i) { const int idx = i * 64 + lane2, row = idx / CPR, ch = idx % CPR;
        const v4u v = *(const LAS v4u*)(stg + row * DH + ch * 8);
        *(GAS v4u*)(Op + (size_t)(wid * 32 + row) * 512 + ch * 8) = v; }
}
#undef ATT_BAR
#undef ATT_WAIT_BAR
}

__device__ __forceinline__ void conv_item(const bf16* PA, const float* conv_w, bf16* CO, int item, int tid) {
    asm volatile("" : "+v"(tid));
    const int ch = (tid & 63) * 8, r0 = item * 64 + (tid >> 6) * 8;
    float w0[8], w1[8], w2[8];
#pragma unroll
    for (int j = 0; j < 8; ++j) { w0[j] = conv_w[ch + j]; w1[j] = conv_w[512 + ch + j]; w2[j] = conv_w[1024 + ch + j]; }
    float pm2[8], pm1[8];
#pragma unroll
    for (int j = 0; j < 8; ++j) { pm2[j] = 0.f; pm1[j] = 0.f; }
    auto load8 = [&](int row, int col, float* o) { const v4u w = *(const GAS v4u*)(PA + (size_t)row * PAW + col + ch);
        o[0] = bflo(w.x); o[1] = bfhi(w.x); o[2] = bflo(w.y); o[3] = bfhi(w.y); o[4] = bflo(w.z); o[5] = bfhi(w.z); o[6] = bflo(w.w); o[7] = bfhi(w.w); };
    const int s0 = r0 & (SEQ - 1);
    if (s0 >= 2) { float a[8], b[8]; load8(r0 - 2, COL_CC, a); load8(r0 - 2, COL_UC, b);
#pragma unroll
        for (int j = 0; j < 8; ++j) pm2[j] = a[j] * b[j]; }
    if (s0 >= 1) { float a[8], b[8]; load8(r0 - 1, COL_CC, a); load8(r0 - 1, COL_UC, b);
#pragma unroll
        for (int j = 0; j < 8; ++j) pm1[j] = a[j] * b[j]; }
#pragma unroll
    for (int i = 0; i < 8; ++i) { const int row = r0 + i; float c[8], u[8], bb[8], y[8];
        load8(row, COL_CC, c); load8(row, COL_UC, u); load8(row, COL_BC, bb);
#pragma unroll
        for (int j = 0; j < 8; ++j) { const float cur = c[j] * u[j]; y[j] = bb[j] * (w0[j] * pm2[j] + w1[j] * pm1[j] + w2[j] * cur); pm2[j] = pm1[j]; pm1[j] = cur; }
        v4u o; o.x = pk2(y[0], y[1]); o.y = pk2(y[2], y[3]); o.z = pk2(y[4], y[5]); o.w = pk2(y[6], y[7]);
        *(GAS v4u*)(CO + (size_t)row * 512 + ch) = o; }
}

namespace pk {
template <int N> __device__ __forceinline__ void bsort_desc(unsigned (&a)[N]) {
#pragma unroll
    for (int k = 2; k <= N; k <<= 1) {
#pragma unroll
        for (int j = k >> 1; j > 0; j >>= 1) {
#pragma unroll
            for (int i = 0; i < N; ++i) { const int l = i ^ j;
                if (l > i) { const unsigned x = a[i], y = a[l]; const unsigned mx = x > y ? x : y, mn = x > y ? y : x;
                    if ((i & k) == 0) { a[i] = mx; a[l] = mn; } else { a[i] = mn; a[l] = mx; } } } } }
}
template <int N> __device__ __forceinline__ void bmerge_desc(unsigned (&a)[N]) {
#pragma unroll
    for (int j = N >> 1; j > 0; j >>= 1) {
#pragma unroll
        for (int i = 0; i < N; ++i) { const int l = i ^ j; if (l > i) { const unsigned x = a[i], y = a[l]; a[i] = x > y ? x : y; a[l] = x > y ? y : x; } } }
}
__device__ __forceinline__ void top16_merge(unsigned (&x)[16], const unsigned (&y)[16]) {
#pragma unroll
    for (int i = 0; i < 16; ++i) x[i] = x[i] > y[15 - i] ? x[i] : y[15 - i];
    bmerge_desc<16>(x);
}
__device__ __forceinline__ unsigned f2ord(float f) { const unsigned u = __float_as_uint(f); return u ^ ((unsigned)((int)u >> 31) | 0x80000000u); }
__device__ __forceinline__ float ord2f(unsigned o) { return __uint_as_float(o ^ ((o & 0x80000000u) ? 0x80000000u : 0xFFFFFFFFu)); }

constexpr int L_TBL = 0;
__device__ __forceinline__ void topk_fill(const bf16* SK, LAS unsigned char* lds, int hp, int tid) {
    for (int tb = 0; tb < 4; ++tb) { const bf16* src = SK + (size_t)(((2 * hp + (tb >> 1)) * 2 + (tb & 1)) * 128) * 128;
        for (int idx = tid; idx < 2048; idx += NWAVES * 64) { const int key = idx >> 4, c16 = idx & 15;
            const v4u w = *(const GAS v4u*)(src + key * 128 + c16 * 8);
            *(LAS v4u*)(lds + L_TBL + tb * 32768 + (c16 * 4 + (key >> 5)) * 512 + (key & 31) * 16) = w; } }
    asm volatile("s_waitcnt vmcnt(0) lgkmcnt(0)\n\ts_barrier" ::: "memory");
}
__device__ __forceinline__ void topk_task(const bf16* QRY, const float* SLOTS, unsigned* SEL, LAS unsigned char* lds, int hp, int t0, int lane) {
    asm volatile("" : "+v"(lane));
    const int r32 = lane & 31, hi = lane >> 5;
    const int tok = t0 + r32;
    float rn; { const GAS f32x4* sl = (const GAS f32x4*)(SLOTS + (size_t)tok * 16); const f32x4 a = sl[0], b = sl[1], c = sl[2], d = sl[3];
        const float ss = ((a.x + a.y) + (a.z + a.w)) + ((b.x + b.y) + (b.z + b.w)) + ((c.x + c.y) + (c.z + c.w)) + ((d.x + d.y) + (d.z + d.w));
        rn = 1.f / sqrtf(ss * (1.f / 1024.f) + RMS_EPS); }
    unsigned L[4][16];
    bf16x8 qf[8];
    { const bf16* qp = QRY + (size_t)tok * 2048 + ((2 * hp) * 2) * 128 + hi * 8;
#pragma unroll
      for (int kk = 0; kk < 8; ++kk) qf[kk] = *(const GAS bf16x8*)(qp + kk * 16); }
#pragma unroll
    for (int tb = 0; tb < 4; ++tb) {
        f32x16 acc[4];
#pragma unroll
        for (int blk = 0; blk < 4; ++blk) acc[blk] = f32x16{};
        const LAS unsigned char* tbase = lds + L_TBL + tb * 32768 + hi * 2048 + r32 * 16;
#pragma unroll
        for (int kk = 0; kk < 8; ++kk)
#pragma unroll
            for (int blk = 0; blk < 4; ++blk) { const bf16x8 af = *(const LAS bf16x8*)(tbase + kk * 4096 + blk * 512);
                acc[blk] = __builtin_amdgcn_mfma_f32_32x32x16_bf16(af, qf[kk], acc[blk], 0, 0, 0); }
        if (tb < 3) { const int tn = tb + 1; const bf16* qp = QRY + (size_t)tok * 2048 + ((2 * hp + (tn >> 1)) * 2 + (tn & 1)) * 128 + hi * 8;
#pragma unroll
            for (int kk = 0; kk < 8; ++kk) qf[kk] = *(const GAS bf16x8*)(qp + kk * 16);
            asm volatile("" ::: "memory"); }
        unsigned g[4][16];
#pragma unroll
        for (int blk = 0; blk < 4; ++blk)
#pragma unroll
            for (int r = 0; r < 16; ++r) g[blk][r] = (f2ord(acc[blk][r]) & ~127u) | (unsigned)(127 - (32 * blk + (r & 3) + 8 * (r >> 2)));
#pragma unroll
        for (int blk = 0; blk < 4; ++blk) bsort_desc<16>(g[blk]);
        top16_merge(g[0], g[1]); top16_merge(g[2], g[3]); top16_merge(g[0], g[2]);
#pragma unroll
        for (int i = 0; i < 16; ++i) L[tb][i] = g[0][i] ^ (unsigned)(4 * hi);
    }
    unsigned A[2][16];
#pragma unroll
    for (int p = 0; p < 2; ++p) {
        unsigned X[16], Y[16];
#pragma unroll
        for (int i = 0; i < 16; ++i) { auto rr = __builtin_amdgcn_permlane32_swap(L[p][i], L[2 + p][i], false, false); X[i] = rr[0]; Y[i] = rr[1]; }
        top16_merge(X, Y);
#pragma unroll
        for (int i = 0; i < 16; ++i) A[p][i] = X[i];
    }
    float f0[16], f1[16];
#pragma unroll
    for (int i = 0; i < 16; ++i) { f0[i] = ord2f(A[0][i] & ~127u); f1[i] = ord2f(A[1][i] & ~127u); }
    float sums[50]; unsigned keys[50];
    { int c = 0;
#pragma unroll
      for (int i = 0; i < 16; ++i)
#pragma unroll
          for (int j = 0; j < 16; ++j) if ((i + 1) * (j + 1) <= 16) { sums[c] = f0[i] + f1[j]; keys[c] = (f2ord(sums[c]) & ~63u) | (unsigned)(63 - c); ++c; } }
    unsigned G0[16], R[32];
#pragma unroll
    for (int i = 0; i < 16; ++i) G0[i] = keys[i];
#pragma unroll
    for (int i = 0; i < 32; ++i) R[i] = (i < 26) ? keys[24 + i] : 0u;
    bsort_desc<32>(R);
#pragma unroll
    for (int i = 0; i < 16; ++i) G0[i] = G0[i] > R[15 - i] ? G0[i] : R[15 - i];
    bmerge_desc<16>(G0);
#pragma unroll
    for (int i = 8; i < 16; ++i) G0[i] = G0[i] > keys[16 + 15 - i] ? G0[i] : keys[16 + 15 - i];
    unsigned thr = G0[0];
#pragma unroll
    for (int i = 1; i < 16; ++i) thr = thr < G0[i] ? thr : G0[i];
    const float s00 = sums[0], sc = rn * LOG2E;
    float w[50]; float den = 0.f;
#pragma unroll
    for (int c = 0; c < 50; ++c) { w[c] = (keys[c] >= thr) ? __builtin_amdgcn_exp2f((sums[c] - s00) * sc) : 0.f; den += w[c]; }
    const float inv = 1.f / den;
    unsigned i0[16], i1[16];
#pragma unroll
    for (int i = 0; i < 16; ++i) { i0[i] = 127u - (A[0][i] & 127u); i1[i] = 127u - (A[1][i] & 127u); }
    GAS unsigned* outp = (GAS unsigned*)(SEL + ((size_t)tok * 8 + 2 * hp + hi) * 16);
    int pos = 0;
    { int c = 0;
#pragma unroll
      for (int i = 0; i < 16; ++i)
#pragma unroll
          for (int j = 0; j < 16; ++j) if ((i + 1) * (j + 1) <= 16) { if (keys[c] >= thr) { outp[pos & 15] = ((i0[i] * 128u + i1[j]) << 16) | f2bf(w[c] * inv); ++pos; } ++c; } }
}
}

constexpr size_t SLICE_BYTES = (size_t)NEXP * 128;
constexpr int TH = T / 2;
__device__ __forceinline__ unsigned nib4(float a, float b, float c, float d, float is, int off) {
    const int n0 = min(max((int)floorf(a * is), -8), 7) + off, n1 = min(max((int)floorf(b * is), -8), 7) + off, n2 = min(max((int)floorf(c * is), -8), 7) + off, n3 = min(max((int)floorf(d * is), -8), 7) + off;
    return (unsigned)(n0 & 15) | ((unsigned)(n1 & 15) << 8) | ((unsigned)(n2 & 15) << 16) | ((unsigned)(n3 & 15) << 24);
}
template <int NR, bool OFFLO> __device__ __forceinline__ void quant_rows_i4(const float* X, unsigned char* qtab, float* scale, int e0, int es, int eend, int lane) {
    f32x4 v[NR][4];
#pragma unroll
    for (int r = 0; r < NR; ++r) { const int e = (e0 + r * es < eend) ? e0 + r * es : eend - 1; const GAS f32x4* xr = (const GAS f32x4*)(X + (size_t)e * DM) + lane;
#pragma unroll
        for (int j = 0; j < 4; ++j) v[r][j] = xr[64 * j]; }
#pragma unroll
    for (int r = 0; r < NR; ++r) { float ss = 0.f;
#pragma unroll
        for (int j = 0; j < 4; ++j) ss += (v[r][j].x * v[r][j].x + v[r][j].y * v[r][j].y) + (v[r][j].z * v[r][j].z + v[r][j].w * v[r][j].w);
        ss = wave_sum(ss);
        const float step = ss > 0.f ? 0.3352f * sqrtf(ss * (1.f / 1024.f)) : 1.f, is = 1.f / step;
        const int e = e0 + r * es;
        const unsigned twoc = (OFFLO && !(lane & 1)) ? 0u : 0x08080808u;
#pragma unroll
        for (int j = 0; j < 4; ++j) {
            const f32x4 y = v[r][j] * is + 7.5f;
            unsigned z[4];
#pragma unroll
            for (int e = 0; e < 4; ++e) z[e] = __builtin_bit_cast(unsigned, __builtin_amdgcn_fmed3f(y[e], -0.5f, 15.0f) + 8388864.0f);
            const unsigned o = (__builtin_amdgcn_perm(z[1], z[0], 0x0c0c0400u) | __builtin_amdgcn_perm(z[3], z[2], 0x04000c0cu)) ^ twoc;
            const unsigned po = (unsigned)__builtin_amdgcn_update_dpp(0, (int)o, 0xB1, 0xf, 0xf, true);
            if (e < eend && !(lane & 1)) *(GAS unsigned*)(qtab + (size_t)j * SLICE_BYTES + (size_t)e * 128 + (lane >> 1) * 4) = o | (po << 4); }
        if (e < eend && lane == 0) scale[e] = 0.5f * step; }
}
template <int NR> __device__ __forceinline__ void quant_x(const bf16* HB, unsigned char* XQ, float* SX, int* XS, const float (&gf)[16], int t0, int ts, int lane) {
    f32x4 hv[NR][4];
#pragma unroll
    for (int r = 0; r < NR; ++r) { const int t = (t0 + r * ts < T) ? t0 + r * ts : T - 1; const GAS v2u* hrow = (const GAS v2u*)(HB + (size_t)t * DM) + lane;
#pragma unroll
        for (int j = 0; j < 4; ++j) { const v2u w = hrow[64 * j]; hv[r][j] = (f32x4){bflo(w.x), bfhi(w.x), bflo(w.y), bfhi(w.y)}; } }
#pragma unroll
    for (int r = 0; r < NR; ++r) { float ss = 0.f;
#pragma unroll
        for (int j = 0; j < 4; ++j) ss += (hv[r][j].x * hv[r][j].x + hv[r][j].y * hv[r][j].y) + (hv[r][j].z * hv[r][j].z + hv[r][j].w * hv[r][j].w);
        const float rn = 1.f / sqrtf(wave_sum(ss) * (1.f / 1024.f) + RMS_EPS);
        float xn[16]; float am = 0.f;
#pragma unroll
        for (int j = 0; j < 4; ++j)
#pragma unroll
            for (int e = 0; e < 4; ++e) { xn[4 * j + e] = hv[r][j][e] * rn * gf[4 * j + e]; am = fmaxf(am, fabsf(xn[4 * j + e])); }
#pragma unroll
        for (int o = 1; o < 64; o <<= 1) am = fmaxf(am, __shfl_xor(am, o));
        const float sx = am > 0.f ? am * (1.f / 119.f) : 1.f, isx = 1.f / sx;
        const int t = t0 + r * ts;
        float qsf = 0.f;
#pragma unroll
        for (int j = 0; j < 4; ++j) {
            unsigned zh[4], zl[4];
#pragma unroll
            for (int e = 0; e < 4; ++e) { const float q = __builtin_rintf(xn[4 * j + e] * isx), qh = __builtin_floorf(q * 0.0625f + 0.5f), ql = q - 16.f * qh; qsf += q;
                zh[e] = __builtin_bit_cast(unsigned, qh + 12582912.0f); zl[e] = __builtin_bit_cast(unsigned, ql + 12582912.0f); }
            const unsigned ph = (__builtin_amdgcn_perm(zh[1], zh[0], 0x0c0c0400u) | __builtin_amdgcn_perm(zh[3], zh[2], 0x04000c0cu)) & 0x0f0f0f0fu;
            const unsigned pl = (__builtin_amdgcn_perm(zl[1], zl[0], 0x0c0c0400u) | __builtin_amdgcn_perm(zl[3], zl[2], 0x04000c0cu)) & 0x0f0f0f0fu;
            const unsigned oh = (unsigned)__builtin_amdgcn_update_dpp(0, (int)ph, 0xB1, 0xf, 0xf, true), ol = (unsigned)__builtin_amdgcn_update_dpp(0, (int)pl, 0xB1, 0xf, 0xf, true);
            const unsigned word = (lane & 1) ? (ol | (pl << 4)) : (ph | (oh << 4));
            if (t < T) *(GAS unsigned*)(XQ + (size_t)t * DM + j * 256 + (lane >> 3) * 32 + (lane & 1) * 16 + ((lane & 7) >> 1) * 4) = word; }
        int qs = (int)qsf;
#pragma unroll
        for (int o = 1; o < 64; o <<= 1) qs += __shfl_xor(qs, o);
        if (t < T && lane == 0) { SX[t] = sx; XS[t] = qs; } }
}
__device__ __forceinline__ float gelu_exact(float x) { return 0.5f * x * (1.0f + erff(x * 0.70710678118654752f)); }
__device__ __forceinline__ int dpp_i(int v, int ctrl_is) {
    return ctrl_is == 0 ? __builtin_amdgcn_update_dpp(0, v, 0x141, 0xf, 0xf, true) : ctrl_is == 1 ? __builtin_amdgcn_update_dpp(0, v, 0xB1, 0xf, 0xf, true) : __builtin_amdgcn_update_dpp(0, v, 0x4E, 0xf, 0xf, true);
}
constexpr int QCHUNK = 8;
__device__ __forceinline__ int q_take(unsigned* q, int lane) {
    unsigned v = 0; if (lane == 0) v = __hip_atomic_fetch_add(q, (unsigned)QCHUNK, __ATOMIC_RELAXED, __HIP_MEMORY_SCOPE_AGENT);
    return (int)__builtin_amdgcn_readfirstlane(v);
}
struct TokStream {
    unsigned* q; int cur, end, nxt, stride;
    __device__ __forceinline__ void open_static(int c0, int W) { q = nullptr; cur = c0 * QCHUNK; end = cur + QCHUNK; nxt = 0; stride = W * QCHUNK; }
    __device__ __forceinline__ void open(unsigned* q_, int lane) { q = q_; stride = 0;
        unsigned v = 0; if (lane == 0) v = __hip_atomic_fetch_add(q, 2u * (unsigned)QCHUNK, __ATOMIC_RELAXED, __HIP_MEMORY_SCOPE_AGENT);
        cur = (int)__builtin_amdgcn_readfirstlane(v); end = cur + QCHUNK; nxt = cur + QCHUNK; }
    __device__ __forceinline__ int next(int lane) { const int t = cur; if (t >= TH) return TH; ++cur;
        if (cur == end) { if (q) { cur = nxt; end = cur + QCHUNK; if (cur < TH) nxt = q_take(q, lane); } else { cur += stride - QCHUNK; end = cur + QCHUNK; } }
        return t; }
};
struct SlicePlan { int xcc, srank, sW; unsigned cnts; };
__device__ __forceinline__ SlicePlan slice_plan(int xcc, int srank, int sW, const unsigned* xcnt  , int lane) {
    SlicePlan p; p.xcc = xcc; p.srank = srank; p.sW = sW;
    p.cnts = (sW > 0 && lane < 8) ? __hip_atomic_load(xcnt + 64 * lane, __ATOMIC_RELAXED, __HIP_MEMORY_SCOPE_AGENT) : 0u;
    return p;
}
__device__ __forceinline__ bool slice_open(TokStream& S, const SlicePlan& p, int qi, int x, unsigned* queues, int lane) {
    if (p.sW > 0 && qi == 0) { S.open_static(p.srank, p.sW); return true; }
    if (p.sW > 0 && (unsigned)__builtin_amdgcn_readlane((int)p.cnts, x) != 0u) return false;
    S.open(queues + 64 * x, lane); return true;
}
#define MEM_ORDER() asm volatile("" ::: "memory")
#ifdef PROBE_MASKV
#define PROBE_EMASK & emask
#define PROBE_EARG , unsigned emask
#define PROBE_EPASS , emask
#else
#define PROBE_EMASK
#define PROBE_EARG
#define PROBE_EPASS
#endif
__device__ __forceinline__ unsigned bperm(int src_lane4, unsigned v) { return (unsigned)__builtin_amdgcn_ds_bpermute(src_lane4, (int)v); }
struct UEnt { v2u R; unsigned x; };
__device__ __forceinline__ void u_ent(UEnt& E, const unsigned* SEL, const unsigned char* XQ, int t, int cs, int lane) {
    E.x = *(const GAS unsigned*)(XQ + (size_t)t * DM + cs * 256 + 4 * lane);
    E.R = *(const GAS v2u*)(SEL + (size_t)t * 128 + 2 * lane);
}
__device__ __forceinline__ void u_rows(v4u (&w)[16], unsigned& xr, const UEnt& E, int lane, const unsigned char* tab, unsigned choff PROBE_EARG) {
    const v2u R = E.R;
    const int gb = (lane >> 3) * 32;
#pragma unroll
    for (int g = 0; g < 16; ++g) { const unsigned e = bperm(gb + 4 * (g >> 1), (g & 1) ? R.y : R.x);
        w[g] = *(const GAS v4u*)(tab + (unsigned)(((e >> 16) PROBE_EMASK) * 128u + choff)); }
    xr = E.x;
}
__device__ __forceinline__ int dot8z(unsigned a, unsigned b) { int r; asm("v_dot8_i32_i4 %0, %1, %2, 0" : "=v"(r) : "v"(a), "v"(b)); return r; }
__device__ __forceinline__ void u_compute(const v4u (&w)[16], const unsigned xr, int* prow, int grp, int ch, int c0, int c1, int c2) {
    int p[16];
    v4u xh, xl;
#pragma unroll
    for (int j = 0; j < 4; ++j) { xh[j] = bperm(32 * ch + 4 * j, xr); xl[j] = bperm(32 * ch + 16 + 4 * j, xr); }
#pragma unroll
    for (int g = 0; g < 16; ++g) { int ah = dot8z(w[g][0], xh[0]), al = dot8z(w[g][0], xl[0]);
#pragma unroll
        for (int j = 1; j < 4; ++j) { ah = __builtin_amdgcn_sdot8((int)w[g][j], (int)xh[j], ah, false); al = __builtin_amdgcn_sdot8((int)w[g][j], (int)xl[j], al, false); }
        p[g] = (ah << 4) + al; }
    int q8[8], q4[4], q2[2];
#pragma unroll
    for (int i = 0; i < 8; ++i) { const int keep = c2 ? p[i + 8] : p[i], send = c2 ? p[i] : p[i + 8]; q8[i] = keep + dpp_i(send, 0); }
#pragma unroll
    for (int i = 0; i < 4; ++i) { const int keep = c0 ? q8[i + 4] : q8[i], send = c0 ? q8[i] : q8[i + 4]; q4[i] = keep + dpp_i(send, 1); }
#pragma unroll
    for (int i = 0; i < 2; ++i) { const int keep = c1 ? q4[i + 2] : q4[i], send = c1 ? q4[i] : q4[i + 2]; q2[i] = keep + dpp_i(send, 2); }
    const int g0 = 8 * c2 + 4 * c0 + 2 * c1;
    typedef int i2 __attribute__((ext_vector_type(2)));
    *(GAS i2*)(prow + grp * 16 + g0) = (i2){q2[0], q2[1]};
}
__device__ __forceinline__ void gather_u(const unsigned* SEL0, const unsigned char* XQ0, const unsigned char* UQS, int* PART, int* dummy, unsigned* queues, const SlicePlan& plan, int lane PROBE_EARG) {
    const int grp = lane >> 3, ch = lane & 7, c0 = ch & 1, c1 = (ch >> 1) & 1, c2 = (ch >> 2) & 1;
    for (int qi = 0; qi < 8; ++qi) { const int x = (plan.xcc + qi) & 7, cs = x & 3, tb = (x >> 2) * TH;
        TokStream S; if (!slice_open(S, plan, qi, x, queues, lane)) continue;
        const unsigned char* tab = UQS + (size_t)cs * SLICE_BYTES; const unsigned choff = (unsigned)ch * 16u;
        int* part = PART + ((size_t)cs * T + tb) * 128;
        const unsigned* SEL = SEL0 + (size_t)tb * 128; const unsigned char* XQ = XQ0 + (size_t)tb * DM;
        int tA = S.next(lane), tB = S.next(lane);
        if (tA >= TH) continue;
        UEnt EA, EB; v4u W0[16], W1[16]; unsigned X0, X1;
        u_ent(EA, SEL, XQ, tA, cs, lane); u_ent(EB, SEL, XQ, tB < TH ? tB : TH - 1, cs, lane); MEM_ORDER();
        u_rows(W0, X0, EA, lane, tab, choff PROBE_EPASS); MEM_ORDER();
        while (tA < TH) {
            const int tC = S.next(lane);
            u_ent(EA, SEL, XQ, tC < TH ? tC : TH - 1, cs, lane); MEM_ORDER();
            u_rows(W1, X1, EB, lane, tab, choff PROBE_EPASS); MEM_ORDER();
            u_compute(W0, X0, part + (size_t)tA * 128, grp, ch, c0, c1, c2); MEM_ORDER();
            const int tD = S.next(lane);
            u_ent(EB, SEL, XQ, tD < TH ? tD : TH - 1, cs, lane); MEM_ORDER();
            u_rows(W0, X0, EA, lane, tab, choff PROBE_EPASS); MEM_ORDER();
            u_compute(W1, X1, tB < TH ? part + (size_t)tB * 128 : dummy, grp, ch, c0, c1, c2); MEM_ORDER();
            tA = tC; tB = tD;
        }
    }
}
template <int NR> __device__ __forceinline__ void gather_coef(const unsigned* SEL, const int* PART, const float* SU, const float* SV, const float* SX, const int* XS, signed char* CQ, unsigned* EO, float* SCL, int* CSM, int t0, int ts, int lane) {
    typedef int i2 __attribute__((ext_vector_type(2)));
    v2u ent[NR]; i2 acc[NR]; float sx[NR]; int xs[NR]; int tt[NR];
#pragma unroll
    for (int r = 0; r < NR; ++r) { tt[r] = (t0 + r * ts < T) ? t0 + r * ts : T - 1; ent[r] = *(const GAS v2u*)(SEL + (size_t)tt[r] * 128 + 2 * lane);
        sx[r] = __hip_atomic_load(SX + tt[r], __ATOMIC_RELAXED, __HIP_MEMORY_SCOPE_AGENT);
        xs[r] = __hip_atomic_load(XS + tt[r], __ATOMIC_RELAXED, __HIP_MEMORY_SCOPE_AGENT);
        acc[r] = (i2){0, 0}; }
#pragma unroll
    for (int r = 0; r < NR; ++r)
#pragma unroll
        for (int x = 0; x < 4; ++x) { const i2 pp = *(const GAS i2*)(PART + ((size_t)x * T + tt[r]) * 128 + 2 * lane); acc[r] += pp; }
    float su0[NR], sv0[NR], su1[NR], sv1[NR];
#pragma unroll
    for (int r = 0; r < NR; ++r) { const unsigned e0 = ent[r].x >> 16, e1 = ent[r].y >> 16; su0[r] = SU[e0]; sv0[r] = SV[e0]; su1[r] = SU[e1]; sv1[r] = SV[e1]; }
#pragma unroll
    for (int r = 0; r < NR; ++r) {
        const float k0 = bflo(ent[r].x) * gelu_exact((float)(2 * acc[r].x + xs[r]) * (su0[r] * sx[r])) * sv0[r], k1 = bflo(ent[r].y) * gelu_exact((float)(2 * acc[r].y + xs[r]) * (su1[r] * sx[r])) * sv1[r];
        float am = fmaxf(fabsf(k0), fabsf(k1));
#pragma unroll
        for (int o = 1; o < 64; o <<= 1) am = fmaxf(am, __shfl_xor(am, o));
        const float sc = am > 0.f ? am * (1.f / 127.f) : 1.f, isc = 1.f / sc;
        const int c0 = (int)rintf(k0 * isc), c1 = (int)rintf(k1 * isc);
        int csum = c0 + c1;
#pragma unroll
        for (int o = 1; o < 64; o <<= 1) csum += __shfl_xor(csum, o);
        if (t0 + r * ts < T) {
            GAS unsigned short* cq = (GAS unsigned short*)((GAS signed char*)CQ + (size_t)tt[r] * 128);
            cq[lane] = (unsigned short)((unsigned)(c0 & 0xff) | ((unsigned)(c1 & 0xff) << 8));
            *(GAS v2u*)(EO + (size_t)tt[r] * 128 + 2 * lane) = (v2u){(ent[r].x >> 16) * 128u, (ent[r].y >> 16) * 128u};
            if (lane == 0) { SCL[tt[r]] = sc * 0.125f; CSM[tt[r]] = 8 * csum; } } }
}
typedef int v4i __attribute__((ext_vector_type(4)));
typedef float vf4 __attribute__((ext_vector_type(4)));
struct VCoef { v4i A; float sc; int cs; v4u hb0, hb1; };
struct VEnt { VCoef c; v2u R; };
__device__ __forceinline__ void v_ent(VEnt& E, const unsigned* EO, const signed char* CQ, const float* SCL, const int* CSM, const bf16* HIcol, int t, int lane) {
    const int ic = lane & 3, kb = lane >> 4;
    E.c.A = *(const GAS v4i*)((const GAS signed char*)CQ + (size_t)t * 128 + (2 * kb + (ic & 1)) * 16);
    E.c.sc = __hip_atomic_load(SCL + t, __ATOMIC_RELAXED, __HIP_MEMORY_SCOPE_AGENT);
    E.c.cs = __hip_atomic_load(CSM + t, __ATOMIC_RELAXED, __HIP_MEMORY_SCOPE_AGENT);
    E.c.hb0 = *(const GAS v4u*)(HIcol + (size_t)t * DM);
    E.c.hb1 = *(const GAS v4u*)(HIcol + (size_t)t * DM + 16);
    E.R = *(const GAS v2u*)(EO + (size_t)t * 128 + 2 * lane);
}
__device__ __forceinline__ void v_rows(v4u (&w)[16], VCoef& c, const VEnt& E, int lane, const unsigned char* tab, unsigned choff) {
    const int gb = (lane >> 3) * 32; const v2u R = E.R;
#pragma unroll
    for (int g = 0; g < 16; ++g) { const unsigned eo = bperm(gb + 4 * (g >> 1), (g & 1) ? R.y : R.x); w[g] = *(const GAS v4u*)(tab + (unsigned)(eo + choff)); }
    c = E.c;
}
__device__ __forceinline__ unsigned permb(unsigned hi, unsigned lo, unsigned sel) { return __builtin_amdgcn_perm(hi, lo, sel); }
__device__ __forceinline__ int ror8(int v) { return __builtin_amdgcn_update_dpp(0, v, 0x128, 0xf, 0xf, true); }
__device__ __forceinline__ void v_compute(const v4u (&w)[16], const VCoef& C, float* hout, bool half, bool storer, bool arow) {
    const v4i CA = arow ? C.A : (v4i){0, 0, 0, 0};
    const int k15 = -15 * C.cs;
#pragma unroll
    for (int jp = 0; jp < 2; ++jp) {
        int tr[2][4], th[2][4];
#pragma unroll
        for (int jj = 0; jj < 2; ++jj) { const int j = 2 * jp + jj;
            unsigned K[4][4];
#pragma unroll
            for (int q = 0; q < 4; ++q) { const unsigned a = w[4 * q][j], b = w[4 * q + 1][j], c = w[4 * q + 2][j], d = w[4 * q + 3][j];
                const unsigned t0 = permb(a, b, 0x01050004u), t1 = permb(a, b, 0x03070206u), t2 = permb(c, d, 0x01050004u), t3 = permb(c, d, 0x03070206u);
                K[q][0] = permb(t2, t0, 0x05040100u); K[q][1] = permb(t2, t0, 0x07060302u); K[q][2] = permb(t3, t1, 0x05040100u); K[q][3] = permb(t3, t1, 0x07060302u); }
#pragma unroll
            for (int k = 0; k < 4; ++k) {
                const v4i Br = {(int)K[0][k], (int)K[1][k], (int)K[2][k], (int)K[3][k]};
                const v4i Bh = {(int)(K[0][k] & 0xF0F0F0F0u), (int)(K[1][k] & 0xF0F0F0F0u), (int)(K[2][k] & 0xF0F0F0F0u), (int)(K[3][k] & 0xF0F0F0F0u)};
                const v4i Dr = __builtin_amdgcn_mfma_i32_16x16x64_i8(CA, Br, (v4i){0, 0, 0, 0}, 0, 0, 0);
                const v4i Dh = __builtin_amdgcn_mfma_i32_16x16x64_i8(CA, Bh, (v4i){0, 0, 0, 0}, 0, 0, 0);
                tr[jj][k] = jj ? Dr[1] + ror8(Dr[0]) : Dr[0] + ror8(Dr[1]);
                th[jj][k] = jj ? Dh[1] + ror8(Dh[0]) : Dh[0] + ror8(Dh[1]); }
        }
        int lo[4], hi[4];
#pragma unroll
        for (int k = 0; k < 4; ++k) { const int d0 = tr[0][k] - th[0][k], d1 = tr[1][k] - th[1][k]; lo[k] = half ? d1 : d0; hi[k] = half ? th[1][k] : th[0][k];
            asm volatile("" : "+v"(lo[k]), "+v"(hi[k])); }
        const v4u hb = jp ? C.hb1 : C.hb0;
        const float h8[8] = {bflo(hb.x), bfhi(hb.x), bflo(hb.y), bfhi(hb.y), bflo(hb.z), bfhi(hb.z), bflo(hb.w), bfhi(hb.w)};
        vf4 o0, o1;
#pragma unroll
        for (int k = 0; k < 4; ++k) { o0[k] = h8[k] + C.sc * (float)((lo[k] << 4) + k15);
                                      o1[k] = h8[4 + k] + C.sc * (float)(hi[k] + C.cs); }
        if (storer) { __builtin_nontemporal_store(o0, (GAS vf4*)(hout + 16 * jp)); __builtin_nontemporal_store(o1, (GAS vf4*)(hout + 16 * jp) + 1); }
    }
}
__device__ __forceinline__ void gather_v(const unsigned* EO0, const signed char* CQ0, const float* SCL0, const int* CSM0, const unsigned char* VQS, const bf16* HI0, float* HO0, float* dummy, unsigned* queues, const SlicePlan& plan, int lane) {
    const int ch = lane & 7; const bool half = ((lane >> 3) & 1) != 0, storer = lane < 16, arow = (lane & 15) < 2;
    for (int qi = 0; qi < 8; ++qi) { const int x = (plan.xcc + qi) & 7, cs = x & 3, tb = (x >> 2) * TH;
        TokStream S; if (!slice_open(S, plan, qi, x, queues, lane)) continue;
        const unsigned char* tab = VQS + (size_t)cs * SLICE_BYTES; const unsigned choff = (unsigned)ch * 16u;
        const int col = cs * 256 + ch * 32 + (half ? 8 : 0);
        const unsigned* EO = EO0 + (size_t)tb * 128; const signed char* CQ = CQ0 + (size_t)tb * 128; const float* SCL = SCL0 + tb; const int* CSM = CSM0 + tb;
        const bf16* HI = HI0 + (size_t)tb * DM + col; float* HO = HO0 + (size_t)tb * DM + col;
        int tA = S.next(lane), tB = S.next(lane);
        if (tA >= TH) continue;
        VEnt EA, EB; v4u W0[16], W1[16]; VCoef C0, C1;
        v_ent(EA, EO, CQ, SCL, CSM, HI, tA, lane); v_ent(EB, EO, CQ, SCL, CSM, HI, tB < TH ? tB : TH - 1, lane); MEM_ORDER();
        v_rows(W0, C0, EA, lane, tab, choff); MEM_ORDER();
        while (tA < TH) {
            const int tC = S.next(lane);
            v_ent(EA, EO, CQ, SCL, CSM, HI, tC < TH ? tC : TH - 1, lane); MEM_ORDER();
            v_rows(W1, C1, EB, lane, tab, choff); MEM_ORDER();
            v_compute(W0, C0, HO + (size_t)tA * DM, half, storer, arow); MEM_ORDER();
            const int tD = S.next(lane);
            v_ent(EB, EO, CQ, SCL, CSM, HI, tD < TH ? tD : TH - 1, lane); MEM_ORDER();
            v_rows(W0, C0, EA, lane, tab, choff); MEM_ORDER();
            v_compute(W1, C1, tB < TH ? HO + (size_t)tB * DM : dummy + 32 * (lane & 15), half, storer, arow); MEM_ORDER();
            tA = tC; tB = tD;
        }
    }
}

#ifndef MK_SPLIT
#define MK_SPLIT 0
#endif
constexpr int NPHASE = 11;
typedef SlicePlan pk_plan_t;
#ifndef PROBE_PH
#define PROBE_PH -1
#endif
#ifndef PROBE_N
#define PROBE_N 1
#endif
#define REPS(k) (((k) == PROBE_PH) ? 1 + PROBE_N : 1)
struct Args { const float* in[21]; float* out; unsigned char* ws; int ph_lo, ph_hi; };
static_assert(sizeof(Args) == 23 * 8 + 8, "Args has no padding");

__global__ void __launch_bounds__(NWAVES * 64, 2) fwd(Args args) {
    extern __shared__ __attribute__((aligned(16))) unsigned char lds_raw[];
    LAS unsigned char* lds = (LAS unsigned char*)lds_raw;
    volatile LAS unsigned* MISC = (volatile LAS unsigned*)(lds + MISC_OFF);
    const int tid = threadIdx.x, lane = tid & 63, wave = __builtin_amdgcn_readfirstlane(tid >> 6);
    const int G = gridDim.x; const int bx = blockIdx.x; const int vcu = (G % 8 == 0) ? (bx % 8) * (G / 8) + bx / 8 : bx;
    const int gw = vcu * NWAVES + wave, NGW = G * NWAVES;
    unsigned char* ws = args.ws;
    gu32* ctl = (gu32*)(ws + WS_CTL);
    const float* x = args.in[0]; const float* mem = args.in[1]; const float* g_mix = args.in[2]; const float* w_in = args.in[3]; const float* q_gain_a = args.in[4]; const float* k_gain_a = args.in[5];
    const float* rel_bias = args.in[6]; const float* conv_w = args.in[7]; const float* g_mem = args.in[8]; const float* w_mem_kv = args.in[9]; const float* q_gain_x = args.in[10]; const float* k_gain_x = args.in[11];
    const float* w_br_attn = args.in[12]; const float* w_br_conv = args.in[13]; const float* w_br_x = args.in[14]; const float* w_out = args.in[15]; const float* g_ffn = args.in[16];
    const float* w_query = args.in[17]; const float* sub_keys = args.in[18]; const float* peer_u = args.in[19]; const float* peer_v = args.in[20];
    float* out = args.out;
    bf16* WinT = (bf16*)(ws + WS_WIN); bf16* WkvT = (bf16*)(ws + WS_WKV); bf16* WbrT = (bf16*)(ws + WS_WBR); bf16* WoutT = (bf16*)(ws + WS_WOUT); bf16* WqT = (bf16*)(ws + WS_WQ);
    bf16* SK = (bf16*)(ws + WS_SK); float* TAB = (float*)(ws + WS_TAB); float* KMEAN = (float*)(ws + WS_KMEAN); bf16* MEMN = (bf16*)(ws + WS_MEMN); bf16* KVM = (bf16*)(ws + WS_KVM);
    float* SLOTS = (float*)(ws + WS_SLOTS); unsigned* SEL = (unsigned*)(ws + WS_SEL);
    bf16* PA = (bf16*)(ws + WS_PA); bf16* PG = (bf16*)(ws + WS_PG);
    bf16* MERGED = (bf16*)(ws + PA_MERGED); bf16* HB = (bf16*)(ws + PA_HB); unsigned char* UQ = ws + PA_UT; unsigned char* VQ = ws + PA_VT; float* SU = (float*)(ws + WS_SU); float* SV = (float*)(ws + WS_SV); int* CM = (int*)(ws + WS_CM); float* SAq = (float*)(ws + WS_SA); float* SBq = (float*)(ws + WS_SB); int* XSM = (int*)(ws + WS_XS); float* SX = (float*)(ws + WS_SX); float* CS = (float*)(ws + WS_CS);
    unsigned char* XQ = ws + PA_XQ; int* PART = (int*)(ws + PG_PART); signed char* CQ = (signed char*)(ws + PG_COEF); unsigned* EO = (unsigned*)(ws + PG_COEF + 8 * MiB); bf16* QRY = (bf16*)(ws + PG_QRY);
    bf16* HN = (bf16*)out;
    bf16* BRO = (bf16*)out;

    for (int u = tid; u < (LDS_BYTES - LDSCTL_OFF) / 4; u += NWAVES * 64) ((LAS unsigned*)(lds + LDSCTL_OFF))[u] = 0u;
    __syncthreads();
#if !MK_SPLIT
    XcdBarrier bar = xcd_barrier_post((unsigned*)(ctl + CW_BAR), MISC + 8);
    if (tid == 0) MISC[10] = __hip_atomic_fetch_add((unsigned*)(ctl + CW_RANK) + 64 * (bar.x & 7u), 1u, __ATOMIC_RELAXED, __HIP_MEMORY_SCOPE_AGENT);
#define GRID_BAR() xcd_barrier(bar)
#else
#define GRID_BAR() do {} while (0)
#endif
    const int lo = args.ph_lo, hi_ = args.ph_hi;
#ifndef PH_MASK
#define PH_MASK 0x7ff
#endif
#define IN(k) ((((PH_MASK) >> (k)) & 1) && lo <= (k) && (k) < hi_)
#define BOTH(k) (IN(k) && IN((k) + 1))

    const P0Args p0a{x, mem, g_mix, w_in, rel_bias, g_mem, w_mem_kv, w_br_attn, w_br_conv, w_br_x, w_out, g_ffn, w_query, sub_keys, WinT, WkvT, WbrT, WoutT, WqT, SK, HN, MEMN, TAB, SAq, SBq};
    const int n_busy = (64 * 26) % G + 32; const bool late_w = IN(0) && IN(1) && n_busy < G;
    if (IN(0)) for (int rep = 0; rep < REPS(0); ++rep) {
        p0_prologue(p0a, lds, late_w, gw, NGW, wave, lane);
        if (BOTH(0) && rep == REPS(0) - 1) GRID_BAR();
    }
    if (IN(1)) for (int rep = 0; rep < REPS(1); ++rep) {
        { pg8::Gemm g{HN, WinT, T, PW, DM / 2}; pg8::GOrder S; S.init(T, PW, G, bx); pg8::EpiProj E{PA, PG, q_gain_a, k_gain_a, KMEAN, C2A, RMS_EPS, SAq, SBq};
          pg8::gemm_phase<pg8::EpiProj, pg8::GOrder, true, true, true>(lds + RING_OFF, g, S, E); }
        { const int nfull = (64 * 26) % G; const int coff = (nfull + 32 <= G) ? bx - nfull : bx;
          pg8::Gemm g{MEMN, WkvT, NBATCH * MEMLEN, 1024, DM}; pg8::GOrder S; S.init(NBATCH * MEMLEN, 1024, G, coff); pg8::EpiBf16<0> E{KVM, 1024, nullptr, 0, 0, 1.f};
          pg8::gemm_phase<pg8::EpiBf16<0>, pg8::GOrder, true, true>(lds + RING_OFF, g, S, E); }
        if (late_w && rep == 0 && bx >= n_busy) p0_transposes(p0a, lds, 1, (bx - n_busy) * NWAVES + wave, (G - n_busy) * NWAVES, wave, lane);
        if (IN(1) && IN(3) && rep == REPS(1) - 1) GRID_BAR();
    }
#if defined(PROBE_BARS) && !MK_SPLIT
    if (IN(1)) for (int i = 0; i < PROBE_BARS; ++i) GRID_BAR();
#endif
    if (IN(3)) for (int rep = 0; rep < REPS(3); ++rep) {
        for (int v = vcu; v < 256; v += G) {
            const int bh = v >> 2, b = bh >> 3, h = bh & 7, s = v & 3;
#pragma unroll 1
            for (int pass = 0; pass < 2; ++pass) { const int qb = pass ? 7 - s : s;
                const bf16* Qp = PA + (size_t)(b * SEQ + qb * 256) * PAW + COL_QA + h * 64;
                const bf16* Kp = PA + (size_t)(b * SEQ) * PAW + COL_KA + h * 64; const bf16* Vp = PA + (size_t)(b * SEQ) * PAW + COL_VA + h * 64;
                bf16* Op = BRO + (size_t)(b * SEQ + qb * 256) * 512 + h * 64;
                att::attn_unit<64, true>(Qp, PAW, Kp, Vp, PAW, Op, qb, KMEAN + (size_t)bh * 512, TAB + h * 2048, nullptr, nullptr, lds + RING_OFF, tid, wave, lane); }
            { const int bb = v >> 5, hx = (v >> 3) & 3, qt = v & 7;
                const bf16* Qp = PA + (size_t)(bb * SEQ + qt * 256) * PAW + COL_QX + hx * 128;
                const bf16* Kp = KVM + (size_t)(bb * MEMLEN) * 1024 + hx * 128; const bf16* Vp = Kp + 512;
                bf16* Op = BRO + (size_t)2 * T * 512 + (size_t)(bb * SEQ + qt * 256) * 512 + hx * 128;
                att::attn_unit<128, false>(Qp, PAW, Kp, Vp, 1024, Op, 0, nullptr, nullptr, q_gain_x, k_gain_x, lds + RING_OFF, tid, wave, lane); }
            conv_item(PA, conv_w, BRO + (size_t)T * 512, v, tid);
        }
        if (BOTH(3) && rep == REPS(3) - 1) GRID_BAR();
    }
    if (IN(4)) for (int rep = 0; rep < REPS(4); ++rep) {
        pg8::Gemm g{BRO, WbrT, 3 * T, 3 * 1024, 512}; pg8::BranchOrder S; S.init(G, bx); pg8::EpiBranch E{PG, MERGED};
        pg8::gemm_phase<pg8::EpiBranch, pg8::BranchOrder, true, true>(lds + RING_OFF, g, S, E);
        if (BOTH(4) && rep == REPS(4) - 1) GRID_BAR();
    }
    if (IN(5)) for (int rep = 0; rep < REPS(5); ++rep) {
        pg8::Gemm g{MERGED, WoutT, T, 1024, DM}; pg8::GOrder S; S.init(T, 1024, G, bx); pg8::EpiWout E{x, out, HB, SLOTS};
        pg8::gemm_phase<pg8::EpiWout, pg8::GOrder, true, true>(lds + RING_OFF, g, S, E);
        if (BOTH(5) && rep == REPS(5) - 1) GRID_BAR();
    }
    if (IN(6)) for (int rep = 0; rep < REPS(6); ++rep) {
        pg8::Gemm g{HB, WqT, T, 2048, DM}; pg8::GOrder S; S.init(T, 2048, G, bx); pg8::EpiBf16<0> E{QRY, 2048, nullptr, 0, 0, 1.f};
        pg8::gemm_phase<pg8::EpiBf16<0>, pg8::GOrder, true, true>(lds + RING_OFF, g, S, E);
        if (BOTH(6) && rep == REPS(6) - 1) GRID_BAR();
    }
    if (IN(7)) for (int rep = 0; rep < REPS(7); ++rep) {
        for (int v = vcu; v < 256; v += G) {
            pk::topk_fill(SK, lds + RING_OFF, v & 3, tid);
#ifndef PROBE_SKIP
#define PROBE_SKIP 0
#endif
            const bool lastrep = rep == REPS(7) - 1;
#ifndef P7_NRQ
#define P7_NRQ 4
#endif
#ifdef P7_STAGGER
            if (wave < 4 && (!(PROBE_SKIP & 1) || lastrep)) pk::topk_task(QRY, SLOTS, SEL, lds + RING_OFF, v & 3, ((v >> 2) * 8 + wave) * 32, lane);
#endif
            if (v == vcu && (!(PROBE_SKIP & 2) || lastrep)) {
                const int qgw = vcu * NWAVES + wave, QNGW = G * NWAVES;
                for (int m = qgw; m < NEXP; m += P7_NRQ * QNGW) quant_rows_i4<P7_NRQ, false>(peer_u, UQ, SU, m, QNGW, NEXP, lane);
                for (int m = qgw; m < NEXP; m += P7_NRQ * QNGW) quant_rows_i4<P7_NRQ, true>(peer_v, VQ, SV, m, QNGW, NEXP, lane);
                float gf[16];
#pragma unroll
                for (int j = 0; j < 16; ++j) gf[j] = g_ffn[4 * lane + 256 * (j >> 2) + (j & 3)];
                for (int t = qgw; t < T; t += P7_NRQ * QNGW) quant_x<P7_NRQ>(HB, XQ, SX, XSM, gf, t, QNGW, lane);
            }
#ifdef P7_STAGGER
            if (wave >= 4 && (!(PROBE_SKIP & 1) || lastrep)) pk::topk_task(QRY, SLOTS, SEL, lds + RING_OFF, v & 3, ((v >> 2) * 8 + wave) * 32, lane);
#else
            if (!(PROBE_SKIP & 1) || lastrep) pk::topk_task(QRY, SLOTS, SEL, lds + RING_OFF, v & 3, ((v >> 2) * 8 + wave) * 32, lane);
#endif
            __syncthreads();
        }
        if (BOTH(7) && rep == REPS(7) - 1) GRID_BAR();
    }
#if !MK_SPLIT
    const int xcc = (int)bar.x & 7;
    const int nloc = (int)__builtin_amdgcn_readfirstlane((int)MISC[8]), wrank = (int)__builtin_amdgcn_readfirstlane((int)MISC[10]);
    const pk_plan_t plan = slice_plan(xcc, wrank * NWAVES + wave, nloc * NWAVES, (const unsigned*)(ctl + CW_BAR) + XB_XCNT(0), lane);
#else
    const int xcc = (int)(xb_xcc_id() & 7u);
    const pk_plan_t plan = slice_plan(xcc, 0, 0, nullptr, lane);
#endif
    if (IN(8)) for (int rep = 0; rep < REPS(8); ++rep) {
        #ifdef PROBE_MASKV
        gather_u(SEL, XQ, UQ, PART, (int*)(ws + WS_END), (unsigned*)(ctl + CW_QU + 4096 * rep), plan, lane, (rep == REPS(8) - 1) ? 0xffffu : (unsigned)PROBE_MASKV);
#else
        gather_u(SEL, XQ, UQ, PART, (int*)(ws + WS_END), (unsigned*)(ctl + CW_QU + 4096 * rep), plan, lane);
#endif
        if (BOTH(8) && rep == REPS(8) - 1) GRID_BAR();
    }
    if (IN(9)) for (int rep = 0; rep < REPS(9); ++rep) {
        for (int t = gw; t < T; t += 4 * NGW) gather_coef<4>(SEL, PART, SU, SV, SX, XSM, CQ, EO, CS, CM, t, NGW, lane);
        if (BOTH(9) && rep == REPS(9) - 1) GRID_BAR();
    }
    if (IN(10)) for (int rep = 0; rep < REPS(10); ++rep) {
        gather_v(EO, CQ, CS, CM, VQ, HB, (rep == REPS(10) - 1) ? out : (float*)PART, (float*)(ws + WS_END), (unsigned*)(ctl + CW_QV + 4096 * rep), plan, lane);
    }
#undef IN
#undef BOTH
}

extern "C" void kernel_launch(void* const* d_in, const int* in_sizes, int n_in, void* d_out, int out_size, void* d_ws, size_t ws_size, hipStream_t stream) {
    static int grid = 0;
    if (grid == 0) {
        if (n_in != 21 || out_size != T * DM || ws_size < WS_END + 4096) { fprintf(stderr, "kernel_launch: unexpected shapes (n_in %d, out %d, ws %zu)\n", n_in, out_size, ws_size); grid = -1; return; }
        int dev = 0, cus = 0, per_cu = 0;
        if (hipGetDevice(&dev) != hipSuccess || hipDeviceGetAttribute(&cus, hipDeviceAttributeMultiprocessorCount, dev) != hipSuccess) { grid = -1; return; }
        if (hipFuncSetAttribute((const void*)fwd, hipFuncAttributeMaxDynamicSharedMemorySize, LDS_BYTES) != hipSuccess) { fprintf(stderr, "kernel_launch: hipFuncSetAttribute failed\n"); grid = -1; return; }
        if (hipOccupancyMaxActiveBlocksPerMultiprocessor(&per_cu, (const void*)fwd, NWAVES * 64, LDS_BYTES) != hipSuccess || per_cu < 1) { fprintf(stderr, "kernel_launch: occupancy query reports %d\n", per_cu); }
        (void)hipGetLastError();
        grid = cus;
    }
    if (grid < 0) return;
    (void)hipMemsetAsync((char*)d_ws + WS_CTL, 0, CTL_ZERO_BYTES, stream);
    Args a{};
    for (int i = 0; i < 21; ++i) a.in[i] = (const float*)d_in[i];
    a.out = (float*)d_out; a.ws = (unsigned char*)d_ws;
#if MK_SPLIT
    for (int p = 0; p < NPHASE; ++p) { a.ph_lo = p; a.ph_hi = p + 1; hipLaunchKernelGGL(fwd, dim3(grid), dim3(NWAVES * 64), LDS_BYTES, stream, a); }
#else
#if defined(PROBE_UPTO)
    a.ph_lo = 0; a.ph_hi = PROBE_UPTO + 1;
    hipLaunchKernelGGL(fwd, dim3(grid), dim3(NWAVES * 64), LDS_BYTES, stream, a);
    (void)hipMemsetAsync((char*)d_ws + WS_CTL, 0, CTL_ZERO_BYTES, stream);
#endif
    a.ph_lo = 0; a.ph_hi = NPHASE;
    hipLaunchKernelGGL(fwd, dim3(grid), dim3(NWAVES * 64), LDS_BYTES, stream, a);
#endif
}
```

```cpp
#define P7_NRQ 8
#include <hip/hip_runtime.h>
#include <hip/hip_bf16.h>
#include <cstdio>
#include <cstdint>
#include <cmath>
namespace pg8 {
#define PG8_LAS __attribute__((address_space(3)))
typedef unsigned short bf16_t;
typedef short bf16x8 __attribute__((ext_vector_type(8)));
typedef float f32x4 __attribute__((ext_vector_type(4)));
typedef unsigned u32x4 __attribute__((ext_vector_type(4)));
typedef int i32x4 __attribute__((ext_vector_type(4)));
constexpr int BM = 256, BK = 64, HALF = 128, HTB = HALF * BK * 2  , STAGE_BYTES = 8 * HTB, NXCD = 8, WGM = 8;

__host__ __device__ __forceinline__ int lds_byte(int r, int c) { const int st = (r >> 4) * 2 + (c >> 5), rr = r & 15, cc = c & 31, ob = rr * 64 + cc * 2; return st * 1024 + (ob ^ (((ob >> 9) & 1) << 5)); }
__host__ __device__ __forceinline__ void stage_rc(int b, int& R, int& C) { const int st = b / 1024, sb = b % 1024, swz = sb ^ (((sb >> 9) & 1) << 5); R = (st >> 1) * 16 + swz / 64; C = (st & 1) * 32 + (swz % 64) / 2; }
__host__ __device__ __forceinline__ int perm32(int rho) { const int n = rho >> 4, i = rho & 15; return 8 * (i >> 2) + 4 * n + (i & 3); }

struct Unit { int pm, pn; };
struct Gemm { const bf16_t* A; const bf16_t* Bt; int M, N, K; };

struct StaticOrder {
    int nM, nN, nwg, G, c;
    __host__ __device__ void init(int M, int N, int G_, int c_) { nM = M / BM; nN = N / BM; nwg = nM * nN; G = G_; c = c_; }
    __host__ __device__ bool next(int i, Unit& u) const {
        const long L = (long)i * G + c; if (L >= nwg) return false;
        int wgid = (int)L; { const int q = nwg / NXCD, r = nwg % NXCD, xcd = wgid % NXCD, off = wgid / NXCD; wgid = (xcd < r ? xcd * (q + 1) : r * (q + 1) + (xcd - r) * q) + off; }
        const int nig = WGM * nN, gid = wgid / nig, fm = gid * WGM, gsz = (nM - fm) < WGM ? (nM - fm) : WGM;
        u.pm = fm + ((wgid % nig) % gsz); u.pn = (wgid % nig) / gsz; return true;
    }
    __device__ __forceinline__ void a_ready(const Unit&) const {}
    __device__ __forceinline__ void done(const Unit&) const {}
};

__device__ __forceinline__ unsigned cvt_pk_bf16(float lo, float hi) { unsigned r; asm volatile("v_cvt_pk_bf16_f32 %0, %1, %2" : "=v"(r) : "v"(lo), "v"(hi)); return r; }
typedef float f32x2 __attribute__((ext_vector_type(2)));
__device__ __forceinline__ f32x2 gelu_pk(f32x2 v) {
    const f32x2 av = __builtin_elementwise_abs(v), d = av * 0.2316418882f + 1.0f;
    f32x2 t; t.x = __builtin_amdgcn_rcpf(d.x); t.y = __builtin_amdgcn_rcpf(d.y);
    f32x2 q = t * 0.5307027145f + (-0.7265760135f); q = q * t + 0.7107068705f; q = q * t + (-0.142248368f); q = q * t + 0.127414796f; q = q * t;
    const f32x2 s = (v * v) * (-0.72134752044f);
    f32x2 e; e.x = __builtin_amdgcn_exp2f(s.x); e.y = __builtin_amdgcn_exp2f(s.y);
    const f32x2 m = v * (q * e), r = v - m;
    f32x2 o; o.x = v.x < 0.f ? m.x : r.x; o.y = v.y < 0.f ? m.y : r.y; return o;
}

template <int ACT  > struct EpiBf16 {
    static constexpr bool PERM = true, AFTER_DRAIN = false, HEAD64 = false; static_assert(ACT == 0 || ACT == 1 || ACT == 2, "EpiBf16: ACT is 0 (none), 1 (gelu_pk) or 2 (sigmoid)");
    bf16_t* O; int ldc; const float* bias; int split_cols; size_t split_stride; float scale0;
    __device__ __forceinline__ void operator()(const f32x4 (&acc)[2][2][4][2], const Unit& u, int wr, int wc, int fr, int fq) const {
        const int row0 = u.pm * BM + wr * 64 + fr; int colt = u.pn * BM; bf16_t* base = O;
        float sc = 1.f; if (split_cols) { const int t = colt / split_cols; base += (size_t)t * split_stride; colt -= t * split_cols; if (t == 0) sc = scale0; }
        const int col0 = colt + wc * 32 + 8 * fq, bcol0 = u.pn * BM + wc * 32 + 8 * fq;
        f32x4 bv[2][2];
#pragma unroll
        for (int bj = 0; bj < 2; ++bj)
#pragma unroll
            for (int n = 0; n < 2; ++n) bv[bj][n] = bias ? *(const f32x4*)(bias + bcol0 + bj * HALF + 4 * n) : (f32x4){0.f, 0.f, 0.f, 0.f};
#pragma unroll
        for (int ai = 0; ai < 2; ++ai)
#pragma unroll
            for (int m = 0; m < 4; ++m) { bf16_t* rowp = base + (size_t)(row0 + ai * HALF + m * 16) * ldc + col0;
#pragma unroll
                for (int bj = 0; bj < 2; ++bj) { f32x4 v0 = acc[ai][bj][m][0] + bv[bj][0], v1 = acc[ai][bj][m][1] + bv[bj][1];
                    if (ACT == 1) { f32x2 a = gelu_pk((f32x2){v0[0], v0[1]}), b = gelu_pk((f32x2){v0[2], v0[3]}), c = gelu_pk((f32x2){v1[0], v1[1]}), d = gelu_pk((f32x2){v1[2], v1[3]});
                        v0 = (f32x4){a.x, a.y, b.x, b.y}; v1 = (f32x4){c.x, c.y, d.x, d.y}; }
                    if (ACT == 2) { _Pragma("unroll") for (int e_ = 0; e_ < 4; ++e_) { v0[e_] = __builtin_amdgcn_rcpf(1.0f + __builtin_amdgcn_exp2f(-1.4426950408889634f * v0[e_])); v1[e_] = __builtin_amdgcn_rcpf(1.0f + __builtin_amdgcn_exp2f(-1.4426950408889634f * v1[e_])); } }
                    v0 = v0 * sc; v1 = v1 * sc; u32x4 w; w.x = cvt_pk_bf16(v0[0], v0[1]); w.y = cvt_pk_bf16(v0[2], v0[3]); w.z = cvt_pk_bf16(v1[0], v1[1]); w.w = cvt_pk_bf16(v1[2], v1[3]);
                    *(u32x4*)(rowp + bj * HALF) = w; } }
    }
};


struct GOrder {
    int nM, nN, nwg, G, c;
    __host__ __device__ void init(int M, int N, int G_, int c_) { nM = M / BM; nN = N / BM; nwg = nM * nN; G = G_; c = c_; }
    __host__ __device__ bool next(int i, Unit& u) const {
        if (c < 0) return false;
        const long L = (long)i * G + c; if (L >= nwg) return false;
        int wgid = (int)L; { const int q = nwg / NXCD, r = nwg % NXCD, xcd = wgid % NXCD, off = wgid / NXCD; wgid = (xcd < r ? xcd * (q + 1) : r * (q + 1) + (xcd - r) * q) + off; }
        const int nig = WGM * nN, gid = wgid / nig, fm = gid * WGM, gsz = (nM - fm) < WGM ? (nM - fm) : WGM;
        u.pm = fm + ((wgid % nig) % gsz); u.pn = (wgid % nig) / gsz; return true;
    }
    __device__ __forceinline__ void a_ready(const Unit&) const {}
    __device__ __forceinline__ void done(const Unit&) const {}
};
struct BranchOrder {
    GOrder g;
    __device__ void init(int G, int c) { g.init(16384, 1024, G, c); }
#if defined(PROBE_P4X2)
    __device__ bool next(int i, Unit& u) const { Unit t; if (i >= 6 || !g.next(0, t)) return false; const int br = i % 3; u.pm = 64 * br + t.pm; u.pn = 4 * br + t.pn; return true; }
#else
    __device__ bool next(int i, Unit& u) const { Unit t; if (!g.next(i / 3, t)) return false; const int br = i % 3; u.pm = 64 * br + t.pm; u.pn = 4 * br + t.pn; return true; }
#endif
    __device__ __forceinline__ void a_ready(const Unit&) const {}
    __device__ __forceinline__ void done(const Unit&) const {}
};
__device__ __forceinline__ float bf_lo(unsigned w) { return __builtin_bit_cast(float, w << 16); }
__device__ __forceinline__ float bf_hi(unsigned w) { return __builtin_bit_cast(float, w & 0xffff0000u); }
__device__ __forceinline__ float sigmoid_f(float x) { return __builtin_amdgcn_rcpf(1.0f + __builtin_amdgcn_exp2f(-1.4426950408889634f * x)); }
struct EpiProj {
    static constexpr bool PERM = true, AFTER_DRAIN = false, HEAD64 = true;
    bf16_t* PA; bf16_t* PG; const float* gq; const float* gk; float* KMEAN; float qscale, eps; const float* SA; const float* SB;
    __device__ __forceinline__ void operator()(const f32x4 (&acc)[2][2][4][2], const Unit& u, int wr, int wc, int fr, int fq) const {
        f32x4 sbv[2][2];
        { const float* sp = SB + u.pn * BM + wc * 64 + 8 * fq;
#pragma unroll
          for (int bj = 0; bj < 2; ++bj)
#pragma unroll
              for (int n = 0; n < 2; ++n) sbv[bj][n] = *(const f32x4*)(sp + 32 * bj + 4 * n); }
#define EPQ(ai, bj, m, n, sa) ({ const i32x4 a_ = __builtin_bit_cast(i32x4, acc[ai][bj][m][n]); const f32x4 s_ = sbv[bj][n] * (sa); (f32x4){(float)a_[0] * s_[0], (float)a_[1] * s_[1], (float)a_[2] * s_[2], (float)a_[3] * s_[3]}; })
        const bool gate = u.pn >= 14; const int mode = u.pn < 2 ? 1 : (u.pn < 4 ? 2 : 0);
        bf16_t* base = gate ? PG : PA; const int ldc = gate ? 3072 : 3584; const int colt = gate ? (u.pn - 14) * BM : u.pn * BM;
        const int row0 = u.pm * BM + wr * 64 + fr, col0 = colt + wc * 64 + 8 * fq;
        f32x4 gn[2][2]; f32x4 cs[2][2];
#pragma unroll
        for (int bj = 0; bj < 2; ++bj)
#pragma unroll
            for (int n = 0; n < 2; ++n) { cs[bj][n] = (f32x4){0.f, 0.f, 0.f, 0.f}; gn[bj][n] = (f32x4){1.f, 1.f, 1.f, 1.f};
                if (mode) { const float* gp = (mode == 1 ? gq : gk) + 32 * bj + 8 * fq + 4 * n; const float sc = mode == 1 ? qscale : 1.0f; gn[bj][n] = (f32x4){gp[0] * sc, gp[1] * sc, gp[2] * sc, gp[3] * sc}; } }
#pragma unroll
        for (int ai = 0; ai < 2; ++ai)
#pragma unroll
            for (int m = 0; m < 4; ++m) { bf16_t* rowp = base + (size_t)(row0 + ai * HALF + m * 16) * ldc + col0;
                const float sa = SA[row0 + ai * HALF + m * 16];
                float r = 1.f;
                if (mode) { float ss = 0.f;
#pragma unroll
                    for (int bj = 0; bj < 2; ++bj)
#pragma unroll
                        for (int n = 0; n < 2; ++n) { const f32x4 v = EPQ(ai, bj, m, n, sa); ss += (v[0] * v[0] + v[1] * v[1]) + (v[2] * v[2] + v[3] * v[3]); }
                    ss += __shfl_xor(ss, 16); ss += __shfl_xor(ss, 32);
                    r = 1.0f / sqrtf(ss * (1.f / 64.f) + eps); }
#pragma unroll
                for (int bj = 0; bj < 2; ++bj) { f32x4 v0 = EPQ(ai, bj, m, 0, sa), v1 = EPQ(ai, bj, m, 1, sa);
                    if (gate) {
#pragma unroll
                        for (int e = 0; e < 4; ++e) { v0[e] = sigmoid_f(v0[e]); v1[e] = sigmoid_f(v1[e]); } }
                    if (mode) { v0 = v0 * r * gn[bj][0]; v1 = v1 * r * gn[bj][1]; if (mode == 2) { cs[bj][0] += v0; cs[bj][1] += v1; } }
                    if (gate) {
                        typedef unsigned u32x2g __attribute__((ext_vector_type(2))); unsigned q[8];
#pragma unroll
                        for (int e = 0; e < 4; ++e) { q[e] = (unsigned)__builtin_rintf(v0[e] * 255.f); q[4 + e] = (unsigned)__builtin_rintf(v1[e] * 255.f); }
                        u32x2g wq; wq.x = q[0] | (q[1] << 8) | (q[2] << 16) | (q[3] << 24); wq.y = q[4] | (q[5] << 8) | (q[6] << 16) | (q[7] << 24);
                        *(u32x2g*)((unsigned char*)PG + (size_t)(row0 + ai * HALF + m * 16) * 3072 + col0 + bj * 32) = wq;
                    } else {
                    u32x4 w; w.x = cvt_pk_bf16(v0[0], v0[1]); w.y = cvt_pk_bf16(v0[2], v0[3]); w.z = cvt_pk_bf16(v1[0], v1[1]); w.w = cvt_pk_bf16(v1[2], v1[3]);
                    *(u32x4*)(rowp + bj * 32) = w; } } }
        if (mode == 2) {
            const int b = u.pm >> 3, nb = u.pm & 7, head = (u.pn - 2) * 4 + wc;
            float* km = KMEAN + (size_t)((b * 8 + head) * 8 + nb) * 64 + 8 * fq;
#pragma unroll
            for (int bj = 0; bj < 2; ++bj)
#pragma unroll
                for (int n = 0; n < 2; ++n)
#pragma unroll
                    for (int e = 0; e < 4; ++e) { float s = cs[bj][n][e];
                        s += __shfl_xor(s, 1); s += __shfl_xor(s, 2); s += __shfl_xor(s, 4); s += __shfl_xor(s, 8);
                        if (fr == 0) atomicAdd(km + 32 * bj + 4 * n + e, s * (1.f / 256.f)); }
        }
    }
};
struct EpiBranch {
    static constexpr bool PERM = true, AFTER_DRAIN = false, HEAD64 = false;
    const bf16_t* PG; bf16_t* MG;
    __device__ __forceinline__ void operator()(const f32x4 (&acc)[2][2][4][2], const Unit& u, int wr, int wc, int fr, int fq) const {
        const int br = u.pm >> 6, tm = u.pm & 63, tn = u.pn & 3;
        const int row0 = tm * BM + wr * 64 + fr, col0 = tn * BM + wc * 32 + 8 * fq;
#pragma unroll
        for (int ai = 0; ai < 2; ++ai) {
            typedef unsigned u32x2g __attribute__((ext_vector_type(2)));
            u32x2g g[4][2]; u32x4 p[4][2];
#pragma unroll
            for (int m = 0; m < 4; ++m)
#pragma unroll
                for (int bj = 0; bj < 2; ++bj) { const size_t row = (size_t)(row0 + ai * HALF + m * 16); const int col = col0 + bj * HALF;
                    g[m][bj] = *(const u32x2g*)((const unsigned char*)PG + row * 3072 + br * 1024 + col);
                    p[m][bj] = (br > 0) ? *(const u32x4*)(MG + row * 1024 + col) : (u32x4){0u, 0u, 0u, 0u}; }
#pragma unroll
            for (int m = 0; m < 4; ++m)
#pragma unroll
                for (int bj = 0; bj < 2; ++bj) { const size_t row = (size_t)(row0 + ai * HALF + m * 16); const int col = col0 + bj * HALF;
                    const u32x2g gg = g[m][bj]; const u32x4 pp = p[m][bj]; constexpr float GS = 1.f / 255.f;
                    f32x4 v0 = acc[ai][bj][m][0], v1 = acc[ai][bj][m][1];
                    v0[0] = v0[0] * ((float)(gg.x & 0xffu) * GS) + bf_lo(pp.x); v0[1] = v0[1] * ((float)((gg.x >> 8) & 0xffu) * GS) + bf_hi(pp.x); v0[2] = v0[2] * ((float)((gg.x >> 16) & 0xffu) * GS) + bf_lo(pp.y); v0[3] = v0[3] * ((float)(gg.x >> 24) * GS) + bf_hi(pp.y);
                    v1[0] = v1[0] * ((float)(gg.y & 0xffu) * GS) + bf_lo(pp.z); v1[1] = v1[1] * ((float)((gg.y >> 8) & 0xffu) * GS) + bf_hi(pp.z); v1[2] = v1[2] * ((float)((gg.y >> 16) & 0xffu) * GS) + bf_lo(pp.w); v1[3] = v1[3] * ((float)(gg.y >> 24) * GS) + bf_hi(pp.w);
                    u32x4 w; w.x = cvt_pk_bf16(v0[0], v0[1]); w.y = cvt_pk_bf16(v0[2], v0[3]); w.z = cvt_pk_bf16(v1[0], v1[1]); w.w = cvt_pk_bf16(v1[2], v1[3]);
                    *(u32x4*)(MG + row * 1024 + col) = w; }
        }
    }
};
struct EpiWout {
    static constexpr bool PERM = false, AFTER_DRAIN = false, HEAD64 = false;
    const float* X; float* H; bf16_t* HB; float* SL;
    __device__ __forceinline__ void operator()(const f32x4 (&acc)[2][2][4][2], const Unit& u, int wr, int wc, int fr, int fq) const {
        typedef unsigned u32x2v __attribute__((ext_vector_type(2)));
        const int row0 = u.pm * BM + wr * 64 + fr, col0 = u.pn * BM + wc * 32 + 4 * fq;
#pragma unroll
        for (int ai = 0; ai < 2; ++ai)
#pragma unroll
            for (int mh = 0; mh < 2; ++mh) {
                f32x4 xv[2][2][2];
#pragma unroll
                for (int mm = 0; mm < 2; ++mm)
#pragma unroll
                    for (int bj = 0; bj < 2; ++bj)
#pragma unroll
                        for (int n = 0; n < 2; ++n) xv[mm][bj][n] = *(const f32x4*)(X + (size_t)(row0 + ai * HALF + (2 * mh + mm) * 16) * 1024 + col0 + bj * HALF + n * 16);
#pragma unroll
                for (int mm = 0; mm < 2; ++mm) { const int m = 2 * mh + mm; const size_t row = (size_t)(row0 + ai * HALF + m * 16); float ss = 0.f;
#pragma unroll
                    for (int bj = 0; bj < 2; ++bj)
#pragma unroll
                        for (int n = 0; n < 2; ++n) { const size_t off = row * 1024 + col0 + bj * HALF + n * 16;
                            const f32x4 hv = xv[mm][bj][n] + acc[ai][bj][m][n];
                            ss += (hv[0] * hv[0] + hv[1] * hv[1]) + (hv[2] * hv[2] + hv[3] * hv[3]);
                            u32x2v w; w.x = cvt_pk_bf16(hv[0], hv[1]); w.y = cvt_pk_bf16(hv[2], hv[3]);
                            *(u32x2v*)(HB + off) = w; }
                    ss += __shfl_xor(ss, 16); ss += __shfl_xor(ss, 32);
                    if (fq == 0) SL[row * 16 + u.pn * 4 + wc] = ss; }
            }
    }
};
template <class Epi, class Sched, bool ALIGN_EPI = false, bool SP2 = false, bool I8 = false>
__device__ __forceinline__ void gemm_phase(PG8_LAS unsigned char* lds, const Gemm g, const Sched& S, const Epi& E) {
    const int tid = threadIdx.x, wid = __builtin_amdgcn_readfirstlane(tid >> 6), lane = tid & 63, wr = wid >> 2, wc = wid & 3, fr = lane & 15, fq = lane >> 4;
    const int K = g.K, nt = K / BK;
    unsigned voffA[2], voffB[2];
#pragma unroll
    for (int i = 0; i < 2; ++i) { int R, C; stage_rc(tid * 16 + i * 8192, R, C); const int Rb = Epi::HEAD64 ? (64 * (R >> 5) + perm32(R & 31)) : (Epi::PERM ? ((R & ~31) + perm32(R & 31)) : R);
        voffA[i] = (unsigned)(R * K + C) * 2u; voffB[i] = (unsigned)(Rb * K + C) * 2u; }
    const size_t kstep = (size_t)(BK * 2);
    const size_t hstep = (size_t)HALF * K * 2;
    const size_t hstepB = Epi::HEAD64 ? (size_t)32 * K * 2 : hstep;
    const size_t tstep = 2 * hstep;
    const unsigned ldsw = (unsigned)wid * 1024u;
    const int aoff = lds_byte(wr * 64 + fr, fq * 8), boff = lds_byte(wc * 32 + fr, fq * 8);
#define PG8_SA(b, h) (((b) * 2 + (h)) * HTB)
#define PG8_SB(b, h) ((4 + (b) * 2 + (h)) * HTB)
#define PG8_STAGE(bufoff, gbase, voff) do { _Pragma("unroll") for (int _i = 0; _i < 2; ++_i) \
        __builtin_amdgcn_global_load_lds((const unsigned*)((const char*)(gbase) + (voff)[_i]), (PG8_LAS unsigned*)(lds + (bufoff) + ldsw + _i * 8192), 16, 0, 0); } while (0)
#define PG8_LDA(dst, b, h) do { _Pragma("unroll") for (int m = 0; m < 4; ++m) _Pragma("unroll") for (int k = 0; k < 2; ++k) dst[m][k] = *(const PG8_LAS bf16x8*)(lds + PG8_SA(b, h) + aoff + m * 2048 + k * 1024); } while (0)
#define PG8_LDB(dst, b, h) do { _Pragma("unroll") for (int n = 0; n < 2; ++n) _Pragma("unroll") for (int k = 0; k < 2; ++k) dst[n][k] = *(const PG8_LAS bf16x8*)(lds + PG8_SB(b, h) + boff + n * 2048 + k * 1024); } while (0)
#define PG8_MMA(ai, bj, At, Bt) do { __builtin_amdgcn_s_setprio(1); _Pragma("unroll") for (int m = 0; m < 4; ++m) _Pragma("unroll") for (int n = 0; n < 2; ++n) _Pragma("unroll") for (int k = 0; k < 2; ++k) \
        { if constexpr (I8) acc[ai][bj][m][n] = __builtin_bit_cast(f32x4, __builtin_amdgcn_mfma_i32_16x16x64_i8(__builtin_bit_cast(i32x4, Bt[n][k]), __builtin_bit_cast(i32x4, At[m][k]), __builtin_bit_cast(i32x4, acc[ai][bj][m][n]), 0, 0, 0)); \
          else acc[ai][bj][m][n] = __builtin_amdgcn_mfma_f32_16x16x32_bf16(Bt[n][k], At[m][k], acc[ai][bj][m][n], 0, 0, 0); } __builtin_amdgcn_s_setprio(0); } while (0)
#define PG8_WAIT_V(n) asm volatile("s_waitcnt vmcnt(" #n ")" ::: "memory")
#define PG8_WAIT_L(n) asm volatile("s_waitcnt lgkmcnt(" #n ")" ::: "memory")
#define PG8_BAR __builtin_amdgcn_s_barrier()
#define PG8_SCHED __builtin_amdgcn_sched_barrier(0)
    Unit cur, nxt; int ui = 0;
    if (!S.next(0, cur)) return;
    f32x4 acc[2][2][4][2];
#pragma unroll
    for (int a = 0; a < 2; ++a)
#pragma unroll
        for (int b = 0; b < 2; ++b)
#pragma unroll
            for (int m = 0; m < 4; ++m)
#pragma unroll
                for (int n = 0; n < 2; ++n) acc[a][b][m][n] = (f32x4){0.f, 0.f, 0.f, 0.f};
    bf16x8 At[4][2], B0[2][2], B1[2][2];
    const char* cA = (const char*)g.A + (size_t)cur.pm * tstep; const char* cB = (const char*)g.Bt + (size_t)cur.pn * tstep;
    S.a_ready(cur);
    if constexpr (SP2) {
        PG8_STAGE(PG8_SB(0, 0), cB, voffB); PG8_STAGE(PG8_SB(0, 1), cB + hstepB, voffB); PG8_STAGE(PG8_SA(0, 0), cA, voffA); PG8_STAGE(PG8_SA(0, 1), cA + hstep, voffA);
        if (wr == 1) PG8_BAR;
        PG8_WAIT_V(2); PG8_BAR;
        PG8_STAGE(PG8_SB(1, 0), cB + kstep, voffB); PG8_STAGE(PG8_SA(1, 0), cA + kstep, voffA); PG8_STAGE(PG8_SB(1, 1), cB + hstepB + kstep, voffB);
        PG8_WAIT_V(6); PG8_BAR;
    } else {
        PG8_STAGE(PG8_SB(0, 0), cB, voffB); PG8_STAGE(PG8_SA(0, 0), cA, voffA); PG8_STAGE(PG8_SB(0, 1), cB + hstepB, voffB); PG8_STAGE(PG8_SA(0, 1), cA + hstep, voffA);
        if (wr == 1) PG8_BAR;
        PG8_WAIT_V(4); PG8_BAR;
        PG8_STAGE(PG8_SB(1, 0), cB + kstep, voffB); PG8_STAGE(PG8_SA(1, 0), cA + kstep, voffA); PG8_STAGE(PG8_SB(1, 1), cB + hstepB + kstep, voffB);
        PG8_WAIT_V(6); PG8_BAR;
    }
    for (;;) {
        const bool has_next = S.next(ui + 1, nxt);
        const char* nA = has_next ? (const char*)g.A + (size_t)nxt.pm * tstep : cA; const char* nB = has_next ? (const char*)g.Bt + (size_t)nxt.pn * tstep : cB;
        for (int t = 0; t < nt; t += 2) {
            const bool last = (t == nt - 2);
            const char* a1 = cA + (size_t)(t + 1) * kstep;
            const char* a2 = last ? nA : cA + (size_t)(t + 2) * kstep; const char* b2 = last ? nB : cB + (size_t)(t + 2) * kstep;
            const char* a3 = a2 + kstep; const char* b3 = b2 + kstep;
            if (last && has_next) S.a_ready(nxt);
            if constexpr (SP2) {
            PG8_LDB(B0, 0, 0); PG8_LDB(B1, 0, 1); PG8_SCHED; PG8_LDA(At, 0, 0); PG8_STAGE(PG8_SA(1, 1), a1 + hstep, voffA);
            PG8_WAIT_V(8); PG8_WAIT_L(0); PG8_BAR; PG8_MMA(0, 0, At, B0); PG8_MMA(0, 1, At, B1); PG8_BAR; PG8_SCHED;
            PG8_LDA(At, 0, 1); PG8_STAGE(PG8_SB(0, 0), b2, voffB); PG8_STAGE(PG8_SB(0, 1), b2 + hstepB, voffB); PG8_STAGE(PG8_SA(0, 0), a2, voffA);
            PG8_WAIT_V(8); PG8_WAIT_L(0); PG8_BAR; PG8_MMA(1, 0, At, B0); PG8_MMA(1, 1, At, B1); PG8_BAR; PG8_SCHED;
            PG8_LDB(B0, 1, 0); PG8_LDB(B1, 1, 1); PG8_SCHED; PG8_LDA(At, 1, 0); PG8_STAGE(PG8_SA(0, 1), a2 + hstep, voffA);
            PG8_WAIT_V(8); PG8_WAIT_L(0); PG8_BAR; PG8_MMA(0, 0, At, B0); PG8_MMA(0, 1, At, B1); PG8_BAR; PG8_SCHED;
            PG8_LDA(At, 1, 1); PG8_STAGE(PG8_SB(1, 0), b3, voffB); PG8_STAGE(PG8_SB(1, 1), b3 + hstepB, voffB); PG8_STAGE(PG8_SA(1, 0), a3, voffA);
            PG8_WAIT_V(8); PG8_WAIT_L(0); PG8_BAR; PG8_MMA(1, 0, At, B0); PG8_MMA(1, 1, At, B1); PG8_BAR; PG8_SCHED;
            } else {
            PG8_LDB(B0, 0, 0); PG8_SCHED; PG8_LDA(At, 0, 0); PG8_STAGE(PG8_SA(1, 1), a1 + hstep, voffA);
            PG8_WAIT_L(8); PG8_BAR; PG8_WAIT_L(0); PG8_MMA(0, 0, At, B0); PG8_BAR; PG8_SCHED;
            PG8_LDB(B1, 0, 1); PG8_STAGE(PG8_SB(0, 0), b2, voffB);
            PG8_BAR; PG8_WAIT_L(0); PG8_MMA(0, 1, At, B1); PG8_BAR;
            PG8_LDA(At, 0, 1); PG8_STAGE(PG8_SA(0, 0), a2, voffA);
            PG8_BAR; PG8_WAIT_L(0); PG8_MMA(1, 0, At, B0); PG8_BAR; PG8_SCHED;
            PG8_STAGE(PG8_SB(0, 1), b2 + hstepB, voffB);
            PG8_WAIT_V(6); PG8_BAR; PG8_MMA(1, 1, At, B1); PG8_BAR;
            PG8_LDB(B0, 1, 0); PG8_SCHED; PG8_LDA(At, 1, 0); PG8_STAGE(PG8_SA(0, 1), a2 + hstep, voffA);
            PG8_WAIT_L(8); PG8_BAR; PG8_WAIT_L(0); PG8_MMA(0, 0, At, B0); PG8_BAR; PG8_SCHED;
            PG8_LDB(B1, 1, 1); PG8_STAGE(PG8_SB(1, 0), b3, voffB);
            PG8_BAR; PG8_WAIT_L(0); PG8_MMA(0, 1, At, B1); PG8_BAR;
            PG8_LDA(At, 1, 1); PG8_STAGE(PG8_SA(1, 0), a3, voffA);
            PG8_BAR; PG8_WAIT_L(0); PG8_MMA(1, 0, At, B0); PG8_BAR; PG8_SCHED;
            PG8_STAGE(PG8_SB(1, 1), b3 + hstepB, voffB);
            PG8_WAIT_V(6); PG8_BAR; PG8_MMA(1, 1, At, B1); PG8_BAR;
            }
        }
        if constexpr (ALIGN_EPI) { if (wr == 0) PG8_BAR; }
        if constexpr (!Epi::AFTER_DRAIN) { E(acc, cur, wr, wc, fr, fq); S.done(cur); }
        if (!has_next) break;
#pragma unroll
        for (int a = 0; a < 2; ++a)
#pragma unroll
            for (int b = 0; b < 2; ++b)
#pragma unroll
                for (int m = 0; m < 4; ++m)
#pragma unroll
                    for (int n = 0; n < 2; ++n) acc[a][b][m][n] = (f32x4){0.f, 0.f, 0.f, 0.f};
        cur = nxt; cA = nA; cB = nB; ++ui;
        if constexpr (ALIGN_EPI) { if (wr == 1) PG8_BAR; }
    }
    PG8_WAIT_V(0);
    if constexpr (!ALIGN_EPI) { if (wr == 0) PG8_BAR; }
    PG8_BAR;
    if constexpr (Epi::AFTER_DRAIN) { E.fused(acc, cur, wr, wc, fr, fq, lds, wid, lane); S.done(cur); }
#undef PG8_SA
#undef PG8_SB
#undef PG8_STAGE
#undef PG8_LDA
#undef PG8_LDB
#undef PG8_MMA
#undef PG8_WAIT_V
#undef PG8_WAIT_L
#undef PG8_BAR
#undef PG8_SCHED
}
}

constexpr int NWAVES = 8;
constexpr int T = 16384, DM = 1024, SEQ = 2048, NBATCH = 8, MEMLEN = 256;
constexpr int PW = 6656, PAW = 3584, PGW = 3072;
constexpr int COL_QA = 0, COL_KA = 512, COL_VA = 1024, COL_UC = 1536, COL_BC = 2048, COL_CC = 2560, COL_QX = 3072;
constexpr float RMS_EPS = 1e-6f, LOG2E = 1.4426950408889634f;
constexpr float C2A = 0.125f * LOG2E;
constexpr float C2X = 0.08838834764831845f * LOG2E;
constexpr int NEXP = 16384;

constexpr size_t MiB = 1u << 20;
constexpr size_t WS_CTL = 0, CTL_ZERO_BYTES = 1 * MiB;
constexpr size_t WS_WIN = 1 * MiB;
constexpr size_t WS_WKV = 14 * MiB;
constexpr size_t WS_WBR = 16 * MiB;
constexpr size_t WS_WOUT = 19 * MiB;
constexpr size_t WS_WQ = 21 * MiB;
constexpr size_t WS_SK = 25 * MiB;
constexpr size_t WS_TAB = 25 * MiB + 512 * 1024;
constexpr size_t WS_KMEAN = WS_CTL + 256 * 1024;
constexpr size_t WS_MEMN = 26 * MiB;
constexpr size_t WS_KVM = 30 * MiB;
constexpr size_t WS_SLOTS = 34 * MiB;
constexpr size_t WS_SEL = 35 * MiB;
constexpr size_t WS_SU = 43 * MiB, WS_SV = 43 * MiB + 65536, WS_SX = 43 * MiB + 2 * 65536, WS_CS = 43 * MiB + 3 * 65536, WS_CM = 43 * MiB + 4 * 65536, WS_XS = 43 * MiB + 5 * 65536, WS_SA = 43 * MiB + 6 * 65536, WS_SB = 43 * MiB + 7 * 65536;
constexpr size_t WS_PA = 44 * MiB;
constexpr size_t WS_PG = 156 * MiB;
constexpr size_t WS_END = 252 * MiB;
constexpr size_t PA_MERGED = WS_PA, PA_HB = WS_PA + 32 * MiB, PA_UT = WS_PA + 64 * MiB, PA_VT = WS_PA;
constexpr size_t PG_QRY = WS_PG, PG_PART = WS_PG, PG_COEF = WS_PG + 64 * MiB, PA_XQ = WS_PG + 80 * MiB;
constexpr int CW_QU = 8192, CW_QV = 8192 + 2048, CW_RANK = 8192 + 4096 + 8192;
constexpr int CW_BAR = 4096;

constexpr int RING_OFF = 0, RING_BYTES = 131072;
constexpr int LDSCTL_OFF = RING_BYTES, MISC_OFF = LDSCTL_OFF + 320;
constexpr int LDS_BYTES = 147456;

#define GAS __attribute__((address_space(1)))
#define LAS __attribute__((address_space(3)))
typedef unsigned short bf16;
typedef unsigned v4u __attribute__((ext_vector_type(4)));
typedef unsigned v2u __attribute__((ext_vector_type(2)));
typedef float f32x4 __attribute__((ext_vector_type(4)));
typedef float f32x16 __attribute__((ext_vector_type(16)));
typedef short bf16x8 __attribute__((ext_vector_type(8)));
typedef short s16x4 __attribute__((ext_vector_type(4)));
typedef GAS unsigned gu32;
#define RLX_AGENT __ATOMIC_RELAXED, __HIP_MEMORY_SCOPE_AGENT
#define LDS_WAIT() asm volatile("s_waitcnt lgkmcnt(0)" ::: "memory")
#define VM_WAIT() asm volatile("s_waitcnt vmcnt(0)" ::: "memory")
__device__ __forceinline__ unsigned f2bf(float f) { unsigned u = __builtin_bit_cast(unsigned, f); return (u + 0x7fffu + ((u >> 16) & 1u)) >> 16; }
__device__ __forceinline__ unsigned pk2(float lo, float hi) { return f2bf(lo) | (f2bf(hi) << 16); }
__device__ __forceinline__ float bflo(unsigned w) { return __builtin_bit_cast(float, w << 16); }
__device__ __forceinline__ float bfhi(unsigned w) { return __builtin_bit_cast(float, w & 0xffff0000u); }
__device__ __forceinline__ float wave_sum(float v) {
#pragma unroll
    for (int o = 1; o < 64; o <<= 1) v += __shfl_xor(v, o);
    return v;
}
#define XB_TMO      128
#define XB_XCNT(j)  (256  + 64 * (j))
#define XB_XSUB(j)  (1280 + 64 * (j))
#define XB_XGEN(j)  (2304 + 64 * (j))
#define XB_TOP      3328
#define XB_TOPGEN   3392
#define XCD_BAR_WORDS 3456
#define XB_SPIN_CAP (1u << 18)

__device__ __forceinline__ unsigned xb_ld(unsigned* p)              { return __hip_atomic_load(p, __ATOMIC_RELAXED, __HIP_MEMORY_SCOPE_AGENT); }
__device__ __forceinline__ unsigned xb_add(unsigned* p, unsigned v) { return __hip_atomic_fetch_add(p, v, __ATOMIC_RELAXED, __HIP_MEMORY_SCOPE_AGENT); }
__device__ __forceinline__ unsigned xb_xcc_id() { return (unsigned)__builtin_amdgcn_s_getreg((3 << 11) | 20) & 0xFu; }
#define XB_SPIN(cond, bar) do { unsigned _sp = 0; while (cond) { __builtin_amdgcn_s_sleep(1); \
    if ((++_sp & 255u) == 0u) { if (xb_ld(&(bar)[XB_TMO])) break; if (_sp > XB_SPIN_CAP) { atomicAdd(&(bar)[XB_TMO], 1u); break; } } } } while (0)

struct XcdBarrier {
    unsigned* bar; unsigned x;
    volatile LAS unsigned* st;
};

__device__ __forceinline__ XcdBarrier xcd_barrier_post(unsigned* bar, volatile LAS unsigned* st) {
    XcdBarrier b; b.bar = bar; b.x = xb_xcc_id(); b.st = st;
    if (threadIdx.x == 0) (void)xb_add(&bar[XB_XCNT(b.x)], 1u);
    return b;
}
__device__ __forceinline__ void xcd_barrier_complete(unsigned* bar, unsigned x, unsigned& nloc, unsigned& nx) {
    const unsigned G = gridDim.x * gridDim.y * gridDim.z;
    unsigned sum, cnt, mine, sp = 0u;
    for (;;) {
        sum = 0u; cnt = 0u; mine = 0u;
#pragma unroll
        for (unsigned j = 0; j < 16; ++j) { const unsigned c = xb_ld(&bar[XB_XCNT(j)]); sum += c; cnt += (c > 0u) ? 1u : 0u; mine = (j == x) ? c : mine; }
        if (sum == G) break;
        __builtin_amdgcn_s_sleep(1);
        if ((++sp & 255u) == 0u) { if (xb_ld(&bar[XB_TMO])) break; if (sp > XB_SPIN_CAP) { atomicAdd(&bar[XB_TMO], 1u); break; } }
    }
    nloc = mine > 0u ? mine : 1u; nx = cnt > 0u ? cnt : 1u;
}

__device__ __forceinline__ void xcd_barrier(const XcdBarrier& b) {
    asm volatile("s_waitcnt vmcnt(0)" ::: "memory");
    __syncthreads();
    if (threadIdx.x < 64) {
        unsigned* bar = b.bar; const unsigned l = threadIdx.x;
        unsigned gen = 0u;
        if (l == 0u) {
            __builtin_amdgcn_s_waitcnt(0);
            unsigned nloc = b.st[0], nx = b.st[1];
            if (nloc == 0u) { xcd_barrier_complete(bar, b.x, nloc, nx); b.st[0] = nloc; b.st[1] = nx; }
            const unsigned old = xb_add(&bar[XB_XSUB(b.x)], 1u);
            gen = old / nloc;
            if (old + 1u == (gen + 1u) * nloc) {
                __builtin_amdgcn_fence(__ATOMIC_RELEASE, "agent");
                asm volatile("s_waitcnt vmcnt(0)" ::: "memory");
                __hip_atomic_store(&bar[XB_XGEN(b.x)], gen + 1u, __ATOMIC_RELAXED, __HIP_MEMORY_SCOPE_AGENT);
            }
        }
        gen = (unsigned)__builtin_amdgcn_readfirstlane((int)gen);
        const unsigned target = gen + 1u;
        const unsigned cntj = l < 16u ? xb_ld(&bar[XB_XCNT(l)]) : 0u;
        unsigned sp = 0u;
        for (;;) {
            const unsigned v = (l < 16u && cntj != 0u) ? xb_ld(&bar[XB_XGEN(l)]) : target;
            if (__builtin_amdgcn_ballot_w64((int)(v - target) >= 0) == ~0ull) break;
            __builtin_amdgcn_s_sleep(1);
            if ((++sp & 255u) == 0u) { if (__builtin_amdgcn_readfirstlane((int)xb_ld(&bar[XB_TMO]))) break; if (sp > XB_SPIN_CAP) { if (l == 0u) atomicAdd(&bar[XB_TMO], 1u); break; } }
        }
        __builtin_amdgcn_fence(__ATOMIC_ACQUIRE, "agent");
        asm volatile("s_waitcnt vmcnt(0)" ::: "memory");
    }
    __syncthreads();
}

__device__ __forceinline__ void p0_transpose_item(const float* W, int K, int N, bf16* WT, int row_off, const float* ksc, LAS float* scr, int item, int lane) {
    const int nblk = N / 32, kb = item / nblk, nb = item % nblk, k0 = 64 * kb, n0 = 32 * nb;
#pragma unroll 8
    for (int i = 0; i < 32; ++i) { const int kk = 2 * i + (lane >> 5); float v = W[(size_t)(k0 + kk) * N + n0 + (lane & 31)]; if (ksc) v *= ksc[k0 + kk]; scr[kk * 33 + (lane & 31)] = v; }
    LDS_WAIT(); asm volatile("" ::: "memory");
    const int c = lane & 7;
#pragma unroll
    for (int j = 0; j < 4; ++j) { const int n = (lane >> 3) + 8 * j; const LAS float* s = scr + (8 * c) * 33 + n;
        v4u o; o.x = pk2(s[0 * 33], s[1 * 33]); o.y = pk2(s[2 * 33], s[3 * 33]); o.z = pk2(s[4 * 33], s[5 * 33]); o.w = pk2(s[6 * 33], s[7 * 33]);
        *(GAS v4u*)(WT + (size_t)(row_off + n0 + n) * K + k0 + 8 * c) = o; }
    LDS_WAIT(); asm volatile("" ::: "memory");
}
template <int NR> __device__ __forceinline__ void rms_rows_to_bf16(const float* X, const float* g, bf16* O, int m0, int ms, int mend, int lane) {
    const GAS f32x4* gr = (const GAS f32x4*)g + lane;
    f32x4 v[NR][4];
#pragma unroll
    for (int r = 0; r < NR; ++r) { const int m = (m0 + r * ms < mend) ? m0 + r * ms : mend - 1; const GAS f32x4* xr = (const GAS f32x4*)(X + (size_t)m * DM) + lane;
#pragma unroll
        for (int j = 0; j < 4; ++j) v[r][j] = xr[64 * j]; }
    f32x4 gv[4];
#pragma unroll
    for (int j = 0; j < 4; ++j) gv[j] = gr[64 * j];
#pragma unroll
    for (int r = 0; r < NR; ++r) { float s = 0.f;
#pragma unroll
        for (int j = 0; j < 4; ++j) s += (v[r][j].x * v[r][j].x + v[r][j].y * v[r][j].y) + (v[r][j].z * v[r][j].z + v[r][j].w * v[r][j].w);
        const float rr = 1.f / sqrtf(wave_sum(s) * (1.f / 1024.f) + RMS_EPS);
        if (m0 + r * ms < mend) { GAS unsigned long long* o8 = (GAS unsigned long long*)(O + (size_t)(m0 + r * ms) * DM) + lane;
#pragma unroll
            for (int j = 0; j < 4; ++j) o8[64 * j] = (unsigned long long)pk2(v[r][j].x * rr * gv[j].x, v[r][j].y * rr * gv[j].y) | ((unsigned long long)pk2(v[r][j].z * rr * gv[j].z, v[r][j].w * rr * gv[j].w) << 32); } }
}
template <int NR> __device__ __forceinline__ void rms_rows_to_i8(const float* X, const float* g, unsigned char* O, float* SA, int m0, int ms, int mend, int lane) {
    const GAS f32x4* gr = (const GAS f32x4*)g + lane;
    f32x4 v[NR][4];
#pragma unroll
    for (int r = 0; r < NR; ++r) { const int m = (m0 + r * ms < mend) ? m0 + r * ms : mend - 1; const GAS f32x4* xr = (const GAS f32x4*)(X + (size_t)m * DM) + lane;
#pragma unroll
        for (int j = 0; j < 4; ++j) v[r][j] = xr[64 * j]; }
    f32x4 gv[4];
#pragma unroll
    for (int j = 0; j < 4; ++j) gv[j] = gr[64 * j];
#pragma unroll
    for (int r = 0; r < NR; ++r) { float s = 0.f;
#pragma unroll
        for (int j = 0; j < 4; ++j) s += (v[r][j].x * v[r][j].x + v[r][j].y * v[r][j].y) + (v[r][j].z * v[r][j].z + v[r][j].w * v[r][j].w);
        const float rr = 1.f / sqrtf(wave_sum(s) * (1.f / 1024.f) + RMS_EPS);
        float am = 0.f;
#pragma unroll
        for (int j = 0; j < 4; ++j) { v[r][j] = v[r][j] * rr * gv[j]; am = fmaxf(am, fmaxf(fmaxf(fabsf(v[r][j].x), fabsf(v[r][j].y)), fmaxf(fabsf(v[r][j].z), fabsf(v[r][j].w)))); }
#pragma unroll
        for (int o = 1; o < 64; o <<= 1) am = fmaxf(am, __shfl_xor(am, o));
        const float sa = am > 0.f ? am * (1.f / 127.f) : 1.f, is = 1.f / sa;
        if (m0 + r * ms < mend) { GAS unsigned* o4 = (GAS unsigned*)(O + (size_t)(m0 + r * ms) * DM) + lane;
#pragma unroll
            for (int j = 0; j < 4; ++j) { const int a = (int)rintf(v[r][j].x * is), b = (int)rintf(v[r][j].y * is), c = (int)rintf(v[r][j].z * is), d = (int)rintf(v[r][j].w * is);
                o4[64 * j] = (unsigned)(a & 0xff) | ((unsigned)(b & 0xff) << 8) | ((unsigned)(c & 0xff) << 16) | ((unsigned)(d & 0xff) << 24); }
            if (lane == 0) SA[m0 + r * ms] = sa; } }
}
__device__ __forceinline__ void p0_quant_cols_wg(const float* W, int N, unsigned char* WT8, float* SB, LAS unsigned char* lds, int nb, int wave, int lane) {
    LAS float* scr = (LAS float*)(lds + RING_OFF + wave * 16384);
    LAS float* red = (LAS float*)(lds + RING_OFF + 8448);
    const int n0 = 32 * nb, kr = lane >> 3, nq = lane & 7;
    f32x4 v[16];
#pragma unroll
    for (int i = 0; i < 16; ++i) v[i] = *(const GAS f32x4*)(W + (size_t)(128 * wave + 8 * i + kr) * N + n0 + 4 * nq);
    f32x4 am = {0.f, 0.f, 0.f, 0.f};
#pragma unroll
    for (int i = 0; i < 16; ++i)
#pragma unroll
        for (int e = 0; e < 4; ++e) am[e] = fmaxf(am[e], fabsf(v[i][e]));
#pragma unroll
    for (int o = 8; o < 64; o <<= 1)
#pragma unroll
        for (int e = 0; e < 4; ++e) am[e] = fmaxf(am[e], __shfl_xor(am[e], o));
    if (lane < 8) *(LAS f32x4*)(red + wave * 32 + 4 * nq) = am;
    __syncthreads();
    f32x4 cm = *(const LAS f32x4*)(red + 4 * nq);
#pragma unroll
    for (int w = 1; w < 8; ++w) { const f32x4 o = *(const LAS f32x4*)(red + w * 32 + 4 * nq);
#pragma unroll
        for (int e = 0; e < 4; ++e) cm[e] = fmaxf(cm[e], o[e]); }
    f32x4 inv, sb;
#pragma unroll
    for (int e = 0; e < 4; ++e) { inv[e] = cm[e] > 0.f ? 127.f / cm[e] : 0.f; sb[e] = cm[e] > 0.f ? cm[e] * (1.f / 127.f) : 1.f; }
    if (wave == 0 && lane < 8) *(GAS f32x4*)(SB + n0 + 4 * nq) = sb;
#pragma unroll
    for (int half = 0; half < 2; ++half) {
#pragma unroll
        for (int i = 0; i < 8; ++i) { const int kk = 8 * i + kr;
#pragma unroll
            for (int e = 0; e < 4; ++e) scr[kk * 33 + 4 * nq + e] = v[8 * half + i][e] * inv[e]; }
        LDS_WAIT(); asm volatile("" ::: "memory");
        const int c = lane & 7;
#pragma unroll
        for (int j = 0; j < 4; ++j) { const int n = (lane >> 3) + 8 * j; const LAS float* s = scr + (8 * c) * 33 + n;
            unsigned q[8];
#pragma unroll
            for (int e = 0; e < 8; ++e) q[e] = (unsigned)((int)rintf(s[e * 33]) & 0xff);
            v2u o; o.x = q[0] | (q[1] << 8) | (q[2] << 16) | (q[3] << 24); o.y = q[4] | (q[5] << 8) | (q[6] << 16) | (q[7] << 24);
            *(GAS v2u*)(WT8 + (size_t)(n0 + n) * DM + 128 * wave + 64 * half + 8 * c) = o; }
        LDS_WAIT(); asm volatile("" ::: "memory");
    }
    __syncthreads();
}
__device__ __forceinline__ void cvt_row_to_bf16(const float* xrow, bf16* orow, int lane) {
    const GAS f32x4* xr = (const GAS f32x4*)xrow + lane; GAS unsigned long long* o8 = (GAS unsigned long long*)orow + lane;
    f32x4 v[4];
#pragma unroll
    for (int j = 0; j < 4; ++j) v[j] = xr[64 * j];
#pragma unroll
    for (int j = 0; j < 4; ++j) o8[64 * j] = (unsigned long long)pk2(v[j].x, v[j].y) | ((unsigned long long)pk2(v[j].z, v[j].w) << 32);
}
__device__ __forceinline__ int rel_bucket_dev(int d) {
    if (d < 16) return d;
    int b = 16;
    b += (d >= 21); b += (d >= 27); b += (d >= 35); b += (d >= 46); b += (d >= 59); b += (d >= 77); b += (d >= 99); b += (d >= 128);
    b += (d >= 166); b += (d >= 216); b += (d >= 280); b += (d >= 363); b += (d >= 470); b += (d >= 609); b += (d >= 790);
    return b;
}
struct P0Args { const float *x, *mem, *g_mix, *w_in, *rel_bias, *g_mem, *w_mem_kv, *w_br_attn, *w_br_conv, *w_br_x, *w_out, *g_ffn, *w_query, *sub_keys;
                bf16 *WinT, *WkvT, *WbrT, *WoutT, *WqT, *SK, *HN, *MEMN; float* TAB; float *SA, *SB; };
__device__ __forceinline__ void p0_transposes(const P0Args& a, LAS unsigned char* lds, int part, int gw, int NGW, int wave, int lane) {
    LAS float* scr = (LAS float*)(lds + RING_OFF + wave * 16384);
    constexpr int I_IN = (DM / 64) * (PW / 32), I_KV = (DM / 64) * (1024 / 32), I_BR = (512 / 64) * (1024 / 32), I_OUT = (DM / 64) * (1024 / 32), I_Q = (DM / 64) * (2048 / 32);
    if (part == 0) {
        for (int nb = gw / NWAVES; nb < PW / 32; nb += NGW / NWAVES) p0_quant_cols_wg(a.w_in, PW, (unsigned char*)a.WinT, a.SB, lds, nb, wave, lane);
        for (int it = gw; it < I_KV; it += NGW) p0_transpose_item(a.w_mem_kv, DM, 1024, a.WkvT, 0, nullptr, scr, it, lane);
    } else {
        for (int it = gw; it < 3 * I_BR + I_OUT + I_Q; it += NGW) {
            int r = it;
            if (r < I_BR) { p0_transpose_item(a.w_br_attn, 512, 1024, a.WbrT, 0, nullptr, scr, r, lane); continue; } r -= I_BR;
            if (r < I_BR) { p0_transpose_item(a.w_br_conv, 512, 1024, a.WbrT, 1024, nullptr, scr, r, lane); continue; } r -= I_BR;
            if (r < I_BR) { p0_transpose_item(a.w_br_x, 512, 1024, a.WbrT, 2048, nullptr, scr, r, lane); continue; } r -= I_BR;
            if (r < I_OUT) { p0_transpose_item(a.w_out, DM, 1024, a.WoutT, 0, nullptr, scr, r, lane); continue; } r -= I_OUT;
            p0_transpose_item(a.w_query, DM, 2048, a.WqT, 0, a.g_ffn, scr, r, lane);
        }
    }
}
__device__ __forceinline__ void p0_prologue(const P0Args& a, LAS unsigned char* lds, bool late_part1, int gw, int NGW, int wave, int lane) {
    p0_transposes(a, lds, 0, gw, NGW, wave, lane);
    if (!late_part1) p0_transposes(a, lds, 1, gw, NGW, wave, lane);
    for (int m = gw; m < T; m += 4 * NGW) rms_rows_to_i8<4>(a.x, a.g_mix, (unsigned char*)a.HN, a.SA, m, NGW, T, lane);
    for (int m = gw; m < NBATCH * MEMLEN; m += NGW) rms_rows_to_bf16<1>(a.mem, a.g_mem, a.MEMN, m, NGW, NBATCH * MEMLEN, lane);
    for (int m = gw; m < 256; m += NGW) cvt_row_to_bf16(a.sub_keys + (size_t)m * 1024, a.SK + (size_t)m * 1024, lane);
    for (int m = gw; m < 256; m += NGW) {
        const int idx = m * 64 + lane, h = idx >> 11, d = idx & 2047;
        a.TAB[idx] = a.rel_bias[rel_bucket_dev(d) * 8 + h] * LOG2E;
    }
}

template <int DH> __device__ __forceinline__ void fix_item(bf16* buf, size_t pitch, int row0, int col0, const float* gain, float gscale, float* kmean, LAS float* red, int wave, int lane) {
    constexpr int LPR = DH / 8, RPI = 64 / LPR, NIT = 32 / RPI;
    const int sub = lane / LPR, ch = lane % LPR;
    float g[8], cs[8];
#pragma unroll
    for (int j = 0; j < 8; ++j) { g[j] = gain[ch * 8 + j] * gscale; cs[j] = 0.f; }
    v4u w[NIT];
#pragma unroll
    for (int it = 0; it < NIT; ++it) w[it] = *(const GAS v4u*)(buf + (size_t)(row0 + wave * 32 + it * RPI + sub) * pitch + col0 + ch * 8);
#pragma unroll
    for (int it = 0; it < NIT; ++it) {
        float x[8] = {bflo(w[it].x), bfhi(w[it].x), bflo(w[it].y), bfhi(w[it].y), bflo(w[it].z), bfhi(w[it].z), bflo(w[it].w), bfhi(w[it].w)};
        float ss = 0.f;
#pragma unroll
        for (int j = 0; j < 8; ++j) ss += x[j] * x[j];
#pragma unroll
        for (int o = 1; o < LPR; o <<= 1) ss += __shfl_xor(ss, o);
        const float r = 1.f / sqrtf(ss * (1.f / DH) + RMS_EPS);
#pragma unroll
        for (int j = 0; j < 8; ++j) { x[j] = x[j] * r * g[j]; cs[j] += x[j]; }
        v4u o; o.x = pk2(x[0], x[1]); o.y = pk2(x[2], x[3]); o.z = pk2(x[4], x[5]); o.w = pk2(x[6], x[7]);
        *(GAS v4u*)(buf + (size_t)(row0 + wave * 32 + it * RPI + sub) * pitch + col0 + ch * 8) = o;
    }
    if (kmean) {
#pragma unroll
        for (int j = 0; j < 8; ++j) {
#pragma unroll
            for (int o = LPR; o < 64; o <<= 1) cs[j] += __shfl_xor(cs[j], o);
        }
        if (sub == 0) {
#pragma unroll
            for (int j = 0; j < 8; ++j) red[wave * DH + ch * 8 + j] = cs[j];
        }
        asm volatile("s_waitcnt lgkmcnt(0)\n\ts_barrier" ::: "memory");
        if (wave == 0 && lane < DH) { float s = 0.f;
#pragma unroll
            for (int w8 = 0; w8 < 8; ++w8) s += red[w8 * DH + lane];
            kmean[lane] = s * (1.f / 256.f); }
        asm volatile("s_waitcnt lgkmcnt(0)\n\ts_barrier" ::: "memory");
    }
}
__device__ __forceinline__ void p2_fixup(bf16* PA, bf16* KVM, float* KMEAN, const float* q_gain_a, const float* k_gain_a, const float* q_gain_x, const float* k_gain_x, LAS unsigned char* lds, int vcu, int G, int wave, int lane) {
    constexpr int N_A = 512, N_X = 256, N_KX = 32, NIT = 2 * N_A + N_X + N_KX;
    LAS float* red = (LAS float*)lds;
    for (int it = vcu; it < NIT; it += G) {
        int r = it;
        if (r < N_A) { const int b = r >> 6, h = (r >> 3) & 7, n = r & 7;
            fix_item<64>(PA, PAW, b * SEQ + n * 256, COL_KA + h * 64, k_gain_a, 1.0f, KMEAN + (size_t)((b * 8 + h) * 8 + n) * 64, red, wave, lane); continue; } r -= N_A;
        if (r < N_A) { const int b = r >> 6, h = (r >> 3) & 7, n = r & 7;
            fix_item<64>(PA, PAW, b * SEQ + n * 256, COL_QA + h * 64, q_gain_a, C2A, nullptr, red, wave, lane); continue; } r -= N_A;
        if (r < N_X) { const int b = r >> 5, h = (r >> 3) & 3, n = r & 7;
            fix_item<128>(PA, PAW, b * SEQ + n * 256, COL_QX + h * 128, q_gain_x, C2X, nullptr, red, wave, lane); continue; } r -= N_X;
        { const int b = r >> 2, h = r & 3;
            fix_item<128>(KVM, 1024, b * MEMLEN, h * 128, k_gain_x, 1.0f, nullptr, red, wave, lane); }
    }
}

namespace att {
constexpr int L_K = 0, L_V = 16384, L_BUF = 32768  , L_OST = 0  ,
              L_TAB = 65536, TAB_PAD = 256, L_KM = L_TAB + (TAB_PAD + 2048) * 4, L_SEL = L_KM + 2048, L_WSF = L_SEL + 1024, L_END = L_WSF + NWAVES * 256;
static_assert(L_END <= RING_BYTES, "attention LDS map");
__device__ __forceinline__ int crow(int r, int hi) { return (r & 3) + 8 * (r >> 2) + 4 * hi; }
__device__ __forceinline__ void glds16(const void* gsrc, unsigned lds_dst) { unsigned keep;
    asm volatile("s_mov_b32 %0, m0\n\ts_mov_b32 m0, %2\n\ts_nop 0\n\tglobal_load_lds_dwordx4 %1, off\n\ts_mov_b32 m0, %0" : "=&s"(keep) : "v"(gsrc), "s"(lds_dst) : "memory"); }
__device__ __forceinline__ unsigned cvtpk(float lo, float hi) { typedef float f2 __attribute__((ext_vector_type(2))); typedef __bf16 b2 __attribute__((ext_vector_type(2))); f2 v = {lo, hi}; b2 b = __builtin_convertvector(v, b2); return __builtin_bit_cast(unsigned, b); }
__device__ __forceinline__ float rowmax(const f32x16& p0, const f32x16& p1) {
    float a = fmaxf(p0[0], p1[0]);
#pragma unroll
    for (int r = 1; r < 16; ++r) a = fmaxf(a, fmaxf(p0[r], p1[r]));
    auto rr = __builtin_amdgcn_permlane32_swap(__float_as_uint(a), __float_as_uint(a), false, false);
    return fmaxf(__uint_as_float(rr[0]), __uint_as_float(rr[1]));
}
template <int ND0> __device__ __forceinline__ void qkt(f32x16& p0, f32x16& p1, const LAS unsigned char* Kslot, const bf16x8* qr, int r32, int hi) {
    const LAS unsigned char* kb = Kslot + hi * 1024 + r32 * 16;
#pragma unroll
    for (int d0 = 0; d0 < ND0; ++d0) {
        const bf16x8 b0 = *(const LAS bf16x8*)(kb + d0 * 2048);
        const bf16x8 b1 = *(const LAS bf16x8*)(kb + d0 * 2048 + 512);
        p0 = __builtin_amdgcn_mfma_f32_32x32x16_bf16(b0, qr[d0], p0, 0, 0, 0);
        p1 = __builtin_amdgcn_mfma_f32_32x32x16_bf16(b1, qr[d0], p1, 0, 0, 0);
    }
}
template <int NDB> __device__ __forceinline__ void pv(f32x16* o, int vb, bf16x8 pa0, bf16x8 pa1, bf16x8 pa2, bf16x8 pa3) {
#pragma unroll
    for (int d0 = 0; d0 < NDB; ++d0) { s16x4 lo[4], hi[4];
#pragma unroll
        for (int ks = 0; ks < 4; ++ks) {
            asm volatile("ds_read_b64_tr_b16 %0,%1 offset:%c2" : "=&v"(lo[ks]) : "v"(vb), "i"(d0 * 4096 + ks * 1024) : "memory");
            asm volatile("ds_read_b64_tr_b16 %0,%1 offset:%c2" : "=&v"(hi[ks]) : "v"(vb), "i"(d0 * 4096 + ks * 1024 + 512) : "memory"); }
        asm volatile("s_waitcnt lgkmcnt(0)" ::: "memory"); __builtin_amdgcn_sched_barrier(0);
#define ATT_PK(k) (bf16x8){lo[k][0], lo[k][1], lo[k][2], lo[k][3], hi[k][0], hi[k][1], hi[k][2], hi[k][3]}
        o[d0] = __builtin_amdgcn_mfma_f32_32x32x16_bf16(pa0, ATT_PK(0), o[d0], 0, 0, 0);
        o[d0] = __builtin_amdgcn_mfma_f32_32x32x16_bf16(pa1, ATT_PK(1), o[d0], 0, 0, 0);
        o[d0] = __builtin_amdgcn_mfma_f32_32x32x16_bf16(pa2, ATT_PK(2), o[d0], 0, 0, 0);
        o[d0] = __builtin_amdgcn_mfma_f32_32x32x16_bf16(pa3, ATT_PK(3), o[d0], 0, 0, 0);
#undef ATT_PK
    }
}
#define ATT_BAR() asm volatile("s_waitcnt lgkmcnt(0)\n\ts_barrier" ::: "memory")
#define ATT_WAIT_BAR() asm volatile("s_waitcnt vmcnt(0) lgkmcnt(0)\n\ts_barrier" ::: "memory")

template <int DH, bool MOBA> __device__ __forceinline__ void attn_unit(const bf16* Qp, size_t qpitch, const bf16* Kp, const bf16* Vp, size_t kpitch, bf16* Op, int qb, const float* kmean_bh, const float* tab_h, const float* gq, const float* gk,
                                                                   LAS unsigned char* lds, int tid, int wid, int lane) {
    constexpr int ND0 = DH / 16, NDB = DH / 32, NPIECE = DH / 64;
    asm volatile("" : "+v"(tid), "+v"(lane));
    const int r32 = lane & 31, hi = lane >> 5;
    const unsigned lds0 = (unsigned)(uintptr_t)lds;
    LAS float* wsf = (LAS float*)(lds + L_WSF) + wid * 64;
    ATT_BAR();
    int my_sel = 0;
    if (MOBA) {
        LAS float* tl = (LAS float*)(lds + L_TAB);
        for (int i = tid; i < TAB_PAD + 2048; i += NWAVES * 64) tl[i] = (i < TAB_PAD) ? -INFINITY : tab_h[i - TAB_PAD];
        LAS float* km = (LAS float*)(lds + L_KM);
        for (int i = tid; i < 512; i += NWAVES * 64) km[i] = kmean_bh[i];
        ATT_BAR();
        if (tid < 256) {
            int sel = 0;
            if (qb <= 3) sel = (1 << qb) - 1;
            else {
                const GAS v4u* qrow = (const GAS v4u*)(Qp + (size_t)tid * qpitch);
                v4u qw[8];
#pragma unroll
                for (int c = 0; c < 8; ++c) qw[c] = qrow[c];
                float b1 = -INFINITY, b2 = -INFINITY, b3 = -INFINITY; int i1 = 0, i2 = 0, i3 = 0;
#pragma unroll 1
                for (int n = 0; n < qb; ++n) { float s = 0.f; const LAS f32x4* kr = (const LAS f32x4*)(km + n * 64);
#pragma unroll
                    for (int c = 0; c < 8; ++c) { const f32x4 ka = kr[2 * c], kb2 = kr[2 * c + 1]; const v4u w = qw[c];
                        s += bflo(w.x) * ka.x; s += bfhi(w.x) * ka.y; s += bflo(w.y) * ka.z; s += bfhi(w.y) * ka.w;
                        s += bflo(w.z) * kb2.x; s += bfhi(w.z) * kb2.y; s += bflo(w.w) * kb2.z; s += bfhi(w.w) * kb2.w; }
                    if (s > b1) { b3 = b2; i3 = i2; b2 = b1; i2 = i1; b1 = s; i1 = n; }
                    else if (s > b2) { b3 = b2; i3 = i2; b2 = s; i2 = n; }
                    else if (s > b3) { b3 = s; i3 = n; } }
                sel = (1 << i1) | (1 << i2) | (1 << i3);
            }
            ((LAS int*)(lds + L_SEL))[tid] = sel;
        }
        ATT_BAR();
        my_sel = ((LAS int*)(lds + L_SEL))[wid * 32 + r32];
    }
    bf16x8 qr[ND0];
    { const bf16* Qw = Qp + (size_t)(wid * 32 + r32) * qpitch + hi * 8;
#pragma unroll
      for (int d0 = 0; d0 < ND0; ++d0) qr[d0] = *(const GAS bf16x8*)(Qw + d0 * 16); }
    if (!MOBA) {
        LAS float* rk = (LAS float*)(lds + L_KM);
        { const int key = tid >> 1, half = tid & 1; const GAS v4u* kr = (const GAS v4u*)(Kp + (size_t)key * kpitch + half * 64); float ss = 0.f;
#pragma unroll
          for (int c = 0; c < 8; ++c) { const v4u w = kr[c]; const float a0 = bflo(w.x), a1 = bfhi(w.x), a2 = bflo(w.y), a3 = bfhi(w.y), a4 = bflo(w.z), a5 = bfhi(w.z), a6 = bflo(w.w), a7 = bfhi(w.w);
              ss += (a0 * a0 + a1 * a1) + (a2 * a2 + a3 * a3) + (a4 * a4 + a5 * a5) + (a6 * a6 + a7 * a7); }
          ss += __shfl_xor(ss, 1);
          if (half == 0) rk[key] = 1.0f / sqrtf(ss * (1.f / 128.f) + RMS_EPS); }
        float qs = 0.f;
#pragma unroll
        for (int d0 = 0; d0 < ND0; ++d0) { const v4u w = __builtin_bit_cast(v4u, qr[d0]); const float a0 = bflo(w.x), a1 = bfhi(w.x), a2 = bflo(w.y), a3 = bfhi(w.y), a4 = bflo(w.z), a5 = bfhi(w.z), a6 = bflo(w.w), a7 = bfhi(w.w);
            qs += (a0 * a0 + a1 * a1) + (a2 * a2 + a3 * a3) + (a4 * a4 + a5 * a5) + (a6 * a6 + a7 * a7); }
        { auto rr = __builtin_amdgcn_permlane32_swap(__float_as_uint(qs), __float_as_uint(qs), false, false); qs = __uint_as_float(rr[0]) + __uint_as_float(rr[1]); }
        const float rq = C2X / sqrtf(qs * (1.f / 128.f) + RMS_EPS);
        int hi8 = hi * 8; asm volatile("" : "+v"(hi8));
#pragma unroll
        for (int d0 = 0; d0 < ND0; ++d0) { const v4u w = __builtin_bit_cast(v4u, qr[d0]);
            const f32x4 ga = *(const GAS f32x4*)(gq + d0 * 16 + hi8), gb = *(const GAS f32x4*)(gq + d0 * 16 + hi8 + 4), ka = *(const GAS f32x4*)(gk + d0 * 16 + hi8), kb2 = *(const GAS f32x4*)(gk + d0 * 16 + hi8 + 4);
            v4u o; o.x = cvtpk(bflo(w.x) * rq * ga.x * ka.x, bfhi(w.x) * rq * ga.y * ka.y); o.y = cvtpk(bflo(w.y) * rq * ga.z * ka.z, bfhi(w.y) * rq * ga.w * ka.w);
            o.z = cvtpk(bflo(w.z) * rq * gb.x * kb2.x, bfhi(w.z) * rq * gb.y * kb2.y); o.w = cvtpk(bflo(w.w) * rq * gb.z * kb2.z, bfhi(w.w) * rq * gb.w * kb2.w);
            qr[d0] = __builtin_bit_cast(bf16x8, o); }
    }
    float m_ref = 0.f, l_run = 0.f;
    constexpr float THR = 8.0f;
    float bfar = 0.f; if (MOBA) bfar = ((const LAS float*)(lds + L_TAB))[TAB_PAD + 2047];
    f32x16 o[NDB];
#pragma unroll
    for (int d = 0; d < NDB; ++d) o[d] = f32x16{};
    const int vb0 = (int)(lds0 + L_V) + ((lane >> 4) & 1) * 32 + (lane & 3) * 8 + (4 * hi + ((lane & 15) >> 2)) * 64;
    const int qrel = wid * 32 + r32;
    const int ntiles = MOBA ? 4 + 4 * qb : 4;
    constexpr int SUB = (DH == 64) ? 2 : 1;
    const int nsteps = ntiles / SUB;
    auto issue_step = [&](int st) {
#pragma unroll
        for (int sub = 0; sub < SUB; ++sub) { const int tt = st * SUB + sub;
            int kb_, j_; if (MOBA) { if (tt < 4) { kb_ = qb; j_ = tt; } else { kb_ = (tt - 4) >> 2; j_ = (tt - 4) & 3; } } else { kb_ = 0; j_ = tt; }
            const int key0_ = kb_ * 256 + j_ * 64; const unsigned bo_ = (unsigned)(st & 1) * L_BUF + (unsigned)sub * 8192u;
#pragma unroll
            for (int pc = 0; pc < NPIECE; ++pc) { const int p = wid + 8 * pc;
                glds16(Kp + (size_t)(key0_ + lane) * kpitch + p * 8, (unsigned)__builtin_amdgcn_readfirstlane(lds0 + bo_ + L_K + p * 1024));
                glds16(Vp + (size_t)(key0_ + 16 * (p & 3) + (lane >> 2)) * kpitch + (p >> 2) * 32 + (lane & 3) * 8, (unsigned)__builtin_amdgcn_readfirstlane(lds0 + bo_ + L_V + p * 1024)); } }
    };
    issue_step(0);
    for (int st = 0; st < nsteps; ++st) {
        ATT_WAIT_BAR();
        if (st + 1 < nsteps) issue_step(st + 1);
#pragma unroll 1
      for (int sub = 0; sub < SUB; ++sub) { const int tt = st * SUB + sub;
        int kb, j; bool own;
        if (MOBA) { if (tt < 4) { kb = qb; j = tt; own = true; } else { kb = (tt - 4) >> 2; j = (tt - 4) & 3; own = false; } }
        else { kb = 0; j = tt; own = false; }
        if (MOBA && own && 64 * j > wid * 32 + 31) continue;
        const unsigned bo = (unsigned)(st & 1) * L_BUF + (unsigned)sub * 8192u;
        f32x16 p0, p1;
        if (MOBA) {
            const float base = ((own || (((my_sel >> kb) & 1) != 0)) ? 0.f : -INFINITY) - m_ref;
            if (!own && qb - kb >= 5) {
                const float cb = base + bfar;
#pragma unroll
                for (int r = 0; r < 16; ++r) { p0[r] = cb; p1[r] = cb; }
            } else {
                const int dbase = (qb - kb) * 256 + qrel - 64 * j - 4 * hi;
                const LAS float* tp = (const LAS float*)(lds + L_TAB) + TAB_PAD + dbase - 63;
#pragma unroll
                for (int r = 0; r < 16; ++r) { const int c = (r & 3) + 8 * (r >> 2); p0[r] = tp[63 - c] + base; p1[r] = tp[31 - c] + base; }
            }
            qkt<ND0>(p0, p1, lds + bo + L_K, qr, r32, hi);
        } else {
            p0 = f32x16{}; p1 = f32x16{};
            qkt<ND0>(p0, p1, lds + bo + L_K, qr, r32, hi);
            const LAS float* rkp = (const LAS float*)(lds + L_KM) + j * 64 + 4 * hi;
#pragma unroll
            for (int r = 0; r < 16; ++r) { const int c = (r & 3) + 8 * (r >> 2); p0[r] = p0[r] * rkp[c] - m_ref; p1[r] = p1[r] * rkp[c + 32] - m_ref; }
        }
        const float rm = rowmax(p0, p1);
        if (__any(rm > THR)) {
            const float dl = fmaxf(rm, 0.f); m_ref += dl;
#pragma unroll
            for (int r = 0; r < 16; ++r) { p0[r] -= dl; p1[r] -= dl; }
            const float f = __builtin_amdgcn_exp2f(-dl); l_run *= f;
            if (hi == 0) wsf[r32] = f;
            LDS_WAIT();
#pragma unroll
            for (int r = 0; r < 16; ++r) { const float ff = wsf[crow(r, hi)];
#pragma unroll
                for (int d = 0; d < NDB; ++d) o[d][r] *= ff; }
        }
        float ps = 0.f;
#pragma unroll
        for (int r = 0; r < 16; ++r) { p0[r] = __builtin_amdgcn_exp2f(p0[r]); p1[r] = __builtin_amdgcn_exp2f(p1[r]); ps += p0[r] + p1[r]; }
        l_run += ps;
        v4u pw0, pw1, pw2, pw3;
        pw0 = (v4u){cvtpk(p0[0], p0[1]), cvtpk(p0[2], p0[3]), cvtpk(p0[4], p0[5]), cvtpk(p0[6], p0[7])};
        pw1 = (v4u){cvtpk(p0[8], p0[9]), cvtpk(p0[10], p0[11]), cvtpk(p0[12], p0[13]), cvtpk(p0[14], p0[15])};
        pw2 = (v4u){cvtpk(p1[0], p1[1]), cvtpk(p1[2], p1[3]), cvtpk(p1[4], p1[5]), cvtpk(p1[6], p1[7])};
        pw3 = (v4u){cvtpk(p1[8], p1[9]), cvtpk(p1[10], p1[11]), cvtpk(p1[12], p1[13]), cvtpk(p1[14], p1[15])};
        pv<NDB>(o, vb0 + (int)bo, __builtin_bit_cast(bf16x8, pw0), __builtin_bit_cast(bf16x8, pw1), __builtin_bit_cast(bf16x8, pw2), __builtin_bit_cast(bf16x8, pw3));
      }
    }
    { auto rr = __builtin_amdgcn_permlane32_swap(__float_as_uint(l_run), __float_as_uint(l_run), false, false); l_run = __uint_as_float(rr[0]) + __uint_as_float(rr[1]); }
    if (hi == 0) wsf[32 + r32] = l_run;
    ATT_BAR();
    LAS bf16* stg = (LAS bf16*)(lds + L_OST + wid * 8192);
#pragma unroll
    for (int r = 0; r < 16; ++r) { const int orow = crow(r, hi); const float rl = __builtin_amdgcn_rcpf(wsf[32 + orow]);
#pragma unroll
        for (int d = 0; d < NDB; ++d) stg[orow * DH + d * 32 + r32] = (bf16)f2bf(o[d][r] * rl); }
    LDS_WAIT();
    constexpr int CPR = DH / 8;
    int lane2 = lane; asm volatile("" : "+v"(lane2));
#pragma unroll
    for (int i = 0; i < (32 * CPR) / 64; ++i) { const int idx = i * 64 + lane2, row = idx / CPR, ch = idx % CPR;
        const v4u v = *(const LAS v4u*)(stg + row * DH + ch * 8);
        *(GAS v4u*)(Op + (size_t)(wid * 32 + row) * 512 + ch * 8) = v; }
}
#undef ATT_BAR
#undef ATT_WAIT_BAR
}

__device__ __forceinline__ void conv_item(const bf16* PA, const float* conv_w, bf16* CO, int item, int tid) {
    asm volatile("" : "+v"(tid));
    const int ch = (tid & 63) * 8, r0 = item * 64 + (tid >> 6) * 8;
    float w0[8], w1[8], w2[8];
#pragma unroll
    for (int j = 0; j < 8; ++j) { w0[j] = conv_w[ch + j]; w1[j] = conv_w[512 + ch + j]; w2[j] = conv_w[1024 + ch + j]; }
    float pm2[8], pm1[8];
#pragma unroll
    for (int j = 0; j < 8; ++j) { pm2[j] = 0.f; pm1[j] = 0.f; }
    auto load8 = [&](int row, int col, float* o) { const v4u w = *(const GAS v4u*)(PA + (size_t)row * PAW + col + ch);
        o[0] = bflo(w.x); o[1] = bfhi(w.x); o[2] = bflo(w.y); o[3] = bfhi(w.y); o[4] = bflo(w.z); o[5] = bfhi(w.z); o[6] = bflo(w.w); o[7] = bfhi(w.w); };
    const int s0 = r0 & (SEQ - 1);
    if (s0 >= 2) { float a[8], b[8]; load8(r0 - 2, COL_CC, a); load8(r0 - 2, COL_UC, b);
#pragma unroll
        for (int j = 0; j < 8; ++j) pm2[j] = a[j] * b[j]; }
    if (s0 >= 1) { float a[8], b[8]; load8(r0 - 1, COL_CC, a); load8(r0 - 1, COL_UC, b);
#pragma unroll
        for (int j = 0; j < 8; ++j) pm1[j] = a[j] * b[j]; }
#pragma unroll
    for (int i = 0; i < 8; ++i) { const int row = r0 + i; float c[8], u[8], bb[8], y[8];
        load8(row, COL_CC, c); load8(row, COL_UC, u); load8(row, COL_BC, bb);
#pragma unroll
        for (int j = 0; j < 8; ++j) { const float cur = c[j] * u[j]; y[j] = bb[j] * (w0[j] * pm2[j] + w1[j] * pm1[j] + w2[j] * cur); pm2[j] = pm1[j]; pm1[j] = cur; }
        v4u o; o.x = pk2(y[0], y[1]); o.y = pk2(y[2], y[3]); o.z = pk2(y[4], y[5]); o.w = pk2(y[6], y[7]);
        *(GAS v4u*)(CO + (size_t)row * 512 + ch) = o; }
}

namespace pk {
template <int N> __device__ __forceinline__ void bsort_desc(unsigned (&a)[N]) {
#pragma unroll
    for (int k = 2; k <= N; k <<= 1) {
#pragma unroll
        for (int j = k >> 1; j > 0; j >>= 1) {
#pragma unroll
            for (int i = 0; i < N; ++i) { const int l = i ^ j;
                if (l > i) { const unsigned x = a[i], y = a[l]; const unsigned mx = x > y ? x : y, mn = x > y ? y : x;
                    if ((i & k) == 0) { a[i] = mx; a[l] = mn; } else { a[i] = mn; a[l] = mx; } } } } }
}
template <int N> __device__ __forceinline__ void bmerge_desc(unsigned (&a)[N]) {
#pragma unroll
    for (int j = N >> 1; j > 0; j >>= 1) {
#pragma unroll
        for (int i = 0; i < N; ++i) { const int l = i ^ j; if (l > i) { const unsigned x = a[i], y = a[l]; a[i] = x > y ? x : y; a[l] = x > y ? y : x; } } }
}
__device__ __forceinline__ void top16_merge(unsigned (&x)[16], const unsigned (&y)[16]) {
#pragma unroll
    for (int i = 0; i < 16; ++i) x[i] = x[i] > y[15 - i] ? x[i] : y[15 - i];
    bmerge_desc<16>(x);
}
__device__ __forceinline__ unsigned f2ord(float f) { const unsigned u = __float_as_uint(f); return u ^ ((unsigned)((int)u >> 31) | 0x80000000u); }
__device__ __forceinline__ float ord2f(unsigned o) { return __uint_as_float(o ^ ((o & 0x80000000u) ? 0x80000000u : 0xFFFFFFFFu)); }

constexpr int L_TBL = 0;
__device__ __forceinline__ void topk_fill(const bf16* SK, LAS unsigned char* lds, int hp, int tid) {
    for (int tb = 0; tb < 4; ++tb) { const bf16* src = SK + (size_t)(((2 * hp + (tb >> 1)) * 2 + (tb & 1)) * 128) * 128;
        for (int idx = tid; idx < 2048; idx += NWAVES * 64) { const int key = idx >> 4, c16 = idx & 15;
            const v4u w = *(const GAS v4u*)(src + key * 128 + c16 * 8);
            *(LAS v4u*)(lds + L_TBL + tb * 32768 + (c16 * 4 + (key >> 5)) * 512 + (key & 31) * 16) = w; } }
    asm volatile("s_waitcnt vmcnt(0) lgkmcnt(0)\n\ts_barrier" ::: "memory");
}
__device__ __forceinline__ void topk_task(const bf16* QRY, const float* SLOTS, unsigned* SEL, LAS unsigned char* lds, int hp, int t0, int lane) {
    asm volatile("" : "+v"(lane));
    const int r32 = lane & 31, hi = lane >> 5;
    const int tok = t0 + r32;
    float rn; { const GAS f32x4* sl = (const GAS f32x4*)(SLOTS + (size_t)tok * 16); const f32x4 a = sl[0], b = sl[1], c = sl[2], d = sl[3];
        const float ss = ((a.x + a.y) + (a.z + a.w)) + ((b.x + b.y) + (b.z + b.w)) + ((c.x + c.y) + (c.z + c.w)) + ((d.x + d.y) + (d.z + d.w));
        rn = 1.f / sqrtf(ss * (1.f / 1024.f) + RMS_EPS); }
    unsigned L[4][16];
    bf16x8 qf[8];
    { const bf16* qp = QRY + (size_t)tok * 2048 + ((2 * hp) * 2) * 128 + hi * 8;
#pragma unroll
      for (int kk = 0; kk < 8; ++kk) qf[kk] = *(const GAS bf16x8*)(qp + kk * 16); }
#pragma unroll
    for (int tb = 0; tb < 4; ++tb) {
        f32x16 acc[4];
#pragma unroll
        for (int blk = 0; blk < 4; ++blk) acc[blk] = f32x16{};
        const LAS unsigned char* tbase = lds + L_TBL + tb * 32768 + hi * 2048 + r32 * 16;
#pragma unroll
        for (int kk = 0; kk < 8; ++kk)
#pragma unroll
            for (int blk = 0; blk < 4; ++blk) { const bf16x8 af = *(const LAS bf16x8*)(tbase + kk * 4096 + blk * 512);
                acc[blk] = __builtin_amdgcn_mfma_f32_32x32x16_bf16(af, qf[kk], acc[blk], 0, 0, 0); }
        if (tb < 3) { const int tn = tb + 1; const bf16* qp = QRY + (size_t)tok * 2048 + ((2 * hp + (tn >> 1)) * 2 + (tn & 1)) * 128 + hi * 8;
#pragma unroll
            for (int kk = 0; kk < 8; ++kk) qf[kk] = *(const GAS bf16x8*)(qp + kk * 16);
            asm volatile("" ::: "memory"); }
        unsigned g[4][16];
#pragma unroll
        for (int blk = 0; blk < 4; ++blk)
#pragma unroll
            for (int r = 0; r < 16; ++r) g[blk][r] = (f2ord(acc[blk][r]) & ~127u) | (unsigned)(127 - (32 * blk + (r & 3) + 8 * (r >> 2)));
#pragma unroll
        for (int blk = 0; blk < 4; ++blk) bsort_desc<16>(g[blk]);
        top16_merge(g[0], g[1]); top16_merge(g[2], g[3]); top16_merge(g[0], g[2]);
#pragma unroll
        for (int i = 0; i < 16; ++i) L[tb][i] = g[0][i] ^ (unsigned)(4 * hi);
    }
    unsigned A[2][16];
#pragma unroll
    for (int p = 0; p < 2; ++p) {
        unsigned X[16], Y[16];
#pragma unroll
        for (int i = 0; i < 16; ++i) { auto rr = __builtin_amdgcn_permlane32_swap(L[p][i], L[2 + p][i], false, false); X[i] = rr[0]; Y[i] = rr[1]; }
        top16_merge(X, Y);
#pragma unroll
        for (int i = 0; i < 16; ++i) A[p][i] = X[i];
    }
    float f0[16], f1[16];
#pragma unroll
    for (int i = 0; i < 16; ++i) { f0[i] = ord2f(A[0][i] & ~127u); f1[i] = ord2f(A[1][i] & ~127u); }
    float sums[50]; unsigned keys[50];
    { int c = 0;
#pragma unroll
      for (int i = 0; i < 16; ++i)
#pragma unroll
          for (int j = 0; j < 16; ++j) if ((i + 1) * (j + 1) <= 16) { sums[c] = f0[i] + f1[j]; keys[c] = (f2ord(sums[c]) & ~63u) | (unsigned)(63 - c); ++c; } }
    unsigned G0[16], R[32];
#pragma unroll
    for (int i = 0; i < 16; ++i) G0[i] = keys[i];
#pragma unroll
    for (int i = 0; i < 32; ++i) R[i] = (i < 26) ? keys[24 + i] : 0u;
    bsort_desc<32>(R);
#pragma unroll
    for (int i = 0; i < 16; ++i) G0[i] = G0[i] > R[15 - i] ? G0[i] : R[15 - i];
    bmerge_desc<16>(G0);
#pragma unroll
    for (int i = 8; i < 16; ++i) G0[i] = G0[i] > keys[16 + 15 - i] ? G0[i] : keys[16 + 15 - i];
    unsigned thr = G0[0];
#pragma unroll
    for (int i = 1; i < 16; ++i) thr = thr < G0[i] ? thr : G0[i];
    const float s00 = sums[0], sc = rn * LOG2E;
    float w[50]; float den = 0.f;
#pragma unroll
    for (int c = 0; c < 50; ++c) { w[c] = (keys[c] >= thr) ? __builtin_amdgcn_exp2f((sums[c] - s00) * sc) : 0.f; den += w[c]; }
    const float inv = 1.f / den;
    unsigned i0[16], i1[16];
#pragma unroll
    for (int i = 0; i < 16; ++i) { i0[i] = 127u - (A[0][i] & 127u); i1[i] = 127u - (A[1][i] & 127u); }
    GAS unsigned* outp = (GAS unsigned*)(SEL + ((size_t)tok * 8 + 2 * hp + hi) * 16);
    int pos = 0;
    { int c = 0;
#pragma unroll
      for (int i = 0; i < 16; ++i)
#pragma unroll
          for (int j = 0; j < 16; ++j) if ((i + 1) * (j + 1) <= 16) { if (keys[c] >= thr) { outp[pos & 15] = ((i0[i] * 128u + i1[j]) << 16) | f2bf(w[c] * inv); ++pos; } ++c; } }
}
}

constexpr size_t SLICE_BYTES = (size_t)NEXP * 128;
constexpr int TH = T / 2;
__device__ __forceinline__ unsigned nib4(float a, float b, float c, float d, float is, int off) {
    const int n0 = min(max((int)floorf(a * is), -8), 7) + off, n1 = min(max((int)floorf(b * is), -8), 7) + off, n2 = min(max((int)floorf(c * is), -8), 7) + off, n3 = min(max((int)floorf(d * is), -8), 7) + off;
    return (unsigned)(n0 & 15) | ((unsigned)(n1 & 15) << 8) | ((unsigned)(n2 & 15) << 16) | ((unsigned)(n3 & 15) << 24);
}
template <int NR, bool OFFLO> __device__ __forceinline__ void quant_rows_i4(const float* X, unsigned char* qtab, float* scale, int e0, int es, int eend, int lane) {
    f32x4 v[NR][4];
#pragma unroll
    for (int r = 0; r < NR; ++r) { const int e = (e0 + r * es < eend) ? e0 + r * es : eend - 1; const GAS f32x4* xr = (const GAS f32x4*)(X + (size_t)e * DM) + lane;
#pragma unroll
        for (int j = 0; j < 4; ++j) v[r][j] = xr[64 * j]; }
#pragma unroll
    for (int r = 0; r < NR; ++r) { float ss = 0.f;
#pragma unroll
        for (int j = 0; j < 4; ++j) ss += (v[r][j].x * v[r][j].x + v[r][j].y * v[r][j].y) + (v[r][j].z * v[r][j].z + v[r][j].w * v[r][j].w);
        ss = wave_sum(ss);
        const float step = ss > 0.f ? 0.3352f * sqrtf(ss * (1.f / 1024.f)) : 1.f, is = 1.f / step;
        const int e = e0 + r * es;
        const unsigned twoc = (OFFLO && !(lane & 1)) ? 0u : 0x08080808u;
#pragma unroll
        for (int j = 0; j < 4; ++j) {
            const f32x4 y = v[r][j] * is + 7.5f;
            unsigned z[4];
#pragma unroll
            for (int e = 0; e < 4; ++e) z[e] = __builtin_bit_cast(unsigned, __builtin_amdgcn_fmed3f(y[e], -0.5f, 15.0f) + 8388864.0f);
            const unsigned o = (__builtin_amdgcn_perm(z[1], z[0], 0x0c0c0400u) | __builtin_amdgcn_perm(z[3], z[2], 0x04000c0cu)) ^ twoc;
            const unsigned po = (unsigned)__builtin_amdgcn_update_dpp(0, (int)o, 0xB1, 0xf, 0xf, true);
            if (e < eend && !(lane & 1)) *(GAS unsigned*)(qtab + (size_t)j * SLICE_BYTES + (size_t)e * 128 + (lane >> 1) * 4) = o | (po << 4); }
        if (e < eend && lane == 0) scale[e] = 0.5f * step; }
}
constexpr int NQCHUNK = 2 * NEXP / 8;
__device__ __forceinline__ void quant_tables_part(const float* PU, const float* PV, unsigned char* UQ, unsigned char* VQ, float* SU, float* SV, int first, int end, int w, int nw, int lane) {
    for (int c = first + w; c < end; c += nw) { const int e0 = (c & 2047) * 8;
        if ((c >> 11) == 0) quant_rows_i4<8, false>(PU, UQ, SU, e0, 1, NEXP, lane); else quant_rows_i4<8, true>(PV, VQ, SV, e0, 1, NEXP, lane); }
}
template <int NR> __device__ __forceinline__ void quant_x(const bf16* HB, unsigned char* XQ, float* SX, int* XS, const float (&gf)[16], int t0, int ts, int lane) {
    f32x4 hv[NR][4];
#pragma unroll
    for (int r = 0; r < NR; ++r) { const int t = (t0 + r * ts < T) ? t0 + r * ts : T - 1; const GAS v2u* hrow = (const GAS v2u*)(HB + (size_t)t * DM) + lane;
#pragma unroll
        for (int j = 0; j < 4; ++j) { const v2u w = hrow[64 * j]; hv[r][j] = (f32x4){bflo(w.x), bfhi(w.x), bflo(w.y), bfhi(w.y)}; } }
#pragma unroll
    for (int r = 0; r < NR; ++r) { float ss = 0.f;
#pragma unroll
        for (int j = 0; j < 4; ++j) ss += (hv[r][j].x * hv[r][j].x + hv[r][j].y * hv[r][j].y) + (hv[r][j].z * hv[r][j].z + hv[r][j].w * hv[r][j].w);
        const float rn = 1.f / sqrtf(wave_sum(ss) * (1.f / 1024.f) + RMS_EPS);
        float xn[16]; float am = 0.f;
#pragma unroll
        for (int j = 0; j < 4; ++j)
#pragma unroll
            for (int e = 0; e < 4; ++e) { xn[4 * j + e] = hv[r][j][e] * rn * gf[4 * j + e]; am = fmaxf(am, fabsf(xn[4 * j + e])); }
#pragma unroll
        for (int o = 1; o < 64; o <<= 1) am = fmaxf(am, __shfl_xor(am, o));
        const float sx = am > 0.f ? am * (1.f / 119.f) : 1.f, isx = 1.f / sx;
        const int t = t0 + r * ts;
        float qsf = 0.f;
#pragma unroll
        for (int j = 0; j < 4; ++j) {
            unsigned zh[4], zl[4];
#pragma unroll
            for (int e = 0; e < 4; ++e) { const float q = __builtin_rintf(xn[4 * j + e] * isx), qh = __builtin_floorf(q * 0.0625f + 0.5f), ql = q - 16.f * qh; qsf += q;
                zh[e] = __builtin_bit_cast(unsigned, qh + 12582912.0f); zl[e] = __builtin_bit_cast(unsigned, ql + 12582912.0f); }
            const unsigned ph = (__builtin_amdgcn_perm(zh[1], zh[0], 0x0c0c0400u) | __builtin_amdgcn_perm(zh[3], zh[2], 0x04000c0cu)) & 0x0f0f0f0fu;
            const unsigned pl = (__builtin_amdgcn_perm(zl[1], zl[0], 0x0c0c0400u) | __builtin_amdgcn_perm(zl[3], zl[2], 0x04000c0cu)) & 0x0f0f0f0fu;
            const unsigned oh = (unsigned)__builtin_amdgcn_update_dpp(0, (int)ph, 0xB1, 0xf, 0xf, true), ol = (unsigned)__builtin_amdgcn_update_dpp(0, (int)pl, 0xB1, 0xf, 0xf, true);
            const unsigned word = (lane & 1) ? (ol | (pl << 4)) : (ph | (oh << 4));
            if (t < T) *(GAS unsigned*)(XQ + (size_t)t * DM + j * 256 + (lane >> 3) * 32 + (lane & 1) * 16 + ((lane & 7) >> 1) * 4) = word; }
        int qs = (int)qsf;
#pragma unroll
        for (int o = 1; o < 64; o <<= 1) qs += __shfl_xor(qs, o);
        if (t < T && lane == 0) { SX[t] = sx; XS[t] = qs; } }
}
__device__ __forceinline__ float gelu_exact(float x) { return 0.5f * x * (1.0f + erff(x * 0.70710678118654752f)); }
__device__ __forceinline__ int dpp_i(int v, int ctrl_is) {
    return ctrl_is == 0 ? __builtin_amdgcn_update_dpp(0, v, 0x141, 0xf, 0xf, true) : ctrl_is == 1 ? __builtin_amdgcn_update_dpp(0, v, 0xB1, 0xf, 0xf, true) : __builtin_amdgcn_update_dpp(0, v, 0x4E, 0xf, 0xf, true);
}
constexpr int QCHUNK = 8;
__device__ __forceinline__ int q_take(unsigned* q, int lane) {
    unsigned v = 0; if (lane == 0) v = __hip_atomic_fetch_add(q, (unsigned)QCHUNK, __ATOMIC_RELAXED, __HIP_MEMORY_SCOPE_AGENT);
    return (int)__builtin_amdgcn_readfirstlane(v);
}
struct TokStream {
    unsigned* q; int cur, end, nxt, stride;
    __device__ __forceinline__ void open_static(int c0, int W) { q = nullptr; cur = c0 * QCHUNK; end = cur + QCHUNK; nxt = 0; stride = W * QCHUNK; }
    __device__ __forceinline__ void open(unsigned* q_, int lane) { q = q_; stride = 0;
        unsigned v = 0; if (lane == 0) v = __hip_atomic_fetch_add(q, 2u * (unsigned)QCHUNK, __ATOMIC_RELAXED, __HIP_MEMORY_SCOPE_AGENT);
        cur = (int)__builtin_amdgcn_readfirstlane(v); end = cur + QCHUNK; nxt = cur + QCHUNK; }
    __device__ __forceinline__ int next(int lane) { const int t = cur; if (t >= TH) return TH; ++cur;
        if (cur == end) { if (q) { cur = nxt; end = cur + QCHUNK; if (cur < TH) nxt = q_take(q, lane); } else { cur += stride - QCHUNK; end = cur + QCHUNK; } }
        return t; }
};
struct SlicePlan { int xcc, srank, sW; unsigned cnts; };
__device__ __forceinline__ SlicePlan slice_plan(int xcc, int srank, int sW, const unsigned* xcnt  , int lane) {
    SlicePlan p; p.xcc = xcc; p.srank = srank; p.sW = sW;
    p.cnts = (sW > 0 && lane < 8) ? __hip_atomic_load(xcnt + 64 * lane, __ATOMIC_RELAXED, __HIP_MEMORY_SCOPE_AGENT) : 0u;
    return p;
}
__device__ __forceinline__ bool slice_open(TokStream& S, const SlicePlan& p, int qi, int x, unsigned* queues, int lane) {
    if (p.sW > 0 && qi == 0) { S.open_static(p.srank, p.sW); return true; }
    if (p.sW > 0 && (unsigned)__builtin_amdgcn_readlane((int)p.cnts, x) != 0u) return false;
    S.open(queues + 64 * x, lane); return true;
}
#define MEM_ORDER() asm volatile("" ::: "memory")
#ifdef PROBE_MASKV
#define PROBE_EMASK & emask
#define PROBE_EARG , unsigned emask
#define PROBE_EPASS , emask
#else
#define PROBE_EMASK
#define PROBE_EARG
#define PROBE_EPASS
#endif
__device__ __forceinline__ unsigned bperm(int src_lane4, unsigned v) { return (unsigned)__builtin_amdgcn_ds_bpermute(src_lane4, (int)v); }
struct UEnt { v2u R; unsigned x; };
__device__ __forceinline__ void u_ent(UEnt& E, const unsigned* SEL, const unsigned char* XQ, int t, int cs, int lane) {
    E.x = *(const GAS unsigned*)(XQ + (size_t)t * DM + cs * 256 + 4 * lane);
    E.R = *(const GAS v2u*)(SEL + (size_t)t * 128 + 2 * lane);
}
__device__ __forceinline__ void u_rows(v4u (&w)[16], unsigned& xr, const UEnt& E, int lane, const unsigned char* tab, unsigned choff PROBE_EARG) {
    const v2u R = E.R;
    const int gb = (lane >> 3) * 32;
#pragma unroll
    for (int g = 0; g < 16; ++g) { const unsigned e = bperm(gb + 4 * (g >> 1), (g & 1) ? R.y : R.x);
        w[g] = *(const GAS v4u*)(tab + (unsigned)(((e >> 16) PROBE_EMASK) * 128u + choff)); }
    xr = E.x;
}
__device__ __forceinline__ int dot8z(unsigned a, unsigned b) { int r; asm("v_dot8_i32_i4 %0, %1, %2, 0" : "=v"(r) : "v"(a), "v"(b)); return r; }
__device__ __forceinline__ void u_compute(const v4u (&w)[16], const unsigned xr, int* prow, int grp, int ch, int c0, int c1, int c2) {
    int p[16];
    v4u xh, xl;
#pragma unroll
    for (int j = 0; j < 4; ++j) { xh[j] = bperm(32 * ch + 4 * j, xr); xl[j] = bperm(32 * ch + 16 + 4 * j, xr); }
#pragma unroll
    for (int g = 0; g < 16; ++g) { int ah = dot8z(w[g][0], xh[0]), al = dot8z(w[g][0], xl[0]);
#pragma unroll
        for (int j = 1; j < 4; ++j) { ah = __builtin_amdgcn_sdot8((int)w[g][j], (int)xh[j], ah, false); al = __builtin_amdgcn_sdot8((int)w[g][j], (int)xl[j], al, false); }
        p[g] = (ah << 4) + al; }
    int q8[8], q4[4], q2[2];
#pragma unroll
    for (int i = 0; i < 8; ++i) { const int keep = c2 ? p[i + 8] : p[i], send = c2 ? p[i] : p[i + 8]; q8[i] = keep + dpp_i(send, 0); }
#pragma unroll
    for (int i = 0; i < 4; ++i) { const int keep = c0 ? q8[i + 4] : q8[i], send = c0 ? q8[i] : q8[i + 4]; q4[i] = keep + dpp_i(send, 1); }
#pragma unroll
    for (int i = 0; i < 2; ++i) { const int keep = c1 ? q4[i + 2] : q4[i], send = c1 ? q4[i] : q4[i + 2]; q2[i] = keep + dpp_i(send, 2); }
    const int g0 = 8 * c2 + 4 * c0 + 2 * c1;
    typedef int i2 __attribute__((ext_vector_type(2)));
    *(GAS i2*)(prow + grp * 16 + g0) = (i2){q2[0], q2[1]};
}
__device__ __forceinline__ void gather_u(const unsigned* SEL0, const unsigned char* XQ0, const unsigned char* UQS, int* PART, int* dummy, unsigned* queues, const SlicePlan& plan, int lane PROBE_EARG) {
    const int grp = lane >> 3, ch = lane & 7, c0 = ch & 1, c1 = (ch >> 1) & 1, c2 = (ch >> 2) & 1;
    for (int qi = 0; qi < 8; ++qi) { const int x = (plan.xcc + qi) & 7, cs = x & 3, tb = (x >> 2) * TH;
        TokStream S; if (!slice_open(S, plan, qi, x, queues, lane)) continue;
        const unsigned char* tab = UQS + (size_t)cs * SLICE_BYTES; const unsigned choff = (unsigned)ch * 16u;
        int* part = PART + ((size_t)cs * T + tb) * 128;
        const unsigned* SEL = SEL0 + (size_t)tb * 128; const unsigned char* XQ = XQ0 + (size_t)tb * DM;
        int tA = S.next(lane), tB = S.next(lane);
        if (tA >= TH) continue;
        UEnt EA, EB; v4u W0[16], W1[16]; unsigned X0, X1;
        u_ent(EA, SEL, XQ, tA, cs, lane); u_ent(EB, SEL, XQ, tB < TH ? tB : TH - 1, cs, lane); MEM_ORDER();
        u_rows(W0, X0, EA, lane, tab, choff PROBE_EPASS); MEM_ORDER();
        while (tA < TH) {
            const int tC = S.next(lane);
            u_ent(EA, SEL, XQ, tC < TH ? tC : TH - 1, cs, lane); MEM_ORDER();
            u_rows(W1, X1, EB, lane, tab, choff PROBE_EPASS); MEM_ORDER();
            u_compute(W0, X0, part + (size_t)tA * 128, grp, ch, c0, c1, c2); MEM_ORDER();
            const int tD = S.next(lane);
            u_ent(EB, SEL, XQ, tD < TH ? tD : TH - 1, cs, lane); MEM_ORDER();
            u_rows(W0, X0, EA, lane, tab, choff PROBE_EPASS); MEM_ORDER();
            u_compute(W1, X1, tB < TH ? part + (size_t)tB * 128 : dummy, grp, ch, c0, c1, c2); MEM_ORDER();
            tA = tC; tB = tD;
        }
    }
}
template <int NR> __device__ __forceinline__ void gather_coef(const unsigned* SEL, const int* PART, const float* SU, const float* SV, const float* SX, const int* XS, signed char* CQ, unsigned* EO, float* SCL, int* CSM, int t0, int ts, int lane) {
    typedef int i2 __attribute__((ext_vector_type(2)));
    v2u ent[NR]; i2 acc[NR]; float sx[NR]; int xs[NR]; int tt[NR];
#pragma unroll
    for (int r = 0; r < NR; ++r) { tt[r] = (t0 + r * ts < T) ? t0 + r * ts : T - 1; ent[r] = *(const GAS v2u*)(SEL + (size_t)tt[r] * 128 + 2 * lane);
        sx[r] = __hip_atomic_load(SX + tt[r], __ATOMIC_RELAXED, __HIP_MEMORY_SCOPE_AGENT);
        xs[r] = __hip_atomic_load(XS + tt[r], __ATOMIC_RELAXED, __HIP_MEMORY_SCOPE_AGENT);
        acc[r] = (i2){0, 0}; }
#pragma unroll
    for (int r = 0; r < NR; ++r)
#pragma unroll
        for (int x = 0; x < 4; ++x) { const i2 pp = *(const GAS i2*)(PART + ((size_t)x * T + tt[r]) * 128 + 2 * lane); acc[r] += pp; }
    float su0[NR], sv0[NR], su1[NR], sv1[NR];
#pragma unroll
    for (int r = 0; r < NR; ++r) { const unsigned e0 = ent[r].x >> 16, e1 = ent[r].y >> 16; su0[r] = SU[e0]; sv0[r] = SV[e0]; su1[r] = SU[e1]; sv1[r] = SV[e1]; }
#pragma unroll
    for (int r = 0; r < NR; ++r) {
        const float k0 = bflo(ent[r].x) * gelu_exact((float)(2 * acc[r].x + xs[r]) * (su0[r] * sx[r])) * sv0[r], k1 = bflo(ent[r].y) * gelu_exact((float)(2 * acc[r].y + xs[r]) * (su1[r] * sx[r])) * sv1[r];
        float am = fmaxf(fabsf(k0), fabsf(k1));
#pragma unroll
        for (int o = 1; o < 64; o <<= 1) am = fmaxf(am, __shfl_xor(am, o));
        const float sc = am > 0.f ? am * (1.f / 127.f) : 1.f, isc = 1.f / sc;
        const int c0 = (int)rintf(k0 * isc), c1 = (int)rintf(k1 * isc);
        int csum = c0 + c1;
#pragma unroll
        for (int o = 1; o < 64; o <<= 1) csum += __shfl_xor(csum, o);
        if (t0 + r * ts < T) {
            GAS unsigned short* cq = (GAS unsigned short*)((GAS signed char*)CQ + (size_t)tt[r] * 128);
            cq[lane] = (unsigned short)((unsigned)(c0 & 0xff) | ((unsigned)(c1 & 0xff) << 8));
            *(GAS v2u*)(EO + (size_t)tt[r] * 128 + 2 * lane) = (v2u){(ent[r].x >> 16) * 128u, (ent[r].y >> 16) * 128u};
            if (lane == 0) { SCL[tt[r]] = sc * 0.125f; CSM[tt[r]] = 8 * csum; } } }
}
typedef int v4i __attribute__((ext_vector_type(4)));
typedef float vf4 __attribute__((ext_vector_type(4)));
struct VCoef { v4i A; float sc; int cs; v4u hb0, hb1; };
struct VEnt { VCoef c; v2u R; };
__device__ __forceinline__ void v_ent(VEnt& E, const unsigned* EO, const signed char* CQ, const float* SCL, const int* CSM, const bf16* HIcol, int t, int lane) {
    const int ic = lane & 3, kb = lane >> 4;
    E.c.A = *(const GAS v4i*)((const GAS signed char*)CQ + (size_t)t * 128 + (2 * kb + (ic & 1)) * 16);
    E.c.sc = __hip_atomic_load(SCL + t, __ATOMIC_RELAXED, __HIP_MEMORY_SCOPE_AGENT);
    E.c.cs = __hip_atomic_load(CSM + t, __ATOMIC_RELAXED, __HIP_MEMORY_SCOPE_AGENT);
    E.c.hb0 = *(const GAS v4u*)(HIcol + (size_t)t * DM);
    E.c.hb1 = *(const GAS v4u*)(HIcol + (size_t)t * DM + 16);
    E.R = *(const GAS v2u*)(EO + (size_t)t * 128 + 2 * lane);
}
__device__ __forceinline__ void v_rows(v4u (&w)[16], VCoef& c, const VEnt& E, int lane, const unsigned char* tab, unsigned choff) {
    const int gb = (lane >> 3) * 32; const v2u R = E.R;
#pragma unroll
    for (int g = 0; g < 16; ++g) { const unsigned eo = bperm(gb + 4 * (g >> 1), (g & 1) ? R.y : R.x); w[g] = *(const GAS v4u*)(tab + (unsigned)(eo + choff)); }
    c = E.c;
}
__device__ __forceinline__ unsigned permb(unsigned hi, unsigned lo, unsigned sel) { return __builtin_amdgcn_perm(hi, lo, sel); }
__device__ __forceinline__ int ror8(int v) { return __builtin_amdgcn_update_dpp(0, v, 0x128, 0xf, 0xf, true); }
__device__ __forceinline__ void v_compute(const v4u (&w)[16], const VCoef& C, float* hout, bool half, bool storer, bool arow) {
    const v4i CA = arow ? C.A : (v4i){0, 0, 0, 0};
    const int k15 = -15 * C.cs;
#pragma unroll
    for (int jp = 0; jp < 2; ++jp) {
        int tr[2][4], th[2][4];
#pragma unroll
        for (int jj = 0; jj < 2; ++jj) { const int j = 2 * jp + jj;
            unsigned K[4][4];
#pragma unroll
            for (int q = 0; q < 4; ++q) { const unsigned a = w[4 * q][j], b = w[4 * q + 1][j], c = w[4 * q + 2][j], d = w[4 * q + 3][j];
                const unsigned t0 = permb(a, b, 0x01050004u), t1 = permb(a, b, 0x03070206u), t2 = permb(c, d, 0x01050004u), t3 = permb(c, d, 0x03070206u);
                K[q][0] = permb(t2, t0, 0x05040100u); K[q][1] = permb(t2, t0, 0x07060302u); K[q][2] = permb(t3, t1, 0x05040100u); K[q][3] = permb(t3, t1, 0x07060302u); }
#pragma unroll
            for (int k = 0; k < 4; ++k) {
                const v4i Br = {(int)K[0][k], (int)K[1][k], (int)K[2][k], (int)K[3][k]};
                const v4i Bh = {(int)(K[0][k] & 0xF0F0F0F0u), (int)(K[1][k] & 0xF0F0F0F0u), (int)(K[2][k] & 0xF0F0F0F0u), (int)(K[3][k] & 0xF0F0F0F0u)};
                const v4i Dr = __builtin_amdgcn_mfma_i32_16x16x64_i8(CA, Br, (v4i){0, 0, 0, 0}, 0, 0, 0);
                const v4i Dh = __builtin_amdgcn_mfma_i32_16x16x64_i8(CA, Bh, (v4i){0, 0, 0, 0}, 0, 0, 0);
                tr[jj][k] = jj ? Dr[1] + ror8(Dr[0]) : Dr[0] + ror8(Dr[1]);
                th[jj][k] = jj ? Dh[1] + ror8(Dh[0]) : Dh[0] + ror8(Dh[1]); }
        }
        int lo[4], hi[4];
#pragma unroll
        for (int k = 0; k < 4; ++k) { const int d0 = tr[0][k] - th[0][k], d1 = tr[1][k] - th[1][k]; lo[k] = half ? d1 : d0; hi[k] = half ? th[1][k] : th[0][k];
            asm volatile("" : "+v"(lo[k]), "+v"(hi[k])); }
        const v4u hb = jp ? C.hb1 : C.hb0;
        const float h8[8] = {bflo(hb.x), bfhi(hb.x), bflo(hb.y), bfhi(hb.y), bflo(hb.z), bfhi(hb.z), bflo(hb.w), bfhi(hb.w)};
        vf4 o0, o1;
#pragma unroll
        for (int k = 0; k < 4; ++k) { o0[k] = h8[k] + C.sc * (float)((lo[k] << 4) + k15);
                                      o1[k] = h8[4 + k] + C.sc * (float)(hi[k] + C.cs); }
        if (storer) { __builtin_nontemporal_store(o0, (GAS vf4*)(hout + 16 * jp)); __builtin_nontemporal_store(o1, (GAS vf4*)(hout + 16 * jp) + 1); }
    }
}
__device__ __forceinline__ void gather_v(const unsigned* EO0, const signed char* CQ0, const float* SCL0, const int* CSM0, const unsigned char* VQS, const bf16* HI0, float* HO0, float* dummy, unsigned* queues, const SlicePlan& plan, int lane) {
    const int ch = lane & 7; const bool half = ((lane >> 3) & 1) != 0, storer = lane < 16, arow = (lane & 15) < 2;
    for (int qi = 0; qi < 8; ++qi) { const int x = (plan.xcc + qi) & 7, cs = x & 3, tb = (x >> 2) * TH;
        TokStream S; if (!slice_open(S, plan, qi, x, queues, lane)) continue;
        const unsigned char* tab = VQS + (size_t)cs * SLICE_BYTES; const unsigned choff = (unsigned)ch * 16u;
        const int col = cs * 256 + ch * 32 + (half ? 8 : 0);
        const unsigned* EO = EO0 + (size_t)tb * 128; const signed char* CQ = CQ0 + (size_t)tb * 128; const float* SCL = SCL0 + tb; const int* CSM = CSM0 + tb;
        const bf16* HI = HI0 + (size_t)tb * DM + col; float* HO = HO0 + (size_t)tb * DM + col;
        int tA = S.next(lane), tB = S.next(lane);
        if (tA >= TH) continue;
        VEnt EA, EB; v4u W0[16], W1[16]; VCoef C0, C1;
        v_ent(EA, EO, CQ, SCL, CSM, HI, tA, lane); v_ent(EB, EO, CQ, SCL, CSM, HI, tB < TH ? tB : TH - 1, lane); MEM_ORDER();
        v_rows(W0, C0, EA, lane, tab, choff); MEM_ORDER();
        while (tA < TH) {
            const int tC = S.next(lane);
            v_ent(EA, EO, CQ, SCL, CSM, HI, tC < TH ? tC : TH - 1, lane); MEM_ORDER();
            v_rows(W1, C1, EB, lane, tab, choff); MEM_ORDER();
            v_compute(W0, C0, HO + (size_t)tA * DM, half, storer, arow); MEM_ORDER();
            const int tD = S.next(lane);
            v_ent(EB, EO, CQ, SCL, CSM, HI, tD < TH ? tD : TH - 1, lane); MEM_ORDER();
            v_rows(W0, C0, EA, lane, tab, choff); MEM_ORDER();
            v_compute(W1, C1, tB < TH ? HO + (size_t)tB * DM : dummy + 32 * (lane & 15), half, storer, arow); MEM_ORDER();
            tA = tC; tB = tD;
        }
    }
}

#ifndef MK_SPLIT
#define MK_SPLIT 0
#endif
constexpr int NPHASE = 11;
typedef SlicePlan pk_plan_t;
#ifndef PROBE_PH
#define PROBE_PH -1
#endif
#ifndef PROBE_N
#define PROBE_N 1
#endif
#define REPS(k) (((k) == PROBE_PH) ? 1 + PROBE_N : 1)
struct Args { const float* in[21]; float* out; unsigned char* ws; int ph_lo, ph_hi; };
static_assert(sizeof(Args) == 23 * 8 + 8, "Args has no padding");

__global__ void __launch_bounds__(NWAVES * 64, 2) fwd(Args args) {
    extern __shared__ __attribute__((aligned(16))) unsigned char lds_raw[];
    LAS unsigned char* lds = (LAS unsigned char*)lds_raw;
    volatile LAS unsigned* MISC = (volatile LAS unsigned*)(lds + MISC_OFF);
    const int tid = threadIdx.x, lane = tid & 63, wave = __builtin_amdgcn_readfirstlane(tid >> 6);
    const int G = gridDim.x; const int bx = blockIdx.x; const int vcu = (G % 8 == 0) ? (bx % 8) * (G / 8) + bx / 8 : bx;
    const int gw = vcu * NWAVES + wave, NGW = G * NWAVES;
    unsigned char* ws = args.ws;
    gu32* ctl = (gu32*)(ws + WS_CTL);
    const float* x = args.in[0]; const float* mem = args.in[1]; const float* g_mix = args.in[2]; const float* w_in = args.in[3]; const float* q_gain_a = args.in[4]; const float* k_gain_a = args.in[5];
    const float* rel_bias = args.in[6]; const float* conv_w = args.in[7]; const float* g_mem = args.in[8]; const float* w_mem_kv = args.in[9]; const float* q_gain_x = args.in[10]; const float* k_gain_x = args.in[11];
    const float* w_br_attn = args.in[12]; const float* w_br_conv = args.in[13]; const float* w_br_x = args.in[14]; const float* w_out = args.in[15]; const float* g_ffn = args.in[16];
    const float* w_query = args.in[17]; const float* sub_keys = args.in[18]; const float* peer_u = args.in[19]; const float* peer_v = args.in[20];
    float* out = args.out;
    bf16* WinT = (bf16*)(ws + WS_WIN); bf16* WkvT = (bf16*)(ws + WS_WKV); bf16* WbrT = (bf16*)(ws + WS_WBR); bf16* WoutT = (bf16*)(ws + WS_WOUT); bf16* WqT = (bf16*)(ws + WS_WQ);
    bf16* SK = (bf16*)(ws + WS_SK); float* TAB = (float*)(ws + WS_TAB); float* KMEAN = (float*)(ws + WS_KMEAN); bf16* MEMN = (bf16*)(ws + WS_MEMN); bf16* KVM = (bf16*)(ws + WS_KVM);
    float* SLOTS = (float*)(ws + WS_SLOTS); unsigned* SEL = (unsigned*)(ws + WS_SEL);
    bf16* PA = (bf16*)(ws + WS_PA); bf16* PG = (bf16*)(ws + WS_PG);
    bf16* MERGED = (bf16*)(ws + PA_MERGED); bf16* HB = (bf16*)(ws + PA_HB); unsigned char* UQ = ws + PA_UT; unsigned char* VQ = ws + PA_VT; float* SU = (float*)(ws + WS_SU); float* SV = (float*)(ws + WS_SV); int* CM = (int*)(ws + WS_CM); float* SAq = (float*)(ws + WS_SA); float* SBq = (float*)(ws + WS_SB); int* XSM = (int*)(ws + WS_XS); float* SX = (float*)(ws + WS_SX); float* CS = (float*)(ws + WS_CS);
    unsigned char* XQ = ws + PA_XQ; int* PART = (int*)(ws + PG_PART); signed char* CQ = (signed char*)(ws + PG_COEF); unsigned* EO = (unsigned*)(ws + PG_COEF + 8 * MiB); bf16* QRY = (bf16*)(ws + PG_QRY);
    bf16* HN = (bf16*)out;
    bf16* BRO = (bf16*)out;

    for (int u = tid; u < (LDS_BYTES - LDSCTL_OFF) / 4; u += NWAVES * 64) ((LAS unsigned*)(lds + LDSCTL_OFF))[u] = 0u;
    __syncthreads();
#if !MK_SPLIT
    XcdBarrier bar = xcd_barrier_post((unsigned*)(ctl + CW_BAR), MISC + 8);
    if (tid == 0) MISC[10] = __hip_atomic_fetch_add((unsigned*)(ctl + CW_RANK) + 64 * (bar.x & 7u), 1u, __ATOMIC_RELAXED, __HIP_MEMORY_SCOPE_AGENT);
#define GRID_BAR() xcd_barrier(bar)
#else
#define GRID_BAR() do {} while (0)
#endif
    const int lo = args.ph_lo, hi_ = args.ph_hi;
#ifndef PH_MASK
#define PH_MASK 0x7ff
#endif
#define IN(k) ((((PH_MASK) >> (k)) & 1) && lo <= (k) && (k) < hi_)
#define BOTH(k) (IN(k) && IN((k) + 1))

    const P0Args p0a{x, mem, g_mix, w_in, rel_bias, g_mem, w_mem_kv, w_br_attn, w_br_conv, w_br_x, w_out, g_ffn, w_query, sub_keys, WinT, WkvT, WbrT, WoutT, WqT, SK, HN, MEMN, TAB, SAq, SBq};
    const int n_busy = (64 * 26) % G + 32; const bool late_w = IN(0) && IN(1) && n_busy < G;
    if (IN(0)) for (int rep = 0; rep < REPS(0); ++rep) {
        p0_prologue(p0a, lds, late_w, gw, NGW, wave, lane);
        if (BOTH(0) && rep == REPS(0) - 1) GRID_BAR();
    }
    if (IN(1)) for (int rep = 0; rep < REPS(1); ++rep) {
        { pg8::Gemm g{HN, WinT, T, PW, DM / 2}; pg8::GOrder S; S.init(T, PW, G, bx); pg8::EpiProj E{PA, PG, q_gain_a, k_gain_a, KMEAN, C2A, RMS_EPS, SAq, SBq};
          pg8::gemm_phase<pg8::EpiProj, pg8::GOrder, true, true, true>(lds + RING_OFF, g, S, E); }
        { const int nfull = (64 * 26) % G; const int coff = (nfull + 32 <= G) ? bx - nfull : bx;
          pg8::Gemm g{MEMN, WkvT, NBATCH * MEMLEN, 1024, DM}; pg8::GOrder S; S.init(NBATCH * MEMLEN, 1024, G, coff); pg8::EpiBf16<0> E{KVM, 1024, nullptr, 0, 0, 1.f};
          pg8::gemm_phase<pg8::EpiBf16<0>, pg8::GOrder, true, true>(lds + RING_OFF, g, S, E); }
        if (late_w && rep == 0 && bx >= n_busy) p0_transposes(p0a, lds, 1, (bx - n_busy) * NWAVES + wave, (G - n_busy) * NWAVES, wave, lane);
        if (IN(1) && IN(3) && rep == REPS(1) - 1) GRID_BAR();
    }
#if defined(PROBE_BARS) && !MK_SPLIT
    if (IN(1)) for (int i = 0; i < PROBE_BARS; ++i) GRID_BAR();
#endif
    if (IN(3)) for (int rep = 0; rep < REPS(3); ++rep) {
        for (int v = vcu; v < 256; v += G) {
            const int bh = v >> 2, b = bh >> 3, h = bh & 7, s = v & 3;
#pragma unroll 1
            for (int pass = 0; pass < 2; ++pass) { const int qb = pass ? 7 - s : s;
                const bf16* Qp = PA + (size_t)(b * SEQ + qb * 256) * PAW + COL_QA + h * 64;
                const bf16* Kp = PA + (size_t)(b * SEQ) * PAW + COL_KA + h * 64; const bf16* Vp = PA + (size_t)(b * SEQ) * PAW + COL_VA + h * 64;
                bf16* Op = BRO + (size_t)(b * SEQ + qb * 256) * 512 + h * 64;
                att::attn_unit<64, true>(Qp, PAW, Kp, Vp, PAW, Op, qb, KMEAN + (size_t)bh * 512, TAB + h * 2048, nullptr, nullptr, lds + RING_OFF, tid, wave, lane); }
            { const int bb = v >> 5, hx = (v >> 3) & 3, qt = v & 7;
                const bf16* Qp = PA + (size_t)(bb * SEQ + qt * 256) * PAW + COL_QX + hx * 128;
                const bf16* Kp = KVM + (size_t)(bb * MEMLEN) * 1024 + hx * 128; const bf16* Vp = Kp + 512;
                bf16* Op = BRO + (size_t)2 * T * 512 + (size_t)(bb * SEQ + qt * 256) * 512 + hx * 128;
                att::attn_unit<128, false>(Qp, PAW, Kp, Vp, 1024, Op, 0, nullptr, nullptr, q_gain_x, k_gain_x, lds + RING_OFF, tid, wave, lane); }
            conv_item(PA, conv_w, BRO + (size_t)T * 512, v, tid);
        }
        if (BOTH(3) && rep == REPS(3) - 1) GRID_BAR();
    }
    if (IN(4)) for (int rep = 0; rep < REPS(4); ++rep) {
        pg8::Gemm g{BRO, WbrT, 3 * T, 3 * 1024, 512}; pg8::BranchOrder S; S.init(G, bx); pg8::EpiBranch E{PG, MERGED};
        pg8::gemm_phase<pg8::EpiBranch, pg8::BranchOrder, true, true>(lds + RING_OFF, g, S, E);
        if (BOTH(4) && rep == REPS(4) - 1) GRID_BAR();
    }
    if (IN(5)) for (int rep = 0; rep < REPS(5); ++rep) {
        pg8::Gemm g{MERGED, WoutT, T, 1024, DM}; pg8::GOrder S; S.init(T, 1024, G, bx); pg8::EpiWout E{x, out, HB, SLOTS};
        pg8::gemm_phase<pg8::EpiWout, pg8::GOrder, true, true>(lds + RING_OFF, g, S, E);
        if (BOTH(5) && rep == REPS(5) - 1) GRID_BAR();
    }
    if (IN(6)) for (int rep = 0; rep < REPS(6); ++rep) {
        pg8::Gemm g{HB, WqT, T, 2048, DM}; pg8::GOrder S; S.init(T, 2048, G, bx); pg8::EpiBf16<0> E{QRY, 2048, nullptr, 0, 0, 1.f};
        pg8::gemm_phase<pg8::EpiBf16<0>, pg8::GOrder, true, true>(lds + RING_OFF, g, S, E);
        if (BOTH(6) && rep == REPS(6) - 1) GRID_BAR();
    }
    if (IN(7)) for (int rep = 0; rep < REPS(7); ++rep) {
        for (int v = vcu; v < 256; v += G) {
            pk::topk_fill(SK, lds + RING_OFF, v & 3, tid);
#ifndef PROBE_SKIP
#define PROBE_SKIP 0
#endif
            const bool lastrep = rep == REPS(7) - 1;
#ifndef P7_NRQ
#define P7_NRQ 4
#endif
#ifdef P7_STAGGER
            if (wave < 4 && (!(PROBE_SKIP & 1) || lastrep)) pk::topk_task(QRY, SLOTS, SEL, lds + RING_OFF, v & 3, ((v >> 2) * 8 + wave) * 32, lane);
#endif
            if (v == vcu && (!(PROBE_SKIP & 2) || lastrep)) {
                const int qgw = vcu * NWAVES + wave, QNGW = G * NWAVES;
                for (int m = qgw; m < NEXP; m += P7_NRQ * QNGW) quant_rows_i4<P7_NRQ, false>(peer_u, UQ, SU, m, QNGW, NEXP, lane);
                for (int m = qgw; m < NEXP; m += P7_NRQ * QNGW) quant_rows_i4<P7_NRQ, true>(peer_v, VQ, SV, m, QNGW, NEXP, lane);
                float gf[16];
#pragma unroll
                for (int j = 0; j < 16; ++j) gf[j] = g_ffn[4 * lane + 256 * (j >> 2) + (j & 3)];
                for (int t = qgw; t < T; t += P7_NRQ * QNGW) quant_x<P7_NRQ>(HB, XQ, SX, XSM, gf, t, QNGW, lane);
            }
#ifdef P7_STAGGER
            if (wave >= 4 && (!(PROBE_SKIP & 1) || lastrep)) pk::topk_task(QRY, SLOTS, SEL, lds + RING_OFF, v & 3, ((v >> 2) * 8 + wave) * 32, lane);
#else
            if (!(PROBE_SKIP & 1) || lastrep) pk::topk_task(QRY, SLOTS, SEL, lds + RING_OFF, v & 3, ((v >> 2) * 8 + wave) * 32, lane);
#endif
            __syncthreads();
        }
        if (BOTH(7) && rep == REPS(7) - 1) GRID_BAR();
    }
#if !MK_SPLIT
    const int xcc = (int)bar.x & 7;
    const int nloc = (int)__builtin_amdgcn_readfirstlane((int)MISC[8]), wrank = (int)__builtin_amdgcn_readfirstlane((int)MISC[10]);
    const pk_plan_t plan = slice_plan(xcc, wrank * NWAVES + wave, nloc * NWAVES, (const unsigned*)(ctl + CW_BAR) + XB_XCNT(0), lane);
#else
    const int xcc = (int)(xb_xcc_id() & 7u);
    const pk_plan_t plan = slice_plan(xcc, 0, 0, nullptr, lane);
#endif
    if (IN(8)) for (int rep = 0; rep < REPS(8); ++rep) {
        #ifdef PROBE_MASKV
        gather_u(SEL, XQ, UQ, PART, (int*)(ws + WS_END), (unsigned*)(ctl + CW_QU + 4096 * rep), plan, lane, (rep == REPS(8) - 1) ? 0xffffu : (unsigned)PROBE_MASKV);
#else
        gather_u(SEL, XQ, UQ, PART, (int*)(ws + WS_END), (unsigned*)(ctl + CW_QU + 4096 * rep), plan, lane);
#endif
        if (BOTH(8) && rep == REPS(8) - 1) GRID_BAR();
    }
    if (IN(9)) for (int rep = 0; rep < REPS(9); ++rep) {
        for (int t = gw; t < T; t += 4 * NGW) gather_coef<4>(SEL, PART, SU, SV, SX, XSM, CQ, EO, CS, CM, t, NGW, lane);
        if (BOTH(9) && rep == REPS(9) - 1) GRID_BAR();
    }
    if (IN(10)) for (int rep = 0; rep < REPS(10); ++rep) {
        gather_v(EO, CQ, CS, CM, VQ, HB, (rep == REPS(10) - 1) ? out : (float*)PART, (float*)(ws + WS_END), (unsigned*)(ctl + CW_QV + 4096 * rep), plan, lane);
    }
#undef IN
#undef BOTH
}

extern "C" void kernel_launch(void* const* d_in, const int* in_sizes, int n_in, void* d_out, int out_size, void* d_ws, size_t ws_size, hipStream_t stream) {
    static int grid = 0;
    if (grid == 0) {
        if (n_in != 21 || out_size != T * DM || ws_size < WS_END + 4096) { fprintf(stderr, "kernel_launch: unexpected shapes (n_in %d, out %d, ws %zu)\n", n_in, out_size, ws_size); grid = -1; return; }
        int dev = 0, cus = 0, per_cu = 0;
        if (hipGetDevice(&dev) != hipSuccess || hipDeviceGetAttribute(&cus, hipDeviceAttributeMultiprocessorCount, dev) != hipSuccess) { grid = -1; return; }
        if (hipFuncSetAttribute((const void*)fwd, hipFuncAttributeMaxDynamicSharedMemorySize, LDS_BYTES) != hipSuccess) { fprintf(stderr, "kernel_launch: hipFuncSetAttribute failed\n"); grid = -1; return; }
        if (hipOccupancyMaxActiveBlocksPerMultiprocessor(&per_cu, (const void*)fwd, NWAVES * 64, LDS_BYTES) != hipSuccess || per_cu < 1) { fprintf(stderr, "kernel_launch: occupancy query reports %d\n", per_cu); }
        (void)hipGetLastError();
        grid = cus;
    }
    if (grid < 0) return;
    (void)hipMemsetAsync((char*)d_ws + WS_CTL, 0, CTL_ZERO_BYTES, stream);
    Args a{};
    for (int i = 0; i < 21; ++i) a.in[i] = (const float*)d_in[i];
    a.out = (float*)d_out; a.ws = (unsigned char*)d_ws;
#if MK_SPLIT
    for (int p = 0; p < NPHASE; ++p) { a.ph_lo = p; a.ph_hi = p + 1; hipLaunchKernelGGL(fwd, dim3(grid), dim3(NWAVES * 64), LDS_BYTES, stream, a); }
#else
#if defined(PROBE_UPTO)
    a.ph_lo = 0; a.ph_hi = PROBE_UPTO + 1;
    hipLaunchKernelGGL(fwd, dim3(grid), dim3(NWAVES * 64), LDS_BYTES, stream, a);
    (void)hipMemsetAsync((char*)d_ws + WS_CTL, 0, CTL_ZERO_BYTES, stream);
#endif
    a.ph_lo = 0; a.ph_hi = NPHASE;
    hipLaunchKernelGGL(fwd, dim3(grid), dim3(NWAVES * 64), LDS_BYTES, stream, a);
#endif
}
```

```cpp
#define P7_NRQ 8
#include <hip/hip_runtime.h>
#include <hip/hip_bf16.h>
#include <cstdio>
#include <cstdint>
#include <cmath>
namespace pg8 {
#define PG8_LAS __attribute__((address_space(3)))
typedef unsigned short bf16_t;
typedef short bf16x8 __attribute__((ext_vector_type(8)));
typedef float f32x4 __attribute__((ext_vector_type(4)));
typedef unsigned u32x4 __attribute__((ext_vector_type(4)));
typedef int i32x4 __attribute__((ext_vector_type(4)));
constexpr int BM = 256, BK = 64, HALF = 128, HTB = HALF * BK * 2  , STAGE_BYTES = 8 * HTB, NXCD = 8, WGM = 8;

__host__ __device__ __forceinline__ int lds_byte(int r, int c) { const int st = (r >> 4) * 2 + (c >> 5), rr = r & 15, cc = c & 31, ob = rr * 64 + cc * 2; return st * 1024 + (ob ^ (((ob >> 9) & 1) << 5)); }
__host__ __device__ __forceinline__ void stage_rc(int b, int& R, int& C) { const int st = b / 1024, sb = b % 1024, swz = sb ^ (((sb >> 9) & 1) << 5); R = (st >> 1) * 16 + swz / 64; C = (st & 1) * 32 + (swz % 64) / 2; }
__host__ __device__ __forceinline__ int perm32(int rho) { const int n = rho >> 4, i = rho & 15; return 8 * (i >> 2) + 4 * n + (i & 3); }

struct Unit { int pm, pn; };
struct Gemm { const bf16_t* A; const bf16_t* Bt; int M, N, K; };

struct StaticOrder {
    int nM, nN, nwg, G, c;
    __host__ __device__ void init(int M, int N, int G_, int c_) { nM = M / BM; nN = N / BM; nwg = nM * nN; G = G_; c = c_; }
    __host__ __device__ bool next(int i, Unit& u) const {
        const long L = (long)i * G + c; if (L >= nwg) return false;
        int wgid = (int)L; { const int q = nwg / NXCD, r = nwg % NXCD, xcd = wgid % NXCD, off = wgid / NXCD; wgid = (xcd < r ? xcd * (q + 1) : r * (q + 1) + (xcd - r) * q) + off; }
        const int nig = WGM * nN, gid = wgid / nig, fm = gid * WGM, gsz = (nM - fm) < WGM ? (nM - fm) : WGM;
        u.pm = fm + ((wgid % nig) % gsz); u.pn = (wgid % nig) / gsz; return true;
    }
    __device__ __forceinline__ void a_ready(const Unit&) const {}
    __device__ __forceinline__ void done(const Unit&) const {}
};

__device__ __forceinline__ unsigned cvt_pk_bf16(float lo, float hi) { unsigned r; asm volatile("v_cvt_pk_bf16_f32 %0, %1, %2" : "=v"(r) : "v"(lo), "v"(hi)); return r; }
typedef float f32x2 __attribute__((ext_vector_type(2)));
__device__ __forceinline__ f32x2 gelu_pk(f32x2 v) {
    const f32x2 av = __builtin_elementwise_abs(v), d = av * 0.2316418882f + 1.0f;
    f32x2 t; t.x = __builtin_amdgcn_rcpf(d.x); t.y = __builtin_amdgcn_rcpf(d.y);
    f32x2 q = t * 0.5307027145f + (-0.7265760135f); q = q * t + 0.7107068705f; q = q * t + (-0.142248368f); q = q * t + 0.127414796f; q = q * t;
    const f32x2 s = (v * v) * (-0.72134752044f);
    f32x2 e; e.x = __builtin_amdgcn_exp2f(s.x); e.y = __builtin_amdgcn_exp2f(s.y);
    const f32x2 m = v * (q * e), r = v - m;
    f32x2 o; o.x = v.x < 0.f ? m.x : r.x; o.y = v.y < 0.f ? m.y : r.y; return o;
}

template <int ACT  > struct EpiBf16 {
    static constexpr bool PERM = true, AFTER_DRAIN = false, HEAD64 = false; static_assert(ACT == 0 || ACT == 1 || ACT == 2, "EpiBf16: ACT is 0 (none), 1 (gelu_pk) or 2 (sigmoid)");
    bf16_t* O; int ldc; const float* bias; int split_cols; size_t split_stride; float scale0;
    __device__ __forceinline__ void operator()(const f32x4 (&acc)[2][2][4][2], const Unit& u, int wr, int wc, int fr, int fq) const {
        const int row0 = u.pm * BM + wr * 64 + fr; int colt = u.pn * BM; bf16_t* base = O;
        float sc = 1.f; if (split_cols) { const int t = colt / split_cols; base += (size_t)t * split_stride; colt -= t * split_cols; if (t == 0) sc = scale0; }
        const int col0 = colt + wc * 32 + 8 * fq, bcol0 = u.pn * BM + wc * 32 + 8 * fq;
        f32x4 bv[2][2];
#pragma unroll
        for (int bj = 0; bj < 2; ++bj)
#pragma unroll
            for (int n = 0; n < 2; ++n) bv[bj][n] = bias ? *(const f32x4*)(bias + bcol0 + bj * HALF + 4 * n) : (f32x4){0.f, 0.f, 0.f, 0.f};
#pragma unroll
        for (int ai = 0; ai < 2; ++ai)
#pragma unroll
            for (int m = 0; m < 4; ++m) { bf16_t* rowp = base + (size_t)(row0 + ai * HALF + m * 16) * ldc + col0;
#pragma unroll
                for (int bj = 0; bj < 2; ++bj) { f32x4 v0 = acc[ai][bj][m][0] + bv[bj][0], v1 = acc[ai][bj][m][1] + bv[bj][1];
                    if (ACT == 1) { f32x2 a = gelu_pk((f32x2){v0[0], v0[1]}), b = gelu_pk((f32x2){v0[2], v0[3]}), c = gelu_pk((f32x2){v1[0], v1[1]}), d = gelu_pk((f32x2){v1[2], v1[3]});
                        v0 = (f32x4){a.x, a.y, b.x, b.y}; v1 = (f32x4){c.x, c.y, d.x, d.y}; }
                    if (ACT == 2) { _Pragma("unroll") for (int e_ = 0; e_ < 4; ++e_) { v0[e_] = __builtin_amdgcn_rcpf(1.0f + __builtin_amdgcn_exp2f(-1.4426950408889634f * v0[e_])); v1[e_] = __builtin_amdgcn_rcpf(1.0f + __builtin_amdgcn_exp2f(-1.4426950408889634f * v1[e_])); } }
                    v0 = v0 * sc; v1 = v1 * sc; u32x4 w; w.x = cvt_pk_bf16(v0[0], v0[1]); w.y = cvt_pk_bf16(v0[2], v0[3]); w.z = cvt_pk_bf16(v1[0], v1[1]); w.w = cvt_pk_bf16(v1[2], v1[3]);
                    *(u32x4*)(rowp + bj * HALF) = w; } }
    }
};


struct GOrder {
    int nM, nN, nwg, G, c;
    __host__ __device__ void init(int M, int N, int G_, int c_) { nM = M / BM; nN = N / BM; nwg = nM * nN; G = G_; c = c_; }
    __host__ __device__ bool next(int i, Unit& u) const {
        if (c < 0) return false;
        const long L = (long)i * G + c; if (L >= nwg) return false;
        int wgid = (int)L; { const int q = nwg / NXCD, r = nwg % NXCD, xcd = wgid % NXCD, off = wgid / NXCD; wgid = (xcd < r ? xcd * (q + 1) : r * (q + 1) + (xcd - r) * q) + off; }
        const int nig = WGM * nN, gid = wgid / nig, fm = gid * WGM, gsz = (nM - fm) < WGM ? (nM - fm) : WGM;
        u.pm = fm + ((wgid % nig) % gsz); u.pn = (wgid % nig) / gsz; return true;
    }
    __device__ __forceinline__ void a_ready(const Unit&) const {}
    __device__ __forceinline__ void done(const Unit&) const {}
};
struct BranchOrder {
    GOrder g;
    __device__ void init(int G, int c) { g.init(16384, 1024, G, c); }
#if defined(PROBE_P4X2)
    __device__ bool next(int i, Unit& u) const { Unit t; if (i >= 6 || !g.next(0, t)) return false; const int br = i % 3; u.pm = 64 * br + t.pm; u.pn = 4 * br + t.pn; return true; }
#else
    __device__ bool next(int i, Unit& u) const { Unit t; if (!g.next(i / 3, t)) return false; const int br = i % 3; u.pm = 64 * br + t.pm; u.pn = 4 * br + t.pn; return true; }
#endif
    __device__ __forceinline__ void a_ready(const Unit&) const {}
    __device__ __forceinline__ void done(const Unit&) const {}
};
__device__ __forceinline__ float bf_lo(unsigned w) { return __builtin_bit_cast(float, w << 16); }
__device__ __forceinline__ float bf_hi(unsigned w) { return __builtin_bit_cast(float, w & 0xffff0000u); }
__device__ __forceinline__ float sigmoid_f(float x) { return __builtin_amdgcn_rcpf(1.0f + __builtin_amdgcn_exp2f(-1.4426950408889634f * x)); }
struct EpiProj {
    static constexpr bool PERM = true, AFTER_DRAIN = false, HEAD64 = true;
    bf16_t* PA; bf16_t* PG; const float* gq; const float* gk; float* KMEAN; float qscale, eps; const float* SA; const float* SB;
    __device__ __forceinline__ void operator()(const f32x4 (&acc)[2][2][4][2], const Unit& u, int wr, int wc, int fr, int fq) const {
        f32x4 sbv[2][2];
        { const float* sp = SB + u.pn * BM + wc * 64 + 8 * fq;
#pragma unroll
          for (int bj = 0; bj < 2; ++bj)
#pragma unroll
              for (int n = 0; n < 2; ++n) sbv[bj][n] = *(const f32x4*)(sp + 32 * bj + 4 * n); }
#define EPQ(ai, bj, m, n, sa) ({ const i32x4 a_ = __builtin_bit_cast(i32x4, acc[ai][bj][m][n]); const f32x4 s_ = sbv[bj][n] * (sa); (f32x4){(float)a_[0] * s_[0], (float)a_[1] * s_[1], (float)a_[2] * s_[2], (float)a_[3] * s_[3]}; })
        const bool gate = u.pn >= 14; const int mode = u.pn < 2 ? 1 : (u.pn < 4 ? 2 : 0);
        bf16_t* base = gate ? PG : PA; const int ldc = gate ? 3072 : 3584; const int colt = gate ? (u.pn - 14) * BM : u.pn * BM;
        const int row0 = u.pm * BM + wr * 64 + fr, col0 = colt + wc * 64 + 8 * fq;
        f32x4 gn[2][2]; f32x4 cs[2][2];
#pragma unroll
        for (int bj = 0; bj < 2; ++bj)
#pragma unroll
            for (int n = 0; n < 2; ++n) { cs[bj][n] = (f32x4){0.f, 0.f, 0.f, 0.f}; gn[bj][n] = (f32x4){1.f, 1.f, 1.f, 1.f};
                if (mode) { const float* gp = (mode == 1 ? gq : gk) + 32 * bj + 8 * fq + 4 * n; const float sc = mode == 1 ? qscale : 1.0f; gn[bj][n] = (f32x4){gp[0] * sc, gp[1] * sc, gp[2] * sc, gp[3] * sc}; } }
#pragma unroll
        for (int ai = 0; ai < 2; ++ai)
#pragma unroll
            for (int m = 0; m < 4; ++m) { bf16_t* rowp = base + (size_t)(row0 + ai * HALF + m * 16) * ldc + col0;
                const float sa = SA[row0 + ai * HALF + m * 16];
                float r = 1.f;
                if (mode) { float ss = 0.f;
#pragma unroll
                    for (int bj = 0; bj < 2; ++bj)
#pragma unroll
                        for (int n = 0; n < 2; ++n) { const f32x4 v = EPQ(ai, bj, m, n, sa); ss += (v[0] * v[0] + v[1] * v[1]) + (v[2] * v[2] + v[3] * v[3]); }
                    ss += __shfl_xor(ss, 16); ss += __shfl_xor(ss, 32);
                    r = 1.0f / sqrtf(ss * (1.f / 64.f) + eps); }
#pragma unroll
                for (int bj = 0; bj < 2; ++bj) { f32x4 v0 = EPQ(ai, bj, m, 0, sa), v1 = EPQ(ai, bj, m, 1, sa);
                    if (gate) {
#pragma unroll
                        for (int e = 0; e < 4; ++e) { v0[e] = sigmoid_f(v0[e]); v1[e] = sigmoid_f(v1[e]); } }
                    if (mode) { v0 = v0 * r * gn[bj][0]; v1 = v1 * r * gn[bj][1]; if (mode == 2) { cs[bj][0] += v0; cs[bj][1] += v1; } }
                    if (gate) {
                        typedef unsigned u32x2g __attribute__((ext_vector_type(2))); unsigned q[8];
#pragma unroll
                        for (int e = 0; e < 4; ++e) { q[e] = (unsigned)__builtin_rintf(v0[e] * 255.f); q[4 + e] = (unsigned)__builtin_rintf(v1[e] * 255.f); }
                        u32x2g wq; wq.x = q[0] | (q[1] << 8) | (q[2] << 16) | (q[3] << 24); wq.y = q[4] | (q[5] << 8) | (q[6] << 16) | (q[7] << 24);
                        *(u32x2g*)((unsigned char*)PG + (size_t)(row0 + ai * HALF + m * 16) * 3072 + col0 + bj * 32) = wq;
                    } else {
                    u32x4 w; w.x = cvt_pk_bf16(v0[0], v0[1]); w.y = cvt_pk_bf16(v0[2], v0[3]); w.z = cvt_pk_bf16(v1[0], v1[1]); w.w = cvt_pk_bf16(v1[2], v1[3]);
                    *(u32x4*)(rowp + bj * 32) = w; } } }
        if (mode == 2) {
            const int b = u.pm >> 3, nb = u.pm & 7, head = (u.pn - 2) * 4 + wc;
            float* km = KMEAN + (size_t)((b * 8 + head) * 8 + nb) * 64 + 8 * fq;
#pragma unroll
            for (int bj = 0; bj < 2; ++bj)
#pragma unroll
                for (int n = 0; n < 2; ++n)
#pragma unroll
                    for (int e = 0; e < 4; ++e) { float s = cs[bj][n][e];
                        s += __shfl_xor(s, 1); s += __shfl_xor(s, 2); s += __shfl_xor(s, 4); s += __shfl_xor(s, 8);
                        if (fr == 0) atomicAdd(km + 32 * bj + 4 * n + e, s * (1.f / 256.f)); }
        }
    }
};
struct EpiBranch {
    static constexpr bool PERM = true, AFTER_DRAIN = false, HEAD64 = false;
    const bf16_t* PG; bf16_t* MG;
    __device__ __forceinline__ void operator()(const f32x4 (&acc)[2][2][4][2], const Unit& u, int wr, int wc, int fr, int fq) const {
        const int br = u.pm >> 6, tm = u.pm & 63, tn = u.pn & 3;
        const int row0 = tm * BM + wr * 64 + fr, col0 = tn * BM + wc * 32 + 8 * fq;
#pragma unroll
        for (int ai = 0; ai < 2; ++ai) {
            typedef unsigned u32x2g __attribute__((ext_vector_type(2)));
            u32x2g g[4][2]; u32x4 p[4][2];
#pragma unroll
            for (int m = 0; m < 4; ++m)
#pragma unroll
                for (int bj = 0; bj < 2; ++bj) { const size_t row = (size_t)(row0 + ai * HALF + m * 16); const int col = col0 + bj * HALF;
                    g[m][bj] = *(const u32x2g*)((const unsigned char*)PG + row * 3072 + br * 1024 + col);
                    p[m][bj] = (br > 0) ? *(const u32x4*)(MG + row * 1024 + col) : (u32x4){0u, 0u, 0u, 0u}; }
#pragma unroll
            for (int m = 0; m < 4; ++m)
#pragma unroll
                for (int bj = 0; bj < 2; ++bj) { const size_t row = (size_t)(row0 + ai * HALF + m * 16); const int col = col0 + bj * HALF;
                    const u32x2g gg = g[m][bj]; const u32x4 pp = p[m][bj]; constexpr float GS = 1.f / 255.f;
                    f32x4 v0 = acc[ai][bj][m][0], v1 = acc[ai][bj][m][1];
                    v0[0] = v0[0] * ((float)(gg.x & 0xffu) * GS) + bf_lo(pp.x); v0[1] = v0[1] * ((float)((gg.x >> 8) & 0xffu) * GS) + bf_hi(pp.x); v0[2] = v0[2] * ((float)((gg.x >> 16) & 0xffu) * GS) + bf_lo(pp.y); v0[3] = v0[3] * ((float)(gg.x >> 24) * GS) + bf_hi(pp.y);
                    v1[0] = v1[0] * ((float)(gg.y & 0xffu) * GS) + bf_lo(pp.z); v1[1] = v1[1] * ((float)((gg.y >> 8) & 0xffu) * GS) + bf_hi(pp.z); v1[2] = v1[2] * ((float)((gg.y >> 16) & 0xffu) * GS) + bf_lo(pp.w); v1[3] = v1[3] * ((float)(gg.y >> 24) * GS) + bf_hi(pp.w);
                    u32x4 w; w.x = cvt_pk_bf16(v0[0], v0[1]); w.y = cvt_pk_bf16(v0[2], v0[3]); w.z = cvt_pk_bf16(v1[0], v1[1]); w.w = cvt_pk_bf16(v1[2], v1[3]);
                    *(u32x4*)(MG + row * 1024 + col) = w; }
        }
    }
};
struct EpiWout {
    static constexpr bool PERM = false, AFTER_DRAIN = false, HEAD64 = false;
    const float* X; float* H; bf16_t* HB; float* SL;
    __device__ __forceinline__ void operator()(const f32x4 (&acc)[2][2][4][2], const Unit& u, int wr, int wc, int fr, int fq) const {
        typedef unsigned u32x2v __attribute__((ext_vector_type(2)));
        const int row0 = u.pm * BM + wr * 64 + fr, col0 = u.pn * BM + wc * 32 + 4 * fq;
#pragma unroll
        for (int ai = 0; ai < 2; ++ai)
#pragma unroll
            for (int mh = 0; mh < 2; ++mh) {
                f32x4 xv[2][2][2];
#pragma unroll
                for (int mm = 0; mm < 2; ++mm)
#pragma unroll
                    for (int bj = 0; bj < 2; ++bj)
#pragma unroll
                        for (int n = 0; n < 2; ++n) xv[mm][bj][n] = *(const f32x4*)(X + (size_t)(row0 + ai * HALF + (2 * mh + mm) * 16) * 1024 + col0 + bj * HALF + n * 16);
#pragma unroll
                for (int mm = 0; mm < 2; ++mm) { const int m = 2 * mh + mm; const size_t row = (size_t)(row0 + ai * HALF + m * 16); float ss = 0.f;
#pragma unroll
                    for (int bj = 0; bj < 2; ++bj)
#pragma unroll
                        for (int n = 0; n < 2; ++n) { const size_t off = row * 1024 + col0 + bj * HALF + n * 16;
                            const f32x4 hv = xv[mm][bj][n] + acc[ai][bj][m][n];
                            ss += (hv[0] * hv[0] + hv[1] * hv[1]) + (hv[2] * hv[2] + hv[3] * hv[3]);
                            u32x2v w; w.x = cvt_pk_bf16(hv[0], hv[1]); w.y = cvt_pk_bf16(hv[2], hv[3]);
                            *(u32x2v*)(HB + off) = w; }
                    ss += __shfl_xor(ss, 16); ss += __shfl_xor(ss, 32);
                    if (fq == 0) SL[row * 16 + u.pn * 4 + wc] = ss; }
            }
    }
};
template <class Epi, class Sched, bool ALIGN_EPI = false, bool SP2 = false, bool I8 = false>
__device__ __forceinline__ void gemm_phase(PG8_LAS unsigned char* lds, const Gemm g, const Sched& S, const Epi& E) {
    const int tid = threadIdx.x, wid = __builtin_amdgcn_readfirstlane(tid >> 6), lane = tid & 63, wr = wid >> 2, wc = wid & 3, fr = lane & 15, fq = lane >> 4;
    const int K = g.K, nt = K / BK;
    unsigned voffA[2], voffB[2];
#pragma unroll
    for (int i = 0; i < 2; ++i) { int R, C; stage_rc(tid * 16 + i * 8192, R, C); const int Rb = Epi::HEAD64 ? (64 * (R >> 5) + perm32(R & 31)) : (Epi::PERM ? ((R & ~31) + perm32(R & 31)) : R);
        voffA[i] = (unsigned)(R * K + C) * 2u; voffB[i] = (unsigned)(Rb * K + C) * 2u; }
    const size_t kstep = (size_t)(BK * 2);
    const size_t hstep = (size_t)HALF * K * 2;
    const size_t hstepB = Epi::HEAD64 ? (size_t)32 * K * 2 : hstep;
    const size_t tstep = 2 * hstep;
    const unsigned ldsw = (unsigned)wid * 1024u;
    const int aoff = lds_byte(wr * 64 + fr, fq * 8), boff = lds_byte(wc * 32 + fr, fq * 8);
#define PG8_SA(b, h) (((b) * 2 + (h)) * HTB)
#define PG8_SB(b, h) ((4 + (b) * 2 + (h)) * HTB)
#define PG8_STAGE(bufoff, gbase, voff) do { _Pragma("unroll") for (int _i = 0; _i < 2; ++_i) \
        __builtin_amdgcn_global_load_lds((const unsigned*)((const char*)(gbase) + (voff)[_i]), (PG8_LAS unsigned*)(lds + (bufoff) + ldsw + _i * 8192), 16, 0, 0); } while (0)
#define PG8_LDA(dst, b, h) do { _Pragma("unroll") for (int m = 0; m < 4; ++m) _Pragma("unroll") for (int k = 0; k < 2; ++k) dst[m][k] = *(const PG8_LAS bf16x8*)(lds + PG8_SA(b, h) + aoff + m * 2048 + k * 1024); } while (0)
#define PG8_LDB(dst, b, h) do { _Pragma("unroll") for (int n = 0; n < 2; ++n) _Pragma("unroll") for (int k = 0; k < 2; ++k) dst[n][k] = *(const PG8_LAS bf16x8*)(lds + PG8_SB(b, h) + boff + n * 2048 + k * 1024); } while (0)
#define PG8_MMA(ai, bj, At, Bt) do { __builtin_amdgcn_s_setprio(1); _Pragma("unroll") for (int m = 0; m < 4; ++m) _Pragma("unroll") for (int n = 0; n < 2; ++n) _Pragma("unroll") for (int k = 0; k < 2; ++k) \
        { if constexpr (I8) acc[ai][bj][m][n] = __builtin_bit_cast(f32x4, __builtin_amdgcn_mfma_i32_16x16x64_i8(__builtin_bit_cast(i32x4, Bt[n][k]), __builtin_bit_cast(i32x4, At[m][k]), __builtin_bit_cast(i32x4, acc[ai][bj][m][n]), 0, 0, 0)); \
          else acc[ai][bj][m][n] = __builtin_amdgcn_mfma_f32_16x16x32_bf16(Bt[n][k], At[m][k], acc[ai][bj][m][n], 0, 0, 0); } __builtin_amdgcn_s_setprio(0); } while (0)
#define PG8_WAIT_V(n) asm volatile("s_waitcnt vmcnt(" #n ")" ::: "memory")
#define PG8_WAIT_L(n) asm volatile("s_waitcnt lgkmcnt(" #n ")" ::: "memory")
#define PG8_BAR __builtin_amdgcn_s_barrier()
#define PG8_SCHED __builtin_amdgcn_sched_barrier(0)
    Unit cur, nxt; int ui = 0;
    if (!S.next(0, cur)) return;
    f32x4 acc[2][2][4][2];
#pragma unroll
    for (int a = 0; a < 2; ++a)
#pragma unroll
        for (int b = 0; b < 2; ++b)
#pragma unroll
            for (int m = 0; m < 4; ++m)
#pragma unroll
                for (int n = 0; n < 2; ++n) acc[a][b][m][n] = (f32x4){0.f, 0.f, 0.f, 0.f};
    bf16x8 At[4][2], B0[2][2], B1[2][2];
    const char* cA = (const char*)g.A + (size_t)cur.pm * tstep; const char* cB = (const char*)g.Bt + (size_t)cur.pn * tstep;
    S.a_ready(cur);
    if constexpr (SP2) {
        PG8_STAGE(PG8_SB(0, 0), cB, voffB); PG8_STAGE(PG8_SB(0, 1), cB + hstepB, voffB); PG8_STAGE(PG8_SA(0, 0), cA, voffA); PG8_STAGE(PG8_SA(0, 1), cA + hstep, voffA);
        if (wr == 1) PG8_BAR;
        PG8_WAIT_V(2); PG8_BAR;
        PG8_STAGE(PG8_SB(1, 0), cB + kstep, voffB); PG8_STAGE(PG8_SA(1, 0), cA + kstep, voffA); PG8_STAGE(PG8_SB(1, 1), cB + hstepB + kstep, voffB);
        PG8_WAIT_V(6); PG8_BAR;
    } else {
        PG8_STAGE(PG8_SB(0, 0), cB, voffB); PG8_STAGE(PG8_SA(0, 0), cA, voffA); PG8_STAGE(PG8_SB(0, 1), cB + hstepB, voffB); PG8_STAGE(PG8_SA(0, 1), cA + hstep, voffA);
        if (wr == 1) PG8_BAR;
        PG8_WAIT_V(4); PG8_BAR;
        PG8_STAGE(PG8_SB(1, 0), cB + kstep, voffB); PG8_STAGE(PG8_SA(1, 0), cA + kstep, voffA); PG8_STAGE(PG8_SB(1, 1), cB + hstepB + kstep, voffB);
        PG8_WAIT_V(6); PG8_BAR;
    }
    for (;;) {
        const bool has_next = S.next(ui + 1, nxt);
        const char* nA = has_next ? (const char*)g.A + (size_t)nxt.pm * tstep : cA; const char* nB = has_next ? (const char*)g.Bt + (size_t)nxt.pn * tstep : cB;
        for (int t = 0; t < nt; t += 2) {
            const bool last = (t == nt - 2);
            const char* a1 = cA + (size_t)(t + 1) * kstep;
            const char* a2 = last ? nA : cA + (size_t)(t + 2) * kstep; const char* b2 = last ? nB : cB + (size_t)(t + 2) * kstep;
            const char* a3 = a2 + kstep; const char* b3 = b2 + kstep;
            if (last && has_next) S.a_ready(nxt);
            if constexpr (SP2) {
            PG8_LDB(B0, 0, 0); PG8_LDB(B1, 0, 1); PG8_SCHED; PG8_LDA(At, 0, 0); PG8_STAGE(PG8_SA(1, 1), a1 + hstep, voffA);
            PG8_WAIT_V(8); PG8_WAIT_L(0); PG8_BAR; PG8_MMA(0, 0, At, B0); PG8_MMA(0, 1, At, B1); PG8_BAR; PG8_SCHED;
            PG8_LDA(At, 0, 1); PG8_STAGE(PG8_SB(0, 0), b2, voffB); PG8_STAGE(PG8_SB(0, 1), b2 + hstepB, voffB); PG8_STAGE(PG8_SA(0, 0), a2, voffA);
            PG8_WAIT_V(8); PG8_WAIT_L(0); PG8_BAR; PG8_MMA(1, 0, At, B0); PG8_MMA(1, 1, At, B1); PG8_BAR; PG8_SCHED;
            PG8_LDB(B0, 1, 0); PG8_LDB(B1, 1, 1); PG8_SCHED; PG8_LDA(At, 1, 0); PG8_STAGE(PG8_SA(0, 1), a2 + hstep, voffA);
            PG8_WAIT_V(8); PG8_WAIT_L(0); PG8_BAR; PG8_MMA(0, 0, At, B0); PG8_MMA(0, 1, At, B1); PG8_BAR; PG8_SCHED;
            PG8_LDA(At, 1, 1); PG8_STAGE(PG8_SB(1, 0), b3, voffB); PG8_STAGE(PG8_SB(1, 1), b3 + hstepB, voffB); PG8_STAGE(PG8_SA(1, 0), a3, voffA);
            PG8_WAIT_V(8); PG8_WAIT_L(0); PG8_BAR; PG8_MMA(1, 0, At, B0); PG8_MMA(1, 1, At, B1); PG8_BAR; PG8_SCHED;
            } else {
            PG8_LDB(B0, 0, 0); PG8_SCHED; PG8_LDA(At, 0, 0); PG8_STAGE(PG8_SA(1, 1), a1 + hstep, voffA);
            PG8_WAIT_L(8); PG8_BAR; PG8_WAIT_L(0); PG8_MMA(0, 0, At, B0); PG8_BAR; PG8_SCHED;
            PG8_LDB(B1, 0, 1); PG8_STAGE(PG8_SB(0, 0), b2, voffB);
            PG8_BAR; PG8_WAIT_L(0); PG8_MMA(0, 1, At, B1); PG8_BAR;
            PG8_LDA(At, 0, 1); PG8_STAGE(PG8_SA(0, 0), a2, voffA);
            PG8_BAR; PG8_WAIT_L(0); PG8_MMA(1, 0, At, B0); PG8_BAR; PG8_SCHED;
            PG8_STAGE(PG8_SB(0, 1), b2 + hstepB, voffB);
            PG8_WAIT_V(6); PG8_BAR; PG8_MMA(1, 1, At, B1); PG8_BAR;
            PG8_LDB(B0, 1, 0); PG8_SCHED; PG8_LDA(At, 1, 0); PG8_STAGE(PG8_SA(0, 1), a2 + hstep, voffA);
            PG8_WAIT_L(8); PG8_BAR; PG8_WAIT_L(0); PG8_MMA(0, 0, At, B0); PG8_BAR; PG8_SCHED;
            PG8_LDB(B1, 1, 1); PG8_STAGE(PG8_SB(1, 0), b3, voffB);
            PG8_BAR; PG8_WAIT_L(0); PG8_MMA(0, 1, At, B1); PG8_BAR;
            PG8_LDA(At, 1, 1); PG8_STAGE(PG8_SA(1, 0), a3, voffA);
            PG8_BAR; PG8_WAIT_L(0); PG8_MMA(1, 0, At, B0); PG8_BAR; PG8_SCHED;
            PG8_STAGE(PG8_SB(1, 1), b3 + hstepB, voffB);
            PG8_WAIT_V(6); PG8_BAR; PG8_MMA(1, 1, At, B1); PG8_BAR;
            }
        }
        if constexpr (ALIGN_EPI) { if (wr == 0) PG8_BAR; }
        if constexpr (!Epi::AFTER_DRAIN) { E(acc, cur, wr, wc, fr, fq); S.done(cur); }
        if (!has_next) break;
#pragma unroll
        for (int a = 0; a < 2; ++a)
#pragma unroll
            for (int b = 0; b < 2; ++b)
#pragma unroll
                for (int m = 0; m < 4; ++m)
#pragma unroll
                    for (int n = 0; n < 2; ++n) acc[a][b][m][n] = (f32x4){0.f, 0.f, 0.f, 0.f};
        cur = nxt; cA = nA; cB = nB; ++ui;
        if constexpr (ALIGN_EPI) { if (wr == 1) PG8_BAR; }
    }
    PG8_WAIT_V(0);
    if constexpr (!ALIGN_EPI) { if (wr == 0) PG8_BAR; }
    PG8_BAR;
    if constexpr (Epi::AFTER_DRAIN) { E.fused(acc, cur, wr, wc, fr, fq, lds, wid, lane); S.done(cur); }
#undef PG8_SA
#undef PG8_SB
#undef PG8_STAGE
#undef PG8_LDA
#undef PG8_LDB
#undef PG8_MMA
#undef PG8_WAIT_V
#undef PG8_WAIT_L
#undef PG8_BAR
#undef PG8_SCHED
}
}

constexpr int NWAVES = 8;
constexpr int T = 16384, DM = 1024, SEQ = 2048, NBATCH = 8, MEMLEN = 256;
constexpr int PW = 6656, PAW = 3584, PGW = 3072;
constexpr int COL_QA = 0, COL_KA = 512, COL_VA = 1024, COL_UC = 1536, COL_BC = 2048, COL_CC = 2560, COL_QX = 3072;
constexpr float RMS_EPS = 1e-6f, LOG2E = 1.4426950408889634f;
constexpr float C2A = 0.125f * LOG2E;
constexpr float C2X = 0.08838834764831845f * LOG2E;
constexpr int NEXP = 16384;

constexpr size_t MiB = 1u << 20;
constexpr size_t WS_CTL = 0, CTL_ZERO_BYTES = 1 * MiB;
constexpr size_t WS_WIN = 1 * MiB;
constexpr size_t WS_WKV = 14 * MiB;
constexpr size_t WS_WBR = 16 * MiB;
constexpr size_t WS_WOUT = 19 * MiB;
constexpr size_t WS_WQ = 21 * MiB;
constexpr size_t WS_SK = 25 * MiB;
constexpr size_t WS_TAB = 25 * MiB + 512 * 1024;
constexpr size_t WS_KMEAN = WS_CTL + 256 * 1024;
constexpr size_t WS_MEMN = 26 * MiB;
constexpr size_t WS_KVM = 30 * MiB;
constexpr size_t WS_SLOTS = 34 * MiB;
constexpr size_t WS_SEL = 35 * MiB;
constexpr size_t WS_SU = 43 * MiB, WS_SV = 43 * MiB + 65536, WS_SX = 43 * MiB + 2 * 65536, WS_CS = 43 * MiB + 3 * 65536, WS_CM = 43 * MiB + 4 * 65536, WS_XS = 43 * MiB + 5 * 65536, WS_SA = 43 * MiB + 6 * 65536, WS_SB = 43 * MiB + 7 * 65536;
constexpr size_t WS_PA = 44 * MiB;
constexpr size_t WS_PG = 156 * MiB;
constexpr size_t WS_END = 252 * MiB;
constexpr size_t PA_MERGED = WS_PA, PA_HB = WS_PA + 32 * MiB, PA_UT = WS_PA + 64 * MiB, PA_VT = WS_PA;
constexpr size_t PG_QRY = WS_PG, PG_PART = WS_PG, PG_COEF = WS_PG + 64 * MiB, PA_XQ = WS_PG + 80 * MiB;
constexpr int CW_QU = 8192, CW_QV = 8192 + 2048, CW_RANK = 8192 + 4096 + 8192;
constexpr int CW_BAR = 4096;

constexpr int RING_OFF = 0, RING_BYTES = 131072;
constexpr int LDSCTL_OFF = RING_BYTES, MISC_OFF = LDSCTL_OFF + 320;
constexpr int LDS_BYTES = 147456;

#define GAS __attribute__((address_space(1)))
#define LAS __attribute__((address_space(3)))
typedef unsigned short bf16;
typedef unsigned v4u __attribute__((ext_vector_type(4)));
typedef unsigned v2u __attribute__((ext_vector_type(2)));
typedef float f32x4 __attribute__((ext_vector_type(4)));
typedef float f32x16 __attribute__((ext_vector_type(16)));
typedef short bf16x8 __attribute__((ext_vector_type(8)));
typedef short s16x4 __attribute__((ext_vector_type(4)));
typedef GAS unsigned gu32;
#define RLX_AGENT __ATOMIC_RELAXED, __HIP_MEMORY_SCOPE_AGENT
#define LDS_WAIT() asm volatile("s_waitcnt lgkmcnt(0)" ::: "memory")
#define VM_WAIT() asm volatile("s_waitcnt vmcnt(0)" ::: "memory")
__device__ __forceinline__ unsigned f2bf(float f) { unsigned u = __builtin_bit_cast(unsigned, f); return (u + 0x7fffu + ((u >> 16) & 1u)) >> 16; }
__device__ __forceinline__ unsigned pk2(float lo, float hi) { return f2bf(lo) | (f2bf(hi) << 16); }
__device__ __forceinline__ float bflo(unsigned w) { return __builtin_bit_cast(float, w << 16); }
__device__ __forceinline__ float bfhi(unsigned w) { return __builtin_bit_cast(float, w & 0xffff0000u); }
__device__ __forceinline__ float wave_sum(float v) {
#pragma unroll
    for (int o = 1; o < 64; o <<= 1) v += __shfl_xor(v, o);
    return v;
}
#define XB_TMO      128
#define XB_XCNT(j)  (256  + 64 * (j))
#define XB_XSUB(j)  (1280 + 64 * (j))
#define XB_XGEN(j)  (2304 + 64 * (j))
#define XB_TOP      3328
#define XB_TOPGEN   3392
#define XCD_BAR_WORDS 3456
#define XB_SPIN_CAP (1u << 18)

__device__ __forceinline__ unsigned xb_ld(unsigned* p)              { return __hip_atomic_load(p, __ATOMIC_RELAXED, __HIP_MEMORY_SCOPE_AGENT); }
__device__ __forceinline__ unsigned xb_add(unsigned* p, unsigned v) { return __hip_atomic_fetch_add(p, v, __ATOMIC_RELAXED, __HIP_MEMORY_SCOPE_AGENT); }
__device__ __forceinline__ unsigned xb_xcc_id() { return (unsigned)__builtin_amdgcn_s_getreg((3 << 11) | 20) & 0xFu; }
#define XB_SPIN(cond, bar) do { unsigned _sp = 0; while (cond) { __builtin_amdgcn_s_sleep(1); \
    if ((++_sp & 255u) == 0u) { if (xb_ld(&(bar)[XB_TMO])) break; if (_sp > XB_SPIN_CAP) { atomicAdd(&(bar)[XB_TMO], 1u); break; } } } } while (0)

struct XcdBarrier {
    unsigned* bar; unsigned x;
    volatile LAS unsigned* st;
};

__device__ __forceinline__ XcdBarrier xcd_barrier_post(unsigned* bar, volatile LAS unsigned* st) {
    XcdBarrier b; b.bar = bar; b.x = xb_xcc_id(); b.st = st;
    if (threadIdx.x == 0) (void)xb_add(&bar[XB_XCNT(b.x)], 1u);
    return b;
}
__device__ __forceinline__ void xcd_barrier_complete(unsigned* bar, unsigned x, unsigned& nloc, unsigned& nx) {
    const unsigned G = gridDim.x * gridDim.y * gridDim.z;
    unsigned sum, cnt, mine, sp = 0u;
    for (;;) {
        sum = 0u; cnt = 0u; mine = 0u;
#pragma unroll
        for (unsigned j = 0; j < 16; ++j) { const unsigned c = xb_ld(&bar[XB_XCNT(j)]); sum += c; cnt += (c > 0u) ? 1u : 0u; mine = (j == x) ? c : mine; }
        if (sum == G) break;
        __builtin_amdgcn_s_sleep(1);
        if ((++sp & 255u) == 0u) { if (xb_ld(&bar[XB_TMO])) break; if (sp > XB_SPIN_CAP) { atomicAdd(&bar[XB_TMO], 1u); break; } }
    }
    nloc = mine > 0u ? mine : 1u; nx = cnt > 0u ? cnt : 1u;
}

__device__ __forceinline__ void xcd_barrier(const XcdBarrier& b) {
    asm volatile("s_waitcnt vmcnt(0)" ::: "memory");
    __syncthreads();
    if (threadIdx.x < 64) {
        unsigned* bar = b.bar; const unsigned l = threadIdx.x;
        unsigned gen = 0u;
        if (l == 0u) {
            __builtin_amdgcn_s_waitcnt(0);
            unsigned nloc = b.st[0], nx = b.st[1];
            if (nloc == 0u) { xcd_barrier_complete(bar, b.x, nloc, nx); b.st[0] = nloc; b.st[1] = nx; }
            const unsigned old = xb_add(&bar[XB_XSUB(b.x)], 1u);
            gen = old / nloc;
            if (old + 1u == (gen + 1u) * nloc) {
                __builtin_amdgcn_fence(__ATOMIC_RELEASE, "agent");
                asm volatile("s_waitcnt vmcnt(0)" ::: "memory");
                __hip_atomic_store(&bar[XB_XGEN(b.x)], gen + 1u, __ATOMIC_RELAXED, __HIP_MEMORY_SCOPE_AGENT);
            }
        }
        gen = (unsigned)__builtin_amdgcn_readfirstlane((int)gen);
        const unsigned target = gen + 1u;
        const unsigned cntj = l < 16u ? xb_ld(&bar[XB_XCNT(l)]) : 0u;
        unsigned sp = 0u;
        for (;;) {
            const unsigned v = (l < 16u && cntj != 0u) ? xb_ld(&bar[XB_XGEN(l)]) : target;
            if (__builtin_amdgcn_ballot_w64((int)(v - target) >= 0) == ~0ull) break;
            __builtin_amdgcn_s_sleep(1);
            if ((++sp & 255u) == 0u) { if (__builtin_amdgcn_readfirstlane((int)xb_ld(&bar[XB_TMO]))) break; if (sp > XB_SPIN_CAP) { if (l == 0u) atomicAdd(&bar[XB_TMO], 1u); break; } }
        }
        __builtin_amdgcn_fence(__ATOMIC_ACQUIRE, "agent");
        asm volatile("s_waitcnt vmcnt(0)" ::: "memory");
    }
    __syncthreads();
}

__device__ __forceinline__ void p0_transpose_item(const float* W, int K, int N, bf16* WT, int row_off, const float* ksc, LAS float* scr, int item, int lane) {
    const int nblk = N / 32, kb = item / nblk, nb = item % nblk, k0 = 64 * kb, n0 = 32 * nb;
#pragma unroll 8
    for (int i = 0; i < 32; ++i) { const int kk = 2 * i + (lane >> 5); float v = W[(size_t)(k0 + kk) * N + n0 + (lane & 31)]; if (ksc) v *= ksc[k0 + kk]; scr[kk * 33 + (lane & 31)] = v; }
    LDS_WAIT(); asm volatile("" ::: "memory");
    const int c = lane & 7;
#pragma unroll
    for (int j = 0; j < 4; ++j) { const int n = (lane >> 3) + 8 * j; const LAS float* s = scr + (8 * c) * 33 + n;
        v4u o; o.x = pk2(s[0 * 33], s[1 * 33]); o.y = pk2(s[2 * 33], s[3 * 33]); o.z = pk2(s[4 * 33], s[5 * 33]); o.w = pk2(s[6 * 33], s[7 * 33]);
        *(GAS v4u*)(WT + (size_t)(row_off + n0 + n) * K + k0 + 8 * c) = o; }
    LDS_WAIT(); asm volatile("" ::: "memory");
}
template <int NR> __device__ __forceinline__ void rms_rows_to_bf16(const float* X, const float* g, bf16* O, int m0, int ms, int mend, int lane) {
    const GAS f32x4* gr = (const GAS f32x4*)g + lane;
    f32x4 v[NR][4];
#pragma unroll
    for (int r = 0; r < NR; ++r) { const int m = (m0 + r * ms < mend) ? m0 + r * ms : mend - 1; const GAS f32x4* xr = (const GAS f32x4*)(X + (size_t)m * DM) + lane;
#pragma unroll
        for (int j = 0; j < 4; ++j) v[r][j] = xr[64 * j]; }
    f32x4 gv[4];
#pragma unroll
    for (int j = 0; j < 4; ++j) gv[j] = gr[64 * j];
#pragma unroll
    for (int r = 0; r < NR; ++r) { float s = 0.f;
#pragma unroll
        for (int j = 0; j < 4; ++j) s += (v[r][j].x * v[r][j].x + v[r][j].y * v[r][j].y) + (v[r][j].z * v[r][j].z + v[r][j].w * v[r][j].w);
        const float rr = 1.f / sqrtf(wave_sum(s) * (1.f / 1024.f) + RMS_EPS);
        if (m0 + r * ms < mend) { GAS unsigned long long* o8 = (GAS unsigned long long*)(O + (size_t)(m0 + r * ms) * DM) + lane;
#pragma unroll
            for (int j = 0; j < 4; ++j) o8[64 * j] = (unsigned long long)pk2(v[r][j].x * rr * gv[j].x, v[r][j].y * rr * gv[j].y) | ((unsigned long long)pk2(v[r][j].z * rr * gv[j].z, v[r][j].w * rr * gv[j].w) << 32); } }
}
template <int NR> __device__ __forceinline__ void rms_rows_to_i8(const float* X, const float* g, unsigned char* O, float* SA, int m0, int ms, int mend, int lane) {
    const GAS f32x4* gr = (const GAS f32x4*)g + lane;
    f32x4 v[NR][4];
#pragma unroll
    for (int r = 0; r < NR; ++r) { const int m = (m0 + r * ms < mend) ? m0 + r * ms : mend - 1; const GAS f32x4* xr = (const GAS f32x4*)(X + (size_t)m * DM) + lane;
#pragma unroll
        for (int j = 0; j < 4; ++j) v[r][j] = xr[64 * j]; }
    f32x4 gv[4];
#pragma unroll
    for (int j = 0; j < 4; ++j) gv[j] = gr[64 * j];
#pragma unroll
    for (int r = 0; r < NR; ++r) { float s = 0.f;
#pragma unroll
        for (int j = 0; j < 4; ++j) s += (v[r][j].x * v[r][j].x + v[r][j].y * v[r][j].y) + (v[r][j].z * v[r][j].z + v[r][j].w * v[r][j].w);
        const float rr = 1.f / sqrtf(wave_sum(s) * (1.f / 1024.f) + RMS_EPS);
        float am = 0.f;
#pragma unroll
        for (int j = 0; j < 4; ++j) { v[r][j] = v[r][j] * rr * gv[j]; am = fmaxf(am, fmaxf(fmaxf(fabsf(v[r][j].x), fabsf(v[r][j].y)), fmaxf(fabsf(v[r][j].z), fabsf(v[r][j].w)))); }
#pragma unroll
        for (int o = 1; o < 64; o <<= 1) am = fmaxf(am, __shfl_xor(am, o));
        const float sa = am > 0.f ? am * (1.f / 127.f) : 1.f, is = 1.f / sa;
        if (m0 + r * ms < mend) { GAS unsigned* o4 = (GAS unsigned*)(O + (size_t)(m0 + r * ms) * DM) + lane;
#pragma unroll
            for (int j = 0; j < 4; ++j) { const int a = (int)rintf(v[r][j].x * is), b = (int)rintf(v[r][j].y * is), c = (int)rintf(v[r][j].z * is), d = (int)rintf(v[r][j].w * is);
                o4[64 * j] = (unsigned)(a & 0xff) | ((unsigned)(b & 0xff) << 8) | ((unsigned)(c & 0xff) << 16) | ((unsigned)(d & 0xff) << 24); }
            if (lane == 0) SA[m0 + r * ms] = sa; } }
}
__device__ __forceinline__ void p0_quant_cols_wg(const float* W, int N, unsigned char* WT8, float* SB, LAS unsigned char* lds, int nb, int wave, int lane) {
    LAS float* scr = (LAS float*)(lds + RING_OFF + wave * 16384);
    LAS float* red = (LAS float*)(lds + RING_OFF + 8448);
    const int n0 = 32 * nb, kr = lane >> 3, nq = lane & 7;
    f32x4 v[16];
#pragma unroll
    for (int i = 0; i < 16; ++i) v[i] = *(const GAS f32x4*)(W + (size_t)(128 * wave + 8 * i + kr) * N + n0 + 4 * nq);
    f32x4 am = {0.f, 0.f, 0.f, 0.f};
#pragma unroll
    for (int i = 0; i < 16; ++i)
#pragma unroll
        for (int e = 0; e < 4; ++e) am[e] = fmaxf(am[e], fabsf(v[i][e]));
#pragma unroll
    for (int o = 8; o < 64; o <<= 1)
#pragma unroll
        for (int e = 0; e < 4; ++e) am[e] = fmaxf(am[e], __shfl_xor(am[e], o));
    if (lane < 8) *(LAS f32x4*)(red + wave * 32 + 4 * nq) = am;
    __syncthreads();
    f32x4 cm = *(const LAS f32x4*)(red + 4 * nq);
#pragma unroll
    for (int w = 1; w < 8; ++w) { const f32x4 o = *(const LAS f32x4*)(red + w * 32 + 4 * nq);
#pragma unroll
        for (int e = 0; e < 4; ++e) cm[e] = fmaxf(cm[e], o[e]); }
    f32x4 inv, sb;
#pragma unroll
    for (int e = 0; e < 4; ++e) { inv[e] = cm[e] > 0.f ? 127.f / cm[e] : 0.f; sb[e] = cm[e] > 0.f ? cm[e] * (1.f / 127.f) : 1.f; }
    if (wave == 0 && lane < 8) *(GAS f32x4*)(SB + n0 + 4 * nq) = sb;
#pragma unroll
    for (int half = 0; half < 2; ++half) {
#pragma unroll
        for (int i = 0; i < 8; ++i) { const int kk = 8 * i + kr;
#pragma unroll
            for (int e = 0; e < 4; ++e) scr[kk * 33 + 4 * nq + e] = v[8 * half + i][e] * inv[e]; }
        LDS_WAIT(); asm volatile("" ::: "memory");
        const int c = lane & 7;
#pragma unroll
        for (int j = 0; j < 4; ++j) { const int n = (lane >> 3) + 8 * j; const LAS float* s = scr + (8 * c) * 33 + n;
            unsigned q[8];
#pragma unroll
            for (int e = 0; e < 8; ++e) q[e] = (unsigned)((int)rintf(s[e * 33]) & 0xff);
            v2u o; o.x = q[0] | (q[1] << 8) | (q[2] << 16) | (q[3] << 24); o.y = q[4] | (q[5] << 8) | (q[6] << 16) | (q[7] << 24);
            *(GAS v2u*)(WT8 + (size_t)(n0 + n) * DM + 128 * wave + 64 * half + 8 * c) = o; }
        LDS_WAIT(); asm volatile("" ::: "memory");
    }
    __syncthreads();
}
__device__ __forceinline__ void cvt_row_to_bf16(const float* xrow, bf16* orow, int lane) {
    const GAS f32x4* xr = (const GAS f32x4*)xrow + lane; GAS unsigned long long* o8 = (GAS unsigned long long*)orow + lane;
    f32x4 v[4];
#pragma unroll
    for (int j = 0; j < 4; ++j) v[j] = xr[64 * j];
#pragma unroll
    for (int j = 0; j < 4; ++j) o8[64 * j] = (unsigned long long)pk2(v[j].x, v[j].y) | ((unsigned long long)pk2(v[j].z, v[j].w) << 32);
}
__device__ __forceinline__ int rel_bucket_dev(int d) {
    if (d < 16) return d;
    int b = 16;
    b += (d >= 21); b += (d >= 27); b += (d >= 35); b += (d >= 46); b += (d >= 59); b += (d >= 77); b += (d >= 99); b += (d >= 128);
    b += (d >= 166); b += (d >= 216); b += (d >= 280); b += (d >= 363); b += (d >= 470); b += (d >= 609); b += (d >= 790);
    return b;
}
struct P0Args { const float *x, *mem, *g_mix, *w_in, *rel_bias, *g_mem, *w_mem_kv, *w_br_attn, *w_br_conv, *w_br_x, *w_out, *g_ffn, *w_query, *sub_keys;
                bf16 *WinT, *WkvT, *WbrT, *WoutT, *WqT, *SK, *HN, *MEMN; float* TAB; float *SA, *SB; };
__device__ __forceinline__ void p0_transposes(const P0Args& a, LAS unsigned char* lds, int part, int gw, int NGW, int wave, int lane) {
    LAS float* scr = (LAS float*)(lds + RING_OFF + wave * 16384);
    constexpr int I_IN = (DM / 64) * (PW / 32), I_KV = (DM / 64) * (1024 / 32), I_BR = (512 / 64) * (1024 / 32), I_OUT = (DM / 64) * (1024 / 32), I_Q = (DM / 64) * (2048 / 32);
    if (part == 0) {
        for (int nb = gw / NWAVES; nb < PW / 32; nb += NGW / NWAVES) p0_quant_cols_wg(a.w_in, PW, (unsigned char*)a.WinT, a.SB, lds, nb, wave, lane);
        for (int it = gw; it < I_KV; it += NGW) p0_transpose_item(a.w_mem_kv, DM, 1024, a.WkvT, 0, nullptr, scr, it, lane);
    } else {
        for (int it = gw; it < 3 * I_BR + I_OUT + I_Q; it += NGW) {
            int r = it;
            if (r < I_BR) { p0_transpose_item(a.w_br_attn, 512, 1024, a.WbrT, 0, nullptr, scr, r, lane); continue; } r -= I_BR;
            if (r < I_BR) { p0_transpose_item(a.w_br_conv, 512, 1024, a.WbrT, 1024, nullptr, scr, r, lane); continue; } r -= I_BR;
            if (r < I_BR) { p0_transpose_item(a.w_br_x, 512, 1024, a.WbrT, 2048, nullptr, scr, r, lane); continue; } r -= I_BR;
            if (r < I_OUT) { p0_transpose_item(a.w_out, DM, 1024, a.WoutT, 0, nullptr, scr, r, lane); continue; } r -= I_OUT;
            p0_transpose_item(a.w_query, DM, 2048, a.WqT, 0, a.g_ffn, scr, r, lane);
        }
    }
}
__device__ __forceinline__ void p0_prologue(const P0Args& a, LAS unsigned char* lds, bool late_part1, int gw, int NGW, int wave, int lane) {
    for (int m = gw; m < T; m += 8 * NGW) rms_rows_to_i8<8>(a.x, a.g_mix, (unsigned char*)a.HN, a.SA, m, NGW, T, lane);
    p0_transposes(a, lds, 0, gw, NGW, wave, lane);
    if (!late_part1) p0_transposes(a, lds, 1, gw, NGW, wave, lane);
    for (int m = gw; m < NBATCH * MEMLEN; m += NGW) rms_rows_to_bf16<1>(a.mem, a.g_mem, a.MEMN, m, NGW, NBATCH * MEMLEN, lane);
    for (int m = gw; m < 256; m += NGW) cvt_row_to_bf16(a.sub_keys + (size_t)m * 1024, a.SK + (size_t)m * 1024, lane);
    for (int m = gw; m < 256; m += NGW) {
        const int idx = m * 64 + lane, h = idx >> 11, d = idx & 2047;
        a.TAB[idx] = a.rel_bias[rel_bucket_dev(d) * 8 + h] * LOG2E;
    }
}

template <int DH> __device__ __forceinline__ void fix_item(bf16* buf, size_t pitch, int row0, int col0, const float* gain, float gscale, float* kmean, LAS float* red, int wave, int lane) {
    constexpr int LPR = DH / 8, RPI = 64 / LPR, NIT = 32 / RPI;
    const int sub = lane / LPR, ch = lane % LPR;
    float g[8], cs[8];
#pragma unroll
    for (int j = 0; j < 8; ++j) { g[j] = gain[ch * 8 + j] * gscale; cs[j] = 0.f; }
    v4u w[NIT];
#pragma unroll
    for (int it = 0; it < NIT; ++it) w[it] = *(const GAS v4u*)(buf + (size_t)(row0 + wave * 32 + it * RPI + sub) * pitch + col0 + ch * 8);
#pragma unroll
    for (int it = 0; it < NIT; ++it) {
        float x[8] = {bflo(w[it].x), bfhi(w[it].x), bflo(w[it].y), bfhi(w[it].y), bflo(w[it].z), bfhi(w[it].z), bflo(w[it].w), bfhi(w[it].w)};
        float ss = 0.f;
#pragma unroll
        for (int j = 0; j < 8; ++j) ss += x[j] * x[j];
#pragma unroll
        for (int o = 1; o < LPR; o <<= 1) ss += __shfl_xor(ss, o);
        const float r = 1.f / sqrtf(ss * (1.f / DH) + RMS_EPS);
#pragma unroll
        for (int j = 0; j < 8; ++j) { x[j] = x[j] * r * g[j]; cs[j] += x[j]; }
        v4u o; o.x = pk2(x[0], x[1]); o.y = pk2(x[2], x[3]); o.z = pk2(x[4], x[5]); o.w = pk2(x[6], x[7]);
        *(GAS v4u*)(buf + (size_t)(row0 + wave * 32 + it * RPI + sub) * pitch + col0 + ch * 8) = o;
    }
    if (kmean) {
#pragma unroll
        for (int j = 0; j < 8; ++j) {
#pragma unroll
            for (int o = LPR; o < 64; o <<= 1) cs[j] += __shfl_xor(cs[j], o);
        }
        if (sub == 0) {
#pragma unroll
            for (int j = 0; j < 8; ++j) red[wave * DH + ch * 8 + j] = cs[j];
        }
        asm volatile("s_waitcnt lgkmcnt(0)\n\ts_barrier" ::: "memory");
        if (wave == 0 && lane < DH) { float s = 0.f;
#pragma unroll
            for (int w8 = 0; w8 < 8; ++w8) s += red[w8 * DH + lane];
            kmean[lane] = s * (1.f / 256.f); }
        asm volatile("s_waitcnt lgkmcnt(0)\n\ts_barrier" ::: "memory");
    }
}
__device__ __forceinline__ void p2_fixup(bf16* PA, bf16* KVM, float* KMEAN, const float* q_gain_a, const float* k_gain_a, const float* q_gain_x, const float* k_gain_x, LAS unsigned char* lds, int vcu, int G, int wave, int lane) {
    constexpr int N_A = 512, N_X = 256, N_KX = 32, NIT = 2 * N_A + N_X + N_KX;
    LAS float* red = (LAS float*)lds;
    for (int it = vcu; it < NIT; it += G) {
        int r = it;
        if (r < N_A) { const int b = r >> 6, h = (r >> 3) & 7, n = r & 7;
            fix_item<64>(PA, PAW, b * SEQ + n * 256, COL_KA + h * 64, k_gain_a, 1.0f, KMEAN + (size_t)((b * 8 + h) * 8 + n) * 64, red, wave, lane); continue; } r -= N_A;
        if (r < N_A) { const int b = r >> 6, h = (r >> 3) & 7, n = r & 7;
            fix_item<64>(PA, PAW, b * SEQ + n * 256, COL_QA + h * 64, q_gain_a, C2A, nullptr, red, wave, lane); continue; } r -= N_A;
        if (r < N_X) { const int b = r >> 5, h = (r >> 3) & 3, n = r & 7;
            fix_item<128>(PA, PAW, b * SEQ + n * 256, COL_QX + h * 128, q_gain_x, C2X, nullptr, red, wave, lane); continue; } r -= N_X;
        { const int b = r >> 2, h = r & 3;
            fix_item<128>(KVM, 1024, b * MEMLEN, h * 128, k_gain_x, 1.0f, nullptr, red, wave, lane); }
    }
}

namespace att {
constexpr int L_K = 0, L_V = 16384, L_BUF = 32768  , L_OST = 0  ,
              L_TAB = 65536, TAB_PAD = 256, L_KM = L_TAB + (TAB_PAD + 2048) * 4, L_SEL = L_KM + 2048, L_WSF = L_SEL + 1024, L_END = L_WSF + NWAVES * 256;
static_assert(L_END <= RING_BYTES, "attention LDS map");
__device__ __forceinline__ int crow(int r, int hi) { return (r & 3) + 8 * (r >> 2) + 4 * hi; }
__device__ __forceinline__ void glds16(const void* gsrc, unsigned lds_dst) { unsigned keep;
    asm volatile("s_mov_b32 %0, m0\n\ts_mov_b32 m0, %2\n\ts_nop 0\n\tglobal_load_lds_dwordx4 %1, off\n\ts_mov_b32 m0, %0" : "=&s"(keep) : "v"(gsrc), "s"(lds_dst) : "memory"); }
__device__ __forceinline__ unsigned cvtpk(float lo, float hi) { typedef float f2 __attribute__((ext_vector_type(2))); typedef __bf16 b2 __attribute__((ext_vector_type(2))); f2 v = {lo, hi}; b2 b = __builtin_convertvector(v, b2); return __builtin_bit_cast(unsigned, b); }
__device__ __forceinline__ float rowmax(const f32x16& p0, const f32x16& p1) {
    float a = fmaxf(p0[0], p1[0]);
#pragma unroll
    for (int r = 1; r < 16; ++r) a = fmaxf(a, fmaxf(p0[r], p1[r]));
    auto rr = __builtin_amdgcn_permlane32_swap(__float_as_uint(a), __float_as_uint(a), false, false);
    return fmaxf(__uint_as_float(rr[0]), __uint_as_float(rr[1]));
}
template <int ND0> __device__ __forceinline__ void qkt(f32x16& p0, f32x16& p1, const LAS unsigned char* Kslot, const bf16x8* qr, int r32, int hi) {
    const LAS unsigned char* kb = Kslot + hi * 1024 + r32 * 16;
#pragma unroll
    for (int d0 = 0; d0 < ND0; ++d0) {
        const bf16x8 b0 = *(const LAS bf16x8*)(kb + d0 * 2048);
        const bf16x8 b1 = *(const LAS bf16x8*)(kb + d0 * 2048 + 512);
        p0 = __builtin_amdgcn_mfma_f32_32x32x16_bf16(b0, qr[d0], p0, 0, 0, 0);
        p1 = __builtin_amdgcn_mfma_f32_32x32x16_bf16(b1, qr[d0], p1, 0, 0, 0);
    }
}
template <int NDB> __device__ __forceinline__ void pv(f32x16* o, int vb, bf16x8 pa0, bf16x8 pa1, bf16x8 pa2, bf16x8 pa3) {
#pragma unroll
    for (int d0 = 0; d0 < NDB; ++d0) { s16x4 lo[4], hi[4];
#pragma unroll
        for (int ks = 0; ks < 4; ++ks) {
            asm volatile("ds_read_b64_tr_b16 %0,%1 offset:%c2" : "=&v"(lo[ks]) : "v"(vb), "i"(d0 * 4096 + ks * 1024) : "memory");
            asm volatile("ds_read_b64_tr_b16 %0,%1 offset:%c2" : "=&v"(hi[ks]) : "v"(vb), "i"(d0 * 4096 + ks * 1024 + 512) : "memory"); }
        asm volatile("s_waitcnt lgkmcnt(0)" ::: "memory"); __builtin_amdgcn_sched_barrier(0);
#define ATT_PK(k) (bf16x8){lo[k][0], lo[k][1], lo[k][2], lo[k][3], hi[k][0], hi[k][1], hi[k][2], hi[k][3]}
        o[d0] = __builtin_amdgcn_mfma_f32_32x32x16_bf16(pa0, ATT_PK(0), o[d0], 0, 0, 0);
        o[d0] = __builtin_amdgcn_mfma_f32_32x32x16_bf16(pa1, ATT_PK(1), o[d0], 0, 0, 0);
        o[d0] = __builtin_amdgcn_mfma_f32_32x32x16_bf16(pa2, ATT_PK(2), o[d0], 0, 0, 0);
        o[d0] = __builtin_amdgcn_mfma_f32_32x32x16_bf16(pa3, ATT_PK(3), o[d0], 0, 0, 0);
#undef ATT_PK
    }
}
#define ATT_BAR() asm volatile("s_waitcnt lgkmcnt(0)\n\ts_barrier" ::: "memory")
#define ATT_WAIT_BAR() asm volatile("s_waitcnt vmcnt(0) lgkmcnt(0)\n\ts_barrier" ::: "memory")

template <int DH, bool MOBA> __device__ __forceinline__ void attn_unit(const bf16* Qp, size_t qpitch, const bf16* Kp, const bf16* Vp, size_t kpitch, bf16* Op, int qb, const float* kmean_bh, const float* tab_h, const float* gq, const float* gk,
                                                                   LAS unsigned char* lds, int tid, int wid, int lane) {
    constexpr int ND0 = DH / 16, NDB = DH / 32, NPIECE = DH / 64;
    asm volatile("" : "+v"(tid), "+v"(lane));
    const int r32 = lane & 31, hi = lane >> 5;
    const unsigned lds0 = (unsigned)(uintptr_t)lds;
    LAS float* wsf = (LAS float*)(lds + L_WSF) + wid * 64;
    ATT_BAR();
    int my_sel = 0;
    if (MOBA) {
        LAS float* tl = (LAS float*)(lds + L_TAB);
        for (int i = tid; i < TAB_PAD + 2048; i += NWAVES * 64) tl[i] = (i < TAB_PAD) ? -INFINITY : tab_h[i - TAB_PAD];
        LAS float* km = (LAS float*)(lds + L_KM);
        for (int i = tid; i < 512; i += NWAVES * 64) km[i] = kmean_bh[i];
        ATT_BAR();
        if (tid < 256) {
            int sel = 0;
            if (qb <= 3) sel = (1 << qb) - 1;
            else {
                const GAS v4u* qrow = (const GAS v4u*)(Qp + (size_t)tid * qpitch);
                v4u qw[8];
#pragma unroll
                for (int c = 0; c < 8; ++c) qw[c] = qrow[c];
                float b1 = -INFINITY, b2 = -INFINITY, b3 = -INFINITY; int i1 = 0, i2 = 0, i3 = 0;
#pragma unroll 1
                for (int n = 0; n < qb; ++n) { float s = 0.f; const LAS f32x4* kr = (const LAS f32x4*)(km + n * 64);
#pragma unroll
                    for (int c = 0; c < 8; ++c) { const f32x4 ka = kr[2 * c], kb2 = kr[2 * c + 1]; const v4u w = qw[c];
                        s += bflo(w.x) * ka.x; s += bfhi(w.x) * ka.y; s += bflo(w.y) * ka.z; s += bfhi(w.y) * ka.w;
                        s += bflo(w.z) * kb2.x; s += bfhi(w.z) * kb2.y; s += bflo(w.w) * kb2.z; s += bfhi(w.w) * kb2.w; }
                    if (s > b1) { b3 = b2; i3 = i2; b2 = b1; i2 = i1; b1 = s; i1 = n; }
                    else if (s > b2) { b3 = b2; i3 = i2; b2 = s; i2 = n; }
                    else if (s > b3) { b3 = s; i3 = n; } }
                sel = (1 << i1) | (1 << i2) | (1 << i3);
            }
            ((LAS int*)(lds + L_SEL))[tid] = sel;
        }
        ATT_BAR();
        my_sel = ((LAS int*)(lds + L_SEL))[wid * 32 + r32];
    }
    bf16x8 qr[ND0];
    { const bf16* Qw = Qp + (size_t)(wid * 32 + r32) * qpitch + hi * 8;
#pragma unroll
      for (int d0 = 0; d0 < ND0; ++d0) qr[d0] = *(const GAS bf16x8*)(Qw + d0 * 16); }
    if (!MOBA) {
        LAS float* rk = (LAS float*)(lds + L_KM);
        { const int key = tid >> 1, half = tid & 1; const GAS v4u* kr = (const GAS v4u*)(Kp + (size_t)key * kpitch + half * 64); float ss = 0.f;
#pragma unroll
          for (int c = 0; c < 8; ++c) { const v4u w = kr[c]; const float a0 = bflo(w.x), a1 = bfhi(w.x), a2 = bflo(w.y), a3 = bfhi(w.y), a4 = bflo(w.z), a5 = bfhi(w.z), a6 = bflo(w.w), a7 = bfhi(w.w);
              ss += (a0 * a0 + a1 * a1) + (a2 * a2 + a3 * a3) + (a4 * a4 + a5 * a5) + (a6 * a6 + a7 * a7); }
          ss += __shfl_xor(ss, 1);
          if (half == 0) rk[key] = 1.0f / sqrtf(ss * (1.f / 128.f) + RMS_EPS); }
        float qs = 0.f;
#pragma unroll
        for (int d0 = 0; d0 < ND0; ++d0) { const v4u w = __builtin_bit_cast(v4u, qr[d0]); const float a0 = bflo(w.x), a1 = bfhi(w.x), a2 = bflo(w.y), a3 = bfhi(w.y), a4 = bflo(w.z), a5 = bfhi(w.z), a6 = bflo(w.w), a7 = bfhi(w.w);
            qs += (a0 * a0 + a1 * a1) + (a2 * a2 + a3 * a3) + (a4 * a4 + a5 * a5) + (a6 * a6 + a7 * a7); }
        { auto rr = __builtin_amdgcn_permlane32_swap(__float_as_uint(qs), __float_as_uint(qs), false, false); qs = __uint_as_float(rr[0]) + __uint_as_float(rr[1]); }
        const float rq = C2X / sqrtf(qs * (1.f / 128.f) + RMS_EPS);
        int hi8 = hi * 8; asm volatile("" : "+v"(hi8));
#pragma unroll
        for (int d0 = 0; d0 < ND0; ++d0) { const v4u w = __builtin_bit_cast(v4u, qr[d0]);
            const f32x4 ga = *(const GAS f32x4*)(gq + d0 * 16 + hi8), gb = *(const GAS f32x4*)(gq + d0 * 16 + hi8 + 4), ka = *(const GAS f32x4*)(gk + d0 * 16 + hi8), kb2 = *(const GAS f32x4*)(gk + d0 * 16 + hi8 + 4);
            v4u o; o.x = cvtpk(bflo(w.x) * rq * ga.x * ka.x, bfhi(w.x) * rq * ga.y * ka.y); o.y = cvtpk(bflo(w.y) * rq * ga.z * ka.z, bfhi(w.y) * rq * ga.w * ka.w);
            o.z = cvtpk(bflo(w.z) * rq * gb.x * kb2.x, bfhi(w.z) * rq * gb.y * kb2.y); o.w = cvtpk(bflo(w.w) * rq * gb.z * kb2.z, bfhi(w.w) * rq * gb.w * kb2.w);
            qr[d0] = __builtin_bit_cast(bf16x8, o); }
    }
    float m_ref = 0.f, l_run = 0.f;
    constexpr float THR = 8.0f;
    float bfar = 0.f; if (MOBA) bfar = ((const LAS float*)(lds + L_TAB))[TAB_PAD + 2047];
    f32x16 o[NDB];
#pragma unroll
    for (int d = 0; d < NDB; ++d) o[d] = f32x16{};
    const int vb0 = (int)(lds0 + L_V) + ((lane >> 4) & 1) * 32 + (lane & 3) * 8 + (4 * hi + ((lane & 15) >> 2)) * 64;
    const int qrel = wid * 32 + r32;
    const int ntiles = MOBA ? 4 + 4 * qb : 4;
    constexpr int SUB = (DH == 64) ? 2 : 1;
    const int nsteps = ntiles / SUB;
    auto issue_step = [&](int st) {
#pragma unroll
        for (int sub = 0; sub < SUB; ++sub) { const int tt = st * SUB + sub;
            int kb_, j_; if (MOBA) { if (tt < 4) { kb_ = qb; j_ = tt; } else { kb_ = (tt - 4) >> 2; j_ = (tt - 4) & 3; } } else { kb_ = 0; j_ = tt; }
            const int key0_ = kb_ * 256 + j_ * 64; const unsigned bo_ = (unsigned)(st & 1) * L_BUF + (unsigned)sub * 8192u;
#pragma unroll
            for (int pc = 0; pc < NPIECE; ++pc) { const int p = wid + 8 * pc;
                glds16(Kp + (size_t)(key0_ + lane) * kpitch + p * 8, (unsigned)__builtin_amdgcn_readfirstlane(lds0 + bo_ + L_K + p * 1024));
                glds16(Vp + (size_t)(key0_ + 16 * (p & 3) + (lane >> 2)) * kpitch + (p >> 2) * 32 + (lane & 3) * 8, (unsigned)__builtin_amdgcn_readfirstlane(lds0 + bo_ + L_V + p * 1024)); } }
    };
    issue_step(0);
    for (int st = 0; st < nsteps; ++st) {
        ATT_WAIT_BAR();
        if (st + 1 < nsteps) issue_step(st + 1);
#pragma unroll 1
      for (int sub = 0; sub < SUB; ++sub) { const int tt = st * SUB + sub;
        int kb, j; bool own;
        if (MOBA) { if (tt < 4) { kb = qb; j = tt; own = true; } else { kb = (tt - 4) >> 2; j = (tt - 4) & 3; own = false; } }
        else { kb = 0; j = tt; own = false; }
        if (MOBA && own && 64 * j > wid * 32 + 31) continue;
        const unsigned bo = (unsigned)(st & 1) * L_BUF + (unsigned)sub * 8192u;
        f32x16 p0, p1;
        if (MOBA) {
            const float base = ((own || (((my_sel >> kb) & 1) != 0)) ? 0.f : -INFINITY) - m_ref;
            if (!own && qb - kb >= 5) {
                const float cb = base + bfar;
#pragma unroll
                for (int r = 0; r < 16; ++r) { p0[r] = cb; p1[r] = cb; }
            } else {
                const int dbase = (qb - kb) * 256 + qrel - 64 * j - 4 * hi;
                const LAS float* tp = (const LAS float*)(lds + L_TAB) + TAB_PAD + dbase - 63;
#pragma unroll
                for (int r = 0; r < 16; ++r) { const int c = (r & 3) + 8 * (r >> 2); p0[r] = tp[63 - c] + base; p1[r] = tp[31 - c] + base; }
            }
            qkt<ND0>(p0, p1, lds + bo + L_K, qr, r32, hi);
        } else {
            p0 = f32x16{}; p1 = f32x16{};
            qkt<ND0>(p0, p1, lds + bo + L_K, qr, r32, hi);
            const LAS float* rkp = (const LAS float*)(lds + L_KM) + j * 64 + 4 * hi;
#pragma unroll
            for (int r = 0; r < 16; ++r) { const int c = (r & 3) + 8 * (r >> 2); p0[r] = p0[r] * rkp[c] - m_ref; p1[r] = p1[r] * rkp[c + 32] - m_ref; }
        }
        const float rm = rowmax(p0, p1);
        if (__any(rm > THR)) {
            const float dl = fmaxf(rm, 0.f); m_ref += dl;
#pragma unroll
            for (int r = 0; r < 16; ++r) { p0[r] -= dl; p1[r] -= dl; }
            const float f = __builtin_amdgcn_exp2f(-dl); l_run *= f;
            if (hi == 0) wsf[r32] = f;
            LDS_WAIT();
#pragma unroll
            for (int r = 0; r < 16; ++r) { const float ff = wsf[crow(r, hi)];
#pragma unroll
                for (int d = 0; d < NDB; ++d) o[d][r] *= ff; }
        }
        float ps = 0.f;
#pragma unroll
        for (int r = 0; r < 16; ++r) { p0[r] = __builtin_amdgcn_exp2f(p0[r]); p1[r] = __builtin_amdgcn_exp2f(p1[r]); ps += p0[r] + p1[r]; }
        l_run += ps;
        v4u pw0, pw1, pw2, pw3;
        pw0 = (v4u){cvtpk(p0[0], p0[1]), cvtpk(p0[2], p0[3]), cvtpk(p0[4], p0[5]), cvtpk(p0[6], p0[7])};
        pw1 = (v4u){cvtpk(p0[8], p0[9]), cvtpk(p0[10], p0[11]), cvtpk(p0[12], p0[13]), cvtpk(p0[14], p0[15])};
        pw2 = (v4u){cvtpk(p1[0], p1[1]), cvtpk(p1[2], p1[3]), cvtpk(p1[4], p1[5]), cvtpk(p1[6], p1[7])};
        pw3 = (v4u){cvtpk(p1[8], p1[9]), cvtpk(p1[10], p1[11]), cvtpk(p1[12], p1[13]), cvtpk(p1[14], p1[15])};
        pv<NDB>(o, vb0 + (int)bo, __builtin_bit_cast(bf16x8, pw0), __builtin_bit_cast(bf16x8, pw1), __builtin_bit_cast(bf16x8, pw2), __builtin_bit_cast(bf16x8, pw3));
      }
    }
    { auto rr = __builtin_amdgcn_permlane32_swap(__float_as_uint(l_run), __float_as_uint(l_run), false, false); l_run = __uint_as_float(rr[0]) + __uint_as_float(rr[1]); }
    if (hi == 0) wsf[32 + r32] = l_run;
    ATT_BAR();
    LAS bf16* stg = (LAS bf16*)(lds + L_OST + wid * 8192);
#pragma unroll
    for (int r = 0; r < 16; ++r) { const int orow = crow(r, hi); const float rl = __builtin_amdgcn_rcpf(wsf[32 + orow]);
#pragma unroll
        for (int d = 0; d < NDB; ++d) stg[orow * DH + d * 32 + r32] = (bf16)f2bf(o[d][r] * rl); }
    LDS_WAIT();
    constexpr int CPR = DH / 8;
    int lane2 = lane; asm volatile("" : "+v"(lane2));
#pragma unroll
    for (int i = 0; i < (32 * CPR) / 64; ++i) { const int idx = i * 64 + lane2, row = idx / CPR, ch = idx % CPR;
        const v4u v = *(const LAS v4u*)(stg + row * DH + ch * 8);
        *(GAS v4u*)(Op + (size_t)(wid * 32 + row) * 512 + ch * 8) = v; }
}
#undef ATT_BAR
#undef ATT_WAIT_BAR
}

__device__ __forceinline__ void conv_item(const bf16* PA, const float* conv_w, bf16* CO, int item, int tid) {
    asm volatile("" : "+v"(tid));
    const int ch = (tid & 63) * 8, r0 = item * 64 + (tid >> 6) * 8;
    float w0[8], w1[8], w2[8];
#pragma unroll
    for (int j = 0; j < 8; ++j) { w0[j] = conv_w[ch + j]; w1[j] = conv_w[512 + ch + j]; w2[j] = conv_w[1024 + ch + j]; }
    float pm2[8], pm1[8];
#pragma unroll
    for (int j = 0; j < 8; ++j) { pm2[j] = 0.f; pm1[j] = 0.f; }
    auto load8 = [&](int row, int col, float* o) { const v4u w = *(const GAS v4u*)(PA + (size_t)row * PAW + col + ch);
        o[0] = bflo(w.x); o[1] = bfhi(w.x); o[2] = bflo(w.y); o[3] = bfhi(w.y); o[4] = bflo(w.z); o[5] = bfhi(w.z); o[6] = bflo(w.w); o[7] = bfhi(w.w); };
    const int s0 = r0 & (SEQ - 1);
    if (s0 >= 2) { float a[8], b[8]; load8(r0 - 2, COL_CC, a); load8(r0 - 2, COL_UC, b);
#pragma unroll
        for (int j = 0; j < 8; ++j) pm2[j] = a[j] * b[j]; }
    if (s0 >= 1) { float a[8], b[8]; load8(r0 - 1, COL_CC, a); load8(r0 - 1, COL_UC, b);
#pragma unroll
        for (int j = 0; j < 8; ++j) pm1[j] = a[j] * b[j]; }
#pragma unroll
    for (int i = 0; i < 8; ++i) { const int row = r0 + i; float c[8], u[8], bb[8], y[8];
        load8(row, COL_CC, c); load8(row, COL_UC, u); load8(row, COL_BC, bb);
#pragma unroll
        for (int j = 0; j < 8; ++j) { const float cur = c[j] * u[j]; y[j] = bb[j] * (w0[j] * pm2[j] + w1[j] * pm1[j] + w2[j] * cur); pm2[j] = pm1[j]; pm1[j] = cur; }
        v4u o; o.x = pk2(y[0], y[1]); o.y = pk2(y[2], y[3]); o.z = pk2(y[4], y[5]); o.w = pk2(y[6], y[7]);
        *(GAS v4u*)(CO + (size_t)row * 512 + ch) = o; }
}

namespace pk {
template <int N> __device__ __forceinline__ void bsort_desc(unsigned (&a)[N]) {
#pragma unroll
    for (int k = 2; k <= N; k <<= 1) {
#pragma unroll
        for (int j = k >> 1; j > 0; j >>= 1) {
#pragma unroll
            for (int i = 0; i < N; ++i) { const int l = i ^ j;
                if (l > i) { const unsigned x = a[i], y = a[l]; const unsigned mx = x > y ? x : y, mn = x > y ? y : x;
                    if ((i & k) == 0) { a[i] = mx; a[l] = mn; } else { a[i] = mn; a[l] = mx; } } } } }
}
template <int N> __device__ __forceinline__ void bmerge_desc(unsigned (&a)[N]) {
#pragma unroll
    for (int j = N >> 1; j > 0; j >>= 1) {
#pragma unroll
        for (int i = 0; i < N; ++i) { const int l = i ^ j; if (l > i) { const unsigned x = a[i], y = a[l]; a[i] = x > y ? x : y; a[l] = x > y ? y : x; } } }
}
__device__ __forceinline__ void top16_merge(unsigned (&x)[16], const unsigned (&y)[16]) {
#pragma unroll
    for (int i = 0; i < 16; ++i) x[i] = x[i] > y[15 - i] ? x[i] : y[15 - i];
    bmerge_desc<16>(x);
}
__device__ __forceinline__ unsigned f2ord(float f) { const unsigned u = __float_as_uint(f); return u ^ ((unsigned)((int)u >> 31) | 0x80000000u); }
__device__ __forceinline__ float ord2f(unsigned o) { return __uint_as_float(o ^ ((o & 0x80000000u) ? 0x80000000u : 0xFFFFFFFFu)); }

constexpr int L_TBL = 0;
__device__ __forceinline__ void topk_fill(const bf16* SK, LAS unsigned char* lds, int hp, int tid) {
    for (int tb = 0; tb < 4; ++tb) { const bf16* src = SK + (size_t)(((2 * hp + (tb >> 1)) * 2 + (tb & 1)) * 128) * 128;
        for (int idx = tid; idx < 2048; idx += NWAVES * 64) { const int key = idx >> 4, c16 = idx & 15;
            const v4u w = *(const GAS v4u*)(src + key * 128 + c16 * 8);
            *(LAS v4u*)(lds + L_TBL + tb * 32768 + (c16 * 4 + (key >> 5)) * 512 + (key & 31) * 16) = w; } }
    asm volatile("s_waitcnt vmcnt(0) lgkmcnt(0)\n\ts_barrier" ::: "memory");
}
__device__ __forceinline__ void topk_task(const bf16* QRY, const float* SLOTS, unsigned* SEL, LAS unsigned char* lds, int hp, int t0, int lane) {
    asm volatile("" : "+v"(lane));
    const int r32 = lane & 31, hi = lane >> 5;
    const int tok = t0 + r32;
    float rn; { const GAS f32x4* sl = (const GAS f32x4*)(SLOTS + (size_t)tok * 16); const f32x4 a = sl[0], b = sl[1], c = sl[2], d = sl[3];
        const float ss = ((a.x + a.y) + (a.z + a.w)) + ((b.x + b.y) + (b.z + b.w)) + ((c.x + c.y) + (c.z + c.w)) + ((d.x + d.y) + (d.z + d.w));
        rn = 1.f / sqrtf(ss * (1.f / 1024.f) + RMS_EPS); }
    unsigned L[4][16];
    bf16x8 qf[8];
    { const bf16* qp = QRY + (size_t)tok * 2048 + ((2 * hp) * 2) * 128 + hi * 8;
#pragma unroll
      for (int kk = 0; kk < 8; ++kk) qf[kk] = *(const GAS bf16x8*)(qp + kk * 16); }
#pragma unroll
    for (int tb = 0; tb < 4; ++tb) {
        f32x16 acc[4];
#pragma unroll
        for (int blk = 0; blk < 4; ++blk) acc[blk] = f32x16{};
        const LAS unsigned char* tbase = lds + L_TBL + tb * 32768 + hi * 2048 + r32 * 16;
#pragma unroll
        for (int kk = 0; kk < 8; ++kk)
#pragma unroll
            for (int blk = 0; blk < 4; ++blk) { const bf16x8 af = *(const LAS bf16x8*)(tbase + kk * 4096 + blk * 512);
                acc[blk] = __builtin_amdgcn_mfma_f32_32x32x16_bf16(af, qf[kk], acc[blk], 0, 0, 0); }
        if (tb < 3) { const int tn = tb + 1; const bf16* qp = QRY + (size_t)tok * 2048 + ((2 * hp + (tn >> 1)) * 2 + (tn & 1)) * 128 + hi * 8;
#pragma unroll
            for (int kk = 0; kk < 8; ++kk) qf[kk] = *(const GAS bf16x8*)(qp + kk * 16);
            asm volatile("" ::: "memory"); }
        unsigned g[4][16];
#pragma unroll
        for (int blk = 0; blk < 4; ++blk)
#pragma unroll
            for (int r = 0; r < 16; ++r) g[blk][r] = (f2ord(acc[blk][r]) & ~127u) | (unsigned)(127 - (32 * blk + (r & 3) + 8 * (r >> 2)));
#pragma unroll
        for (int blk = 0; blk < 4; ++blk) bsort_desc<16>(g[blk]);
        top16_merge(g[0], g[1]); top16_merge(g[2], g[3]); top16_merge(g[0], g[2]);
#pragma unroll
        for (int i = 0; i < 16; ++i) L[tb][i] = g[0][i] ^ (unsigned)(4 * hi);
    }
    unsigned A[2][16];
#pragma unroll
    for (int p = 0; p < 2; ++p) {
        unsigned X[16], Y[16];
#pragma unroll
        for (int i = 0; i < 16; ++i) { auto rr = __builtin_amdgcn_permlane32_swap(L[p][i], L[2 + p][i], false, false); X[i] = rr[0]; Y[i] = rr[1]; }
        top16_merge(X, Y);
#pragma unroll
        for (int i = 0; i < 16; ++i) A[p][i] = X[i];
    }
    float f0[16], f1[16];
#pragma unroll
    for (int i = 0; i < 16; ++i) { f0[i] = ord2f(A[0][i] & ~127u); f1[i] = ord2f(A[1][i] & ~127u); }
    float sums[50]; unsigned keys[50];
    { int c = 0;
#pragma unroll
      for (int i = 0; i < 16; ++i)
#pragma unroll
          for (int j = 0; j < 16; ++j) if ((i + 1) * (j + 1) <= 16) { sums[c] = f0[i] + f1[j]; keys[c] = (f2ord(sums[c]) & ~63u) | (unsigned)(63 - c); ++c; } }
    unsigned G0[16], R[32];
#pragma unroll
    for (int i = 0; i < 16; ++i) G0[i] = keys[i];
#pragma unroll
    for (int i = 0; i < 32; ++i) R[i] = (i < 26) ? keys[24 + i] : 0u;
    bsort_desc<32>(R);
#pragma unroll
    for (int i = 0; i < 16; ++i) G0[i] = G0[i] > R[15 - i] ? G0[i] : R[15 - i];
    bmerge_desc<16>(G0);
#pragma unroll
    for (int i = 8; i < 16; ++i) G0[i] = G0[i] > keys[16 + 15 - i] ? G0[i] : keys[16 + 15 - i];
    unsigned thr = G0[0];
#pragma unroll
    for (int i = 1; i < 16; ++i) thr = thr < G0[i] ? thr : G0[i];
    const float s00 = sums[0], sc = rn * LOG2E;
    float w[50]; float den = 0.f;
#pragma unroll
    for (int c = 0; c < 50; ++c) { w[c] = (keys[c] >= thr) ? __builtin_amdgcn_exp2f((sums[c] - s00) * sc) : 0.f; den += w[c]; }
    const float inv = 1.f / den;
    unsigned i0[16], i1[16];
#pragma unroll
    for (int i = 0; i < 16; ++i) { i0[i] = 127u - (A[0][i] & 127u); i1[i] = 127u - (A[1][i] & 127u); }
    GAS unsigned* outp = (GAS unsigned*)(SEL + ((size_t)tok * 8 + 2 * hp + hi) * 16);
    int pos = 0;
    { int c = 0;
#pragma unroll
      for (int i = 0; i < 16; ++i)
#pragma unroll
          for (int j = 0; j < 16; ++j) if ((i + 1) * (j + 1) <= 16) { if (keys[c] >= thr) { outp[pos & 15] = ((i0[i] * 128u + i1[j]) << 16) | f2bf(w[c] * inv); ++pos; } ++c; } }
}
}

constexpr size_t SLICE_BYTES = (size_t)NEXP * 128;
constexpr int TH = T / 2;
__device__ __forceinline__ unsigned nib4(float a, float b, float c, float d, float is, int off) {
    const int n0 = min(max((int)floorf(a * is), -8), 7) + off, n1 = min(max((int)floorf(b * is), -8), 7) + off, n2 = min(max((int)floorf(c * is), -8), 7) + off, n3 = min(max((int)floorf(d * is), -8), 7) + off;
    return (unsigned)(n0 & 15) | ((unsigned)(n1 & 15) << 8) | ((unsigned)(n2 & 15) << 16) | ((unsigned)(n3 & 15) << 24);
}
template <int NR, bool OFFLO> __device__ __forceinline__ void quant_rows_i4(const float* X, unsigned char* qtab, float* scale, int e0, int es, int eend, int lane) {
    f32x4 v[NR][4];
#pragma unroll
    for (int r = 0; r < NR; ++r) { const int e = (e0 + r * es < eend) ? e0 + r * es : eend - 1; const GAS f32x4* xr = (const GAS f32x4*)(X + (size_t)e * DM) + lane;
#pragma unroll
        for (int j = 0; j < 4; ++j) v[r][j] = xr[64 * j]; }
#pragma unroll
    for (int r = 0; r < NR; ++r) { float ss = 0.f;
#pragma unroll
        for (int j = 0; j < 4; ++j) ss += (v[r][j].x * v[r][j].x + v[r][j].y * v[r][j].y) + (v[r][j].z * v[r][j].z + v[r][j].w * v[r][j].w);
        ss = wave_sum(ss);
        const float step = ss > 0.f ? 0.3352f * sqrtf(ss * (1.f / 1024.f)) : 1.f, is = 1.f / step;
        const int e = e0 + r * es;
        const unsigned twoc = (OFFLO && !(lane & 1)) ? 0u : 0x08080808u;
#pragma unroll
        for (int j = 0; j < 4; ++j) {
            const f32x4 y = v[r][j] * is + 7.5f;
            unsigned z[4];
#pragma unroll
            for (int e = 0; e < 4; ++e) z[e] = __builtin_bit_cast(unsigned, __builtin_amdgcn_fmed3f(y[e], -0.5f, 15.0f) + 8388864.0f);
            const unsigned o = (__builtin_amdgcn_perm(z[1], z[0], 0x0c0c0400u) | __builtin_amdgcn_perm(z[3], z[2], 0x04000c0cu)) ^ twoc;
            const unsigned po = (unsigned)__builtin_amdgcn_update_dpp(0, (int)o, 0xB1, 0xf, 0xf, true);
            if (e < eend && !(lane & 1)) *(GAS unsigned*)(qtab + (size_t)j * SLICE_BYTES + (size_t)e * 128 + (lane >> 1) * 4) = o | (po << 4); }
        if (e < eend && lane == 0) scale[e] = 0.5f * step; }
}
constexpr int NQCHUNK = 2 * NEXP / 8;
__device__ __forceinline__ void quant_tables_part(const float* PU, const float* PV, unsigned char* UQ, unsigned char* VQ, float* SU, float* SV, int first, int end, int w, int nw, int lane) {
    for (int c = first + w; c < end; c += nw) { const int e0 = (c & 2047) * 8;
        if ((c >> 11) == 0) quant_rows_i4<8, false>(PU, UQ, SU, e0, 1, NEXP, lane); else quant_rows_i4<8, true>(PV, VQ, SV, e0, 1, NEXP, lane); }
}
template <int NR> __device__ __forceinline__ void quant_x(const bf16* HB, unsigned char* XQ, float* SX, int* XS, const float (&gf)[16], int t0, int ts, int lane) {
    f32x4 hv[NR][4];
#pragma unroll
    for (int r = 0; r < NR; ++r) { const int t = (t0 + r * ts < T) ? t0 + r * ts : T - 1; const GAS v2u* hrow = (const GAS v2u*)(HB + (size_t)t * DM) + lane;
#pragma unroll
        for (int j = 0; j < 4; ++j) { const v2u w = hrow[64 * j]; hv[r][j] = (f32x4){bflo(w.x), bfhi(w.x), bflo(w.y), bfhi(w.y)}; } }
#pragma unroll
    for (int r = 0; r < NR; ++r) { float ss = 0.f;
#pragma unroll
        for (int j = 0; j < 4; ++j) ss += (hv[r][j].x * hv[r][j].x + hv[r][j].y * hv[r][j].y) + (hv[r][j].z * hv[r][j].z + hv[r][j].w * hv[r][j].w);
        const float rn = 1.f / sqrtf(wave_sum(ss) * (1.f / 1024.f) + RMS_EPS);
        float xn[16]; float am = 0.f;
#pragma unroll
        for (int j = 0; j < 4; ++j)
#pragma unroll
            for (int e = 0; e < 4; ++e) { xn[4 * j + e] = hv[r][j][e] * rn * gf[4 * j + e]; am = fmaxf(am, fabsf(xn[4 * j + e])); }
#pragma unroll
        for (int o = 1; o < 64; o <<= 1) am = fmaxf(am, __shfl_xor(am, o));
        const float sx = am > 0.f ? am * (1.f / 119.f) : 1.f, isx = 1.f / sx;
        const int t = t0 + r * ts;
        float qsf = 0.f;
#pragma unroll
        for (int j = 0; j < 4; ++j) {
            unsigned zh[4], zl[4];
#pragma unroll
            for (int e = 0; e < 4; ++e) { const float q = __builtin_rintf(xn[4 * j + e] * isx), qh = __builtin_floorf(q * 0.0625f + 0.5f), ql = q - 16.f * qh; qsf += q;
                zh[e] = __builtin_bit_cast(unsigned, qh + 12582912.0f); zl[e] = __builtin_bit_cast(unsigned, ql + 12582912.0f); }
            const unsigned ph = (__builtin_amdgcn_perm(zh[1], zh[0], 0x0c0c0400u) | __builtin_amdgcn_perm(zh[3], zh[2], 0x04000c0cu)) & 0x0f0f0f0fu;
            const unsigned pl = (__builtin_amdgcn_perm(zl[1], zl[0], 0x0c0c0400u) | __builtin_amdgcn_perm(zl[3], zl[2], 0x04000c0cu)) & 0x0f0f0f0fu;
            const unsigned oh = (unsigned)__builtin_amdgcn_update_dpp(0, (int)ph, 0xB1, 0xf, 0xf, true), ol = (unsigned)__builtin_amdgcn_update_dpp(0, (int)pl, 0xB1, 0xf, 0xf, true);
            const unsigned word = (lane & 1) ? (ol | (pl << 4)) : (ph | (oh << 4));
            if (t < T) *(GAS unsigned*)(XQ + (size_t)t * DM + j * 256 + (lane >> 3) * 32 + (lane & 1) * 16 + ((lane & 7) >> 1) * 4) = word; }
        int qs = (int)qsf;
#pragma unroll
        for (int o = 1; o < 64; o <<= 1) qs += __shfl_xor(qs, o);
        if (t < T && lane == 0) { SX[t] = sx; XS[t] = qs; } }
}
__device__ __forceinline__ float gelu_exact(float x) { return 0.5f * x * (1.0f + erff(x * 0.70710678118654752f)); }
__device__ __forceinline__ int dpp_i(int v, int ctrl_is) {
    return ctrl_is == 0 ? __builtin_amdgcn_update_dpp(0, v, 0x141, 0xf, 0xf, true) : ctrl_is == 1 ? __builtin_amdgcn_update_dpp(0, v, 0xB1, 0xf, 0xf, true) : __builtin_amdgcn_update_dpp(0, v, 0x4E, 0xf, 0xf, true);
}
constexpr int QCHUNK = 8;
__device__ __forceinline__ int q_take(unsigned* q, int lane) {
    unsigned v = 0; if (lane == 0) v = __hip_atomic_fetch_add(q, (unsigned)QCHUNK, __ATOMIC_RELAXED, __HIP_MEMORY_SCOPE_AGENT);
    return (int)__builtin_amdgcn_readfirstlane(v);
}
struct TokStream {
    unsigned* q; int cur, end, nxt, stride;
    __device__ __forceinline__ void open_static(int c0, int W) { q = nullptr; cur = c0 * QCHUNK; end = cur + QCHUNK; nxt = 0; stride = W * QCHUNK; }
    __device__ __forceinline__ void open(unsigned* q_, int lane) { q = q_; stride = 0;
        unsigned v = 0; if (lane == 0) v = __hip_atomic_fetch_add(q, 2u * (unsigned)QCHUNK, __ATOMIC_RELAXED, __HIP_MEMORY_SCOPE_AGENT);
        cur = (int)__builtin_amdgcn_readfirstlane(v); end = cur + QCHUNK; nxt = cur + QCHUNK; }
    __device__ __forceinline__ int next(int lane) { const int t = cur; if (t >= TH) return TH; ++cur;
        if (cur == end) { if (q) { cur = nxt; end = cur + QCHUNK; if (cur < TH) nxt = q_take(q, lane); } else { cur += stride - QCHUNK; end = cur + QCHUNK; } }
        return t; }
};
struct SlicePlan { int xcc, srank, sW; unsigned cnts; };
__device__ __forceinline__ SlicePlan slice_plan(int xcc, int srank, int sW, const unsigned* xcnt  , int lane) {
    SlicePlan p; p.xcc = xcc; p.srank = srank; p.sW = sW;
    p.cnts = (sW > 0 && lane < 8) ? __hip_atomic_load(xcnt + 64 * lane, __ATOMIC_RELAXED, __HIP_MEMORY_SCOPE_AGENT) : 0u;
    return p;
}
__device__ __forceinline__ bool slice_open(TokStream& S, const SlicePlan& p, int qi, int x, unsigned* queues, int lane) {
    if (p.sW > 0 && qi == 0) { S.open_static(p.srank, p.sW); return true; }
    if (p.sW > 0 && (unsigned)__builtin_amdgcn_readlane((int)p.cnts, x) != 0u) return false;
    S.open(queues + 64 * x, lane); return true;
}
#define MEM_ORDER() asm volatile("" ::: "memory")
#ifdef PROBE_MASKV
#define PROBE_EMASK & emask
#define PROBE_EARG , unsigned emask
#define PROBE_EPASS , emask
#else
#define PROBE_EMASK
#define PROBE_EARG
#define PROBE_EPASS
#endif
__device__ __forceinline__ unsigned bperm(int src_lane4, unsigned v) { return (unsigned)__builtin_amdgcn_ds_bpermute(src_lane4, (int)v); }
struct UEnt { v2u R; unsigned x; };
__device__ __forceinline__ void u_ent(UEnt& E, const unsigned* SEL, const unsigned char* XQ, int t, int cs, int lane) {
    E.x = *(const GAS unsigned*)(XQ + (size_t)t * DM + cs * 256 + 4 * lane);
    E.R = *(const GAS v2u*)(SEL + (size_t)t * 128 + 2 * lane);
}
__device__ __forceinline__ void u_rows(v4u (&w)[16], unsigned& xr, const UEnt& E, int lane, const unsigned char* tab, unsigned choff PROBE_EARG) {
    const v2u R = E.R;
    const int gb = (lane >> 3) * 32;
#pragma unroll
    for (int g = 0; g < 16; ++g) { const unsigned e = bperm(gb + 4 * (g >> 1), (g & 1) ? R.y : R.x);
        w[g] = *(const GAS v4u*)(tab + (unsigned)(((e >> 16) PROBE_EMASK) * 128u + choff)); }
    xr = E.x;
}
__device__ __forceinline__ int dot8z(unsigned a, unsigned b) { int r; asm("v_dot8_i32_i4 %0, %1, %2, 0" : "=v"(r) : "v"(a), "v"(b)); return r; }
__device__ __forceinline__ void u_compute(const v4u (&w)[16], const unsigned xr, int* prow, int grp, int ch, int c0, int c1, int c2) {
    int p[16];
    v4u xh, xl;
#pragma unroll
    for (int j = 0; j < 4; ++j) { xh[j] = bperm(32 * ch + 4 * j, xr); xl[j] = bperm(32 * ch + 16 + 4 * j, xr); }
#pragma unroll
    for (int g = 0; g < 16; ++g) { int ah = dot8z(w[g][0], xh[0]), al = dot8z(w[g][0], xl[0]);
#pragma unroll
        for (int j = 1; j < 4; ++j) { ah = __builtin_amdgcn_sdot8((int)w[g][j], (int)xh[j], ah, false); al = __builtin_amdgcn_sdot8((int)w[g][j], (int)xl[j], al, false); }
        p[g] = (ah << 4) + al; }
    int q8[8], q4[4], q2[2];
#pragma unroll
    for (int i = 0; i < 8; ++i) { const int keep = c2 ? p[i + 8] : p[i], send = c2 ? p[i] : p[i + 8]; q8[i] = keep + dpp_i(send, 0); }
#pragma unroll
    for (int i = 0; i < 4; ++i) { const int keep = c0 ? q8[i + 4] : q8[i], send = c0 ? q8[i] : q8[i + 4]; q4[i] = keep + dpp_i(send, 1); }
#pragma unroll
    for (int i = 0; i < 2; ++i) { const int keep = c1 ? q4[i + 2] : q4[i], send = c1 ? q4[i] : q4[i + 2]; q2[i] = keep + dpp_i(send, 2); }
    const int g0 = 8 * c2 + 4 * c0 + 2 * c1;
    typedef int i2 __attribute__((ext_vector_type(2)));
    *(GAS i2*)(prow + grp * 16 + g0) = (i2){q2[0], q2[1]};
}
__device__ __forceinline__ void gather_u(const unsigned* SEL0, const unsigned char* XQ0, const unsigned char* UQS, int* PART, int* dummy, unsigned* queues, const SlicePlan& plan, int lane PROBE_EARG) {
    const int grp = lane >> 3, ch = lane & 7, c0 = ch & 1, c1 = (ch >> 1) & 1, c2 = (ch >> 2) & 1;
    for (int qi = 0; qi < 8; ++qi) { const int x = (plan.xcc + qi) & 7, cs = x & 3, tb = (x >> 2) * TH;
        TokStream S; if (!slice_open(S, plan, qi, x, queues, lane)) continue;
        const unsigned char* tab = UQS + (size_t)cs * SLICE_BYTES; const unsigned choff = (unsigned)ch * 16u;
        int* part = PART + ((size_t)cs * T + tb) * 128;
        const unsigned* SEL = SEL0 + (size_t)tb * 128; const unsigned char* XQ = XQ0 + (size_t)tb * DM;
        int tA = S.next(lane), tB = S.next(lane);
        if (tA >= TH) continue;
        UEnt EA, EB; v4u W0[16], W1[16]; unsigned X0, X1;
        u_ent(EA, SEL, XQ, tA, cs, lane); u_ent(EB, SEL, XQ, tB < TH ? tB : TH - 1, cs, lane); MEM_ORDER();
        u_rows(W0, X0, EA, lane, tab, choff PROBE_EPASS); MEM_ORDER();
        while (tA < TH) {
            const int tC = S.next(lane);
            u_ent(EA, SEL, XQ, tC < TH ? tC : TH - 1, cs, lane); MEM_ORDER();
            u_rows(W1, X1, EB, lane, tab, choff PROBE_EPASS); MEM_ORDER();
            u_compute(W0, X0, part + (size_t)tA * 128, grp, ch, c0, c1, c2); MEM_ORDER();
            const int tD = S.next(lane);
            u_ent(EB, SEL, XQ, tD < TH ? tD : TH - 1, cs, lane); MEM_ORDER();
            u_rows(W0, X0, EA, lane, tab, choff PROBE_EPASS); MEM_ORDER();
            u_compute(W1, X1, tB < TH ? part + (size_t)tB * 128 : dummy, grp, ch, c0, c1, c2); MEM_ORDER();
            tA = tC; tB = tD;
        }
    }
}
template <int NR> __device__ __forceinline__ void gather_coef(const unsigned* SEL, const int* PART, const float* SU, const float* SV, const float* SX, const int* XS, signed char* CQ, unsigned* EO, float* SCL, int* CSM, int t0, int ts, int lane) {
    typedef int i2 __attribute__((ext_vector_type(2)));
    v2u ent[NR]; i2 acc[NR]; float sx[NR]; int xs[NR]; int tt[NR];
#pragma unroll
    for (int r = 0; r < NR; ++r) { tt[r] = (t0 + r * ts < T) ? t0 + r * ts : T - 1; ent[r] = *(const GAS v2u*)(SEL + (size_t)tt[r] * 128 + 2 * lane);
        sx[r] = __hip_atomic_load(SX + tt[r], __ATOMIC_RELAXED, __HIP_MEMORY_SCOPE_AGENT);
        xs[r] = __hip_atomic_load(XS + tt[r], __ATOMIC_RELAXED, __HIP_MEMORY_SCOPE_AGENT);
        acc[r] = (i2){0, 0}; }
#pragma unroll
    for (int r = 0; r < NR; ++r)
#pragma unroll
        for (int x = 0; x < 4; ++x) { const i2 pp = *(const GAS i2*)(PART + ((size_t)x * T + tt[r]) * 128 + 2 * lane); acc[r] += pp; }
    float su0[NR], sv0[NR], su1[NR], sv1[NR];
#pragma unroll
    for (int r = 0; r < NR; ++r) { const unsigned e0 = ent[r].x >> 16, e1 = ent[r].y >> 16; su0[r] = SU[e0]; sv0[r] = SV[e0]; su1[r] = SU[e1]; sv1[r] = SV[e1]; }
#pragma unroll
    for (int r = 0; r < NR; ++r) {
        const float k0 = bflo(ent[r].x) * gelu_exact((float)(2 * acc[r].x + xs[r]) * (su0[r] * sx[r])) * sv0[r], k1 = bflo(ent[r].y) * gelu_exact((float)(2 * acc[r].y + xs[r]) * (su1[r] * sx[r])) * sv1[r];
        float am = fmaxf(fabsf(k0), fabsf(k1));
#pragma unroll
        for (int o = 1; o < 64; o <<= 1) am = fmaxf(am, __shfl_xor(am, o));
        const float sc = am > 0.f ? am * (1.f / 127.f) : 1.f, isc = 1.f / sc;
        const int c0 = (int)rintf(k0 * isc), c1 = (int)rintf(k1 * isc);
        int csum = c0 + c1;
#pragma unroll
        for (int o = 1; o < 64; o <<= 1) csum += __shfl_xor(csum, o);
        if (t0 + r * ts < T) {
            GAS unsigned short* cq = (GAS unsigned short*)((GAS signed char*)CQ + (size_t)tt[r] * 128);
            cq[lane] = (unsigned short)((unsigned)(c0 & 0xff) | ((unsigned)(c1 & 0xff) << 8));
            *(GAS v2u*)(EO + (size_t)tt[r] * 128 + 2 * lane) = (v2u){(ent[r].x >> 16) * 128u, (ent[r].y >> 16) * 128u};
            if (lane == 0) { SCL[tt[r]] = sc * 0.125f; CSM[tt[r]] = 8 * csum; } } }
}
typedef int v4i __attribute__((ext_vector_type(4)));
typedef float vf4 __attribute__((ext_vector_type(4)));
struct VCoef { v4i A; float sc; int cs; v4u hb0, hb1; };
struct VEnt { VCoef c; v2u R; };
__device__ __forceinline__ void v_ent(VEnt& E, const unsigned* EO, const signed char* CQ, const float* SCL, const int* CSM, const bf16* HIcol, int t, int lane) {
    const int ic = lane & 3, kb = lane >> 4;
    E.c.A = *(const GAS v4i*)((const GAS signed char*)CQ + (size_t)t * 128 + (2 * kb + (ic & 1)) * 16);
    E.c.sc = __hip_atomic_load(SCL + t, __ATOMIC_RELAXED, __HIP_MEMORY_SCOPE_AGENT);
    E.c.cs = __hip_atomic_load(CSM + t, __ATOMIC_RELAXED, __HIP_MEMORY_SCOPE_AGENT);
    E.c.hb0 = *(const GAS v4u*)(HIcol + (size_t)t * DM);
    E.c.hb1 = *(const GAS v4u*)(HIcol + (size_t)t * DM + 16);
    E.R = *(const GAS v2u*)(EO + (size_t)t * 128 + 2 * lane);
}
__device__ __forceinline__ void v_rows(v4u (&w)[16], VCoef& c, const VEnt& E, int lane, const unsigned char* tab, unsigned choff) {
    const int gb = (lane >> 3) * 32; const v2u R = E.R;
#pragma unroll
    for (int g = 0; g < 16; ++g) { const unsigned eo = bperm(gb + 4 * (g >> 1), (g & 1) ? R.y : R.x); w[g] = *(const GAS v4u*)(tab + (unsigned)(eo + choff)); }
    c = E.c;
}
__device__ __forceinline__ unsigned permb(unsigned hi, unsigned lo, unsigned sel) { return __builtin_amdgcn_perm(hi, lo, sel); }
__device__ __forceinline__ int ror8(int v) { return __builtin_amdgcn_update_dpp(0, v, 0x128, 0xf, 0xf, true); }
__device__ __forceinline__ void v_compute(const v4u (&w)[16], const VCoef& C, float* hout, bool half, bool storer, bool arow) {
    const v4i CA = arow ? C.A : (v4i){0, 0, 0, 0};
    const int k15 = -15 * C.cs;
#pragma unroll
    for (int jp = 0; jp < 2; ++jp) {
        int tr[2][4], th[2][4];
#pragma unroll
        for (int jj = 0; jj < 2; ++jj) { const int j = 2 * jp + jj;
            unsigned K[4][4];
#pragma unroll
            for (int q = 0; q < 4; ++q) { const unsigned a = w[4 * q][j], b = w[4 * q + 1][j], c = w[4 * q + 2][j], d = w[4 * q + 3][j];
                const unsigned t0 = permb(a, b, 0x01050004u), t1 = permb(a, b, 0x03070206u), t2 = permb(c, d, 0x01050004u), t3 = permb(c, d, 0x03070206u);
                K[q][0] = permb(t2, t0, 0x05040100u); K[q][1] = permb(t2, t0, 0x07060302u); K[q][2] = permb(t3, t1, 0x05040100u); K[q][3] = permb(t3, t1, 0x07060302u); }
#pragma unroll
            for (int k = 0; k < 4; ++k) {
                const v4i Br = {(int)K[0][k], (int)K[1][k], (int)K[2][k], (int)K[3][k]};
                const v4i Bh = {(int)(K[0][k] & 0xF0F0F0F0u), (int)(K[1][k] & 0xF0F0F0F0u), (int)(K[2][k] & 0xF0F0F0F0u), (int)(K[3][k] & 0xF0F0F0F0u)};
                const v4i Dr = __builtin_amdgcn_mfma_i32_16x16x64_i8(CA, Br, (v4i){0, 0, 0, 0}, 0, 0, 0);
                const v4i Dh = __builtin_amdgcn_mfma_i32_16x16x64_i8(CA, Bh, (v4i){0, 0, 0, 0}, 0, 0, 0);
                tr[jj][k] = jj ? Dr[1] + ror8(Dr[0]) : Dr[0] + ror8(Dr[1]);
                th[jj][k] = jj ? Dh[1] + ror8(Dh[0]) : Dh[0] + ror8(Dh[1]); }
        }
        int lo[4], hi[4];
#pragma unroll
        for (int k = 0; k < 4; ++k) { const int d0 = tr[0][k] - th[0][k], d1 = tr[1][k] - th[1][k]; lo[k] = half ? d1 : d0; hi[k] = half ? th[1][k] : th[0][k];
            asm volatile("" : "+v"(lo[k]), "+v"(hi[k])); }
        const v4u hb = jp ? C.hb1 : C.hb0;
        const float h8[8] = {bflo(hb.x), bfhi(hb.x), bflo(hb.y), bfhi(hb.y), bflo(hb.z), bfhi(hb.z), bflo(hb.w), bfhi(hb.w)};
        vf4 o0, o1;
#pragma unroll
        for (int k = 0; k < 4; ++k) { o0[k] = h8[k] + C.sc * (float)((lo[k] << 4) + k15);
                                      o1[k] = h8[4 + k] + C.sc * (float)(hi[k] + C.cs); }
        if (storer) { __builtin_nontemporal_store(o0, (GAS vf4*)(hout + 16 * jp)); __builtin_nontemporal_store(o1, (GAS vf4*)(hout + 16 * jp) + 1); }
    }
}
__device__ __forceinline__ void gather_v(const unsigned* EO0, const signed char* CQ0, const float* SCL0, const int* CSM0, const unsigned char* VQS, const bf16* HI0, float* HO0, float* dummy, unsigned* queues, const SlicePlan& plan, int lane) {
    const int ch = lane & 7; const bool half = ((lane >> 3) & 1) != 0, storer = lane < 16, arow = (lane & 15) < 2;
    for (int qi = 0; qi < 8; ++qi) { const int x = (plan.xcc + qi) & 7, cs = x & 3, tb = (x >> 2) * TH;
        TokStream S; if (!slice_open(S, plan, qi, x, queues, lane)) continue;
        const unsigned char* tab = VQS + (size_t)cs * SLICE_BYTES; const unsigned choff = (unsigned)ch * 16u;
        const int col = cs * 256 + ch * 32 + (half ? 8 : 0);
        const unsigned* EO = EO0 + (size_t)tb * 128; const signed char* CQ = CQ0 + (size_t)tb * 128; const float* SCL = SCL0 + tb; const int* CSM = CSM0 + tb;
        const bf16* HI = HI0 + (size_t)tb * DM + col; float* HO = HO0 + (size_t)tb * DM + col;
        int tA = S.next(lane), tB = S.next(lane);
        if (tA >= TH) continue;
        VEnt EA, EB; v4u W0[16], W1[16]; VCoef C0, C1;
        v_ent(EA, EO, CQ, SCL, CSM, HI, tA, lane); v_ent(EB, EO, CQ, SCL, CSM, HI, tB < TH ? tB : TH - 1, lane); MEM_ORDER();
        v_rows(W0, C0, EA, lane, tab, choff); MEM_ORDER();
        while (tA < TH) {
            const int tC = S.next(lane);
            v_ent(EA, EO, CQ, SCL, CSM, HI, tC < TH ? tC : TH - 1, lane); MEM_ORDER();
            v_rows(W1, C1, EB, lane, tab, choff); MEM_ORDER();
            v_compute(W0, C0, HO + (size_t)tA * DM, half, storer, arow); MEM_ORDER();
            const int tD = S.next(lane);
            v_ent(EB, EO, CQ, SCL, CSM, HI, tD < TH ? tD : TH - 1, lane); MEM_ORDER();
            v_rows(W0, C0, EA, lane, tab, choff); MEM_ORDER();
            v_compute(W1, C1, tB < TH ? HO + (size_t)tB * DM : dummy + 32 * (lane & 15), half, storer, arow); MEM_ORDER();
            tA = tC; tB = tD;
        }
    }
}

#ifndef MK_SPLIT
#define MK_SPLIT 0
#endif
constexpr int NPHASE = 11;
typedef SlicePlan pk_plan_t;
#ifndef PROBE_PH
#define PROBE_PH -1
#endif
#ifndef PROBE_N
#define PROBE_N 1
#endif
#define REPS(k) (((k) == PROBE_PH) ? 1 + PROBE_N : 1)
struct Args { const float* in[21]; float* out; unsigned char* ws; int ph_lo, ph_hi; };
static_assert(sizeof(Args) == 23 * 8 + 8, "Args has no padding");

__global__ void __launch_bounds__(NWAVES * 64, 2) fwd(Args args) {
    extern __shared__ __attribute__((aligned(16))) unsigned char lds_raw[];
    LAS unsigned char* lds = (LAS unsigned char*)lds_raw;
    volatile LAS unsigned* MISC = (volatile LAS unsigned*)(lds + MISC_OFF);
    const int tid = threadIdx.x, lane = tid & 63, wave = __builtin_amdgcn_readfirstlane(tid >> 6);
    const int G = gridDim.x; const int bx = blockIdx.x; const int vcu = (G % 8 == 0) ? (bx % 8) * (G / 8) + bx / 8 : bx;
    const int gw = vcu * NWAVES + wave, NGW = G * NWAVES;
    unsigned char* ws = args.ws;
    gu32* ctl = (gu32*)(ws + WS_CTL);
    const float* x = args.in[0]; const float* mem = args.in[1]; const float* g_mix = args.in[2]; const float* w_in = args.in[3]; const float* q_gain_a = args.in[4]; const float* k_gain_a = args.in[5];
    const float* rel_bias = args.in[6]; const float* conv_w = args.in[7]; const float* g_mem = args.in[8]; const float* w_mem_kv = args.in[9]; const float* q_gain_x = args.in[10]; const float* k_gain_x = args.in[11];
    const float* w_br_attn = args.in[12]; const float* w_br_conv = args.in[13]; const float* w_br_x = args.in[14]; const float* w_out = args.in[15]; const float* g_ffn = args.in[16];
    const float* w_query = args.in[17]; const float* sub_keys = args.in[18]; const float* peer_u = args.in[19]; const float* peer_v = args.in[20];
    float* out = args.out;
    bf16* WinT = (bf16*)(ws + WS_WIN); bf16* WkvT = (bf16*)(ws + WS_WKV); bf16* WbrT = (bf16*)(ws + WS_WBR); bf16* WoutT = (bf16*)(ws + WS_WOUT); bf16* WqT = (bf16*)(ws + WS_WQ);
    bf16* SK = (bf16*)(ws + WS_SK); float* TAB = (float*)(ws + WS_TAB); float* KMEAN = (float*)(ws + WS_KMEAN); bf16* MEMN = (bf16*)(ws + WS_MEMN); bf16* KVM = (bf16*)(ws + WS_KVM);
    float* SLOTS = (float*)(ws + WS_SLOTS); unsigned* SEL = (unsigned*)(ws + WS_SEL);
    bf16* PA = (bf16*)(ws + WS_PA); bf16* PG = (bf16*)(ws + WS_PG);
    bf16* MERGED = (bf16*)(ws + PA_MERGED); bf16* HB = (bf16*)(ws + PA_HB); unsigned char* UQ = ws + PA_UT; unsigned char* VQ = ws + PA_VT; float* SU = (float*)(ws + WS_SU); float* SV = (float*)(ws + WS_SV); int* CM = (int*)(ws + WS_CM); float* SAq = (float*)(ws + WS_SA); float* SBq = (float*)(ws + WS_SB); int* XSM = (int*)(ws + WS_XS); float* SX = (float*)(ws + WS_SX); float* CS = (float*)(ws + WS_CS);
    unsigned char* XQ = ws + PA_XQ; int* PART = (int*)(ws + PG_PART); signed char* CQ = (signed char*)(ws + PG_COEF); unsigned* EO = (unsigned*)(ws + PG_COEF + 8 * MiB); bf16* QRY = (bf16*)(ws + PG_QRY);
    bf16* HN = (bf16*)out;
    bf16* BRO = (bf16*)out;

    for (int u = tid; u < (LDS_BYTES - LDSCTL_OFF) / 4; u += NWAVES * 64) ((LAS unsigned*)(lds + LDSCTL_OFF))[u] = 0u;
    __syncthreads();
#if !MK_SPLIT
    XcdBarrier bar = xcd_barrier_post((unsigned*)(ctl + CW_BAR), MISC + 8);
    if (tid == 0) MISC[10] = __hip_atomic_fetch_add((unsigned*)(ctl + CW_RANK) + 64 * (bar.x & 7u), 1u, __ATOMIC_RELAXED, __HIP_MEMORY_SCOPE_AGENT);
#define GRID_BAR() xcd_barrier(bar)
#else
#define GRID_BAR() do {} while (0)
#endif
    const int lo = args.ph_lo, hi_ = args.ph_hi;
#ifndef PH_MASK
#define PH_MASK 0x7ff
#endif
#define IN(k) ((((PH_MASK) >> (k)) & 1) && lo <= (k) && (k) < hi_)
#define BOTH(k) (IN(k) && IN((k) + 1))

    const P0Args p0a{x, mem, g_mix, w_in, rel_bias, g_mem, w_mem_kv, w_br_attn, w_br_conv, w_br_x, w_out, g_ffn, w_query, sub_keys, WinT, WkvT, WbrT, WoutT, WqT, SK, HN, MEMN, TAB, SAq, SBq};
    const int n_busy = (64 * 26) % G + 32; const bool late_w = IN(0) && IN(1) && n_busy < G;
    if (IN(0)) for (int rep = 0; rep < REPS(0); ++rep) {
        p0_prologue(p0a, lds, late_w, gw, NGW, wave, lane);
        if (BOTH(0) && rep == REPS(0) - 1) GRID_BAR();
    }
    if (IN(1)) for (int rep = 0; rep < REPS(1); ++rep) {
        { pg8::Gemm g{HN, WinT, T, PW, DM / 2}; pg8::GOrder S; S.init(T, PW, G, bx); pg8::EpiProj E{PA, PG, q_gain_a, k_gain_a, KMEAN, C2A, RMS_EPS, SAq, SBq};
          pg8::gemm_phase<pg8::EpiProj, pg8::GOrder, true, true, true>(lds + RING_OFF, g, S, E); }
        { const int nfull = (64 * 26) % G; const int coff = (nfull + 32 <= G) ? bx - nfull : bx;
          pg8::Gemm g{MEMN, WkvT, NBATCH * MEMLEN, 1024, DM}; pg8::GOrder S; S.init(NBATCH * MEMLEN, 1024, G, coff); pg8::EpiBf16<0> E{KVM, 1024, nullptr, 0, 0, 1.f};
          pg8::gemm_phase<pg8::EpiBf16<0>, pg8::GOrder, true, true>(lds + RING_OFF, g, S, E); }
        if (late_w && rep == 0 && bx >= n_busy) p0_transposes(p0a, lds, 1, (bx - n_busy) * NWAVES + wave, (G - n_busy) * NWAVES, wave, lane);
        if (IN(1) && IN(3) && rep == REPS(1) - 1) GRID_BAR();
    }
#if defined(PROBE_BARS) && !MK_SPLIT
    if (IN(1)) for (int i = 0; i < PROBE_BARS; ++i) GRID_BAR();
#endif
    if (IN(3)) for (int rep = 0; rep < REPS(3); ++rep) {
        for (int v = vcu; v < 256; v += G) {
            const int bh = v >> 2, b = bh >> 3, h = bh & 7, s = v & 3;
#pragma unroll 1
            for (int pass = 0; pass < 2; ++pass) { const int qb = pass ? 7 - s : s;
                const bf16* Qp = PA + (size_t)(b * SEQ + qb * 256) * PAW + COL_QA + h * 64;
                const bf16* Kp = PA + (size_t)(b * SEQ) * PAW + COL_KA + h * 64; const bf16* Vp = PA + (size_t)(b * SEQ) * PAW + COL_VA + h * 64;
                bf16* Op = BRO + (size_t)(b * SEQ + qb * 256) * 512 + h * 64;
                att::attn_unit<64, true>(Qp, PAW, Kp, Vp, PAW, Op, qb, KMEAN + (size_t)bh * 512, TAB + h * 2048, nullptr, nullptr, lds + RING_OFF, tid, wave, lane); }
            { const int bb = v >> 5, hx = (v >> 3) & 3, qt = v & 7;
                const bf16* Qp = PA + (size_t)(bb * SEQ + qt * 256) * PAW + COL_QX + hx * 128;
                const bf16* Kp = KVM + (size_t)(bb * MEMLEN) * 1024 + hx * 128; const bf16* Vp = Kp + 512;
                bf16* Op = BRO + (size_t)2 * T * 512 + (size_t)(bb * SEQ + qt * 256) * 512 + hx * 128;
                att::attn_unit<128, false>(Qp, PAW, Kp, Vp, 1024, Op, 0, nullptr, nullptr, q_gain_x, k_gain_x, lds + RING_OFF, tid, wave, lane); }
            conv_item(PA, conv_w, BRO + (size_t)T * 512, v, tid);
        }
        if (BOTH(3) && rep == REPS(3) - 1) GRID_BAR();
    }
    if (IN(4)) for (int rep = 0; rep < REPS(4); ++rep) {
        pg8::Gemm g{BRO, WbrT, 3 * T, 3 * 1024, 512}; pg8::BranchOrder S; S.init(G, bx); pg8::EpiBranch E{PG, MERGED};
        pg8::gemm_phase<pg8::EpiBranch, pg8::BranchOrder, true, true>(lds + RING_OFF, g, S, E);
        if (BOTH(4) && rep == REPS(4) - 1) GRID_BAR();
    }
    if (IN(5)) for (int rep = 0; rep < REPS(5); ++rep) {
        pg8::Gemm g{MERGED, WoutT, T, 1024, DM}; pg8::GOrder S; S.init(T, 1024, G, bx); pg8::EpiWout E{x, out, HB, SLOTS};
        pg8::gemm_phase<pg8::EpiWout, pg8::GOrder, true, true>(lds + RING_OFF, g, S, E);
        if (BOTH(5) && rep == REPS(5) - 1) GRID_BAR();
    }
    if (IN(6)) for (int rep = 0; rep < REPS(6); ++rep) {
        pg8::Gemm g{HB, WqT, T, 2048, DM}; pg8::GOrder S; S.init(T, 2048, G, bx); pg8::EpiBf16<0> E{QRY, 2048, nullptr, 0, 0, 1.f};
        pg8::gemm_phase<pg8::EpiBf16<0>, pg8::GOrder, true, true>(lds + RING_OFF, g, S, E);
        if (BOTH(6) && rep == REPS(6) - 1) GRID_BAR();
    }
    if (IN(7)) for (int rep = 0; rep < REPS(7); ++rep) {
        for (int v = vcu; v < 256; v += G) {
            pk::topk_fill(SK, lds + RING_OFF, v & 3, tid);
#ifndef PROBE_SKIP
#define PROBE_SKIP 0
#endif
            const bool lastrep = rep == REPS(7) - 1;
#ifndef P7_NRQ
#define P7_NRQ 4
#endif
#ifdef P7_STAGGER
            if (wave < 4 && (!(PROBE_SKIP & 1) || lastrep)) pk::topk_task(QRY, SLOTS, SEL, lds + RING_OFF, v & 3, ((v >> 2) * 8 + wave) * 32, lane);
#endif
            if (v == vcu && (!(PROBE_SKIP & 2) || lastrep)) {
                const int qgw = vcu * NWAVES + wave, QNGW = G * NWAVES;
                for (int m = qgw; m < NEXP; m += P7_NRQ * QNGW) quant_rows_i4<P7_NRQ, false>(peer_u, UQ, SU, m, QNGW, NEXP, lane);
                for (int m = qgw; m < NEXP; m += P7_NRQ * QNGW) quant_rows_i4<P7_NRQ, true>(peer_v, VQ, SV, m, QNGW, NEXP, lane);
                float gf[16];
#pragma unroll
                for (int j = 0; j < 16; ++j) gf[j] = g_ffn[4 * lane + 256 * (j >> 2) + (j & 3)];
                for (int t = qgw; t < T; t += P7_NRQ * QNGW) quant_x<P7_NRQ>(HB, XQ, SX, XSM, gf, t, QNGW, lane);
            }
#ifdef P7_STAGGER
            if (wave >= 4 && (!(PROBE_SKIP & 1) || lastrep)) pk::topk_task(QRY, SLOTS, SEL, lds + RING_OFF, v & 3, ((v >> 2) * 8 + wave) * 32, lane);
#else
            if (!(PROBE_SKIP & 1) || lastrep) pk::topk_task(QRY, SLOTS, SEL, lds + RING_OFF, v & 3, ((v >> 2) * 8 + wave) * 32, lane);
#endif
            __syncthreads();
        }
        if (BOTH(7) && rep == REPS(7) - 1) GRID_BAR();
    }
#if !MK_SPLIT
    const int xcc = (int)bar.x & 7;
    const int nloc = (int)__builtin_amdgcn_readfirstlane((int)MISC[8]), wrank = (int)__builtin_amdgcn_readfirstlane((int)MISC[10]);
    const pk_plan_t plan = slice_plan(xcc, wrank * NWAVES + wave, nloc * NWAVES, (const unsigned*)(ctl + CW_BAR) + XB_XCNT(0), lane);
#else
    const int xcc = (int)(xb_xcc_id() & 7u);
    const pk_plan_t plan = slice_plan(xcc, 0, 0, nullptr, lane);
#endif
    if (IN(8)) for (int rep = 0; rep < REPS(8); ++rep) {
        #ifdef PROBE_MASKV
        gather_u(SEL, XQ, UQ, PART, (int*)(ws + WS_END), (unsigned*)(ctl + CW_QU + 4096 * rep), plan, lane, (rep == REPS(8) - 1) ? 0xffffu : (unsigned)PROBE_MASKV);
#else
        gather_u(SEL, XQ, UQ, PART, (int*)(ws + WS_END), (unsigned*)(ctl + CW_QU + 4096 * rep), plan, lane);
#endif
        if (BOTH(8) && rep == REPS(8) - 1) GRID_BAR();
    }
    if (IN(9)) for (int rep = 0; rep < REPS(9); ++rep) {
        for (int t = gw; t < T; t += 4 * NGW) gather_coef<4>(SEL, PART, SU, SV, SX, XSM, CQ, EO, CS, CM, t, NGW, lane);
        if (BOTH(9) && rep == REPS(9) - 1) GRID_BAR();
    }
    if (IN(10)) for (int rep = 0; rep < REPS(10); ++rep) {
        gather_v(EO, CQ, CS, CM, VQ, HB, (rep == REPS(10) - 1) ? out : (float*)PART, (float*)(ws + WS_END), (unsigned*)(ctl + CW_QV + 4096 * rep), plan, lane);
    }
#undef IN
#undef BOTH
}

extern "C" void kernel_launch(void* const* d_in, const int* in_sizes, int n_in, void* d_out, int out_size, void* d_ws, size_t ws_size, hipStream_t stream) {
    static int grid = 0;
    if (grid == 0) {
        if (n_in != 21 || out_size != T * DM || ws_size < WS_END + 4096) { fprintf(stderr, "kernel_launch: unexpected shapes (n_in %d, out %d, ws %zu)\n", n_in, out_size, ws_size); grid = -1; return; }
        int dev = 0, cus = 0, per_cu = 0;
        if (hipGetDevice(&dev) != hipSuccess || hipDeviceGetAttribute(&cus, hipDeviceAttributeMultiprocessorCount, dev) != hipSuccess) { grid = -1; return; }
        if (hipFuncSetAttribute((const void*)fwd, hipFuncAttributeMaxDynamicSharedMemorySize, LDS_BYTES) != hipSuccess) { fprintf(stderr, "kernel_launch: hipFuncSetAttribute failed\n"); grid = -1; return; }
        if (hipOccupancyMaxActiveBlocksPerMultiprocessor(&per_cu, (const void*)fwd, NWAVES * 64, LDS_BYTES) != hipSuccess || per_cu < 1) { fprintf(stderr, "kernel_launch: occupancy query reports %d\n", per_cu); }
        (void)hipGetLastError();
        grid = cus;
    }
    if (grid < 0) return;
    (void)hipMemsetAsync((char*)d_ws + WS_CTL, 0, CTL_ZERO_BYTES, stream);
    Args a{};
    for (int i = 0; i < 21; ++i) a.in[i] = (const float*)d_in[i];
    a.out = (float*)d_out; a.ws = (unsigned char*)d_ws;
#if MK_SPLIT
    for (int p = 0; p < NPHASE; ++p) { a.ph_lo = p; a.ph_hi = p + 1; hipLaunchKernelGGL(fwd, dim3(grid), dim3(NWAVES * 64), LDS_BYTES, stream, a); }
#else
#if defined(PROBE_UPTO)
    a.ph_lo = 0; a.ph_hi = PROBE_UPTO + 1;
    hipLaunchKernelGGL(fwd, dim3(grid), dim3(NWAVES * 64), LDS_BYTES, stream, a);
    (void)hipMemsetAsync((char*)d_ws + WS_CTL, 0, CTL_ZERO_BYTES, stream);
#endif
    a.ph_lo = 0; a.ph_hi = NPHASE;
    hipLaunchKernelGGL(fwd, dim3(grid), dim3(NWAVES * 64), LDS_BYTES, stream, a);
#endif
}
```

```cpp
#define P7_NRQ 8
#include <hip/hip_runtime.h>
#include <hip/hip_bf16.h>
#include <cstdio>
#include <cstdint>
#include <cmath>
namespace pg8 {
#define PG8_LAS __attribute__((address_space(3)))
typedef unsigned short bf16_t;
typedef short bf16x8 __attribute__((ext_vector_type(8)));
typedef float f32x4 __attribute__((ext_vector_type(4)));
typedef unsigned u32x4 __attribute__((ext_vector_type(4)));
typedef int i32x4 __attribute__((ext_vector_type(4)));
constexpr int BM = 256, BK = 64, HALF = 128, HTB = HALF * BK * 2  , STAGE_BYTES = 8 * HTB, NXCD = 8, WGM = 8;

__host__ __device__ __forceinline__ int lds_byte(int r, int c) { const int st = (r >> 4) * 2 + (c >> 5), rr = r & 15, cc = c & 31, ob = rr * 64 + cc * 2; return st * 1024 + (ob ^ (((ob >> 9) & 1) << 5)); }
__host__ __device__ __forceinline__ void stage_rc(int b, int& R, int& C) { const int st = b / 1024, sb = b % 1024, swz = sb ^ (((sb >> 9) & 1) << 5); R = (st >> 1) * 16 + swz / 64; C = (st & 1) * 32 + (swz % 64) / 2; }
__host__ __device__ __forceinline__ int perm32(int rho) { const int n = rho >> 4, i = rho & 15; return 8 * (i >> 2) + 4 * n + (i & 3); }

struct Unit { int pm, pn; };
struct Gemm { const bf16_t* A; const bf16_t* Bt; int M, N, K; };

struct StaticOrder {
    int nM, nN, nwg, G, c;
    __host__ __device__ void init(int M, int N, int G_, int c_) { nM = M / BM; nN = N / BM; nwg = nM * nN; G = G_; c = c_; }
    __host__ __device__ bool next(int i, Unit& u) const {
        const long L = (long)i * G + c; if (L >= nwg) return false;
        int wgid = (int)L; { const int q = nwg / NXCD, r = nwg % NXCD, xcd = wgid % NXCD, off = wgid / NXCD; wgid = (xcd < r ? xcd * (q + 1) : r * (q + 1) + (xcd - r) * q) + off; }
        const int nig = WGM * nN, gid = wgid / nig, fm = gid * WGM, gsz = (nM - fm) < WGM ? (nM - fm) : WGM;
        u.pm = fm + ((wgid % nig) % gsz); u.pn = (wgid % nig) / gsz; return true;
    }
    __device__ __forceinline__ void a_ready(const Unit&) const {}
    __device__ __forceinline__ void done(const Unit&) const {}
};

__device__ __forceinline__ unsigned cvt_pk_bf16(float lo, float hi) { unsigned r; asm volatile("v_cvt_pk_bf16_f32 %0, %1, %2" : "=v"(r) : "v"(lo), "v"(hi)); return r; }
typedef float f32x2 __attribute__((ext_vector_type(2)));
__device__ __forceinline__ f32x2 gelu_pk(f32x2 v) {
    const f32x2 av = __builtin_elementwise_abs(v), d = av * 0.2316418882f + 1.0f;
    f32x2 t; t.x = __builtin_amdgcn_rcpf(d.x); t.y = __builtin_amdgcn_rcpf(d.y);
    f32x2 q = t * 0.5307027145f + (-0.7265760135f); q = q * t + 0.7107068705f; q = q * t + (-0.142248368f); q = q * t + 0.127414796f; q = q * t;
    const f32x2 s = (v * v) * (-0.72134752044f);
    f32x2 e; e.x = __builtin_amdgcn_exp2f(s.x); e.y = __builtin_amdgcn_exp2f(s.y);
    const f32x2 m = v * (q * e), r = v - m;
    f32x2 o; o.x = v.x < 0.f ? m.x : r.x; o.y = v.y < 0.f ? m.y : r.y; return o;
}

template <int ACT  > struct EpiBf16 {
    static constexpr bool PERM = true, AFTER_DRAIN = false, HEAD64 = false; static_assert(ACT == 0 || ACT == 1 || ACT == 2, "EpiBf16: ACT is 0 (none), 1 (gelu_pk) or 2 (sigmoid)");
    bf16_t* O; int ldc; const float* bias; int split_cols; size_t split_stride; float scale0;
    __device__ __forceinline__ void operator()(const f32x4 (&acc)[2][2][4][2], const Unit& u, int wr, int wc, int fr, int fq) const {
        const int row0 = u.pm * BM + wr * 64 + fr; int colt = u.pn * BM; bf16_t* base = O;
        float sc = 1.f; if (split_cols) { const int t = colt / split_cols; base += (size_t)t * split_stride; colt -= t * split_cols; if (t == 0) sc = scale0; }
        const int col0 = colt + wc * 32 + 8 * fq, bcol0 = u.pn * BM + wc * 32 + 8 * fq;
        f32x4 bv[2][2];
#pragma unroll
        for (int bj = 0; bj < 2; ++bj)
#pragma unroll
            for (int n = 0; n < 2; ++n) bv[bj][n] = bias ? *(const f32x4*)(bias + bcol0 + bj * HALF + 4 * n) : (f32x4){0.f, 0.f, 0.f, 0.f};
#pragma unroll
        for (int ai = 0; ai < 2; ++ai)
#pragma unroll
            for (int m = 0; m < 4; ++m) { bf16_t* rowp = base + (size_t)(row0 + ai * HALF + m * 16) * ldc + col0;
#pragma unroll
                for (int bj = 0; bj < 2; ++bj) { f32x4 v0 = acc[ai][bj][m][0] + bv[bj][0], v1 = acc[ai][bj][m][1] + bv[bj][1];
                    if (ACT == 1) { f32x2 a = gelu_pk((f32x2){v0[0], v0[1]}), b = gelu_pk((f32x2){v0[2], v0[3]}), c = gelu_pk((f32x2){v1[0], v1[1]}), d = gelu_pk((f32x2){v1[2], v1[3]});
                        v0 = (f32x4){a.x, a.y, b.x, b.y}; v1 = (f32x4){c.x, c.y, d.x, d.y}; }
                    if (ACT == 2) { _Pragma("unroll") for (int e_ = 0; e_ < 4; ++e_) { v0[e_] = __builtin_amdgcn_rcpf(1.0f + __builtin_amdgcn_exp2f(-1.4426950408889634f * v0[e_])); v1[e_] = __builtin_amdgcn_rcpf(1.0f + __builtin_amdgcn_exp2f(-1.4426950408889634f * v1[e_])); } }
                    v0 = v0 * sc; v1 = v1 * sc; u32x4 w; w.x = cvt_pk_bf16(v0[0], v0[1]); w.y = cvt_pk_bf16(v0[2], v0[3]); w.z = cvt_pk_bf16(v1[0], v1[1]); w.w = cvt_pk_bf16(v1[2], v1[3]);
                    *(u32x4*)(rowp + bj * HALF) = w; } }
    }
};


struct GOrder {
    int nM, nN, nwg, G, c;
    __host__ __device__ void init(int M, int N, int G_, int c_) { nM = M / BM; nN = N / BM; nwg = nM * nN; G = G_; c = c_; }
    __host__ __device__ bool next(int i, Unit& u) const {
        if (c < 0) return false;
        const long L = (long)i * G + c; if (L >= nwg) return false;
        int wgid = (int)L; { const int q = nwg / NXCD, r = nwg % NXCD, xcd = wgid % NXCD, off = wgid / NXCD; wgid = (xcd < r ? xcd * (q + 1) : r * (q + 1) + (xcd - r) * q) + off; }
        const int nig = WGM * nN, gid = wgid / nig, fm = gid * WGM, gsz = (nM - fm) < WGM ? (nM - fm) : WGM;
        u.pm = fm + ((wgid % nig) % gsz); u.pn = (wgid % nig) / gsz; return true;
    }
    __device__ __forceinline__ void a_ready(const Unit&) const {}
    __device__ __forceinline__ void done(const Unit&) const {}
};
struct BranchOrder {
    GOrder g;
    __device__ void init(int G, int c) { g.init(16384, 1024, G, c); }
#if defined(PROBE_P4X2)
    __device__ bool next(int i, Unit& u) const { Unit t; if (i >= 6 || !g.next(0, t)) return false; const int br = i % 3; u.pm = 64 * br + t.pm; u.pn = 4 * br + t.pn; return true; }
#else
    __device__ bool next(int i, Unit& u) const { Unit t; if (!g.next(i / 3, t)) return false; const int br = i % 3; u.pm = 64 * br + t.pm; u.pn = 4 * br + t.pn; return true; }
#endif
    __device__ __forceinline__ void a_ready(const Unit&) const {}
    __device__ __forceinline__ void done(const Unit&) const {}
};
__device__ __forceinline__ float bf_lo(unsigned w) { return __builtin_bit_cast(float, w << 16); }
__device__ __forceinline__ float bf_hi(unsigned w) { return __builtin_bit_cast(float, w & 0xffff0000u); }
__device__ __forceinline__ float sigmoid_f(float x) { return __builtin_amdgcn_rcpf(1.0f + __builtin_amdgcn_exp2f(-1.4426950408889634f * x)); }
struct EpiProj {
    static constexpr bool PERM = true, AFTER_DRAIN = false, HEAD64 = true;
    bf16_t* PA; bf16_t* PG; const float* gq; const float* gk; float* KMEAN; float qscale, eps; const float* SA; const float* SB;
    __device__ __forceinline__ void operator()(const f32x4 (&acc)[2][2][4][2], const Unit& u, int wr, int wc, int fr, int fq) const {
        f32x4 sbv[2][2];
        { const float* sp = SB + u.pn * BM + wc * 64 + 8 * fq;
#pragma unroll
          for (int bj = 0; bj < 2; ++bj)
#pragma unroll
              for (int n = 0; n < 2; ++n) sbv[bj][n] = *(const f32x4*)(sp + 32 * bj + 4 * n); }
#define EPQ(ai, bj, m, n, sa) ({ const i32x4 a_ = __builtin_bit_cast(i32x4, acc[ai][bj][m][n]); const f32x4 s_ = sbv[bj][n] * (sa); (f32x4){(float)a_[0] * s_[0], (float)a_[1] * s_[1], (float)a_[2] * s_[2], (float)a_[3] * s_[3]}; })
        const bool gate = u.pn >= 14; const int mode = u.pn < 2 ? 1 : (u.pn < 4 ? 2 : 0);
        bf16_t* base = gate ? PG : PA; const int ldc = gate ? 3072 : 3584; const int colt = gate ? (u.pn - 14) * BM : u.pn * BM;
        const int row0 = u.pm * BM + wr * 64 + fr, col0 = colt + wc * 64 + 8 * fq;
        f32x4 gn[2][2]; f32x4 cs[2][2];
#pragma unroll
        for (int bj = 0; bj < 2; ++bj)
#pragma unroll
            for (int n = 0; n < 2; ++n) { cs[bj][n] = (f32x4){0.f, 0.f, 0.f, 0.f}; gn[bj][n] = (f32x4){1.f, 1.f, 1.f, 1.f};
                if (mode) { const float* gp = (mode == 1 ? gq : gk) + 32 * bj + 8 * fq + 4 * n; const float sc = mode == 1 ? qscale : 1.0f; gn[bj][n] = (f32x4){gp[0] * sc, gp[1] * sc, gp[2] * sc, gp[3] * sc}; } }
#pragma unroll
        for (int ai = 0; ai < 2; ++ai)
#pragma unroll
            for (int m = 0; m < 4; ++m) { bf16_t* rowp = base + (size_t)(row0 + ai * HALF + m * 16) * ldc + col0;
                const float sa = SA[row0 + ai * HALF + m * 16];
                float r = 1.f;
                if (mode) { float ss = 0.f;
#pragma unroll
                    for (int bj = 0; bj < 2; ++bj)
#pragma unroll
                        for (int n = 0; n < 2; ++n) { const f32x4 v = EPQ(ai, bj, m, n, sa); ss += (v[0] * v[0] + v[1] * v[1]) + (v[2] * v[2] + v[3] * v[3]); }
                    ss += __shfl_xor(ss, 16); ss += __shfl_xor(ss, 32);
                    r = 1.0f / sqrtf(ss * (1.f / 64.f) + eps); }
#pragma unroll
                for (int bj = 0; bj < 2; ++bj) { f32x4 v0 = EPQ(ai, bj, m, 0, sa), v1 = EPQ(ai, bj, m, 1, sa);
                    if (gate) {
#pragma unroll
                        for (int e = 0; e < 4; ++e) { v0[e] = sigmoid_f(v0[e]); v1[e] = sigmoid_f(v1[e]); } }
                    if (mode) { v0 = v0 * r * gn[bj][0]; v1 = v1 * r * gn[bj][1]; if (mode == 2) { cs[bj][0] += v0; cs[bj][1] += v1; } }
                    if (gate) {
                        typedef unsigned u32x2g __attribute__((ext_vector_type(2))); unsigned q[8];
#pragma unroll
                        for (int e = 0; e < 4; ++e) { q[e] = (unsigned)__builtin_rintf(v0[e] * 255.f); q[4 + e] = (unsigned)__builtin_rintf(v1[e] * 255.f); }
                        u32x2g wq; wq.x = q[0] | (q[1] << 8) | (q[2] << 16) | (q[3] << 24); wq.y = q[4] | (q[5] << 8) | (q[6] << 16) | (q[7] << 24);
                        *(u32x2g*)((unsigned char*)PG + (size_t)(row0 + ai * HALF + m * 16) * 3072 + col0 + bj * 32) = wq;
                    } else {
                    u32x4 w; w.x = cvt_pk_bf16(v0[0], v0[1]); w.y = cvt_pk_bf16(v0[2], v0[3]); w.z = cvt_pk_bf16(v1[0], v1[1]); w.w = cvt_pk_bf16(v1[2], v1[3]);
                    *(u32x4*)(rowp + bj * 32) = w; } } }
        if (mode == 2) {
            const int b = u.pm >> 3, nb = u.pm & 7, head = (u.pn - 2) * 4 + wc;
            float* km = KMEAN + (size_t)((b * 8 + head) * 8 + nb) * 64 + 8 * fq;
#pragma unroll
            for (int bj = 0; bj < 2; ++bj)
#pragma unroll
                for (int n = 0; n < 2; ++n)
#pragma unroll
                    for (int e = 0; e < 4; ++e) { float s = cs[bj][n][e];
                        s += __shfl_xor(s, 1); s += __shfl_xor(s, 2); s += __shfl_xor(s, 4); s += __shfl_xor(s, 8);
                        if (fr == 0) atomicAdd(km + 32 * bj + 4 * n + e, s * (1.f / 256.f)); }
        }
    }
};
struct EpiBranch {
    static constexpr bool PERM = true, AFTER_DRAIN = false, HEAD64 = false;
    const bf16_t* PG; bf16_t* MG;
    __device__ __forceinline__ void operator()(const f32x4 (&acc)[2][2][4][2], const Unit& u, int wr, int wc, int fr, int fq) const {
        const int br = u.pm >> 6, tm = u.pm & 63, tn = u.pn & 3;
        const int row0 = tm * BM + wr * 64 + fr, col0 = tn * BM + wc * 32 + 8 * fq;
#pragma unroll
        for (int ai = 0; ai < 2; ++ai) {
            typedef unsigned u32x2g __attribute__((ext_vector_type(2)));
            u32x2g g[4][2]; u32x4 p[4][2];
#pragma unroll
            for (int m = 0; m < 4; ++m)
#pragma unroll
                for (int bj = 0; bj < 2; ++bj) { const size_t row = (size_t)(row0 + ai * HALF + m * 16); const int col = col0 + bj * HALF;
                    g[m][bj] = *(const u32x2g*)((const unsigned char*)PG + row * 3072 + br * 1024 + col);
                    p[m][bj] = (br > 0) ? *(const u32x4*)(MG + row * 1024 + col) : (u32x4){0u, 0u, 0u, 0u}; }
#pragma unroll
            for (int m = 0; m < 4; ++m)
#pragma unroll
                for (int bj = 0; bj < 2; ++bj) { const size_t row = (size_t)(row0 + ai * HALF + m * 16); const int col = col0 + bj * HALF;
                    const u32x2g gg = g[m][bj]; const u32x4 pp = p[m][bj]; constexpr float GS = 1.f / 255.f;
                    f32x4 v0 = acc[ai][bj][m][0], v1 = acc[ai][bj][m][1];
                    v0[0] = v0[0] * ((float)(gg.x & 0xffu) * GS) + bf_lo(pp.x); v0[1] = v0[1] * ((float)((gg.x >> 8) & 0xffu) * GS) + bf_hi(pp.x); v0[2] = v0[2] * ((float)((gg.x >> 16) & 0xffu) * GS) + bf_lo(pp.y); v0[3] = v0[3] * ((float)(gg.x >> 24) * GS) + bf_hi(pp.y);
                    v1[0] = v1[0] * ((float)(gg.y & 0xffu) * GS) + bf_lo(pp.z); v1[1] = v1[1] * ((float)((gg.y >> 8) & 0xffu) * GS) + bf_hi(pp.z); v1[2] = v1[2] * ((float)((gg.y >> 16) & 0xffu) * GS) + bf_lo(pp.w); v1[3] = v1[3] * ((float)(gg.y >> 24) * GS) + bf_hi(pp.w);
                    u32x4 w; w.x = cvt_pk_bf16(v0[0], v0[1]); w.y = cvt_pk_bf16(v0[2], v0[3]); w.z = cvt_pk_bf16(v1[0], v1[1]); w.w = cvt_pk_bf16(v1[2], v1[3]);
                    *(u32x4*)(MG + row * 1024 + col) = w; }
        }
    }
};
struct EpiWout {
    static constexpr bool PERM = false, AFTER_DRAIN = false, HEAD64 = false;
    const float* X; float* H; bf16_t* HB; float* SL;
    __device__ __forceinline__ void operator()(const f32x4 (&acc)[2][2][4][2], const Unit& u, int wr, int wc, int fr, int fq) const {
        typedef unsigned u32x2v __attribute__((ext_vector_type(2)));
        const int row0 = u.pm * BM + wr * 64 + fr, col0 = u.pn * BM + wc * 32 + 4 * fq;
#pragma unroll
        for (int ai = 0; ai < 2; ++ai)
#pragma unroll
            for (int mh = 0; mh < 2; ++mh) {
                f32x4 xv[2][2][2];
#pragma unroll
                for (int mm = 0; mm < 2; ++mm)
#pragma unroll
                    for (int bj = 0; bj < 2; ++bj)
#pragma unroll
                        for (int n = 0; n < 2; ++n) xv[mm][bj][n] = *(const f32x4*)(X + (size_t)(row0 + ai * HALF + (2 * mh + mm) * 16) * 1024 + col0 + bj * HALF + n * 16);
#pragma unroll
                for (int mm = 0; mm < 2; ++mm) { const int m = 2 * mh + mm; const size_t row = (size_t)(row0 + ai * HALF + m * 16); float ss = 0.f;
#pragma unroll
                    for (int bj = 0; bj < 2; ++bj)
#pragma unroll
                        for (int n = 0; n < 2; ++n) { const size_t off = row * 1024 + col0 + bj * HALF + n * 16;
                            const f32x4 hv = xv[mm][bj][n] + acc[ai][bj][m][n];
                            ss += (hv[0] * hv[0] + hv[1] * hv[1]) + (hv[2] * hv[2] + hv[3] * hv[3]);
                            u32x2v w; w.x = cvt_pk_bf16(hv[0], hv[1]); w.y = cvt_pk_bf16(hv[2], hv[3]);
                            *(u32x2v*)(HB + off) = w; }
                    ss += __shfl_xor(ss, 16); ss += __shfl_xor(ss, 32);
                    if (fq == 0) SL[row * 16 + u.pn * 4 + wc] = ss; }
            }
    }
};
template <class Epi, class Sched, bool ALIGN_EPI = false, bool SP2 = false, bool I8 = false>
__device__ __forceinline__ void gemm_phase(PG8_LAS unsigned char* lds, const Gemm g, const Sched& S, const Epi& E) {
    const int tid = threadIdx.x, wid = __builtin_amdgcn_readfirstlane(tid >> 6), lane = tid & 63, wr = wid >> 2, wc = wid & 3, fr = lane & 15, fq = lane >> 4;
    const int K = g.K, nt = K / BK;
    unsigned voffA[2], voffB[2];
#pragma unroll
    for (int i = 0; i < 2; ++i) { int R, C; stage_rc(tid * 16 + i * 8192, R, C); const int Rb = Epi::HEAD64 ? (64 * (R >> 5) + perm32(R & 31)) : (Epi::PERM ? ((R & ~31) + perm32(R & 31)) : R);
        voffA[i] = (unsigned)(R * K + C) * 2u; voffB[i] = (unsigned)(Rb * K + C) * 2u; }
    const size_t kstep = (size_t)(BK * 2);
    const size_t hstep = (size_t)HALF * K * 2;
    const size_t hstepB = Epi::HEAD64 ? (size_t)32 * K * 2 : hstep;
    const size_t tstep = 2 * hstep;
    const unsigned ldsw = (unsigned)wid * 1024u;
    const int aoff = lds_byte(wr * 64 + fr, fq * 8), boff = lds_byte(wc * 32 + fr, fq * 8);
#define PG8_SA(b, h) (((b) * 2 + (h)) * HTB)
#define PG8_SB(b, h) ((4 + (b) * 2 + (h)) * HTB)
#define PG8_STAGE(bufoff, gbase, voff) do { _Pragma("unroll") for (int _i = 0; _i < 2; ++_i) \
        __builtin_amdgcn_global_load_lds((const unsigned*)((const char*)(gbase) + (voff)[_i]), (PG8_LAS unsigned*)(lds + (bufoff) + ldsw + _i * 8192), 16, 0, 0); } while (0)
#define PG8_LDA(dst, b, h) do { _Pragma("unroll") for (int m = 0; m < 4; ++m) _Pragma("unroll") for (int k = 0; k < 2; ++k) dst[m][k] = *(const PG8_LAS bf16x8*)(lds + PG8_SA(b, h) + aoff + m * 2048 + k * 1024); } while (0)
#define PG8_LDB(dst, b, h) do { _Pragma("unroll") for (int n = 0; n < 2; ++n) _Pragma("unroll") for (int k = 0; k < 2; ++k) dst[n][k] = *(const PG8_LAS bf16x8*)(lds + PG8_SB(b, h) + boff + n * 2048 + k * 1024); } while (0)
#define PG8_MMA(ai, bj, At, Bt) do { __builtin_amdgcn_s_setprio(1); _Pragma("unroll") for (int m = 0; m < 4; ++m) _Pragma("unroll") for (int n = 0; n < 2; ++n) _Pragma("unroll") for (int k = 0; k < 2; ++k) \
        { if constexpr (I8) acc[ai][bj][m][n] = __builtin_bit_cast(f32x4, __builtin_amdgcn_mfma_i32_16x16x64_i8(__builtin_bit_cast(i32x4, Bt[n][k]), __builtin_bit_cast(i32x4, At[m][k]), __builtin_bit_cast(i32x4, acc[ai][bj][m][n]), 0, 0, 0)); \
          else acc[ai][bj][m][n] = __builtin_amdgcn_mfma_f32_16x16x32_bf16(Bt[n][k], At[m][k], acc[ai][bj][m][n], 0, 0, 0); } __builtin_amdgcn_s_setprio(0); } while (0)
#define PG8_WAIT_V(n) asm volatile("s_waitcnt vmcnt(" #n ")" ::: "memory")
#define PG8_WAIT_L(n) asm volatile("s_waitcnt lgkmcnt(" #n ")" ::: "memory")
#define PG8_BAR __builtin_amdgcn_s_barrier()
#define PG8_SCHED __builtin_amdgcn_sched_barrier(0)
    Unit cur, nxt; int ui = 0;
    if (!S.next(0, cur)) return;
    f32x4 acc[2][2][4][2];
#pragma unroll
    for (int a = 0; a < 2; ++a)
#pragma unroll
        for (int b = 0; b < 2; ++b)
#pragma unroll
            for (int m = 0; m < 4; ++m)
#pragma unroll
                for (int n = 0; n < 2; ++n) acc[a][b][m][n] = (f32x4){0.f, 0.f, 0.f, 0.f};
    bf16x8 At[4][2], B0[2][2], B1[2][2];
    const char* cA = (const char*)g.A + (size_t)cur.pm * tstep; const char* cB = (const char*)g.Bt + (size_t)cur.pn * tstep;
    S.a_ready(cur);
    if constexpr (SP2) {
        PG8_STAGE(PG8_SB(0, 0), cB, voffB); PG8_STAGE(PG8_SB(0, 1), cB + hstepB, voffB); PG8_STAGE(PG8_SA(0, 0), cA, voffA); PG8_STAGE(PG8_SA(0, 1), cA + hstep, voffA);
        if (wr == 1) PG8_BAR;
        PG8_WAIT_V(2); PG8_BAR;
        PG8_STAGE(PG8_SB(1, 0), cB + kstep, voffB); PG8_STAGE(PG8_SA(1, 0), cA + kstep, voffA); PG8_STAGE(PG8_SB(1, 1), cB + hstepB + kstep, voffB);
        PG8_WAIT_V(6); PG8_BAR;
    } else {
        PG8_STAGE(PG8_SB(0, 0), cB, voffB); PG8_STAGE(PG8_SA(0, 0), cA, voffA); PG8_STAGE(PG8_SB(0, 1), cB + hstepB, voffB); PG8_STAGE(PG8_SA(0, 1), cA + hstep, voffA);
        if (wr == 1) PG8_BAR;
        PG8_WAIT_V(4); PG8_BAR;
        PG8_STAGE(PG8_SB(1, 0), cB + kstep, voffB); PG8_STAGE(PG8_SA(1, 0), cA + kstep, voffA); PG8_STAGE(PG8_SB(1, 1), cB + hstepB + kstep, voffB);
        PG8_WAIT_V(6); PG8_BAR;
    }
    for (;;) {
        const bool has_next = S.next(ui + 1, nxt);
        const char* nA = has_next ? (const char*)g.A + (size_t)nxt.pm * tstep : cA; const char* nB = has_next ? (const char*)g.Bt + (size_t)nxt.pn * tstep : cB;
        for (int t = 0; t < nt; t += 2) {
            const bool last = (t == nt - 2);
            const char* a1 = cA + (size_t)(t + 1) * kstep;
            const char* a2 = last ? nA : cA + (size_t)(t + 2) * kstep; const char* b2 = last ? nB : cB + (size_t)(t + 2) * kstep;
            const char* a3 = a2 + kstep; const char* b3 = b2 + kstep;
            if (last && has_next) S.a_ready(nxt);
            if constexpr (SP2) {
            PG8_LDB(B0, 0, 0); PG8_LDB(B1, 0, 1); PG8_SCHED; PG8_LDA(At, 0, 0); PG8_STAGE(PG8_SA(1, 1), a1 + hstep, voffA);
            PG8_WAIT_V(8); PG8_WAIT_L(0); PG8_BAR; PG8_MMA(0, 0, At, B0); PG8_MMA(0, 1, At, B1); PG8_BAR; PG8_SCHED;
            PG8_LDA(At, 0, 1); PG8_STAGE(PG8_SB(0, 0), b2, voffB); PG8_STAGE(PG8_SB(0, 1), b2 + hstepB, voffB); PG8_STAGE(PG8_SA(0, 0), a2, voffA);
            PG8_WAIT_V(8); PG8_WAIT_L(0); PG8_BAR; PG8_MMA(1, 0, At, B0); PG8_MMA(1, 1, At, B1); PG8_BAR; PG8_SCHED;
            PG8_LDB(B0, 1, 0); PG8_LDB(B1, 1, 1); PG8_SCHED; PG8_LDA(At, 1, 0); PG8_STAGE(PG8_SA(0, 1), a2 + hstep, voffA);
            PG8_WAIT_V(8); PG8_WAIT_L(0); PG8_BAR; PG8_MMA(0, 0, At, B0); PG8_MMA(0, 1, At, B1); PG8_BAR; PG8_SCHED;
            PG8_LDA(At, 1, 1); PG8_STAGE(PG8_SB(1, 0), b3, voffB); PG8_STAGE(PG8_SB(1, 1), b3 + hstepB, voffB); PG8_STAGE(PG8_SA(1, 0), a3, voffA);
            PG8_WAIT_V(8); PG8_WAIT_L(0); PG8_BAR; PG8_MMA(1, 0, At, B0); PG8_MMA(1, 1, At, B1); PG8_BAR; PG8_SCHED;
            } else {
            PG8_LDB(B0, 0, 0); PG8_SCHED; PG8_LDA(At, 0, 0); PG8_STAGE(PG8_SA(1, 1), a1 + hstep, voffA);
            PG8_WAIT_L(8); PG8_BAR; PG8_WAIT_L(0); PG8_MMA(0, 0, At, B0); PG8_BAR; PG8_SCHED;
            PG8_LDB(B1, 0, 1); PG8_STAGE(PG8_SB(0, 0), b2, voffB);
            PG8_BAR; PG8_WAIT_L(0); PG8_MMA(0, 1, At, B1); PG8_BAR;
            PG8_LDA(At, 0, 1); PG8_STAGE(PG8_SA(0, 0), a2, voffA);
            PG8_BAR; PG8_WAIT_L(0); PG8_MMA(1, 0, At, B0); PG8_BAR; PG8_SCHED;
            PG8_STAGE(PG8_SB(0, 1), b2 + hstepB, voffB);
            PG8_WAIT_V(6); PG8_BAR; PG8_MMA(1, 1, At, B1); PG8_BAR;
            PG8_LDB(B0, 1, 0); PG8_SCHED; PG8_LDA(At, 1, 0); PG8_STAGE(PG8_SA(0, 1), a2 + hstep, voffA);
            PG8_WAIT_L(8); PG8_BAR; PG8_WAIT_L(0); PG8_MMA(0, 0, At, B0); PG8_BAR; PG8_SCHED;
            PG8_LDB(B1, 1, 1); PG8_STAGE(PG8_SB(1, 0), b3, voffB);
            PG8_BAR; PG8_WAIT_L(0); PG8_MMA(0, 1, At, B1); PG8_BAR;
            PG8_LDA(At, 1, 1); PG8_STAGE(PG8_SA(1, 0), a3, voffA);
            PG8_BAR; PG8_WAIT_L(0); PG8_MMA(1, 0, At, B0); PG8_BAR; PG8_SCHED;
            PG8_STAGE(PG8_SB(1, 1), b3 + hstepB, voffB);
            PG8_WAIT_V(6); PG8_BAR; PG8_MMA(1, 1, At, B1); PG8_BAR;
            }
        }
        if constexpr (ALIGN_EPI) { if (wr == 0) PG8_BAR; }
        if constexpr (!Epi::AFTER_DRAIN) { E(acc, cur, wr, wc, fr, fq); S.done(cur); }
        if (!has_next) break;
#pragma unroll
        for (int a = 0; a < 2; ++a)
#pragma unroll
            for (int b = 0; b < 2; ++b)
#pragma unroll
                for (int m = 0; m < 4; ++m)
#pragma unroll
                    for (int n = 0; n < 2; ++n) acc[a][b][m][n] = (f32x4){0.f, 0.f, 0.f, 0.f};
        cur = nxt; cA = nA; cB = nB; ++ui;
        if constexpr (ALIGN_EPI) { if (wr == 1) PG8_BAR; }
    }
    PG8_WAIT_V(0);
    if constexpr (!ALIGN_EPI) { if (wr == 0) PG8_BAR; }
    PG8_BAR;
    if constexpr (Epi::AFTER_DRAIN) { E.fused(acc, cur, wr, wc, fr, fq, lds, wid, lane); S.done(cur); }
#undef PG8_SA
#undef PG8_SB
#undef PG8_STAGE
#undef PG8_LDA
#undef PG8_LDB
#undef PG8_MMA
#undef PG8_WAIT_V
#undef PG8_WAIT_L
#undef PG8_BAR
#undef PG8_SCHED
}
}

constexpr int NWAVES = 8;
constexpr int T = 16384, DM = 1024, SEQ = 2048, NBATCH = 8, MEMLEN = 256;
constexpr int PW = 6656, PAW = 3584, PGW = 3072;
constexpr int COL_QA = 0, COL_KA = 512, COL_VA = 1024, COL_UC = 1536, COL_BC = 2048, COL_CC = 2560, COL_QX = 3072;
constexpr float RMS_EPS = 1e-6f, LOG2E = 1.4426950408889634f;
constexpr float C2A = 0.125f * LOG2E;
constexpr float C2X = 0.08838834764831845f * LOG2E;
constexpr int NEXP = 16384;

constexpr size_t MiB = 1u << 20;
constexpr size_t WS_CTL = 0, CTL_ZERO_BYTES = 1 * MiB;
constexpr size_t WS_WIN = 1 * MiB;
constexpr size_t WS_WKV = 14 * MiB;
constexpr size_t WS_WBR = 16 * MiB;
constexpr size_t WS_WOUT = 19 * MiB;
constexpr size_t WS_WQ = 21 * MiB;
constexpr size_t WS_SK = 25 * MiB;
constexpr size_t WS_TAB = 25 * MiB + 512 * 1024;
constexpr size_t WS_KMEAN = WS_CTL + 256 * 1024;
constexpr size_t WS_MEMN = 26 * MiB;
constexpr size_t WS_KVM = 30 * MiB;
constexpr size_t WS_SLOTS = 34 * MiB;
constexpr size_t WS_SEL = 35 * MiB;
constexpr size_t WS_SU = 43 * MiB, WS_SV = 43 * MiB + 65536, WS_SX = 43 * MiB + 2 * 65536, WS_CS = 43 * MiB + 3 * 65536, WS_CM = 43 * MiB + 4 * 65536, WS_XS = 43 * MiB + 5 * 65536, WS_SA = 43 * MiB + 6 * 65536, WS_SB = 43 * MiB + 7 * 65536;
constexpr size_t WS_PA = 44 * MiB;
constexpr size_t WS_PG = 156 * MiB;
constexpr size_t WS_END = 252 * MiB;
constexpr size_t PA_MERGED = WS_PA, PA_HB = WS_PA + 32 * MiB, PA_UT = WS_PA + 64 * MiB, PA_VT = WS_PA;
constexpr size_t PG_QRY = WS_PG, PG_PART = WS_PG, PG_COEF = WS_PG + 64 * MiB, PA_XQ = WS_PG + 80 * MiB;
constexpr int CW_QU = 8192, CW_QV = 8192 + 2048, CW_RANK = 8192 + 4096 + 8192;
constexpr int CW_BAR = 4096;

constexpr int RING_OFF = 0, RING_BYTES = 131072;
constexpr int LDSCTL_OFF = RING_BYTES, MISC_OFF = LDSCTL_OFF + 320;
constexpr int LDS_BYTES = 147456;

#define GAS __attribute__((address_space(1)))
#define LAS __attribute__((address_space(3)))
typedef unsigned short bf16;
typedef unsigned v4u __attribute__((ext_vector_type(4)));
typedef unsigned v2u __attribute__((ext_vector_type(2)));
typedef float f32x4 __attribute__((ext_vector_type(4)));
typedef float f32x16 __attribute__((ext_vector_type(16)));
typedef short bf16x8 __attribute__((ext_vector_type(8)));
typedef short s16x4 __attribute__((ext_vector_type(4)));
typedef GAS unsigned gu32;
#define RLX_AGENT __ATOMIC_RELAXED, __HIP_MEMORY_SCOPE_AGENT
#define LDS_WAIT() asm volatile("s_waitcnt lgkmcnt(0)" ::: "memory")
#define VM_WAIT() asm volatile("s_waitcnt vmcnt(0)" ::: "memory")
__device__ __forceinline__ unsigned f2bf(float f) { unsigned u = __builtin_bit_cast(unsigned, f); return (u + 0x7fffu + ((u >> 16) & 1u)) >> 16; }
__device__ __forceinline__ unsigned pk2(float lo, float hi) { return f2bf(lo) | (f2bf(hi) << 16); }
__device__ __forceinline__ float bflo(unsigned w) { return __builtin_bit_cast(float, w << 16); }
__device__ __forceinline__ float bfhi(unsigned w) { return __builtin_bit_cast(float, w & 0xffff0000u); }
__device__ __forceinline__ float wave_sum(float v) {
#pragma unroll
    for (int o = 1; o < 64; o <<= 1) v += __shfl_xor(v, o);
    return v;
}
#define XB_TMO      128
#define XB_XCNT(j)  (256  + 64 * (j))
#define XB_XSUB(j)  (1280 + 64 * (j))
#define XB_XGEN(j)  (2304 + 64 * (j))
#define XB_TOP      3328
#define XB_TOPGEN   3392
#define XCD_BAR_WORDS 3456
#define XB_SPIN_CAP (1u << 18)

__device__ __forceinline__ unsigned xb_ld(unsigned* p)              { return __hip_atomic_load(p, __ATOMIC_RELAXED, __HIP_MEMORY_SCOPE_AGENT); }
__device__ __forceinline__ unsigned xb_add(unsigned* p, unsigned v) { return __hip_atomic_fetch_add(p, v, __ATOMIC_RELAXED, __HIP_MEMORY_SCOPE_AGENT); }
__device__ __forceinline__ unsigned xb_xcc_id() { return (unsigned)__builtin_amdgcn_s_getreg((3 << 11) | 20) & 0xFu; }
#define XB_SPIN(cond, bar) do { unsigned _sp = 0; while (cond) { __builtin_amdgcn_s_sleep(1); \
    if ((++_sp & 255u) == 0u) { if (xb_ld(&(bar)[XB_TMO])) break; if (_sp > XB_SPIN_CAP) { atomicAdd(&(bar)[XB_TMO], 1u); break; } } } } while (0)

struct XcdBarrier {
    unsigned* bar; unsigned x;
    volatile LAS unsigned* st;
};

__device__ __forceinline__ XcdBarrier xcd_barrier_post(unsigned* bar, volatile LAS unsigned* st) {
    XcdBarrier b; b.bar = bar; b.x = xb_xcc_id(); b.st = st;
    if (threadIdx.x == 0) (void)xb_add(&bar[XB_XCNT(b.x)], 1u);
    return b;
}
__device__ __forceinline__ void xcd_barrier_complete(unsigned* bar, unsigned x, unsigned& nloc, unsigned& nx) {
    const unsigned G = gridDim.x * gridDim.y * gridDim.z;
    unsigned sum, cnt, mine, sp = 0u;
    for (;;) {
        sum = 0u; cnt = 0u; mine = 0u;
#pragma unroll
        for (unsigned j = 0; j < 16; ++j) { const unsigned c = xb_ld(&bar[XB_XCNT(j)]); sum += c; cnt += (c > 0u) ? 1u : 0u; mine = (j == x) ? c : mine; }
        if (sum == G) break;
        __builtin_amdgcn_s_sleep(1);
        if ((++sp & 255u) == 0u) { if (xb_ld(&bar[XB_TMO])) break; if (sp > XB_SPIN_CAP) { atomicAdd(&bar[XB_TMO], 1u); break; } }
    }
    nloc = mine > 0u ? mine : 1u; nx = cnt > 0u ? cnt : 1u;
}

__device__ __forceinline__ void xcd_barrier(const XcdBarrier& b) {
    asm volatile("s_waitcnt vmcnt(0)" ::: "memory");
    __syncthreads();
    if (threadIdx.x < 64) {
        unsigned* bar = b.bar; const unsigned l = threadIdx.x;
        unsigned gen = 0u;
        if (l == 0u) {
            __builtin_amdgcn_s_waitcnt(0);
            unsigned nloc = b.st[0], nx = b.st[1];
            if (nloc == 0u) { xcd_barrier_complete(bar, b.x, nloc, nx); b.st[0] = nloc; b.st[1] = nx; }
            const unsigned old = xb_add(&bar[XB_XSUB(b.x)], 1u);
            gen = old / nloc;
            if (old + 1u == (gen + 1u) * nloc) {
                __builtin_amdgcn_fence(__ATOMIC_RELEASE, "agent");
                asm volatile("s_waitcnt vmcnt(0)" ::: "memory");
                __hip_atomic_store(&bar[XB_XGEN(b.x)], gen + 1u, __ATOMIC_RELAXED, __HIP_MEMORY_SCOPE_AGENT);
            }
        }
        gen = (unsigned)__builtin_amdgcn_readfirstlane((int)gen);
        const unsigned target = gen + 1u;
        const unsigned cntj = l < 16u ? xb_ld(&bar[XB_XCNT(l)]) : 0u;
        unsigned sp = 0u;
        for (;;) {
            const unsigned v = (l < 16u && cntj != 0u) ? xb_ld(&bar[XB_XGEN(l)]) : target;
            if (__builtin_amdgcn_ballot_w64((int)(v - target) >= 0) == ~0ull) break;
            __builtin_amdgcn_s_sleep(1);
            if ((++sp & 255u) == 0u) { if (__builtin_amdgcn_readfirstlane((int)xb_ld(&bar[XB_TMO]))) break; if (sp > XB_SPIN_CAP) { if (l == 0u) atomicAdd(&bar[XB_TMO], 1u); break; } }
        }
        __builtin_amdgcn_fence(__ATOMIC_ACQUIRE, "agent");
        asm volatile("s_waitcnt vmcnt(0)" ::: "memory");
    }
    __syncthreads();
}

__device__ __forceinline__ void p0_transpose_item(const float* W, int K, int N, bf16* WT, int row_off, const float* ksc, LAS float* scr, int item, int lane) {
    const int nblk = N / 32, kb = item / nblk, nb = item % nblk, k0 = 64 * kb, n0 = 32 * nb;
    { const int kr = lane >> 3, nq = lane & 7;
      f32x4 v[8];
#pragma unroll
      for (int i = 0; i < 8; ++i) v[i] = *(const GAS f32x4*)(W + (size_t)(k0 + 8 * i + kr) * N + n0 + 4 * nq);
#pragma unroll
      for (int i = 0; i < 8; ++i) { const int kk = 8 * i + kr; const float sc = ksc ? ksc[k0 + kk] : 1.f;
#pragma unroll
          for (int e = 0; e < 4; ++e) scr[kk * 33 + 4 * nq + e] = v[i][e] * sc; } }
    LDS_WAIT(); asm volatile("" ::: "memory");
    const int c = lane & 7;
#pragma unroll
    for (int j = 0; j < 4; ++j) { const int n = (lane >> 3) + 8 * j; const LAS float* s = scr + (8 * c) * 33 + n;
        v4u o; o.x = pk2(s[0 * 33], s[1 * 33]); o.y = pk2(s[2 * 33], s[3 * 33]); o.z = pk2(s[4 * 33], s[5 * 33]); o.w = pk2(s[6 * 33], s[7 * 33]);
        *(GAS v4u*)(WT + (size_t)(row_off + n0 + n) * K + k0 + 8 * c) = o; }
    LDS_WAIT(); asm volatile("" ::: "memory");
}
template <int NR> __device__ __forceinline__ void rms_rows_to_bf16(const float* X, const float* g, bf16* O, int m0, int ms, int mend, int lane) {
    const GAS f32x4* gr = (const GAS f32x4*)g + lane;
    f32x4 v[NR][4];
#pragma unroll
    for (int r = 0; r < NR; ++r) { const int m = (m0 + r * ms < mend) ? m0 + r * ms : mend - 1; const GAS f32x4* xr = (const GAS f32x4*)(X + (size_t)m * DM) + lane;
#pragma unroll
        for (int j = 0; j < 4; ++j) v[r][j] = xr[64 * j]; }
    f32x4 gv[4];
#pragma unroll
    for (int j = 0; j < 4; ++j) gv[j] = gr[64 * j];
#pragma unroll
    for (int r = 0; r < NR; ++r) { float s = 0.f;
#pragma unroll
        for (int j = 0; j < 4; ++j) s += (v[r][j].x * v[r][j].x + v[r][j].y * v[r][j].y) + (v[r][j].z * v[r][j].z + v[r][j].w * v[r][j].w);
        const float rr = 1.f / sqrtf(wave_sum(s) * (1.f / 1024.f) + RMS_EPS);
        if (m0 + r * ms < mend) { GAS unsigned long long* o8 = (GAS unsigned long long*)(O + (size_t)(m0 + r * ms) * DM) + lane;
#pragma unroll
            for (int j = 0; j < 4; ++j) o8[64 * j] = (unsigned long long)pk2(v[r][j].x * rr * gv[j].x, v[r][j].y * rr * gv[j].y) | ((unsigned long long)pk2(v[r][j].z * rr * gv[j].z, v[r][j].w * rr * gv[j].w) << 32); } }
}
template <int NR> __device__ __forceinline__ void rms_rows_to_i8(const float* X, const float* g, unsigned char* O, float* SA, int m0, int ms, int mend, int lane) {
    const GAS f32x4* gr = (const GAS f32x4*)g + lane;
    f32x4 v[NR][4];
#pragma unroll
    for (int r = 0; r < NR; ++r) { const int m = (m0 + r * ms < mend) ? m0 + r * ms : mend - 1; const GAS f32x4* xr = (const GAS f32x4*)(X + (size_t)m * DM) + lane;
#pragma unroll
        for (int j = 0; j < 4; ++j) v[r][j] = xr[64 * j]; }
    f32x4 gv[4];
#pragma unroll
    for (int j = 0; j < 4; ++j) gv[j] = gr[64 * j];
#pragma unroll
    for (int r = 0; r < NR; ++r) { float s = 0.f;
#pragma unroll
        for (int j = 0; j < 4; ++j) s += (v[r][j].x * v[r][j].x + v[r][j].y * v[r][j].y) + (v[r][j].z * v[r][j].z + v[r][j].w * v[r][j].w);
        const float rr = 1.f / sqrtf(wave_sum(s) * (1.f / 1024.f) + RMS_EPS);
        float am = 0.f;
#pragma unroll
        for (int j = 0; j < 4; ++j) { v[r][j] = v[r][j] * rr * gv[j]; am = fmaxf(am, fmaxf(fmaxf(fabsf(v[r][j].x), fabsf(v[r][j].y)), fmaxf(fabsf(v[r][j].z), fabsf(v[r][j].w)))); }
#pragma unroll
        for (int o = 1; o < 64; o <<= 1) am = fmaxf(am, __shfl_xor(am, o));
        const float sa = am > 0.f ? am * (1.f / 127.f) : 1.f, is = 1.f / sa;
        if (m0 + r * ms < mend) { GAS unsigned* o4 = (GAS unsigned*)(O + (size_t)(m0 + r * ms) * DM) + lane;
#pragma unroll
            for (int j = 0; j < 4; ++j) { const int a = (int)rintf(v[r][j].x * is), b = (int)rintf(v[r][j].y * is), c = (int)rintf(v[r][j].z * is), d = (int)rintf(v[r][j].w * is);
                o4[64 * j] = (unsigned)(a & 0xff) | ((unsigned)(b & 0xff) << 8) | ((unsigned)(c & 0xff) << 16) | ((unsigned)(d & 0xff) << 24); }
            if (lane == 0) SA[m0 + r * ms] = sa; } }
}
__device__ __forceinline__ void p0_quant_cols_wg(const float* W, int N, unsigned char* WT8, float* SB, LAS unsigned char* lds, int nb, int wave, int lane) {
    LAS float* scr = (LAS float*)(lds + RING_OFF + wave * 16384);
    LAS float* red = (LAS float*)(lds + RING_OFF + 8448);
    const int n0 = 32 * nb, kr = lane >> 3, nq = lane & 7;
    f32x4 v[16];
#pragma unroll
    for (int i = 0; i < 16; ++i) v[i] = *(const GAS f32x4*)(W + (size_t)(128 * wave + 8 * i + kr) * N + n0 + 4 * nq);
    f32x4 am = {0.f, 0.f, 0.f, 0.f};
#pragma unroll
    for (int i = 0; i < 16; ++i)
#pragma unroll
        for (int e = 0; e < 4; ++e) am[e] = fmaxf(am[e], fabsf(v[i][e]));
#pragma unroll
    for (int o = 8; o < 64; o <<= 1)
#pragma unroll
        for (int e = 0; e < 4; ++e) am[e] = fmaxf(am[e], __shfl_xor(am[e], o));
    if (lane < 8) *(LAS f32x4*)(red + wave * 32 + 4 * nq) = am;
    __syncthreads();
    f32x4 cm = *(const LAS f32x4*)(red + 4 * nq);
#pragma unroll
    for (int w = 1; w < 8; ++w) { const f32x4 o = *(const LAS f32x4*)(red + w * 32 + 4 * nq);
#pragma unroll
        for (int e = 0; e < 4; ++e) cm[e] = fmaxf(cm[e], o[e]); }
    f32x4 inv, sb;
#pragma unroll
    for (int e = 0; e < 4; ++e) { inv[e] = cm[e] > 0.f ? 127.f / cm[e] : 0.f; sb[e] = cm[e] > 0.f ? cm[e] * (1.f / 127.f) : 1.f; }
    if (wave == 0 && lane < 8) *(GAS f32x4*)(SB + n0 + 4 * nq) = sb;
#pragma unroll
    for (int half = 0; half < 2; ++half) {
#pragma unroll
        for (int i = 0; i < 8; ++i) { const int kk = 8 * i + kr;
#pragma unroll
            for (int e = 0; e < 4; ++e) scr[kk * 33 + 4 * nq + e] = v[8 * half + i][e] * inv[e]; }
        LDS_WAIT(); asm volatile("" ::: "memory");
        const int c = lane & 7;
#pragma unroll
        for (int j = 0; j < 4; ++j) { const int n = (lane >> 3) + 8 * j; const LAS float* s = scr + (8 * c) * 33 + n;
            unsigned q[8];
#pragma unroll
            for (int e = 0; e < 8; ++e) q[e] = (unsigned)((int)rintf(s[e * 33]) & 0xff);
            v2u o; o.x = q[0] | (q[1] << 8) | (q[2] << 16) | (q[3] << 24); o.y = q[4] | (q[5] << 8) | (q[6] << 16) | (q[7] << 24);
            *(GAS v2u*)(WT8 + (size_t)(n0 + n) * DM + 128 * wave + 64 * half + 8 * c) = o; }
        LDS_WAIT(); asm volatile("" ::: "memory");
    }
    __syncthreads();
}
__device__ __forceinline__ void cvt_row_to_bf16(const float* xrow, bf16* orow, int lane) {
    const GAS f32x4* xr = (const GAS f32x4*)xrow + lane; GAS unsigned long long* o8 = (GAS unsigned long long*)orow + lane;
    f32x4 v[4];
#pragma unroll
    for (int j = 0; j < 4; ++j) v[j] = xr[64 * j];
#pragma unroll
    for (int j = 0; j < 4; ++j) o8[64 * j] = (unsigned long long)pk2(v[j].x, v[j].y) | ((unsigned long long)pk2(v[j].z, v[j].w) << 32);
}
__device__ __forceinline__ int rel_bucket_dev(int d) {
    if (d < 16) return d;
    int b = 16;
    b += (d >= 21); b += (d >= 27); b += (d >= 35); b += (d >= 46); b += (d >= 59); b += (d >= 77); b += (d >= 99); b += (d >= 128);
    b += (d >= 166); b += (d >= 216); b += (d >= 280); b += (d >= 363); b += (d >= 470); b += (d >= 609); b += (d >= 790);
    return b;
}
struct P0Args { const float *x, *mem, *g_mix, *w_in, *rel_bias, *g_mem, *w_mem_kv, *w_br_attn, *w_br_conv, *w_br_x, *w_out, *g_ffn, *w_query, *sub_keys;
                bf16 *WinT, *WkvT, *WbrT, *WoutT, *WqT, *SK, *HN, *MEMN; float* TAB; float *SA, *SB; };
__device__ __forceinline__ void p0_transposes(const P0Args& a, LAS unsigned char* lds, int part, int gw, int NGW, int wave, int lane) {
    LAS float* scr = (LAS float*)(lds + RING_OFF + wave * 16384);
    constexpr int I_IN = (DM / 64) * (PW / 32), I_KV = (DM / 64) * (1024 / 32), I_BR = (512 / 64) * (1024 / 32), I_OUT = (DM / 64) * (1024 / 32), I_Q = (DM / 64) * (2048 / 32);
    if (part == 0) {
        for (int nb = gw / NWAVES; nb < PW / 32; nb += NGW / NWAVES) p0_quant_cols_wg(a.w_in, PW, (unsigned char*)a.WinT, a.SB, lds, nb, wave, lane);
        for (int it = gw; it < I_KV; it += NGW) p0_transpose_item(a.w_mem_kv, DM, 1024, a.WkvT, 0, nullptr, scr, it, lane);
    } else {
        for (int it = gw; it < 3 * I_BR + I_OUT + I_Q; it += NGW) {
            int r = it;
            if (r < I_BR) { p0_transpose_item(a.w_br_attn, 512, 1024, a.WbrT, 0, nullptr, scr, r, lane); continue; } r -= I_BR;
            if (r < I_BR) { p0_transpose_item(a.w_br_conv, 512, 1024, a.WbrT, 1024, nullptr, scr, r, lane); continue; } r -= I_BR;
            if (r < I_BR) { p0_transpose_item(a.w_br_x, 512, 1024, a.WbrT, 2048, nullptr, scr, r, lane); continue; } r -= I_BR;
            if (r < I_OUT) { p0_transpose_item(a.w_out, DM, 1024, a.WoutT, 0, nullptr, scr, r, lane); continue; } r -= I_OUT;
            p0_transpose_item(a.w_query, DM, 2048, a.WqT, 0, a.g_ffn, scr, r, lane);
        }
    }
}
__device__ __forceinline__ void p0_prologue(const P0Args& a, LAS unsigned char* lds, bool late_part1, int gw, int NGW, int wave, int lane) {
    for (int m = gw; m < T; m += 8 * NGW) rms_rows_to_i8<8>(a.x, a.g_mix, (unsigned char*)a.HN, a.SA, m, NGW, T, lane);
    p0_transposes(a, lds, 0, gw, NGW, wave, lane);
    if (!late_part1) p0_transposes(a, lds, 1, gw, NGW, wave, lane);
    for (int m = gw; m < NBATCH * MEMLEN; m += NGW) rms_rows_to_bf16<1>(a.mem, a.g_mem, a.MEMN, m, NGW, NBATCH * MEMLEN, lane);
    for (int m = gw; m < 256; m += NGW) cvt_row_to_bf16(a.sub_keys + (size_t)m * 1024, a.SK + (size_t)m * 1024, lane);
    for (int m = gw; m < 256; m += NGW) {
        const int idx = m * 64 + lane, h = idx >> 11, d = idx & 2047;
        a.TAB[idx] = a.rel_bias[rel_bucket_dev(d) * 8 + h] * LOG2E;
    }
}

template <int DH> __device__ __forceinline__ void fix_item(bf16* buf, size_t pitch, int row0, int col0, const float* gain, float gscale, float* kmean, LAS float* red, int wave, int lane) {
    constexpr int LPR = DH / 8, RPI = 64 / LPR, NIT = 32 / RPI;
    const int sub = lane / LPR, ch = lane % LPR;
    float g[8], cs[8];
#pragma unroll
    for (int j = 0; j < 8; ++j) { g[j] = gain[ch * 8 + j] * gscale; cs[j] = 0.f; }
    v4u w[NIT];
#pragma unroll
    for (int it = 0; it < NIT; ++it) w[it] = *(const GAS v4u*)(buf + (size_t)(row0 + wave * 32 + it * RPI + sub) * pitch + col0 + ch * 8);
#pragma unroll
    for (int it = 0; it < NIT; ++it) {
        float x[8] = {bflo(w[it].x), bfhi(w[it].x), bflo(w[it].y), bfhi(w[it].y), bflo(w[it].z), bfhi(w[it].z), bflo(w[it].w), bfhi(w[it].w)};
        float ss = 0.f;
#pragma unroll
        for (int j = 0; j < 8; ++j) ss += x[j] * x[j];
#pragma unroll
        for (int o = 1; o < LPR; o <<= 1) ss += __shfl_xor(ss, o);
        const float r = 1.f / sqrtf(ss * (1.f / DH) + RMS_EPS);
#pragma unroll
        for (int j = 0; j < 8; ++j) { x[j] = x[j] * r * g[j]; cs[j] += x[j]; }
        v4u o; o.x = pk2(x[0], x[1]); o.y = pk2(x[2], x[3]); o.z = pk2(x[4], x[5]); o.w = pk2(x[6], x[7]);
        *(GAS v4u*)(buf + (size_t)(row0 + wave * 32 + it * RPI + sub) * pitch + col0 + ch * 8) = o;
    }
    if (kmean) {
#pragma unroll
        for (int j = 0; j < 8; ++j) {
#pragma unroll
            for (int o = LPR; o < 64; o <<= 1) cs[j] += __shfl_xor(cs[j], o);
        }
        if (sub == 0) {
#pragma unroll
            for (int j = 0; j < 8; ++j) red[wave * DH + ch * 8 + j] = cs[j];
        }
        asm volatile("s_waitcnt lgkmcnt(0)\n\ts_barrier" ::: "memory");
        if (wave == 0 && lane < DH) { float s = 0.f;
#pragma unroll
            for (int w8 = 0; w8 < 8; ++w8) s += red[w8 * DH + lane];
            kmean[lane] = s * (1.f / 256.f); }
        asm volatile("s_waitcnt lgkmcnt(0)\n\ts_barrier" ::: "memory");
    }
}
__device__ __forceinline__ void p2_fixup(bf16* PA, bf16* KVM, float* KMEAN, const float* q_gain_a, const float* k_gain_a, const float* q_gain_x, const float* k_gain_x, LAS unsigned char* lds, int vcu, int G, int wave, int lane) {
    constexpr int N_A = 512, N_X = 256, N_KX = 32, NIT = 2 * N_A + N_X + N_KX;
    LAS float* red = (LAS float*)lds;
    for (int it = vcu; it < NIT; it += G) {
        int r = it;
        if (r < N_A) { const int b = r >> 6, h = (r >> 3) & 7, n = r & 7;
            fix_item<64>(PA, PAW, b * SEQ + n * 256, COL_KA + h * 64, k_gain_a, 1.0f, KMEAN + (size_t)((b * 8 + h) * 8 + n) * 64, red, wave, lane); continue; } r -= N_A;
        if (r < N_A) { const int b = r >> 6, h = (r >> 3) & 7, n = r & 7;
            fix_item<64>(PA, PAW, b * SEQ + n * 256, COL_QA + h * 64, q_gain_a, C2A, nullptr, red, wave, lane); continue; } r -= N_A;
        if (r < N_X) { const int b = r >> 5, h = (r >> 3) & 3, n = r & 7;
            fix_item<128>(PA, PAW, b * SEQ + n * 256, COL_QX + h * 128, q_gain_x, C2X, nullptr, red, wave, lane); continue; } r -= N_X;
        { const int b = r >> 2, h = r & 3;
            fix_item<128>(KVM, 1024, b * MEMLEN, h * 128, k_gain_x, 1.0f, nullptr, red, wave, lane); }
    }
}

namespace att {
constexpr int L_K = 0, L_V = 16384, L_BUF = 32768  , L_OST = 0  ,
              L_TAB = 65536, TAB_PAD = 256, L_KM = L_TAB + (TAB_PAD + 2048) * 4, L_SEL = L_KM + 2048, L_WSF = L_SEL + 1024, L_END = L_WSF + NWAVES * 256;
static_assert(L_END <= RING_BYTES, "attention LDS map");
__device__ __forceinline__ int crow(int r, int hi) { return (r & 3) + 8 * (r >> 2) + 4 * hi; }
__device__ __forceinline__ void glds16(const void* gsrc, unsigned lds_dst) { unsigned keep;
    asm volatile("s_mov_b32 %0, m0\n\ts_mov_b32 m0, %2\n\ts_nop 0\n\tglobal_load_lds_dwordx4 %1, off\n\ts_mov_b32 m0, %0" : "=&s"(keep) : "v"(gsrc), "s"(lds_dst) : "memory"); }
__device__ __forceinline__ unsigned cvtpk(float lo, float hi) { typedef float f2 __attribute__((ext_vector_type(2))); typedef __bf16 b2 __attribute__((ext_vector_type(2))); f2 v = {lo, hi}; b2 b = __builtin_convertvector(v, b2); return __builtin_bit_cast(unsigned, b); }
__device__ __forceinline__ float rowmax(const f32x16& p0, const f32x16& p1) {
    float a = fmaxf(p0[0], p1[0]);
#pragma unroll
    for (int r = 1; r < 16; ++r) a = fmaxf(a, fmaxf(p0[r], p1[r]));
    auto rr = __builtin_amdgcn_permlane32_swap(__float_as_uint(a), __float_as_uint(a), false, false);
    return fmaxf(__uint_as_float(rr[0]), __uint_as_float(rr[1]));
}
template <int ND0> __device__ __forceinline__ void qkt(f32x16& p0, f32x16& p1, const LAS unsigned char* Kslot, const bf16x8* qr, int r32, int hi) {
    const LAS unsigned char* kb = Kslot + hi * 1024 + r32 * 16;
#pragma unroll
    for (int d0 = 0; d0 < ND0; ++d0) {
        const bf16x8 b0 = *(const LAS bf16x8*)(kb + d0 * 2048);
        const bf16x8 b1 = *(const LAS bf16x8*)(kb + d0 * 2048 + 512);
        p0 = __builtin_amdgcn_mfma_f32_32x32x16_bf16(b0, qr[d0], p0, 0, 0, 0);
        p1 = __builtin_amdgcn_mfma_f32_32x32x16_bf16(b1, qr[d0], p1, 0, 0, 0);
    }
}
template <int NDB> __device__ __forceinline__ void pv(f32x16* o, int vb, bf16x8 pa0, bf16x8 pa1, bf16x8 pa2, bf16x8 pa3) {
#pragma unroll
    for (int d0 = 0; d0 < NDB; ++d0) { s16x4 lo[4], hi[4];
#pragma unroll
        for (int ks = 0; ks < 4; ++ks) {
            asm volatile("ds_read_b64_tr_b16 %0,%1 offset:%c2" : "=&v"(lo[ks]) : "v"(vb), "i"(d0 * 4096 + ks * 1024) : "memory");
            asm volatile("ds_read_b64_tr_b16 %0,%1 offset:%c2" : "=&v"(hi[ks]) : "v"(vb), "i"(d0 * 4096 + ks * 1024 + 512) : "memory"); }
        asm volatile("s_waitcnt lgkmcnt(0)" ::: "memory"); __builtin_amdgcn_sched_barrier(0);
#define ATT_PK(k) (bf16x8){lo[k][0], lo[k][1], lo[k][2], lo[k][3], hi[k][0], hi[k][1], hi[k][2], hi[k][3]}
        o[d0] = __builtin_amdgcn_mfma_f32_32x32x16_bf16(pa0, ATT_PK(0), o[d0], 0, 0, 0);
        o[d0] = __builtin_amdgcn_mfma_f32_32x32x16_bf16(pa1, ATT_PK(1), o[d0], 0, 0, 0);
        o[d0] = __builtin_amdgcn_mfma_f32_32x32x16_bf16(pa2, ATT_PK(2), o[d0], 0, 0, 0);
        o[d0] = __builtin_amdgcn_mfma_f32_32x32x16_bf16(pa3, ATT_PK(3), o[d0], 0, 0, 0);
#undef ATT_PK
    }
}
#define ATT_BAR() asm volatile("s_waitcnt lgkmcnt(0)\n\ts_barrier" ::: "memory")
#define ATT_WAIT_BAR() asm volatile("s_waitcnt vmcnt(0) lgkmcnt(0)\n\ts_barrier" ::: "memory")

template <int DH, bool MOBA> __device__ __forceinline__ void attn_unit(const bf16* Qp, size_t qpitch, const bf16* Kp, const bf16* Vp, size_t kpitch, bf16* Op, int qb, const float* kmean_bh, const float* tab_h, const float* gq, const float* gk,
                                                                   LAS unsigned char* lds, int tid, int wid, int lane) {
    constexpr int ND0 = DH / 16, NDB = DH / 32, NPIECE = DH / 64;
    asm volatile("" : "+v"(tid), "+v"(lane));
    const int r32 = lane & 31, hi = lane >> 5;
    const unsigned lds0 = (unsigned)(uintptr_t)lds;
    LAS float* wsf = (LAS float*)(lds + L_WSF) + wid * 64;
    ATT_BAR();
    int my_sel = 0;
    if (MOBA) {
        LAS float* tl = (LAS float*)(lds + L_TAB);
        for (int i = tid; i < TAB_PAD + 2048; i += NWAVES * 64) tl[i] = (i < TAB_PAD) ? -INFINITY : tab_h[i - TAB_PAD];
        LAS float* km = (LAS float*)(lds + L_KM);
        for (int i = tid; i < 512; i += NWAVES * 64) km[i] = kmean_bh[i];
        ATT_BAR();
        if (tid < 256) {
            int sel = 0;
            if (qb <= 3) sel = (1 << qb) - 1;
            else {
                const GAS v4u* qrow = (const GAS v4u*)(Qp + (size_t)tid * qpitch);
                v4u qw[8];
#pragma unroll
                for (int c = 0; c < 8; ++c) qw[c] = qrow[c];
                float b1 = -INFINITY, b2 = -INFINITY, b3 = -INFINITY; int i1 = 0, i2 = 0, i3 = 0;
#pragma unroll 1
                for (int n = 0; n < qb; ++n) { float s = 0.f; const LAS f32x4* kr = (const LAS f32x4*)(km + n * 64);
#pragma unroll
                    for (int c = 0; c < 8; ++c) { const f32x4 ka = kr[2 * c], kb2 = kr[2 * c + 1]; const v4u w = qw[c];
                        s += bflo(w.x) * ka.x; s += bfhi(w.x) * ka.y; s += bflo(w.y) * ka.z; s += bfhi(w.y) * ka.w;
                        s += bflo(w.z) * kb2.x; s += bfhi(w.z) * kb2.y; s += bflo(w.w) * kb2.z; s += bfhi(w.w) * kb2.w; }
                    if (s > b1) { b3 = b2; i3 = i2; b2 = b1; i2 = i1; b1 = s; i1 = n; }
                    else if (s > b2) { b3 = b2; i3 = i2; b2 = s; i2 = n; }
                    else if (s > b3) { b3 = s; i3 = n; } }
                sel = (1 << i1) | (1 << i2) | (1 << i3);
            }
            ((LAS int*)(lds + L_SEL))[tid] = sel;
        }
        ATT_BAR();
        my_sel = ((LAS int*)(lds + L_SEL))[wid * 32 + r32];
    }
    bf16x8 qr[ND0];
    { const bf16* Qw = Qp + (size_t)(wid * 32 + r32) * qpitch + hi * 8;
#pragma unroll
      for (int d0 = 0; d0 < ND0; ++d0) qr[d0] = *(const GAS bf16x8*)(Qw + d0 * 16); }
    if (!MOBA) {
        LAS float* rk = (LAS float*)(lds + L_KM);
        { const int key = tid >> 1, half = tid & 1; const GAS v4u* kr = (const GAS v4u*)(Kp + (size_t)key * kpitch + half * 64); float ss = 0.f;
#pragma unroll
          for (int c = 0; c < 8; ++c) { const v4u w = kr[c]; const float a0 = bflo(w.x), a1 = bfhi(w.x), a2 = bflo(w.y), a3 = bfhi(w.y), a4 = bflo(w.z), a5 = bfhi(w.z), a6 = bflo(w.w), a7 = bfhi(w.w);
              ss += (a0 * a0 + a1 * a1) + (a2 * a2 + a3 * a3) + (a4 * a4 + a5 * a5) + (a6 * a6 + a7 * a7); }
          ss += __shfl_xor(ss, 1);
          if (half == 0) rk[key] = 1.0f / sqrtf(ss * (1.f / 128.f) + RMS_EPS); }
        float qs = 0.f;
#pragma unroll
        for (int d0 = 0; d0 < ND0; ++d0) { const v4u w = __builtin_bit_cast(v4u, qr[d0]); const float a0 = bflo(w.x), a1 = bfhi(w.x), a2 = bflo(w.y), a3 = bfhi(w.y), a4 = bflo(w.z), a5 = bfhi(w.z), a6 = bflo(w.w), a7 = bfhi(w.w);
            qs += (a0 * a0 + a1 * a1) + (a2 * a2 + a3 * a3) + (a4 * a4 + a5 * a5) + (a6 * a6 + a7 * a7); }
        { auto rr = __builtin_amdgcn_permlane32_swap(__float_as_uint(qs), __float_as_uint(qs), false, false); qs = __uint_as_float(rr[0]) + __uint_as_float(rr[1]); }
        const float rq = C2X / sqrtf(qs * (1.f / 128.f) + RMS_EPS);
        int hi8 = hi * 8; asm volatile("" : "+v"(hi8));
#pragma unroll
        for (int d0 = 0; d0 < ND0; ++d0) { const v4u w = __builtin_bit_cast(v4u, qr[d0]);
            const f32x4 ga = *(const GAS f32x4*)(gq + d0 * 16 + hi8), gb = *(const GAS f32x4*)(gq + d0 * 16 + hi8 + 4), ka = *(const GAS f32x4*)(gk + d0 * 16 + hi8), kb2 = *(const GAS f32x4*)(gk + d0 * 16 + hi8 + 4);
            v4u o; o.x = cvtpk(bflo(w.x) * rq * ga.x * ka.x, bfhi(w.x) * rq * ga.y * ka.y); o.y = cvtpk(bflo(w.y) * rq * ga.z * ka.z, bfhi(w.y) * rq * ga.w * ka.w);
            o.z = cvtpk(bflo(w.z) * rq * gb.x * kb2.x, bfhi(w.z) * rq * gb.y * kb2.y); o.w = cvtpk(bflo(w.w) * rq * gb.z * kb2.z, bfhi(w.w) * rq * gb.w * kb2.w);
            qr[d0] = __builtin_bit_cast(bf16x8, o); }
    }
    float m_ref = 0.f, l_run = 0.f;
    constexpr float THR = 8.0f;
    float bfar = 0.f; if (MOBA) bfar = ((const LAS float*)(lds + L_TAB))[TAB_PAD + 2047];
    f32x16 o[NDB];
#pragma unroll
    for (int d = 0; d < NDB; ++d) o[d] = f32x16{};
    const int vb0 = (int)(lds0 + L_V) + ((lane >> 4) & 1) * 32 + (lane & 3) * 8 + (4 * hi + ((lane & 15) >> 2)) * 64;
    const int qrel = wid * 32 + r32;
    const int ntiles = MOBA ? 4 + 4 * qb : 4;
    constexpr int SUB = (DH == 64) ? 2 : 1;
    const int nsteps = ntiles / SUB;
    auto issue_step = [&](int st) {
#pragma unroll
        for (int sub = 0; sub < SUB; ++sub) { const int tt = st * SUB + sub;
            int kb_, j_; if (MOBA) { if (tt < 4) { kb_ = qb; j_ = tt; } else { kb_ = (tt - 4) >> 2; j_ = (tt - 4) & 3; } } else { kb_ = 0; j_ = tt; }
            const int key0_ = kb_ * 256 + j_ * 64; const unsigned bo_ = (unsigned)(st & 1) * L_BUF + (unsigned)sub * 8192u;
#pragma unroll
            for (int pc = 0; pc < NPIECE; ++pc) { const int p = wid + 8 * pc;
                glds16(Kp + (size_t)(key0_ + lane) * kpitch + p * 8, (unsigned)__builtin_amdgcn_readfirstlane(lds0 + bo_ + L_K + p * 1024));
                glds16(Vp + (size_t)(key0_ + 16 * (p & 3) + (lane >> 2)) * kpitch + (p >> 2) * 32 + (lane & 3) * 8, (unsigned)__builtin_amdgcn_readfirstlane(lds0 + bo_ + L_V + p * 1024)); } }
    };
    issue_step(0);
    for (int st = 0; st < nsteps; ++st) {
        ATT_WAIT_BAR();
        if (st + 1 < nsteps) issue_step(st + 1);
#pragma unroll 1
      for (int sub = 0; sub < SUB; ++sub) { const int tt = st * SUB + sub;
        int kb, j; bool own;
        if (MOBA) { if (tt < 4) { kb = qb; j = tt; own = true; } else { kb = (tt - 4) >> 2; j = (tt - 4) & 3; own = false; } }
        else { kb = 0; j = tt; own = false; }
        if (MOBA && own && 64 * j > wid * 32 + 31) continue;
        const unsigned bo = (unsigned)(st & 1) * L_BUF + (unsigned)sub * 8192u;
        f32x16 p0, p1;
        if (MOBA) {
            const float base = ((own || (((my_sel >> kb) & 1) != 0)) ? 0.f : -INFINITY) - m_ref;
            if (!own && qb - kb >= 5) {
                const float cb = base + bfar;
#pragma unroll
                for (int r = 0; r < 16; ++r) { p0[r] = cb; p1[r] = cb; }
            } else {
                const int dbase = (qb - kb) * 256 + qrel - 64 * j - 4 * hi;
                const LAS float* tp = (const LAS float*)(lds + L_TAB) + TAB_PAD + dbase - 63;
#pragma unroll
                for (int r = 0; r < 16; ++r) { const int c = (r & 3) + 8 * (r >> 2); p0[r] = tp[63 - c] + base; p1[r] = tp[31 - c] + base; }
            }
            qkt<ND0>(p0, p1, lds + bo + L_K, qr, r32, hi);
        } else {
            p0 = f32x16{}; p1 = f32x16{};
            qkt<ND0>(p0, p1, lds + bo + L_K, qr, r32, hi);
            const LAS float* rkp = (const LAS float*)(lds + L_KM) + j * 64 + 4 * hi;
#pragma unroll
            for (int r = 0; r < 16; ++r) { const int c = (r & 3) + 8 * (r >> 2); p0[r] = p0[r] * rkp[c] - m_ref; p1[r] = p1[r] * rkp[c + 32] - m_ref; }
        }
        const float rm = rowmax(p0, p1);
        if (__any(rm > THR)) {
            const float dl = fmaxf(rm, 0.f); m_ref += dl;
#pragma unroll
            for (int r = 0; r < 16; ++r) { p0[r] -= dl; p1[r] -= dl; }
            const float f = __builtin_amdgcn_exp2f(-dl); l_run *= f;
            if (hi == 0) wsf[r32] = f;
            LDS_WAIT();
#pragma unroll
            for (int r = 0; r < 16; ++r) { const float ff = wsf[crow(r, hi)];
#pragma unroll
                for (int d = 0; d < NDB; ++d) o[d][r] *= ff; }
        }
        float ps = 0.f;
#pragma unroll
        for (int r = 0; r < 16; ++r) { p0[r] = __builtin_amdgcn_exp2f(p0[r]); p1[r] = __builtin_amdgcn_exp2f(p1[r]); ps += p0[r] + p1[r]; }
        l_run += ps;
        v4u pw0, pw1, pw2, pw3;
        pw0 = (v4u){cvtpk(p0[0], p0[1]), cvtpk(p0[2], p0[3]), cvtpk(p0[4], p0[5]), cvtpk(p0[6], p0[7])};
        pw1 = (v4u){cvtpk(p0[8], p0[9]), cvtpk(p0[10], p0[11]), cvtpk(p0[12], p0[13]), cvtpk(p0[14], p0[15])};
        pw2 = (v4u){cvtpk(p1[0], p1[1]), cvtpk(p1[2], p1[3]), cvtpk(p1[4], p1[5]), cvtpk(p1[6], p1[7])};
        pw3 = (v4u){cvtpk(p1[8], p1[9]), cvtpk(p1[10], p1[11]), cvtpk(p1[12], p1[13]), cvtpk(p1[14], p1[15])};
        pv<NDB>(o, vb0 + (int)bo, __builtin_bit_cast(bf16x8, pw0), __builtin_bit_cast(bf16x8, pw1), __builtin_bit_cast(bf16x8, pw2), __builtin_bit_cast(bf16x8, pw3));
      }
    }
    { auto rr = __builtin_amdgcn_permlane32_swap(__float_as_uint(l_run), __float_as_uint(l_run), false, false); l_run = __uint_as_float(rr[0]) + __uint_as_float(rr[1]); }
    if (hi == 0) wsf[32 + r32] = l_run;
    ATT_BAR();
    LAS bf16* stg = (LAS bf16*)(lds + L_OST + wid * 8192);
#pragma unroll
    for (int r = 0; r < 16; ++r) { const int orow = crow(r, hi); const float rl = __builtin_amdgcn_rcpf(wsf[32 + orow]);
#pragma unroll
        for (int d = 0; d < NDB; ++d) stg[orow * DH + d * 32 + r32] = (bf16)f2bf(o[d][r] * rl); }
    LDS_WAIT();
    constexpr int CPR = DH / 8;
    int lane2 = lane; asm volatile("" : "+v"(lane2));
#pragma unroll
    for (int i = 0; i < (32 * CPR) / 64; ++i) { const int idx = i * 64 + lane2, row = idx / CPR, ch = idx % CPR;
        const v4u v = *(const LAS v4u*)(stg + row * DH + ch * 8);
        *(GAS v4u*)(Op + (size_t)(wid * 32 + row) * 512 + ch * 8) = v; }
}
#undef ATT_BAR
#undef ATT_WAIT_BAR
}

__device__ __forceinline__ void conv_item(const bf16* PA, const float* conv_w, bf16* CO, int item, int tid) {
    asm volatile("" : "+v"(tid));
    const int ch = (tid & 63) * 8, r0 = item * 64 + (tid >> 6) * 8;
    float w0[8], w1[8], w2[8];
#pragma unroll
    for (int j = 0; j < 8; ++j) { w0[j] = conv_w[ch + j]; w1[j] = conv_w[512 + ch + j]; w2[j] = conv_w[1024 + ch + j]; }
    float pm2[8], pm1[8];
#pragma unroll
    for (int j = 0; j < 8; ++j) { pm2[j] = 0.f; pm1[j] = 0.f; }
    auto load8 = [&](int row, int col, float* o) { const v4u w = *(const GAS v4u*)(PA + (size_t)row * PAW + col + ch);
        o[0] = bflo(w.x); o[1] = bfhi(w.x); o[2] = bflo(w.y); o[3] = bfhi(w.y); o[4] = bflo(w.z); o[5] = bfhi(w.z); o[6] = bflo(w.w); o[7] = bfhi(w.w); };
    const int s0 = r0 & (SEQ - 1);
    if (s0 >= 2) { float a[8], b[8]; load8(r0 - 2, COL_CC, a); load8(r0 - 2, COL_UC, b);
#pragma unroll
        for (int j = 0; j < 8; ++j) pm2[j] = a[j] * b[j]; }
    if (s0 >= 1) { float a[8], b[8]; load8(r0 - 1, COL_CC, a); load8(r0 - 1, COL_UC, b);
#pragma unroll
        for (int j = 0; j < 8; ++j) pm1[j] = a[j] * b[j]; }
#pragma unroll
    for (int i = 0; i < 8; ++i) { const int row = r0 + i; float c[8], u[8], bb[8], y[8];
        load8(row, COL_CC, c); load8(row, COL_UC, u); load8(row, COL_BC, bb);
#pragma unroll
        for (int j = 0; j < 8; ++j) { const float cur = c[j] * u[j]; y[j] = bb[j] * (w0[j] * pm2[j] + w1[j] * pm1[j] + w2[j] * cur); pm2[j] = pm1[j]; pm1[j] = cur; }
        v4u o; o.x = pk2(y[0], y[1]); o.y = pk2(y[2], y[3]); o.z = pk2(y[4], y[5]); o.w = pk2(y[6], y[7]);
        *(GAS v4u*)(CO + (size_t)row * 512 + ch) = o; }
}

namespace pk {
template <int N> __device__ __forceinline__ void bsort_desc(unsigned (&a)[N]) {
#pragma unroll
    for (int k = 2; k <= N; k <<= 1) {
#pragma unroll
        for (int j = k >> 1; j > 0; j >>= 1) {
#pragma unroll
            for (int i = 0; i < N; ++i) { const int l = i ^ j;
                if (l > i) { const unsigned x = a[i], y = a[l]; const unsigned mx = x > y ? x : y, mn = x > y ? y : x;
                    if ((i & k) == 0) { a[i] = mx; a[l] = mn; } else { a[i] = mn; a[l] = mx; } } } } }
}
template <int N> __device__ __forceinline__ void bmerge_desc(unsigned (&a)[N]) {
#pragma unroll
    for (int j = N >> 1; j > 0; j >>= 1) {
#pragma unroll
        for (int i = 0; i < N; ++i) { const int l = i ^ j; if (l > i) { const unsigned x = a[i], y = a[l]; a[i] = x > y ? x : y; a[l] = x > y ? y : x; } } }
}
__device__ __forceinline__ void top16_merge(unsigned (&x)[16], const unsigned (&y)[16]) {
#pragma unroll
    for (int i = 0; i < 16; ++i) x[i] = x[i] > y[15 - i] ? x[i] : y[15 - i];
    bmerge_desc<16>(x);
}
__device__ __forceinline__ unsigned f2ord(float f) { const unsigned u = __float_as_uint(f); return u ^ ((unsigned)((int)u >> 31) | 0x80000000u); }
__device__ __forceinline__ float ord2f(unsigned o) { return __uint_as_float(o ^ ((o & 0x80000000u) ? 0x80000000u : 0xFFFFFFFFu)); }

constexpr int L_TBL = 0;
__device__ __forceinline__ void topk_fill(const bf16* SK, LAS unsigned char* lds, int hp, int tid) {
    for (int tb = 0; tb < 4; ++tb) { const bf16* src = SK + (size_t)(((2 * hp + (tb >> 1)) * 2 + (tb & 1)) * 128) * 128;
        for (int idx = tid; idx < 2048; idx += NWAVES * 64) { const int key = idx >> 4, c16 = idx & 15;
            const v4u w = *(const GAS v4u*)(src + key * 128 + c16 * 8);
            *(LAS v4u*)(lds + L_TBL + tb * 32768 + (c16 * 4 + (key >> 5)) * 512 + (key & 31) * 16) = w; } }
    asm volatile("s_waitcnt vmcnt(0) lgkmcnt(0)\n\ts_barrier" ::: "memory");
}
__device__ __forceinline__ void topk_task(const bf16* QRY, const float* SLOTS, unsigned* SEL, LAS unsigned char* lds, int hp, int t0, int lane) {
    asm volatile("" : "+v"(lane));
    const int r32 = lane & 31, hi = lane >> 5;
    const int tok = t0 + r32;
    float rn; { const GAS f32x4* sl = (const GAS f32x4*)(SLOTS + (size_t)tok * 16); const f32x4 a = sl[0], b = sl[1], c = sl[2], d = sl[3];
        const float ss = ((a.x + a.y) + (a.z + a.w)) + ((b.x + b.y) + (b.z + b.w)) + ((c.x + c.y) + (c.z + c.w)) + ((d.x + d.y) + (d.z + d.w));
        rn = 1.f / sqrtf(ss * (1.f / 1024.f) + RMS_EPS); }
    unsigned L[4][16];
    bf16x8 qf[8];
    { const bf16* qp = QRY + (size_t)tok * 2048 + ((2 * hp) * 2) * 128 + hi * 8;
#pragma unroll
      for (int kk = 0; kk < 8; ++kk) qf[kk] = *(const GAS bf16x8*)(qp + kk * 16); }
#pragma unroll
    for (int tb = 0; tb < 4; ++tb) {
        f32x16 acc[4];
#pragma unroll
        for (int blk = 0; blk < 4; ++blk) acc[blk] = f32x16{};
        const LAS unsigned char* tbase = lds + L_TBL + tb * 32768 + hi * 2048 + r32 * 16;
#pragma unroll
        for (int kk = 0; kk < 8; ++kk)
#pragma unroll
            for (int blk = 0; blk < 4; ++blk) { const bf16x8 af = *(const LAS bf16x8*)(tbase + kk * 4096 + blk * 512);
                acc[blk] = __builtin_amdgcn_mfma_f32_32x32x16_bf16(af, qf[kk], acc[blk], 0, 0, 0); }
        if (tb < 3) { const int tn = tb + 1; const bf16* qp = QRY + (size_t)tok * 2048 + ((2 * hp + (tn >> 1)) * 2 + (tn & 1)) * 128 + hi * 8;
#pragma unroll
            for (int kk = 0; kk < 8; ++kk) qf[kk] = *(const GAS bf16x8*)(qp + kk * 16);
            asm volatile("" ::: "memory"); }
        unsigned g[4][16];
#pragma unroll
        for (int blk = 0; blk < 4; ++blk)
#pragma unroll
            for (int r = 0; r < 16; ++r) g[blk][r] = (f2ord(acc[blk][r]) & ~127u) | (unsigned)(127 - (32 * blk + (r & 3) + 8 * (r >> 2)));
#pragma unroll
        for (int blk = 0; blk < 4; ++blk) bsort_desc<16>(g[blk]);
        top16_merge(g[0], g[1]); top16_merge(g[2], g[3]); top16_merge(g[0], g[2]);
#pragma unroll
        for (int i = 0; i < 16; ++i) L[tb][i] = g[0][i] ^ (unsigned)(4 * hi);
    }
    unsigned A[2][16];
#pragma unroll
    for (int p = 0; p < 2; ++p) {
        unsigned X[16], Y[16];
#pragma unroll
        for (int i = 0; i < 16; ++i) { auto rr = __builtin_amdgcn_permlane32_swap(L[p][i], L[2 + p][i], false, false); X[i] = rr[0]; Y[i] = rr[1]; }
        top16_merge(X, Y);
#pragma unroll
        for (int i = 0; i < 16; ++i) A[p][i] = X[i];
    }
    float f0[16], f1[16];
#pragma unroll
    for (int i = 0; i < 16; ++i) { f0[i] = ord2f(A[0][i] & ~127u); f1[i] = ord2f(A[1][i] & ~127u); }
    float sums[50]; unsigned keys[50];
    { int c = 0;
#pragma unroll
      for (int i = 0; i < 16; ++i)
#pragma unroll
          for (int j = 0; j < 16; ++j) if ((i + 1) * (j + 1) <= 16) { sums[c] = f0[i] + f1[j]; keys[c] = (f2ord(sums[c]) & ~63u) | (unsigned)(63 - c); ++c; } }
    unsigned G0[16], R[32];
#pragma unroll
    for (int i = 0; i < 16; ++i) G0[i] = keys[i];
#pragma unroll
    for (int i = 0; i < 32; ++i) R[i] = (i < 26) ? keys[24 + i] : 0u;
    bsort_desc<32>(R);
#pragma unroll
    for (int i = 0; i < 16; ++i) G0[i] = G0[i] > R[15 - i] ? G0[i] : R[15 - i];
    bmerge_desc<16>(G0);
#pragma unroll
    for (int i = 8; i < 16; ++i) G0[i] = G0[i] > keys[16 + 15 - i] ? G0[i] : keys[16 + 15 - i];
    unsigned thr = G0[0];
#pragma unroll
    for (int i = 1; i < 16; ++i) thr = thr < G0[i] ? thr : G0[i];
    const float s00 = sums[0], sc = rn * LOG2E;
    float w[50]; float den = 0.f;
#pragma unroll
    for (int c = 0; c < 50; ++c) { w[c] = (keys[c] >= thr) ? __builtin_amdgcn_exp2f((sums[c] - s00) * sc) : 0.f; den += w[c]; }
    const float inv = 1.f / den;
    unsigned i0[16], i1[16];
#pragma unroll
    for (int i = 0; i < 16; ++i) { i0[i] = 127u - (A[0][i] & 127u); i1[i] = 127u - (A[1][i] & 127u); }
    GAS unsigned* outp = (GAS unsigned*)(SEL + ((size_t)tok * 8 + 2 * hp + hi) * 16);
    int pos = 0;
    { int c = 0;
#pragma unroll
      for (int i = 0; i < 16; ++i)
#pragma unroll
          for (int j = 0; j < 16; ++j) if ((i + 1) * (j + 1) <= 16) { if (keys[c] >= thr) { outp[pos & 15] = ((i0[i] * 128u + i1[j]) << 16) | f2bf(w[c] * inv); ++pos; } ++c; } }
}
}

constexpr size_t SLICE_BYTES = (size_t)NEXP * 128;
constexpr int TH = T / 2;
__device__ __forceinline__ unsigned nib4(float a, float b, float c, float d, float is, int off) {
    const int n0 = min(max((int)floorf(a * is), -8), 7) + off, n1 = min(max((int)floorf(b * is), -8), 7) + off, n2 = min(max((int)floorf(c * is), -8), 7) + off, n3 = min(max((int)floorf(d * is), -8), 7) + off;
    return (unsigned)(n0 & 15) | ((unsigned)(n1 & 15) << 8) | ((unsigned)(n2 & 15) << 16) | ((unsigned)(n3 & 15) << 24);
}
template <int NR, bool OFFLO> __device__ __forceinline__ void quant_rows_i4(const float* X, unsigned char* qtab, float* scale, int e0, int es, int eend, int lane) {
    f32x4 v[NR][4];
#pragma unroll
    for (int r = 0; r < NR; ++r) { const int e = (e0 + r * es < eend) ? e0 + r * es : eend - 1; const GAS f32x4* xr = (const GAS f32x4*)(X + (size_t)e * DM) + lane;
#pragma unroll
        for (int j = 0; j < 4; ++j) v[r][j] = xr[64 * j]; }
#pragma unroll
    for (int r = 0; r < NR; ++r) { float ss = 0.f;
#pragma unroll
        for (int j = 0; j < 4; ++j) ss += (v[r][j].x * v[r][j].x + v[r][j].y * v[r][j].y) + (v[r][j].z * v[r][j].z + v[r][j].w * v[r][j].w);
        ss = wave_sum(ss);
        const float step = ss > 0.f ? 0.3352f * sqrtf(ss * (1.f / 1024.f)) : 1.f, is = 1.f / step;
        const int e = e0 + r * es;
        const unsigned twoc = (OFFLO && !(lane & 1)) ? 0u : 0x08080808u;
#pragma unroll
        for (int j = 0; j < 4; ++j) {
            const f32x4 y = v[r][j] * is + 7.5f;
            unsigned z[4];
#pragma unroll
            for (int e = 0; e < 4; ++e) z[e] = __builtin_bit_cast(unsigned, __builtin_amdgcn_fmed3f(y[e], -0.5f, 15.0f) + 8388864.0f);
            const unsigned o = (__builtin_amdgcn_perm(z[1], z[0], 0x0c0c0400u) | __builtin_amdgcn_perm(z[3], z[2], 0x04000c0cu)) ^ twoc;
            const unsigned po = (unsigned)__builtin_amdgcn_update_dpp(0, (int)o, 0xB1, 0xf, 0xf, true);
            if (e < eend && !(lane & 1)) *(GAS unsigned*)(qtab + (size_t)j * SLICE_BYTES + (size_t)e * 128 + (lane >> 1) * 4) = o | (po << 4); }
        if (e < eend && lane == 0) scale[e] = 0.5f * step; }
}
constexpr int NQCHUNK = 2 * NEXP / 8;
__device__ __forceinline__ void quant_tables_part(const float* PU, const float* PV, unsigned char* UQ, unsigned char* VQ, float* SU, float* SV, int first, int end, int w, int nw, int lane) {
    for (int c = first + w; c < end; c += nw) { const int e0 = (c & 2047) * 8;
        if ((c >> 11) == 0) quant_rows_i4<8, false>(PU, UQ, SU, e0, 1, NEXP, lane); else quant_rows_i4<8, true>(PV, VQ, SV, e0, 1, NEXP, lane); }
}
template <int NR> __device__ __forceinline__ void quant_x(const bf16* HB, unsigned char* XQ, float* SX, int* XS, const float (&gf)[16], int t0, int ts, int lane) {
    f32x4 hv[NR][4];
#pragma unroll
    for (int r = 0; r < NR; ++r) { const int t = (t0 + r * ts < T) ? t0 + r * ts : T - 1; const GAS v2u* hrow = (const GAS v2u*)(HB + (size_t)t * DM) + lane;
#pragma unroll
        for (int j = 0; j < 4; ++j) { const v2u w = hrow[64 * j]; hv[r][j] = (f32x4){bflo(w.x), bfhi(w.x), bflo(w.y), bfhi(w.y)}; } }
#pragma unroll
    for (int r = 0; r < NR; ++r) { float ss = 0.f;
#pragma unroll
        for (int j = 0; j < 4; ++j) ss += (hv[r][j].x * hv[r][j].x + hv[r][j].y * hv[r][j].y) + (hv[r][j].z * hv[r][j].z + hv[r][j].w * hv[r][j].w);
        const float rn = 1.f / sqrtf(wave_sum(ss) * (1.f / 1024.f) + RMS_EPS);
        float xn[16]; float am = 0.f;
#pragma unroll
        for (int j = 0; j < 4; ++j)
#pragma unroll
            for (int e = 0; e < 4; ++e) { xn[4 * j + e] = hv[r][j][e] * rn * gf[4 * j + e]; am = fmaxf(am, fabsf(xn[4 * j + e])); }
#pragma unroll
        for (int o = 1; o < 64; o <<= 1) am = fmaxf(am, __shfl_xor(am, o));
        const float sx = am > 0.f ? am * (1.f / 119.f) : 1.f, isx = 1.f / sx;
        const int t = t0 + r * ts;
        float qsf = 0.f;
#pragma unroll
        for (int j = 0; j < 4; ++j) {
            unsigned zh[4], zl[4];
#pragma unroll
            for (int e = 0; e < 4; ++e) { const float q = __builtin_rintf(xn[4 * j + e] * isx), qh = __builtin_floorf(q * 0.0625f + 0.5f), ql = q - 16.f * qh; qsf += q;
                zh[e] = __builtin_bit_cast(unsigned, qh + 12582912.0f); zl[e] = __builtin_bit_cast(unsigned, ql + 12582912.0f); }
            const unsigned ph = (__builtin_amdgcn_perm(zh[1], zh[0], 0x0c0c0400u) | __builtin_amdgcn_perm(zh[3], zh[2], 0x04000c0cu)) & 0x0f0f0f0fu;
            const unsigned pl = (__builtin_amdgcn_perm(zl[1], zl[0], 0x0c0c0400u) | __builtin_amdgcn_perm(zl[3], zl[2], 0x04000c0cu)) & 0x0f0f0f0fu;
            const unsigned oh = (unsigned)__builtin_amdgcn_update_dpp(0, (int)ph, 0xB1, 0xf, 0xf, true), ol = (unsigned)__builtin_amdgcn_update_dpp(0, (int)pl, 0xB1, 0xf, 0xf, true);
            const unsigned word = (lane & 1) ? (ol | (pl << 4)) : (ph | (oh << 4));
            if (t < T) *(GAS unsigned*)(XQ + (size_t)t * DM + j * 256 + (lane >> 3) * 32 + (lane & 1) * 16 + ((lane & 7) >> 1) * 4) = word; }
        int qs = (int)qsf;
#pragma unroll
        for (int o = 1; o < 64; o <<= 1) qs += __shfl_xor(qs, o);
        if (t < T && lane == 0) { SX[t] = sx; XS[t] = qs; } }
}
__device__ __forceinline__ float gelu_exact(float x) { return 0.5f * x * (1.0f + erff(x * 0.70710678118654752f)); }
__device__ __forceinline__ int dpp_i(int v, int ctrl_is) {
    return ctrl_is == 0 ? __builtin_amdgcn_update_dpp(0, v, 0x141, 0xf, 0xf, true) : ctrl_is == 1 ? __builtin_amdgcn_update_dpp(0, v, 0xB1, 0xf, 0xf, true) : __builtin_amdgcn_update_dpp(0, v, 0x4E, 0xf, 0xf, true);
}
constexpr int QCHUNK = 8;
__device__ __forceinline__ int q_take(unsigned* q, int lane) {
    unsigned v = 0; if (lane == 0) v = __hip_atomic_fetch_add(q, (unsigned)QCHUNK, __ATOMIC_RELAXED, __HIP_MEMORY_SCOPE_AGENT);
    return (int)__builtin_amdgcn_readfirstlane(v);
}
struct TokStream {
    unsigned* q; int cur, end, nxt, stride;
    __device__ __forceinline__ void open_static(int c0, int W) { q = nullptr; cur = c0 * QCHUNK; end = cur + QCHUNK; nxt = 0; stride = W * QCHUNK; }
    __device__ __forceinline__ void open(unsigned* q_, int lane) { q = q_; stride = 0;
        unsigned v = 0; if (lane == 0) v = __hip_atomic_fetch_add(q, 2u * (unsigned)QCHUNK, __ATOMIC_RELAXED, __HIP_MEMORY_SCOPE_AGENT);
        cur = (int)__builtin_amdgcn_readfirstlane(v); end = cur + QCHUNK; nxt = cur + QCHUNK; }
    __device__ __forceinline__ int next(int lane) { const int t = cur; if (t >= TH) return TH; ++cur;
        if (cur == end) { if (q) { cur = nxt; end = cur + QCHUNK; if (cur < TH) nxt = q_take(q, lane); } else { cur += stride - QCHUNK; end = cur + QCHUNK; } }
        return t; }
};
struct SlicePlan { int xcc, srank, sW; unsigned cnts; };
__device__ __forceinline__ SlicePlan slice_plan(int xcc, int srank, int sW, const unsigned* xcnt  , int lane) {
    SlicePlan p; p.xcc = xcc; p.srank = srank; p.sW = sW;
    p.cnts = (sW > 0 && lane < 8) ? __hip_atomic_load(xcnt + 64 * lane, __ATOMIC_RELAXED, __HIP_MEMORY_SCOPE_AGENT) : 0u;
    return p;
}
__device__ __forceinline__ bool slice_open(TokStream& S, const SlicePlan& p, int qi, int x, unsigned* queues, int lane) {
    if (p.sW > 0 && qi == 0) { S.open_static(p.srank, p.sW); return true; }
    if (p.sW > 0 && (unsigned)__builtin_amdgcn_readlane((int)p.cnts, x) != 0u) return false;
    S.open(queues + 64 * x, lane); return true;
}
#define MEM_ORDER() asm volatile("" ::: "memory")
#ifdef PROBE_MASKV
#define PROBE_EMASK & emask
#define PROBE_EARG , unsigned emask
#define PROBE_EPASS , emask
#else
#define PROBE_EMASK
#define PROBE_EARG
#define PROBE_EPASS
#endif
__device__ __forceinline__ unsigned bperm(int src_lane4, unsigned v) { return (unsigned)__builtin_amdgcn_ds_bpermute(src_lane4, (int)v); }
struct UEnt { v2u R; unsigned x; };
__device__ __forceinline__ void u_ent(UEnt& E, const unsigned* SEL, const unsigned char* XQ, int t, int cs, int lane) {
    E.x = *(const GAS unsigned*)(XQ + (size_t)t * DM + cs * 256 + 4 * lane);
    E.R = *(const GAS v2u*)(SEL + (size_t)t * 128 + 2 * lane);
}
__device__ __forceinline__ void u_rows(v4u (&w)[16], unsigned& xr, const UEnt& E, int lane, const unsigned char* tab, unsigned choff PROBE_EARG) {
    const v2u R = E.R;
    const int gb = (lane >> 3) * 32;
#pragma unroll
    for (int g = 0; g < 16; ++g) { const unsigned e = bperm(gb + 4 * (g >> 1), (g & 1) ? R.y : R.x);
        w[g] = *(const GAS v4u*)(tab + (unsigned)(((e >> 16) PROBE_EMASK) * 128u + choff)); }
    xr = E.x;
}
__device__ __forceinline__ int dot8z(unsigned a, unsigned b) { int r; asm("v_dot8_i32_i4 %0, %1, %2, 0" : "=v"(r) : "v"(a), "v"(b)); return r; }
__device__ __forceinline__ void u_compute(const v4u (&w)[16], const unsigned xr, int* prow, int grp, int ch, int c0, int c1, int c2) {
    int p[16];
    v4u xh, xl;
#pragma unroll
    for (int j = 0; j < 4; ++j) { xh[j] = bperm(32 * ch + 4 * j, xr); xl[j] = bperm(32 * ch + 16 + 4 * j, xr); }
#pragma unroll
    for (int g = 0; g < 16; ++g) { int ah = dot8z(w[g][0], xh[0]), al = dot8z(w[g][0], xl[0]);
#pragma unroll
        for (int j = 1; j < 4; ++j) { ah = __builtin_amdgcn_sdot8((int)w[g][j], (int)xh[j], ah, false); al = __builtin_amdgcn_sdot8((int)w[g][j], (int)xl[j], al, false); }
        p[g] = (ah << 4) + al; }
    int q8[8], q4[4], q2[2];
#pragma unroll
    for (int i = 0; i < 8; ++i) { const int keep = c2 ? p[i + 8] : p[i], send = c2 ? p[i] : p[i + 8]; q8[i] = keep + dpp_i(send, 0); }
#pragma unroll
    for (int i = 0; i < 4; ++i) { const int keep = c0 ? q8[i + 4] : q8[i], send = c0 ? q8[i] : q8[i + 4]; q4[i] = keep + dpp_i(send, 1); }
#pragma unroll
    for (int i = 0; i < 2; ++i) { const int keep = c1 ? q4[i + 2] : q4[i], send = c1 ? q4[i] : q4[i + 2]; q2[i] = keep + dpp_i(send, 2); }
    const int g0 = 8 * c2 + 4 * c0 + 2 * c1;
    typedef int i2 __attribute__((ext_vector_type(2)));
    *(GAS i2*)(prow + grp * 16 + g0) = (i2){q2[0], q2[1]};
}
__device__ __forceinline__ void gather_u(const unsigned* SEL0, const unsigned char* XQ0, const unsigned char* UQS, int* PART, int* dummy, unsigned* queues, const SlicePlan& plan, int lane PROBE_EARG) {
    const int grp = lane >> 3, ch = lane & 7, c0 = ch & 1, c1 = (ch >> 1) & 1, c2 = (ch >> 2) & 1;
    for (int qi = 0; qi < 8; ++qi) { const int x = (plan.xcc + qi) & 7, cs = x & 3, tb = (x >> 2) * TH;
        TokStream S; if (!slice_open(S, plan, qi, x, queues, lane)) continue;
        const unsigned char* tab = UQS + (size_t)cs * SLICE_BYTES; const unsigned choff = (unsigned)ch * 16u;
        int* part = PART + ((size_t)cs * T + tb) * 128;
        const unsigned* SEL = SEL0 + (size_t)tb * 128; const unsigned char* XQ = XQ0 + (size_t)tb * DM;
        int tA = S.next(lane), tB = S.next(lane);
        if (tA >= TH) continue;
        UEnt EA, EB; v4u W0[16], W1[16]; unsigned X0, X1;
        u_ent(EA, SEL, XQ, tA, cs, lane); u_ent(EB, SEL, XQ, tB < TH ? tB : TH - 1, cs, lane); MEM_ORDER();
        u_rows(W0, X0, EA, lane, tab, choff PROBE_EPASS); MEM_ORDER();
        while (tA < TH) {
            const int tC = S.next(lane);
            u_ent(EA, SEL, XQ, tC < TH ? tC : TH - 1, cs, lane); MEM_ORDER();
            u_rows(W1, X1, EB, lane, tab, choff PROBE_EPASS); MEM_ORDER();
            u_compute(W0, X0, part + (size_t)tA * 128, grp, ch, c0, c1, c2); MEM_ORDER();
            const int tD = S.next(lane);
            u_ent(EB, SEL, XQ, tD < TH ? tD : TH - 1, cs, lane); MEM_ORDER();
            u_rows(W0, X0, EA, lane, tab, choff PROBE_EPASS); MEM_ORDER();
            u_compute(W1, X1, tB < TH ? part + (size_t)tB * 128 : dummy, grp, ch, c0, c1, c2); MEM_ORDER();
            tA = tC; tB = tD;
        }
    }
}
template <int NR> __device__ __forceinline__ void gather_coef(const unsigned* SEL, const int* PART, const float* SU, const float* SV, const float* SX, const int* XS, signed char* CQ, unsigned* EO, float* SCL, int* CSM, int t0, int ts, int lane) {
    typedef int i2 __attribute__((ext_vector_type(2)));
    v2u ent[NR]; i2 acc[NR]; float sx[NR]; int xs[NR]; int tt[NR];
#pragma unroll
    for (int r = 0; r < NR; ++r) { tt[r] = (t0 + r * ts < T) ? t0 + r * ts : T - 1; ent[r] = *(const GAS v2u*)(SEL + (size_t)tt[r] * 128 + 2 * lane);
        sx[r] = __hip_atomic_load(SX + tt[r], __ATOMIC_RELAXED, __HIP_MEMORY_SCOPE_AGENT);
        xs[r] = __hip_atomic_load(XS + tt[r], __ATOMIC_RELAXED, __HIP_MEMORY_SCOPE_AGENT);
        acc[r] = (i2){0, 0}; }
#pragma unroll
    for (int r = 0; r < NR; ++r)
#pragma unroll
        for (int x = 0; x < 4; ++x) { const i2 pp = *(const GAS i2*)(PART + ((size_t)x * T + tt[r]) * 128 + 2 * lane); acc[r] += pp; }
    float su0[NR], sv0[NR], su1[NR], sv1[NR];
#pragma unroll
    for (int r = 0; r < NR; ++r) { const unsigned e0 = ent[r].x >> 16, e1 = ent[r].y >> 16; su0[r] = SU[e0]; sv0[r] = SV[e0]; su1[r] = SU[e1]; sv1[r] = SV[e1]; }
#pragma unroll
    for (int r = 0; r < NR; ++r) {
        const float k0 = bflo(ent[r].x) * gelu_exact((float)(2 * acc[r].x + xs[r]) * (su0[r] * sx[r])) * sv0[r], k1 = bflo(ent[r].y) * gelu_exact((float)(2 * acc[r].y + xs[r]) * (su1[r] * sx[r])) * sv1[r];
        float am = fmaxf(fabsf(k0), fabsf(k1));
#pragma unroll
        for (int o = 1; o < 64; o <<= 1) am = fmaxf(am, __shfl_xor(am, o));
        const float sc = am > 0.f ? am * (1.f / 127.f) : 1.f, isc = 1.f / sc;
        const int c0 = (int)rintf(k0 * isc), c1 = (int)rintf(k1 * isc);
        int csum = c0 + c1;
#pragma unroll
        for (int o = 1; o < 64; o <<= 1) csum += __shfl_xor(csum, o);
        if (t0 + r * ts < T) {
            GAS unsigned short* cq = (GAS unsigned short*)((GAS signed char*)CQ + (size_t)tt[r] * 128);
            cq[lane] = (unsigned short)((unsigned)(c0 & 0xff) | ((unsigned)(c1 & 0xff) << 8));
            *(GAS v2u*)(EO + (size_t)tt[r] * 128 + 2 * lane) = (v2u){(ent[r].x >> 16) * 128u, (ent[r].y >> 16) * 128u};
            if (lane == 0) { SCL[tt[r]] = sc * 0.125f; CSM[tt[r]] = 8 * csum; } } }
}
typedef int v4i __attribute__((ext_vector_type(4)));
typedef float vf4 __attribute__((ext_vector_type(4)));
struct VCoef { v4i A; float sc; int cs; v4u hb0, hb1; };
struct VEnt { VCoef c; v2u R; };
__device__ __forceinline__ void v_ent(VEnt& E, const unsigned* EO, const signed char* CQ, const float* SCL, const int* CSM, const bf16* HIcol, int t, int lane) {
    const int ic = lane & 3, kb = lane >> 4;
    E.c.A = *(const GAS v4i*)((const GAS signed char*)CQ + (size_t)t * 128 + (2 * kb + (ic & 1)) * 16);
    E.c.sc = __hip_atomic_load(SCL + t, __ATOMIC_RELAXED, __HIP_MEMORY_SCOPE_AGENT);
    E.c.cs = __hip_atomic_load(CSM + t, __ATOMIC_RELAXED, __HIP_MEMORY_SCOPE_AGENT);
    E.c.hb0 = *(const GAS v4u*)(HIcol + (size_t)t * DM);
    E.c.hb1 = *(const GAS v4u*)(HIcol + (size_t)t * DM + 16);
    E.R = *(const GAS v2u*)(EO + (size_t)t * 128 + 2 * lane);
}
__device__ __forceinline__ void v_rows(v4u (&w)[16], VCoef& c, const VEnt& E, int lane, const unsigned char* tab, unsigned choff) {
    const int gb = (lane >> 3) * 32; const v2u R = E.R;
#pragma unroll
    for (int g = 0; g < 16; ++g) { const unsigned eo = bperm(gb + 4 * (g >> 1), (g & 1) ? R.y : R.x); w[g] = *(const GAS v4u*)(tab + (unsigned)(eo + choff)); }
    c = E.c;
}
__device__ __forceinline__ unsigned permb(unsigned hi, unsigned lo, unsigned sel) { return __builtin_amdgcn_perm(hi, lo, sel); }
__device__ __forceinline__ int ror8(int v) { return __builtin_amdgcn_update_dpp(0, v, 0x128, 0xf, 0xf, true); }
__device__ __forceinline__ void v_compute(const v4u (&w)[16], const VCoef& C, float* hout, bool half, bool storer, bool arow) {
    const v4i CA = arow ? C.A : (v4i){0, 0, 0, 0};
    const int k15 = -15 * C.cs;
#pragma unroll
    for (int jp = 0; jp < 2; ++jp) {
        int tr[2][4], th[2][4];
#pragma unroll
        for (int jj = 0; jj < 2; ++jj) { const int j = 2 * jp + jj;
            unsigned K[4][4];
#pragma unroll
            for (int q = 0; q < 4; ++q) { const unsigned a = w[4 * q][j], b = w[4 * q + 1][j], c = w[4 * q + 2][j], d = w[4 * q + 3][j];
                const unsigned t0 = permb(a, b, 0x01050004u), t1 = permb(a, b, 0x03070206u), t2 = permb(c, d, 0x01050004u), t3 = permb(c, d, 0x03070206u);
                K[q][0] = permb(t2, t0, 0x05040100u); K[q][1] = permb(t2, t0, 0x07060302u); K[q][2] = permb(t3, t1, 0x05040100u); K[q][3] = permb(t3, t1, 0x07060302u); }
#pragma unroll
            for (int k = 0; k < 4; ++k) {
                const v4i Br = {(int)K[0][k], (int)K[1][k], (int)K[2][k], (int)K[3][k]};
                const v4i Bh = {(int)(K[0][k] & 0xF0F0F0F0u), (int)(K[1][k] & 0xF0F0F0F0u), (int)(K[2][k] & 0xF0F0F0F0u), (int)(K[3][k] & 0xF0F0F0F0u)};
                const v4i Dr = __builtin_amdgcn_mfma_i32_16x16x64_i8(CA, Br, (v4i){0, 0, 0, 0}, 0, 0, 0);
                const v4i Dh = __builtin_amdgcn_mfma_i32_16x16x64_i8(CA, Bh, (v4i){0, 0, 0, 0}, 0, 0, 0);
                tr[jj][k] = jj ? Dr[1] + ror8(Dr[0]) : Dr[0] + ror8(Dr[1]);
                th[jj][k] = jj ? Dh[1] + ror8(Dh[0]) : Dh[0] + ror8(Dh[1]); }
        }
        int lo[4], hi[4];
#pragma unroll
        for (int k = 0; k < 4; ++k) { const int d0 = tr[0][k] - th[0][k], d1 = tr[1][k] - th[1][k]; lo[k] = half ? d1 : d0; hi[k] = half ? th[1][k] : th[0][k];
            asm volatile("" : "+v"(lo[k]), "+v"(hi[k])); }
        const v4u hb = jp ? C.hb1 : C.hb0;
        const float h8[8] = {bflo(hb.x), bfhi(hb.x), bflo(hb.y), bfhi(hb.y), bflo(hb.z), bfhi(hb.z), bflo(hb.w), bfhi(hb.w)};
        vf4 o0, o1;
#pragma unroll
        for (int k = 0; k < 4; ++k) { o0[k] = h8[k] + C.sc * (float)((lo[k] << 4) + k15);
                                      o1[k] = h8[4 + k] + C.sc * (float)(hi[k] + C.cs); }
        if (storer) { __builtin_nontemporal_store(o0, (GAS vf4*)(hout + 16 * jp)); __builtin_nontemporal_store(o1, (GAS vf4*)(hout + 16 * jp) + 1); }
    }
}
__device__ __forceinline__ void gather_v(const unsigned* EO0, const signed char* CQ0, const float* SCL0, const int* CSM0, const unsigned char* VQS, const bf16* HI0, float* HO0, float* dummy, unsigned* queues, const SlicePlan& plan, int lane) {
    const int ch = lane & 7; const bool half = ((lane >> 3) & 1) != 0, storer = lane < 16, arow = (lane & 15) < 2;
    for (int qi = 0; qi < 8; ++qi) { const int x = (plan.xcc + qi) & 7, cs = x & 3, tb = (x >> 2) * TH;
        TokStream S; if (!slice_open(S, plan, qi, x, queues, lane)) continue;
        const unsigned char* tab = VQS + (size_t)cs * SLICE_BYTES; const unsigned choff = (unsigned)ch * 16u;
        const int col = cs * 256 + ch * 32 + (half ? 8 : 0);
        const unsigned* EO = EO0 + (size_t)tb * 128; const signed char* CQ = CQ0 + (size_t)tb * 128; const float* SCL = SCL0 + tb; const int* CSM = CSM0 + tb;
        const bf16* HI = HI0 + (size_t)tb * DM + col; float* HO = HO0 + (size_t)tb * DM + col;
        int tA = S.next(lane), tB = S.next(lane);
        if (tA >= TH) continue;
        VEnt EA, EB; v4u W0[16], W1[16]; VCoef C0, C1;
        v_ent(EA, EO, CQ, SCL, CSM, HI, tA, lane); v_ent(EB, EO, CQ, SCL, CSM, HI, tB < TH ? tB : TH - 1, lane); MEM_ORDER();
        v_rows(W0, C0, EA, lane, tab, choff); MEM_ORDER();
        while (tA < TH) {
            const int tC = S.next(lane);
            v_ent(EA, EO, CQ, SCL, CSM, HI, tC < TH ? tC : TH - 1, lane); MEM_ORDER();
            v_rows(W1, C1, EB, lane, tab, choff); MEM_ORDER();
            v_compute(W0, C0, HO + (size_t)tA * DM, half, storer, arow); MEM_ORDER();
            const int tD = S.next(lane);
            v_ent(EB, EO, CQ, SCL, CSM, HI, tD < TH ? tD : TH - 1, lane); MEM_ORDER();
            v_rows(W0, C0, EA, lane, tab, choff); MEM_ORDER();
            v_compute(W1, C1, tB < TH ? HO + (size_t)tB * DM : dummy + 32 * (lane & 15), half, storer, arow); MEM_ORDER();
            tA = tC; tB = tD;
        }
    }
}

#ifndef MK_SPLIT
#define MK_SPLIT 0
#endif
constexpr int NPHASE = 11;
typedef SlicePlan pk_plan_t;
#ifndef PROBE_PH
#define PROBE_PH -1
#endif
#ifndef PROBE_N
#define PROBE_N 1
#endif
#define REPS(k) (((k) == PROBE_PH) ? 1 + PROBE_N : 1)
struct Args { const float* in[21]; float* out; unsigned char* ws; int ph_lo, ph_hi; };
static_assert(sizeof(Args) == 23 * 8 + 8, "Args has no padding");

__global__ void __launch_bounds__(NWAVES * 64, 2) fwd(Args args) {
    extern __shared__ __attribute__((aligned(16))) unsigned char lds_raw[];
    LAS unsigned char* lds = (LAS unsigned char*)lds_raw;
    volatile LAS unsigned* MISC = (volatile LAS unsigned*)(lds + MISC_OFF);
    const int tid = threadIdx.x, lane = tid & 63, wave = __builtin_amdgcn_readfirstlane(tid >> 6);
    const int G = gridDim.x; const int bx = blockIdx.x; const int vcu = (G % 8 == 0) ? (bx % 8) * (G / 8) + bx / 8 : bx;
    const int gw = vcu * NWAVES + wave, NGW = G * NWAVES;
    unsigned char* ws = args.ws;
    gu32* ctl = (gu32*)(ws + WS_CTL);
    const float* x = args.in[0]; const float* mem = args.in[1]; const float* g_mix = args.in[2]; const float* w_in = args.in[3]; const float* q_gain_a = args.in[4]; const float* k_gain_a = args.in[5];
    const float* rel_bias = args.in[6]; const float* conv_w = args.in[7]; const float* g_mem = args.in[8]; const float* w_mem_kv = args.in[9]; const float* q_gain_x = args.in[10]; const float* k_gain_x = args.in[11];
    const float* w_br_attn = args.in[12]; const float* w_br_conv = args.in[13]; const float* w_br_x = args.in[14]; const float* w_out = args.in[15]; const float* g_ffn = args.in[16];
    const float* w_query = args.in[17]; const float* sub_keys = args.in[18]; const float* peer_u = args.in[19]; const float* peer_v = args.in[20];
    float* out = args.out;
    bf16* WinT = (bf16*)(ws + WS_WIN); bf16* WkvT = (bf16*)(ws + WS_WKV); bf16* WbrT = (bf16*)(ws + WS_WBR); bf16* WoutT = (bf16*)(ws + WS_WOUT); bf16* WqT = (bf16*)(ws + WS_WQ);
    bf16* SK = (bf16*)(ws + WS_SK); float* TAB = (float*)(ws + WS_TAB); float* KMEAN = (float*)(ws + WS_KMEAN); bf16* MEMN = (bf16*)(ws + WS_MEMN); bf16* KVM = (bf16*)(ws + WS_KVM);
    float* SLOTS = (float*)(ws + WS_SLOTS); unsigned* SEL = (unsigned*)(ws + WS_SEL);
    bf16* PA = (bf16*)(ws + WS_PA); bf16* PG = (bf16*)(ws + WS_PG);
    bf16* MERGED = (bf16*)(ws + PA_MERGED); bf16* HB = (bf16*)(ws + PA_HB); unsigned char* UQ = ws + PA_UT; unsigned char* VQ = ws + PA_VT; float* SU = (float*)(ws + WS_SU); float* SV = (float*)(ws + WS_SV); int* CM = (int*)(ws + WS_CM); float* SAq = (float*)(ws + WS_SA); float* SBq = (float*)(ws + WS_SB); int* XSM = (int*)(ws + WS_XS); float* SX = (float*)(ws + WS_SX); float* CS = (float*)(ws + WS_CS);
    unsigned char* XQ = ws + PA_XQ; int* PART = (int*)(ws + PG_PART); signed char* CQ = (signed char*)(ws + PG_COEF); unsigned* EO = (unsigned*)(ws + PG_COEF + 8 * MiB); bf16* QRY = (bf16*)(ws + PG_QRY);
    bf16* HN = (bf16*)out;
    bf16* BRO = (bf16*)out;

    for (int u = tid; u < (LDS_BYTES - LDSCTL_OFF) / 4; u += NWAVES * 64) ((LAS unsigned*)(lds + LDSCTL_OFF))[u] = 0u;
    __syncthreads();
#if !MK_SPLIT
    XcdBarrier bar = xcd_barrier_post((unsigned*)(ctl + CW_BAR), MISC + 8);
    if (tid == 0) MISC[10] = __hip_atomic_fetch_add((unsigned*)(ctl + CW_RANK) + 64 * (bar.x & 7u), 1u, __ATOMIC_RELAXED, __HIP_MEMORY_SCOPE_AGENT);
#define GRID_BAR() xcd_barrier(bar)
#else
#define GRID_BAR() do {} while (0)
#endif
    const int lo = args.ph_lo, hi_ = args.ph_hi;
#ifndef PH_MASK
#define PH_MASK 0x7ff
#endif
#define IN(k) ((((PH_MASK) >> (k)) & 1) && lo <= (k) && (k) < hi_)
#define BOTH(k) (IN(k) && IN((k) + 1))

    const P0Args p0a{x, mem, g_mix, w_in, rel_bias, g_mem, w_mem_kv, w_br_attn, w_br_conv, w_br_x, w_out, g_ffn, w_query, sub_keys, WinT, WkvT, WbrT, WoutT, WqT, SK, HN, MEMN, TAB, SAq, SBq};
    const int n_busy = (64 * 26) % G + 32; const bool late_w = IN(0) && IN(1) && n_busy < G;
    if (IN(0)) for (int rep = 0; rep < REPS(0); ++rep) {
        p0_prologue(p0a, lds, late_w, gw, NGW, wave, lane);
        if (BOTH(0) && rep == REPS(0) - 1) GRID_BAR();
    }
    if (IN(1)) for (int rep = 0; rep < REPS(1); ++rep) {
        { pg8::Gemm g{HN, WinT, T, PW, DM / 2}; pg8::GOrder S; S.init(T, PW, G, bx); pg8::EpiProj E{PA, PG, q_gain_a, k_gain_a, KMEAN, C2A, RMS_EPS, SAq, SBq};
          pg8::gemm_phase<pg8::EpiProj, pg8::GOrder, true, true, true>(lds + RING_OFF, g, S, E); }
        { const int nfull = (64 * 26) % G; const int coff = (nfull + 32 <= G) ? bx - nfull : bx;
          pg8::Gemm g{MEMN, WkvT, NBATCH * MEMLEN, 1024, DM}; pg8::GOrder S; S.init(NBATCH * MEMLEN, 1024, G, coff); pg8::EpiBf16<0> E{KVM, 1024, nullptr, 0, 0, 1.f};
          pg8::gemm_phase<pg8::EpiBf16<0>, pg8::GOrder, true, true>(lds + RING_OFF, g, S, E); }
        if (late_w && rep == 0 && bx >= n_busy) p0_transposes(p0a, lds, 1, (bx - n_busy) * NWAVES + wave, (G - n_busy) * NWAVES, wave, lane);
        if (IN(1) && IN(3) && rep == REPS(1) - 1) GRID_BAR();
    }
#if defined(PROBE_BARS) && !MK_SPLIT
    if (IN(1)) for (int i = 0; i < PROBE_BARS; ++i) GRID_BAR();
#endif
    if (IN(3)) for (int rep = 0; rep < REPS(3); ++rep) {
        for (int v = vcu; v < 256; v += G) {
            const int bh = v >> 2, b = bh >> 3, h = bh & 7, s = v & 3;
#pragma unroll 1
            for (int pass = 0; pass < 2; ++pass) { const int qb = pass ? 7 - s : s;
                const bf16* Qp = PA + (size_t)(b * SEQ + qb * 256) * PAW + COL_QA + h * 64;
                const bf16* Kp = PA + (size_t)(b * SEQ) * PAW + COL_KA + h * 64; const bf16* Vp = PA + (size_t)(b * SEQ) * PAW + COL_VA + h * 64;
                bf16* Op = BRO + (size_t)(b * SEQ + qb * 256) * 512 + h * 64;
                att::attn_unit<64, true>(Qp, PAW, Kp, Vp, PAW, Op, qb, KMEAN + (size_t)bh * 512, TAB + h * 2048, nullptr, nullptr, lds + RING_OFF, tid, wave, lane); }
            { const int bb = v >> 5, hx = (v >> 3) & 3, qt = v & 7;
                const bf16* Qp = PA + (size_t)(bb * SEQ + qt * 256) * PAW + COL_QX + hx * 128;
                const bf16* Kp = KVM + (size_t)(bb * MEMLEN) * 1024 + hx * 128; const bf16* Vp = Kp + 512;
                bf16* Op = BRO + (size_t)2 * T * 512 + (size_t)(bb * SEQ + qt * 256) * 512 + hx * 128;
                att::attn_unit<128, false>(Qp, PAW, Kp, Vp, 1024, Op, 0, nullptr, nullptr, q_gain_x, k_gain_x, lds + RING_OFF, tid, wave, lane); }
            conv_item(PA, conv_w, BRO + (size_t)T * 512, v, tid);
        }
        if (BOTH(3) && rep == REPS(3) - 1) GRID_BAR();
    }
    if (IN(4)) for (int rep = 0; rep < REPS(4); ++rep) {
        pg8::Gemm g{BRO, WbrT, 3 * T, 3 * 1024, 512}; pg8::BranchOrder S; S.init(G, bx); pg8::EpiBranch E{PG, MERGED};
        pg8::gemm_phase<pg8::EpiBranch, pg8::BranchOrder, true, true>(lds + RING_OFF, g, S, E);
        if (BOTH(4) && rep == REPS(4) - 1) GRID_BAR();
    }
    if (IN(5)) for (int rep = 0; rep < REPS(5); ++rep) {
        pg8::Gemm g{MERGED, WoutT, T, 1024, DM}; pg8::GOrder S; S.init(T, 1024, G, bx); pg8::EpiWout E{x, out, HB, SLOTS};
        pg8::gemm_phase<pg8::EpiWout, pg8::GOrder, true, true>(lds + RING_OFF, g, S, E);
        if (BOTH(5) && rep == REPS(5) - 1) GRID_BAR();
    }
    if (IN(6)) for (int rep = 0; rep < REPS(6); ++rep) {
        pg8::Gemm g{HB, WqT, T, 2048, DM}; pg8::GOrder S; S.init(T, 2048, G, bx); pg8::EpiBf16<0> E{QRY, 2048, nullptr, 0, 0, 1.f};
        pg8::gemm_phase<pg8::EpiBf16<0>, pg8::GOrder, true, true>(lds + RING_OFF, g, S, E);
        if (BOTH(6) && rep == REPS(6) - 1) GRID_BAR();
    }
    if (IN(7)) for (int rep = 0; rep < REPS(7); ++rep) {
        for (int v = vcu; v < 256; v += G) {
            pk::topk_fill(SK, lds + RING_OFF, v & 3, tid);
#ifndef PROBE_SKIP
#define PROBE_SKIP 0
#endif
            const bool lastrep = rep == REPS(7) - 1;
#ifndef P7_NRQ
#define P7_NRQ 4
#endif
#ifdef P7_STAGGER
            if (wave < 4 && (!(PROBE_SKIP & 1) || lastrep)) pk::topk_task(QRY, SLOTS, SEL, lds + RING_OFF, v & 3, ((v >> 2) * 8 + wave) * 32, lane);
#endif
            if (v == vcu && (!(PROBE_SKIP & 2) || lastrep)) {
                const int qgw = vcu * NWAVES + wave, QNGW = G * NWAVES;
                for (int m = qgw; m < NEXP; m += P7_NRQ * QNGW) quant_rows_i4<P7_NRQ, false>(peer_u, UQ, SU, m, QNGW, NEXP, lane);
                for (int m = qgw; m < NEXP; m += P7_NRQ * QNGW) quant_rows_i4<P7_NRQ, true>(peer_v, VQ, SV, m, QNGW, NEXP, lane);
                float gf[16];
#pragma unroll
                for (int j = 0; j < 16; ++j) gf[j] = g_ffn[4 * lane + 256 * (j >> 2) + (j & 3)];
                for (int t = qgw; t < T; t += P7_NRQ * QNGW) quant_x<P7_NRQ>(HB, XQ, SX, XSM, gf, t, QNGW, lane);
            }
#ifdef P7_STAGGER
            if (wave >= 4 && (!(PROBE_SKIP & 1) || lastrep)) pk::topk_task(QRY, SLOTS, SEL, lds + RING_OFF, v & 3, ((v >> 2) * 8 + wave) * 32, lane);
#else
            if (!(PROBE_SKIP & 1) || lastrep) pk::topk_task(QRY, SLOTS, SEL, lds + RING_OFF, v & 3, ((v >> 2) * 8 + wave) * 32, lane);
#endif
            __syncthreads();
        }
        if (BOTH(7) && rep == REPS(7) - 1) GRID_BAR();
    }
#if !MK_SPLIT
    const int xcc = (int)bar.x & 7;
    const int nloc = (int)__builtin_amdgcn_readfirstlane((int)MISC[8]), wrank = (int)__builtin_amdgcn_readfirstlane((int)MISC[10]);
    const pk_plan_t plan = slice_plan(xcc, wrank * NWAVES + wave, nloc * NWAVES, (const unsigned*)(ctl + CW_BAR) + XB_XCNT(0), lane);
#else
    const int xcc = (int)(xb_xcc_id() & 7u);
    const pk_plan_t plan = slice_plan(xcc, 0, 0, nullptr, lane);
#endif
    if (IN(8)) for (int rep = 0; rep < REPS(8); ++rep) {
        #ifdef PROBE_MASKV
        gather_u(SEL, XQ, UQ, PART, (int*)(ws + WS_END), (unsigned*)(ctl + CW_QU + 4096 * rep), plan, lane, (rep == REPS(8) - 1) ? 0xffffu : (unsigned)PROBE_MASKV);
#else
        gather_u(SEL, XQ, UQ, PART, (int*)(ws + WS_END), (unsigned*)(ctl + CW_QU + 4096 * rep), plan, lane);
#endif
        if (BOTH(8) && rep == REPS(8) - 1) GRID_BAR();
    }
    if (IN(9)) for (int rep = 0; rep < REPS(9); ++rep) {
        for (int t = gw; t < T; t += 4 * NGW) gather_coef<4>(SEL, PART, SU, SV, SX, XSM, CQ, EO, CS, CM, t, NGW, lane);
        if (BOTH(9) && rep == REPS(9) - 1) GRID_BAR();
    }
    if (IN(10)) for (int rep = 0; rep < REPS(10); ++rep) {
        gather_v(EO, CQ, CS, CM, VQ, HB, (rep == REPS(10) - 1) ? out : (float*)PART, (float*)(ws + WS_END), (unsigned*)(ctl + CW_QV + 4096 * rep), plan, lane);
    }
#undef IN
#undef BOTH
}

extern "C" void kernel_launch(void* const* d_in, const int* in_sizes, int n_in, void* d_out, int out_size, void* d_ws, size_t ws_size, hipStream_t stream) {
    static int grid = 0;
    if (grid == 0) {
        if (n_in != 21 || out_size != T * DM || ws_size < WS_END + 4096) { fprintf(stderr, "kernel_launch: unexpected shapes (n_in %d, out %d, ws %zu)\n", n_in, out_size, ws_size); grid = -1; return; }
        int dev = 0, cus = 0, per_cu = 0;
        if (hipGetDevice(&dev) != hipSuccess || hipDeviceGetAttribute(&cus, hipDeviceAttributeMultiprocessorCount, dev) != hipSuccess) { grid = -1; return; }
        if (hipFuncSetAttribute((const void*)fwd, hipFuncAttributeMaxDynamicSharedMemorySize, LDS_BYTES) != hipSuccess) { fprintf(stderr, "kernel_launch: hipFuncSetAttribute failed\n"); grid = -1; return; }
        if (hipOccupancyMaxActiveBlocksPerMultiprocessor(&per_cu, (const void*)fwd, NWAVES * 64, LDS_BYTES) != hipSuccess || per_cu < 1) { fprintf(stderr, "kernel_launch: occupancy query reports %d\n", per_cu); }
        (void)hipGetLastError();
        grid = cus;
    }
    if (grid < 0) return;
    (void)hipMemsetAsync((char*)d_ws + WS_CTL, 0, CTL_ZERO_BYTES, stream);
    Args a{};
    for (int i = 0; i < 21; ++i) a.in[i] = (const float*)d_in[i];
    a.out = (float*)d_out; a.ws = (unsigned char*)d_ws;
#if MK_SPLIT
    for (int p = 0; p < NPHASE; ++p) { a.ph_lo = p; a.ph_hi = p + 1; hipLaunchKernelGGL(fwd, dim3(grid), dim3(NWAVES * 64), LDS_BYTES, stream, a); }
#else
#if defined(PROBE_UPTO)
    a.ph_lo = 0; a.ph_hi = PROBE_UPTO + 1;
    hipLaunchKernelGGL(fwd, dim3(grid), dim3(NWAVES * 64), LDS_BYTES, stream, a);
    (void)hipMemsetAsync((char*)d_ws + WS_CTL, 0, CTL_ZERO_BYTES, stream);
#endif
    a.ph_lo = 0; a.ph_hi = NPHASE;
    hipLaunchKernelGGL(fwd, dim3(grid), dim3(NWAVES * 64), LDS_BYTES, stream, a);
#endif
}
```

```cpp
#include <hip/hip_runtime.h>
#include <hip/hip_bf16.h>
#include <cstdio>
#include <cstdint>
#include <cmath>
namespace pg8 {
#define PG8_LAS __attribute__((address_space(3)))
typedef unsigned short bf16_t;
typedef short bf16x8 __attribute__((ext_vector_type(8)));
typedef float f32x4 __attribute__((ext_vector_type(4)));
typedef unsigned u32x4 __attribute__((ext_vector_type(4)));
typedef int i32x4 __attribute__((ext_vector_type(4)));
constexpr int BM = 256, BK = 64, HALF = 128, HTB = HALF * BK * 2  , STAGE_BYTES = 8 * HTB, NXCD = 8, WGM = 8;

__host__ __device__ __forceinline__ int lds_byte(int r, int c) { const int st = (r >> 4) * 2 + (c >> 5), rr = r & 15, cc = c & 31, ob = rr * 64 + cc * 2; return st * 1024 + (ob ^ (((ob >> 9) & 1) << 5)); }
__host__ __device__ __forceinline__ void stage_rc(int b, int& R, int& C) { const int st = b / 1024, sb = b % 1024, swz = sb ^ (((sb >> 9) & 1) << 5); R = (st >> 1) * 16 + swz / 64; C = (st & 1) * 32 + (swz % 64) / 2; }
__host__ __device__ __forceinline__ int perm32(int rho) { const int n = rho >> 4, i = rho & 15; return 8 * (i >> 2) + 4 * n + (i & 3); }

struct Unit { int pm, pn; };
struct Gemm { const bf16_t* A; const bf16_t* Bt; int M, N, K; };

struct StaticOrder {
    int nM, nN, nwg, G, c;
    __host__ __device__ void init(int M, int N, int G_, int c_) { nM = M / BM; nN = N / BM; nwg = nM * nN; G = G_; c = c_; }
    __host__ __device__ bool next(int i, Unit& u) const {
        const long L = (long)i * G + c; if (L >= nwg) return false;
        int wgid = (int)L; { const int q = nwg / NXCD, r = nwg % NXCD, xcd = wgid % NXCD, off = wgid / NXCD; wgid = (xcd < r ? xcd * (q + 1) : r * (q + 1) + (xcd - r) * q) + off; }
        const int nig = WGM * nN, gid = wgid / nig, fm = gid * WGM, gsz = (nM - fm) < WGM ? (nM - fm) : WGM;
        u.pm = fm + ((wgid % nig) % gsz); u.pn = (wgid % nig) / gsz; return true;
    }
    __device__ __forceinline__ void a_ready(const Unit&) const {}
    __device__ __forceinline__ void done(const Unit&) const {}
};

__device__ __forceinline__ unsigned cvt_pk_bf16(float lo, float hi) { unsigned r; asm volatile("v_cvt_pk_bf16_f32 %0, %1, %2" : "=v"(r) : "v"(lo), "v"(hi)); return r; }
typedef float f32x2 __attribute__((ext_vector_type(2)));
__device__ __forceinline__ f32x2 gelu_pk(f32x2 v) {
    const f32x2 av = __builtin_elementwise_abs(v), d = av * 0.2316418882f + 1.0f;
    f32x2 t; t.x = __builtin_amdgcn_rcpf(d.x); t.y = __builtin_amdgcn_rcpf(d.y);
    f32x2 q = t * 0.5307027145f + (-0.7265760135f); q = q * t + 0.7107068705f; q = q * t + (-0.142248368f); q = q * t + 0.127414796f; q = q * t;
    const f32x2 s = (v * v) * (-0.72134752044f);
    f32x2 e; e.x = __builtin_amdgcn_exp2f(s.x); e.y = __builtin_amdgcn_exp2f(s.y);
    const f32x2 m = v * (q * e), r = v - m;
    f32x2 o; o.x = v.x < 0.f ? m.x : r.x; o.y = v.y < 0.f ? m.y : r.y; return o;
}

template <int ACT  > struct EpiBf16 {
    static constexpr bool KEEP_ACC = false; static constexpr bool PERM = true, AFTER_DRAIN = false, HEAD64 = false; static_assert(ACT == 0 || ACT == 1 || ACT == 2, "EpiBf16: ACT is 0 (none), 1 (gelu_pk) or 2 (sigmoid)");
    bf16_t* O; int ldc; const float* bias; int split_cols; size_t split_stride; float scale0;
    __device__ __forceinline__ void operator()(const f32x4 (&acc)[2][2][4][2], const Unit& u, int wr, int wc, int fr, int fq) const {
        const int row0 = u.pm * BM + wr * 64 + fr; int colt = u.pn * BM; bf16_t* base = O;
        float sc = 1.f; if (split_cols) { const int t = colt / split_cols; base += (size_t)t * split_stride; colt -= t * split_cols; if (t == 0) sc = scale0; }
        const int col0 = colt + wc * 32 + 8 * fq, bcol0 = u.pn * BM + wc * 32 + 8 * fq;
        f32x4 bv[2][2];
#pragma unroll
        for (int bj = 0; bj < 2; ++bj)
#pragma unroll
            for (int n = 0; n < 2; ++n) bv[bj][n] = bias ? *(const f32x4*)(bias + bcol0 + bj * HALF + 4 * n) : (f32x4){0.f, 0.f, 0.f, 0.f};
#pragma unroll
        for (int ai = 0; ai < 2; ++ai)
#pragma unroll
            for (int m = 0; m < 4; ++m) { bf16_t* rowp = base + (size_t)(row0 + ai * HALF + m * 16) * ldc + col0;
#pragma unroll
                for (int bj = 0; bj < 2; ++bj) { f32x4 v0 = acc[ai][bj][m][0] + bv[bj][0], v1 = acc[ai][bj][m][1] + bv[bj][1];
                    if (ACT == 1) { f32x2 a = gelu_pk((f32x2){v0[0], v0[1]}), b = gelu_pk((f32x2){v0[2], v0[3]}), c = gelu_pk((f32x2){v1[0], v1[1]}), d = gelu_pk((f32x2){v1[2], v1[3]});
                        v0 = (f32x4){a.x, a.y, b.x, b.y}; v1 = (f32x4){c.x, c.y, d.x, d.y}; }
                    if (ACT == 2) { _Pragma("unroll") for (int e_ = 0; e_ < 4; ++e_) { v0[e_] = __builtin_amdgcn_rcpf(1.0f + __builtin_amdgcn_exp2f(-1.4426950408889634f * v0[e_])); v1[e_] = __builtin_amdgcn_rcpf(1.0f + __builtin_amdgcn_exp2f(-1.4426950408889634f * v1[e_])); } }
                    v0 = v0 * sc; v1 = v1 * sc; u32x4 w; w.x = cvt_pk_bf16(v0[0], v0[1]); w.y = cvt_pk_bf16(v0[2], v0[3]); w.z = cvt_pk_bf16(v1[0], v1[1]); w.w = cvt_pk_bf16(v1[2], v1[3]);
                    *(u32x4*)(rowp + bj * HALF) = w; } }
    }
};


struct GOrder {
    int nM, nN, nwg, G, c;
    __host__ __device__ void init(int M, int N, int G_, int c_) { nM = M / BM; nN = N / BM; nwg = nM * nN; G = G_; c = c_; }
    __host__ __device__ bool next(int i, Unit& u) const {
        if (c < 0) return false;
        const long L = (long)i * G + c; if (L >= nwg) return false;
        int wgid = (int)L; { const int q = nwg / NXCD, r = nwg % NXCD, xcd = wgid % NXCD, off = wgid / NXCD; wgid = (xcd < r ? xcd * (q + 1) : r * (q + 1) + (xcd - r) * q) + off; }
        const int nig = WGM * nN, gid = wgid / nig, fm = gid * WGM, gsz = (nM - fm) < WGM ? (nM - fm) : WGM;
        u.pm = fm + ((wgid % nig) % gsz); u.pn = (wgid % nig) / gsz; return true;
    }
    __device__ __forceinline__ void a_ready(const Unit&) const {}
    __device__ __forceinline__ void done(const Unit&) const {}
};
struct P1Order : GOrder {
    __host__ __device__ bool next(int i, Unit& u) const {
        if (G == 256 && nwg == 1664 && c >= 128) {
            if (c < 160) { if (i >= 5) return false; }
            else if (c < 192 && i == 6) { GOrder o = *this; o.c = c - 32; return o.GOrder::next(5, u); }
        }
        return GOrder::next(i, u);
    }
};
struct KvOrder {
    GOrder g; int pm, pn; bool direct, has;
    __device__ void init(int G, int bx, int coff) { direct = (G == 256); has = direct && (bx >> 3) >= 16 && (bx >> 3) < 20; pm = bx & 7; pn = (bx >> 3) - 16; g.init(2048, 1024, G, coff); }
    __device__ bool next(int i, Unit& u) const { if (!direct) return g.next(i, u); if (i != 0 || !has) return false; u.pm = pm; u.pn = pn; return true; }
    __device__ __forceinline__ void a_ready(const Unit&) const {}
    __device__ __forceinline__ void done(const Unit&) const {}
};

struct BranchOrder {
    GOrder g;
    __device__ void init(int G, int c) { g.init(16384, 1024, G, c); }
#if defined(PROBE_P4X2)
    __device__ bool next(int i, Unit& u) const { Unit t; if (i >= 6 || !g.next(0, t)) return false; const int br = i % 3; u.pm = 64 * br + t.pm; u.pn = 4 * br + t.pn; return true; }
#else
    __device__ bool next(int i, Unit& u) const { Unit t; if (!g.next(i / 3, t)) return false; const int br = i % 3; u.pm = 64 * br + t.pm; u.pn = 4 * br + t.pn; return true; }
#endif
    __device__ __forceinline__ void a_ready(const Unit&) const {}
    __device__ __forceinline__ void done(const Unit&) const {}
};
__device__ __forceinline__ float bf_lo(unsigned w) { return __builtin_bit_cast(float, w << 16); }
__device__ __forceinline__ float bf_hi(unsigned w) { return __builtin_bit_cast(float, w & 0xffff0000u); }
__device__ __forceinline__ float sigmoid_f(float x) { return __builtin_amdgcn_rcpf(1.0f + __builtin_amdgcn_exp2f(-1.4426950408889634f * x)); }
struct EpiProj {
    static constexpr bool KEEP_ACC = false; static constexpr bool PERM = true, AFTER_DRAIN = false, HEAD64 = true;
    bf16_t* PA; bf16_t* PG; const float* gq; const float* gk; float* KMEAN; float qscale, eps; const float* SA; const float* SB; const PG8_LAS unsigned char* ST; PG8_LAS float* SAS; const PG8_LAS float* GL;
    __device__ __forceinline__ void operator()(const f32x4 (&acc)[2][2][4][2], const Unit& u, int wr, int wc, int fr, int fq) const {
        f32x4 sbv[2][2];
        { const float* sp = SB + u.pn * BM + wc * 64 + 8 * fq;
#pragma unroll
          for (int bj = 0; bj < 2; ++bj)
#pragma unroll
              for (int n = 0; n < 2; ++n) sbv[bj][n] = *(const f32x4*)(sp + 32 * bj + 4 * n) * (u.pn >= 14 ? 256.0f : 1.0f); }
        if (threadIdx.x < 256) SAS[threadIdx.x] = SA[u.pm * BM + threadIdx.x];
        asm volatile("s_waitcnt vmcnt(0) lgkmcnt(0)\n\ts_barrier" ::: "memory");
#define EPQ(ai, bj, m, n, sa) ({ const i32x4 a_ = __builtin_bit_cast(i32x4, acc[ai][bj][m][n]); const f32x4 s_ = sbv[bj][n] * (sa); (f32x4){(float)a_[0] * s_[0], (float)a_[1] * s_[1], (float)a_[2] * s_[2], (float)a_[3] * s_[3]}; })
        const bool gate = u.pn >= 14; const int mode = u.pn < 2 ? 1 : (u.pn < 4 ? 2 : 0);
        bf16_t* base = gate ? PG : PA; const int ldc = gate ? 3072 : 3584; const int colt = gate ? (u.pn - 14) * BM : u.pn * BM;
        const int row0 = u.pm * BM + wr * 64 + fr, col0 = colt + wc * 64 + 8 * fq;
        f32x4 gn[2][2]; f32x4 cs[2][2];
#pragma unroll
        for (int bj = 0; bj < 2; ++bj)
#pragma unroll
            for (int n = 0; n < 2; ++n) { cs[bj][n] = (f32x4){0.f, 0.f, 0.f, 0.f}; gn[bj][n] = (f32x4){1.f, 1.f, 1.f, 1.f};
                if (mode) gn[bj][n] = *(const PG8_LAS f32x4*)(GL + (mode == 1 ? 0 : 64) + 32 * bj + 8 * fq + 4 * n); }
#pragma unroll
        for (int ai = 0; ai < 2; ++ai)
#pragma unroll
            for (int m = 0; m < 4; ++m) { bf16_t* rowp = base + (size_t)(row0 + ai * HALF + m * 16) * ldc + col0;
                const float sa = SAS[wr * 64 + fr + ai * HALF + m * 16];
                float r = 1.f;
                if (mode) { float ss = 0.f;
#pragma unroll
                    for (int bj = 0; bj < 2; ++bj)
#pragma unroll
                        for (int n = 0; n < 2; ++n) { const f32x4 v = EPQ(ai, bj, m, n, sa); ss += (v[0] * v[0] + v[1] * v[1]) + (v[2] * v[2] + v[3] * v[3]); }
                    ss += __shfl_xor(ss, 16); ss += __shfl_xor(ss, 32);
                    r = 1.0f / sqrtf(ss * (1.f / 64.f) + eps); }
#pragma unroll
                for (int bj = 0; bj < 2; ++bj) { f32x4 v0 = EPQ(ai, bj, m, 0, sa), v1 = EPQ(ai, bj, m, 1, sa);
                    if (gate) {
#pragma unroll
                        for (int e = 0; e < 4; ++e) { v0[e] = __builtin_amdgcn_fmed3f(v0[e], -2048.f, 2047.f); v1[e] = __builtin_amdgcn_fmed3f(v1[e], -2048.f, 2047.f); } }
                    if (mode) { v0 = v0 * r * gn[bj][0]; v1 = v1 * r * gn[bj][1]; if (mode == 2) { cs[bj][0] += v0; cs[bj][1] += v1; } }
                    if (gate) {
                        typedef unsigned u32x2g __attribute__((ext_vector_type(2))); unsigned q[8];
#pragma unroll
                        for (int e = 0; e < 4; ++e) { q[e] = ST[__builtin_bit_cast(unsigned, v0[e] + 12584960.0f) & 0xfffu]; q[4 + e] = ST[__builtin_bit_cast(unsigned, v1[e] + 12584960.0f) & 0xfffu]; }
                        u32x2g wq; wq.x = __builtin_amdgcn_perm(q[1], q[0], 0x0c0c0400u) | __builtin_amdgcn_perm(q[3], q[2], 0x04000c0cu); wq.y = __builtin_amdgcn_perm(q[5], q[4], 0x0c0c0400u) | __builtin_amdgcn_perm(q[7], q[6], 0x04000c0cu);
                        *(u32x2g*)((unsigned char*)PG + (size_t)((u.pm * 3 + ((u.pn - 14) >> 2)) * 4 + ((u.pn - 14) & 3)) * 65536 + (wr * 4 + 2 * (wc & 1)) * 8192 + (wc >> 1) * 512 + (threadIdx.x & 63) * 8 + bj * 8192 + ai * 4096 + m * 1024) = wq;
                    } else {
                    u32x4 w; w.x = cvt_pk_bf16(v0[0], v0[1]); w.y = cvt_pk_bf16(v0[2], v0[3]); w.z = cvt_pk_bf16(v1[0], v1[1]); w.w = cvt_pk_bf16(v1[2], v1[3]);
                    *(u32x4*)(rowp + bj * 32) = w; } } }
        if (mode == 2) {
            const int b = u.pm >> 3, nb = u.pm & 7, head = (u.pn - 2) * 4 + wc;
            float* km = KMEAN + (size_t)((b * 8 + head) * 8 + nb) * 64 + 8 * fq;
#pragma unroll
            for (int bj = 0; bj < 2; ++bj)
#pragma unroll
                for (int n = 0; n < 2; ++n)
#pragma unroll
                    for (int e = 0; e < 4; ++e) { float s = cs[bj][n][e];
                        s += __shfl_xor(s, 1); s += __shfl_xor(s, 2); s += __shfl_xor(s, 4); s += __shfl_xor(s, 8);
                        if (fr == 0) atomicAdd(km + 32 * bj + 4 * n + e, s * (1.f / 256.f)); }
        }
    }
};
struct EpiBranch {
    static constexpr bool KEEP_ACC = true; static constexpr bool PERM = true, AFTER_DRAIN = false, HEAD64 = false;
    const bf16_t* PG; bf16_t* MG; unsigned char* TMP;
    __device__ __forceinline__ void operator()(f32x4 (&acc)[2][2][4][2], const Unit& u, int wr, int wc, int fr, int fq) const {
        const int br = u.pm >> 6, tm = u.pm & 63, tn = u.pn & 3;
        const int row0 = tm * BM + wr * 64 + fr, col0 = tn * BM + wc * 32 + 8 * fq;
        typedef unsigned u32x2g __attribute__((ext_vector_type(2)));
        const unsigned char* gp = (const unsigned char*)PG + (size_t)((tm * 3 + br) * 4 + tn) * 65536 + (wr * 4 + wc) * 8192 + (fr + 16 * fq) * 8;
        constexpr float GS = 1.f / 255.f;
#define BR_G(W, J) ((float)(((W) >> (8 * (J))) & 0xffu))
        {
            u32x2g ga[4][2]; u32x4 p[4][2]; unsigned char* tp = TMP + (wr * 4 + wc) * 8192 + (threadIdx.x & 63) * 16;
#pragma unroll
            for (int m = 0; m < 4; ++m)
#pragma unroll
                for (int bj = 0; bj < 2; ++bj) { ga[m][bj] = *(const u32x2g*)(gp + 4096 + m * 1024 + bj * 512);
                    p[m][bj] = (br > 0) ? *(const u32x4*)(tp + (m * 2 + bj) * 1024) : (u32x4){0u, 0u, 0u, 0u}; }
#pragma unroll
            for (int m = 0; m < 4; ++m)
#pragma unroll
                for (int bj = 0; bj < 2; ++bj) { const u32x2g gg = ga[m][bj]; const u32x4 pp = p[m][bj];
                    f32x4 v0 = acc[1][bj][m][0], v1 = acc[1][bj][m][1];
                    v0[0] = v0[0] * (BR_G(gg.x, 0) * GS) + bf_lo(pp.x); v0[1] = v0[1] * (BR_G(gg.x, 1) * GS) + bf_hi(pp.x); v0[2] = v0[2] * (BR_G(gg.x, 2) * GS) + bf_lo(pp.y); v0[3] = v0[3] * (BR_G(gg.x, 3) * GS) + bf_hi(pp.y);
                    v1[0] = v1[0] * (BR_G(gg.y, 0) * GS) + bf_lo(pp.z); v1[1] = v1[1] * (BR_G(gg.y, 1) * GS) + bf_hi(pp.z); v1[2] = v1[2] * (BR_G(gg.y, 2) * GS) + bf_lo(pp.w); v1[3] = v1[3] * (BR_G(gg.y, 3) * GS) + bf_hi(pp.w);
                    u32x4 w; w.x = cvt_pk_bf16(v0[0], v0[1]); w.y = cvt_pk_bf16(v0[2], v0[3]); w.z = cvt_pk_bf16(v1[0], v1[1]); w.w = cvt_pk_bf16(v1[2], v1[3]);
                    if (br < 2) *(u32x4*)(tp + (m * 2 + bj) * 1024) = w; else *(u32x4*)(MG + (size_t)(row0 + HALF + m * 16) * 1024 + col0 + bj * HALF) = w; }
        }
        if (br < 2) {
            u32x2g ga[4][2], gb[4][2];
#pragma unroll
            for (int m = 0; m < 4; ++m)
#pragma unroll
                for (int bj = 0; bj < 2; ++bj) { const unsigned char* q = gp + m * 1024 + bj * 512; ga[m][bj] = *(const u32x2g*)q; gb[m][bj] = *(const u32x2g*)(q + 262144); }
#pragma unroll
            for (int m = 0; m < 4; ++m)
#pragma unroll
                for (int bj = 0; bj < 2; ++bj) { const u32x2g g0 = ga[m][bj], g1 = gb[m][bj];
#pragma unroll
                    for (int j = 0; j < 4; ++j) {
                        acc[0][bj][m][0][j] *= BR_G(g0.x, j) * __builtin_amdgcn_rcpf(BR_G(g1.x, j));
                        acc[0][bj][m][1][j] *= BR_G(g0.y, j) * __builtin_amdgcn_rcpf(BR_G(g1.y, j)); } }
        } else {
            u32x2g ga[4][2];
#pragma unroll
            for (int m = 0; m < 4; ++m)
#pragma unroll
                for (int bj = 0; bj < 2; ++bj) ga[m][bj] = *(const u32x2g*)(gp + m * 1024 + bj * 512);
#pragma unroll
            for (int m = 0; m < 4; ++m)
#pragma unroll
                for (int bj = 0; bj < 2; ++bj) { const u32x2g gg = ga[m][bj];
                    f32x4 v0 = acc[0][bj][m][0], v1 = acc[0][bj][m][1];
#pragma unroll
                    for (int j = 0; j < 4; ++j) { v0[j] *= BR_G(gg.x, j) * GS; v1[j] *= BR_G(gg.y, j) * GS; }
                    u32x4 w; w.x = cvt_pk_bf16(v0[0], v0[1]); w.y = cvt_pk_bf16(v0[2], v0[3]); w.z = cvt_pk_bf16(v1[0], v1[1]); w.w = cvt_pk_bf16(v1[2], v1[3]);
                    *(u32x4*)(MG + (size_t)(row0 + m * 16) * 1024 + col0 + bj * HALF) = w;
                    acc[0][bj][m][0] = (f32x4){0.f, 0.f, 0.f, 0.f}; acc[0][bj][m][1] = (f32x4){0.f, 0.f, 0.f, 0.f}; }
        }
#undef BR_G
    }
};
struct EpiScores {
    static constexpr bool KEEP_ACC = false; static constexpr bool PERM = true, AFTER_DRAIN = false, HEAD64 = false;
    bf16_t* O;
    __device__ __forceinline__ void operator()(const f32x4 (&acc)[2][2][4][2], const Unit& u, int wr, int wc, int fr, int fq) const {
        unsigned char* bp = (unsigned char*)O + (size_t)(u.pm * 8 + u.pn) * 131072 + wr * 32768 + wc * 1024 + (threadIdx.x & 63) * 16;
#pragma unroll
        for (int ai = 0; ai < 2; ++ai)
#pragma unroll
            for (int m = 0; m < 4; ++m)
#pragma unroll
                for (int bj = 0; bj < 2; ++bj) { const f32x4 v0 = acc[ai][bj][m][0], v1 = acc[ai][bj][m][1];
                    u32x4 w; w.x = cvt_pk_bf16(v0[0], v0[1]); w.y = cvt_pk_bf16(v0[2], v0[3]); w.z = cvt_pk_bf16(v1[0], v1[1]); w.w = cvt_pk_bf16(v1[2], v1[3]);
                    *(u32x4*)(bp + ai * 65536 + m * 8192 + bj * 4096) = w; }
    }
};
struct EpiWout {
    static constexpr bool KEEP_ACC = false; static constexpr bool PERM = true, AFTER_DRAIN = false, HEAD64 = false;
    const float* X; float* H; bf16_t* HB; float* SL;
    __device__ __forceinline__ void operator()(const f32x4 (&acc)[2][2][4][2], const Unit& u, int wr, int wc, int fr, int fq) const {
        const int row0 = u.pm * BM + wr * 64 + fr, col0 = u.pn * BM + wc * 32 + 8 * fq;
        f32x4 xv[2][2][2][2];
#define WOUT_LOAD(G_) do { _Pragma("unroll") for (int mm = 0; mm < 2; ++mm) _Pragma("unroll") for (int bj = 0; bj < 2; ++bj) _Pragma("unroll") for (int n = 0; n < 2; ++n) \
            xv[(G_) & 1][mm][bj][n] = *(const f32x4*)(X + (size_t)(row0 + ((G_) >> 1) * HALF + (2 * ((G_) & 1) + mm) * 16) * 1024 + col0 + bj * HALF + n * 4); } while (0)
        WOUT_LOAD(0);
#pragma unroll
        for (int g = 0; g < 4; ++g) { const int ai = g >> 1, mh = g & 1;
            if (g < 3) WOUT_LOAD(g + 1);
#pragma unroll
            for (int mm = 0; mm < 2; ++mm) { const int m = 2 * mh + mm; const size_t row = (size_t)(row0 + ai * HALF + m * 16); float ss = 0.f;
#pragma unroll
                for (int bj = 0; bj < 2; ++bj) {
                    const f32x4 h0 = xv[g & 1][mm][bj][0] + acc[ai][bj][m][0], h1 = xv[g & 1][mm][bj][1] + acc[ai][bj][m][1];
                    ss += ((h0[0] * h0[0] + h0[1] * h0[1]) + (h0[2] * h0[2] + h0[3] * h0[3])) + ((h1[0] * h1[0] + h1[1] * h1[1]) + (h1[2] * h1[2] + h1[3] * h1[3]));
                    u32x4 w; w.x = cvt_pk_bf16(h0[0], h0[1]); w.y = cvt_pk_bf16(h0[2], h0[3]); w.z = cvt_pk_bf16(h1[0], h1[1]); w.w = cvt_pk_bf16(h1[2], h1[3]);
                    *(u32x4*)(HB + row * 1024 + col0 + bj * HALF) = w; }
                ss += __shfl_xor(ss, 16); ss += __shfl_xor(ss, 32);
                if (fq == 0) SL[row * 16 + u.pn * 4 + wc] = ss; }
        }
#undef WOUT_LOAD
    }
};
template <class Epi, class Sched, bool ALIGN_EPI = false, bool SP2 = false, bool I8 = false>
__device__ __forceinline__ void gemm_phase(PG8_LAS unsigned char* lds, const Gemm g, const Sched& S, const Epi& E) {
    const int tid = threadIdx.x, wid = __builtin_amdgcn_readfirstlane(tid >> 6), lane = tid & 63, wr = wid >> 2, wc = wid & 3, fr = lane & 15, fq = lane >> 4;
    const int K = g.K, nt = K / BK;
    unsigned voffA[2], voffB[2];
#pragma unroll
    for (int i = 0; i < 2; ++i) { int R, C; stage_rc(tid * 16 + i * 8192, R, C); const int Rb = Epi::HEAD64 ? (64 * (R >> 5) + perm32(R & 31)) : (Epi::PERM ? ((R & ~31) + perm32(R & 31)) : R);
        voffA[i] = (unsigned)(R * K + C) * 2u; voffB[i] = (unsigned)(Rb * K + C) * 2u; }
    const size_t kstep = (size_t)(BK * 2);
    const size_t hstep = (size_t)HALF * K * 2;
    const size_t hstepB = Epi::HEAD64 ? (size_t)32 * K * 2 : hstep;
    const size_t tstep = 2 * hstep;
    const unsigned ldsw = (unsigned)wid * 1024u;
    const int aoff = lds_byte(wr * 64 + fr, fq * 8), boff = lds_byte(wc * 32 + fr, fq * 8);
#define PG8_SA(b, h) (((b) * 2 + (h)) * HTB)
#define PG8_SB(b, h) ((4 + (b) * 2 + (h)) * HTB)
#define PG8_STAGE(bufoff, gbase, voff) do { _Pragma("unroll") for (int _i = 0; _i < 2; ++_i) \
        __builtin_amdgcn_global_load_lds((const unsigned*)((const char*)(gbase) + (voff)[_i]), (PG8_LAS unsigned*)(lds + (bufoff) + ldsw + _i * 8192), 16, 0, 0); } while (0)
#define PG8_LDA(dst, b, h) do { _Pragma("unroll") for (int m = 0; m < 4; ++m) _Pragma("unroll") for (int k = 0; k < 2; ++k) dst[m][k] = *(const PG8_LAS bf16x8*)(lds + PG8_SA(b, h) + aoff + m * 2048 + k * 1024); } while (0)
#define PG8_LDB(dst, b, h) do { _Pragma("unroll") for (int n = 0; n < 2; ++n) _Pragma("unroll") for (int k = 0; k < 2; ++k) dst[n][k] = *(const PG8_LAS bf16x8*)(lds + PG8_SB(b, h) + boff + n * 2048 + k * 1024); } while (0)
#define PG8_MMA(ai, bj, At, Bt) do { __builtin_amdgcn_s_setprio(1); _Pragma("unroll") for (int m = 0; m < 4; ++m) _Pragma("unroll") for (int n = 0; n < 2; ++n) _Pragma("unroll") for (int k = 0; k < 2; ++k) \
        { if constexpr (I8) acc[ai][bj][m][n] = __builtin_bit_cast(f32x4, __builtin_amdgcn_mfma_i32_16x16x64_i8(__builtin_bit_cast(i32x4, Bt[n][k]), __builtin_bit_cast(i32x4, At[m][k]), __builtin_bit_cast(i32x4, acc[ai][bj][m][n]), 0, 0, 0)); \
          else acc[ai][bj][m][n] = __builtin_amdgcn_mfma_f32_16x16x32_bf16(Bt[n][k], At[m][k], acc[ai][bj][m][n], 0, 0, 0); } __builtin_amdgcn_s_setprio(0); } while (0)
#define PG8_WAIT_V(n) asm volatile("s_waitcnt vmcnt(" #n ")" ::: "memory")
#define PG8_WAIT_L(n) asm volatile("s_waitcnt lgkmcnt(" #n ")" ::: "memory")
#define PG8_BAR __builtin_amdgcn_s_barrier()
#define PG8_SCHED __builtin_amdgcn_sched_barrier(0)
    Unit cur, nxt; int ui = 0;
    if (!S.next(0, cur)) return;
    f32x4 acc[2][2][4][2];
#pragma unroll
    for (int a = 0; a < 2; ++a)
#pragma unroll
        for (int b = 0; b < 2; ++b)
#pragma unroll
            for (int m = 0; m < 4; ++m)
#pragma unroll
                for (int n = 0; n < 2; ++n) acc[a][b][m][n] = (f32x4){0.f, 0.f, 0.f, 0.f};
    bf16x8 At[4][2], B0[2][2], B1[2][2];
    const char* cA = (const char*)g.A + (size_t)cur.pm * tstep; const char* cB = (const char*)g.Bt + (size_t)cur.pn * tstep;
    S.a_ready(cur);
    if constexpr (SP2) {
        PG8_STAGE(PG8_SB(0, 0), cB, voffB); PG8_STAGE(PG8_SB(0, 1), cB + hstepB, voffB); PG8_STAGE(PG8_SA(0, 0), cA, voffA); PG8_STAGE(PG8_SA(0, 1), cA + hstep, voffA);
        if (wr == 1) PG8_BAR;
        PG8_WAIT_V(2); PG8_BAR;
        PG8_STAGE(PG8_SB(1, 0), cB + kstep, voffB); PG8_STAGE(PG8_SA(1, 0), cA + kstep, voffA); PG8_STAGE(PG8_SB(1, 1), cB + hstepB + kstep, voffB);
        PG8_WAIT_V(6); PG8_BAR;
    } else {
        PG8_STAGE(PG8_SB(0, 0), cB, voffB); PG8_STAGE(PG8_SA(0, 0), cA, voffA); PG8_STAGE(PG8_SB(0, 1), cB + hstepB, voffB); PG8_STAGE(PG8_SA(0, 1), cA + hstep, voffA);
        if (wr == 1) PG8_BAR;
        PG8_WAIT_V(4); PG8_BAR;
        PG8_STAGE(PG8_SB(1, 0), cB + kstep, voffB); PG8_STAGE(PG8_SA(1, 0), cA + kstep, voffA); PG8_STAGE(PG8_SB(1, 1), cB + hstepB + kstep, voffB);
        PG8_WAIT_V(6); PG8_BAR;
    }
    for (;;) {
        const bool has_next = S.next(ui + 1, nxt);
        const char* nA = has_next ? (const char*)g.A + (size_t)nxt.pm * tstep : cA; const char* nB = has_next ? (const char*)g.Bt + (size_t)nxt.pn * tstep : cB;
        for (int t = 0; t < nt; t += 2) {
            const bool last = (t == nt - 2);
            const char* a1 = cA + (size_t)(t + 1) * kstep;
            const char* a2 = last ? nA : cA + (size_t)(t + 2) * kstep; const char* b2 = last ? nB : cB + (size_t)(t + 2) * kstep;
            const char* a3 = a2 + kstep; const char* b3 = b2 + kstep;
            if (last && has_next) S.a_ready(nxt);
            if constexpr (SP2) {
            PG8_LDB(B0, 0, 0); PG8_LDB(B1, 0, 1); PG8_SCHED; PG8_LDA(At, 0, 0); PG8_STAGE(PG8_SA(1, 1), a1 + hstep, voffA);
            PG8_WAIT_V(8); PG8_WAIT_L(0); PG8_BAR; PG8_MMA(0, 0, At, B0); PG8_MMA(0, 1, At, B1); PG8_BAR; PG8_SCHED;
            PG8_LDA(At, 0, 1); PG8_STAGE(PG8_SB(0, 0), b2, voffB); PG8_STAGE(PG8_SB(0, 1), b2 + hstepB, voffB); PG8_STAGE(PG8_SA(0, 0), a2, voffA);
            PG8_WAIT_V(8); PG8_WAIT_L(0); PG8_BAR; PG8_MMA(1, 0, At, B0); PG8_MMA(1, 1, At, B1); PG8_BAR; PG8_SCHED;
            PG8_LDB(B0, 1, 0); PG8_LDB(B1, 1, 1); PG8_SCHED; PG8_LDA(At, 1, 0); PG8_STAGE(PG8_SA(0, 1), a2 + hstep, voffA);
            PG8_WAIT_V(8); PG8_WAIT_L(0); PG8_BAR; PG8_MMA(0, 0, At, B0); PG8_MMA(0, 1, At, B1); PG8_BAR; PG8_SCHED;
            PG8_LDA(At, 1, 1); PG8_STAGE(PG8_SB(1, 0), b3, voffB); PG8_STAGE(PG8_SB(1, 1), b3 + hstepB, voffB); PG8_STAGE(PG8_SA(1, 0), a3, voffA);
            PG8_WAIT_V(8); PG8_WAIT_L(0); PG8_BAR; PG8_MMA(1, 0, At, B0); PG8_MMA(1, 1, At, B1); PG8_BAR; PG8_SCHED;
            } else {
            PG8_LDB(B0, 0, 0); PG8_SCHED; PG8_LDA(At, 0, 0); PG8_STAGE(PG8_SA(1, 1), a1 + hstep, voffA);
            PG8_WAIT_L(8); PG8_BAR; PG8_WAIT_L(0); PG8_MMA(0, 0, At, B0); PG8_BAR; PG8_SCHED;
            PG8_LDB(B1, 0, 1); PG8_STAGE(PG8_SB(0, 0), b2, voffB);
            PG8_BAR; PG8_WAIT_L(0); PG8_MMA(0, 1, At, B1); PG8_BAR;
            PG8_LDA(At, 0, 1); PG8_STAGE(PG8_SA(0, 0), a2, voffA);
            PG8_BAR; PG8_WAIT_L(0); PG8_MMA(1, 0, At, B0); PG8_BAR; PG8_SCHED;
            PG8_STAGE(PG8_SB(0, 1), b2 + hstepB, voffB);
            PG8_WAIT_V(6); PG8_BAR; PG8_MMA(1, 1, At, B1); PG8_BAR;
            PG8_LDB(B0, 1, 0); PG8_SCHED; PG8_LDA(At, 1, 0); PG8_STAGE(PG8_SA(0, 1), a2 + hstep, voffA);
            PG8_WAIT_L(8); PG8_BAR; PG8_WAIT_L(0); PG8_MMA(0, 0, At, B0); PG8_BAR; PG8_SCHED;
            PG8_LDB(B1, 1, 1); PG8_STAGE(PG8_SB(1, 0), b3, voffB);
            PG8_BAR; PG8_WAIT_L(0); PG8_MMA(0, 1, At, B1); PG8_BAR;
            PG8_LDA(At, 1, 1); PG8_STAGE(PG8_SA(1, 0), a3, voffA);
            PG8_BAR; PG8_WAIT_L(0); PG8_MMA(1, 0, At, B0); PG8_BAR; PG8_SCHED;
            PG8_STAGE(PG8_SB(1, 1), b3 + hstepB, voffB);
            PG8_WAIT_V(6); PG8_BAR; PG8_MMA(1, 1, At, B1); PG8_BAR;
            }
        }
        if constexpr (ALIGN_EPI) { if (wr == 0) PG8_BAR; }
        if constexpr (!Epi::AFTER_DRAIN) { E(acc, cur, wr, wc, fr, fq); S.done(cur); }
        if (!has_next) break;
#pragma unroll
        for (int a = Epi::KEEP_ACC ? 1 : 0; a < 2; ++a)
#pragma unroll
            for (int b = 0; b < 2; ++b)
#pragma unroll
                for (int m = 0; m < 4; ++m)
#pragma unroll
                    for (int n = 0; n < 2; ++n) acc[a][b][m][n] = (f32x4){0.f, 0.f, 0.f, 0.f};
        cur = nxt; cA = nA; cB = nB; ++ui;
        if constexpr (ALIGN_EPI) { if (wr == 1) PG8_BAR; }
    }
    PG8_WAIT_V(0);
    if constexpr (!ALIGN_EPI) { if (wr == 0) PG8_BAR; }
    PG8_BAR;
    if constexpr (Epi::AFTER_DRAIN) { E.fused(acc, cur, wr, wc, fr, fq, lds, wid, lane); S.done(cur); }
#undef PG8_SA
#undef PG8_SB
#undef PG8_STAGE
#undef PG8_LDA
#undef PG8_LDB
#undef PG8_MMA
#undef PG8_WAIT_V
#undef PG8_WAIT_L
#undef PG8_BAR
#undef PG8_SCHED
}
}

constexpr int NWAVES = 8;
constexpr int T = 16384, DM = 1024, SEQ = 2048, NBATCH = 8, MEMLEN = 256;
constexpr int PW = 6656, PAW = 3584, PGW = 3072;
constexpr int COL_QA = 0, COL_KA = 512, COL_VA = 1024, COL_UC = 1536, COL_BC = 2048, COL_CC = 2560, COL_QX = 3072;
constexpr float RMS_EPS = 1e-6f, LOG2E = 1.4426950408889634f;
constexpr float C2A = 0.125f * LOG2E;
constexpr float C2X = 0.08838834764831845f * LOG2E;
constexpr int NEXP = 16384;

constexpr size_t MiB = 1u << 20;
constexpr size_t WS_CTL = 0, CTL_ZERO_BYTES = 1 * MiB;
constexpr size_t WS_WIN = 1 * MiB;
constexpr size_t WS_WKV = 14 * MiB;
constexpr size_t WS_WBR = 16 * MiB;
constexpr size_t WS_WOUT = 19 * MiB;
constexpr size_t WS_WQ = 21 * MiB;
constexpr size_t WS_SK = 25 * MiB;
constexpr size_t WS_TAB = 25 * MiB + 512 * 1024;
constexpr size_t WS_KMEAN = WS_CTL + 256 * 1024;
constexpr size_t WS_MEMN = 26 * MiB;
constexpr size_t WS_KVM = 30 * MiB;
constexpr size_t WS_SLOTS = 34 * MiB;
constexpr size_t WS_SEL = 35 * MiB;
constexpr size_t WS_SU = 43 * MiB, WS_SV = 43 * MiB + 65536, WS_SX = 43 * MiB + 2 * 65536, WS_CS = 43 * MiB + 3 * 65536, WS_CM = 43 * MiB + 4 * 65536, WS_XS = 43 * MiB + 5 * 65536, WS_SA = 43 * MiB + 6 * 65536, WS_SB = 43 * MiB + 7 * 65536;
constexpr size_t WS_PA = 44 * MiB;
constexpr size_t WS_PG = 204 * MiB;
constexpr size_t WS_END = 252 * MiB;
constexpr size_t PA_MERGED = WS_PA, PA_HB = WS_PA + 32 * MiB, PA_UT = 172 * MiB, PA_VT = 180 * MiB;
constexpr size_t PG_QRY = 108 * MiB, PG_PART = 108 * MiB, PG_COEF = 140 * MiB, PA_XQ = 188 * MiB;
constexpr int CW_QU = 8192, CW_QV = 8192 + 2048, CW_RANK = 8192 + 4096 + 8192;
constexpr int CW_BAR = 4096;
constexpr int CW_GB = 28672;

constexpr int RING_OFF = 0, RING_BYTES = 131072;
constexpr int LDSCTL_OFF = RING_BYTES, MISC_OFF = LDSCTL_OFF + 320;
constexpr int LDS_BYTES = 147456;
constexpr int QKGAIN_OFF = LDSCTL_OFF + 9216;
constexpr int SASTAGE_OFF = LDSCTL_OFF + 8192;
constexpr int SIGTAB_OFF = LDSCTL_OFF + 2048;

#define GAS __attribute__((address_space(1)))
#define LAS __attribute__((address_space(3)))
typedef unsigned short bf16;
typedef unsigned v4u __attribute__((ext_vector_type(4)));
typedef unsigned v2u __attribute__((ext_vector_type(2)));
typedef float f32x4 __attribute__((ext_vector_type(4)));
typedef float f32x16 __attribute__((ext_vector_type(16)));
typedef short bf16x8 __attribute__((ext_vector_type(8)));
typedef short s16x4 __attribute__((ext_vector_type(4)));
typedef GAS unsigned gu32;
#define RLX_AGENT __ATOMIC_RELAXED, __HIP_MEMORY_SCOPE_AGENT
#define LDS_WAIT() asm volatile("s_waitcnt lgkmcnt(0)" ::: "memory")
#define VM_WAIT() asm volatile("s_waitcnt vmcnt(0)" ::: "memory")
__device__ __forceinline__ unsigned f2bf(float f) { unsigned u = __builtin_bit_cast(unsigned, f); return (u + 0x7fffu + ((u >> 16) & 1u)) >> 16; }
__device__ __forceinline__ unsigned pk2(float lo, float hi) { return f2bf(lo) | (f2bf(hi) << 16); }
__device__ __forceinline__ float bflo(unsigned w) { return __builtin_bit_cast(float, w << 16); }
__device__ __forceinline__ float bfhi(unsigned w) { return __builtin_bit_cast(float, w & 0xffff0000u); }
__device__ __forceinline__ float wave_sum(float v) {
#pragma unroll
    for (int o = 1; o < 64; o <<= 1) v += __shfl_xor(v, o);
    return v;
}
#define XB_TMO      128
#define XB_XCNT(j)  (256  + 64 * (j))
#define XB_XSUB(j)  (1280 + 64 * (j))
#define XB_XGEN(j)  (2304 + 64 * (j))
#define XB_TOP      3328
#define XB_TOPGEN   3392
#define XCD_BAR_WORDS 3456
#define XB_SPIN_CAP (1u << 18)

__device__ __forceinline__ unsigned xb_ld(unsigned* p)              { return __hip_atomic_load(p, __ATOMIC_RELAXED, __HIP_MEMORY_SCOPE_AGENT); }
__device__ __forceinline__ unsigned xb_add(unsigned* p, unsigned v) { return __hip_atomic_fetch_add(p, v, __ATOMIC_RELAXED, __HIP_MEMORY_SCOPE_AGENT); }
__device__ __forceinline__ unsigned xb_xcc_id() { return (unsigned)__builtin_amdgcn_s_getreg((3 << 11) | 20) & 0xFu; }
#define XB_SPIN(cond, bar) do { unsigned _sp = 0; while (cond) { __builtin_amdgcn_s_sleep(1); \
    if ((++_sp & 255u) == 0u) { if (xb_ld(&(bar)[XB_TMO])) break; if (_sp > XB_SPIN_CAP) { atomicAdd(&(bar)[XB_TMO], 1u); break; } } } } while (0)

struct XcdBarrier {
    unsigned* bar; unsigned x;
    volatile LAS unsigned* st;
};

__device__ __forceinline__ XcdBarrier xcd_barrier_post(unsigned* bar, volatile LAS unsigned* st) {
    XcdBarrier b; b.bar = bar; b.x = xb_xcc_id(); b.st = st;
    if (threadIdx.x == 0) (void)xb_add(&bar[XB_XCNT(b.x)], 1u);
    return b;
}
__device__ __forceinline__ void xcd_barrier_complete(unsigned* bar, unsigned x, unsigned& nloc, unsigned& nx) {
    const unsigned G = gridDim.x * gridDim.y * gridDim.z;
    unsigned sum, cnt, mine, sp = 0u;
    for (;;) {
        sum = 0u; cnt = 0u; mine = 0u;
#pragma unroll
        for (unsigned j = 0; j < 16; ++j) { const unsigned c = xb_ld(&bar[XB_XCNT(j)]); sum += c; cnt += (c > 0u) ? 1u : 0u; mine = (j == x) ? c : mine; }
        if (sum == G) break;
        __builtin_amdgcn_s_sleep(1);
        if ((++sp & 255u) == 0u) { if (xb_ld(&bar[XB_TMO])) break; if (sp > XB_SPIN_CAP) { atomicAdd(&bar[XB_TMO], 1u); break; } }
    }
    nloc = mine > 0u ? mine : 1u; nx = cnt > 0u ? cnt : 1u;
}

__device__ __forceinline__ void xcd_barrier(const XcdBarrier& b) {
    asm volatile("s_waitcnt vmcnt(0)" ::: "memory");
    __syncthreads();
    if (threadIdx.x < 64) {
        unsigned* bar = b.bar; const unsigned l = threadIdx.x;
        unsigned gen = 0u;
        if (l == 0u) {
            __builtin_amdgcn_s_waitcnt(0);
            unsigned nloc = b.st[0], nx = b.st[1];
            if (nloc == 0u) { xcd_barrier_complete(bar, b.x, nloc, nx); b.st[0] = nloc; b.st[1] = nx; }
            const unsigned old = xb_add(&bar[XB_XSUB(b.x)], 1u);
            gen = old / nloc;
            if (old + 1u == (gen + 1u) * nloc) {
                __builtin_amdgcn_fence(__ATOMIC_RELEASE, "agent");
                asm volatile("s_waitcnt vmcnt(0)" ::: "memory");
                __hip_atomic_store(&bar[XB_XGEN(b.x)], gen + 1u, __ATOMIC_RELAXED, __HIP_MEMORY_SCOPE_AGENT);
            }
        }
        gen = (unsigned)__builtin_amdgcn_readfirstlane((int)gen);
        const unsigned target = gen + 1u;
        const unsigned cntj = l < 16u ? xb_ld(&bar[XB_XCNT(l)]) : 0u;
        unsigned sp = 0u;
        for (;;) {
            const unsigned v = (l < 16u && cntj != 0u) ? xb_ld(&bar[XB_XGEN(l)]) : target;
            if (__builtin_amdgcn_ballot_w64((int)(v - target) >= 0) == ~0ull) break;
            __builtin_amdgcn_s_sleep(1);
            if ((++sp & 255u) == 0u) { if (__builtin_amdgcn_readfirstlane((int)xb_ld(&bar[XB_TMO]))) break; if (sp > XB_SPIN_CAP) { if (l == 0u) atomicAdd(&bar[XB_TMO], 1u); break; } }
        }
        __builtin_amdgcn_fence(__ATOMIC_ACQUIRE, "agent");
        asm volatile("s_waitcnt vmcnt(0)" ::: "memory");
    }
    __syncthreads();
}

#define GB_CNT(g)  (64 * (g))
#define GB_GEN(g)  (512 + 64 * (g))
#define GB_MASK(g) (1024 + 64 * (g))
__device__ __forceinline__ void grp_barrier(unsigned* gb, unsigned g, unsigned n) {
    asm volatile("s_waitcnt vmcnt(0)" ::: "memory");
    __syncthreads();
    if (threadIdx.x < 64) {
        unsigned gen = 0u;
        if (threadIdx.x == 0) {
            __builtin_amdgcn_s_waitcnt(0);
            const unsigned old = xb_add(&gb[GB_CNT(g)], 1u);
            gen = old / n;
            if (old + 1u == (gen + 1u) * n) __hip_atomic_store(&gb[GB_GEN(g)], gen + 1u, __ATOMIC_RELAXED, __HIP_MEMORY_SCOPE_AGENT);
        }
        gen = (unsigned)__builtin_amdgcn_readfirstlane((int)gen);
        const unsigned target = gen + 1u; unsigned sp = 0u;
        for (;;) {
            const unsigned v = xb_ld(&gb[GB_GEN(g)]);
            if ((int)((unsigned)__builtin_amdgcn_readfirstlane((int)v) - target) >= 0) break;
            __builtin_amdgcn_s_sleep(1);
            if (++sp > XB_SPIN_CAP) break;
        }
        __builtin_amdgcn_fence(__ATOMIC_ACQUIRE, "agent");
        asm volatile("s_waitcnt vmcnt(0)" ::: "memory");
    }
    __syncthreads();
}

__device__ __forceinline__ void p0_transpose_item(const float* W, int K, int N, bf16* WT, int row_off, const float* ksc, LAS float* scr, int item, int lane) {
    const int nblk = N / 32, kb = item / nblk, nb = item % nblk, k0 = 64 * kb, n0 = 32 * nb;
    { const int kr = lane >> 3, nq = lane & 7;
      f32x4 v[8];
#pragma unroll
      for (int i = 0; i < 8; ++i) v[i] = *(const GAS f32x4*)(W + (size_t)(k0 + 8 * i + kr) * N + n0 + 4 * nq);
#pragma unroll
      for (int i = 0; i < 8; ++i) { const int kk = 8 * i + kr; const float sc = ksc ? ksc[k0 + kk] : 1.f;
#pragma unroll
          for (int e = 0; e < 4; ++e) scr[kk * 33 + 4 * nq + e] = v[i][e] * sc; } }
    LDS_WAIT(); asm volatile("" ::: "memory");
    const int c = lane & 7;
#pragma unroll
    for (int j = 0; j < 4; ++j) { const int n = (lane >> 3) + 8 * j; const LAS float* s = scr + (8 * c) * 33 + n;
        v4u o; o.x = pk2(s[0 * 33], s[1 * 33]); o.y = pk2(s[2 * 33], s[3 * 33]); o.z = pk2(s[4 * 33], s[5 * 33]); o.w = pk2(s[6 * 33], s[7 * 33]);
        *(GAS v4u*)(WT + (size_t)(row_off + n0 + n) * K + k0 + 8 * c) = o; }
    LDS_WAIT(); asm volatile("" ::: "memory");
}
template <int NR> __device__ __forceinline__ void rms_rows_to_bf16(const float* X, const float* g, bf16* O, int m0, int ms, int mend, int lane) {
    const GAS f32x4* gr = (const GAS f32x4*)g + lane;
    f32x4 v[NR][4];
#pragma unroll
    for (int r = 0; r < NR; ++r) { const int m = (m0 + r * ms < mend) ? m0 + r * ms : mend - 1; const GAS f32x4* xr = (const GAS f32x4*)(X + (size_t)m * DM) + lane;
#pragma unroll
        for (int j = 0; j < 4; ++j) v[r][j] = xr[64 * j]; }
    f32x4 gv[4];
#pragma unroll
    for (int j = 0; j < 4; ++j) gv[j] = gr[64 * j];
#pragma unroll
    for (int r = 0; r < NR; ++r) { float s = 0.f;
#pragma unroll
        for (int j = 0; j < 4; ++j) s += (v[r][j].x * v[r][j].x + v[r][j].y * v[r][j].y) + (v[r][j].z * v[r][j].z + v[r][j].w * v[r][j].w);
        const float rr = 1.f / sqrtf(wave_sum(s) * (1.f / 1024.f) + RMS_EPS);
        if (m0 + r * ms < mend) { GAS unsigned long long* o8 = (GAS unsigned long long*)(O + (size_t)(m0 + r * ms) * DM) + lane;
#pragma unroll
            for (int j = 0; j < 4; ++j) o8[64 * j] = (unsigned long long)pk2(v[r][j].x * rr * gv[j].x, v[r][j].y * rr * gv[j].y) | ((unsigned long long)pk2(v[r][j].z * rr * gv[j].z, v[r][j].w * rr * gv[j].w) << 32); } }
}
template <int NR> __device__ __forceinline__ void rms_rows_to_i8(const float* X, const float* g, unsigned char* O, float* SA, int m0, int ms, int mend, int lane) {
    const GAS f32x4* gr = (const GAS f32x4*)g + lane;
    f32x4 v[NR][4];
#pragma unroll
    for (int r = 0; r < NR; ++r) { const int m = (m0 + r * ms < mend) ? m0 + r * ms : mend - 1; const GAS f32x4* xr = (const GAS f32x4*)(X + (size_t)m * DM) + lane;
#pragma unroll
        for (int j = 0; j < 4; ++j) v[r][j] = xr[64 * j]; }
    f32x4 gv[4];
#pragma unroll
    for (int j = 0; j < 4; ++j) gv[j] = gr[64 * j];
#pragma unroll
    for (int r = 0; r < NR; ++r) { float s = 0.f;
#pragma unroll
        for (int j = 0; j < 4; ++j) s += (v[r][j].x * v[r][j].x + v[r][j].y * v[r][j].y) + (v[r][j].z * v[r][j].z + v[r][j].w * v[r][j].w);
        const float rr = 1.f / sqrtf(wave_sum(s) * (1.f / 1024.f) + RMS_EPS);
        float am = 0.f;
#pragma unroll
        for (int j = 0; j < 4; ++j) { v[r][j] = v[r][j] * rr * gv[j]; am = fmaxf(am, fmaxf(fmaxf(fabsf(v[r][j].x), fabsf(v[r][j].y)), fmaxf(fabsf(v[r][j].z), fabsf(v[r][j].w)))); }
#pragma unroll
        for (int o = 1; o < 64; o <<= 1) am = fmaxf(am, __shfl_xor(am, o));
        const float sa = am > 0.f ? am * (1.f / 127.f) : 1.f, is = 1.f / sa;
        if (m0 + r * ms < mend) { GAS unsigned* o4 = (GAS unsigned*)(O + (size_t)(m0 + r * ms) * DM) + lane;
#pragma unroll
            for (int j = 0; j < 4; ++j) { const int a = (int)rintf(v[r][j].x * is), b = (int)rintf(v[r][j].y * is), c = (int)rintf(v[r][j].z * is), d = (int)rintf(v[r][j].w * is);
                o4[64 * j] = (unsigned)(a & 0xff) | ((unsigned)(b & 0xff) << 8) | ((unsigned)(c & 0xff) << 16) | ((unsigned)(d & 0xff) << 24); }
            if (lane == 0) SA[m0 + r * ms] = sa; } }
}
__device__ __forceinline__ void p0_quant_cols_wg(const float* W, int N, unsigned char* WT8, float* SB, LAS unsigned char* lds, int nb, int wave, int lane) {
    LAS float* scr = (LAS float*)(lds + RING_OFF + wave * 16384);
    LAS float* red = (LAS float*)(lds + RING_OFF + 8448);
    const int n0 = 32 * nb, kr = lane >> 3, nq = lane & 7;
    f32x4 v[16];
#pragma unroll
    for (int i = 0; i < 16; ++i) v[i] = *(const GAS f32x4*)(W + (size_t)(128 * wave + 8 * i + kr) * N + n0 + 4 * nq);
    f32x4 am = {0.f, 0.f, 0.f, 0.f};
#pragma unroll
    for (int i = 0; i < 16; ++i)
#pragma unroll
        for (int e = 0; e < 4; ++e) am[e] = fmaxf(am[e], fabsf(v[i][e]));
#pragma unroll
    for (int o = 8; o < 64; o <<= 1)
#pragma unroll
        for (int e = 0; e < 4; ++e) am[e] = fmaxf(am[e], __shfl_xor(am[e], o));
    if (lane < 8) *(LAS f32x4*)(red + wave * 32 + 4 * nq) = am;
    __syncthreads();
    f32x4 cm = *(const LAS f32x4*)(red + 4 * nq);
#pragma unroll
    for (int w = 1; w < 8; ++w) { const f32x4 o = *(const LAS f32x4*)(red + w * 32 + 4 * nq);
#pragma unroll
        for (int e = 0; e < 4; ++e) cm[e] = fmaxf(cm[e], o[e]); }
    f32x4 inv, sb;
#pragma unroll
    for (int e = 0; e < 4; ++e) { inv[e] = cm[e] > 0.f ? 127.f / cm[e] : 0.f; sb[e] = cm[e] > 0.f ? cm[e] * (1.f / 127.f) : 1.f; }
    if (wave == 0 && lane < 8) *(GAS f32x4*)(SB + n0 + 4 * nq) = sb;
#pragma unroll
    for (int half = 0; half < 2; ++half) {
#pragma unroll
        for (int i = 0; i < 8; ++i) { const int kk = 8 * i + kr;
#pragma unroll
            for (int e = 0; e < 4; ++e) scr[kk * 33 + 4 * nq + e] = v[8 * half + i][e] * inv[e]; }
        LDS_WAIT(); asm volatile("" ::: "memory");
        const int c = lane & 7;
#pragma unroll
        for (int j = 0; j < 4; ++j) { const int n = (lane >> 3) + 8 * j; const LAS float* s = scr + (8 * c) * 33 + n;
            unsigned q[8];
#pragma unroll
            for (int e = 0; e < 8; ++e) q[e] = (unsigned)((int)rintf(s[e * 33]) & 0xff);
            v2u o; o.x = q[0] | (q[1] << 8) | (q[2] << 16) | (q[3] << 24); o.y = q[4] | (q[5] << 8) | (q[6] << 16) | (q[7] << 24);
            *(GAS v2u*)(WT8 + (size_t)(n0 + n) * DM + 128 * wave + 64 * half + 8 * c) = o; }
        LDS_WAIT(); asm volatile("" ::: "memory");
    }
    __syncthreads();
}
__device__ __forceinline__ void cvt_row_to_bf16(const float* xrow, bf16* orow, int lane) {
    const GAS f32x4* xr = (const GAS f32x4*)xrow + lane; GAS unsigned long long* o8 = (GAS unsigned long long*)orow + lane;
    f32x4 v[4];
#pragma unroll
    for (int j = 0; j < 4; ++j) v[j] = xr[64 * j];
#pragma unroll
    for (int j = 0; j < 4; ++j) o8[64 * j] = (unsigned long long)pk2(v[j].x, v[j].y) | ((unsigned long long)pk2(v[j].z, v[j].w) << 32);
}
__device__ __forceinline__ int rel_bucket_dev(int d) {
    if (d < 16) return d;
    int b = 16;
    b += (d >= 21); b += (d >= 27); b += (d >= 35); b += (d >= 46); b += (d >= 59); b += (d >= 77); b += (d >= 99); b += (d >= 128);
    b += (d >= 166); b += (d >= 216); b += (d >= 280); b += (d >= 363); b += (d >= 470); b += (d >= 609); b += (d >= 790);
    return b;
}
__device__ __forceinline__ void p0_wcomb_item(const float* wq, const float* sk, const float* gff, bf16* WT, int it, int lane) {
    asm volatile("" : "+v"(lane));
    const int b = it >> 5, k0 = (it & 31) * 32, r32 = lane & 31, hi = lane >> 5;
    const float gk = gff[k0 + r32];
    bf16x8 wf[8];
#pragma unroll
    for (int kk = 0; kk < 8; ++kk) { const GAS f32x4* pw = (const GAS f32x4*)(wq + (size_t)(k0 + r32) * 2048 + 128 * b + 16 * kk + 8 * hi); const f32x4 x0 = pw[0], x1 = pw[1];
        const v4u o = {pk2(x0.x * gk, x0.y * gk), pk2(x0.z * gk, x0.w * gk), pk2(x1.x * gk, x1.y * gk), pk2(x1.z * gk, x1.w * gk)}; wf[kk] = __builtin_bit_cast(bf16x8, o); }
#pragma unroll 1
    for (int nt = 0; nt < 4; ++nt) {
        f32x16 acc = {};
#pragma unroll
        for (int kk = 0; kk < 8; ++kk) { const GAS f32x4* ps = (const GAS f32x4*)(sk + ((size_t)b * 128 + 32 * nt + r32) * 128 + 16 * kk + 8 * hi); const f32x4 y0 = ps[0], y1 = ps[1];
            const v4u o = {pk2(y0.x, y0.y), pk2(y0.z, y0.w), pk2(y1.x, y1.y), pk2(y1.z, y1.w)};
            acc = __builtin_amdgcn_mfma_f32_32x32x16_bf16(__builtin_bit_cast(bf16x8, o), wf[kk], acc, 0, 0, 0); }
#pragma unroll
        for (int r = 0; r < 16; ++r) { const int key = 32 * nt + (r & 3) + 8 * (r >> 2) + 4 * hi;
            WT[(size_t)(128 * b + key) * DM + k0 + r32] = (bf16)f2bf(acc[r]); }
    }
}
struct P0Args { const float *x, *mem, *g_mix, *w_in, *rel_bias, *g_mem, *w_mem_kv, *w_br_attn, *w_br_conv, *w_br_x, *w_out, *g_ffn, *w_query, *sub_keys;
                bf16 *WinT, *WkvT, *WbrT, *WoutT, *WqT, *SK, *HN, *MEMN; float* TAB; float *SA, *SB; };
__device__ __forceinline__ void p0_transposes(const P0Args& a, LAS unsigned char* lds, int part, int gw, int NGW, int wave, int lane) {
    LAS float* scr = (LAS float*)(lds + RING_OFF + wave * 16384);
    constexpr int I_IN = (DM / 64) * (PW / 32), I_KV = (DM / 64) * (1024 / 32), I_BR = (512 / 64) * (1024 / 32), I_OUT = (DM / 64) * (1024 / 32), I_Q = (DM / 64) * (2048 / 32);
    if (part == 0) {
        for (int nb = gw / NWAVES; nb < PW / 32; nb += NGW / NWAVES) p0_quant_cols_wg(a.w_in, PW, (unsigned char*)a.WinT, a.SB, lds, nb, wave, lane);
        for (int it = gw; it < I_KV; it += NGW) p0_transpose_item(a.w_mem_kv, DM, 1024, a.WkvT, 0, nullptr, scr, it, lane);
    } else {
        for (int it = gw; it < 3 * I_BR + I_OUT; it += NGW) {
            int r = it;
            if (r < I_BR) { p0_transpose_item(a.w_br_attn, 512, 1024, a.WbrT, 0, nullptr, scr, r, lane); continue; } r -= I_BR;
            if (r < I_BR) { p0_transpose_item(a.w_br_conv, 512, 1024, a.WbrT, 1024, nullptr, scr, r, lane); continue; } r -= I_BR;
            if (r < I_BR) { p0_transpose_item(a.w_br_x, 512, 1024, a.WbrT, 2048, nullptr, scr, r, lane); continue; } r -= I_BR;
            p0_transpose_item(a.w_out, DM, 1024, a.WoutT, 0, nullptr, scr, r, lane);
        }

    }
}
__device__ __forceinline__ void p0_prologue(const P0Args& a, LAS unsigned char* lds, bool late_part1, int gw, int NGW, int wave, int lane) {
    for (int m = gw; m < T; m += 8 * NGW) rms_rows_to_i8<8>(a.x, a.g_mix, (unsigned char*)a.HN, a.SA, m, NGW, T, lane);
    p0_transposes(a, lds, 0, gw, NGW, wave, lane);
    if (!late_part1) p0_transposes(a, lds, 1, gw, NGW, wave, lane);
    if ((gw & 3) == 0) for (int it = gw >> 2; it < 512; it += (NGW + 3) >> 2) p0_wcomb_item(a.w_query, a.sub_keys, a.g_ffn, a.WqT, it, lane);
    for (int m = gw; m < NBATCH * MEMLEN; m += NGW) rms_rows_to_bf16<1>(a.mem, a.g_mem, a.MEMN, m, NGW, NBATCH * MEMLEN, lane);
    for (int m = gw; m < 256; m += NGW) {
        const int idx = m * 64 + lane, h = idx >> 11, d = idx & 2047;
        a.TAB[idx] = a.rel_bias[rel_bucket_dev(d) * 8 + h] * LOG2E;
    }
}

template <int DH> __device__ __forceinline__ void fix_item(bf16* buf, size_t pitch, int row0, int col0, const float* gain, float gscale, float* kmean, LAS float* red, int wave, int lane) {
    constexpr int LPR = DH / 8, RPI = 64 / LPR, NIT = 32 / RPI;
    const int sub = lane / LPR, ch = lane % LPR;
    float g[8], cs[8];
#pragma unroll
    for (int j = 0; j < 8; ++j) { g[j] = gain[ch * 8 + j] * gscale; cs[j] = 0.f; }
    v4u w[NIT];
#pragma unroll
    for (int it = 0; it < NIT; ++it) w[it] = *(const GAS v4u*)(buf + (size_t)(row0 + wave * 32 + it * RPI + sub) * pitch + col0 + ch * 8);
#pragma unroll
    for (int it = 0; it < NIT; ++it) {
        float x[8] = {bflo(w[it].x), bfhi(w[it].x), bflo(w[it].y), bfhi(w[it].y), bflo(w[it].z), bfhi(w[it].z), bflo(w[it].w), bfhi(w[it].w)};
        float ss = 0.f;
#pragma unroll
        for (int j = 0; j < 8; ++j) ss += x[j] * x[j];
#pragma unroll
        for (int o = 1; o < LPR; o <<= 1) ss += __shfl_xor(ss, o);
        const float r = 1.f / sqrtf(ss * (1.f / DH) + RMS_EPS);
#pragma unroll
        for (int j = 0; j < 8; ++j) { x[j] = x[j] * r * g[j]; cs[j] += x[j]; }
        v4u o; o.x = pk2(x[0], x[1]); o.y = pk2(x[2], x[3]); o.z = pk2(x[4], x[5]); o.w = pk2(x[6], x[7]);
        *(GAS v4u*)(buf + (size_t)(row0 + wave * 32 + it * RPI + sub) * pitch + col0 + ch * 8) = o;
    }
    if (kmean) {
#pragma unroll
        for (int j = 0; j < 8; ++j) {
#pragma unroll
            for (int o = LPR; o < 64; o <<= 1) cs[j] += __shfl_xor(cs[j], o);
        }
        if (sub == 0) {
#pragma unroll
            for (int j = 0; j < 8; ++j) red[wave * DH + ch * 8 + j] = cs[j];
        }
        asm volatile("s_waitcnt lgkmcnt(0)\n\ts_barrier" ::: "memory");
        if (wave == 0 && lane < DH) { float s = 0.f;
#pragma unroll
            for (int w8 = 0; w8 < 8; ++w8) s += red[w8 * DH + lane];
            kmean[lane] = s * (1.f / 256.f); }
        asm volatile("s_waitcnt lgkmcnt(0)\n\ts_barrier" ::: "memory");
    }
}
__device__ __forceinline__ void p2_fixup(bf16* PA, bf16* KVM, float* KMEAN, const float* q_gain_a, const float* k_gain_a, const float* q_gain_x, const float* k_gain_x, LAS unsigned char* lds, int vcu, int G, int wave, int lane) {
    constexpr int N_A = 512, N_X = 256, N_KX = 32, NIT = 2 * N_A + N_X + N_KX;
    LAS float* red = (LAS float*)lds;
    for (int it = vcu; it < NIT; it += G) {
        int r = it;
        if (r < N_A) { const int b = r >> 6, h = (r >> 3) & 7, n = r & 7;
            fix_item<64>(PA, PAW, b * SEQ + n * 256, COL_KA + h * 64, k_gain_a, 1.0f, KMEAN + (size_t)((b * 8 + h) * 8 + n) * 64, red, wave, lane); continue; } r -= N_A;
        if (r < N_A) { const int b = r >> 6, h = (r >> 3) & 7, n = r & 7;
            fix_item<64>(PA, PAW, b * SEQ + n * 256, COL_QA + h * 64, q_gain_a, C2A, nullptr, red, wave, lane); continue; } r -= N_A;
        if (r < N_X) { const int b = r >> 5, h = (r >> 3) & 3, n = r & 7;
            fix_item<128>(PA, PAW, b * SEQ + n * 256, COL_QX + h * 128, q_gain_x, C2X, nullptr, red, wave, lane); continue; } r -= N_X;
        { const int b = r >> 2, h = r & 3;
            fix_item<128>(KVM, 1024, b * MEMLEN, h * 128, k_gain_x, 1.0f, nullptr, red, wave, lane); }
    }
}

namespace att {
constexpr int L_K = 0, L_V = 16384, L_BUF = 32768  , L_OST = 0  ,
              L_TAB = 65536, TAB_PAD = 256, L_KM = L_TAB + (TAB_PAD + 2048) * 4, L_SEL = L_KM + 2048, L_WSF = L_SEL + 1024, L_END = L_WSF + NWAVES * 256;
static_assert(L_END <= RING_BYTES, "attention LDS map");
__device__ __forceinline__ int crow(int r, int hi) { return (r & 3) + 8 * (r >> 2) + 4 * hi; }
__device__ __forceinline__ void glds16(const void* gsrc, unsigned lds_dst) { unsigned keep;
    asm volatile("s_mov_b32 %0, m0\n\ts_mov_b32 m0, %2\n\ts_nop 0\n\tglobal_load_lds_dwordx4 %1, off\n\ts_mov_b32 m0, %0" : "=&s"(keep) : "v"(gsrc), "s"(lds_dst) : "memory"); }
__device__ __forceinline__ unsigned cvtpk(float lo, float hi) { typedef float f2 __attribute__((ext_vector_type(2))); typedef __bf16 b2 __attribute__((ext_vector_type(2))); f2 v = {lo, hi}; b2 b = __builtin_convertvector(v, b2); return __builtin_bit_cast(unsigned, b); }
__device__ __forceinline__ float rowmax(const f32x16& p0, const f32x16& p1) {
    float a = fmaxf(p0[0], p1[0]);
#pragma unroll
    for (int r = 1; r < 16; ++r) a = fmaxf(a, fmaxf(p0[r], p1[r]));
    auto rr = __builtin_amdgcn_permlane32_swap(__float_as_uint(a), __float_as_uint(a), false, false);
    return fmaxf(__uint_as_float(rr[0]), __uint_as_float(rr[1]));
}
template <int ND0> __device__ __forceinline__ void qkt(f32x16& p0, f32x16& p1, const LAS unsigned char* Kslot, const bf16x8* qr, int r32, int hi) {
    const LAS unsigned char* kb = Kslot + hi * 1024 + r32 * 16;
#pragma unroll
    for (int d0 = 0; d0 < ND0; ++d0) {
        const bf16x8 b0 = *(const LAS bf16x8*)(kb + d0 * 2048);
        const bf16x8 b1 = *(const LAS bf16x8*)(kb + d0 * 2048 + 512);
        p0 = __builtin_amdgcn_mfma_f32_32x32x16_bf16(b0, qr[d0], p0, 0, 0, 0);
        p1 = __builtin_amdgcn_mfma_f32_32x32x16_bf16(b1, qr[d0], p1, 0, 0, 0);
    }
}
template <int NDB> __device__ __forceinline__ void pv(f32x16* o, int vb, bf16x8 pa0, bf16x8 pa1, bf16x8 pa2, bf16x8 pa3) {
#pragma unroll
    for (int d0 = 0; d0 < NDB; ++d0) { s16x4 lo[4], hi[4];
#pragma unroll
        for (int ks = 0; ks < 4; ++ks) {
            asm volatile("ds_read_b64_tr_b16 %0,%1 offset:%c2" : "=&v"(lo[ks]) : "v"(vb), "i"(d0 * 4096 + ks * 1024) : "memory");
            asm volatile("ds_read_b64_tr_b16 %0,%1 offset:%c2" : "=&v"(hi[ks]) : "v"(vb), "i"(d0 * 4096 + ks * 1024 + 512) : "memory"); }
        asm volatile("s_waitcnt lgkmcnt(0)" ::: "memory"); __builtin_amdgcn_sched_barrier(0);
#define ATT_PK(k) (bf16x8){lo[k][0], lo[k][1], lo[k][2], lo[k][3], hi[k][0], hi[k][1], hi[k][2], hi[k][3]}
        o[d0] = __builtin_amdgcn_mfma_f32_32x32x16_bf16(pa0, ATT_PK(0), o[d0], 0, 0, 0);
        o[d0] = __builtin_amdgcn_mfma_f32_32x32x16_bf16(pa1, ATT_PK(1), o[d0], 0, 0, 0);
        o[d0] = __builtin_amdgcn_mfma_f32_32x32x16_bf16(pa2, ATT_PK(2), o[d0], 0, 0, 0);
        o[d0] = __builtin_amdgcn_mfma_f32_32x32x16_bf16(pa3, ATT_PK(3), o[d0], 0, 0, 0);
#undef ATT_PK
    }
}
#define ATT_BAR() asm volatile("s_waitcnt lgkmcnt(0)\n\ts_barrier" ::: "memory")
#define ATT_WAIT_BAR() asm volatile("s_waitcnt vmcnt(0) lgkmcnt(0)\n\ts_barrier" ::: "memory")

template <int DH, bool MOBA> __device__ __forceinline__ void attn_unit(const bf16* Qp, size_t qpitch, const bf16* Kp, const bf16* Vp, size_t kpitch, bf16* Op, int qb, const float* kmean_bh, const float* tab_h, const float* gq, const float* gk,
                                                                   LAS unsigned char* lds, int tid, int wid, int lane) {
    constexpr int ND0 = DH / 16, NDB = DH / 32, NPIECE = DH / 64;
    asm volatile("" : "+v"(tid), "+v"(lane));
    const int r32 = lane & 31, hi = lane >> 5;
    const unsigned lds0 = (unsigned)(uintptr_t)lds;
    LAS float* wsf = (LAS float*)(lds + L_WSF) + wid * 64;
    ATT_BAR();
    int my_sel = 0;
    if (MOBA) {
        LAS float* tl = (LAS float*)(lds + L_TAB);
        for (int i = tid; i < TAB_PAD + 2048; i += NWAVES * 64) tl[i] = (i < TAB_PAD) ? -INFINITY : tab_h[i - TAB_PAD];
        LAS float* km = (LAS float*)(lds + L_KM);
        for (int i = tid; i < 512; i += NWAVES * 64) km[i] = kmean_bh[i];
        ATT_BAR();
        if (tid < 256) {
            int sel = 0;
            if (qb <= 3) sel = (1 << qb) - 1;
            else {
                const GAS v4u* qrow = (const GAS v4u*)(Qp + (size_t)tid * qpitch);
                v4u qw[8];
#pragma unroll
                for (int c = 0; c < 8; ++c) qw[c] = qrow[c];
                float b1 = -INFINITY, b2 = -INFINITY, b3 = -INFINITY; int i1 = 0, i2 = 0, i3 = 0;
#pragma unroll 1
                for (int n = 0; n < qb; ++n) { float s = 0.f; const LAS f32x4* kr = (const LAS f32x4*)(km + n * 64);
#pragma unroll
                    for (int c = 0; c < 8; ++c) { const f32x4 ka = kr[2 * c], kb2 = kr[2 * c + 1]; const v4u w = qw[c];
                        s += bflo(w.x) * ka.x; s += bfhi(w.x) * ka.y; s += bflo(w.y) * ka.z; s += bfhi(w.y) * ka.w;
                        s += bflo(w.z) * kb2.x; s += bfhi(w.z) * kb2.y; s += bflo(w.w) * kb2.z; s += bfhi(w.w) * kb2.w; }
                    if (s > b1) { b3 = b2; i3 = i2; b2 = b1; i2 = i1; b1 = s; i1 = n; }
                    else if (s > b2) { b3 = b2; i3 = i2; b2 = s; i2 = n; }
                    else if (s > b3) { b3 = s; i3 = n; } }
                sel = (1 << i1) | (1 << i2) | (1 << i3);
            }
            ((LAS int*)(lds + L_SEL))[tid] = sel;
        }
        ATT_BAR();
        my_sel = ((LAS int*)(lds + L_SEL))[wid * 32 + r32];
    }
    bf16x8 qr[ND0];
    { const bf16* Qw = Qp + (size_t)(wid * 32 + r32) * qpitch + hi * 8;
#pragma unroll
      for (int d0 = 0; d0 < ND0; ++d0) qr[d0] = *(const GAS bf16x8*)(Qw + d0 * 16); }
    if (!MOBA) {
        LAS float* rk = (LAS float*)(lds + L_KM);
        { const int key = tid >> 1, half = tid & 1; const GAS v4u* kr = (const GAS v4u*)(Kp + (size_t)key * kpitch + half * 64); float ss = 0.f;
#pragma unroll
          for (int c = 0; c < 8; ++c) { const v4u w = kr[c]; const float a0 = bflo(w.x), a1 = bfhi(w.x), a2 = bflo(w.y), a3 = bfhi(w.y), a4 = bflo(w.z), a5 = bfhi(w.z), a6 = bflo(w.w), a7 = bfhi(w.w);
              ss += (a0 * a0 + a1 * a1) + (a2 * a2 + a3 * a3) + (a4 * a4 + a5 * a5) + (a6 * a6 + a7 * a7); }
          ss += __shfl_xor(ss, 1);
          if (half == 0) rk[key] = 1.0f / sqrtf(ss * (1.f / 128.f) + RMS_EPS); }
        float qs = 0.f;
#pragma unroll
        for (int d0 = 0; d0 < ND0; ++d0) { const v4u w = __builtin_bit_cast(v4u, qr[d0]); const float a0 = bflo(w.x), a1 = bfhi(w.x), a2 = bflo(w.y), a3 = bfhi(w.y), a4 = bflo(w.z), a5 = bfhi(w.z), a6 = bflo(w.w), a7 = bfhi(w.w);
            qs += (a0 * a0 + a1 * a1) + (a2 * a2 + a3 * a3) + (a4 * a4 + a5 * a5) + (a6 * a6 + a7 * a7); }
        { auto rr = __builtin_amdgcn_permlane32_swap(__float_as_uint(qs), __float_as_uint(qs), false, false); qs = __uint_as_float(rr[0]) + __uint_as_float(rr[1]); }
        const float rq = C2X / sqrtf(qs * (1.f / 128.f) + RMS_EPS);
        int hi8 = hi * 8; asm volatile("" : "+v"(hi8));
#pragma unroll
        for (int d0 = 0; d0 < ND0; ++d0) { const v4u w = __builtin_bit_cast(v4u, qr[d0]);
            const f32x4 ga = *(const GAS f32x4*)(gq + d0 * 16 + hi8), gb = *(const GAS f32x4*)(gq + d0 * 16 + hi8 + 4), ka = *(const GAS f32x4*)(gk + d0 * 16 + hi8), kb2 = *(const GAS f32x4*)(gk + d0 * 16 + hi8 + 4);
            v4u o; o.x = cvtpk(bflo(w.x) * rq * ga.x * ka.x, bfhi(w.x) * rq * ga.y * ka.y); o.y = cvtpk(bflo(w.y) * rq * ga.z * ka.z, bfhi(w.y) * rq * ga.w * ka.w);
            o.z = cvtpk(bflo(w.z) * rq * gb.x * kb2.x, bfhi(w.z) * rq * gb.y * kb2.y); o.w = cvtpk(bflo(w.w) * rq * gb.z * kb2.z, bfhi(w.w) * rq * gb.w * kb2.w);
            qr[d0] = __builtin_bit_cast(bf16x8, o); }
    }
    float m_ref = 0.f, l_run = 0.f;
    constexpr float THR = 8.0f;
    bool fast;
    { float bnd;
      if (MOBA) { float a = fabsf(gq[lane]), b = fabsf(gk[lane]);
          int dd = lane & 31; { const int t16[16] = {16, 21, 27, 35, 46, 59, 77, 99, 128, 166, 216, 280, 363, 470, 609, 790};
#pragma unroll
              for (int i = 0; i < 16; ++i) dd = ((lane & 31) == 16 + i) ? t16[i] : dd; }
          float c = tab_h[dd];
#pragma unroll
          for (int o = 1; o < 64; o <<= 1) { a = fmaxf(a, __shfl_xor(a, o)); b = fmaxf(b, __shfl_xor(b, o)); c = fmaxf(c, __shfl_xor(c, o)); }
          bnd = 64.f * a * b * C2A + c;
      } else { float a = fmaxf(fabsf(gq[lane] * gk[lane]), fabsf(gq[lane + 64] * gk[lane + 64]));
#pragma unroll
          for (int o = 1; o < 64; o <<= 1) a = fmaxf(a, __shfl_xor(a, o));
          bnd = 128.f * a * C2X; }
      fast = __builtin_amdgcn_readfirstlane(bnd <= 60.f ? 1 : 0) != 0; }
    float bfar = 0.f; if (MOBA) bfar = ((const LAS float*)(lds + L_TAB))[TAB_PAD + 2047];
    f32x16 o[NDB];
#pragma unroll
    for (int d = 0; d < NDB; ++d) o[d] = f32x16{};
    const int vb0 = (int)(lds0 + L_V) + ((lane >> 4) & 1) * 32 + (lane & 3) * 8 + (4 * hi + ((lane & 15) >> 2)) * 64;
    const int qrel = wid * 32 + r32;
    const int ntiles = MOBA ? 4 + 4 * qb : 4;
    constexpr int SUB = (DH == 64) ? 2 : 1;
    const int nsteps = ntiles / SUB;
    auto issue_step = [&](int st) {
#pragma unroll
        for (int sub = 0; sub < SUB; ++sub) { const int tt = st * SUB + sub;
            int kb_, j_; if (MOBA) { if (tt < 4) { kb_ = qb; j_ = tt; } else { kb_ = (tt - 4) >> 2; j_ = (tt - 4) & 3; } } else { kb_ = 0; j_ = tt; }
            const int key0_ = kb_ * 256 + j_ * 64; const unsigned bo_ = (unsigned)(st & 1) * L_BUF + (unsigned)sub * 8192u;
#pragma unroll
            for (int pc = 0; pc < NPIECE; ++pc) { const int p = wid + 8 * pc;
                glds16(Kp + (size_t)(key0_ + lane) * kpitch + p * 8, (unsigned)__builtin_amdgcn_readfirstlane(lds0 + bo_ + L_K + p * 1024));
                glds16(Vp + (size_t)(key0_ + 16 * (p & 3) + (lane >> 2)) * kpitch + (p >> 2) * 32 + (lane & 3) * 8, (unsigned)__builtin_amdgcn_readfirstlane(lds0 + bo_ + L_V + p * 1024)); } }
    };
    issue_step(0);
    for (int st = 0; st < nsteps; ++st) {
        ATT_WAIT_BAR();
        if (st + 1 < nsteps) issue_step(st + 1);
#pragma unroll 1
      for (int sub = 0; sub < SUB; ++sub) { const int tt = st * SUB + sub;
        int kb, j; bool own;
        if (MOBA) { if (tt < 4) { kb = qb; j = tt; own = true; } else { kb = (tt - 4) >> 2; j = (tt - 4) & 3; own = false; } }
        else { kb = 0; j = tt; own = false; }
        if (MOBA && own && 64 * j > wid * 32 + 31) continue;
        const unsigned bo = (unsigned)(st & 1) * L_BUF + (unsigned)sub * 8192u;
        f32x16 p0, p1;
        if (MOBA) {
            const float base = ((own || (((my_sel >> kb) & 1) != 0)) ? 0.f : -INFINITY) - m_ref;
            if (!own && qb - kb >= 5) {
                const float cb = base + bfar;
#pragma unroll
                for (int r = 0; r < 16; ++r) { p0[r] = cb; p1[r] = cb; }
            } else {
                const int dbase = (qb - kb) * 256 + qrel - 64 * j - 4 * hi;
                const LAS float* tp = (const LAS float*)(lds + L_TAB) + TAB_PAD + dbase - 63;
#pragma unroll
                for (int r = 0; r < 16; ++r) { const int c = (r & 3) + 8 * (r >> 2); p0[r] = tp[63 - c] + base; p1[r] = tp[31 - c] + base; }
            }
            qkt<ND0>(p0, p1, lds + bo + L_K, qr, r32, hi);
        } else {
            p0 = f32x16{}; p1 = f32x16{};
            qkt<ND0>(p0, p1, lds + bo + L_K, qr, r32, hi);
            const LAS float* rkp = (const LAS float*)(lds + L_KM) + j * 64 + 4 * hi;
#pragma unroll
            for (int r = 0; r < 16; ++r) { const int c = (r & 3) + 8 * (r >> 2); p0[r] = p0[r] * rkp[c] - m_ref; p1[r] = p1[r] * rkp[c + 32] - m_ref; }
        }
        if (!fast) {
        const float rm = rowmax(p0, p1);
        if (__any(rm > THR)) {
            const float dl = fmaxf(rm, 0.f); m_ref += dl;
#pragma unroll
            for (int r = 0; r < 16; ++r) { p0[r] -= dl; p1[r] -= dl; }
            const float f = __builtin_amdgcn_exp2f(-dl); l_run *= f;
            if (hi == 0) wsf[r32] = f;
            LDS_WAIT();
#pragma unroll
            for (int r = 0; r < 16; ++r) { const float ff = wsf[crow(r, hi)];
#pragma unroll
                for (int d = 0; d < NDB; ++d) o[d][r] *= ff; }
        } }
        float ps = 0.f;
#pragma unroll
        for (int r = 0; r < 16; ++r) { p0[r] = __builtin_amdgcn_exp2f(p0[r]); p1[r] = __builtin_amdgcn_exp2f(p1[r]); ps += p0[r] + p1[r]; }
        l_run += ps;
        v4u pw0, pw1, pw2, pw3;
        pw0 = (v4u){cvtpk(p0[0], p0[1]), cvtpk(p0[2], p0[3]), cvtpk(p0[4], p0[5]), cvtpk(p0[6], p0[7])};
        pw1 = (v4u){cvtpk(p0[8], p0[9]), cvtpk(p0[10], p0[11]), cvtpk(p0[12], p0[13]), cvtpk(p0[14], p0[15])};
        pw2 = (v4u){cvtpk(p1[0], p1[1]), cvtpk(p1[2], p1[3]), cvtpk(p1[4], p1[5]), cvtpk(p1[6], p1[7])};
        pw3 = (v4u){cvtpk(p1[8], p1[9]), cvtpk(p1[10], p1[11]), cvtpk(p1[12], p1[13]), cvtpk(p1[14], p1[15])};
        pv<NDB>(o, vb0 + (int)bo, __builtin_bit_cast(bf16x8, pw0), __builtin_bit_cast(bf16x8, pw1), __builtin_bit_cast(bf16x8, pw2), __builtin_bit_cast(bf16x8, pw3));
      }
    }
    { auto rr = __builtin_amdgcn_permlane32_swap(__float_as_uint(l_run), __float_as_uint(l_run), false, false); l_run = __uint_as_float(rr[0]) + __uint_as_float(rr[1]); }
    if (hi == 0) wsf[32 + r32] = l_run;
    ATT_BAR();
    LAS bf16* stg = (LAS bf16*)(lds + L_OST + wid * 8192);
#pragma unroll
    for (int r = 0; r < 16; ++r) { const int orow = crow(r, hi); const float rl = __builtin_amdgcn_rcpf(wsf[32 + orow]);
#pragma unroll
        for (int d = 0; d < NDB; ++d) stg[orow * DH + d * 32 + r32] = (bf16)f2bf(o[d][r] * rl); }
    LDS_WAIT();
    constexpr int CPR = DH / 8;
    int lane2 = lane; asm volatile("" : "+v"(lane2));
#pragma unroll
    for (int i = 0; i < (32 * CPR) / 64; ++i) { const int idx = i * 64 + lane2, row = idx / CPR, ch = idx % CPR;
        const v4u v = *(const LAS v4u*)(stg + row * DH + ch * 8);
        *(GAS v4u*)(Op + (size_t)(wid * 32 + row) * 512 + ch * 8) = v; }
}
#undef ATT_BAR
#undef ATT_WAIT_BAR
}

__device__ __forceinline__ void conv_item(const bf16* PA, const float* conv_w, bf16* CO, int item, int tid) {
    asm volatile("" : "+v"(tid));
    const int ch = (tid & 63) * 8, r0 = item * 64 + (tid >> 6) * 8;
    float w0[8], w1[8], w2[8];
#pragma unroll
    for (int j = 0; j < 8; ++j) { w0[j] = conv_w[ch + j]; w1[j] = conv_w[512 + ch + j]; w2[j] = conv_w[1024 + ch + j]; }
    float pm2[8], pm1[8];
#pragma unroll
    for (int j = 0; j < 8; ++j) { pm2[j] = 0.f; pm1[j] = 0.f; }
    auto load8 = [&](int row, int col, float* o) { const v4u w = *(const GAS v4u*)(PA + (size_t)row * PAW + col + ch);
        o[0] = bflo(w.x); o[1] = bfhi(w.x); o[2] = bflo(w.y); o[3] = bfhi(w.y); o[4] = bflo(w.z); o[5] = bfhi(w.z); o[6] = bflo(w.w); o[7] = bfhi(w.w); };
    const int s0 = r0 & (SEQ - 1);
    if (s0 >= 2) { float a[8], b[8]; load8(r0 - 2, COL_CC, a); load8(r0 - 2, COL_UC, b);
#pragma unroll
        for (int j = 0; j < 8; ++j) pm2[j] = a[j] * b[j]; }
    if (s0 >= 1) { float a[8], b[8]; load8(r0 - 1, COL_CC, a); load8(r0 - 1, COL_UC, b);
#pragma unroll
        for (int j = 0; j < 8; ++j) pm1[j] = a[j] * b[j]; }
#pragma unroll
    for (int i = 0; i < 8; ++i) { const int row = r0 + i; float c[8], u[8], bb[8], y[8];
        load8(row, COL_CC, c); load8(row, COL_UC, u); load8(row, COL_BC, bb);
#pragma unroll
        for (int j = 0; j < 8; ++j) { const float cur = c[j] * u[j]; y[j] = bb[j] * (w0[j] * pm2[j] + w1[j] * pm1[j] + w2[j] * cur); pm2[j] = pm1[j]; pm1[j] = cur; }
        v4u o; o.x = pk2(y[0], y[1]); o.y = pk2(y[2], y[3]); o.z = pk2(y[4], y[5]); o.w = pk2(y[6], y[7]);
        *(GAS v4u*)(CO + (size_t)row * 512 + ch) = o; }
}

namespace pk {
template <int N> __device__ __forceinline__ void bsort_desc(unsigned (&a)[N]) {
#pragma unroll
    for (int k = 2; k <= N; k <<= 1) {
#pragma unroll
        for (int j = k >> 1; j > 0; j >>= 1) {
#pragma unroll
            for (int i = 0; i < N; ++i) { const int l = i ^ j;
                if (l > i) { const unsigned x = a[i], y = a[l]; const unsigned mx = x > y ? x : y, mn = x > y ? y : x;
                    if ((i & k) == 0) { a[i] = mx; a[l] = mn; } else { a[i] = mn; a[l] = mx; } } } } }
}
__device__ __forceinline__ void sort16_desc(unsigned (&a)[16]) {
#define SN_CE(i, j) { const unsigned x_ = a[i], y_ = a[j]; a[i] = x_ > y_ ? x_ : y_; a[j] = x_ > y_ ? y_ : x_; }
    SN_CE(0, 13) SN_CE(1, 12) SN_CE(2, 15) SN_CE(3, 14) SN_CE(4, 8) SN_CE(5, 6) SN_CE(7, 11) SN_CE(9, 10)
    SN_CE(0, 5) SN_CE(1, 7) SN_CE(2, 9) SN_CE(3, 4) SN_CE(6, 13) SN_CE(8, 14) SN_CE(10, 15) SN_CE(11, 12)
    SN_CE(0, 1) SN_CE(2, 3) SN_CE(4, 5) SN_CE(6, 8) SN_CE(7, 9) SN_CE(10, 11) SN_CE(12, 13) SN_CE(14, 15)
    SN_CE(0, 2) SN_CE(1, 3) SN_CE(4, 10) SN_CE(5, 11) SN_CE(6, 7) SN_CE(8, 9) SN_CE(12, 14) SN_CE(13, 15)
    SN_CE(1, 2) SN_CE(3, 12) SN_CE(4, 6) SN_CE(5, 7) SN_CE(8, 10) SN_CE(9, 11) SN_CE(13, 14)
    SN_CE(1, 4) SN_CE(2, 6) SN_CE(5, 8) SN_CE(7, 10) SN_CE(9, 13) SN_CE(11, 14)
    SN_CE(2, 4) SN_CE(3, 6) SN_CE(9, 12) SN_CE(11, 13)
    SN_CE(3, 5) SN_CE(6, 8) SN_CE(7, 9) SN_CE(10, 12)
    SN_CE(3, 4) SN_CE(5, 6) SN_CE(7, 8) SN_CE(9, 10) SN_CE(11, 12)
    SN_CE(6, 7) SN_CE(8, 9)
#undef SN_CE
}
template <int N> __device__ __forceinline__ void bmerge_desc(unsigned (&a)[N]) {
#pragma unroll
    for (int j = N >> 1; j > 0; j >>= 1) {
#pragma unroll
        for (int i = 0; i < N; ++i) { const int l = i ^ j; if (l > i) { const unsigned x = a[i], y = a[l]; a[i] = x > y ? x : y; a[l] = x > y ? y : x; } } }
}
__device__ __forceinline__ void top16_merge(unsigned (&x)[16], const unsigned (&y)[16]) {
#pragma unroll
    for (int i = 0; i < 16; ++i) x[i] = x[i] > y[15 - i] ? x[i] : y[15 - i];
    bmerge_desc<16>(x);
}
__device__ __forceinline__ unsigned f2ord(float f) { const unsigned u = __float_as_uint(f); return u ^ ((unsigned)((int)u >> 31) | 0x80000000u); }
__device__ __forceinline__ float ord2f(unsigned o) { return __uint_as_float(o ^ ((o & 0x80000000u) ? 0x80000000u : 0xFFFFFFFFu)); }

constexpr int L_TBL = 0;
__device__ __forceinline__ void topk_fill(const bf16* SK, LAS unsigned char* lds, int hp, int tid) {
    for (int tb = 0; tb < 4; ++tb) { const bf16* src = SK + (size_t)(((2 * hp + (tb >> 1)) * 2 + (tb & 1)) * 128) * 128;
        for (int idx = tid; idx < 2048; idx += NWAVES * 64) { const int key = idx >> 4, c16 = idx & 15;
            const v4u w = *(const GAS v4u*)(src + key * 128 + c16 * 8);
            *(LAS v4u*)(lds + L_TBL + tb * 32768 + (c16 * 4 + (key >> 5)) * 512 + (key & 31) * 16) = w; } }
    asm volatile("s_waitcnt vmcnt(0) lgkmcnt(0)\n\ts_barrier" ::: "memory");
}
__device__ __forceinline__ void topk_task(const bf16* QRY, const float* SLOTS, unsigned* SEL, LAS unsigned char* lds, int hp, int t0, int lane) {
    asm volatile("" : "+v"(lane));
    const int r32 = lane & 31, hi = lane >> 5;
    const int tok = t0 + r32;
    float rn; { const GAS f32x4* sl = (const GAS f32x4*)(SLOTS + (size_t)tok * 16); const f32x4 a = sl[0], b = sl[1], c = sl[2], d = sl[3];
        const float ss = ((a.x + a.y) + (a.z + a.w)) + ((b.x + b.y) + (b.z + b.w)) + ((c.x + c.y) + (c.z + c.w)) + ((d.x + d.y) + (d.z + d.w));
        rn = 1.f / sqrtf(ss * (1.f / 1024.f) + RMS_EPS); }
    unsigned L[4][16];
    v4u sf[8];
    const GAS unsigned char* qb = (const GAS unsigned char*)QRY + (size_t)(tok >> 8) * (8 * 131072) + ((tok >> 4) & 15) * 8192 + (tok & 15) * 16 + hi * 2048;
    { const GAS v4u* sp = (const GAS v4u*)(qb + (size_t)((4 * hp) >> 1) * 131072 + ((4 * hp) & 1) * 4096);
#pragma unroll
      for (int i = 0; i < 8; ++i) sf[i] = sp[16 * i]; }
#pragma unroll
    for (int tb = 0; tb < 4; ++tb) {
        unsigned g[4][16];
#pragma unroll
        for (int blk = 0; blk < 4; ++blk)
#pragma unroll
            for (int r = 0; r < 16; ++r) { const int e = 16 * blk + r; const unsigned w = sf[e >> 3][(e >> 1) & 3]; const float sc_ = (e & 1) ? bfhi(w) : bflo(w);
                g[blk][r] = (f2ord(sc_) & ~127u) | (unsigned)(127 - e); }
        if (tb < 3) { const int tn = tb + 1; const GAS v4u* sp = (const GAS v4u*)(qb + (size_t)((4 * hp + tn) >> 1) * 131072 + ((4 * hp + tn) & 1) * 4096);
#pragma unroll
            for (int i = 0; i < 8; ++i) sf[i] = sp[16 * i];
            asm volatile("" ::: "memory"); }
#pragma unroll
        for (int blk = 0; blk < 4; ++blk) sort16_desc(g[blk]);
        top16_merge(g[0], g[1]); top16_merge(g[2], g[3]); top16_merge(g[0], g[2]);
#pragma unroll
        for (int i = 0; i < 16; ++i) L[tb][i] = g[0][i] ^ (unsigned)(64 * hi);
    }
    unsigned A[2][16];
#pragma unroll
    for (int p = 0; p < 2; ++p) {
        unsigned X[16], Y[16];
#pragma unroll
        for (int i = 0; i < 16; ++i) { auto rr = __builtin_amdgcn_permlane32_swap(L[p][i], L[2 + p][i], false, false); X[i] = rr[0]; Y[i] = rr[1]; }
        top16_merge(X, Y);
#pragma unroll
        for (int i = 0; i < 16; ++i) A[p][i] = X[i];
    }
    float f0[16], f1[16];
#pragma unroll
    for (int i = 0; i < 16; ++i) { f0[i] = ord2f(A[0][i] & ~127u); f1[i] = ord2f(A[1][i] & ~127u); }
    float sums[50]; unsigned keys[50];
    { int c = 0;
#pragma unroll
      for (int i = 0; i < 16; ++i)
#pragma unroll
          for (int j = 0; j < 16; ++j) if ((i + 1) * (j + 1) <= 16) { sums[c] = f0[i] + f1[j]; keys[c] = (f2ord(sums[c]) & ~63u) | (unsigned)(63 - c); ++c; } }
    unsigned G0[16], R[32];
#pragma unroll
    for (int i = 0; i < 16; ++i) G0[i] = keys[i];
#pragma unroll
    for (int i = 0; i < 32; ++i) R[i] = (i < 26) ? keys[24 + i] : 0u;
    bsort_desc<32>(R);
#pragma unroll
    for (int i = 0; i < 16; ++i) G0[i] = G0[i] > R[15 - i] ? G0[i] : R[15 - i];
    bmerge_desc<16>(G0);
#pragma unroll
    for (int i = 8; i < 16; ++i) G0[i] = G0[i] > keys[16 + 15 - i] ? G0[i] : keys[16 + 15 - i];
    unsigned thr = G0[0];
#pragma unroll
    for (int i = 1; i < 16; ++i) thr = thr < G0[i] ? thr : G0[i];
    const float s00 = sums[0], sc = rn * LOG2E;
    float w[50]; float den = 0.f;
#pragma unroll
    for (int c = 0; c < 50; ++c) { w[c] = (keys[c] >= thr) ? __builtin_amdgcn_exp2f((sums[c] - s00) * sc) : 0.f; den += w[c]; }
    const float inv = 1.f / den;
    unsigned i0[16], i1[16];
#pragma unroll
    for (int i = 0; i < 16; ++i) { i0[i] = 127u - (A[0][i] & 127u); i1[i] = 127u - (A[1][i] & 127u); }
    GAS unsigned* outp = (GAS unsigned*)(SEL + ((size_t)tok * 8 + 2 * hp + hi) * 16);
    int pos = 0;
    { int c = 0;
#pragma unroll
      for (int i = 0; i < 16; ++i)
#pragma unroll
          for (int j = 0; j < 16; ++j) if ((i + 1) * (j + 1) <= 16) { if (keys[c] >= thr) { outp[pos & 15] = ((i0[i] * 128u + i1[j]) << 16) | f2bf(w[c] * inv); ++pos; } ++c; } }
}
}

constexpr size_t SLICE_BYTES = (size_t)NEXP * 128;
constexpr int TH = T / 2;
__device__ __forceinline__ unsigned nib4(float a, float b, float c, float d, float is, int off) {
    const int n0 = min(max((int)floorf(a * is), -8), 7) + off, n1 = min(max((int)floorf(b * is), -8), 7) + off, n2 = min(max((int)floorf(c * is), -8), 7) + off, n3 = min(max((int)floorf(d * is), -8), 7) + off;
    return (unsigned)(n0 & 15) | ((unsigned)(n1 & 15) << 8) | ((unsigned)(n2 & 15) << 16) | ((unsigned)(n3 & 15) << 24);
}
template <int NR> struct QRows { f32x4 v[NR][4]; };
template <int NR> __device__ __forceinline__ void quant_rows_load(QRows<NR>& q, const float* X, int e0, int es, int eend, int lane) {
#pragma unroll
    for (int r = 0; r < NR; ++r) { const int e = (e0 + r * es < eend) ? e0 + r * es : eend - 1; const GAS f32x4* xr = (const GAS f32x4*)(X + (size_t)e * DM) + lane;
#pragma unroll
        for (int j = 0; j < 4; ++j) q.v[r][j] = xr[64 * j]; }
}
template <int NR, bool OFFLO> __device__ __forceinline__ void quant_rows_finish(const QRows<NR>& q, unsigned char* qtab, float* scale, int e0, int es, int eend, int lane) {
#pragma unroll
    for (int r = 0; r < NR; ++r) { float ss = 0.f;
#pragma unroll
        for (int j = 0; j < 4; ++j) ss += (q.v[r][j].x * q.v[r][j].x + q.v[r][j].y * q.v[r][j].y) + (q.v[r][j].z * q.v[r][j].z + q.v[r][j].w * q.v[r][j].w);
        ss = wave_sum(ss);
        const float step = ss > 0.f ? 0.3352f * sqrtf(ss * (1.f / 1024.f)) : 1.f, is = 1.f / step;
        const int e = e0 + r * es;
        const unsigned twoc = (OFFLO && !(lane & 1)) ? 0u : 0x08080808u;
#pragma unroll
        for (int j = 0; j < 4; ++j) {
            const f32x4 y = q.v[r][j] * is + 7.5f;
            unsigned z[4];
#pragma unroll
            for (int e2 = 0; e2 < 4; ++e2) z[e2] = __builtin_bit_cast(unsigned, __builtin_amdgcn_fmed3f(y[e2], -0.5f, 15.0f) + 8388864.0f);
            const unsigned o = (__builtin_amdgcn_perm(z[1], z[0], 0x0c0c0400u) | __builtin_amdgcn_perm(z[3], z[2], 0x04000c0cu)) ^ twoc;
            const unsigned po = (unsigned)__builtin_amdgcn_update_dpp(0, (int)o, 0xB1, 0xf, 0xf, true);
            if (e < eend && !(lane & 1)) *(GAS unsigned*)(qtab + (size_t)j * SLICE_BYTES + (size_t)e * 128 + (lane >> 1) * 4) = o | (po << 4); }
        if (e < eend && lane == 0) scale[e] = 0.5f * step; }
}
template <int NR, bool OFFLO> __device__ __forceinline__ void quant_rows_i4(const float* X, unsigned char* qtab, float* scale, int e0, int es, int eend, int lane) {
    QRows<NR> q; quant_rows_load<NR>(q, X, e0, es, eend, lane); quant_rows_finish<NR, OFFLO>(q, qtab, scale, e0, es, eend, lane);
}
__device__ __forceinline__ void quant_tables_pipe(const float* PU, const float* PV, unsigned char* UQ, unsigned char* VQ, float* SU, float* SV, int w, int nw, int lane) {
    const int nb = (NEXP - w + 4 * nw - 1) / (4 * nw);
    QRows<4> A, B;
    auto ld = [&](QRows<4>& q, int k) { const int t = k / nb, m = w + 4 * (k % nb) * nw; quant_rows_load<4>(q, t ? PV : PU, m, nw, NEXP, lane); };
    auto fin = [&](const QRows<4>& q, int k) { const int t = k / nb, m = w + 4 * (k % nb) * nw; if (t) quant_rows_finish<4, true>(q, VQ, SV, m, nw, NEXP, lane); else quant_rows_finish<4, false>(q, UQ, SU, m, nw, NEXP, lane); };
    const int K = 2 * nb;
    ld(A, 0); asm volatile("" ::: "memory");
    for (int k = 0; k < K; k += 2) {
        if (k + 1 < K) ld(B, k + 1);
        asm volatile("" ::: "memory");
        fin(A, k); asm volatile("" ::: "memory");
        if (k + 2 < K) ld(A, k + 2);
        asm volatile("" ::: "memory");
        if (k + 1 < K) fin(B, k + 1);
        asm volatile("" ::: "memory");
    }
}
constexpr int NQCHUNK = 2 * NEXP / 8;
__device__ __forceinline__ void quant_tables_part(const float* PU, const float* PV, unsigned char* UQ, unsigned char* VQ, float* SU, float* SV, int first, int end, int w, int nw, int lane) {
    for (int c = first + w; c < end; c += nw) { const int e0 = (c & 2047) * 8;
        if ((c >> 11) == 0) quant_rows_i4<8, false>(PU, UQ, SU, e0, 1, NEXP, lane); else quant_rows_i4<8, true>(PV, VQ, SV, e0, 1, NEXP, lane); }
}
template <int NR> __device__ __forceinline__ void quant_x(const bf16* HB, unsigned char* XQ, float* SX, int* XS, const float (&gf)[16], int t0, int ts, int lane) {
    f32x4 hv[NR][4];
#pragma unroll
    for (int r = 0; r < NR; ++r) { const int t = (t0 + r * ts < T) ? t0 + r * ts : T - 1; const GAS v2u* hrow = (const GAS v2u*)(HB + (size_t)t * DM) + lane;
#pragma unroll
        for (int j = 0; j < 4; ++j) { const v2u w = hrow[64 * j]; hv[r][j] = (f32x4){bflo(w.x), bfhi(w.x), bflo(w.y), bfhi(w.y)}; } }
#pragma unroll
    for (int r = 0; r < NR; ++r) { float ss = 0.f;
#pragma unroll
        for (int j = 0; j < 4; ++j) ss += (hv[r][j].x * hv[r][j].x + hv[r][j].y * hv[r][j].y) + (hv[r][j].z * hv[r][j].z + hv[r][j].w * hv[r][j].w);
        const float rn = 1.f / sqrtf(wave_sum(ss) * (1.f / 1024.f) + RMS_EPS);
        float xn[16]; float am = 0.f;
#pragma unroll
        for (int j = 0; j < 4; ++j)
#pragma unroll
            for (int e = 0; e < 4; ++e) { xn[4 * j + e] = hv[r][j][e] * rn * gf[4 * j + e]; am = fmaxf(am, fabsf(xn[4 * j + e])); }
#pragma unroll
        for (int o = 1; o < 64; o <<= 1) am = fmaxf(am, __shfl_xor(am, o));
        const float sx = am > 0.f ? am * (1.f / 119.f) : 1.f, isx = 1.f / sx;
        const int t = t0 + r * ts;
        float qsf = 0.f;
#pragma unroll
        for (int j = 0; j < 4; ++j) {
            unsigned zh[4], zl[4];
#pragma unroll
            for (int e = 0; e < 4; ++e) { const float q = __builtin_rintf(xn[4 * j + e] * isx), qh = __builtin_floorf(q * 0.0625f + 0.5f), ql = q - 16.f * qh; qsf += q;
                zh[e] = __builtin_bit_cast(unsigned, qh + 12582912.0f); zl[e] = __builtin_bit_cast(unsigned, ql + 12582912.0f); }
            const unsigned ph = (__builtin_amdgcn_perm(zh[1], zh[0], 0x0c0c0400u) | __builtin_amdgcn_perm(zh[3], zh[2], 0x04000c0cu)) & 0x0f0f0f0fu;
            const unsigned pl = (__builtin_amdgcn_perm(zl[1], zl[0], 0x0c0c0400u) | __builtin_amdgcn_perm(zl[3], zl[2], 0x04000c0cu)) & 0x0f0f0f0fu;
            const unsigned oh = (unsigned)__builtin_amdgcn_update_dpp(0, (int)ph, 0xB1, 0xf, 0xf, true), ol = (unsigned)__builtin_amdgcn_update_dpp(0, (int)pl, 0xB1, 0xf, 0xf, true);
            const unsigned word = (lane & 1) ? (ol | (pl << 4)) : (ph | (oh << 4));
            if (t < T) *(GAS unsigned*)(XQ + (size_t)t * DM + j * 256 + (lane >> 3) * 32 + (lane & 1) * 16 + ((lane & 7) >> 1) * 4) = word; }
        int qs = (int)qsf;
#pragma unroll
        for (int o = 1; o < 64; o <<= 1) qs += __shfl_xor(qs, o);
        if (t < T && lane == 0) { SX[t] = sx; XS[t] = qs; } }
}
__device__ __forceinline__ float gelu_exact(float x) { return 0.5f * x * (1.0f + erff(x * 0.70710678118654752f)); }
__device__ __forceinline__ int dpp_i(int v, int ctrl_is) {
    return ctrl_is == 0 ? __builtin_amdgcn_update_dpp(0, v, 0x141, 0xf, 0xf, true) : ctrl_is == 1 ? __builtin_amdgcn_update_dpp(0, v, 0xB1, 0xf, 0xf, true) : __builtin_amdgcn_update_dpp(0, v, 0x4E, 0xf, 0xf, true);
}
constexpr int QCHUNK = 8;
__device__ __forceinline__ int q_take(unsigned* q, int lane) {
    unsigned v = 0; if (lane == 0) v = __hip_atomic_fetch_add(q, (unsigned)QCHUNK, __ATOMIC_RELAXED, __HIP_MEMORY_SCOPE_AGENT);
    return (int)__builtin_amdgcn_readfirstlane(v);
}
struct TokStream {
    unsigned* q; int cur, end, nxt, stride;
    __device__ __forceinline__ void open_static(int c0, int W) { q = nullptr; cur = c0 * QCHUNK; end = cur + QCHUNK; nxt = 0; stride = W * QCHUNK; }
    __device__ __forceinline__ void open(unsigned* q_, int lane) { q = q_; stride = 0;
        unsigned v = 0; if (lane == 0) v = __hip_atomic_fetch_add(q, 2u * (unsigned)QCHUNK, __ATOMIC_RELAXED, __HIP_MEMORY_SCOPE_AGENT);
        cur = (int)__builtin_amdgcn_readfirstlane(v); end = cur + QCHUNK; nxt = cur + QCHUNK; }
    __device__ __forceinline__ int next(int lane) { const int t = cur; if (t >= TH) return TH; ++cur;
        if (cur == end) { if (q) { cur = nxt; end = cur + QCHUNK; if (cur < TH) nxt = q_take(q, lane); } else { cur += stride - QCHUNK; end = cur + QCHUNK; } }
        return t; }
};
struct SlicePlan { int xcc, srank, sW; unsigned cnts; };
__device__ __forceinline__ SlicePlan slice_plan(int xcc, int srank, int sW, const unsigned* xcnt  , int lane) {
    SlicePlan p; p.xcc = xcc; p.srank = srank; p.sW = sW;
    p.cnts = (sW > 0 && lane < 8) ? __hip_atomic_load(xcnt + 64 * lane, __ATOMIC_RELAXED, __HIP_MEMORY_SCOPE_AGENT) : 0u;
    return p;
}
__device__ __forceinline__ bool slice_open(TokStream& S, const SlicePlan& p, int qi, int x, unsigned* queues, int lane) {
    if (p.sW > 0 && qi == 0) { S.open_static(p.srank, p.sW); return true; }
    if (p.sW > 0 && (unsigned)__builtin_amdgcn_readlane((int)p.cnts, x) != 0u) return false;
    S.open(queues + 64 * x, lane); return true;
}
#define MEM_ORDER() asm volatile("" ::: "memory")
#ifdef PROBE_MASKV
#define PROBE_EMASK & emask
#define PROBE_EARG , unsigned emask
#define PROBE_EPASS , emask
#else
#define PROBE_EMASK
#define PROBE_EARG
#define PROBE_EPASS
#endif
__device__ __forceinline__ unsigned bperm(int src_lane4, unsigned v) { return (unsigned)__builtin_amdgcn_ds_bpermute(src_lane4, (int)v); }
struct UEnt { v2u R; unsigned x; };
__device__ __forceinline__ void u_ent(UEnt& E, const unsigned* SEL, const unsigned char* XQ, int t, int cs, int lane) {
    E.x = *(const GAS unsigned*)(XQ + (size_t)t * DM + cs * 256 + 4 * lane);
    E.R = *(const GAS v2u*)(SEL + (size_t)t * 128 + 2 * lane);
}
__device__ __forceinline__ void u_rows(v4u (&w)[16], unsigned& xr, const UEnt& E, int lane, const unsigned char* tab, unsigned choff PROBE_EARG) {
    const v2u R = E.R;
    const int gb = (lane >> 3) * 32;
#pragma unroll
    for (int g = 0; g < 16; ++g) { const unsigned e = bperm(gb + 4 * (g >> 1), (g & 1) ? R.y : R.x);
        w[g] = *(const GAS v4u*)(tab + (unsigned)(((e >> 16) PROBE_EMASK) * 128u + choff)); }
    xr = E.x;
}
__device__ __forceinline__ int dot8z(unsigned a, unsigned b) { int r; asm("v_dot8_i32_i4 %0, %1, %2, 0" : "=v"(r) : "v"(a), "v"(b)); return r; }
__device__ __forceinline__ void u_compute(const v4u (&w)[16], const unsigned xr, int* prow, int grp, int ch, int c0, int c1, int c2) {
    int p[16];
    v4u xh, xl;
#pragma unroll
    for (int j = 0; j < 4; ++j) { xh[j] = bperm(32 * ch + 4 * j, xr); xl[j] = bperm(32 * ch + 16 + 4 * j, xr); }
#pragma unroll
    for (int g = 0; g < 16; ++g) { int ah = dot8z(w[g][0], xh[0]), al = dot8z(w[g][0], xl[0]);
#pragma unroll
        for (int j = 1; j < 4; ++j) { ah = __builtin_amdgcn_sdot8((int)w[g][j], (int)xh[j], ah, false); al = __builtin_amdgcn_sdot8((int)w[g][j], (int)xl[j], al, false); }
        p[g] = (ah << 4) + al; }
    int q8[8], q4[4], q2[2];
#pragma unroll
    for (int i = 0; i < 8; ++i) { const int keep = c2 ? p[i + 8] : p[i], send = c2 ? p[i] : p[i + 8]; q8[i] = keep + dpp_i(send, 0); }
#pragma unroll
    for (int i = 0; i < 4; ++i) { const int keep = c0 ? q8[i + 4] : q8[i], send = c0 ? q8[i] : q8[i + 4]; q4[i] = keep + dpp_i(send, 1); }
#pragma unroll
    for (int i = 0; i < 2; ++i) { const int keep = c1 ? q4[i + 2] : q4[i], send = c1 ? q4[i] : q4[i + 2]; q2[i] = keep + dpp_i(send, 2); }
    const int g0 = 8 * c2 + 4 * c0 + 2 * c1;
    typedef int i2 __attribute__((ext_vector_type(2)));
    *(GAS i2*)(prow + grp * 16 + g0) = (i2){q2[0], q2[1]};
}
__device__ __forceinline__ void gather_u(const unsigned* SEL0, const unsigned char* XQ0, const unsigned char* UQS, int* PART, int* dummy, unsigned* queues, const SlicePlan& plan, int lane PROBE_EARG) {
    const int grp = lane >> 3, ch = lane & 7, c0 = ch & 1, c1 = (ch >> 1) & 1, c2 = (ch >> 2) & 1;
    for (int qi = 0; qi < 8; ++qi) { const int x = (plan.xcc + qi) & 7, cs = x & 3, tb = (x >> 2) * TH;
        TokStream S; if (!slice_open(S, plan, qi, x, queues, lane)) continue;
        const unsigned char* tab = UQS + (size_t)cs * SLICE_BYTES; const unsigned choff = (unsigned)ch * 16u;
        int* part = PART + ((size_t)cs * T + tb) * 128;
        const unsigned* SEL = SEL0 + (size_t)tb * 128; const unsigned char* XQ = XQ0 + (size_t)tb * DM;
        int tA = S.next(lane), tB = S.next(lane);
        if (tA >= TH) continue;
        UEnt EA, EB; v4u W0[16], W1[16]; unsigned X0, X1;
        u_ent(EA, SEL, XQ, tA, cs, lane); u_ent(EB, SEL, XQ, tB < TH ? tB : TH - 1, cs, lane); MEM_ORDER();
        u_rows(W0, X0, EA, lane, tab, choff PROBE_EPASS); MEM_ORDER();
        while (tA < TH) {
            const int tC = S.next(lane);
            u_ent(EA, SEL, XQ, tC < TH ? tC : TH - 1, cs, lane); MEM_ORDER();
            u_rows(W1, X1, EB, lane, tab, choff PROBE_EPASS); MEM_ORDER();
            u_compute(W0, X0, part + (size_t)tA * 128, grp, ch, c0, c1, c2); MEM_ORDER();
            const int tD = S.next(lane);
            u_ent(EB, SEL, XQ, tD < TH ? tD : TH - 1, cs, lane); MEM_ORDER();
            u_rows(W0, X0, EA, lane, tab, choff PROBE_EPASS); MEM_ORDER();
            u_compute(W1, X1, tB < TH ? part + (size_t)tB * 128 : dummy, grp, ch, c0, c1, c2); MEM_ORDER();
            tA = tC; tB = tD;
        }
    }
}
template <int NR> __device__ __forceinline__ void gather_coef(const unsigned* SEL, const int* PART, const float* SU, const float* SV, const float* SX, const int* XS, signed char* CQ, unsigned* EO, float* SCL, int* CSM, int t0, int ts, int lane) {
    typedef int i2 __attribute__((ext_vector_type(2)));
    v2u ent[NR]; i2 acc[NR]; float sx[NR]; int xs[NR]; int tt[NR];
#pragma unroll
    for (int r = 0; r < NR; ++r) { tt[r] = (t0 + r * ts < T) ? t0 + r * ts : T - 1; ent[r] = *(const GAS v2u*)(SEL + (size_t)tt[r] * 128 + 2 * lane);
        sx[r] = __hip_atomic_load(SX + tt[r], __ATOMIC_RELAXED, __HIP_MEMORY_SCOPE_AGENT);
        xs[r] = __hip_atomic_load(XS + tt[r], __ATOMIC_RELAXED, __HIP_MEMORY_SCOPE_AGENT);
        acc[r] = (i2){0, 0}; }
#pragma unroll
    for (int r = 0; r < NR; ++r)
#pragma unroll
        for (int x = 0; x < 4; ++x) { const i2 pp = *(const GAS i2*)(PART + ((size_t)x * T + tt[r]) * 128 + 2 * lane); acc[r] += pp; }
    float su0[NR], sv0[NR], su1[NR], sv1[NR];
#pragma unroll
    for (int r = 0; r < NR; ++r) { const unsigned e0 = ent[r].x >> 16, e1 = ent[r].y >> 16; su0[r] = SU[e0]; sv0[r] = SV[e0]; su1[r] = SU[e1]; sv1[r] = SV[e1]; }
#pragma unroll
    for (int r = 0; r < NR; ++r) {
        const float k0 = bflo(ent[r].x) * gelu_exact((float)(2 * acc[r].x + xs[r]) * (su0[r] * sx[r])) * sv0[r], k1 = bflo(ent[r].y) * gelu_exact((float)(2 * acc[r].y + xs[r]) * (su1[r] * sx[r])) * sv1[r];
        float am = fmaxf(fabsf(k0), fabsf(k1));
#pragma unroll
        for (int o = 1; o < 64; o <<= 1) am = fmaxf(am, __shfl_xor(am, o));
        const float sc = am > 0.f ? am * (1.f / 127.f) : 1.f, isc = 1.f / sc;
        const int c0 = (int)rintf(k0 * isc), c1 = (int)rintf(k1 * isc);
        int csum = c0 + c1;
#pragma unroll
        for (int o = 1; o < 64; o <<= 1) csum += __shfl_xor(csum, o);
        if (t0 + r * ts < T) {
            GAS unsigned short* cq = (GAS unsigned short*)((GAS signed char*)CQ + (size_t)tt[r] * 128);
            cq[lane] = (unsigned short)((unsigned)(c0 & 0xff) | ((unsigned)(c1 & 0xff) << 8));
            *(GAS v2u*)(EO + (size_t)tt[r] * 128 + 2 * lane) = (v2u){(ent[r].x >> 16) * 128u, (ent[r].y >> 16) * 128u};
            if (lane == 0) { SCL[tt[r]] = sc * 0.125f; CSM[tt[r]] = 8 * csum; } } }
}
typedef int v4i __attribute__((ext_vector_type(4)));
typedef float vf4 __attribute__((ext_vector_type(4)));
struct VCoef { v4i A; float sc; int cs; v2u hb; };
struct VEnt { VCoef c; v2u R; };
__device__ __forceinline__ void v_ent(VEnt& E, const unsigned* EO, const signed char* CQ, const float* SCL, const int* CSM, const bf16* HIcol, int t, int lane) {
    const int ic = lane & 3, kb = lane >> 4;
    E.c.A = *(const GAS v4i*)((const GAS signed char*)CQ + (size_t)t * 128 + (2 * kb + (ic & 1)) * 16);
    E.c.sc = __hip_atomic_load(SCL + t, __ATOMIC_RELAXED, __HIP_MEMORY_SCOPE_AGENT);
    E.c.cs = __hip_atomic_load(CSM + t, __ATOMIC_RELAXED, __HIP_MEMORY_SCOPE_AGENT);
    E.c.hb = *(const GAS v2u*)(HIcol + (size_t)t * DM);
    E.R = *(const GAS v2u*)(EO + (size_t)t * 128 + 2 * lane);
}
__device__ __forceinline__ void v_rows(v4u (&w)[16], VCoef& c, const VEnt& E, int lane, const unsigned char* tab, unsigned choff) {
    const int gb = (lane >> 3) * 32; const v2u R = E.R;
#pragma unroll
    for (int g = 0; g < 16; ++g) { const unsigned eo = bperm(gb + 4 * (g >> 1), (g & 1) ? R.y : R.x); w[g] = *(const GAS v4u*)(tab + (unsigned)(eo + choff)); }
    c = E.c;
}
__device__ __forceinline__ unsigned permb(unsigned hi, unsigned lo, unsigned sel) { return __builtin_amdgcn_perm(hi, lo, sel); }
__device__ __forceinline__ int ror8(int v) { return __builtin_amdgcn_update_dpp(0, v, 0x128, 0xf, 0xf, true); }
__device__ __forceinline__ void v_compute(const v4u (&w)[16], const VCoef& C, float* hout, LAS int* stg, int lane, bool half, bool storer, bool arow) {
    const v4i CA = arow ? C.A : (v4i){0, 0, 0, 0};
#pragma unroll
    for (int jp = 0; jp < 2; ++jp) {
        int tr[2][4], th[2][4];
#pragma unroll
        for (int jj = 0; jj < 2; ++jj) { const int j = 2 * jp + jj;
            unsigned K[4][4];
#pragma unroll
            for (int q = 0; q < 4; ++q) { const unsigned a = w[4 * q][j], b = w[4 * q + 1][j], c = w[4 * q + 2][j], d = w[4 * q + 3][j];
                const unsigned t0 = permb(a, b, 0x01050004u), t1 = permb(a, b, 0x03070206u), t2 = permb(c, d, 0x01050004u), t3 = permb(c, d, 0x03070206u);
                K[q][0] = permb(t2, t0, 0x05040100u); K[q][1] = permb(t2, t0, 0x07060302u); K[q][2] = permb(t3, t1, 0x05040100u); K[q][3] = permb(t3, t1, 0x07060302u); }
#pragma unroll
            for (int k = 0; k < 4; ++k) {
                const v4i Br = {(int)K[0][k], (int)K[1][k], (int)K[2][k], (int)K[3][k]};
                const v4i Bh = {(int)(K[0][k] & 0xF0F0F0F0u), (int)(K[1][k] & 0xF0F0F0F0u), (int)(K[2][k] & 0xF0F0F0F0u), (int)(K[3][k] & 0xF0F0F0F0u)};
                const v4i Dr = __builtin_amdgcn_mfma_i32_16x16x64_i8(CA, Br, (v4i){0, 0, 0, 0}, 0, 0, 0);
                const v4i Dh = __builtin_amdgcn_mfma_i32_16x16x64_i8(CA, Bh, (v4i){0, 0, 0, 0}, 0, 0, 0);
                tr[jj][k] = jj ? Dr[1] + ror8(Dr[0]) : Dr[0] + ror8(Dr[1]);
                th[jj][k] = jj ? Dh[1] + ror8(Dh[0]) : Dh[0] + ror8(Dh[1]); }
        }
        v4i lo, hi;
#pragma unroll
        for (int k = 0; k < 4; ++k) { const int d0 = tr[0][k] - th[0][k], d1 = tr[1][k] - th[1][k]; lo[k] = half ? d1 : d0; hi[k] = half ? th[1][k] : th[0][k]; }
        if (storer) { LAS v4i* sp = (LAS v4i*)(stg + (lane & 7) * 32 + 16 * jp + 8 * (lane >> 3)); sp[0] = lo; sp[1] = hi; }
    }
    const v4i x = *(const LAS v4i*)(stg + 4 * lane);
    const bool hin = (lane & 1) != 0; const int k15 = -15 * C.cs;
    const float h4[4] = {bflo(C.hb.x), bfhi(C.hb.x), bflo(C.hb.y), bfhi(C.hb.y)};
    vf4 o;
#pragma unroll
    for (int e = 0; e < 4; ++e) o[e] = h4[e] + C.sc * (float)(hin ? x[e] + C.cs : (x[e] << 4) + k15);
    __builtin_nontemporal_store(o, (GAS vf4*)hout);
}
#define VCOMP(W, C, P) v_compute(W, C, P, stg, lane, half, storer, arow)
__device__ __forceinline__ void gather_v(const unsigned* EO0, const signed char* CQ0, const float* SCL0, const int* CSM0, const unsigned char* VQS, const bf16* HI0, float* HO0, float* dummy, unsigned* queues, const SlicePlan& plan, int lane, LAS int* stg) {
    const int ch = lane & 7; const bool half = ((lane >> 3) & 1) != 0, storer = lane < 16, arow = (lane & 15) < 2;
    for (int qi = 0; qi < 8; ++qi) { const int x = (plan.xcc + qi) & 7, cs = x & 3, tb = (x >> 2) * TH;
        TokStream S; if (!slice_open(S, plan, qi, x, queues, lane)) continue;
        const unsigned char* tab = VQS + (size_t)cs * SLICE_BYTES; const unsigned choff = (unsigned)ch * 16u;
        const int col = cs * 256 + 4 * lane;
        const unsigned* EO = EO0 + (size_t)tb * 128; const signed char* CQ = CQ0 + (size_t)tb * 128; const float* SCL = SCL0 + tb; const int* CSM = CSM0 + tb;
        const bf16* HI = HI0 + (size_t)tb * DM + col; float* HO = HO0 + (size_t)tb * DM + col;
        int tA = S.next(lane), tB = S.next(lane);
        if (tA >= TH) continue;
        VEnt EA, EB; v4u W0[16], W1[16]; VCoef C0, C1;
        v_ent(EA, EO, CQ, SCL, CSM, HI, tA, lane); v_ent(EB, EO, CQ, SCL, CSM, HI, tB < TH ? tB : TH - 1, lane); MEM_ORDER();
        v_rows(W0, C0, EA, lane, tab, choff); MEM_ORDER();
        while (tA < TH) {
            const int tC = S.next(lane);
            v_ent(EA, EO, CQ, SCL, CSM, HI, tC < TH ? tC : TH - 1, lane); MEM_ORDER();
            v_rows(W1, C1, EB, lane, tab, choff); MEM_ORDER();
            VCOMP(W0, C0, HO + (size_t)tA * DM); MEM_ORDER();
            const int tD = S.next(lane);
            v_ent(EB, EO, CQ, SCL, CSM, HI, tD < TH ? tD : TH - 1, lane); MEM_ORDER();
            v_rows(W0, C0, EA, lane, tab, choff); MEM_ORDER();
            VCOMP(W1, C1, tB < TH ? HO + (size_t)tB * DM : dummy + 4 * lane); MEM_ORDER();
            tA = tC; tB = tD;
        }
    }
}

#ifndef MK_SPLIT
#define MK_SPLIT 0
#endif
constexpr int NPHASE = 11;
typedef SlicePlan pk_plan_t;
#ifndef PROBE_PH
#define PROBE_PH -1
#endif
#ifndef PROBE_N
#define PROBE_N 1
#endif
#define REPS(k) (((k) == PROBE_PH) ? 1 + PROBE_N : 1)
struct Args { const float* in[21]; float* out; unsigned char* ws; int ph_lo, ph_hi; };
static_assert(sizeof(Args) == 23 * 8 + 8, "Args has no padding");

__global__ void __launch_bounds__(NWAVES * 64, 2) fwd(Args args) {
    extern __shared__ __attribute__((aligned(16))) unsigned char lds_raw[];
    LAS unsigned char* lds = (LAS unsigned char*)lds_raw;
    volatile LAS unsigned* MISC = (volatile LAS unsigned*)(lds + MISC_OFF);
    const int tid = threadIdx.x, lane = tid & 63, wave = __builtin_amdgcn_readfirstlane(tid >> 6);
    const int G = gridDim.x; const int bx = blockIdx.x; const int vcu = (G % 8 == 0) ? (bx % 8) * (G / 8) + bx / 8 : bx;
    const int gw = vcu * NWAVES + wave, NGW = G * NWAVES;
    unsigned char* ws = args.ws;
    gu32* ctl = (gu32*)(ws + WS_CTL);
    const float* x = args.in[0]; const float* mem = args.in[1]; const float* g_mix = args.in[2]; const float* w_in = args.in[3]; const float* q_gain_a = args.in[4]; const float* k_gain_a = args.in[5];
    const float* rel_bias = args.in[6]; const float* conv_w = args.in[7]; const float* g_mem = args.in[8]; const float* w_mem_kv = args.in[9]; const float* q_gain_x = args.in[10]; const float* k_gain_x = args.in[11];
    const float* w_br_attn = args.in[12]; const float* w_br_conv = args.in[13]; const float* w_br_x = args.in[14]; const float* w_out = args.in[15]; const float* g_ffn = args.in[16];
    const float* w_query = args.in[17]; const float* sub_keys = args.in[18]; const float* peer_u = args.in[19]; const float* peer_v = args.in[20];
    float* out = args.out;
    bf16* WinT = (bf16*)(ws + WS_WIN); bf16* WkvT = (bf16*)(ws + WS_WKV); bf16* WbrT = (bf16*)(ws + WS_WBR); bf16* WoutT = (bf16*)(ws + WS_WOUT); bf16* WqT = (bf16*)(ws + WS_WQ);
    bf16* SK = (bf16*)(ws + WS_SK); float* TAB = (float*)(ws + WS_TAB); float* KMEAN = (float*)(ws + WS_KMEAN); bf16* MEMN = (bf16*)(ws + WS_MEMN); bf16* KVM = (bf16*)(ws + WS_KVM);
    float* SLOTS = (float*)(ws + WS_SLOTS); unsigned* SEL = (unsigned*)(ws + WS_SEL);
    bf16* PA = (bf16*)(ws + WS_PA); bf16* PG = (bf16*)(ws + WS_PG);
    bf16* MERGED = (bf16*)(ws + PA_MERGED); bf16* HB = (bf16*)(ws + PA_HB); unsigned char* UQ = ws + PA_UT; unsigned char* VQ = ws + PA_VT; float* SU = (float*)(ws + WS_SU); float* SV = (float*)(ws + WS_SV); int* CM = (int*)(ws + WS_CM); float* SAq = (float*)(ws + WS_SA); float* SBq = (float*)(ws + WS_SB); int* XSM = (int*)(ws + WS_XS); float* SX = (float*)(ws + WS_SX); float* CS = (float*)(ws + WS_CS);
    unsigned char* XQ = ws + PA_XQ; int* PART = (int*)(ws + PG_PART); signed char* CQ = (signed char*)(ws + PG_COEF); unsigned* EO = (unsigned*)(ws + PG_COEF + 8 * MiB); bf16* QRY = (bf16*)(ws + PG_QRY);
    bf16* HN = (bf16*)out;
    bf16* BRO = (bf16*)out;

    for (int u = tid; u < (LDS_BYTES - LDSCTL_OFF) / 4; u += NWAVES * 64) ((LAS unsigned*)(lds + LDSCTL_OFF))[u] = 0u;
    __syncthreads();
    for (int u = tid; u < 4096; u += NWAVES * 64) {
        const float sg = __builtin_amdgcn_rcpf(1.0f + __builtin_amdgcn_exp2f(-1.4426950408889634f * ((float)(u - 2048) * (1.f / 256.f))));
        lds[SIGTAB_OFF + u] = (unsigned char)fmaxf(1.f, __builtin_rintf(sg * 255.f)); }
    if (tid < 128) ((LAS float*)(lds + QKGAIN_OFF))[tid] = tid < 64 ? q_gain_a[tid] * C2A : k_gain_a[tid - 64];
    __syncthreads();
#if !MK_SPLIT
    XcdBarrier bar = xcd_barrier_post((unsigned*)(ctl + CW_BAR), MISC + 8);
    if (tid == 0) MISC[10] = __hip_atomic_fetch_add((unsigned*)(ctl + CW_RANK) + 64 * (bar.x & 7u), 1u, __ATOMIC_RELAXED, __HIP_MEMORY_SCOPE_AGENT);
#define GRID_BAR() xcd_barrier(bar)
#define gbw ((unsigned*)(ctl + CW_GB))
    if (tid == 0) (void)__hip_atomic_fetch_or(&gbw[GB_MASK(bx & 7)], 1u << (bar.x & 15u), __ATOMIC_RELAXED, __HIP_MEMORY_SCOPE_AGENT);
#define GROUP_BAR() do { if (MISC[12] != 0u) grp_barrier(gbw, (unsigned)(bx & 7), 32u); else xcd_barrier(bar); } while (0)
#else
#define GRID_BAR() do {} while (0)
#define GROUP_BAR() do {} while (0)
#endif
    const int lo = args.ph_lo, hi_ = args.ph_hi;
#ifndef PH_MASK
#define PH_MASK 0x7ff
#endif
#define IN(k) ((((PH_MASK) >> (k)) & 1) && lo <= (k) && (k) < hi_)
#define BOTH(k) (IN(k) && IN((k) + 1))

    const P0Args p0a{x, mem, g_mix, w_in, rel_bias, g_mem, w_mem_kv, w_br_attn, w_br_conv, w_br_x, w_out, g_ffn, w_query, sub_keys, WinT, WkvT, WbrT, WoutT, WqT, SK, HN, MEMN, TAB, SAq, SBq};
    #ifndef LATE_W
#define LATE_W 1
#endif
    const int n_busy = (G == 256) ? 192 : (64 * 26) % G + 32;
    const bool late_w = LATE_W && IN(0) && IN(1) && n_busy < G;
    if (IN(0)) for (int rep = 0; rep < REPS(0); ++rep) {
        p0_prologue(p0a, lds, late_w, gw, NGW, wave, lane);
        if (BOTH(0) && rep == REPS(0) - 1) { GRID_BAR();
#if !MK_SPLIT
            if (tid == 0) { unsigned ok = (G == 256) ? 1u : 0u;
                for (int j = 0; j < 8; ++j) { const unsigned m = xb_ld(&gbw[GB_MASK(j)]); ok &= (__builtin_popcount(m) == 1) ? 1u : 0u; }
                MISC[12] = ok; }
            __syncthreads();
#endif
        }
    }
    if (IN(1)) for (int rep = 0; rep < REPS(1); ++rep) {
        { pg8::Gemm g{HN, WinT, T, PW, DM / 2}; pg8::P1Order S; S.init(T, PW, G, bx); pg8::EpiProj E{PA, PG, q_gain_a, k_gain_a, KMEAN, C2A, RMS_EPS, SAq, SBq, lds + SIGTAB_OFF, (LAS float*)(lds + SASTAGE_OFF), (const LAS float*)(lds + QKGAIN_OFF)};
          pg8::gemm_phase<pg8::EpiProj, pg8::P1Order, true, true, true>(lds + RING_OFF, g, S, E); }
        { const int nfull = (64 * 26) % G; const int coff = (nfull + 32 <= G) ? bx - nfull : bx;
          pg8::Gemm g{MEMN, WkvT, NBATCH * MEMLEN, 1024, DM}; pg8::GOrder S; S.init(NBATCH * MEMLEN, 1024, G, (G == 256) ? (((bx >> 3) >= 16 && (bx >> 3) < 20) ? (((bx & 3) << 3) + 2 * ((bx >> 3) - 16) + ((bx & 7) >> 2)) : -1) : coff); pg8::EpiBf16<0> E{KVM, 1024, nullptr, 0, 0, 1.f};
          pg8::gemm_phase<pg8::EpiBf16<0>, pg8::GOrder, true, true>(lds + RING_OFF, g, S, E); }
        if (late_w && rep == 0 && bx >= n_busy) p0_transposes(p0a, lds, 1, (bx - n_busy) * NWAVES + wave, (G - n_busy) * NWAVES, wave, lane);
        if (IN(1) && IN(3) && rep == REPS(1) - 1) GROUP_BAR();
    }
#if defined(PROBE_BARS) && !MK_SPLIT
    if (IN(1)) for (int i = 0; i < PROBE_BARS; ++i) GRID_BAR();
#endif
    if (IN(3)) for (int rep = 0; rep < REPS(3); ++rep) {
        for (int v = vcu; v < 256; v += G) {
            const int bh = v >> 2, b = bh >> 3, h = bh & 7, s = v & 3;
#pragma unroll 1
            for (int pass = 0; pass < 2; ++pass) { const int qb = pass ? 7 - s : s;
                const bf16* Qp = PA + (size_t)(b * SEQ + qb * 256) * PAW + COL_QA + h * 64;
                const bf16* Kp = PA + (size_t)(b * SEQ) * PAW + COL_KA + h * 64; const bf16* Vp = PA + (size_t)(b * SEQ) * PAW + COL_VA + h * 64;
                bf16* Op = BRO + (size_t)(b * SEQ + qb * 256) * 512 + h * 64;
                att::attn_unit<64, true>(Qp, PAW, Kp, Vp, PAW, Op, qb, KMEAN + (size_t)bh * 512, TAB + h * 2048, q_gain_a, k_gain_a, lds + RING_OFF, tid, wave, lane); }
            { const int bb = v >> 5, hx = (v >> 3) & 3, qt = v & 7;
                const bf16* Qp = PA + (size_t)(bb * SEQ + qt * 256) * PAW + COL_QX + hx * 128;
                const bf16* Kp = KVM + (size_t)(bb * MEMLEN) * 1024 + hx * 128; const bf16* Vp = Kp + 512;
                bf16* Op = BRO + (size_t)2 * T * 512 + (size_t)(bb * SEQ + qt * 256) * 512 + hx * 128;
                att::attn_unit<128, false>(Qp, PAW, Kp, Vp, 1024, Op, 0, nullptr, nullptr, q_gain_x, k_gain_x, lds + RING_OFF, tid, wave, lane); }
            conv_item(PA, conv_w, BRO + (size_t)T * 512, v, tid);
        }
#if LATE_W
        if (BOTH(3) && rep == REPS(3) - 1) GRID_BAR();
#else
        if (BOTH(3) && rep == REPS(3) - 1) GROUP_BAR();
#endif
    }
    if (IN(4)) for (int rep = 0; rep < REPS(4); ++rep) {
        pg8::Gemm g{BRO, WbrT, 3 * T, 3 * 1024, 512}; pg8::BranchOrder S; S.init(G, bx); pg8::EpiBranch E{PG, MERGED, ws + 108 * MiB + (size_t)(bx & 7) * (8 * MiB) + (size_t)(bx >> 3) * 65536};
        pg8::gemm_phase<pg8::EpiBranch, pg8::BranchOrder, true, true>(lds + RING_OFF, g, S, E);
        if (BOTH(4) && rep == REPS(4) - 1) GROUP_BAR();
    }
    if (IN(5)) for (int rep = 0; rep < REPS(5); ++rep) {
        pg8::Gemm g{MERGED, WoutT, T, 1024, DM}; pg8::GOrder S; S.init(T, 1024, G, bx); pg8::EpiWout E{x, out, HB, SLOTS};
        pg8::gemm_phase<pg8::EpiWout, pg8::GOrder, true, true>(lds + RING_OFF, g, S, E);
        if (BOTH(5) && rep == REPS(5) - 1) GROUP_BAR();
    }
    if (IN(6)) for (int rep = 0; rep < REPS(6); ++rep) {
        pg8::Gemm g{HB, WqT, T, 2048, DM}; pg8::GOrder S; S.init(T, 2048, G, bx); pg8::EpiScores E{QRY};
        pg8::gemm_phase<pg8::EpiScores, pg8::GOrder, true, true>(lds + RING_OFF, g, S, E);
        if (BOTH(6) && rep == REPS(6) - 1) GROUP_BAR();
    }
    if (IN(7)) for (int rep = 0; rep < REPS(7); ++rep) {
        for (int v = vcu; v < 256; v += G) {
#ifndef PROBE_SKIP
#define PROBE_SKIP 0
#endif
            const bool lastrep = rep == REPS(7) - 1;
#ifndef P7_NRQ
#define P7_NRQ 8
#endif
#ifdef P7_STAGGER
            if (wave < 4 && (!(PROBE_SKIP & 1) || lastrep)) pk::topk_task(QRY, SLOTS, SEL, lds + RING_OFF, v & 3, ((v >> 2) * 8 + wave) * 32, lane);
#endif
#ifdef P7_SIDE
            if (wave < 4) {
#pragma unroll 1
                for (int r2 = 0; r2 < 2; ++r2) pk::topk_task(QRY, SLOTS, SEL, lds + RING_OFF, v & 3, ((v >> 2) * 8 + wave * 2 + r2) * 32, lane);
            } else if (v == vcu) {
                const int qgw = vcu * 4 + (wave - 4), QNGW = G * 4;
                for (int m = qgw; m < NEXP; m += 8 * QNGW) quant_rows_i4<8, false>(peer_u, UQ, SU, m, QNGW, NEXP, lane);
                for (int m = qgw; m < NEXP; m += 8 * QNGW) quant_rows_i4<8, true>(peer_v, VQ, SV, m, QNGW, NEXP, lane);
                float gf[16];
#pragma unroll
                for (int j = 0; j < 16; ++j) gf[j] = g_ffn[4 * lane + 256 * (j >> 2) + (j & 3)];
                for (int t = qgw; t < T; t += 8 * QNGW) quant_x<8>(HB, XQ, SX, XSM, gf, t, QNGW, lane);
            }
#else
            if (v == vcu && (!(PROBE_SKIP & 2) || lastrep)) {
                const int qgw = vcu * NWAVES + wave, QNGW = G * NWAVES;
#ifndef P7_NOPIPE
                quant_tables_pipe(peer_u, peer_v, UQ, VQ, SU, SV, qgw, QNGW, lane);
#else
                for (int m = qgw; m < NEXP; m += P7_NRQ * QNGW) quant_rows_i4<P7_NRQ, false>(peer_u, UQ, SU, m, QNGW, NEXP, lane);
                for (int m = qgw; m < NEXP; m += P7_NRQ * QNGW) quant_rows_i4<P7_NRQ, true>(peer_v, VQ, SV, m, QNGW, NEXP, lane);
#endif
                float gf[16];
#pragma unroll
                for (int j = 0; j < 16; ++j) gf[j] = g_ffn[4 * lane + 256 * (j >> 2) + (j & 3)];
                {
                  const bool own = (G == 256); const int qt0 = own ? vcu * 64 + wave * 8 : qgw, qts = own ? 1 : QNGW, qend = own ? qt0 + 1 : T;
                  for (int t = qt0; t < qend; t += P7_NRQ * QNGW) quant_x<P7_NRQ>(HB, XQ, SX, XSM, gf, t, qts, lane); }
            }
#ifdef P7_STAGGER
            if (wave >= 4 && (!(PROBE_SKIP & 1) || lastrep)) pk::topk_task(QRY, SLOTS, SEL, lds + RING_OFF, v & 3, ((v >> 2) * 8 + wave) * 32, lane);
#else
            if (!(PROBE_SKIP & 1) || lastrep) pk::topk_task(QRY, SLOTS, SEL, lds + RING_OFF, v & 3, ((v >> 2) * 8 + wave) * 32, lane);
#endif
#endif
            __syncthreads();
        }
        if (BOTH(7) && rep == REPS(7) - 1) GRID_BAR();
    }
#if !MK_SPLIT
    const int xcc = (int)bar.x & 7;
    const int nloc = (int)__builtin_amdgcn_readfirstlane((int)MISC[8]), wrank = (int)__builtin_amdgcn_readfirstlane((int)MISC[10]);
    const pk_plan_t plan = slice_plan(xcc, wrank * NWAVES + wave, nloc * NWAVES, (const unsigned*)(ctl + CW_BAR) + XB_XCNT(0), lane);
#else
    const int xcc = (int)(xb_xcc_id() & 7u);
    const pk_plan_t plan = slice_plan(xcc, 0, 0, nullptr, lane);
#endif
    if (IN(8)) for (int rep = 0; rep < REPS(8); ++rep) {
        #ifdef PROBE_MASKV
        gather_u(SEL, XQ, UQ, PART, (int*)(ws + WS_END), (unsigned*)(ctl + CW_QU + 4096 * rep), plan, lane, (rep == REPS(8) - 1) ? 0xffffu : (unsigned)PROBE_MASKV);
#else
        gather_u(SEL, XQ, UQ, PART, (int*)(ws + WS_END), (unsigned*)(ctl + CW_QU + 4096 * rep), plan, lane);
#endif
        if (BOTH(8) && rep == REPS(8) - 1) GRID_BAR();
    }
    if (IN(9)) for (int rep = 0; rep < REPS(9); ++rep) {
        for (int t = gw; t < T; t += 4 * NGW) gather_coef<4>(SEL, PART, SU, SV, SX, XSM, CQ, EO, CS, CM, t, NGW, lane);
        if (BOTH(9) && rep == REPS(9) - 1) GRID_BAR();
    }
    if (IN(10)) for (int rep = 0; rep < REPS(10); ++rep) {
        gather_v(EO, CQ, CS, CM, VQ, HB, (rep == REPS(10) - 1) ? out : (float*)PART, (float*)(ws + WS_END), (unsigned*)(ctl + CW_QV + 4096 * rep), plan, lane, (LAS int*)(lds + RING_OFF + wave * 1024));
    }
#undef IN
#undef BOTH
}

extern "C" void kernel_launch(void* const* d_in, const int* in_sizes, int n_in, void* d_out, int out_size, void* d_ws, size_t ws_size, hipStream_t stream) {
    static int grid = 0;
    if (grid == 0) {
        if (n_in != 21 || out_size != T * DM || ws_size < WS_END + 4096) { fprintf(stderr, "kernel_launch: unexpected shapes (n_in %d, out %d, ws %zu)\n", n_in, out_size, ws_size); grid = -1; return; }
        int dev = 0, cus = 0, per_cu = 0;
        if (hipGetDevice(&dev) != hipSuccess || hipDeviceGetAttribute(&cus, hipDeviceAttributeMultiprocessorCount, dev) != hipSuccess) { grid = -1; return; }
        if (hipFuncSetAttribute((const void*)fwd, hipFuncAttributeMaxDynamicSharedMemorySize, LDS_BYTES) != hipSuccess) { fprintf(stderr, "kernel_launch: hipFuncSetAttribute failed\n"); grid = -1; return; }
        if (hipOccupancyMaxActiveBlocksPerMultiprocessor(&per_cu, (const void*)fwd, NWAVES * 64, LDS_BYTES) != hipSuccess || per_cu < 1) { fprintf(stderr, "kernel_launch: occupancy query reports %d\n", per_cu); }
        (void)hipGetLastError();
        grid = cus;
    }
    if (grid < 0) return;
    (void)hipMemsetAsync((char*)d_ws + WS_CTL, 0, CTL_ZERO_BYTES, stream);
    Args a{};
    for (int i = 0; i < 21; ++i) a.in[i] = (const float*)d_in[i];
    a.out = (float*)d_out; a.ws = (unsigned char*)d_ws;
#if MK_SPLIT
    for (int p = 0; p < NPHASE; ++p) { a.ph_lo = p; a.ph_hi = p + 1; hipLaunchKernelGGL(fwd, dim3(grid), dim3(NWAVES * 64), LDS_BYTES, stream, a); }
#else
#if defined(PROBE_UPTO)
    a.ph_lo = 0; a.ph_hi = PROBE_UPTO + 1;
    hipLaunchKernelGGL(fwd, dim3(grid), dim3(NWAVES * 64), LDS_BYTES, stream, a);
    (void)hipMemsetAsync((char*)d_ws + WS_CTL, 0, CTL_ZERO_BYTES, stream);
#endif
    a.ph_lo = 0; a.ph_hi = NPHASE;
    hipLaunchKernelGGL(fwd, dim3(grid), dim3(NWAVES * 64), LDS_BYTES, stream, a);
#endif
}
```
